# Optimizing an MI355X kernel written in HIP

```python
import math
import jax, jax.numpy as jnp
from jax import lax
import numpy as np

D_MODEL = 1024
BATCH = 8
SEQ = 4096
DEPTH = 2

GRID_W = 64
CTX_LEN = 256
N_MIXERS = 2
N_RWKV = (DEPTH + 1) // 2
N_ATTN = DEPTH // 2
RWKV_HEAD = 64
RWKV_HEADS = D_MODEL // RWKV_HEAD
DECAY_LORA = 64
AAA_LORA = 64
GATE_LORA = 128
GN_EPS = 64e-5
ATTN_HEAD = 64
ATTN_HEADS = D_MODEL // ATTN_HEAD
KV_HEADS = 4
KV_GROUP = ATTN_HEADS // KV_HEADS
Q_BLOCK = 128
ROPE_THETA = 10000.0
D_FF = 4 * D_MODEL
NORM_EPS = 1e-6

kernel_name = "hybrid_rwkv7_gqa_dit_block"


def rms_norm(x, gain, eps=NORM_EPS):
    xf = x.astype(jnp.float32)
    y = xf * lax.rsqrt(jnp.mean(xf * xf, -1, keepdims=True) + eps)
    return (y * gain.astype(jnp.float32)).astype(x.dtype)


def modulate(h, shift, scale):
    return h * (1 + scale) + shift


def sqrelu_mlp(h, w1, w2):
    return jnp.square(jax.nn.relu(h @ w1)) @ w2


def grid_shift(x, rows):
    b, s, d = x.shape
    q = d // 4
    g = x.reshape(b, rows, GRID_W, d)
    left = jnp.pad(g[:, :, :-1, :q], ((0, 0), (0, 0), (1, 0), (0, 0)))
    right = jnp.pad(g[:, :, 1:, q:2 * q], ((0, 0), (0, 0), (0, 1), (0, 0)))
    up = jnp.pad(g[:, :-1, :, 2 * q:3 * q], ((0, 0), (1, 0), (0, 0), (0, 0)))
    down = jnp.pad(g[:, 1:, :, 3 * q:], ((0, 0), (0, 1), (0, 0), (0, 0)))
    return jnp.concatenate([left, right, up, down], -1).reshape(b, s, d)


def seq_shift(x):
    h = x.shape[-1] // 2
    prev = jnp.pad(x[:, :-1, :h], ((0, 0), (1, 0), (0, 0)))
    nxt = jnp.pad(x[:, 1:, h:], ((0, 0), (0, 1), (0, 0)))
    return jnp.concatenate([prev, nxt], -1)


def _wkv_step(state, inp):
    r, w, k, v, kk, bvec = inp
    sa = jnp.einsum('bhvk,bhk->bhv', state, -kk)
    state = state * w[:, :, None, :] + sa[..., None] * bvec[:, :, None, :] + v[..., None] * k[:, :, None, :]
    y = jnp.einsum('bhvk,bhk->bhv', state, r)
    return state, y


def wkv_scan(r, w, k, v, kk, bvec, state0, reverse):
    seqs = tuple(jnp.swapaxes(t, 0, 1) for t in (r, w, k, v, kk, bvec))
    state, y = lax.scan(_wkv_step, state0, seqs, reverse=reverse)
    return state, jnp.swapaxes(y, 0, 1)


def _rwkv_project(h, hs, mu, wr, wk, wv, w0, w1, w2, a0, a1, a2, g1, g2, k_k, k_a):
    b, t, d = h.shape
    hf = h.astype(jnp.float32)
    xx = hs.astype(jnp.float32) - hf
    xr, xw, xk, xv, xa, xg = [hf + xx * mu[j] for j in range(6)]
    split = lambda z: z.reshape(b, t, RWKV_HEADS, RWKV_HEAD)
    r = xr @ wr
    k = xk @ wk
    v = xv @ wv
    g = jax.nn.sigmoid(xg @ g1) @ g2
    kk = split(k * k_k)
    kk = kk * lax.rsqrt(jnp.sum(kk * kk, -1, keepdims=True) + 1e-12)
    dirs = []
    for dr in range(2):
        w_log = -jax.nn.softplus(-(w0[dr] + jnp.tanh(xw @ w1[dr]) @ w2[dr])) - 0.5
        decay = jnp.exp(-jnp.exp(w_log))
        a = jax.nn.sigmoid(a0[dr] + (xa @ a1[dr]) @ a2[dr])
        k_dir = k * (1 + (a - 1) * k_a)
        dirs.append((split(decay), split(k_dir), split(a)))
    return split(r), split(v), g, kk, dirs


def _rwkv_scans(p, init_f, init_b):
    r, v, g, kk, dirs = p
    (dec_f, k_f, a_f), (dec_b, k_b, a_b) = dirs
    s_f, y_f = wkv_scan(r, dec_f, k_f, v, kk, kk * a_f, init_f, False)
    s_b, y_b = wkv_scan(r, dec_b, k_b, v, kk, kk * a_b, init_b, True)
    return s_f, s_b, y_f + y_b


def _rwkv_readout(y, p, r_k, ln_w, ln_b, wo, out_dtype):
    r, v, g, kk, dirs = p
    b, t = y.shape[:2]
    mean = jnp.mean(y, -1, keepdims=True)
    var = jnp.mean(jnp.square(y - mean), -1, keepdims=True)
    yn = ((y - mean) * lax.rsqrt(var + GN_EPS)).reshape(b, t, D_MODEL) * ln_w + ln_b
    bonus = (jnp.sum(r * dirs[0][1] * r_k, -1, keepdims=True)
             + jnp.sum(r * dirs[1][1] * r_k, -1, keepdims=True)) * v
    out = (yn + bonus.reshape(b, t, D_MODEL)) * g
    return (out @ wo).astype(out_dtype)


def rwkv_mix(h_lat, h_ctx, rows, need_ctx, mu, wr, wk, wv, wo, w0, w1, w2, a0, a1, a2, g1, g2, k_k, k_a, r_k, ln_w, ln_b):
    pw = (mu, wr, wk, wv, w0, w1, w2, a0, a1, a2, g1, g2, k_k, k_a)
    zero = jnp.zeros((h_lat.shape[0], RWKV_HEADS, RWKV_HEAD, RWKV_HEAD), jnp.float32)
    p_ctx = _rwkv_project(h_ctx, seq_shift(h_ctx), *pw)
    s_f, s_b, y_ctx = _rwkv_scans(p_ctx, zero, zero)
    p_lat = _rwkv_project(h_lat, grid_shift(h_lat, rows), *pw)
    _, _, y_lat = _rwkv_scans(p_lat, s_f, s_b)
    o_lat = _rwkv_readout(y_lat, p_lat, r_k, ln_w, ln_b, wo, h_lat.dtype)
    o_ctx = _rwkv_readout(y_ctx, p_ctx, r_k, ln_w, ln_b, wo, h_ctx.dtype) if need_ctx else None
    return o_lat, o_ctx


def rope_2d_tables(n_tokens):
    t = jnp.arange(n_tokens)
    row = (t // GRID_W).astype(jnp.float32)
    col = (t % GRID_W).astype(jnp.float32)
    half = ATTN_HEAD // 2
    freqs = ROPE_THETA ** (-jnp.arange(0, half, 2, dtype=jnp.float32) / half)
    ang = jnp.stack([row[:, None] * freqs, col[:, None] * freqs], 0)
    return jnp.cos(ang), jnp.sin(ang)


def apply_rope_2d(x, cos, sin):
    half = ATTN_HEAD // 2
    quarter = half // 2
    outs = []
    for ax in range(2):
        xa = x[..., ax * half:(ax + 1) * half]
        x1, x2 = xa[..., :quarter], xa[..., quarter:]
        c = cos[ax][None, :, None, :]
        s = sin[ax][None, :, None, :]
        outs += [x1 * c - x2 * s, x2 * c + x1 * s]
    return jnp.concatenate(outs, -1)


def attn_mix(h_lat, h_ctx, cos, sin, need_ctx, wqkv, q_norm, k_norm, wo):
    nq = ATTN_HEADS * ATTN_HEAD
    nk = KV_HEADS * ATTN_HEAD
    scale = ATTN_HEAD ** -0.5

    def project(h):
        b, t, _ = h.shape
        qkv = h @ wqkv
        q = qkv[..., :nq].reshape(b, t, ATTN_HEADS, ATTN_HEAD)
        k = qkv[..., nq:nq + nk].reshape(b, t, KV_HEADS, ATTN_HEAD)
        v = qkv[..., nq + nk:].reshape(b, t, KV_HEADS, ATTN_HEAD)
        q = rms_norm(q, q_norm).astype(jnp.float32)
        k = rms_norm(k, k_norm).astype(jnp.float32)
        return q, k, v.astype(jnp.float32)

    ql, kl, vl = project(h_lat)
    ql = apply_rope_2d(ql, cos, sin)
    kl = apply_rope_2d(kl, cos, sin)
    qc, kc, vc = project(h_ctx)
    k_all = jnp.concatenate([kl, kc], 1)
    v_all = jnp.concatenate([vl, vc], 1)
    b, s = ql.shape[:2]
    nb = s // Q_BLOCK
    qb = ql.reshape(b, nb, Q_BLOCK, KV_HEADS, KV_GROUP, ATTN_HEAD).transpose(1, 0, 2, 3, 4, 5)

    def block(q):
        sc = jnp.einsum('bqkgd,bskd->bkgqs', q, k_all) * scale
        p = jax.nn.softmax(sc, -1)
        return jnp.einsum('bkgqs,bskd->bqkgd', p, v_all)

    o = lax.map(block, qb)
    o_lat = (o.transpose(1, 0, 2, 3, 4, 5).reshape(b, s, nq) @ wo).astype(h_lat.dtype)
    o_ctx = None
    if need_ctx:
        c_len = qc.shape[1]
        qg = qc.reshape(b, c_len, KV_HEADS, KV_GROUP, ATTN_HEAD)
        p = jax.nn.softmax(jnp.einsum('bqkgd,bskd->bkgqs', qg, kc) * scale, -1)
        oc = jnp.einsum('bkgqs,bskd->bqkgd', p, vc).reshape(b, c_len, nq)
        o_ctx = (oc @ wo).astype(h_ctx.dtype)
    return o_lat, o_ctx


def setup_inputs(seed: int = 0) -> dict:
    key = jax.random.key(seed)
    ks = iter(jax.random.split(key, 48))
    D = D_MODEL
    nrm = lambda shape, std: jax.random.normal(next(ks), shape, jnp.float32) * std
    uni = lambda shape, lo, hi: jax.random.uniform(next(ks), shape, jnp.float32, lo, hi)
    qkv_w = (ATTN_HEADS + 2 * KV_HEADS) * ATTN_HEAD
    return {
        "x": nrm((BATCH, SEQ, D), 1.0),
        "c": nrm((BATCH, D), 1.0),
        "ctx": nrm((BATCH, CTX_LEN, D), 1.0),
        "c_ctx": nrm((D,), 1.0),
        "w_mod": nrm((DEPTH, D, 6 * D), 0.5 * D ** -0.5),
        "b_mod": nrm((DEPTH, 6 * D), 0.01),
        "norm_mix": 1.0 + nrm((DEPTH, D), 0.05),
        "norm_mlp": 1.0 + nrm((DEPTH, D), 0.05),
        "mlp_w1": nrm((DEPTH, D, D_FF), D ** -0.5),
        "mlp_w2": nrm((DEPTH, D_FF, D), D_FF ** -0.5),
        "rwkv_mu": uni((N_RWKV, 6, D), 0.0, 1.0),
        "rwkv_wr": nrm((N_RWKV, D, D), D ** -0.5),
        "rwkv_wk": nrm((N_RWKV, D, D), D ** -0.5),
        "rwkv_wv": nrm((N_RWKV, D, D), D ** -0.5),
        "rwkv_wo": nrm((N_RWKV, D, D), D ** -0.5),
        "rwkv_w0": uni((N_RWKV, 2, D), -4.0, 1.0),
        "rwkv_w1": nrm((N_RWKV, 2, D, DECAY_LORA), D ** -0.5),
        "rwkv_w2": nrm((N_RWKV, 2, DECAY_LORA, D), 0.5 * DECAY_LORA ** -0.5),
        "rwkv_a0": nrm((N_RWKV, 2, D), 0.1),
        "rwkv_a1": nrm((N_RWKV, 2, D, AAA_LORA), D ** -0.5),
        "rwkv_a2": nrm((N_RWKV, 2, AAA_LORA, D), 0.5 * AAA_LORA ** -0.5),
        "rwkv_g1": nrm((N_RWKV, D, GATE_LORA), D ** -0.5),
        "rwkv_g2": nrm((N_RWKV, GATE_LORA, D), GATE_LORA ** -0.5),
        "rwkv_k_k": 0.85 + nrm((N_RWKV, D), 0.05),
        "rwkv_k_a": 1.0 + nrm((N_RWKV, D), 0.05),
        "rwkv_r_k": nrm((N_RWKV, RWKV_HEADS, RWKV_HEAD), 0.1),
        "rwkv_ln_w": 1.0 + nrm((N_RWKV, D), 0.05),
        "rwkv_ln_b": nrm((N_RWKV, D), 0.01),
        "attn_wqkv": nrm((N_ATTN, D, qkv_w), D ** -0.5),
        "attn_q_norm": 1.0 + nrm((N_ATTN, ATTN_HEAD), 0.05),
        "attn_k_norm": 1.0 + nrm((N_ATTN, ATTN_HEAD), 0.05),
        "attn_wo": nrm((N_ATTN, ATTN_HEADS * ATTN_HEAD, D), (ATTN_HEADS * ATTN_HEAD) ** -0.5),
        "final_norm": 1.0 + nrm((D,), 0.05),
    }


def reference(x, c, ctx, c_ctx, w_mod, b_mod, norm_mix, norm_mlp, mlp_w1, mlp_w2,
              rwkv_mu, rwkv_wr, rwkv_wk, rwkv_wv, rwkv_wo, rwkv_w0, rwkv_w1, rwkv_w2,
              rwkv_a0, rwkv_a1, rwkv_a2, rwkv_g1, rwkv_g2, rwkv_k_k, rwkv_k_a, rwkv_r_k,
              rwkv_ln_w, rwkv_ln_b, attn_wqkv, attn_q_norm, attn_k_norm, attn_wo, final_norm):
    s = x.shape[1]
    rows = s // GRID_W
    cos, sin = rope_2d_tables(s)
    sc = jax.nn.silu(c)
    scc = jax.nn.silu(c_ctx)
    xl, xc = x, ctx
    for i in range(DEPTH):
        j = i // N_MIXERS
        need_ctx = i < DEPTH - 1
        m_l = jnp.split(sc @ w_mod[i] + b_mod[i], 6, -1)
        m_c = jnp.split(scc @ w_mod[i] + b_mod[i], 6, -1)
        h_l = modulate(rms_norm(xl, norm_mix[i]), m_l[0][:, None], m_l[1][:, None])
        h_c = modulate(rms_norm(xc, norm_mix[i]), m_c[0], m_c[1])
        if i % N_MIXERS == 0:
            o_l, o_c = rwkv_mix(h_l, h_c, rows, need_ctx, rwkv_mu[j], rwkv_wr[j], rwkv_wk[j], rwkv_wv[j], rwkv_wo[j],
                                rwkv_w0[j], rwkv_w1[j], rwkv_w2[j], rwkv_a0[j], rwkv_a1[j], rwkv_a2[j],
                                rwkv_g1[j], rwkv_g2[j], rwkv_k_k[j], rwkv_k_a[j], rwkv_r_k[j],
                                rwkv_ln_w[j], rwkv_ln_b[j])
        else:
            o_l, o_c = attn_mix(h_l, h_c, cos, sin, need_ctx, attn_wqkv[j], attn_q_norm[j],
                                attn_k_norm[j], attn_wo[j])
        xl = xl + m_l[2][:, None] * o_l
        h_l = modulate(rms_norm(xl, norm_mlp[i]), m_l[3][:, None], m_l[4][:, None])
        xl = xl + m_l[5][:, None] * sqrelu_mlp(h_l, mlp_w1[i], mlp_w2[i])
        if need_ctx:
            xc = xc + m_c[2] * o_c
            h_c = modulate(rms_norm(xc, norm_mlp[i]), m_c[3], m_c[4])
            xc = xc + m_c[5] * sqrelu_mlp(h_c, mlp_w1[i], mlp_w2[i])
    return rms_norm(xl, final_norm).astype(x.dtype)
```

```cpp
#include <hip/hip_runtime.h>
#include <hip/hip_cooperative_groups.h>
#include <cstdint>
#include <cstring>
#include <cstdio>
namespace cg = cooperative_groups;

#ifndef SINGLE_LAUNCH
#define SINGLE_LAUNCH 1
#endif

typedef unsigned short bf16_t;
typedef short bf16x8 __attribute__((ext_vector_type(8)));
typedef float f32x2 __attribute__((ext_vector_type(2)));
typedef float f32x4 __attribute__((ext_vector_type(4)));
typedef float f32x16 __attribute__((ext_vector_type(16)));
typedef __bf16 bf16x2_t __attribute__((ext_vector_type(2)));
#define DI __device__ __forceinline__

constexpr int D = 1024, NB = 8, SEQ = 4096, CTXL = 256;
constexpr int NL = NB * SEQ, NC = NB * CTXL, NT = NL + NC, DFF = 4096;
constexpr int NKEY = SEQ + CTXL;
constexpr int NTHREADS = 512;
constexpr int ROWB = 144;
constexpr int GEMM_STAGE = (256 + 128) * ROWB;
constexpr int LDS_BYTES = 114688;

struct TJob { const float* src; bf16_t* dst; int K, N, tstart, tiles_n; };

struct Params {
  const float *x, *c, *ctx, *c_ctx, *w_mod, *b_mod, *norm_mix, *norm_mlp, *mlp_w1, *mlp_w2;
  const float *mu, *wr, *wk, *wv, *wo, *w0, *w1, *w2, *a0, *a1, *a2, *g1, *g2, *k_k, *k_a, *r_k, *ln_w, *ln_b;
  const float *wqkv, *q_norm, *k_norm, *awo, *final_norm;
  float* out;
  bf16_t *Wcat, *L2w, *g2T, *woT, *w1T[2], *w2T[2], *wqkvT, *awoT;
  float *MOD, *TAB, *XC;
  bf16_t* S[6];
  bf16_t *Hd, *L1;
  float* BON;
  TJob jobs[20];
  int njobs, total_tiles;
};

DI unsigned pack2(float lo, float hi) {
  f32x2 v = {lo, hi};
  bf16x2_t b = __builtin_convertvector(v, bf16x2_t);
  return __builtin_bit_cast(unsigned, b);
}
DI float bflo(unsigned u) { return __uint_as_float(u << 16); }
DI float bfhi(unsigned u) { return __uint_as_float(u & 0xffff0000u); }
DI void store_bf4(bf16_t* p, float a, float b, float c, float d) { *(uint2*)p = make_uint2(pack2(a, b), pack2(c, d)); }
DI void load_bf4(const bf16_t* p, float& a, float& b, float& c, float& d) { uint2 u = *(const uint2*)p; a = bflo(u.x); b = bfhi(u.x); c = bflo(u.y); d = bfhi(u.y); }
DI float sigmoidf_(float x) { return 1.f / (1.f + __expf(-x)); }
DI float tanhf_(float x) { return 1.f - 2.f / (1.f + __expf(2.f * x)); }
DI float quad_sum(float x) {
  x += __builtin_bit_cast(float, __builtin_amdgcn_mov_dpp(__builtin_bit_cast(int, x), 0xB1, 0xF, 0xF, true));
  x += __builtin_bit_cast(float, __builtin_amdgcn_mov_dpp(__builtin_bit_cast(int, x), 0x4E, 0xF, 0xF, true));
  return x;
}
DI float wave_sum(float x) {
#pragma unroll
  for (int m = 1; m < 64; m <<= 1) x += __shfl_xor(x, m);
  return x;
}
#define MFMA16(a, b, c) __builtin_amdgcn_mfma_f32_16x16x32_bf16((a), (b), (c), 0, 0, 0)
#define MFMA32(a, b, c) __builtin_amdgcn_mfma_f32_32x32x16_bf16((a), (b), (c), 0, 0, 0)

DI unsigned lerp2(unsigned a, unsigned n, float ma, float mb) {
  const float h0 = bflo(a), h1 = bfhi(a), s0 = bflo(n), s1 = bfhi(n);
  return pack2(h0 + (s0 - h0) * ma, h1 + (s1 - h1) * mb);
}
template <bool LERP>
DI void gemm_tile(const bf16_t* __restrict__ X, int ldx, const bf16_t* __restrict__ W, int ldw, int K, int tok0, int f0,
                  char* lds, f32x4 (&acc)[4][4], const float* __restrict__ mu) {
  const int tid = threadIdx.x, lane = tid & 63, wave = tid >> 6;
  const int wt = wave & 3, wf = wave >> 2, lr = lane & 15, lq = lane >> 4;
  const int lrow = tid >> 3, kc = tid & 7;
#pragma unroll
  for (int i = 0; i < 4; ++i)
#pragma unroll
    for (int j = 0; j < 4; ++j) acc[i][j] = f32x4{0.f, 0.f, 0.f, 0.f};
  uint4 xr[4], wr[2], xn[4];
  float4 m0 = make_float4(0, 0, 0, 0), m1 = m0;
  const int nk = K >> 6;
  __syncthreads();
  for (int kt = -1; kt < nk; ++kt) {
    const bool more = kt + 1 < nk;
    if (more) {
      const int k0 = (kt + 1) << 6;
#pragma unroll
      for (int i = 0; i < 4; ++i) {
        const int tg = tok0 + lrow + 64 * i;
        xr[i] = *(const uint4*)(X + (size_t)tg * ldx + k0 + kc * 8);
        if (LERP) {
          int nb; bool valid;
          if (tok0 < NL) {
            const int s = tg & 4095, col = s & 63, rw = s >> 6, qd = k0 >> 8;
            if (qd == 0) { valid = col > 0; nb = tg - 1; }
            else if (qd == 1) { valid = col < 63; nb = tg + 1; }
            else if (qd == 2) { valid = rw > 0; nb = tg - 64; }
            else { valid = rw < 63; nb = tg + 64; }
          } else {
            const int s = (tg - NL) & 255;
            if (k0 < 512) { valid = s > 0; nb = tg - 1; }
            else { valid = s < 255; nb = tg + 1; }
          }
          if (valid) xn[i] = *(const uint4*)(X + (size_t)nb * ldx + k0 + kc * 8);
          else xn[i] = make_uint4(0, 0, 0, 0);
        }
      }
#pragma unroll
      for (int i = 0; i < 2; ++i) wr[i] = *(const uint4*)(W + (size_t)(f0 + lrow + 64 * i) * ldw + k0 + kc * 8);
      if (LERP) { m0 = *(const float4*)(mu + k0 + kc * 8); m1 = *(const float4*)(mu + k0 + kc * 8 + 4); }
    }
    if (kt >= 0) {
      const char* xs = lds + (kt & 1) * GEMM_STAGE;
      const char* wsm = xs + 256 * ROWB;
#pragma unroll
      for (int ks = 0; ks < 2; ++ks) {
        bf16x8 wfr[4], xfr[4];
#pragma unroll
        for (int i = 0; i < 4; ++i) wfr[i] = *(const bf16x8*)(wsm + (wf * 64 + i * 16 + lr) * ROWB + ks * 64 + lq * 16);
#pragma unroll
        for (int i = 0; i < 4; ++i) xfr[i] = *(const bf16x8*)(xs + (wt * 64 + i * 16 + lr) * ROWB + ks * 64 + lq * 16);
#pragma unroll
        for (int fi = 0; fi < 4; ++fi)
#pragma unroll
          for (int ti = 0; ti < 4; ++ti) acc[fi][ti] = MFMA16(wfr[fi], xfr[ti], acc[fi][ti]);
      }
    }
    if (more) {
      char* xs = lds + ((kt + 1) & 1) * GEMM_STAGE;
      char* wsm = xs + 256 * ROWB;
#pragma unroll
      for (int i = 0; i < 4; ++i) {
        uint4 v = xr[i];
        if (LERP) {
          v.x = lerp2(xr[i].x, xn[i].x, m0.x, m0.y);
          v.y = lerp2(xr[i].y, xn[i].y, m0.z, m0.w);
          v.z = lerp2(xr[i].z, xn[i].z, m1.x, m1.y);
          v.w = lerp2(xr[i].w, xn[i].w, m1.z, m1.w);
        }
        *(uint4*)(xs + (lrow + 64 * i) * ROWB + kc * 16) = v;
      }
#pragma unroll
      for (int i = 0; i < 2; ++i) *(uint4*)(wsm + (lrow + 64 * i) * ROWB + kc * 16) = wr[i];
    }
    __syncthreads();
  }
}

DI void convert_tile(const TJob& jb, int t, char* lds) {
  float* tile = (float*)lds;
  const int tid = threadIdx.x;
  const int tk = t / jb.tiles_n, tn = t % jb.tiles_n;
  const int k0 = tk * 64, n0 = tn * 64;
  __syncthreads();
#pragma unroll
  for (int i = 0; i < 2; ++i) {
    const int idx = tid + 512 * i, row = idx >> 4, c4 = idx & 15;
    const float4 v = *(const float4*)(jb.src + (size_t)(k0 + row) * jb.N + n0 + c4 * 4);
    tile[row * 65 + c4 * 4 + 0] = v.x; tile[row * 65 + c4 * 4 + 1] = v.y; tile[row * 65 + c4 * 4 + 2] = v.z; tile[row * 65 + c4 * 4 + 3] = v.w;
  }
  __syncthreads();
  const int n = tid >> 3, kc = tid & 7;
  float v[8];
#pragma unroll
  for (int j = 0; j < 8; ++j) v[j] = tile[(kc * 8 + j) * 65 + n];
  uint4 o;
  o.x = pack2(v[0], v[1]); o.y = pack2(v[2], v[3]); o.z = pack2(v[4], v[5]); o.w = pack2(v[6], v[7]);
  *(uint4*)(jb.dst + (size_t)(n0 + n) * jb.K + k0 + kc * 8) = o;
}

DI void mod_unit(const Params& p, int mu_, char* lds) {
  const int tid = threadIdx.x;
  const int layer = mu_ / 96, cc = mu_ % 96;
  float* sc = (float*)lds;
  float* red = sc + 9 * 1024;
  __syncthreads();
  for (int i = tid; i < 9 * 1024; i += 512) {
    const int row = i >> 10, k = i & 1023;
    const float v = row < 8 ? p.c[row * 1024 + k] : p.c_ctx[k];
    sc[i] = v / (1.f + __expf(-v));
  }
  __syncthreads();
  const int kg = tid >> 6, col = tid & 63;
  const float* w = p.w_mod + (size_t)layer * 1024 * 6144 + cc * 64 + col;
  float a[9];
#pragma unroll
  for (int r = 0; r < 9; ++r) a[r] = 0.f;
#pragma unroll 4
  for (int k = kg * 128; k < kg * 128 + 128; ++k) {
    const float wv = w[(size_t)k * 6144];
#pragma unroll
    for (int r = 0; r < 9; ++r) a[r] += sc[r * 1024 + k] * wv;
  }
#pragma unroll
  for (int r = 0; r < 9; ++r) red[(kg * 9 + r) * 64 + col] = a[r];
  __syncthreads();
  for (int i = tid; i < 576; i += 512) {
    const int r = i >> 6, cl = i & 63;
    float s = 0.f;
#pragma unroll
    for (int g = 0; g < 8; ++g) s += red[(g * 9 + r) * 64 + cl];
    const int n = cc * 64 + cl;
    p.MOD[(layer * 9 + r) * 6144 + n] = s + p.b_mod[layer * 6144 + n];
  }
  __syncthreads();
}

DI void sincos_d(double a, double& s, double& c) {
  const double n = rint(a * 0.6366197723675814);
  const double r = (a - n * 1.5707963267948966) - n * 6.123233995736766e-17;
  const double r2 = r * r;
  const double sp = r * (1.0 + r2 * (-1.0 / 6.0 + r2 * (1.0 / 120.0 + r2 * (-1.0 / 5040.0 + r2 * (1.0 / 362880.0 + r2 * (-1.0 / 39916800.0 + r2 * (1.0 / 6227020800.0)))))));
  const double cp = 1.0 + r2 * (-0.5 + r2 * (1.0 / 24.0 + r2 * (-1.0 / 720.0 + r2 * (1.0 / 40320.0 + r2 * (-1.0 / 3628800.0 + r2 * (1.0 / 479001600.0 + r2 * (-1.0 / 87178291200.0)))))));
  const int q = ((int)n) & 3;
  if (q == 0) { s = sp; c = cp; }
  else if (q == 1) { s = cp; c = -sp; }
  else if (q == 2) { s = -sp; c = -cp; }
  else { s = -cp; c = sp; }
}

DI void tab_unit(const Params& p) {
  for (int idx = threadIdx.x; idx < 1024; idx += 512) {
    const int pos = idx >> 4, fi = idx & 15;
    double f = 1.0;
    for (int i = 0; i < fi; ++i) f *= 0.5623413251903491;
    double s, c;
    sincos_d((double)pos * (double)(float)f, s, c);
    p.TAB[idx * 2 + 0] = (float)c;
    p.TAB[idx * 2 + 1] = (float)s;
  }
}

__device__ void phase0(const Params& p, char* lds) {
  const int total = p.total_tiles + 192 + 1;
  for (int u = blockIdx.x; u < total; u += gridDim.x) {
    if (u < p.total_tiles) {
      int j = 0;
#pragma unroll 1
      for (int q = 1; q < p.njobs; ++q) if (u >= p.jobs[q].tstart) j = q;
      convert_tile(p.jobs[j], u - p.jobs[j].tstart, lds);
    } else if (u < p.total_tiles + 192) {
      mod_unit(p, u - p.total_tiles, lds);
    } else {
      tab_unit(p);
    }
  }
}

__device__ void norm_mod_phase(const float* __restrict__ xl, const float* __restrict__ xc, const float* __restrict__ gain,
                               const float* __restrict__ mod, int shift_i, int scale_i, bf16_t* __restrict__ H, int ntok) {
  const int lane = threadIdx.x & 63;
  const int wg = blockIdx.x * 8 + (threadIdx.x >> 6), nw = gridDim.x * 8;
  for (int t = wg; t < ntok; t += nw) {
    const float* row = t < NL ? xl + (size_t)t * 1024 : xc + (size_t)(t - NL) * 1024;
    float4 v[4];
    float ss = 0.f;
#pragma unroll
    for (int i = 0; i < 4; ++i) {
      v[i] = *(const float4*)(row + (lane + 64 * i) * 4);
      ss += v[i].x * v[i].x + v[i].y * v[i].y + v[i].z * v[i].z + v[i].w * v[i].w;
    }
    ss = wave_sum(ss);
    const float rstd = rsqrtf(ss * (1.f / 1024.f) + 1e-6f);
    const int bp = t < NL ? (t >> 12) : 8;
    const float* sh = mod + (bp * 6 + shift_i) * 1024;
    const float* sc = mod + (bp * 6 + scale_i) * 1024;
#pragma unroll
    for (int i = 0; i < 4; ++i) {
      const int c = (lane + 64 * i) * 4;
      const float4 g = *(const float4*)(gain + c), s4 = *(const float4*)(sh + c), c4 = *(const float4*)(sc + c);
      store_bf4(H + (size_t)t * 1024 + c,
                v[i].x * rstd * g.x * (1.f + c4.x) + s4.x, v[i].y * rstd * g.y * (1.f + c4.y) + s4.y,
                v[i].z * rstd * g.z * (1.f + c4.z) + s4.z, v[i].w * rstd * g.w * (1.f + c4.w) + s4.w);
    }
  }
}

__device__ void final_norm_phase(const Params& p) {
  const int lane = threadIdx.x & 63;
  const int wg = blockIdx.x * 8 + (threadIdx.x >> 6), nw = gridDim.x * 8;
  for (int t = wg; t < NL; t += nw) {
    float* row = p.out + (size_t)t * 1024;
    float4 v[4];
    float ss = 0.f;
#pragma unroll
    for (int i = 0; i < 4; ++i) {
      v[i] = *(const float4*)(row + (lane + 64 * i) * 4);
      ss += v[i].x * v[i].x + v[i].y * v[i].y + v[i].z * v[i].z + v[i].w * v[i].w;
    }
    ss = wave_sum(ss);
    const float rstd = rsqrtf(ss * (1.f / 1024.f) + 1e-6f);
#pragma unroll
    for (int i = 0; i < 4; ++i) {
      const int c = (lane + 64 * i) * 4;
      const float4 g = *(const float4*)(p.final_norm + c);
      *(float4*)(row + c) = make_float4(v[i].x * rstd * g.x, v[i].y * rstd * g.y, v[i].z * rstd * g.z, v[i].w * rstd * g.w);
    }
  }
}

__device__ void phase_proj(const Params& p, char* lds) {
  const int lane = threadIdx.x & 63, wave = threadIdx.x >> 6;
  const int wt = wave & 3, wf = wave >> 2, lr = lane & 15, lq = lane >> 4;
  const int ntn = 27, total = (NT / 256) * ntn;
  for (int u = blockIdx.x; u < total; u += gridDim.x) {
    const int mt = u / ntn, nt = u % ntn;
    const int mi = nt < 8 ? 0 : nt < 16 ? 2 : nt < 24 ? 3 : nt == 24 ? 5 : nt == 25 ? 1 : 4;
    f32x4 acc[4][4];
    gemm_tile<true>(p.Hd, 1024, p.Wcat, 1024, 1024, mt * 256, nt * 128, lds, acc, p.mu + mi * 1024);
#pragma unroll
    for (int fi = 0; fi < 4; ++fi)
#pragma unroll
      for (int ti = 0; ti < 4; ++ti) {
        const int t = mt * 256 + wt * 64 + ti * 16 + lr;
        const int fl = wf * 64 + fi * 16 + lq * 4;
        const f32x4 a = acc[fi][ti];
        if (nt < 24) {
          bf16_t* dst = nt < 8 ? p.S[0] : nt < 16 ? p.S[2] : p.S[1];
          store_bf4(dst + (size_t)t * 1024 + (nt & 7) * 128 + fl, a[0], a[1], a[2], a[3]);
        } else if (nt == 24) {
          store_bf4(p.L1 + (size_t)t * 384 + fl, sigmoidf_(a[0]), sigmoidf_(a[1]), sigmoidf_(a[2]), sigmoidf_(a[3]));
        } else if (nt == 25) {
          store_bf4(p.L1 + (size_t)t * 384 + 128 + fl, tanhf_(a[0]), tanhf_(a[1]), tanhf_(a[2]), tanhf_(a[3]));
        } else {
          store_bf4(p.L1 + (size_t)t * 384 + 256 + fl, a[0], a[1], a[2], a[3]);
        }
      }
  }
}

__device__ void phase_prep(const Params& p, char* lds) {
  const int lane = threadIdx.x & 63, wave = threadIdx.x >> 6;
  const int wt = wave & 3, wf = wave >> 2, lr = lane & 15, lq = lane >> 4;
  const int total = (NT / 256) * 8;
  for (int u = blockIdx.x; u < total; u += gridDim.x) {
    const int mt = u >> 3, nt = u & 7;
    const int tok0 = mt * 256, f0 = nt * 128;
    f32x4 af[4][4], acc[4][4];
    gemm_tile<false>(p.L1 + 256, 384, p.L2w + 0 * 65536, 64, 64, tok0, f0, lds, af, nullptr);
#pragma unroll
    for (int fi = 0; fi < 4; ++fi) {
      const int f = f0 + wf * 64 + fi * 16 + lq * 4;
      const float4 a0 = *(const float4*)(p.a0 + f);
#pragma unroll
      for (int ti = 0; ti < 4; ++ti) {
        const int t = tok0 + wt * 64 + ti * 16 + lr;
        f32x4 a = af[fi][ti];
        a[0] = sigmoidf_(a[0] + a0.x); a[1] = sigmoidf_(a[1] + a0.y); a[2] = sigmoidf_(a[2] + a0.z); a[3] = sigmoidf_(a[3] + a0.w);
        af[fi][ti] = a;
        store_bf4(p.S[3] + (size_t)t * 1024 + f, a[0], a[1], a[2], a[3]);
      }
    }
    gemm_tile<false>(p.L1 + 320, 384, p.L2w + 1 * 65536, 64, 64, tok0, f0, lds, acc, nullptr);
    float bon[4] = {0.f, 0.f, 0.f, 0.f};
#pragma unroll
    for (int fi = 0; fi < 4; ++fi) {
      const int f = f0 + wf * 64 + fi * 16 + lq * 4;
      const float4 a0 = *(const float4*)(p.a0 + 1024 + f);
      const float4 rk4 = *(const float4*)(p.r_k + f);
      const float4 ka4 = *(const float4*)(p.k_a + f);
#pragma unroll
      for (int ti = 0; ti < 4; ++ti) {
        const int t = tok0 + wt * 64 + ti * 16 + lr;
        f32x4 a = acc[fi][ti];
        a[0] = sigmoidf_(a[0] + a0.x); a[1] = sigmoidf_(a[1] + a0.y); a[2] = sigmoidf_(a[2] + a0.z); a[3] = sigmoidf_(a[3] + a0.w);
        store_bf4(p.S[4] + (size_t)t * 1024 + f, a[0], a[1], a[2], a[3]);
        float r0, r1, r2, r3, k0, k1, k2, k3;
        load_bf4(p.S[0] + (size_t)t * 1024 + f, r0, r1, r2, r3);
        load_bf4(p.S[2] + (size_t)t * 1024 + f, k0, k1, k2, k3);
        const f32x4 b = af[fi][ti];
        bon[ti] += r0 * k0 * rk4.x * (2.f + (a[0] + b[0] - 2.f) * ka4.x) + r1 * k1 * rk4.y * (2.f + (a[1] + b[1] - 2.f) * ka4.y)
                 + r2 * k2 * rk4.z * (2.f + (a[2] + b[2] - 2.f) * ka4.z) + r3 * k3 * rk4.w * (2.f + (a[3] + b[3] - 2.f) * ka4.w);
      }
    }
#pragma unroll
    for (int ti = 0; ti < 4; ++ti) {
      float s = bon[ti];
      s += __shfl_xor(s, 16);
      s += __shfl_xor(s, 32);
      if (lq == 0) p.BON[(size_t)(tok0 + wt * 64 + ti * 16 + lr) * 16 + (nt * 2 + wf)] = s;
    }
#pragma unroll 1
    for (int dr = 0; dr < 2; ++dr) {
      gemm_tile<false>(p.L1 + 128 + dr * 64, 384, p.L2w + (2 + dr) * 65536, 64, 64, tok0, f0, lds, acc, nullptr);
      bf16_t* dst = dr ? p.S[5] : p.Hd;
#pragma unroll
      for (int fi = 0; fi < 4; ++fi) {
        const int f = f0 + wf * 64 + fi * 16 + lq * 4;
        const float4 w0 = *(const float4*)(p.w0 + dr * 1024 + f);
#pragma unroll
        for (int ti = 0; ti < 4; ++ti) {
          const int t = tok0 + wt * 64 + ti * 16 + lr;
          const f32x4 a = acc[fi][ti];
          store_bf4(dst + (size_t)t * 1024 + f, -0.60653066f * sigmoidf_(a[0] + w0.x), -0.60653066f * sigmoidf_(a[1] + w0.y),
                    -0.60653066f * sigmoidf_(a[2] + w0.z), -0.60653066f * sigmoidf_(a[3] + w0.w));
        }
      }
    }
  }
}

__device__ void phase_scan(const Params& p, char* lds) {
  float* buf = (float*)lds;
  float* ybuf = (float*)(lds + 2 * 49152);
  const int tid = threadIdx.x;
  const bool loader = tid >= 256;
  const int lt = tid & 255, ltk = lt >> 3, lch = (lt & 7) * 8;
  const int vrow = lt >> 2, q = lt & 3;
  constexpr int NCH = NKEY / 32;
  for (int unit = blockIdx.x; unit < 256; unit += gridDim.x) {
    const int dir = unit & 1, h = (unit >> 1) & 15, b = unit >> 5;
    const bf16_t* Rp = p.S[0]; const bf16_t* Vp = p.S[1]; const bf16_t* Kp = p.S[2];
    bf16_t* Ap = dir ? p.S[4] : p.S[3];
    const bf16_t* Lp = dir ? p.S[5] : p.Hd;
    auto tok_of = [&](int i) -> int {
      if (i < 256) return NL + b * 256 + (dir ? 255 - i : i);
      const int s = i - 256;
      return b * 4096 + (dir ? 4095 - s : s);
    };
    uint4 raw[5];
    float kkc[8], kac[8];
    float S[16];
#pragma unroll
    for (int i = 0; i < 16; ++i) S[i] = 0.f;
    if (loader) {
#pragma unroll
      for (int j = 0; j < 8; ++j) { kkc[j] = p.k_k[h * 64 + lch + j]; kac[j] = p.k_a[h * 64 + lch + j]; }
    }
    auto issue = [&](int c) {
      const int t = tok_of(c * 32 + ltk);
      const size_t off = (size_t)t * 1024 + h * 64 + lch;
      raw[0] = *(const uint4*)(Rp + off); raw[1] = *(const uint4*)(Vp + off); raw[2] = *(const uint4*)(Kp + off);
      raw[3] = *(const uint4*)(Ap + off); raw[4] = *(const uint4*)(Lp + off);
    };
    auto unpack8 = [&](const uint4& u, float (&o)[8]) {
      o[0] = bflo(u.x); o[1] = bfhi(u.x); o[2] = bflo(u.y); o[3] = bfhi(u.y); o[4] = bflo(u.z); o[5] = bfhi(u.z); o[6] = bflo(u.w); o[7] = bfhi(u.w);
    };
    auto process = [&](int stage) {
      float r8[8], v8[8], k8[8], a8[8], l8[8], kk8[8], kd8[8], b8[8], w8[8];
      unpack8(raw[0], r8); unpack8(raw[1], v8); unpack8(raw[2], k8); unpack8(raw[3], a8); unpack8(raw[4], l8);
      float ss = 0.f;
#pragma unroll
      for (int j = 0; j < 8; ++j) { kk8[j] = k8[j] * kkc[j]; ss += kk8[j] * kk8[j]; }
      ss += __shfl_xor(ss, 1); ss += __shfl_xor(ss, 2); ss += __shfl_xor(ss, 4);
      const float inv = rsqrtf(ss + 1e-12f);
#pragma unroll
      for (int j = 0; j < 8; ++j) {
        kk8[j] *= inv;
        kd8[j] = k8[j] * (1.f + (a8[j] - 1.f) * kac[j]);
        b8[j] = kk8[j] * a8[j];
        w8[j] = __expf(l8[j]);
      }
      float* dst = buf + stage * 12288 + ltk * 384 + lch;
      *(float4*)(dst + 0) = make_float4(r8[0], r8[1], r8[2], r8[3]);       *(float4*)(dst + 4) = make_float4(r8[4], r8[5], r8[6], r8[7]);
      *(float4*)(dst + 64) = make_float4(w8[0], w8[1], w8[2], w8[3]);      *(float4*)(dst + 68) = make_float4(w8[4], w8[5], w8[6], w8[7]);
      *(float4*)(dst + 128) = make_float4(kd8[0], kd8[1], kd8[2], kd8[3]); *(float4*)(dst + 132) = make_float4(kd8[4], kd8[5], kd8[6], kd8[7]);
      *(float4*)(dst + 192) = make_float4(kk8[0], kk8[1], kk8[2], kk8[3]); *(float4*)(dst + 196) = make_float4(kk8[4], kk8[5], kk8[6], kk8[7]);
      *(float4*)(dst + 256) = make_float4(b8[0], b8[1], b8[2], b8[3]);     *(float4*)(dst + 260) = make_float4(b8[4], b8[5], b8[6], b8[7]);
      *(float4*)(dst + 320) = make_float4(v8[0], v8[1], v8[2], v8[3]);     *(float4*)(dst + 324) = make_float4(v8[4], v8[5], v8[6], v8[7]);
    };
    auto yout = [&](int c) {
      const float* yb = ybuf + (c & 1) * 2048 + ltk * 64 + lch;
      const float4 y0 = *(const float4*)yb, y1 = *(const float4*)(yb + 4);
      const int t = tok_of(c * 32 + ltk);
      uint4 o;
      o.x = pack2(y0.x, y0.y); o.y = pack2(y0.z, y0.w); o.z = pack2(y1.x, y1.y); o.w = pack2(y1.z, y1.w);
      *(uint4*)(Ap + (size_t)t * 1024 + h * 64 + lch) = o;
    };
    __syncthreads();
    if (loader) { issue(0); process(0); issue(1); }
    __syncthreads();
    for (int c = 0; c < NCH; ++c) {
      if (loader) {
        if (c >= 1) yout(c - 1);
        if (c + 1 < NCH) { process((c + 1) & 1); if (c + 2 < NCH) issue(c + 2); }
      } else {
        const float* bb = buf + (c & 1) * 12288 + q * 16;
        float* yb = ybuf + (c & 1) * 2048 + vrow;
#pragma unroll 2
        for (int j = 0; j < 32; ++j) {
          const float* base = bb + j * 384;
          float rr[16], ww[16], kv[16], kkv[16], bv[16];
#pragma unroll
          for (int i = 0; i < 4; ++i) {
            const float4 t0 = *(const float4*)(base + i * 4);       rr[4 * i] = t0.x; rr[4 * i + 1] = t0.y; rr[4 * i + 2] = t0.z; rr[4 * i + 3] = t0.w;
            const float4 t1 = *(const float4*)(base + 64 + i * 4);  ww[4 * i] = t1.x; ww[4 * i + 1] = t1.y; ww[4 * i + 2] = t1.z; ww[4 * i + 3] = t1.w;
            const float4 t2 = *(const float4*)(base + 128 + i * 4); kv[4 * i] = t2.x; kv[4 * i + 1] = t2.y; kv[4 * i + 2] = t2.z; kv[4 * i + 3] = t2.w;
            const float4 t3 = *(const float4*)(base + 192 + i * 4); kkv[4 * i] = t3.x; kkv[4 * i + 1] = t3.y; kkv[4 * i + 2] = t3.z; kkv[4 * i + 3] = t3.w;
            const float4 t4 = *(const float4*)(base + 256 + i * 4); bv[4 * i] = t4.x; bv[4 * i + 1] = t4.y; bv[4 * i + 2] = t4.z; bv[4 * i + 3] = t4.w;
          }
          const float vv = buf[(c & 1) * 12288 + j * 384 + 320 + vrow];
          float s0 = 0.f, s1 = 0.f, s2 = 0.f, s3 = 0.f;
#pragma unroll
          for (int i = 0; i < 4; ++i) { s0 += S[i] * kkv[i]; s1 += S[4 + i] * kkv[4 + i]; s2 += S[8 + i] * kkv[8 + i]; s3 += S[12 + i] * kkv[12 + i]; }
          const float sa = -quad_sum((s0 + s1) + (s2 + s3));
          float y0 = 0.f, y1 = 0.f, y2 = 0.f, y3 = 0.f;
#pragma unroll
          for (int i = 0; i < 16; ++i) S[i] = S[i] * ww[i] + (sa * bv[i] + vv * kv[i]);
#pragma unroll
          for (int i = 0; i < 4; ++i) { y0 += S[i] * rr[i]; y1 += S[4 + i] * rr[4 + i]; y2 += S[8 + i] * rr[8 + i]; y3 += S[12 + i] * rr[12 + i]; }
          const float y = quad_sum((y0 + y1) + (y2 + y3));
          if (q == 0) yb[j * 64] = y;
        }
      }
      __syncthreads();
    }
    if (loader) yout(NCH - 1);
    __syncthreads();
  }
}

__device__ void phase_readout(const Params& p, char* lds) {
  const int lane = threadIdx.x & 63, wave = threadIdx.x >> 6;
  const int wt = wave & 3, wf = wave >> 2, lr = lane & 15, lq = lane >> 4;
  const int total = (NT / 256) * 8;
  for (int u = blockIdx.x; u < total; u += gridDim.x) {
    const int mt = u >> 3, nt = u & 7;
    const int tok0 = mt * 256, f0 = nt * 128;
    f32x4 g[4][4];
    gemm_tile<false>(p.L1, 384, p.g2T, 128, 128, tok0, f0, lds, g, nullptr);
    const int head = nt * 2 + wf;
#pragma unroll
    for (int ti = 0; ti < 4; ++ti) {
      const int t = tok0 + wt * 64 + ti * 16 + lr;
      float y[4][4];
      float sum = 0.f;
#pragma unroll
      for (int fi = 0; fi < 4; ++fi) {
        const int f = f0 + wf * 64 + fi * 16 + lq * 4;
        float a0, a1, a2, a3, b0, b1, b2, b3;
        load_bf4(p.S[3] + (size_t)t * 1024 + f, a0, a1, a2, a3);
        load_bf4(p.S[4] + (size_t)t * 1024 + f, b0, b1, b2, b3);
        y[fi][0] = a0 + b0; y[fi][1] = a1 + b1; y[fi][2] = a2 + b2; y[fi][3] = a3 + b3;
        sum += (y[fi][0] + y[fi][1]) + (y[fi][2] + y[fi][3]);
      }
      sum += __shfl_xor(sum, 16); sum += __shfl_xor(sum, 32);
      const float mean = sum * (1.f / 64.f);
      float vs = 0.f;
#pragma unroll
      for (int fi = 0; fi < 4; ++fi)
#pragma unroll
        for (int j = 0; j < 4; ++j) { const float d = y[fi][j] - mean; vs += d * d; }
      vs += __shfl_xor(vs, 16); vs += __shfl_xor(vs, 32);
      const float rstd = rsqrtf(vs * (1.f / 64.f) + 64e-5f);
      const float bon = p.BON[(size_t)t * 16 + head];
#pragma unroll
      for (int fi = 0; fi < 4; ++fi) {
        const int f = f0 + wf * 64 + fi * 16 + lq * 4;
        const float4 lw = *(const float4*)(p.ln_w + f), lb = *(const float4*)(p.ln_b + f);
        float v0, v1, v2, v3;
        load_bf4(p.S[1] + (size_t)t * 1024 + f, v0, v1, v2, v3);
        const f32x4 gg = g[fi][ti];
        store_bf4(p.S[0] + (size_t)t * 1024 + f,
                  ((y[fi][0] - mean) * rstd * lw.x + lb.x + bon * v0) * gg[0], ((y[fi][1] - mean) * rstd * lw.y + lb.y + bon * v1) * gg[1],
                  ((y[fi][2] - mean) * rstd * lw.z + lb.z + bon * v2) * gg[2], ((y[fi][3] - mean) * rstd * lw.w + lb.w + bon * v3) * gg[3]);
      }
    }
  }
}

__device__ void phase_gemm_resid(const Params& p, char* lds, const bf16_t* A, int lda, const bf16_t* W, int K, int ntm,
                                 const float* xin_l, const float* xin_c, const float* gate  ) {
  const int lane = threadIdx.x & 63, wave = threadIdx.x >> 6;
  const int wt = wave & 3, wf = wave >> 2, lr = lane & 15, lq = lane >> 4;
  const int total = ntm * 8;
  for (int u = blockIdx.x; u < total; u += gridDim.x) {
    const int mt = u >> 3, nt = u & 7;
    f32x4 acc[4][4];
    gemm_tile<false>(A, lda, W, K, K, mt * 256, nt * 128, lds, acc, nullptr);
#pragma unroll
    for (int ti = 0; ti < 4; ++ti) {
      const int t = mt * 256 + wt * 64 + ti * 16 + lr;
      const int bp = t < NL ? (t >> 12) : 8;
      const float* xi = t < NL ? xin_l + (size_t)t * 1024 : xin_c + (size_t)(t - NL) * 1024;
      float* xo = t < NL ? p.out + (size_t)t * 1024 : p.XC + (size_t)(t - NL) * 1024;
#pragma unroll
      for (int fi = 0; fi < 4; ++fi) {
        const int f = nt * 128 + wf * 64 + fi * 16 + lq * 4;
        const float4 g4 = *(const float4*)(gate + bp * 6144 + f);
        const float4 x4 = *(const float4*)(xi + f);
        const f32x4 a = acc[fi][ti];
        *(float4*)(xo + f) = make_float4(x4.x + g4.x * a[0], x4.y + g4.y * a[1], x4.z + g4.z * a[2], x4.w + g4.w * a[3]);
      }
    }
  }
}

__device__ void phase_up(const Params& p, char* lds, const bf16_t* H, const bf16_t* W, bf16_t* U, int ntm) {
  const int lane = threadIdx.x & 63, wave = threadIdx.x >> 6;
  const int wt = wave & 3, wf = wave >> 2, lr = lane & 15, lq = lane >> 4;
  const int total = ntm * 32;
  for (int u = blockIdx.x; u < total; u += gridDim.x) {
    const int mt = u >> 5, nt = u & 31;
    f32x4 acc[4][4];
    gemm_tile<false>(H, 1024, W, 1024, 1024, mt * 256, nt * 128, lds, acc, nullptr);
#pragma unroll
    for (int ti = 0; ti < 4; ++ti) {
      const int t = mt * 256 + wt * 64 + ti * 16 + lr;
#pragma unroll
      for (int fi = 0; fi < 4; ++fi) {
        const int f = nt * 128 + wf * 64 + fi * 16 + lq * 4;
        const f32x4 a = acc[fi][ti];
        const float r0 = fmaxf(a[0], 0.f), r1 = fmaxf(a[1], 0.f), r2 = fmaxf(a[2], 0.f), r3 = fmaxf(a[3], 0.f);
        store_bf4(U + (size_t)t * 4096 + f, r0 * r0, r1 * r1, r2 * r2, r3 * r3);
      }
    }
  }
}

__device__ void phase_qkv(const Params& p, char* lds) {
  const int lane = threadIdx.x & 63, wave = threadIdx.x >> 6;
  const int wt = wave & 3, wf = wave >> 2, lr = lane & 15, lq = lane >> 4;
  const int total = (NT / 256) * 12;
  bf16_t* Q = p.S[0]; bf16_t* KA = p.S[1]; bf16_t* VT = p.S[2];
  for (int u = blockIdx.x; u < total; u += gridDim.x) {
    const int mt = u / 12, nt = u % 12;
    if (mt >= NL / 256 && nt < 8) continue;
    f32x4 acc[4][4];
    gemm_tile<false>(p.S[5], 1024, p.wqkvT, 1024, 1024, mt * 256, nt * 128, lds, acc, nullptr);
#pragma unroll
    for (int ti = 0; ti < 4; ++ti) {
      const int t = mt * 256 + wt * 64 + ti * 16 + lr;
      const bool lat = t < NL;
      const int b = lat ? (t >> 12) : ((t - NL) >> 8);
      const int key = lat ? (t & 4095) : 4096 + ((t - NL) & 255);
      if (nt < 10) {
        float ss = 0.f;
#pragma unroll
        for (int fi = 0; fi < 4; ++fi)
#pragma unroll
          for (int j = 0; j < 4; ++j) ss += acc[fi][ti][j] * acc[fi][ti][j];
        ss += __shfl_xor(ss, 16); ss += __shfl_xor(ss, 32);
        const float rstd = rsqrtf(ss * (1.f / 64.f) + 1e-6f);
        const float* gn = nt < 8 ? p.q_norm : p.k_norm;
        float v[4][4];
#pragma unroll
        for (int fi = 0; fi < 4; ++fi) {
          const float4 g4 = *(const float4*)(gn + fi * 16 + lq * 4);
          v[fi][0] = acc[fi][ti][0] * rstd * g4.x; v[fi][1] = acc[fi][ti][1] * rstd * g4.y;
          v[fi][2] = acc[fi][ti][2] * rstd * g4.z; v[fi][3] = acc[fi][ti][3] * rstd * g4.w;
        }
        if (lat) {
          const int s = t & 4095, rowp = s >> 6, colp = s & 63;
#pragma unroll
          for (int j = 0; j < 4; ++j) {
            const float2 cs0 = *(const float2*)(p.TAB + (rowp * 16 + lq * 4 + j) * 2);
            const float2 cs1 = *(const float2*)(p.TAB + (colp * 16 + lq * 4 + j) * 2);
            const float x1 = v[0][j], x2 = v[1][j], z1 = v[2][j], z2 = v[3][j];
            v[0][j] = x1 * cs0.x - x2 * cs0.y; v[1][j] = x2 * cs0.x + x1 * cs0.y;
            v[2][j] = z1 * cs1.x - z2 * cs1.y; v[3][j] = z2 * cs1.x + z1 * cs1.y;
          }
        }
        if (nt < 8) {
          const float qs = 0.125f * 1.4426950408889634f;
          const int head = nt * 2 + wf;
#pragma unroll
          for (int fi = 0; fi < 4; ++fi)
            store_bf4(Q + (size_t)t * 1024 + head * 64 + fi * 16 + lq * 4, v[fi][0] * qs, v[fi][1] * qs, v[fi][2] * qs, v[fi][3] * qs);
        } else {
          const int kvh = (nt - 8) * 2 + wf;
#pragma unroll
          for (int fi = 0; fi < 4; ++fi)
            store_bf4(KA + ((size_t)(b * 4 + kvh) * NKEY + key) * 64 + fi * 16 + lq * 4, v[fi][0], v[fi][1], v[fi][2], v[fi][3]);
        }
      } else {
        const int kvh = (nt - 10) * 2 + wf;
#pragma unroll
        for (int fi = 0; fi < 4; ++fi)
#pragma unroll
          for (int j = 0; j < 4; ++j) {
            const int d = fi * 16 + lq * 4 + j;
            const unsigned pk = pack2(acc[fi][ti][j], 0.f);
            VT[((size_t)(b * 4 + kvh) * 64 + d) * NKEY + key] = (bf16_t)(pk & 0xffffu);
          }
      }
    }
  }
}

__device__ void phase_attn(const Params& p, char* lds) {
  const int tid = threadIdx.x, lane = tid & 63, wave = tid >> 6;
  const int l31 = lane & 31, lh = lane >> 5;
  const int srow = tid >> 3, sch = tid & 7;
  const bf16_t* Q = p.S[0]; const bf16_t* KA = p.S[1]; const bf16_t* VT = p.S[2]; bf16_t* O = p.S[3];
  float gq = 0.f, gk = 0.f;
  for (int i = 0; i < 64; ++i) { gq = fmaxf(gq, fabsf(p.q_norm[i])); gk = fmaxf(gk, fabsf(p.k_norm[i])); }
  const float M2 = 8.f * gq * gk * 1.4426950408889634f;
  constexpr int NKT = NKEY / 64;
  constexpr int AST = 2 * 64 * ROWB;
  for (int u = blockIdx.x; u < 2048; u += gridDim.x) {
    const int qb = u & 15, head = (u >> 4) & 15, b = u >> 8, kvh = head >> 2;
    const bf16_t* Kg = KA + (size_t)(b * 4 + kvh) * NKEY * 64;
    const bf16_t* Vg = VT + (size_t)(b * 4 + kvh) * 64 * NKEY;
    const int tq = b * 4096 + qb * 256 + wave * 32 + l31;
    bf16x8 qf[4];
#pragma unroll
    for (int s = 0; s < 4; ++s) qf[s] = *(const bf16x8*)(Q + (size_t)tq * 1024 + head * 64 + s * 16 + lh * 8);
    f32x16 o0, o1;
#pragma unroll
    for (int i = 0; i < 16; ++i) { o0[i] = 0.f; o1[i] = 0.f; }
    float lsum = 0.f;
    uint4 kreg, vreg;
    auto gload = [&](int kt) {
      kreg = *(const uint4*)(Kg + (size_t)(kt * 64 + srow) * 64 + sch * 8);
      vreg = *(const uint4*)(Vg + (size_t)srow * NKEY + kt * 64 + sch * 8);
    };
    auto lwrite = [&](int st) {
      *(uint4*)(lds + st * AST + srow * ROWB + sch * 16) = kreg;
      *(uint4*)(lds + st * AST + 64 * ROWB + srow * ROWB + sch * 16) = vreg;
    };
    gload(0);
    __syncthreads();
    lwrite(0);
    __syncthreads();
    for (int kt = 0; kt < NKT; ++kt) {
      if (kt + 1 < NKT) gload(kt + 1);
      const char* ksm = lds + (kt & 1) * AST;
      const char* vsm = ksm + 64 * ROWB;
      f32x16 sT[2];
#pragma unroll
      for (int k2 = 0; k2 < 2; ++k2) {
#pragma unroll
        for (int i = 0; i < 16; ++i) sT[k2][i] = 0.f;
#pragma unroll
        for (int s = 0; s < 4; ++s) {
          const bf16x8 kf = *(const bf16x8*)(ksm + (k2 * 32 + l31) * ROWB + s * 32 + lh * 16);
          sT[k2] = MFMA32(kf, qf[s], sT[k2]);
        }
      }
#pragma unroll
      for (int k2 = 0; k2 < 2; ++k2)
#pragma unroll
        for (int i = 0; i < 16; ++i) { const float pv = __builtin_amdgcn_exp2f(sT[k2][i] - M2); lsum += pv; sT[k2][i] = pv; }
#pragma unroll
      for (int k2 = 0; k2 < 2; ++k2)
#pragma unroll
        for (int s2 = 0; s2 < 2; ++s2) {
          uint4 pk;
          pk.x = pack2(sT[k2][8 * s2 + 0], sT[k2][8 * s2 + 1]); pk.y = pack2(sT[k2][8 * s2 + 2], sT[k2][8 * s2 + 3]);
          pk.z = pack2(sT[k2][8 * s2 + 4], sT[k2][8 * s2 + 5]); pk.w = pack2(sT[k2][8 * s2 + 6], sT[k2][8 * s2 + 7]);
          const bf16x8 pf = __builtin_bit_cast(bf16x8, pk);
          const int koff = (k2 * 32 + 16 * s2 + 4 * lh) * 2;
          {
            const uint2 lo = *(const uint2*)(vsm + l31 * ROWB + koff), hi = *(const uint2*)(vsm + l31 * ROWB + koff + 16);
            const uint4 vv = make_uint4(lo.x, lo.y, hi.x, hi.y);
            o0 = MFMA32(__builtin_bit_cast(bf16x8, vv), pf, o0);
          }
          {
            const uint2 lo = *(const uint2*)(vsm + (32 + l31) * ROWB + koff), hi = *(const uint2*)(vsm + (32 + l31) * ROWB + koff + 16);
            const uint4 vv = make_uint4(lo.x, lo.y, hi.x, hi.y);
            o1 = MFMA32(__builtin_bit_cast(bf16x8, vv), pf, o1);
          }
        }
      if (kt + 1 < NKT) lwrite((kt + 1) & 1);
      __syncthreads();
    }
    lsum += __shfl_xor(lsum, 32);
    const float inv = 1.f / lsum;
#pragma unroll
    for (int g = 0; g < 4; ++g) {
      const int d0 = 8 * g + 4 * lh;
      store_bf4(O + (size_t)tq * 1024 + head * 64 + d0, o0[4 * g] * inv, o0[4 * g + 1] * inv, o0[4 * g + 2] * inv, o0[4 * g + 3] * inv);
      store_bf4(O + (size_t)tq * 1024 + head * 64 + 32 + d0, o1[4 * g] * inv, o1[4 * g + 1] * inv, o1[4 * g + 2] * inv, o1[4 * g + 3] * inv);
    }
  }
}

DI void run_phase(const Params& p, int ph, char* lds) {
  const float* mod0 = p.MOD;
  const float* mod1 = p.MOD + 9 * 6144;
  switch (ph) {
    case 0: phase0(p, lds); break;
    case 1: norm_mod_phase(p.x, p.ctx, p.norm_mix, mod0, 0, 1, p.Hd, NT); break;
    case 2: phase_proj(p, lds); break;
    case 3: phase_prep(p, lds); break;
    case 4: phase_scan(p, lds); break;
    case 5: phase_readout(p, lds); break;
    case 6: phase_gemm_resid(p, lds, p.S[0], 1024, p.woT, 1024, NT / 256, p.x, p.ctx, mod0 + 2 * 1024); break;
    case 7: norm_mod_phase(p.out, p.XC, p.norm_mlp, mod0, 3, 4, p.S[5], NT); break;
    case 8: phase_up(p, lds, p.S[5], p.w1T[0], p.S[0], NT / 256); break;
    case 9: phase_gemm_resid(p, lds, p.S[0], 4096, p.w2T[0], 4096, NT / 256, p.out, p.XC, mod0 + 5 * 1024); break;
    case 10: norm_mod_phase(p.out, p.XC, p.norm_mix + 1024, mod1, 0, 1, p.S[5], NT); break;
    case 11: phase_qkv(p, lds); break;
    case 12: phase_attn(p, lds); break;
    case 13: phase_gemm_resid(p, lds, p.S[3], 1024, p.awoT, 1024, NL / 256, p.out, p.XC, mod1 + 2 * 1024); break;
    case 14: norm_mod_phase(p.out, p.XC, p.norm_mlp + 1024, mod1, 3, 4, p.S[5], NL); break;
    case 15: phase_up(p, lds, p.S[5], p.w1T[1], p.S[0], NL / 256); break;
    case 16: phase_gemm_resid(p, lds, p.S[0], 4096, p.w2T[1], 4096, NL / 256, p.out, p.XC, mod1 + 5 * 1024); break;
    case 17: final_norm_phase(p); break;
  }
}
constexpr int NPHASE = 18;

__global__ void __launch_bounds__(NTHREADS) phase_kernel(Params p, int ph) {
  extern __shared__ __attribute__((aligned(16))) char lds[];
  run_phase(p, ph, lds);
}

__global__ void __launch_bounds__(NTHREADS) mega_kernel(Params p) {
  extern __shared__ __attribute__((aligned(16))) char lds[];
  cg::grid_group grid = cg::this_grid();
#define PH(n) run_phase(p, n, lds); grid.sync();
  PH(0) PH(1) PH(2) PH(3) PH(4) PH(5) PH(6) PH(7) PH(8) PH(9) PH(10) PH(11) PH(12) PH(13) PH(14) PH(15) PH(16)
  run_phase(p, 17, lds);
}

extern "C" void kernel_launch(void* const* d_in, const int* in_sizes, int n_in, void* d_out, int out_size, void* d_ws, size_t ws_size, hipStream_t stream) {
  Params p;
  memset(&p, 0, sizeof(p));
  const float* const* in = (const float* const*)d_in;
  p.x = in[0]; p.c = in[1]; p.ctx = in[2]; p.c_ctx = in[3]; p.w_mod = in[4]; p.b_mod = in[5]; p.norm_mix = in[6]; p.norm_mlp = in[7];
  p.mlp_w1 = in[8]; p.mlp_w2 = in[9]; p.mu = in[10]; p.wr = in[11]; p.wk = in[12]; p.wv = in[13]; p.wo = in[14]; p.w0 = in[15]; p.w1 = in[16];
  p.w2 = in[17]; p.a0 = in[18]; p.a1 = in[19]; p.a2 = in[20]; p.g1 = in[21]; p.g2 = in[22]; p.k_k = in[23]; p.k_a = in[24]; p.r_k = in[25];
  p.ln_w = in[26]; p.ln_b = in[27]; p.wqkv = in[28]; p.q_norm = in[29]; p.k_norm = in[30]; p.awo = in[31]; p.final_norm = in[32];
  p.out = (float*)d_out;
  char* ws = (char*)d_ws;
  size_t off = 0;
  auto take = [&](size_t bytes) -> char* { char* r = ws + off; off += (bytes + 255) & ~(size_t)255; return r; };
  p.Wcat = (bf16_t*)take((size_t)3456 * 1024 * 2);
  p.L2w = (bf16_t*)take((size_t)4 * 65536 * 2);
  p.g2T = (bf16_t*)take((size_t)1024 * 128 * 2);
  p.woT = (bf16_t*)take((size_t)1024 * 1024 * 2);
  p.w1T[0] = (bf16_t*)take((size_t)4096 * 1024 * 2);
  p.w1T[1] = (bf16_t*)take((size_t)4096 * 1024 * 2);
  p.w2T[0] = (bf16_t*)take((size_t)4096 * 1024 * 2);
  p.w2T[1] = (bf16_t*)take((size_t)4096 * 1024 * 2);
  p.wqkvT = (bf16_t*)take((size_t)1536 * 1024 * 2);
  p.awoT = (bf16_t*)take((size_t)1024 * 1024 * 2);
  p.MOD = (float*)take((size_t)2 * 9 * 6144 * 4);
  p.TAB = (float*)take((size_t)1024 * 2 * 4);
  p.XC = (float*)take((size_t)NC * 1024 * 4);
  for (int i = 0; i < 6; ++i) p.S[i] = (bf16_t*)take((size_t)NT * 1024 * 2);
  if (off > ws_size) { fprintf(stderr, "kernel_launch: workspace too small (%zu needed, %zu given)\n", off, ws_size); return; }
  char* ob = (char*)d_out;
  p.Hd = (bf16_t*)ob;
  p.L1 = (bf16_t*)(ob + (size_t)NT * 1024 * 2);
  p.BON = (float*)(ob + (size_t)NT * 1024 * 2 + (size_t)NT * 384 * 2);
  int nj = 0, tiles = 0;
  auto job = [&](const float* src, bf16_t* dst, int K, int N) {
    p.jobs[nj].src = src; p.jobs[nj].dst = dst; p.jobs[nj].K = K; p.jobs[nj].N = N; p.jobs[nj].tstart = tiles; p.jobs[nj].tiles_n = N / 64;
    tiles += (K / 64) * (N / 64); ++nj;
  };
  job(p.wr, p.Wcat, 1024, 1024);
  job(p.wk, p.Wcat + (size_t)1024 * 1024, 1024, 1024);
  job(p.wv, p.Wcat + (size_t)2048 * 1024, 1024, 1024);
  job(p.g1, p.Wcat + (size_t)3072 * 1024, 1024, 128);
  job(p.w1, p.Wcat + (size_t)3200 * 1024, 1024, 64);
  job(p.w1 + 65536, p.Wcat + (size_t)3264 * 1024, 1024, 64);
  job(p.a1, p.Wcat + (size_t)3328 * 1024, 1024, 64);
  job(p.a1 + 65536, p.Wcat + (size_t)3392 * 1024, 1024, 64);
  job(p.a2, p.L2w, 64, 1024);
  job(p.a2 + 65536, p.L2w + 65536, 64, 1024);
  job(p.w2, p.L2w + 2 * 65536, 64, 1024);
  job(p.w2 + 65536, p.L2w + 3 * 65536, 64, 1024);
  job(p.g2, p.g2T, 128, 1024);
  job(p.wo, p.woT, 1024, 1024);
  job(p.mlp_w1, p.w1T[0], 1024, 4096);
  job(p.mlp_w1 + (size_t)4096 * 1024, p.w1T[1], 1024, 4096);
  job(p.mlp_w2, p.w2T[0], 4096, 1024);
  job(p.mlp_w2 + (size_t)4096 * 1024, p.w2T[1], 4096, 1024);
  job(p.wqkv, p.wqkvT, 1024, 1536);
  job(p.awo, p.awoT, 1024, 1024);
  p.njobs = nj; p.total_tiles = tiles;

  static int grid_blocks = 0;
  if (!grid_blocks) {
    (void)hipFuncSetAttribute((const void*)mega_kernel, hipFuncAttributeMaxDynamicSharedMemorySize, LDS_BYTES);
    (void)hipFuncSetAttribute((const void*)phase_kernel, hipFuncAttributeMaxDynamicSharedMemorySize, LDS_BYTES);
    int dev = 0, cus = 0, per_cu = 0;
    (void)hipGetDevice(&dev);
    (void)hipDeviceGetAttribute(&cus, hipDeviceAttributeMultiprocessorCount, dev);
    if (hipOccupancyMaxActiveBlocksPerMultiprocessor(&per_cu, (const void*)mega_kernel, NTHREADS, LDS_BYTES) != hipSuccess || per_cu < 1) per_cu = 1;
    if (cus <= 0) cus = 256;
    grid_blocks = cus * per_cu;
    (void)hipGetLastError();
  }
#if SINGLE_LAUNCH
  void* args[] = {&p};
  hipError_t e = hipLaunchCooperativeKernel((const void*)mega_kernel, dim3(grid_blocks), dim3(NTHREADS), args, LDS_BYTES, stream);
  if (e != hipSuccess) fprintf(stderr, "cooperative launch failed: %s (grid %d)\n", hipGetErrorString(e), grid_blocks);
#else
  for (int ph = 0; ph < NPHASE; ++ph) hipLaunchKernelGGL(phase_kernel, dim3(grid_blocks), dim3(NTHREADS), LDS_BYTES, stream, p, ph);
#endif
}
```

```cpp
#include <hip/hip_runtime.h>
#include <hip/hip_cooperative_groups.h>
#include <cstdint>
#include <cstring>
#include <cstdio>
namespace cg = cooperative_groups;

#ifndef SINGLE_LAUNCH
#define SINGLE_LAUNCH 1
#endif

typedef unsigned short bf16_t;
typedef short bf16x8 __attribute__((ext_vector_type(8)));
typedef float f32x2 __attribute__((ext_vector_type(2)));
typedef float f32x4 __attribute__((ext_vector_type(4)));
typedef float f32x16 __attribute__((ext_vector_type(16)));
typedef __bf16 bf16x2_t __attribute__((ext_vector_type(2)));
#define DI __device__ __forceinline__

constexpr int D = 1024, NB = 8, SEQ = 4096, CTXL = 256;
constexpr int NL = NB * SEQ, NC = NB * CTXL, NT = NL + NC, DFF = 4096;
constexpr int NKEY = SEQ + CTXL;
constexpr int NTHREADS = 512;
constexpr int ROWB = 144;
constexpr int GEMM_STAGE = (256 + 128) * ROWB;
constexpr int LDS_BYTES = 131072;

struct TJob { const float* src; bf16_t* dst; int K, N, tstart, tiles_n; };

struct Params {
  const float *x, *c, *ctx, *c_ctx, *w_mod, *b_mod, *norm_mix, *norm_mlp, *mlp_w1, *mlp_w2;
  const float *mu, *wr, *wk, *wv, *wo, *w0, *w1, *w2, *a0, *a1, *a2, *g1, *g2, *k_k, *k_a, *r_k, *ln_w, *ln_b;
  const float *wqkv, *q_norm, *k_norm, *awo, *final_norm;
  float* out;
  bf16_t *Wcat, *L2w, *g2T, *woT, *w1T[2], *w2T[2], *wqkvT, *awoT;
  float *MOD, *TAB, *XC;
  bf16_t* S[6];
  bf16_t *Hd, *L1;
  float* BON;
  TJob jobs[20];
  int njobs, total_tiles;
};

DI unsigned pack2(float lo, float hi) {
  f32x2 v = {lo, hi};
  bf16x2_t b = __builtin_convertvector(v, bf16x2_t);
  return __builtin_bit_cast(unsigned, b);
}
DI float bflo(unsigned u) { return __uint_as_float(u << 16); }
DI float bfhi(unsigned u) { return __uint_as_float(u & 0xffff0000u); }
DI void store_bf4(bf16_t* p, float a, float b, float c, float d) { *(uint2*)p = make_uint2(pack2(a, b), pack2(c, d)); }
DI void load_bf4(const bf16_t* p, float& a, float& b, float& c, float& d) { uint2 u = *(const uint2*)p; a = bflo(u.x); b = bfhi(u.x); c = bflo(u.y); d = bfhi(u.y); }
DI float sigmoidf_(float x) { return 1.f / (1.f + __expf(-x)); }
DI float tanhf_(float x) { return 1.f - 2.f / (1.f + __expf(2.f * x)); }
DI float quad_sum(float x) {
  x += __builtin_bit_cast(float, __builtin_amdgcn_mov_dpp(__builtin_bit_cast(int, x), 0xB1, 0xF, 0xF, true));
  x += __builtin_bit_cast(float, __builtin_amdgcn_mov_dpp(__builtin_bit_cast(int, x), 0x4E, 0xF, 0xF, true));
  return x;
}
DI float wave_sum(float x) {
#pragma unroll
  for (int m = 1; m < 64; m <<= 1) x += __shfl_xor(x, m);
  return x;
}
#define MFMA16(a, b, c) __builtin_amdgcn_mfma_f32_16x16x32_bf16((a), (b), (c), 0, 0, 0)
#define MFMA32(a, b, c) __builtin_amdgcn_mfma_f32_32x32x16_bf16((a), (b), (c), 0, 0, 0)

DI unsigned lerp2(unsigned a, unsigned n, float ma, float mb) {
  const float h0 = bflo(a), h1 = bfhi(a), s0 = bflo(n), s1 = bfhi(n);
  return pack2(h0 + (s0 - h0) * ma, h1 + (s1 - h1) * mb);
}
template <bool LERP>
DI void gemm_tile(const bf16_t* __restrict__ X, int ldx, const bf16_t* __restrict__ W, int ldw, int K, int tok0, int f0,
                  char* lds, f32x4 (&acc)[4][4], const float* __restrict__ mu) {
  const int tid = threadIdx.x, lane = tid & 63, wave = tid >> 6;
  const int wt = wave & 3, wf = wave >> 2, lr = lane & 15, lq = lane >> 4;
  const int lrow = tid >> 3, kc = tid & 7;
#pragma unroll
  for (int i = 0; i < 4; ++i)
#pragma unroll
    for (int j = 0; j < 4; ++j) acc[i][j] = f32x4{0.f, 0.f, 0.f, 0.f};
  uint4 xr[4], wr[2], xn[4];
  float4 m0 = make_float4(0, 0, 0, 0), m1 = m0;
  const int nk = K >> 6;
  __syncthreads();
  for (int kt = -1; kt < nk; ++kt) {
    const bool more = kt + 1 < nk;
    if (more) {
      const int k0 = (kt + 1) << 6;
#pragma unroll
      for (int i = 0; i < 4; ++i) {
        const int tg = tok0 + lrow + 64 * i;
        xr[i] = *(const uint4*)(X + (size_t)tg * ldx + k0 + kc * 8);
        if (LERP) {
          int nb; bool valid;
          if (tok0 < NL) {
            const int s = tg & 4095, col = s & 63, rw = s >> 6, qd = k0 >> 8;
            if (qd == 0) { valid = col > 0; nb = tg - 1; }
            else if (qd == 1) { valid = col < 63; nb = tg + 1; }
            else if (qd == 2) { valid = rw > 0; nb = tg - 64; }
            else { valid = rw < 63; nb = tg + 64; }
          } else {
            const int s = (tg - NL) & 255;
            if (k0 < 512) { valid = s > 0; nb = tg - 1; }
            else { valid = s < 255; nb = tg + 1; }
          }
          if (valid) xn[i] = *(const uint4*)(X + (size_t)nb * ldx + k0 + kc * 8);
          else xn[i] = make_uint4(0, 0, 0, 0);
        }
      }
#pragma unroll
      for (int i = 0; i < 2; ++i) wr[i] = *(const uint4*)(W + (size_t)(f0 + lrow + 64 * i) * ldw + k0 + kc * 8);
      if (LERP) { m0 = *(const float4*)(mu + k0 + kc * 8); m1 = *(const float4*)(mu + k0 + kc * 8 + 4); }
    }
    if (kt >= 0) {
      const char* xs = lds + (kt & 1) * GEMM_STAGE;
      const char* wsm = xs + 256 * ROWB;
#pragma unroll
      for (int ks = 0; ks < 2; ++ks) {
        bf16x8 wfr[4], xfr[4];
#pragma unroll
        for (int i = 0; i < 4; ++i) wfr[i] = *(const bf16x8*)(wsm + (wf * 64 + i * 16 + lr) * ROWB + ks * 64 + lq * 16);
#pragma unroll
        for (int i = 0; i < 4; ++i) xfr[i] = *(const bf16x8*)(xs + (wt * 64 + i * 16 + lr) * ROWB + ks * 64 + lq * 16);
#pragma unroll
        for (int fi = 0; fi < 4; ++fi)
#pragma unroll
          for (int ti = 0; ti < 4; ++ti) acc[fi][ti] = MFMA16(wfr[fi], xfr[ti], acc[fi][ti]);
      }
    }
    if (more) {
      char* xs = lds + ((kt + 1) & 1) * GEMM_STAGE;
      char* wsm = xs + 256 * ROWB;
#pragma unroll
      for (int i = 0; i < 4; ++i) {
        uint4 v = xr[i];
        if (LERP) {
          v.x = lerp2(xr[i].x, xn[i].x, m0.x, m0.y);
          v.y = lerp2(xr[i].y, xn[i].y, m0.z, m0.w);
          v.z = lerp2(xr[i].z, xn[i].z, m1.x, m1.y);
          v.w = lerp2(xr[i].w, xn[i].w, m1.z, m1.w);
        }
        *(uint4*)(xs + (lrow + 64 * i) * ROWB + kc * 16) = v;
      }
#pragma unroll
      for (int i = 0; i < 2; ++i) *(uint4*)(wsm + (lrow + 64 * i) * ROWB + kc * 16) = wr[i];
    }
    __syncthreads();
  }
}


namespace g256 {
constexpr int BK = 64, HALF = 128, HT = HALF * BK;
DI int lds_byte(int r, int c) { const int st = (r >> 4) * 2 + (c >> 5), rr = r & 15, cc = c & 31, ob = rr * 64 + cc * 2; return st * 1024 + (ob ^ (((ob >> 9) & 1) << 5)); }
DI void stage_rc(int b, int& R, int& C) { const int st = b / 1024, sb = b % 1024, swz = sb ^ (((sb >> 9) & 1) << 5); R = (st >> 1) * 16 + swz / 64; C = (st & 1) * 32 + (swz % 64) / 2; }
}
#define G_SA(b, h) (((b) * 2 + (h)) * 16384)
#define G_SB(b, h) ((4 + (b) * 2 + (h)) * 16384)
#define G_STAGE(bufoff, gbase) do { _Pragma("unroll") for (int _i = 0; _i < 2; ++_i) \
    __builtin_amdgcn_global_load_lds((const unsigned*)((const char*)(gbase) + voff[_i]), (__attribute__((address_space(3))) unsigned*)(lds + (bufoff) + ldsw + _i * 8192), 16, 0, 0); } while (0)
#define G_LDA(dst, b, h) do { _Pragma("unroll") for (int m = 0; m < 4; ++m) _Pragma("unroll") for (int k = 0; k < 2; ++k) \
    dst[m][k] = *(const __attribute__((address_space(3))) bf16x8*)(lds + G_SA(b, h) + aoff + m * 2048 + k * 1024); } while (0)
#define G_LDB(dst, b, h) do { _Pragma("unroll") for (int n = 0; n < 2; ++n) _Pragma("unroll") for (int k = 0; k < 2; ++k) \
    dst[n][k] = *(const __attribute__((address_space(3))) bf16x8*)(lds + G_SB(b, h) + boff + n * 2048 + k * 1024); } while (0)
#define G_MMA(ai, bj, At, Bt) do { __builtin_amdgcn_s_setprio(1); \
    _Pragma("unroll") for (int m = 0; m < 4; ++m) _Pragma("unroll") for (int n = 0; n < 2; ++n) _Pragma("unroll") for (int k = 0; k < 2; ++k) \
      acc[ai][bj][m][n] = __builtin_amdgcn_mfma_f32_16x16x32_bf16(At[m][k], Bt[n][k], acc[ai][bj][m][n], 0, 0, 0); \
    __builtin_amdgcn_s_setprio(0); } while (0)
#define G_WAIT_V(n) asm volatile("s_waitcnt vmcnt(" #n ")" ::: "memory")
#define G_WAIT_L(n) asm volatile("s_waitcnt lgkmcnt(" #n ")" ::: "memory")
#define G_BAR __builtin_amdgcn_s_barrier()
#define G_SCHED __builtin_amdgcn_sched_barrier(0)

DI void gemm256_tile(const bf16_t* __restrict__ A, const bf16_t* __restrict__ Bt, int K, int brow, int bcol, char* lds_, f32x4 (&acc)[2][2][4][2]) {
  __attribute__((address_space(3))) unsigned char* lds = (__attribute__((address_space(3))) unsigned char*)lds_;
  const int tid = threadIdx.x, wid = __builtin_amdgcn_readfirstlane(tid >> 6), lane = tid & 63, wr = wid >> 2, wc = wid & 3, fr = lane & 15, fq = lane >> 4;
#pragma unroll
  for (int a = 0; a < 2; ++a)
#pragma unroll
    for (int b = 0; b < 2; ++b)
#pragma unroll
      for (int m = 0; m < 4; ++m)
#pragma unroll
        for (int n = 0; n < 2; ++n) acc[a][b][m][n] = f32x4{0.f, 0.f, 0.f, 0.f};
  unsigned voff[2];
#pragma unroll
  for (int i = 0; i < 2; ++i) { int R, C; g256::stage_rc(tid * 16 + i * 8192, R, C); voff[i] = (unsigned)(R * K + C) * 2u; }
  const size_t kstep = 128, hstep = (size_t)128 * K * 2;
  const unsigned ldsw = (unsigned)wid * 1024u;
  const int aoff = g256::lds_byte(wr * 64 + fr, fq * 8), boff = g256::lds_byte(wc * 32 + fr, fq * 8);
  const char* cA = (const char*)A + (size_t)brow * K * 2;
  const char* cB = (const char*)Bt + (size_t)bcol * K * 2;
  bf16x8 At[4][2], B0[2][2], B1[2][2];
  const int nt = K / g256::BK;
  __syncthreads();
  G_STAGE(G_SB(0, 0), cB); G_STAGE(G_SA(0, 0), cA); G_STAGE(G_SB(0, 1), cB + hstep); G_STAGE(G_SA(0, 1), cA + hstep);
  if (wr == 1) G_BAR;
  G_WAIT_V(4); G_BAR;
  G_STAGE(G_SB(1, 0), cB + kstep); G_STAGE(G_SA(1, 0), cA + kstep); G_STAGE(G_SB(1, 1), cB + hstep + kstep);
  G_WAIT_V(6); G_BAR;
  for (int t = 0; t < nt - 2; t += 2) {
    const char* a1 = cA + (size_t)(t + 1) * kstep;
    const char* a2 = cA + (size_t)(t + 2) * kstep; const char* b2 = cB + (size_t)(t + 2) * kstep;
    const char* a3 = a2 + kstep; const char* b3 = b2 + kstep;
    G_LDB(B0, 0, 0); G_SCHED; G_LDA(At, 0, 0); G_STAGE(G_SA(1, 1), a1 + hstep);
    G_WAIT_L(8); G_BAR; G_WAIT_L(0); G_MMA(0, 0, At, B0); G_BAR; G_SCHED;
    G_LDB(B1, 0, 1); G_STAGE(G_SB(0, 0), b2);
    G_BAR; G_WAIT_L(0); G_MMA(0, 1, At, B1); G_BAR;
    G_LDA(At, 0, 1); G_STAGE(G_SA(0, 0), a2);
    G_BAR; G_WAIT_L(0); G_MMA(1, 0, At, B0); G_BAR; G_SCHED;
    G_STAGE(G_SB(0, 1), b2 + hstep);
    G_WAIT_V(6); G_BAR; G_MMA(1, 1, At, B1); G_BAR;
    G_LDB(B0, 1, 0); G_SCHED; G_LDA(At, 1, 0); G_STAGE(G_SA(0, 1), a2 + hstep);
    G_WAIT_L(8); G_BAR; G_WAIT_L(0); G_MMA(0, 0, At, B0); G_BAR; G_SCHED;
    G_LDB(B1, 1, 1); G_STAGE(G_SB(1, 0), b3);
    G_BAR; G_WAIT_L(0); G_MMA(0, 1, At, B1); G_BAR;
    G_LDA(At, 1, 1); G_STAGE(G_SA(1, 0), a3);
    G_BAR; G_WAIT_L(0); G_MMA(1, 0, At, B0); G_BAR; G_SCHED;
    G_STAGE(G_SB(1, 1), b3 + hstep);
    G_WAIT_V(6); G_BAR; G_MMA(1, 1, At, B1); G_BAR;
  }
  { G_LDB(B0, 0, 0); G_LDA(At, 0, 0); G_STAGE(G_SA(1, 1), cA + (size_t)(nt - 1) * kstep + hstep);
    G_BAR; G_WAIT_L(0); G_MMA(0, 0, At, B0); G_BAR;
    G_LDB(B1, 0, 1); G_BAR; G_WAIT_L(0); G_MMA(0, 1, At, B1); G_BAR;
    G_LDA(At, 0, 1); G_WAIT_V(4); G_BAR; G_WAIT_L(0); G_MMA(1, 0, At, B0); G_MMA(1, 1, At, B1); G_BAR; }
  { G_LDB(B0, 1, 0); G_LDA(At, 1, 0); G_WAIT_V(2); G_BAR; G_WAIT_L(0); G_MMA(0, 0, At, B0); G_BAR;
    G_LDB(B1, 1, 1); G_WAIT_V(0); G_BAR; G_WAIT_L(0); G_MMA(0, 1, At, B1); G_BAR;
    G_LDA(At, 1, 1); G_BAR; G_WAIT_L(0); G_MMA(1, 0, At, B0); G_MMA(1, 1, At, B1); G_BAR; }
  if (wr == 0) G_BAR;
}

DI void convert_tile(const TJob& jb, int t, char* lds) {
  float* tile = (float*)lds;
  const int tid = threadIdx.x;
  const int tk = t / jb.tiles_n, tn = t % jb.tiles_n;
  const int k0 = tk * 64, n0 = tn * 64;
  __syncthreads();
#pragma unroll
  for (int i = 0; i < 2; ++i) {
    const int idx = tid + 512 * i, row = idx >> 4, c4 = idx & 15;
    const float4 v = *(const float4*)(jb.src + (size_t)(k0 + row) * jb.N + n0 + c4 * 4);
    tile[row * 65 + c4 * 4 + 0] = v.x; tile[row * 65 + c4 * 4 + 1] = v.y; tile[row * 65 + c4 * 4 + 2] = v.z; tile[row * 65 + c4 * 4 + 3] = v.w;
  }
  __syncthreads();
  const int n = tid >> 3, kc = tid & 7;
  float v[8];
#pragma unroll
  for (int j = 0; j < 8; ++j) v[j] = tile[(kc * 8 + j) * 65 + n];
  uint4 o;
  o.x = pack2(v[0], v[1]); o.y = pack2(v[2], v[3]); o.z = pack2(v[4], v[5]); o.w = pack2(v[6], v[7]);
  *(uint4*)(jb.dst + (size_t)(n0 + n) * jb.K + k0 + kc * 8) = o;
}

DI void mod_unit(const Params& p, int mu_, char* lds) {
  const int tid = threadIdx.x;
  const int layer = mu_ / 96, cc = mu_ % 96;
  float* sc = (float*)lds;
  float* red = sc + 9 * 1024;
  __syncthreads();
  for (int i = tid; i < 9 * 1024; i += 512) {
    const int row = i >> 10, k = i & 1023;
    const float v = row < 8 ? p.c[row * 1024 + k] : p.c_ctx[k];
    sc[i] = v / (1.f + __expf(-v));
  }
  __syncthreads();
  const int kg = tid >> 6, col = tid & 63;
  const float* w = p.w_mod + (size_t)layer * 1024 * 6144 + cc * 64 + col;
  float a[9];
#pragma unroll
  for (int r = 0; r < 9; ++r) a[r] = 0.f;
#pragma unroll 4
  for (int k = kg * 128; k < kg * 128 + 128; ++k) {
    const float wv = w[(size_t)k * 6144];
#pragma unroll
    for (int r = 0; r < 9; ++r) a[r] += sc[r * 1024 + k] * wv;
  }
#pragma unroll
  for (int r = 0; r < 9; ++r) red[(kg * 9 + r) * 64 + col] = a[r];
  __syncthreads();
  for (int i = tid; i < 576; i += 512) {
    const int r = i >> 6, cl = i & 63;
    float s = 0.f;
#pragma unroll
    for (int g = 0; g < 8; ++g) s += red[(g * 9 + r) * 64 + cl];
    const int n = cc * 64 + cl;
    p.MOD[(layer * 9 + r) * 6144 + n] = s + p.b_mod[layer * 6144 + n];
  }
  __syncthreads();
}

DI void sincos_d(double a, double& s, double& c) {
  const double n = rint(a * 0.6366197723675814);
  const double r = (a - n * 1.5707963267948966) - n * 6.123233995736766e-17;
  const double r2 = r * r;
  const double sp = r * (1.0 + r2 * (-1.0 / 6.0 + r2 * (1.0 / 120.0 + r2 * (-1.0 / 5040.0 + r2 * (1.0 / 362880.0 + r2 * (-1.0 / 39916800.0 + r2 * (1.0 / 6227020800.0)))))));
  const double cp = 1.0 + r2 * (-0.5 + r2 * (1.0 / 24.0 + r2 * (-1.0 / 720.0 + r2 * (1.0 / 40320.0 + r2 * (-1.0 / 3628800.0 + r2 * (1.0 / 479001600.0 + r2 * (-1.0 / 87178291200.0)))))));
  const int q = ((int)n) & 3;
  if (q == 0) { s = sp; c = cp; }
  else if (q == 1) { s = cp; c = -sp; }
  else if (q == 2) { s = -sp; c = -cp; }
  else { s = -cp; c = sp; }
}

DI void tab_unit(const Params& p) {
  for (int idx = threadIdx.x; idx < 1024; idx += 512) {
    const int pos = idx >> 4, fi = idx & 15;
    double f = 1.0;
    for (int i = 0; i < fi; ++i) f *= 0.5623413251903491;
    double s, c;
    sincos_d((double)pos * (double)(float)f, s, c);
    p.TAB[idx * 2 + 0] = (float)c;
    p.TAB[idx * 2 + 1] = (float)s;
  }
}

__device__ void phase0(const Params& p, char* lds) {
  const int total = p.total_tiles + 192 + 1;
  for (int u = blockIdx.x; u < total; u += gridDim.x) {
    if (u < p.total_tiles) {
      int j = 0;
#pragma unroll 1
      for (int q = 1; q < p.njobs; ++q) if (u >= p.jobs[q].tstart) j = q;
      convert_tile(p.jobs[j], u - p.jobs[j].tstart, lds);
    } else if (u < p.total_tiles + 192) {
      mod_unit(p, u - p.total_tiles, lds);
    } else {
      tab_unit(p);
    }
  }
}

DI void norm_mod_phase(const float* __restrict__ xl, const float* __restrict__ xc, const float* __restrict__ gain,
                               const float* __restrict__ mod, int shift_i, int scale_i, bf16_t* __restrict__ H, int ntok) {
  const int lane = threadIdx.x & 63;
  const int wg = blockIdx.x * 8 + (threadIdx.x >> 6), nw = gridDim.x * 8;
  for (int t = wg; t < ntok; t += nw) {
    const float* row = t < NL ? xl + (size_t)t * 1024 : xc + (size_t)(t - NL) * 1024;
    float4 v[4];
    float ss = 0.f;
#pragma unroll
    for (int i = 0; i < 4; ++i) {
      v[i] = *(const float4*)(row + (lane + 64 * i) * 4);
      ss += v[i].x * v[i].x + v[i].y * v[i].y + v[i].z * v[i].z + v[i].w * v[i].w;
    }
    ss = wave_sum(ss);
    const float rstd = rsqrtf(ss * (1.f / 1024.f) + 1e-6f);
    const int bp = t < NL ? (t >> 12) : 8;
    const float* sh = mod + (bp * 6 + shift_i) * 1024;
    const float* sc = mod + (bp * 6 + scale_i) * 1024;
#pragma unroll
    for (int i = 0; i < 4; ++i) {
      const int c = (lane + 64 * i) * 4;
      const float4 g = *(const float4*)(gain + c), s4 = *(const float4*)(sh + c), c4 = *(const float4*)(sc + c);
      store_bf4(H + (size_t)t * 1024 + c,
                v[i].x * rstd * g.x * (1.f + c4.x) + s4.x, v[i].y * rstd * g.y * (1.f + c4.y) + s4.y,
                v[i].z * rstd * g.z * (1.f + c4.z) + s4.z, v[i].w * rstd * g.w * (1.f + c4.w) + s4.w);
    }
  }
}

__device__ void final_norm_phase(const Params& p) {
  const int lane = threadIdx.x & 63;
  const int wg = blockIdx.x * 8 + (threadIdx.x >> 6), nw = gridDim.x * 8;
  for (int t = wg; t < NL; t += nw) {
    float* row = p.out + (size_t)t * 1024;
    float4 v[4];
    float ss = 0.f;
#pragma unroll
    for (int i = 0; i < 4; ++i) {
      v[i] = *(const float4*)(row + (lane + 64 * i) * 4);
      ss += v[i].x * v[i].x + v[i].y * v[i].y + v[i].z * v[i].z + v[i].w * v[i].w;
    }
    ss = wave_sum(ss);
    const float rstd = rsqrtf(ss * (1.f / 1024.f) + 1e-6f);
#pragma unroll
    for (int i = 0; i < 4; ++i) {
      const int c = (lane + 64 * i) * 4;
      const float4 g = *(const float4*)(p.final_norm + c);
      *(float4*)(row + c) = make_float4(v[i].x * rstd * g.x, v[i].y * rstd * g.y, v[i].z * rstd * g.z, v[i].w * rstd * g.w);
    }
  }
}

__device__ void phase_proj(const Params& p, char* lds) {
  const int lane = threadIdx.x & 63, wave = threadIdx.x >> 6;
  const int wt = wave & 3, wf = wave >> 2, lr = lane & 15, lq = lane >> 4;
  const int ntn = 27, total = (NT / 256) * ntn;
  for (int u = blockIdx.x; u < total; u += gridDim.x) {
    const int mt = u / ntn, nt = u % ntn;
    const int mi = nt < 8 ? 0 : nt < 16 ? 2 : nt < 24 ? 3 : nt == 24 ? 5 : nt == 25 ? 1 : 4;
    f32x4 acc[4][4];
    gemm_tile<true>(p.Hd, 1024, p.Wcat, 1024, 1024, mt * 256, nt * 128, lds, acc, p.mu + mi * 1024);
#pragma unroll
    for (int fi = 0; fi < 4; ++fi)
#pragma unroll
      for (int ti = 0; ti < 4; ++ti) {
        const int t = mt * 256 + wt * 64 + ti * 16 + lr;
        const int fl = wf * 64 + fi * 16 + lq * 4;
        const f32x4 a = acc[fi][ti];
        if (nt < 24) {
          bf16_t* dst = nt < 8 ? p.S[0] : nt < 16 ? p.S[2] : p.S[1];
          store_bf4(dst + (size_t)t * 1024 + (nt & 7) * 128 + fl, a[0], a[1], a[2], a[3]);
        } else if (nt == 24) {
          store_bf4(p.L1 + (size_t)t * 384 + fl, sigmoidf_(a[0]), sigmoidf_(a[1]), sigmoidf_(a[2]), sigmoidf_(a[3]));
        } else if (nt == 25) {
          store_bf4(p.L1 + (size_t)t * 384 + 128 + fl, tanhf_(a[0]), tanhf_(a[1]), tanhf_(a[2]), tanhf_(a[3]));
        } else {
          store_bf4(p.L1 + (size_t)t * 384 + 256 + fl, a[0], a[1], a[2], a[3]);
        }
      }
  }
}

__device__ void phase_prep(const Params& p, char* lds) {
  const int lane = threadIdx.x & 63, wave = threadIdx.x >> 6;
  const int wt = wave & 3, wf = wave >> 2, lr = lane & 15, lq = lane >> 4;
  const int total = (NT / 256) * 8;
  for (int u = blockIdx.x; u < total; u += gridDim.x) {
    const int mt = u >> 3, nt = u & 7;
    const int tok0 = mt * 256, f0 = nt * 128;
    f32x4 af[4][4], acc[4][4];
    gemm_tile<false>(p.L1 + 256, 384, p.L2w + 0 * 65536, 64, 64, tok0, f0, lds, af, nullptr);
#pragma unroll
    for (int fi = 0; fi < 4; ++fi) {
      const int f = f0 + wf * 64 + fi * 16 + lq * 4;
      const float4 a0 = *(const float4*)(p.a0 + f);
#pragma unroll
      for (int ti = 0; ti < 4; ++ti) {
        const int t = tok0 + wt * 64 + ti * 16 + lr;
        f32x4 a = af[fi][ti];
        a[0] = sigmoidf_(a[0] + a0.x); a[1] = sigmoidf_(a[1] + a0.y); a[2] = sigmoidf_(a[2] + a0.z); a[3] = sigmoidf_(a[3] + a0.w);
        af[fi][ti] = a;
        store_bf4(p.S[3] + (size_t)t * 1024 + f, a[0], a[1], a[2], a[3]);
      }
    }
    gemm_tile<false>(p.L1 + 320, 384, p.L2w + 1 * 65536, 64, 64, tok0, f0, lds, acc, nullptr);
    float bon[4] = {0.f, 0.f, 0.f, 0.f};
#pragma unroll
    for (int fi = 0; fi < 4; ++fi) {
      const int f = f0 + wf * 64 + fi * 16 + lq * 4;
      const float4 a0 = *(const float4*)(p.a0 + 1024 + f);
      const float4 rk4 = *(const float4*)(p.r_k + f);
      const float4 ka4 = *(const float4*)(p.k_a + f);
#pragma unroll
      for (int ti = 0; ti < 4; ++ti) {
        const int t = tok0 + wt * 64 + ti * 16 + lr;
        f32x4 a = acc[fi][ti];
        a[0] = sigmoidf_(a[0] + a0.x); a[1] = sigmoidf_(a[1] + a0.y); a[2] = sigmoidf_(a[2] + a0.z); a[3] = sigmoidf_(a[3] + a0.w);
        store_bf4(p.S[4] + (size_t)t * 1024 + f, a[0], a[1], a[2], a[3]);
        float r0, r1, r2, r3, k0, k1, k2, k3;
        load_bf4(p.S[0] + (size_t)t * 1024 + f, r0, r1, r2, r3);
        load_bf4(p.S[2] + (size_t)t * 1024 + f, k0, k1, k2, k3);
        const f32x4 b = af[fi][ti];
        bon[ti] += r0 * k0 * rk4.x * (2.f + (a[0] + b[0] - 2.f) * ka4.x) + r1 * k1 * rk4.y * (2.f + (a[1] + b[1] - 2.f) * ka4.y)
                 + r2 * k2 * rk4.z * (2.f + (a[2] + b[2] - 2.f) * ka4.z) + r3 * k3 * rk4.w * (2.f + (a[3] + b[3] - 2.f) * ka4.w);
      }
    }
#pragma unroll
    for (int ti = 0; ti < 4; ++ti) {
      float s = bon[ti];
      s += __shfl_xor(s, 16);
      s += __shfl_xor(s, 32);
      if (lq == 0) p.BON[(size_t)(tok0 + wt * 64 + ti * 16 + lr) * 16 + (nt * 2 + wf)] = s;
    }
#pragma unroll 1
    for (int dr = 0; dr < 2; ++dr) {
      gemm_tile<false>(p.L1 + 128 + dr * 64, 384, p.L2w + (2 + dr) * 65536, 64, 64, tok0, f0, lds, acc, nullptr);
      bf16_t* dst = dr ? p.S[5] : p.Hd;
#pragma unroll
      for (int fi = 0; fi < 4; ++fi) {
        const int f = f0 + wf * 64 + fi * 16 + lq * 4;
        const float4 w0 = *(const float4*)(p.w0 + dr * 1024 + f);
#pragma unroll
        for (int ti = 0; ti < 4; ++ti) {
          const int t = tok0 + wt * 64 + ti * 16 + lr;
          const f32x4 a = acc[fi][ti];
          store_bf4(dst + (size_t)t * 1024 + f, -0.60653066f * sigmoidf_(a[0] + w0.x), -0.60653066f * sigmoidf_(a[1] + w0.y),
                    -0.60653066f * sigmoidf_(a[2] + w0.z), -0.60653066f * sigmoidf_(a[3] + w0.w));
        }
      }
    }
  }
}

__device__ void phase_scan(const Params& p, char* lds, bool dupout = false) {
  float* buf = (float*)lds;
  float* ybuf = (float*)(lds + 2 * 49152);
  const int tid = threadIdx.x;
  const bool loader = tid >= 256;
  const int lt = tid & 255, ltk = lt >> 3, lch = (lt & 7) * 8;
  const int vrow = lt >> 2, q = lt & 3;
  constexpr int NCH = NKEY / 32;
  for (int unit = blockIdx.x; unit < 256; unit += gridDim.x) {
    const int dir = unit & 1, h = (unit >> 1) & 15, b = unit >> 5;
    const bf16_t* Rp = p.S[0]; const bf16_t* Vp = p.S[1]; const bf16_t* Kp = p.S[2];
    bf16_t* Ap = dir ? p.S[4] : p.S[3];
    const bf16_t* Lp = dir ? p.S[5] : p.Hd;
    auto tok_of = [&](int i) -> int {
      if (i < 256) return NL + b * 256 + (dir ? 255 - i : i);
      const int s = i - 256;
      return b * 4096 + (dir ? 4095 - s : s);
    };
    uint4 raw[5];
    float kkc[8], kac[8];
    float S[16];
#pragma unroll
    for (int i = 0; i < 16; ++i) S[i] = 0.f;
    if (loader) {
#pragma unroll
      for (int j = 0; j < 8; ++j) { kkc[j] = p.k_k[h * 64 + lch + j]; kac[j] = p.k_a[h * 64 + lch + j]; }
    }
    auto issue = [&](int c) {
      const int t = tok_of(c * 32 + ltk);
      const size_t off = (size_t)t * 1024 + h * 64 + lch;
      raw[0] = *(const uint4*)(Rp + off); raw[1] = *(const uint4*)(Vp + off); raw[2] = *(const uint4*)(Kp + off);
      raw[3] = *(const uint4*)(Ap + off); raw[4] = *(const uint4*)(Lp + off);
    };
    auto unpack8 = [&](const uint4& u, float (&o)[8]) {
      o[0] = bflo(u.x); o[1] = bfhi(u.x); o[2] = bflo(u.y); o[3] = bfhi(u.y); o[4] = bflo(u.z); o[5] = bfhi(u.z); o[6] = bflo(u.w); o[7] = bfhi(u.w);
    };
    auto process = [&](int stage) {
      float r8[8], v8[8], k8[8], a8[8], l8[8], kk8[8], kd8[8], b8[8], w8[8];
      unpack8(raw[0], r8); unpack8(raw[1], v8); unpack8(raw[2], k8); unpack8(raw[3], a8); unpack8(raw[4], l8);
      float ss = 0.f;
#pragma unroll
      for (int j = 0; j < 8; ++j) { kk8[j] = k8[j] * kkc[j]; ss += kk8[j] * kk8[j]; }
      ss += __shfl_xor(ss, 1); ss += __shfl_xor(ss, 2); ss += __shfl_xor(ss, 4);
      const float inv = rsqrtf(ss + 1e-12f);
#pragma unroll
      for (int j = 0; j < 8; ++j) {
        kk8[j] *= inv;
        kd8[j] = k8[j] * (1.f + (a8[j] - 1.f) * kac[j]);
        b8[j] = kk8[j] * a8[j];
        w8[j] = __expf(l8[j]);
      }
      float* dst = buf + stage * 12288 + ltk * 384 + lch;
      *(float4*)(dst + 0) = make_float4(r8[0], r8[1], r8[2], r8[3]);       *(float4*)(dst + 4) = make_float4(r8[4], r8[5], r8[6], r8[7]);
      *(float4*)(dst + 64) = make_float4(w8[0], w8[1], w8[2], w8[3]);      *(float4*)(dst + 68) = make_float4(w8[4], w8[5], w8[6], w8[7]);
      *(float4*)(dst + 128) = make_float4(kd8[0], kd8[1], kd8[2], kd8[3]); *(float4*)(dst + 132) = make_float4(kd8[4], kd8[5], kd8[6], kd8[7]);
      *(float4*)(dst + 192) = make_float4(kk8[0], kk8[1], kk8[2], kk8[3]); *(float4*)(dst + 196) = make_float4(kk8[4], kk8[5], kk8[6], kk8[7]);
      *(float4*)(dst + 256) = make_float4(b8[0], b8[1], b8[2], b8[3]);     *(float4*)(dst + 260) = make_float4(b8[4], b8[5], b8[6], b8[7]);
      *(float4*)(dst + 320) = make_float4(v8[0], v8[1], v8[2], v8[3]);     *(float4*)(dst + 324) = make_float4(v8[4], v8[5], v8[6], v8[7]);
    };
    auto yout = [&](int c) {
      const float* yb = ybuf + (c & 1) * 2048 + ltk * 64 + lch;
      const float4 y0 = *(const float4*)yb, y1 = *(const float4*)(yb + 4);
      const int t = tok_of(c * 32 + ltk);
      uint4 o;
      o.x = pack2(y0.x, y0.y); o.y = pack2(y0.z, y0.w); o.z = pack2(y1.x, y1.y); o.w = pack2(y1.z, y1.w);
      *(uint4*)((dupout ? p.S[0] : Ap) + (size_t)t * 1024 + h * 64 + lch) = o;
    };
    __syncthreads();
    if (loader) { issue(0); process(0); issue(1); }
    __syncthreads();
    for (int c = 0; c < NCH; ++c) {
      if (loader) {
        if (c >= 1) yout(c - 1);
        if (c + 1 < NCH) { process((c + 1) & 1); if (c + 2 < NCH) issue(c + 2); }
      } else {
        const float* bb = buf + (c & 1) * 12288 + q * 16;
        float* yb = ybuf + (c & 1) * 2048 + vrow;
#pragma unroll 2
        for (int j = 0; j < 32; ++j) {
          const float* base = bb + j * 384;
          float rr[16], ww[16], kv[16], kkv[16], bv[16];
#pragma unroll
          for (int i = 0; i < 4; ++i) {
            const float4 t0 = *(const float4*)(base + i * 4);       rr[4 * i] = t0.x; rr[4 * i + 1] = t0.y; rr[4 * i + 2] = t0.z; rr[4 * i + 3] = t0.w;
            const float4 t1 = *(const float4*)(base + 64 + i * 4);  ww[4 * i] = t1.x; ww[4 * i + 1] = t1.y; ww[4 * i + 2] = t1.z; ww[4 * i + 3] = t1.w;
            const float4 t2 = *(const float4*)(base + 128 + i * 4); kv[4 * i] = t2.x; kv[4 * i + 1] = t2.y; kv[4 * i + 2] = t2.z; kv[4 * i + 3] = t2.w;
            const float4 t3 = *(const float4*)(base + 192 + i * 4); kkv[4 * i] = t3.x; kkv[4 * i + 1] = t3.y; kkv[4 * i + 2] = t3.z; kkv[4 * i + 3] = t3.w;
            const float4 t4 = *(const float4*)(base + 256 + i * 4); bv[4 * i] = t4.x; bv[4 * i + 1] = t4.y; bv[4 * i + 2] = t4.z; bv[4 * i + 3] = t4.w;
          }
          const float vv = buf[(c & 1) * 12288 + j * 384 + 320 + vrow];
          float s0 = 0.f, s1 = 0.f, s2 = 0.f, s3 = 0.f;
#pragma unroll
          for (int i = 0; i < 4; ++i) { s0 += S[i] * kkv[i]; s1 += S[4 + i] * kkv[4 + i]; s2 += S[8 + i] * kkv[8 + i]; s3 += S[12 + i] * kkv[12 + i]; }
          const float sa = -quad_sum((s0 + s1) + (s2 + s3));
          float y0 = 0.f, y1 = 0.f, y2 = 0.f, y3 = 0.f;
#pragma unroll
          for (int i = 0; i < 16; ++i) S[i] = S[i] * ww[i] + (sa * bv[i] + vv * kv[i]);
#pragma unroll
          for (int i = 0; i < 4; ++i) { y0 += S[i] * rr[i]; y1 += S[4 + i] * rr[4 + i]; y2 += S[8 + i] * rr[8 + i]; y3 += S[12 + i] * rr[12 + i]; }
          const float y = quad_sum((y0 + y1) + (y2 + y3));
          if (q == 0) yb[j * 64] = y;
        }
      }
      __syncthreads();
    }
    if (loader) yout(NCH - 1);
    __syncthreads();
  }
}

__device__ void phase_readout(const Params& p, char* lds) {
  const int lane = threadIdx.x & 63, wave = threadIdx.x >> 6;
  const int wt = wave & 3, wf = wave >> 2, lr = lane & 15, lq = lane >> 4;
  const int total = (NT / 256) * 8;
  for (int u = blockIdx.x; u < total; u += gridDim.x) {
    const int mt = u >> 3, nt = u & 7;
    const int tok0 = mt * 256, f0 = nt * 128;
    f32x4 g[4][4];
    gemm_tile<false>(p.L1, 384, p.g2T, 128, 128, tok0, f0, lds, g, nullptr);
    const int head = nt * 2 + wf;
#pragma unroll
    for (int ti = 0; ti < 4; ++ti) {
      const int t = tok0 + wt * 64 + ti * 16 + lr;
      float y[4][4];
      float sum = 0.f;
#pragma unroll
      for (int fi = 0; fi < 4; ++fi) {
        const int f = f0 + wf * 64 + fi * 16 + lq * 4;
        float a0, a1, a2, a3, b0, b1, b2, b3;
        load_bf4(p.S[3] + (size_t)t * 1024 + f, a0, a1, a2, a3);
        load_bf4(p.S[4] + (size_t)t * 1024 + f, b0, b1, b2, b3);
        y[fi][0] = a0 + b0; y[fi][1] = a1 + b1; y[fi][2] = a2 + b2; y[fi][3] = a3 + b3;
        sum += (y[fi][0] + y[fi][1]) + (y[fi][2] + y[fi][3]);
      }
      sum += __shfl_xor(sum, 16); sum += __shfl_xor(sum, 32);
      const float mean = sum * (1.f / 64.f);
      float vs = 0.f;
#pragma unroll
      for (int fi = 0; fi < 4; ++fi)
#pragma unroll
        for (int j = 0; j < 4; ++j) { const float d = y[fi][j] - mean; vs += d * d; }
      vs += __shfl_xor(vs, 16); vs += __shfl_xor(vs, 32);
      const float rstd = rsqrtf(vs * (1.f / 64.f) + 64e-5f);
      const float bon = p.BON[(size_t)t * 16 + head];
#pragma unroll
      for (int fi = 0; fi < 4; ++fi) {
        const int f = f0 + wf * 64 + fi * 16 + lq * 4;
        const float4 lw = *(const float4*)(p.ln_w + f), lb = *(const float4*)(p.ln_b + f);
        float v0, v1, v2, v3;
        load_bf4(p.S[1] + (size_t)t * 1024 + f, v0, v1, v2, v3);
        const f32x4 gg = g[fi][ti];
        store_bf4(p.S[0] + (size_t)t * 1024 + f,
                  ((y[fi][0] - mean) * rstd * lw.x + lb.x + bon * v0) * gg[0], ((y[fi][1] - mean) * rstd * lw.y + lb.y + bon * v1) * gg[1],
                  ((y[fi][2] - mean) * rstd * lw.z + lb.z + bon * v2) * gg[2], ((y[fi][3] - mean) * rstd * lw.w + lb.w + bon * v3) * gg[3]);
      }
    }
  }
}

DI void phase_gemm_resid(const Params& p, char* lds, const bf16_t* A, const bf16_t* W, int K, int ntm,
                                 const float* xin_l, const float* xin_c, const float* gate) {
  const int lane = threadIdx.x & 63, wave = threadIdx.x >> 6;
  const int wr = wave >> 2, wc = wave & 3;
  const int total = ntm * 4;
  for (int u = blockIdx.x; u < total; u += gridDim.x) {
    const int mt = u >> 2, nt = u & 3;
    f32x4 acc[2][2][4][2];
    gemm256_tile(W, A, K, nt * 256, mt * 256, lds, acc);
    int lane_o = threadIdx.x & 63; asm volatile("" : "+v"(lane_o));
    const int fr = lane_o & 15, fq = lane_o >> 4;
#pragma unroll
    for (int bj = 0; bj < 2; ++bj)
#pragma unroll
      for (int n = 0; n < 2; ++n) {
        const int t = mt * 256 + bj * 128 + wc * 32 + n * 16 + fr;
        const int bp = t < NL ? (t >> 12) : 8;
        const float* xi = t < NL ? xin_l + (size_t)t * 1024 : xin_c + (size_t)(t - NL) * 1024;
        float* xo = t < NL ? p.out + (size_t)t * 1024 : p.XC + (size_t)(t - NL) * 1024;
#pragma unroll
        for (int ai = 0; ai < 2; ++ai)
#pragma unroll
          for (int m = 0; m < 4; ++m) {
            const int f = nt * 256 + ai * 128 + wr * 64 + m * 16 + fq * 4;
            const float4 g4 = *(const float4*)(gate + bp * 6144 + f);
            const float4 x4 = *(const float4*)(xi + f);
            const f32x4 a = acc[ai][bj][m][n];
            *(float4*)(xo + f) = make_float4(x4.x + g4.x * a[0], x4.y + g4.y * a[1], x4.z + g4.z * a[2], x4.w + g4.w * a[3]);
          }
      }
  }
}

DI void phase_up(const Params& p, char* lds, const bf16_t* H, const bf16_t* W, bf16_t* U, int ntm) {
  const int lane = threadIdx.x & 63, wave = threadIdx.x >> 6;
  const int wr = wave >> 2, wc = wave & 3;
  const int total = ntm * 16;
  for (int u = blockIdx.x; u < total; u += gridDim.x) {
    const int mt = u >> 4, nt = u & 15;
    f32x4 acc[2][2][4][2];
    gemm256_tile(W, H, 1024, nt * 256, mt * 256, lds, acc);
    int lane_o = threadIdx.x & 63; asm volatile("" : "+v"(lane_o));
    const int fr = lane_o & 15, fq = lane_o >> 4;
#pragma unroll
    for (int bj = 0; bj < 2; ++bj)
#pragma unroll
      for (int n = 0; n < 2; ++n) {
        const int t = mt * 256 + bj * 128 + wc * 32 + n * 16 + fr;
#pragma unroll
        for (int ai = 0; ai < 2; ++ai)
#pragma unroll
          for (int m = 0; m < 4; ++m) {
            const int f = nt * 256 + ai * 128 + wr * 64 + m * 16 + fq * 4;
            const f32x4 a = acc[ai][bj][m][n];
            const float r0 = fmaxf(a[0], 0.f), r1 = fmaxf(a[1], 0.f), r2 = fmaxf(a[2], 0.f), r3 = fmaxf(a[3], 0.f);
            store_bf4(U + (size_t)t * 4096 + f, r0 * r0, r1 * r1, r2 * r2, r3 * r3);
          }
      }
  }
}

__device__ void phase_qkv(const Params& p, char* lds) {
  const int lane = threadIdx.x & 63, wave = threadIdx.x >> 6;
  const int wr = wave >> 2, wc = wave & 3;
  const int total = (NT / 256) * 6;
  bf16_t* Q = p.S[0]; bf16_t* KA = p.S[1]; bf16_t* VT = p.S[2];
  for (int u = blockIdx.x; u < total; u += gridDim.x) {
    const int mt = u / 6, nt = u % 6;
    if (mt >= NL / 256 && nt < 4) continue;
    f32x4 acc[2][2][4][2];
    gemm256_tile(p.wqkvT, p.S[5], 1024, nt * 256, mt * 256, lds, acc);
    int lane_o = threadIdx.x & 63; asm volatile("" : "+v"(lane_o));
    const int fr = lane_o & 15, fq = lane_o >> 4;
#pragma unroll
    for (int bj = 0; bj < 2; ++bj)
#pragma unroll
      for (int n = 0; n < 2; ++n) {
        const int t = mt * 256 + bj * 128 + wc * 32 + n * 16 + fr;
        const bool lat = t < NL;
        const int b = lat ? (t >> 12) : ((t - NL) >> 8);
        const int key = lat ? (t & 4095) : 4096 + ((t - NL) & 255);
#pragma unroll
        for (int ai = 0; ai < 2; ++ai) {
          const int hh = ai * 2 + wr;
          asm volatile("" ::: "memory");
          if (nt < 5) {
            float ss = 0.f;
#pragma unroll
            for (int m = 0; m < 4; ++m)
#pragma unroll
              for (int j = 0; j < 4; ++j) ss += acc[ai][bj][m][n][j] * acc[ai][bj][m][n][j];
            ss += __shfl_xor(ss, 16); ss += __shfl_xor(ss, 32);
            const float rstd = rsqrtf(ss * (1.f / 64.f) + 1e-6f);
            const float* gn = nt < 4 ? p.q_norm : p.k_norm;
            float v[4][4];
#pragma unroll
            for (int m = 0; m < 4; ++m) {
              const float4 g4 = *(const float4*)(gn + m * 16 + fq * 4);
              v[m][0] = acc[ai][bj][m][n][0] * rstd * g4.x; v[m][1] = acc[ai][bj][m][n][1] * rstd * g4.y;
              v[m][2] = acc[ai][bj][m][n][2] * rstd * g4.z; v[m][3] = acc[ai][bj][m][n][3] * rstd * g4.w;
            }
            if (lat) {
              const int s = t & 4095, rowp = s >> 6, colp = s & 63;
#pragma unroll
              for (int j = 0; j < 4; ++j) {
                const float2 cs0 = *(const float2*)(p.TAB + (rowp * 16 + fq * 4 + j) * 2);
                const float2 cs1 = *(const float2*)(p.TAB + (colp * 16 + fq * 4 + j) * 2);
                const float x1 = v[0][j], x2 = v[1][j], z1 = v[2][j], z2 = v[3][j];
                v[0][j] = x1 * cs0.x - x2 * cs0.y; v[1][j] = x2 * cs0.x + x1 * cs0.y;
                v[2][j] = z1 * cs1.x - z2 * cs1.y; v[3][j] = z2 * cs1.x + z1 * cs1.y;
              }
            }
            if (nt < 4) {
              const float qs = 0.125f * 1.4426950408889634f;
              const int head = nt * 4 + hh;
#pragma unroll
              for (int m = 0; m < 4; ++m)
                store_bf4(Q + (size_t)t * 1024 + head * 64 + m * 16 + fq * 4, v[m][0] * qs, v[m][1] * qs, v[m][2] * qs, v[m][3] * qs);
            } else {
#pragma unroll
              for (int m = 0; m < 4; ++m)
                store_bf4(KA + ((size_t)(b * 4 + hh) * NKEY + key) * 64 + m * 16 + fq * 4, v[m][0], v[m][1], v[m][2], v[m][3]);
            }
          } else {
#pragma unroll
            for (int m = 0; m < 4; ++m)
#pragma unroll
              for (int j = 0; j < 4; ++j) {
                const int d = m * 16 + fq * 4 + j;
                const unsigned pk = pack2(acc[ai][bj][m][n][j], 0.f);
                VT[((size_t)(b * 4 + hh) * 64 + d) * NKEY + key] = (bf16_t)(pk & 0xffffu);
              }
          }
        }
      }
  }
}

__device__ void phase_attn(const Params& p, char* lds) {
  const int tid = threadIdx.x, lane = tid & 63, wave = tid >> 6;
  const int l31 = lane & 31, lh = lane >> 5;
  const int srow = tid >> 3, sch = tid & 7;
  const bf16_t* Q = p.S[0]; const bf16_t* KA = p.S[1]; const bf16_t* VT = p.S[2]; bf16_t* O = p.S[3];
  float gq = 0.f, gk = 0.f;
  for (int i = 0; i < 64; ++i) { gq = fmaxf(gq, fabsf(p.q_norm[i])); gk = fmaxf(gk, fabsf(p.k_norm[i])); }
  const float M2 = 8.f * gq * gk * 1.4426950408889634f;
  constexpr int NKT = NKEY / 64;
  constexpr int AST = 2 * 64 * ROWB;
  for (int u = blockIdx.x; u < 2048; u += gridDim.x) {
    const int qb = u & 15, head = (u >> 4) & 15, b = u >> 8, kvh = head >> 2;
    const bf16_t* Kg = KA + (size_t)(b * 4 + kvh) * NKEY * 64;
    const bf16_t* Vg = VT + (size_t)(b * 4 + kvh) * 64 * NKEY;
    const int tq = b * 4096 + qb * 256 + wave * 32 + l31;
    bf16x8 qf[4];
#pragma unroll
    for (int s = 0; s < 4; ++s) qf[s] = *(const bf16x8*)(Q + (size_t)tq * 1024 + head * 64 + s * 16 + lh * 8);
    f32x16 o0, o1;
#pragma unroll
    for (int i = 0; i < 16; ++i) { o0[i] = 0.f; o1[i] = 0.f; }
    float lsum = 0.f;
    uint4 kreg, vreg;
    auto gload = [&](int kt) {
      kreg = *(const uint4*)(Kg + (size_t)(kt * 64 + srow) * 64 + sch * 8);
      vreg = *(const uint4*)(Vg + (size_t)srow * NKEY + kt * 64 + sch * 8);
    };
    auto lwrite = [&](int st) {
      *(uint4*)(lds + st * AST + srow * ROWB + sch * 16) = kreg;
      *(uint4*)(lds + st * AST + 64 * ROWB + srow * ROWB + sch * 16) = vreg;
    };
    gload(0);
    __syncthreads();
    lwrite(0);
    __syncthreads();
    for (int kt = 0; kt < NKT; ++kt) {
      if (kt + 1 < NKT) gload(kt + 1);
      const char* ksm = lds + (kt & 1) * AST;
      const char* vsm = ksm + 64 * ROWB;
      f32x16 sT[2];
#pragma unroll
      for (int k2 = 0; k2 < 2; ++k2) {
#pragma unroll
        for (int i = 0; i < 16; ++i) sT[k2][i] = 0.f;
#pragma unroll
        for (int s = 0; s < 4; ++s) {
          const bf16x8 kf = *(const bf16x8*)(ksm + (k2 * 32 + l31) * ROWB + s * 32 + lh * 16);
          sT[k2] = MFMA32(kf, qf[s], sT[k2]);
        }
      }
#pragma unroll
      for (int k2 = 0; k2 < 2; ++k2)
#pragma unroll
        for (int i = 0; i < 16; ++i) { const float pv = __builtin_amdgcn_exp2f(sT[k2][i] - M2); lsum += pv; sT[k2][i] = pv; }
#pragma unroll
      for (int k2 = 0; k2 < 2; ++k2)
#pragma unroll
        for (int s2 = 0; s2 < 2; ++s2) {
          uint4 pk;
          pk.x = pack2(sT[k2][8 * s2 + 0], sT[k2][8 * s2 + 1]); pk.y = pack2(sT[k2][8 * s2 + 2], sT[k2][8 * s2 + 3]);
          pk.z = pack2(sT[k2][8 * s2 + 4], sT[k2][8 * s2 + 5]); pk.w = pack2(sT[k2][8 * s2 + 6], sT[k2][8 * s2 + 7]);
          const bf16x8 pf = __builtin_bit_cast(bf16x8, pk);
          const int koff = (k2 * 32 + 16 * s2 + 4 * lh) * 2;
          {
            const uint2 lo = *(const uint2*)(vsm + l31 * ROWB + koff), hi = *(const uint2*)(vsm + l31 * ROWB + koff + 16);
            const uint4 vv = make_uint4(lo.x, lo.y, hi.x, hi.y);
            o0 = MFMA32(__builtin_bit_cast(bf16x8, vv), pf, o0);
          }
          {
            const uint2 lo = *(const uint2*)(vsm + (32 + l31) * ROWB + koff), hi = *(const uint2*)(vsm + (32 + l31) * ROWB + koff + 16);
            const uint4 vv = make_uint4(lo.x, lo.y, hi.x, hi.y);
            o1 = MFMA32(__builtin_bit_cast(bf16x8, vv), pf, o1);
          }
        }
      if (kt + 1 < NKT) lwrite((kt + 1) & 1);
      __syncthreads();
    }
    lsum += __shfl_xor(lsum, 32);
    const float inv = 1.f / lsum;
#pragma unroll
    for (int g = 0; g < 4; ++g) {
      const int d0 = 8 * g + 4 * lh;
      store_bf4(O + (size_t)tq * 1024 + head * 64 + d0, o0[4 * g] * inv, o0[4 * g + 1] * inv, o0[4 * g + 2] * inv, o0[4 * g + 3] * inv);
      store_bf4(O + (size_t)tq * 1024 + head * 64 + 32 + d0, o1[4 * g] * inv, o1[4 * g + 1] * inv, o1[4 * g + 2] * inv, o1[4 * g + 3] * inv);
    }
  }
}

DI void run_phase(const Params& p, int ph, char* lds) {
  const float* mod0 = p.MOD;
  const float* mod1 = p.MOD + 9 * 6144;
  switch (ph) {
    case 0: phase0(p, lds); break;
    case 1: norm_mod_phase(p.x, p.ctx, p.norm_mix, mod0, 0, 1, p.Hd, NT); break;
    case 2: phase_proj(p, lds); break;
    case 3: phase_prep(p, lds); break;
    case 4: phase_scan(p, lds); break;
    case 5: phase_readout(p, lds); break;
    case 6: phase_gemm_resid(p, lds, p.S[0], p.woT, 1024, NT / 256, p.x, p.ctx, mod0 + 2 * 1024); break;
    case 7: norm_mod_phase(p.out, p.XC, p.norm_mlp, mod0, 3, 4, p.S[5], NT); break;
    case 8: phase_up(p, lds, p.S[5], p.w1T[0], p.S[0], NT / 256); break;
    case 9: phase_gemm_resid(p, lds, p.S[0], p.w2T[0], 4096, NT / 256, p.out, p.XC, mod0 + 5 * 1024); break;
    case 10: norm_mod_phase(p.out, p.XC, p.norm_mix + 1024, mod1, 0, 1, p.S[5], NT); break;
    case 11: phase_qkv(p, lds); break;
    case 12: phase_attn(p, lds); break;
    case 13: phase_gemm_resid(p, lds, p.S[3], p.awoT, 1024, NL / 256, p.out, p.XC, mod1 + 2 * 1024); break;
    case 14: norm_mod_phase(p.out, p.XC, p.norm_mlp + 1024, mod1, 3, 4, p.S[5], NL); break;
    case 15: phase_up(p, lds, p.S[5], p.w1T[1], p.S[0], NL / 256); break;
    case 16: phase_gemm_resid(p, lds, p.S[0], p.w2T[1], 4096, NL / 256, p.out, p.XC, mod1 + 5 * 1024); break;
    case 17: final_norm_phase(p); break;
  }
}
constexpr int NPHASE = 18;

__global__ void __launch_bounds__(NTHREADS) phase_kernel(Params p, int ph) {
  extern __shared__ __attribute__((aligned(16))) char lds[];
  run_phase(p, ph, lds);
}

__global__ void __launch_bounds__(NTHREADS) mega_kernel(Params p) {
  extern __shared__ __attribute__((aligned(16))) char lds[];
  cg::grid_group grid = cg::this_grid();
#ifndef DUP
#define DUP -1
#endif
#define PH(n) run_phase(p, n, lds); grid.sync(); if (DUP == n) { if (n == 4) phase_scan(p, lds, true); else run_phase(p, n, lds); grid.sync(); }
  PH(0) PH(1) PH(2) PH(3) PH(4) PH(5) PH(6) PH(7) PH(8) PH(9) PH(10) PH(11) PH(12) PH(13) PH(14) PH(15) PH(16)
  run_phase(p, 17, lds);
}

extern "C" void kernel_launch(void* const* d_in, const int* in_sizes, int n_in, void* d_out, int out_size, void* d_ws, size_t ws_size, hipStream_t stream) {
  Params p;
  memset(&p, 0, sizeof(p));
  const float* const* in = (const float* const*)d_in;
  p.x = in[0]; p.c = in[1]; p.ctx = in[2]; p.c_ctx = in[3]; p.w_mod = in[4]; p.b_mod = in[5]; p.norm_mix = in[6]; p.norm_mlp = in[7];
  p.mlp_w1 = in[8]; p.mlp_w2 = in[9]; p.mu = in[10]; p.wr = in[11]; p.wk = in[12]; p.wv = in[13]; p.wo = in[14]; p.w0 = in[15]; p.w1 = in[16];
  p.w2 = in[17]; p.a0 = in[18]; p.a1 = in[19]; p.a2 = in[20]; p.g1 = in[21]; p.g2 = in[22]; p.k_k = in[23]; p.k_a = in[24]; p.r_k = in[25];
  p.ln_w = in[26]; p.ln_b = in[27]; p.wqkv = in[28]; p.q_norm = in[29]; p.k_norm = in[30]; p.awo = in[31]; p.final_norm = in[32];
  p.out = (float*)d_out;
  char* ws = (char*)d_ws;
  size_t off = 0;
  auto take = [&](size_t bytes) -> char* { char* r = ws + off; off += (bytes + 255) & ~(size_t)255; return r; };
  p.Wcat = (bf16_t*)take((size_t)3456 * 1024 * 2);
  p.L2w = (bf16_t*)take((size_t)4 * 65536 * 2);
  p.g2T = (bf16_t*)take((size_t)1024 * 128 * 2);
  p.woT = (bf16_t*)take((size_t)1024 * 1024 * 2);
  p.w1T[0] = (bf16_t*)take((size_t)4096 * 1024 * 2);
  p.w1T[1] = (bf16_t*)take((size_t)4096 * 1024 * 2);
  p.w2T[0] = (bf16_t*)take((size_t)4096 * 1024 * 2);
  p.w2T[1] = (bf16_t*)take((size_t)4096 * 1024 * 2);
  p.wqkvT = (bf16_t*)take((size_t)1536 * 1024 * 2);
  p.awoT = (bf16_t*)take((size_t)1024 * 1024 * 2);
  p.MOD = (float*)take((size_t)2 * 9 * 6144 * 4);
  p.TAB = (float*)take((size_t)1024 * 2 * 4);
  p.XC = (float*)take((size_t)NC * 1024 * 4);
  for (int i = 0; i < 6; ++i) p.S[i] = (bf16_t*)take((size_t)NT * 1024 * 2);
  if (off > ws_size) { fprintf(stderr, "kernel_launch: workspace too small (%zu needed, %zu given)\n", off, ws_size); return; }
  char* ob = (char*)d_out;
  p.Hd = (bf16_t*)ob;
  p.L1 = (bf16_t*)(ob + (size_t)NT * 1024 * 2);
  p.BON = (float*)(ob + (size_t)NT * 1024 * 2 + (size_t)NT * 384 * 2);
  int nj = 0, tiles = 0;
  auto job = [&](const float* src, bf16_t* dst, int K, int N) {
    p.jobs[nj].src = src; p.jobs[nj].dst = dst; p.jobs[nj].K = K; p.jobs[nj].N = N; p.jobs[nj].tstart = tiles; p.jobs[nj].tiles_n = N / 64;
    tiles += (K / 64) * (N / 64); ++nj;
  };
  job(p.wr, p.Wcat, 1024, 1024);
  job(p.wk, p.Wcat + (size_t)1024 * 1024, 1024, 1024);
  job(p.wv, p.Wcat + (size_t)2048 * 1024, 1024, 1024);
  job(p.g1, p.Wcat + (size_t)3072 * 1024, 1024, 128);
  job(p.w1, p.Wcat + (size_t)3200 * 1024, 1024, 64);
  job(p.w1 + 65536, p.Wcat + (size_t)3264 * 1024, 1024, 64);
  job(p.a1, p.Wcat + (size_t)3328 * 1024, 1024, 64);
  job(p.a1 + 65536, p.Wcat + (size_t)3392 * 1024, 1024, 64);
  job(p.a2, p.L2w, 64, 1024);
  job(p.a2 + 65536, p.L2w + 65536, 64, 1024);
  job(p.w2, p.L2w + 2 * 65536, 64, 1024);
  job(p.w2 + 65536, p.L2w + 3 * 65536, 64, 1024);
  job(p.g2, p.g2T, 128, 1024);
  job(p.wo, p.woT, 1024, 1024);
  job(p.mlp_w1, p.w1T[0], 1024, 4096);
  job(p.mlp_w1 + (size_t)4096 * 1024, p.w1T[1], 1024, 4096);
  job(p.mlp_w2, p.w2T[0], 4096, 1024);
  job(p.mlp_w2 + (size_t)4096 * 1024, p.w2T[1], 4096, 1024);
  job(p.wqkv, p.wqkvT, 1024, 1536);
  job(p.awo, p.awoT, 1024, 1024);
  p.njobs = nj; p.total_tiles = tiles;

  static int grid_blocks = 0;
  if (!grid_blocks) {
    (void)hipFuncSetAttribute((const void*)mega_kernel, hipFuncAttributeMaxDynamicSharedMemorySize, LDS_BYTES);
    (void)hipFuncSetAttribute((const void*)phase_kernel, hipFuncAttributeMaxDynamicSharedMemorySize, LDS_BYTES);
    int dev = 0, cus = 0, per_cu = 0;
    (void)hipGetDevice(&dev);
    (void)hipDeviceGetAttribute(&cus, hipDeviceAttributeMultiprocessorCount, dev);
    if (hipOccupancyMaxActiveBlocksPerMultiprocessor(&per_cu, (const void*)mega_kernel, NTHREADS, LDS_BYTES) != hipSuccess || per_cu < 1) per_cu = 1;
    if (cus <= 0) cus = 256;
    grid_blocks = cus * per_cu;
    (void)hipGetLastError();
  }
#if SINGLE_LAUNCH
  void* args[] = {&p};
  hipError_t e = hipLaunchCooperativeKernel((const void*)mega_kernel, dim3(grid_blocks), dim3(NTHREADS), args, LDS_BYTES, stream);
  if (e != hipSuccess) fprintf(stderr, "cooperative launch failed: %s (grid %d)\n", hipGetErrorString(e), grid_blocks);
#else
  for (int ph = 0; ph < NPHASE; ++ph) hipLaunchKernelGGL(phase_kernel, dim3(grid_blocks), dim3(NTHREADS), LDS_BYTES, stream, p, ph);
#endif
}
```

```cpp
#include <hip/hip_runtime.h>
#include <hip/hip_cooperative_groups.h>
#include <cstdint>
#include <cstring>
#include <cstdio>
namespace cg = cooperative_groups;

#ifndef SINGLE_LAUNCH
#define SINGLE_LAUNCH 1
#endif

typedef unsigned short bf16_t;
typedef short bf16x8 __attribute__((ext_vector_type(8)));
typedef float f32x2 __attribute__((ext_vector_type(2)));
typedef float f32x4 __attribute__((ext_vector_type(4)));
typedef float f32x16 __attribute__((ext_vector_type(16)));
typedef __bf16 bf16x2_t __attribute__((ext_vector_type(2)));
#define DI __device__ __forceinline__

constexpr int D = 1024, NB = 8, SEQ = 4096, CTXL = 256;
constexpr int NL = NB * SEQ, NC = NB * CTXL, NT = NL + NC, DFF = 4096;
constexpr int NKEY = SEQ + CTXL;
constexpr int NTHREADS = 512;
constexpr int ROWB = 144;
constexpr int GEMM_STAGE = (256 + 128) * ROWB;
constexpr int LDS_BYTES = 131072 + 16;

struct TJob { const float* src; bf16_t* dst; int K, N, tstart, tiles_n; };

struct Params {
  const float *x, *c, *ctx, *c_ctx, *w_mod, *b_mod, *norm_mix, *norm_mlp, *mlp_w1, *mlp_w2;
  const float *mu, *wr, *wk, *wv, *wo, *w0, *w1, *w2, *a0, *a1, *a2, *g1, *g2, *k_k, *k_a, *r_k, *ln_w, *ln_b;
  const float *wqkv, *q_norm, *k_norm, *awo, *final_norm;
  float* out;
  bf16_t *Wcat, *L2w, *g2T, *woT, *w1T[2], *w2T[2], *wqkvT, *awoT;
  float *MOD, *TAB, *XC;
  bf16_t* S[6];
  bf16_t *Hd, *L1;
  float* BON;
  unsigned* BAR;
  TJob jobs[20];
  int njobs, total_tiles;
};

DI unsigned pack2(float lo, float hi) {
  f32x2 v = {lo, hi};
  bf16x2_t b = __builtin_convertvector(v, bf16x2_t);
  return __builtin_bit_cast(unsigned, b);
}
DI float bflo(unsigned u) { return __uint_as_float(u << 16); }
DI float bfhi(unsigned u) { return __uint_as_float(u & 0xffff0000u); }
DI void store_bf4(bf16_t* p, float a, float b, float c, float d) { *(uint2*)p = make_uint2(pack2(a, b), pack2(c, d)); }
DI void load_bf4(const bf16_t* p, float& a, float& b, float& c, float& d) { uint2 u = *(const uint2*)p; a = bflo(u.x); b = bfhi(u.x); c = bflo(u.y); d = bfhi(u.y); }
DI void store_bf8(bf16_t* p, const f32x4& a, const f32x4& b) {
  uint4 o; o.x = pack2(a[0], a[1]); o.y = pack2(a[2], a[3]); o.z = pack2(b[0], b[1]); o.w = pack2(b[2], b[3]);
  *(uint4*)p = o;
}
DI void unpack_bf8(const uint4& u, float (&o)[8]) {
  o[0] = bflo(u.x); o[1] = bfhi(u.x); o[2] = bflo(u.y); o[3] = bfhi(u.y); o[4] = bflo(u.z); o[5] = bfhi(u.z); o[6] = bflo(u.w); o[7] = bfhi(u.w);
}
DI int perm32(int rho) { return 8 * ((rho & 15) >> 2) + 4 * (rho >> 4) + (rho & 3); }
DI float sigmoidf_(float x) { return 1.f / (1.f + __expf(-x)); }
DI float tanhf_(float x) { return 1.f - 2.f / (1.f + __expf(2.f * x)); }
DI float quad_sum(float x) {
  x += __builtin_bit_cast(float, __builtin_amdgcn_mov_dpp(__builtin_bit_cast(int, x), 0xB1, 0xF, 0xF, true));
  x += __builtin_bit_cast(float, __builtin_amdgcn_mov_dpp(__builtin_bit_cast(int, x), 0x4E, 0xF, 0xF, true));
  return x;
}
DI float oct_sum(float x) {
  x = quad_sum(x);
  x += __builtin_bit_cast(float, __builtin_amdgcn_mov_dpp(__builtin_bit_cast(int, x), 0x141, 0xF, 0xF, true));
  return x;
}
struct StepV { f32x2 r[4], w[4], k[4], kk[4], b[4]; f32x2 v; };
DI void scan_load(StepV& s, const float* base, const float* vp) {
#pragma unroll
  for (int i = 0; i < 2; ++i) {
    const float4 t0 = *(const float4*)(base + i * 4);       s.r[2 * i] = f32x2{t0.x, t0.y};  s.r[2 * i + 1] = f32x2{t0.z, t0.w};
    const float4 t1 = *(const float4*)(base + 64 + i * 4);  s.w[2 * i] = f32x2{t1.x, t1.y};  s.w[2 * i + 1] = f32x2{t1.z, t1.w};
    const float4 t2 = *(const float4*)(base + 128 + i * 4); s.k[2 * i] = f32x2{t2.x, t2.y};  s.k[2 * i + 1] = f32x2{t2.z, t2.w};
    const float4 t3 = *(const float4*)(base + 192 + i * 4); s.kk[2 * i] = f32x2{t3.x, t3.y}; s.kk[2 * i + 1] = f32x2{t3.z, t3.w};
    const float4 t4 = *(const float4*)(base + 256 + i * 4); s.b[2 * i] = f32x2{t4.x, t4.y};  s.b[2 * i + 1] = f32x2{t4.z, t4.w};
  }
  const float2 vv = *(const float2*)vp;
  s.v = f32x2{vv.x, vv.y};
}
DI void scan_step(const StepV& s, f32x2 (&S0)[4], f32x2 (&S1)[4], float* yp, bool writer) {
  f32x2 d0 = S0[0] * s.kk[0], d1 = S1[0] * s.kk[0];
#pragma unroll
  for (int i = 1; i < 4; ++i) { d0 += S0[i] * s.kk[i]; d1 += S1[i] * s.kk[i]; }
  const float sa0 = -oct_sum(d0.x + d0.y), sa1 = -oct_sum(d1.x + d1.y);
  const f32x2 sa0v = {sa0, sa0}, sa1v = {sa1, sa1}, v0 = {s.v.x, s.v.x}, v1 = {s.v.y, s.v.y};
#pragma unroll
  for (int i = 0; i < 4; ++i) {
    S0[i] = S0[i] * s.w[i] + (sa0v * s.b[i] + v0 * s.k[i]);
    S1[i] = S1[i] * s.w[i] + (sa1v * s.b[i] + v1 * s.k[i]);
  }
  f32x2 y0 = S0[0] * s.r[0], y1 = S1[0] * s.r[0];
#pragma unroll
  for (int i = 1; i < 4; ++i) { y0 += S0[i] * s.r[i]; y1 += S1[i] * s.r[i]; }
  const float ya = oct_sum(y0.x + y0.y), yb = oct_sum(y1.x + y1.y);
  if (writer) *(float2*)yp = make_float2(ya, yb);
}
DI float wave_sum(float x) {
#pragma unroll
  for (int m = 1; m < 64; m <<= 1) x += __shfl_xor(x, m);
  return x;
}
#define MFMA16(a, b, c) __builtin_amdgcn_mfma_f32_16x16x32_bf16((a), (b), (c), 0, 0, 0)
#define MFMA32(a, b, c) __builtin_amdgcn_mfma_f32_32x32x16_bf16((a), (b), (c), 0, 0, 0)

DI unsigned lerp2(unsigned a, unsigned n, float ma, float mb) {
  const float h0 = bflo(a), h1 = bfhi(a), s0 = bflo(n), s1 = bfhi(n);
  return pack2(h0 + (s0 - h0) * ma, h1 + (s1 - h1) * mb);
}
template <bool LERP>
DI void gemm_tile(const bf16_t* __restrict__ X, int ldx, const bf16_t* __restrict__ W, int ldw, int K, int tok0, int f0,
                  char* lds, f32x4 (&acc)[4][4], const float* __restrict__ mu) {
  const int tid = threadIdx.x, lane = tid & 63, wave = tid >> 6;
  const int wt = wave & 3, wf = wave >> 2, lr = lane & 15, lq = lane >> 4;
  const int lrow = tid >> 3, kc = tid & 7;
#pragma unroll
  for (int i = 0; i < 4; ++i)
#pragma unroll
    for (int j = 0; j < 4; ++j) acc[i][j] = f32x4{0.f, 0.f, 0.f, 0.f};
  uint4 xr[4], wr[2], xn[4];
  float4 m0 = make_float4(0, 0, 0, 0), m1 = m0;
  const int nk = K >> 6;
  __syncthreads();
  for (int kt = -1; kt < nk; ++kt) {
    const bool more = kt + 1 < nk;
    if (more) {
      const int k0 = (kt + 1) << 6;
#pragma unroll
      for (int i = 0; i < 4; ++i) {
        const int tg = tok0 + lrow + 64 * i;
        xr[i] = *(const uint4*)(X + (size_t)tg * ldx + k0 + kc * 8);
        if (LERP) {
          int nb; bool valid;
          if (tok0 < NL) {
            const int s = tg & 4095, col = s & 63, rw = s >> 6, qd = k0 >> 8;
            if (qd == 0) { valid = col > 0; nb = tg - 1; }
            else if (qd == 1) { valid = col < 63; nb = tg + 1; }
            else if (qd == 2) { valid = rw > 0; nb = tg - 64; }
            else { valid = rw < 63; nb = tg + 64; }
          } else {
            const int s = (tg - NL) & 255;
            if (k0 < 512) { valid = s > 0; nb = tg - 1; }
            else { valid = s < 255; nb = tg + 1; }
          }
          if (valid) xn[i] = *(const uint4*)(X + (size_t)nb * ldx + k0 + kc * 8);
          else xn[i] = make_uint4(0, 0, 0, 0);
        }
      }
#pragma unroll
      for (int i = 0; i < 2; ++i) wr[i] = *(const uint4*)(W + (size_t)(f0 + 64 * i + (lrow & 32) + perm32(lrow & 31)) * ldw + k0 + kc * 8);
      if (LERP) { m0 = *(const float4*)(mu + k0 + kc * 8); m1 = *(const float4*)(mu + k0 + kc * 8 + 4); }
    }
    if (kt >= 0) {
      const char* xs = lds + (kt & 1) * GEMM_STAGE;
      const char* wsm = xs + 256 * ROWB;
#pragma unroll
      for (int ks = 0; ks < 2; ++ks) {
        bf16x8 wfr[4], xfr[4];
#pragma unroll
        for (int i = 0; i < 4; ++i) wfr[i] = *(const bf16x8*)(wsm + (wf * 64 + i * 16 + lr) * ROWB + ks * 64 + lq * 16);
#pragma unroll
        for (int i = 0; i < 4; ++i) xfr[i] = *(const bf16x8*)(xs + (wt * 64 + i * 16 + lr) * ROWB + ks * 64 + lq * 16);
#pragma unroll
        for (int fi = 0; fi < 4; ++fi)
#pragma unroll
          for (int ti = 0; ti < 4; ++ti) acc[fi][ti] = MFMA16(wfr[fi], xfr[ti], acc[fi][ti]);
      }
    }
    if (more) {
      char* xs = lds + ((kt + 1) & 1) * GEMM_STAGE;
      char* wsm = xs + 256 * ROWB;
#pragma unroll
      for (int i = 0; i < 4; ++i) {
        uint4 v = xr[i];
        if (LERP) {
          v.x = lerp2(xr[i].x, xn[i].x, m0.x, m0.y);
          v.y = lerp2(xr[i].y, xn[i].y, m0.z, m0.w);
          v.z = lerp2(xr[i].z, xn[i].z, m1.x, m1.y);
          v.w = lerp2(xr[i].w, xn[i].w, m1.z, m1.w);
        }
        *(uint4*)(xs + (lrow + 64 * i) * ROWB + kc * 16) = v;
      }
#pragma unroll
      for (int i = 0; i < 2; ++i) *(uint4*)(wsm + (lrow + 64 * i) * ROWB + kc * 16) = wr[i];
    }
    __syncthreads();
  }
}


namespace g256 {
constexpr int BK = 64, HALF = 128, HT = HALF * BK;
DI int lds_byte(int r, int c) { const int st = (r >> 4) * 2 + (c >> 5), rr = r & 15, cc = c & 31, ob = rr * 64 + cc * 2; return st * 1024 + (ob ^ (((ob >> 9) & 1) << 5)); }
DI void stage_rc(int b, int& R, int& C) { const int st = b / 1024, sb = b % 1024, swz = sb ^ (((sb >> 9) & 1) << 5); R = (st >> 1) * 16 + swz / 64; C = (st & 1) * 32 + (swz % 64) / 2; }
}
#define G_SA(b, h) (((b) * 2 + (h)) * 16384)
#define G_SB(b, h) ((4 + (b) * 2 + (h)) * 16384)
#define G_STAGEV(bufoff, gbase, vo) do { _Pragma("unroll") for (int _i = 0; _i < 2; ++_i) \
    __builtin_amdgcn_global_load_lds((const unsigned*)((const char*)(gbase) + (vo)[_i]), (__attribute__((address_space(3))) unsigned*)(lds + (bufoff) + ldsw + _i * 8192), 16, 0, 0); } while (0)
#define G_LDA(dst, b, h) do { _Pragma("unroll") for (int m = 0; m < 4; ++m) _Pragma("unroll") for (int k = 0; k < 2; ++k) \
    dst[m][k] = *(const __attribute__((address_space(3))) bf16x8*)(lds + G_SA(b, h) + aoff + m * 2048 + k * 1024); } while (0)
#define G_LDB(dst, b, h) do { _Pragma("unroll") for (int n = 0; n < 2; ++n) _Pragma("unroll") for (int k = 0; k < 2; ++k) \
    dst[n][k] = *(const __attribute__((address_space(3))) bf16x8*)(lds + G_SB(b, h) + boff + n * 2048 + k * 1024); } while (0)
#define G_MMA(ai, bj, At, Bt) do { __builtin_amdgcn_s_setprio(1); \
    _Pragma("unroll") for (int m = 0; m < 4; ++m) _Pragma("unroll") for (int n = 0; n < 2; ++n) _Pragma("unroll") for (int k = 0; k < 2; ++k) \
      acc[ai][bj][m][n] = __builtin_amdgcn_mfma_f32_16x16x32_bf16(At[m][k], Bt[n][k], acc[ai][bj][m][n], 0, 0, 0); \
    __builtin_amdgcn_s_setprio(0); } while (0)
#define G_WAIT_V(n) asm volatile("s_waitcnt vmcnt(" #n ")" ::: "memory")
#define G_WAIT_L(n) asm volatile("s_waitcnt lgkmcnt(" #n ")" ::: "memory")
#define G_BAR __builtin_amdgcn_s_barrier()
#define G_SCHED __builtin_amdgcn_sched_barrier(0)

template <bool PERM>
DI void gemm256_tile(const bf16_t* __restrict__ A, const bf16_t* __restrict__ Bt, int K, int brow, int bcol, char* lds_, f32x4 (&acc)[2][2][4][2]) {
  __attribute__((address_space(3))) unsigned char* lds = (__attribute__((address_space(3))) unsigned char*)lds_;
  int tid = threadIdx.x; asm volatile("" : "+v"(tid));
  const int wid = __builtin_amdgcn_readfirstlane(tid >> 6), lane = tid & 63, wr = wid >> 2, wc = wid & 3, fr = lane & 15, fq = lane >> 4;
#pragma unroll
  for (int a = 0; a < 2; ++a)
#pragma unroll
    for (int b = 0; b < 2; ++b)
#pragma unroll
      for (int m = 0; m < 4; ++m)
#pragma unroll
        for (int n = 0; n < 2; ++n) acc[a][b][m][n] = f32x4{0.f, 0.f, 0.f, 0.f};
  unsigned voff[2], voffA[2];
#pragma unroll
  for (int i = 0; i < 2; ++i) { int R, C; g256::stage_rc(tid * 16 + i * 8192, R, C); voff[i] = (unsigned)(R * K + C) * 2u;
    const int Ra = PERM ? ((R & ~31) + perm32(R & 31)) : R; voffA[i] = (unsigned)(Ra * K + C) * 2u; }
  const size_t kstep = 128, hstep = (size_t)128 * K * 2;
  const unsigned ldsw = (unsigned)wid * 1024u;
  const int aoff = g256::lds_byte(wr * 64 + fr, fq * 8), boff = g256::lds_byte(wc * 32 + fr, fq * 8);
  const char* cA = (const char*)A + (size_t)brow * K * 2;
  const char* cB = (const char*)Bt + (size_t)bcol * K * 2;
  bf16x8 At[4][2], B0[2][2], B1[2][2];
  const int nt = K / g256::BK;
  __syncthreads();
  G_STAGEV(G_SB(0, 0), cB, voff); G_STAGEV(G_SA(0, 0), cA, voffA); G_STAGEV(G_SB(0, 1), cB + hstep, voff); G_STAGEV(G_SA(0, 1), cA + hstep, voffA);
  if (wr == 1) G_BAR;
  G_WAIT_V(4); G_BAR;
  G_STAGEV(G_SB(1, 0), cB + kstep, voff); G_STAGEV(G_SA(1, 0), cA + kstep, voffA); G_STAGEV(G_SB(1, 1), cB + hstep + kstep, voff);
  G_WAIT_V(6); G_BAR;
  for (int t = 0; t < nt - 2; t += 2) {
    const char* a1 = cA + (size_t)(t + 1) * kstep;
    const char* a2 = cA + (size_t)(t + 2) * kstep; const char* b2 = cB + (size_t)(t + 2) * kstep;
    const char* a3 = a2 + kstep; const char* b3 = b2 + kstep;
    G_LDB(B0, 0, 0); G_SCHED; G_LDA(At, 0, 0); G_STAGEV(G_SA(1, 1), a1 + hstep, voffA);
    G_WAIT_L(8); G_BAR; G_WAIT_L(0); G_MMA(0, 0, At, B0); G_BAR; G_SCHED;
    G_LDB(B1, 0, 1); G_STAGEV(G_SB(0, 0), b2, voff);
    G_BAR; G_WAIT_L(0); G_MMA(0, 1, At, B1); G_BAR;
    G_LDA(At, 0, 1); G_STAGEV(G_SA(0, 0), a2, voffA);
    G_BAR; G_WAIT_L(0); G_MMA(1, 0, At, B0); G_BAR; G_SCHED;
    G_STAGEV(G_SB(0, 1), b2 + hstep, voff);
    G_WAIT_V(6); G_BAR; G_MMA(1, 1, At, B1); G_BAR;
    G_LDB(B0, 1, 0); G_SCHED; G_LDA(At, 1, 0); G_STAGEV(G_SA(0, 1), a2 + hstep, voffA);
    G_WAIT_L(8); G_BAR; G_WAIT_L(0); G_MMA(0, 0, At, B0); G_BAR; G_SCHED;
    G_LDB(B1, 1, 1); G_STAGEV(G_SB(1, 0), b3, voff);
    G_BAR; G_WAIT_L(0); G_MMA(0, 1, At, B1); G_BAR;
    G_LDA(At, 1, 1); G_STAGEV(G_SA(1, 0), a3, voffA);
    G_BAR; G_WAIT_L(0); G_MMA(1, 0, At, B0); G_BAR; G_SCHED;
    G_STAGEV(G_SB(1, 1), b3 + hstep, voff);
    G_WAIT_V(6); G_BAR; G_MMA(1, 1, At, B1); G_BAR;
  }
  { G_LDB(B0, 0, 0); G_LDA(At, 0, 0); G_STAGEV(G_SA(1, 1), cA + (size_t)(nt - 1) * kstep + hstep, voffA);
    G_BAR; G_WAIT_L(0); G_MMA(0, 0, At, B0); G_BAR;
    G_LDB(B1, 0, 1); G_BAR; G_WAIT_L(0); G_MMA(0, 1, At, B1); G_BAR;
    G_LDA(At, 0, 1); G_WAIT_V(4); G_BAR; G_WAIT_L(0); G_MMA(1, 0, At, B0); G_MMA(1, 1, At, B1); G_BAR; }
  { G_LDB(B0, 1, 0); G_LDA(At, 1, 0); G_WAIT_V(2); G_BAR; G_WAIT_L(0); G_MMA(0, 0, At, B0); G_BAR;
    G_LDB(B1, 1, 1); G_WAIT_V(0); G_BAR; G_WAIT_L(0); G_MMA(0, 1, At, B1); G_BAR;
    G_LDA(At, 1, 1); G_BAR; G_WAIT_L(0); G_MMA(1, 0, At, B0); G_MMA(1, 1, At, B1); G_BAR; }
  if (wr == 0) G_BAR;
}

DI void convert_tile(const TJob& jb, int t, char* lds) {
  float* tile = (float*)lds;
  const int tid = threadIdx.x;
  const int tk = t / jb.tiles_n, tn = t % jb.tiles_n;
  const int k0 = tk * 64, n0 = tn * 64;
  __syncthreads();
#pragma unroll
  for (int i = 0; i < 2; ++i) {
    const int idx = tid + 512 * i, row = idx >> 4, c4 = idx & 15;
    const float4 v = *(const float4*)(jb.src + (size_t)(k0 + row) * jb.N + n0 + c4 * 4);
    tile[row * 65 + c4 * 4 + 0] = v.x; tile[row * 65 + c4 * 4 + 1] = v.y; tile[row * 65 + c4 * 4 + 2] = v.z; tile[row * 65 + c4 * 4 + 3] = v.w;
  }
  __syncthreads();
  const int n = tid >> 3, kc = tid & 7;
  float v[8];
#pragma unroll
  for (int j = 0; j < 8; ++j) v[j] = tile[(kc * 8 + j) * 65 + n];
  uint4 o;
  o.x = pack2(v[0], v[1]); o.y = pack2(v[2], v[3]); o.z = pack2(v[4], v[5]); o.w = pack2(v[6], v[7]);
  *(uint4*)(jb.dst + (size_t)(n0 + n) * jb.K + k0 + kc * 8) = o;
}

DI void mod_unit(const Params& p, int mu_, char* lds) {
  const int tid = threadIdx.x;
  const int layer = mu_ / 96, cc = mu_ % 96;
  float* sc = (float*)lds;
  float* red = sc + 9 * 1024;
  __syncthreads();
  for (int i = tid; i < 9 * 1024; i += 512) {
    const int row = i >> 10, k = i & 1023;
    const float v = row < 8 ? p.c[row * 1024 + k] : p.c_ctx[k];
    sc[i] = v / (1.f + __expf(-v));
  }
  __syncthreads();
  const int kg = tid >> 6, col = tid & 63;
  const float* w = p.w_mod + (size_t)layer * 1024 * 6144 + cc * 64 + col;
  float a[9];
#pragma unroll
  for (int r = 0; r < 9; ++r) a[r] = 0.f;
#pragma unroll 4
  for (int k = kg * 128; k < kg * 128 + 128; ++k) {
    const float wv = w[(size_t)k * 6144];
#pragma unroll
    for (int r = 0; r < 9; ++r) a[r] += sc[r * 1024 + k] * wv;
  }
#pragma unroll
  for (int r = 0; r < 9; ++r) red[(kg * 9 + r) * 64 + col] = a[r];
  __syncthreads();
  for (int i = tid; i < 576; i += 512) {
    const int r = i >> 6, cl = i & 63;
    float s = 0.f;
#pragma unroll
    for (int g = 0; g < 8; ++g) s += red[(g * 9 + r) * 64 + cl];
    const int n = cc * 64 + cl;
    p.MOD[(layer * 9 + r) * 6144 + n] = s + p.b_mod[layer * 6144 + n];
  }
  __syncthreads();
}

DI void sincos_d(double a, double& s, double& c) {
  const double n = rint(a * 0.6366197723675814);
  const double r = (a - n * 1.5707963267948966) - n * 6.123233995736766e-17;
  const double r2 = r * r;
  const double sp = r * (1.0 + r2 * (-1.0 / 6.0 + r2 * (1.0 / 120.0 + r2 * (-1.0 / 5040.0 + r2 * (1.0 / 362880.0 + r2 * (-1.0 / 39916800.0 + r2 * (1.0 / 6227020800.0)))))));
  const double cp = 1.0 + r2 * (-0.5 + r2 * (1.0 / 24.0 + r2 * (-1.0 / 720.0 + r2 * (1.0 / 40320.0 + r2 * (-1.0 / 3628800.0 + r2 * (1.0 / 479001600.0 + r2 * (-1.0 / 87178291200.0)))))));
  const int q = ((int)n) & 3;
  if (q == 0) { s = sp; c = cp; }
  else if (q == 1) { s = cp; c = -sp; }
  else if (q == 2) { s = -sp; c = -cp; }
  else { s = -cp; c = sp; }
}

DI void tab_unit(const Params& p) {
  for (int idx = threadIdx.x; idx < 1024; idx += 512) {
    const int pos = idx >> 4, fi = idx & 15;
    double f = 1.0;
    for (int i = 0; i < fi; ++i) f *= 0.5623413251903491;
    double s, c;
    sincos_d((double)pos * (double)(float)f, s, c);
    p.TAB[idx * 2 + 0] = (float)c;
    p.TAB[idx * 2 + 1] = (float)s;
  }
}

__device__ void phase0(const Params& p, char* lds) {
  const int total = p.total_tiles + 192 + 1;
  for (int u = blockIdx.x; u < total; u += gridDim.x) {
    if (u < p.total_tiles) {
      int j = 0;
#pragma unroll 1
      for (int q = 1; q < p.njobs; ++q) if (u >= p.jobs[q].tstart) j = q;
      convert_tile(p.jobs[j], u - p.jobs[j].tstart, lds);
    } else if (u < p.total_tiles + 192) {
      mod_unit(p, u - p.total_tiles, lds);
    } else {
      tab_unit(p);
    }
  }
}

DI void norm_mod_phase(const float* __restrict__ xl, const float* __restrict__ xc, const float* __restrict__ gain,
                               const float* __restrict__ mod, int shift_i, int scale_i, bf16_t* __restrict__ H, int ntok) {
  const int lane = threadIdx.x & 63;
  const int wg = blockIdx.x * 8 + (threadIdx.x >> 6), nw = gridDim.x * 8;
  for (int t = wg; t < ntok; t += nw) {
    const float* row = t < NL ? xl + (size_t)t * 1024 : xc + (size_t)(t - NL) * 1024;
    float4 v[4];
    float ss = 0.f;
#pragma unroll
    for (int i = 0; i < 4; ++i) {
      v[i] = *(const float4*)(row + (lane + 64 * i) * 4);
      ss += v[i].x * v[i].x + v[i].y * v[i].y + v[i].z * v[i].z + v[i].w * v[i].w;
    }
    ss = wave_sum(ss);
    const float rstd = rsqrtf(ss * (1.f / 1024.f) + 1e-6f);
    const int bp = t < NL ? (t >> 12) : 8;
    const float* sh = mod + (bp * 6 + shift_i) * 1024;
    const float* sc = mod + (bp * 6 + scale_i) * 1024;
#pragma unroll
    for (int i = 0; i < 4; ++i) {
      const int c = (lane + 64 * i) * 4;
      const float4 g = *(const float4*)(gain + c), s4 = *(const float4*)(sh + c), c4 = *(const float4*)(sc + c);
      store_bf4(H + (size_t)t * 1024 + c,
                v[i].x * rstd * g.x * (1.f + c4.x) + s4.x, v[i].y * rstd * g.y * (1.f + c4.y) + s4.y,
                v[i].z * rstd * g.z * (1.f + c4.z) + s4.z, v[i].w * rstd * g.w * (1.f + c4.w) + s4.w);
    }
  }
}

__device__ void final_norm_phase(const Params& p) {
  const int lane = threadIdx.x & 63;
  const int wg = blockIdx.x * 8 + (threadIdx.x >> 6), nw = gridDim.x * 8;
  for (int t = wg; t < NL; t += nw) {
    float* row = p.out + (size_t)t * 1024;
    float4 v[4];
    float ss = 0.f;
#pragma unroll
    for (int i = 0; i < 4; ++i) {
      v[i] = *(const float4*)(row + (lane + 64 * i) * 4);
      ss += v[i].x * v[i].x + v[i].y * v[i].y + v[i].z * v[i].z + v[i].w * v[i].w;
    }
    ss = wave_sum(ss);
    const float rstd = rsqrtf(ss * (1.f / 1024.f) + 1e-6f);
#pragma unroll
    for (int i = 0; i < 4; ++i) {
      const int c = (lane + 64 * i) * 4;
      const float4 g = *(const float4*)(p.final_norm + c);
      *(float4*)(row + c) = make_float4(v[i].x * rstd * g.x, v[i].y * rstd * g.y, v[i].z * rstd * g.z, v[i].w * rstd * g.w);
    }
  }
}

__device__ void phase_proj(const Params& p, char* lds) {
  const int lane = threadIdx.x & 63, wave = threadIdx.x >> 6;
  const int wt = wave & 3, wf = wave >> 2, lr = lane & 15, lq = lane >> 4;
  const int ntn = 27, total = (NT / 256) * ntn;
  for (int u = blockIdx.x; u < total; u += gridDim.x) {
    const int mt = u / ntn, nt = u % ntn;
    const int mi = nt < 8 ? 0 : nt < 16 ? 2 : nt < 24 ? 3 : nt == 24 ? 5 : nt == 25 ? 1 : 4;
    f32x4 acc[4][4];
    gemm_tile<true>(p.Hd, 1024, p.Wcat, 1024, 1024, mt * 256, nt * 128, lds, acc, p.mu + mi * 1024);
#pragma unroll
    for (int pp = 0; pp < 2; ++pp)
#pragma unroll
      for (int ti = 0; ti < 4; ++ti) {
        const int t = mt * 256 + wt * 64 + ti * 16 + lr;
        const int fl = wf * 64 + pp * 32 + lq * 8;
        f32x4 a = acc[2 * pp][ti], b = acc[2 * pp + 1][ti];
        if (nt < 24) {
          bf16_t* dst = nt < 8 ? p.S[0] : nt < 16 ? p.S[2] : p.S[1];
          store_bf8(dst + (size_t)t * 1024 + (nt & 7) * 128 + fl, a, b);
        } else if (nt == 24) {
#pragma unroll
          for (int j = 0; j < 4; ++j) { a[j] = sigmoidf_(a[j]); b[j] = sigmoidf_(b[j]); }
          store_bf8(p.L1 + (size_t)t * 384 + fl, a, b);
        } else if (nt == 25) {
#pragma unroll
          for (int j = 0; j < 4; ++j) { a[j] = tanhf_(a[j]); b[j] = tanhf_(b[j]); }
          store_bf8(p.L1 + (size_t)t * 384 + 128 + fl, a, b);
        } else {
          store_bf8(p.L1 + (size_t)t * 384 + 256 + fl, a, b);
        }
      }
  }
}

__device__ void phase_prep(const Params& p, char* lds) {
  const int lane = threadIdx.x & 63, wave = threadIdx.x >> 6;
  const int wt = wave & 3, wf = wave >> 2, lr = lane & 15, lq = lane >> 4;
  const int total = (NT / 256) * 8;
  for (int u = blockIdx.x; u < total; u += gridDim.x) {
    const int mt = u >> 3, nt = u & 7;
    const int tok0 = mt * 256, f0 = nt * 128;
    f32x4 acc[4][4];
    uint4 afp[2][4];
    gemm_tile<false>(p.L1 + 256, 384, p.L2w + 0 * 65536, 64, 64, tok0, f0, lds, acc, nullptr);
#pragma unroll
    for (int pp = 0; pp < 2; ++pp) {
      const int f = f0 + wf * 64 + pp * 32 + lq * 8;
      const float4 a0l = *(const float4*)(p.a0 + f), a0h = *(const float4*)(p.a0 + f + 4);
#pragma unroll
      for (int ti = 0; ti < 4; ++ti) {
        const int t = tok0 + wt * 64 + ti * 16 + lr;
        f32x4 a = acc[2 * pp][ti], b = acc[2 * pp + 1][ti];
        a[0] = sigmoidf_(a[0] + a0l.x); a[1] = sigmoidf_(a[1] + a0l.y); a[2] = sigmoidf_(a[2] + a0l.z); a[3] = sigmoidf_(a[3] + a0l.w);
        b[0] = sigmoidf_(b[0] + a0h.x); b[1] = sigmoidf_(b[1] + a0h.y); b[2] = sigmoidf_(b[2] + a0h.z); b[3] = sigmoidf_(b[3] + a0h.w);
        uint4 o; o.x = pack2(a[0], a[1]); o.y = pack2(a[2], a[3]); o.z = pack2(b[0], b[1]); o.w = pack2(b[2], b[3]);
        afp[pp][ti] = o;
        *(uint4*)(p.S[3] + (size_t)t * 1024 + f) = o;
      }
    }
    gemm_tile<false>(p.L1 + 320, 384, p.L2w + 1 * 65536, 64, 64, tok0, f0, lds, acc, nullptr);
    float bon[4] = {0.f, 0.f, 0.f, 0.f};
#pragma unroll
    for (int pp = 0; pp < 2; ++pp) {
      const int f = f0 + wf * 64 + pp * 32 + lq * 8;
      const float4 a0l = *(const float4*)(p.a0 + 1024 + f), a0h = *(const float4*)(p.a0 + 1024 + f + 4);
      const float4 rkl = *(const float4*)(p.r_k + f), rkh = *(const float4*)(p.r_k + f + 4);
      const float4 kal = *(const float4*)(p.k_a + f), kah = *(const float4*)(p.k_a + f + 4);
      const float rk8[8] = {rkl.x, rkl.y, rkl.z, rkl.w, rkh.x, rkh.y, rkh.z, rkh.w};
      const float ka8[8] = {kal.x, kal.y, kal.z, kal.w, kah.x, kah.y, kah.z, kah.w};
#pragma unroll
      for (int ti = 0; ti < 4; ++ti) {
        const int t = tok0 + wt * 64 + ti * 16 + lr;
        f32x4 a = acc[2 * pp][ti], b = acc[2 * pp + 1][ti];
        a[0] = sigmoidf_(a[0] + a0l.x); a[1] = sigmoidf_(a[1] + a0l.y); a[2] = sigmoidf_(a[2] + a0l.z); a[3] = sigmoidf_(a[3] + a0l.w);
        b[0] = sigmoidf_(b[0] + a0h.x); b[1] = sigmoidf_(b[1] + a0h.y); b[2] = sigmoidf_(b[2] + a0h.z); b[3] = sigmoidf_(b[3] + a0h.w);
        store_bf8(p.S[4] + (size_t)t * 1024 + f, a, b);
        const float ab8[8] = {a[0], a[1], a[2], a[3], b[0], b[1], b[2], b[3]};
        float af8[8], r8[8], k8[8];
        unpack_bf8(afp[pp][ti], af8);
        unpack_bf8(*(const uint4*)(p.S[0] + (size_t)t * 1024 + f), r8);
        unpack_bf8(*(const uint4*)(p.S[2] + (size_t)t * 1024 + f), k8);
#pragma unroll
        for (int e2 = 0; e2 < 8; ++e2) bon[ti] += r8[e2] * k8[e2] * rk8[e2] * (2.f + (ab8[e2] + af8[e2] - 2.f) * ka8[e2]);
      }
    }
#pragma unroll
    for (int ti = 0; ti < 4; ++ti) {
      float s = bon[ti];
      s += __shfl_xor(s, 16);
      s += __shfl_xor(s, 32);
      if (lq == 0) p.BON[(size_t)(tok0 + wt * 64 + ti * 16 + lr) * 16 + (nt * 2 + wf)] = s;
    }
#pragma unroll 1
    for (int dr = 0; dr < 2; ++dr) {
      gemm_tile<false>(p.L1 + 128 + dr * 64, 384, p.L2w + (2 + dr) * 65536, 64, 64, tok0, f0, lds, acc, nullptr);
      bf16_t* dst = dr ? p.S[5] : p.Hd;
#pragma unroll
      for (int pp = 0; pp < 2; ++pp) {
        const int f = f0 + wf * 64 + pp * 32 + lq * 8;
        const float4 w0l = *(const float4*)(p.w0 + dr * 1024 + f), w0h = *(const float4*)(p.w0 + dr * 1024 + f + 4);
#pragma unroll
        for (int ti = 0; ti < 4; ++ti) {
          const int t = tok0 + wt * 64 + ti * 16 + lr;
          f32x4 a = acc[2 * pp][ti], b = acc[2 * pp + 1][ti];
          a[0] = -0.60653066f * sigmoidf_(a[0] + w0l.x); a[1] = -0.60653066f * sigmoidf_(a[1] + w0l.y);
          a[2] = -0.60653066f * sigmoidf_(a[2] + w0l.z); a[3] = -0.60653066f * sigmoidf_(a[3] + w0l.w);
          b[0] = -0.60653066f * sigmoidf_(b[0] + w0h.x); b[1] = -0.60653066f * sigmoidf_(b[1] + w0h.y);
          b[2] = -0.60653066f * sigmoidf_(b[2] + w0h.z); b[3] = -0.60653066f * sigmoidf_(b[3] + w0h.w);
          store_bf8(dst + (size_t)t * 1024 + f, a, b);
        }
      }
    }
  }
}

__device__ void phase_scan(const Params& p, char* lds, bool dupout = false) {
  float* buf = (float*)lds;
  float* ybuf = (float*)(lds + 2 * 49152);
  const int tid = threadIdx.x;
  const bool loader = tid >= 256;
  const int lt = tid & 255, ltk = lt >> 3, lch = (lt & 7) * 8;
  const int rp = lt >> 3, l8 = lt & 7;
  constexpr int NCH = NKEY / 32;
  for (int unit = blockIdx.x; unit < 256; unit += gridDim.x) {
    const int dir = unit & 1, h = (unit >> 1) & 15, b = unit >> 5;
    const bf16_t* Rp = p.S[0]; const bf16_t* Vp = p.S[1]; const bf16_t* Kp = p.S[2];
    bf16_t* Ap = dir ? p.S[4] : p.S[3];
    const bf16_t* Lp = dir ? p.S[5] : p.Hd;
    auto tok_of = [&](int i) -> int {
      if (i < 256) return NL + b * 256 + (dir ? 255 - i : i);
      const int s = i - 256;
      return b * 4096 + (dir ? 4095 - s : s);
    };
    uint4 raw[5];
    float kkc[8], kac[8];
    f32x2 S0[4], S1[4];
#pragma unroll
    for (int i = 0; i < 4; ++i) { S0[i] = f32x2{0.f, 0.f}; S1[i] = f32x2{0.f, 0.f}; }
    if (loader) {
#pragma unroll
      for (int j = 0; j < 8; ++j) { kkc[j] = p.k_k[h * 64 + lch + j]; kac[j] = p.k_a[h * 64 + lch + j]; }
    }
    auto issue = [&](int c) {
      const int t = tok_of(c * 32 + ltk);
      const size_t off = (size_t)t * 1024 + h * 64 + lch;
      raw[0] = *(const uint4*)(Rp + off); raw[1] = *(const uint4*)(Vp + off); raw[2] = *(const uint4*)(Kp + off);
      raw[3] = *(const uint4*)(Ap + off); raw[4] = *(const uint4*)(Lp + off);
    };
    auto unpack8 = [&](const uint4& u, float (&o)[8]) {
      o[0] = bflo(u.x); o[1] = bfhi(u.x); o[2] = bflo(u.y); o[3] = bfhi(u.y); o[4] = bflo(u.z); o[5] = bfhi(u.z); o[6] = bflo(u.w); o[7] = bfhi(u.w);
    };
    auto process = [&](int stage) {
      float r8[8], v8[8], k8[8], a8[8], l8[8], kk8[8], kd8[8], b8[8], w8[8];
      unpack8(raw[0], r8); unpack8(raw[1], v8); unpack8(raw[2], k8); unpack8(raw[3], a8); unpack8(raw[4], l8);
      float ss = 0.f;
#pragma unroll
      for (int j = 0; j < 8; ++j) { kk8[j] = k8[j] * kkc[j]; ss += kk8[j] * kk8[j]; }
      ss += __shfl_xor(ss, 1); ss += __shfl_xor(ss, 2); ss += __shfl_xor(ss, 4);
      const float inv = rsqrtf(ss + 1e-12f);
#pragma unroll
      for (int j = 0; j < 8; ++j) {
        kk8[j] *= inv;
        kd8[j] = k8[j] * (1.f + (a8[j] - 1.f) * kac[j]);
        b8[j] = kk8[j] * a8[j];
        w8[j] = __expf(l8[j]);
      }
      float* dst = buf + stage * 12288 + ltk * 384 + lch;
      *(float4*)(dst + 0) = make_float4(r8[0], r8[1], r8[2], r8[3]);       *(float4*)(dst + 4) = make_float4(r8[4], r8[5], r8[6], r8[7]);
      *(float4*)(dst + 64) = make_float4(w8[0], w8[1], w8[2], w8[3]);      *(float4*)(dst + 68) = make_float4(w8[4], w8[5], w8[6], w8[7]);
      *(float4*)(dst + 128) = make_float4(kd8[0], kd8[1], kd8[2], kd8[3]); *(float4*)(dst + 132) = make_float4(kd8[4], kd8[5], kd8[6], kd8[7]);
      *(float4*)(dst + 192) = make_float4(kk8[0], kk8[1], kk8[2], kk8[3]); *(float4*)(dst + 196) = make_float4(kk8[4], kk8[5], kk8[6], kk8[7]);
      *(float4*)(dst + 256) = make_float4(b8[0], b8[1], b8[2], b8[3]);     *(float4*)(dst + 260) = make_float4(b8[4], b8[5], b8[6], b8[7]);
      *(float4*)(dst + 320) = make_float4(v8[0], v8[1], v8[2], v8[3]);     *(float4*)(dst + 324) = make_float4(v8[4], v8[5], v8[6], v8[7]);
    };
    auto yout = [&](int c) {
      const float* yb = ybuf + (c & 1) * 2048 + ltk * 64 + lch;
      const float4 y0 = *(const float4*)yb, y1 = *(const float4*)(yb + 4);
      const int t = tok_of(c * 32 + ltk);
      uint4 o;
      o.x = pack2(y0.x, y0.y); o.y = pack2(y0.z, y0.w); o.z = pack2(y1.x, y1.y); o.w = pack2(y1.z, y1.w);
      *(uint4*)((dupout ? p.S[0] : Ap) + (size_t)t * 1024 + h * 64 + lch) = o;
    };
    __syncthreads();
    if (loader) { issue(0); process(0); issue(1); }
    __syncthreads();
    for (int c = 0; c < NCH; ++c) {
      if (loader) {
        if (c >= 1) yout(c - 1);
        if (c + 1 < NCH) { process((c + 1) & 1); if (c + 2 < NCH) issue(c + 2); }
      } else {
        const float* bb = buf + (c & 1) * 12288 + l8 * 8;
        const float* vb = buf + (c & 1) * 12288 + 320 + 2 * rp;
        float* yb = ybuf + (c & 1) * 2048 + 2 * rp;
        StepV A, B;
        scan_load(A, bb, vb);
#pragma unroll 1
        for (int j = 0; j < 32; j += 2) {
          scan_load(B, bb + (j + 1) * 384, vb + (j + 1) * 384);
          scan_step(A, S0, S1, yb + j * 64, l8 == 0);
          if (j + 2 < 32) scan_load(A, bb + (j + 2) * 384, vb + (j + 2) * 384);
          scan_step(B, S0, S1, yb + (j + 1) * 64, l8 == 0);
        }
      }
      __syncthreads();
    }
    if (loader) yout(NCH - 1);
    __syncthreads();
  }
}

__device__ void phase_readout(const Params& p, char* lds) {
  const int lane = threadIdx.x & 63, wave = threadIdx.x >> 6;
  const int wt = wave & 3, wf = wave >> 2, lr = lane & 15, lq = lane >> 4;
  const int total = (NT / 256) * 8;
  for (int u = blockIdx.x; u < total; u += gridDim.x) {
    const int mt = u >> 3, nt = u & 7;
    const int tok0 = mt * 256, f0 = nt * 128;
    f32x4 g[4][4];
    gemm_tile<false>(p.L1, 384, p.g2T, 128, 128, tok0, f0, lds, g, nullptr);
    const int head = nt * 2 + wf;
#pragma unroll
    for (int ti = 0; ti < 4; ++ti) {
      const int t = tok0 + wt * 64 + ti * 16 + lr;
      float y[2][8];
      float sum = 0.f;
#pragma unroll
      for (int pp = 0; pp < 2; ++pp) {
        const int f = f0 + wf * 64 + pp * 32 + lq * 8;
        float ya[8], yb[8];
        unpack_bf8(*(const uint4*)(p.S[3] + (size_t)t * 1024 + f), ya);
        unpack_bf8(*(const uint4*)(p.S[4] + (size_t)t * 1024 + f), yb);
#pragma unroll
        for (int e2 = 0; e2 < 8; ++e2) { y[pp][e2] = ya[e2] + yb[e2]; sum += y[pp][e2]; }
      }
      sum += __shfl_xor(sum, 16); sum += __shfl_xor(sum, 32);
      const float mean = sum * (1.f / 64.f);
      float vs = 0.f;
#pragma unroll
      for (int pp = 0; pp < 2; ++pp)
#pragma unroll
        for (int e2 = 0; e2 < 8; ++e2) { const float d = y[pp][e2] - mean; vs += d * d; }
      vs += __shfl_xor(vs, 16); vs += __shfl_xor(vs, 32);
      const float rstd = rsqrtf(vs * (1.f / 64.f) + 64e-5f);
      const float bon = p.BON[(size_t)t * 16 + head];
#pragma unroll
      for (int pp = 0; pp < 2; ++pp) {
        const int f = f0 + wf * 64 + pp * 32 + lq * 8;
        const float4 lwl = *(const float4*)(p.ln_w + f), lwh = *(const float4*)(p.ln_w + f + 4);
        const float4 lbl = *(const float4*)(p.ln_b + f), lbh = *(const float4*)(p.ln_b + f + 4);
        const float lw8[8] = {lwl.x, lwl.y, lwl.z, lwl.w, lwh.x, lwh.y, lwh.z, lwh.w};
        const float lb8[8] = {lbl.x, lbl.y, lbl.z, lbl.w, lbh.x, lbh.y, lbh.z, lbh.w};
        float v8[8];
        unpack_bf8(*(const uint4*)(p.S[1] + (size_t)t * 1024 + f), v8);
        f32x4 oa, ob;
#pragma unroll
        for (int j = 0; j < 4; ++j) {
          oa[j] = ((y[pp][j] - mean) * rstd * lw8[j] + lb8[j] + bon * v8[j]) * g[2 * pp][ti][j];
          ob[j] = ((y[pp][4 + j] - mean) * rstd * lw8[4 + j] + lb8[4 + j] + bon * v8[4 + j]) * g[2 * pp + 1][ti][j];
        }
        store_bf8(p.S[0] + (size_t)t * 1024 + f, oa, ob);
      }
    }
  }
}

DI void phase_gemm_resid(const Params& p, char* lds, const bf16_t* A, const bf16_t* W, int K, int ntm,
                                 const float* xin_l, const float* xin_c, const float* gate, float* dummy_out = nullptr) {
  const int lane = threadIdx.x & 63, wave = threadIdx.x >> 6;
  const int wr = wave >> 2, wc = wave & 3;
  const int total = ntm * 4;
  for (int u = blockIdx.x; u < total; u += gridDim.x) {
    const int mt = u >> 2, nt = u & 3;
    f32x4 acc[2][2][4][2];
    gemm256_tile<true>(W, A, K, nt * 256, mt * 256, lds, acc);
    int lane_o = threadIdx.x & 63; asm volatile("" : "+v"(lane_o));
    const int fr = lane_o & 15, fq = lane_o >> 4;
#pragma unroll
    for (int bj = 0; bj < 2; ++bj)
#pragma unroll
      for (int n = 0; n < 2; ++n) {
        const int t = mt * 256 + bj * 128 + wc * 32 + n * 16 + fr;
        const int bp = t < NL ? (t >> 12) : 8;
        const float* xi = t < NL ? xin_l + (size_t)t * 1024 : xin_c + (size_t)(t - NL) * 1024;
        float* xo = dummy_out ? dummy_out + (size_t)t * 1024 : (t < NL ? p.out + (size_t)t * 1024 : p.XC + (size_t)(t - NL) * 1024);
#pragma unroll
        for (int ai = 0; ai < 2; ++ai)
#pragma unroll
          for (int mp = 0; mp < 2; ++mp) {
            const int f = nt * 256 + ai * 128 + wr * 64 + mp * 32 + fq * 8;
            const float4 g0 = *(const float4*)(gate + bp * 6144 + f), g1 = *(const float4*)(gate + bp * 6144 + f + 4);
            const float4 x0 = *(const float4*)(xi + f), x1 = *(const float4*)(xi + f + 4);
            const f32x4 a = acc[ai][bj][2 * mp][n], b = acc[ai][bj][2 * mp + 1][n];
            *(float4*)(xo + f) = make_float4(x0.x + g0.x * a[0], x0.y + g0.y * a[1], x0.z + g0.z * a[2], x0.w + g0.w * a[3]);
            *(float4*)(xo + f + 4) = make_float4(x1.x + g1.x * b[0], x1.y + g1.y * b[1], x1.z + g1.z * b[2], x1.w + g1.w * b[3]);
          }
      }
  }
}

DI void phase_up(const Params& p, char* lds, const bf16_t* H, const bf16_t* W, bf16_t* U, int ntm) {
  const int lane = threadIdx.x & 63, wave = threadIdx.x >> 6;
  const int wr = wave >> 2, wc = wave & 3;
  const int total = ntm * 16;
  for (int u = blockIdx.x; u < total; u += gridDim.x) {
    const int mt = u >> 4, nt = u & 15;
    f32x4 acc[2][2][4][2];
    gemm256_tile<true>(W, H, 1024, nt * 256, mt * 256, lds, acc);
    int lane_o = threadIdx.x & 63; asm volatile("" : "+v"(lane_o));
    const int fr = lane_o & 15, fq = lane_o >> 4;
#pragma unroll
    for (int bj = 0; bj < 2; ++bj)
#pragma unroll
      for (int n = 0; n < 2; ++n) {
        const int t = mt * 256 + bj * 128 + wc * 32 + n * 16 + fr;
#pragma unroll
        for (int ai = 0; ai < 2; ++ai)
#pragma unroll
          for (int mp = 0; mp < 2; ++mp) {
            const int f = nt * 256 + ai * 128 + wr * 64 + mp * 32 + fq * 8;
            f32x4 a = acc[ai][bj][2 * mp][n], b = acc[ai][bj][2 * mp + 1][n];
#pragma unroll
            for (int j = 0; j < 4; ++j) { const float ra = fmaxf(a[j], 0.f), rb = fmaxf(b[j], 0.f); a[j] = ra * ra; b[j] = rb * rb; }
            store_bf8(U + (size_t)t * 4096 + f, a, b);
          }
      }
  }
}

__device__ void phase_qkv(const Params& p, char* lds) {
  const int lane = threadIdx.x & 63, wave = threadIdx.x >> 6;
  const int wr = wave >> 2, wc = wave & 3;
  const int total = (NT / 256) * 6;
  bf16_t* Q = p.S[0]; bf16_t* KA = p.S[1]; bf16_t* VT = p.S[2];
  for (int u = blockIdx.x; u < total; u += gridDim.x) {
    const int mt = u / 6, nt = u % 6;
    if (mt >= NL / 256 && nt < 4) continue;
    f32x4 acc[2][2][4][2];
    gemm256_tile<false>(p.wqkvT, p.S[5], 1024, nt * 256, mt * 256, lds, acc);
    int lane_o = threadIdx.x & 63; asm volatile("" : "+v"(lane_o));
    const int fr = lane_o & 15, fq = lane_o >> 4;
#pragma unroll
    for (int bj = 0; bj < 2; ++bj)
#pragma unroll
      for (int n = 0; n < 2; ++n) {
        const int t = mt * 256 + bj * 128 + wc * 32 + n * 16 + fr;
        const bool lat = t < NL;
        const int b = lat ? (t >> 12) : ((t - NL) >> 8);
        const int key = lat ? (t & 4095) : 4096 + ((t - NL) & 255);
#pragma unroll
        for (int ai = 0; ai < 2; ++ai) {
          const int hh = ai * 2 + wr;
          asm volatile("" ::: "memory");
          if (nt < 5) {
            float ss = 0.f;
#pragma unroll
            for (int m = 0; m < 4; ++m)
#pragma unroll
              for (int j = 0; j < 4; ++j) ss += acc[ai][bj][m][n][j] * acc[ai][bj][m][n][j];
            ss += __shfl_xor(ss, 16); ss += __shfl_xor(ss, 32);
            const float rstd = rsqrtf(ss * (1.f / 64.f) + 1e-6f);
            const float* gn = nt < 4 ? p.q_norm : p.k_norm;
            float v[4][4];
#pragma unroll
            for (int m = 0; m < 4; ++m) {
              const float4 g4 = *(const float4*)(gn + m * 16 + fq * 4);
              v[m][0] = acc[ai][bj][m][n][0] * rstd * g4.x; v[m][1] = acc[ai][bj][m][n][1] * rstd * g4.y;
              v[m][2] = acc[ai][bj][m][n][2] * rstd * g4.z; v[m][3] = acc[ai][bj][m][n][3] * rstd * g4.w;
            }
            if (lat) {
              const int s = t & 4095, rowp = s >> 6, colp = s & 63;
#pragma unroll
              for (int j = 0; j < 4; ++j) {
                const float2 cs0 = *(const float2*)(p.TAB + (rowp * 16 + fq * 4 + j) * 2);
                const float2 cs1 = *(const float2*)(p.TAB + (colp * 16 + fq * 4 + j) * 2);
                const float x1 = v[0][j], x2 = v[1][j], z1 = v[2][j], z2 = v[3][j];
                v[0][j] = x1 * cs0.x - x2 * cs0.y; v[1][j] = x2 * cs0.x + x1 * cs0.y;
                v[2][j] = z1 * cs1.x - z2 * cs1.y; v[3][j] = z2 * cs1.x + z1 * cs1.y;
              }
            }
            if (nt < 4) {
              const float qs = 0.125f * 1.4426950408889634f;
              const int head = nt * 4 + hh;
#pragma unroll
              for (int m = 0; m < 4; ++m)
                store_bf4(Q + (size_t)t * 1024 + head * 64 + m * 16 + fq * 4, v[m][0] * qs, v[m][1] * qs, v[m][2] * qs, v[m][3] * qs);
            } else {
#pragma unroll
              for (int m = 0; m < 4; ++m)
                store_bf4(KA + ((size_t)(b * 4 + hh) * NKEY + key) * 64 + m * 16 + fq * 4, v[m][0], v[m][1], v[m][2], v[m][3]);
            }
          } else {
#pragma unroll
            for (int m = 0; m < 4; ++m)
#pragma unroll
              for (int j = 0; j < 4; ++j) {
                const int d = m * 16 + fq * 4 + j;
                const unsigned pk = pack2(acc[ai][bj][m][n][j], 0.f);
                VT[((size_t)(b * 4 + hh) * 64 + d) * NKEY + key] = (bf16_t)(pk & 0xffffu);
              }
          }
        }
      }
  }
}

__device__ void phase_attn(const Params& p, char* lds) {
  const int tid = threadIdx.x, lane = tid & 63, wave = tid >> 6;
  const int l31 = lane & 31, lh = lane >> 5;
  const int srow = tid >> 3, sch = tid & 7;
  const bf16_t* Q = p.S[0]; const bf16_t* KA = p.S[1]; const bf16_t* VT = p.S[2]; bf16_t* O = p.S[3];
  float gq = 0.f, gk = 0.f;
  for (int i = 0; i < 64; ++i) { gq = fmaxf(gq, fabsf(p.q_norm[i])); gk = fmaxf(gk, fabsf(p.k_norm[i])); }
  const float M2 = 8.f * gq * gk * 1.4426950408889634f;
  constexpr int NKT = NKEY / 64;
  constexpr int AST = 2 * 64 * ROWB;
  for (int u = blockIdx.x; u < 2048; u += gridDim.x) {
    const int qb = u & 15, head = (u >> 4) & 15, b = u >> 8, kvh = head >> 2;
    const bf16_t* Kg = KA + (size_t)(b * 4 + kvh) * NKEY * 64;
    const bf16_t* Vg = VT + (size_t)(b * 4 + kvh) * 64 * NKEY;
    const int tq = b * 4096 + qb * 256 + wave * 32 + l31;
    bf16x8 qf[4];
#pragma unroll
    for (int s = 0; s < 4; ++s) qf[s] = *(const bf16x8*)(Q + (size_t)tq * 1024 + head * 64 + s * 16 + lh * 8);
    f32x16 o0, o1;
#pragma unroll
    for (int i = 0; i < 16; ++i) { o0[i] = 0.f; o1[i] = 0.f; }
    float lsum = 0.f;
    uint4 kreg, vreg;
    auto gload = [&](int kt) {
      kreg = *(const uint4*)(Kg + (size_t)(kt * 64 + srow) * 64 + sch * 8);
      vreg = *(const uint4*)(Vg + (size_t)srow * NKEY + kt * 64 + sch * 8);
    };
    auto lwrite = [&](int st) {
      *(uint4*)(lds + st * AST + srow * ROWB + sch * 16) = kreg;
      *(uint4*)(lds + st * AST + 64 * ROWB + srow * ROWB + sch * 16) = vreg;
    };
    gload(0);
    __syncthreads();
    lwrite(0);
    __syncthreads();
    for (int kt = 0; kt < NKT; ++kt) {
      if (kt + 1 < NKT) gload(kt + 1);
      const char* ksm = lds + (kt & 1) * AST;
      const char* vsm = ksm + 64 * ROWB;
      f32x16 sT[2];
#pragma unroll
      for (int k2 = 0; k2 < 2; ++k2) {
#pragma unroll
        for (int i = 0; i < 16; ++i) sT[k2][i] = 0.f;
#pragma unroll
        for (int s = 0; s < 4; ++s) {
          const bf16x8 kf = *(const bf16x8*)(ksm + (k2 * 32 + l31) * ROWB + s * 32 + lh * 16);
          sT[k2] = MFMA32(kf, qf[s], sT[k2]);
        }
      }
#pragma unroll
      for (int k2 = 0; k2 < 2; ++k2)
#pragma unroll
        for (int i = 0; i < 16; ++i) { const float pv = __builtin_amdgcn_exp2f(sT[k2][i] - M2); lsum += pv; sT[k2][i] = pv; }
#pragma unroll
      for (int k2 = 0; k2 < 2; ++k2)
#pragma unroll
        for (int s2 = 0; s2 < 2; ++s2) {
          uint4 pk;
          pk.x = pack2(sT[k2][8 * s2 + 0], sT[k2][8 * s2 + 1]); pk.y = pack2(sT[k2][8 * s2 + 2], sT[k2][8 * s2 + 3]);
          pk.z = pack2(sT[k2][8 * s2 + 4], sT[k2][8 * s2 + 5]); pk.w = pack2(sT[k2][8 * s2 + 6], sT[k2][8 * s2 + 7]);
          const bf16x8 pf = __builtin_bit_cast(bf16x8, pk);
          const int koff = (k2 * 32 + 16 * s2 + 4 * lh) * 2;
          {
            const uint2 lo = *(const uint2*)(vsm + l31 * ROWB + koff), hi = *(const uint2*)(vsm + l31 * ROWB + koff + 16);
            const uint4 vv = make_uint4(lo.x, lo.y, hi.x, hi.y);
            o0 = MFMA32(__builtin_bit_cast(bf16x8, vv), pf, o0);
          }
          {
            const uint2 lo = *(const uint2*)(vsm + (32 + l31) * ROWB + koff), hi = *(const uint2*)(vsm + (32 + l31) * ROWB + koff + 16);
            const uint4 vv = make_uint4(lo.x, lo.y, hi.x, hi.y);
            o1 = MFMA32(__builtin_bit_cast(bf16x8, vv), pf, o1);
          }
        }
      if (kt + 1 < NKT) lwrite((kt + 1) & 1);
      __syncthreads();
    }
    lsum += __shfl_xor(lsum, 32);
    const float inv = 1.f / lsum;
#pragma unroll
    for (int g = 0; g < 4; ++g) {
      const int d0 = 8 * g + 4 * lh;
      store_bf4(O + (size_t)tq * 1024 + head * 64 + d0, o0[4 * g] * inv, o0[4 * g + 1] * inv, o0[4 * g + 2] * inv, o0[4 * g + 3] * inv);
      store_bf4(O + (size_t)tq * 1024 + head * 64 + 32 + d0, o1[4 * g] * inv, o1[4 * g + 1] * inv, o1[4 * g + 2] * inv, o1[4 * g + 3] * inv);
    }
  }
}

#define XB_TMO      128
#define XB_XCNT(j)  (256  + 64 * (j))
#define XB_XSUB(j)  (1280 + 64 * (j))
#define XB_XGEN(j)  (2304 + 64 * (j))
#define XB_TOP      3328
#define XB_TOPGEN   3392
#define XCD_BAR_WORDS 3456
#define XB_SPIN_CAP (1u << 18)
#define LAS __attribute__((address_space(3)))

__device__ __forceinline__ unsigned xb_ld(unsigned* p)              { return __hip_atomic_load(p, __ATOMIC_RELAXED, __HIP_MEMORY_SCOPE_AGENT); }
__device__ __forceinline__ unsigned xb_add(unsigned* p, unsigned v) { return __hip_atomic_fetch_add(p, v, __ATOMIC_RELAXED, __HIP_MEMORY_SCOPE_AGENT); }
__device__ __forceinline__ unsigned xb_xcc_id() { return (unsigned)__builtin_amdgcn_s_getreg((3 << 11) | 20) & 0xFu; }
#define XB_SPIN(cond, bar) do { unsigned _sp = 0; while (cond) { __builtin_amdgcn_s_sleep(1); \
    if ((++_sp & 255u) == 0u) { if (xb_ld(&(bar)[XB_TMO])) break; if (_sp > XB_SPIN_CAP) { atomicAdd(&(bar)[XB_TMO], 1u); break; } } } } while (0)

struct XcdBarrier {
    unsigned* bar; unsigned x;
    volatile LAS unsigned* st;
};

__device__ __forceinline__ XcdBarrier xcd_barrier_post(unsigned* bar, volatile LAS unsigned* st) {
    XcdBarrier b; b.bar = bar; b.x = xb_xcc_id(); b.st = st;
    if (threadIdx.x == 0) (void)xb_add(&bar[XB_XCNT(b.x)], 1u);
    return b;
}
__device__ __forceinline__ void xcd_barrier_complete(unsigned* bar, unsigned x, unsigned& nloc, unsigned& nx) {
    const unsigned G = gridDim.x * gridDim.y * gridDim.z;
    unsigned sum, cnt, mine, sp = 0u;
    for (;;) {
        sum = 0u; cnt = 0u; mine = 0u;
#pragma unroll
        for (unsigned j = 0; j < 16; ++j) { const unsigned c = xb_ld(&bar[XB_XCNT(j)]); sum += c; cnt += (c > 0u) ? 1u : 0u; mine = (j == x) ? c : mine; }
        if (sum == G) break;
        __builtin_amdgcn_s_sleep(1);
        if ((++sp & 255u) == 0u) { if (xb_ld(&bar[XB_TMO])) break; if (sp > XB_SPIN_CAP) { atomicAdd(&bar[XB_TMO], 1u); break; } }
    }
    nloc = mine > 0u ? mine : 1u; nx = cnt > 0u ? cnt : 1u;
}

__device__ __forceinline__ void xcd_barrier(const XcdBarrier& b) {
    asm volatile("s_waitcnt vmcnt(0)" ::: "memory");
    __syncthreads();
    if (threadIdx.x == 0) {
        unsigned* bar = b.bar;
        __builtin_amdgcn_s_waitcnt(0);
        unsigned nloc = b.st[0], nx = b.st[1];
        if (nloc == 0u) { xcd_barrier_complete(bar, b.x, nloc, nx); b.st[0] = nloc; b.st[1] = nx; }
        const unsigned old = xb_add(&bar[XB_XSUB(b.x)], 1u);
        const unsigned gen = old / nloc;
        if (old + 1u == (gen + 1u) * nloc) {
            __builtin_amdgcn_fence(__ATOMIC_RELEASE, "agent");
            asm volatile("s_waitcnt vmcnt(0)" ::: "memory");
            const unsigned og = xb_add(&bar[XB_TOP], 1u);
            const unsigned tg = og / nx;
            if (og + 1u == (tg + 1u) * nx) xb_add(&bar[XB_TOPGEN], 1u);
            else XB_SPIN(xb_ld(&bar[XB_TOPGEN]) == tg, bar);
            __builtin_amdgcn_fence(__ATOMIC_ACQUIRE, "agent");
            xb_add(&bar[XB_XGEN(b.x)], 1u);
            asm volatile("s_waitcnt vmcnt(0)" ::: "memory");
        } else {
            XB_SPIN(xb_ld(&bar[XB_XGEN(b.x)]) == gen, bar);
            __builtin_amdgcn_fence(__ATOMIC_ACQUIRE, "agent");
            asm volatile("s_waitcnt vmcnt(0)" ::: "memory");
        }
    }
    __syncthreads();
}


DI void run_phase(const Params& p, int ph, char* lds) {
  const float* mod0 = p.MOD;
  const float* mod1 = p.MOD + 9 * 6144;
  switch (ph) {
    case 0: phase0(p, lds); break;
    case 1: norm_mod_phase(p.x, p.ctx, p.norm_mix, mod0, 0, 1, p.Hd, NT); break;
    case 2: phase_proj(p, lds); break;
    case 3: phase_prep(p, lds); break;
    case 4: phase_scan(p, lds); break;
    case 5: phase_readout(p, lds); break;
    case 6: phase_gemm_resid(p, lds, p.S[0], p.woT, 1024, NT / 256, p.x, p.ctx, mod0 + 2 * 1024); break;
    case 7: norm_mod_phase(p.out, p.XC, p.norm_mlp, mod0, 3, 4, p.S[5], NT); break;
    case 8: phase_up(p, lds, p.S[5], p.w1T[0], p.S[0], NT / 256); break;
    case 9: phase_gemm_resid(p, lds, p.S[0], p.w2T[0], 4096, NT / 256, p.out, p.XC, mod0 + 5 * 1024); break;
    case 10: norm_mod_phase(p.out, p.XC, p.norm_mix + 1024, mod1, 0, 1, p.S[5], NT); break;
    case 11: phase_qkv(p, lds); break;
    case 12: phase_attn(p, lds); break;
    case 13: phase_gemm_resid(p, lds, p.S[3], p.awoT, 1024, NL / 256, p.out, p.XC, mod1 + 2 * 1024); break;
    case 14: norm_mod_phase(p.out, p.XC, p.norm_mlp + 1024, mod1, 3, 4, p.S[5], NL); break;
    case 15: phase_up(p, lds, p.S[5], p.w1T[1], p.S[0], NL / 256); break;
    case 16: phase_gemm_resid(p, lds, p.S[0], p.w2T[1], 4096, NL / 256, p.out, p.XC, mod1 + 5 * 1024); break;
    case 17: final_norm_phase(p); break;
  }
}
constexpr int NPHASE = 18;

__global__ void __launch_bounds__(NTHREADS) phase_kernel(Params p, int ph) {
  extern __shared__ __attribute__((aligned(16))) char lds[];
  run_phase(p, ph, lds);
}

__global__ void __launch_bounds__(NTHREADS) mega_kernel(Params p) {
  extern __shared__ __attribute__((aligned(16))) char lds[];
  cg::grid_group grid = cg::this_grid();
  volatile LAS unsigned* st = (volatile LAS unsigned*)(LAS char*)(lds + 131072);
  if (threadIdx.x == 0) { st[0] = 0u; st[1] = 0u; }
  if (blockIdx.x == 0) for (int i = threadIdx.x; i < XCD_BAR_WORDS; i += NTHREADS) p.BAR[i] = 0u;
  __syncthreads();
  run_phase(p, 0, lds);
  grid.sync();
  const XcdBarrier xb = xcd_barrier_post(p.BAR, st);
#ifndef DUP
#define DUP -1
#endif
#define PH(n) run_phase(p, n, lds); xcd_barrier(xb); if (DUP == n) { if (n == 4) phase_scan(p, lds, true); else if (n == 9) phase_gemm_resid(p, lds, p.S[0], p.w2T[0], 4096, NT / 256, p.out, p.XC, p.MOD + 5 * 1024, (float*)p.S[4]); else run_phase(p, n, lds); xcd_barrier(xb); } if (DUP == 100) { xcd_barrier(xb); }
  PH(1) PH(2) PH(3) PH(4) PH(5) PH(6) PH(7) PH(8) PH(9) PH(10) PH(11) PH(12) PH(13) PH(14) PH(15) PH(16)
  run_phase(p, 17, lds);
}

extern "C" void kernel_launch(void* const* d_in, const int* in_sizes, int n_in, void* d_out, int out_size, void* d_ws, size_t ws_size, hipStream_t stream) {
  Params p;
  memset(&p, 0, sizeof(p));
  const float* const* in = (const float* const*)d_in;
  p.x = in[0]; p.c = in[1]; p.ctx = in[2]; p.c_ctx = in[3]; p.w_mod = in[4]; p.b_mod = in[5]; p.norm_mix = in[6]; p.norm_mlp = in[7];
  p.mlp_w1 = in[8]; p.mlp_w2 = in[9]; p.mu = in[10]; p.wr = in[11]; p.wk = in[12]; p.wv = in[13]; p.wo = in[14]; p.w0 = in[15]; p.w1 = in[16];
  p.w2 = in[17]; p.a0 = in[18]; p.a1 = in[19]; p.a2 = in[20]; p.g1 = in[21]; p.g2 = in[22]; p.k_k = in[23]; p.k_a = in[24]; p.r_k = in[25];
  p.ln_w = in[26]; p.ln_b = in[27]; p.wqkv = in[28]; p.q_norm = in[29]; p.k_norm = in[30]; p.awo = in[31]; p.final_norm = in[32];
  p.out = (float*)d_out;
  char* ws = (char*)d_ws;
  size_t off = 0;
  auto take = [&](size_t bytes) -> char* { char* r = ws + off; off += (bytes + 255) & ~(size_t)255; return r; };
  p.Wcat = (bf16_t*)take((size_t)3456 * 1024 * 2);
  p.L2w = (bf16_t*)take((size_t)4 * 65536 * 2);
  p.g2T = (bf16_t*)take((size_t)1024 * 128 * 2);
  p.woT = (bf16_t*)take((size_t)1024 * 1024 * 2);
  p.w1T[0] = (bf16_t*)take((size_t)4096 * 1024 * 2);
  p.w1T[1] = (bf16_t*)take((size_t)4096 * 1024 * 2);
  p.w2T[0] = (bf16_t*)take((size_t)4096 * 1024 * 2);
  p.w2T[1] = (bf16_t*)take((size_t)4096 * 1024 * 2);
  p.wqkvT = (bf16_t*)take((size_t)1536 * 1024 * 2);
  p.awoT = (bf16_t*)take((size_t)1024 * 1024 * 2);
  p.MOD = (float*)take((size_t)2 * 9 * 6144 * 4);
  p.TAB = (float*)take((size_t)1024 * 2 * 4);
  p.XC = (float*)take((size_t)NC * 1024 * 4);
  p.BAR = (unsigned*)take((size_t)XCD_BAR_WORDS * 4);
  for (int i = 0; i < 6; ++i) p.S[i] = (bf16_t*)take((size_t)NT * 1024 * 2);
  if (off > ws_size) { fprintf(stderr, "kernel_launch: workspace too small (%zu needed, %zu given)\n", off, ws_size); return; }
  char* ob = (char*)d_out;
  p.Hd = (bf16_t*)ob;
  p.L1 = (bf16_t*)(ob + (size_t)NT * 1024 * 2);
  p.BON = (float*)(ob + (size_t)NT * 1024 * 2 + (size_t)NT * 384 * 2);
  int nj = 0, tiles = 0;
  auto job = [&](const float* src, bf16_t* dst, int K, int N) {
    p.jobs[nj].src = src; p.jobs[nj].dst = dst; p.jobs[nj].K = K; p.jobs[nj].N = N; p.jobs[nj].tstart = tiles; p.jobs[nj].tiles_n = N / 64;
    tiles += (K / 64) * (N / 64); ++nj;
  };
  job(p.wr, p.Wcat, 1024, 1024);
  job(p.wk, p.Wcat + (size_t)1024 * 1024, 1024, 1024);
  job(p.wv, p.Wcat + (size_t)2048 * 1024, 1024, 1024);
  job(p.g1, p.Wcat + (size_t)3072 * 1024, 1024, 128);
  job(p.w1, p.Wcat + (size_t)3200 * 1024, 1024, 64);
  job(p.w1 + 65536, p.Wcat + (size_t)3264 * 1024, 1024, 64);
  job(p.a1, p.Wcat + (size_t)3328 * 1024, 1024, 64);
  job(p.a1 + 65536, p.Wcat + (size_t)3392 * 1024, 1024, 64);
  job(p.a2, p.L2w, 64, 1024);
  job(p.a2 + 65536, p.L2w + 65536, 64, 1024);
  job(p.w2, p.L2w + 2 * 65536, 64, 1024);
  job(p.w2 + 65536, p.L2w + 3 * 65536, 64, 1024);
  job(p.g2, p.g2T, 128, 1024);
  job(p.wo, p.woT, 1024, 1024);
  job(p.mlp_w1, p.w1T[0], 1024, 4096);
  job(p.mlp_w1 + (size_t)4096 * 1024, p.w1T[1], 1024, 4096);
  job(p.mlp_w2, p.w2T[0], 4096, 1024);
  job(p.mlp_w2 + (size_t)4096 * 1024, p.w2T[1], 4096, 1024);
  job(p.wqkv, p.wqkvT, 1024, 1536);
  job(p.awo, p.awoT, 1024, 1024);
  p.njobs = nj; p.total_tiles = tiles;

  static int grid_blocks = 0;
  if (!grid_blocks) {
    (void)hipFuncSetAttribute((const void*)mega_kernel, hipFuncAttributeMaxDynamicSharedMemorySize, LDS_BYTES);
    (void)hipFuncSetAttribute((const void*)phase_kernel, hipFuncAttributeMaxDynamicSharedMemorySize, LDS_BYTES);
    int dev = 0, cus = 0, per_cu = 0;
    (void)hipGetDevice(&dev);
    (void)hipDeviceGetAttribute(&cus, hipDeviceAttributeMultiprocessorCount, dev);
    if (hipOccupancyMaxActiveBlocksPerMultiprocessor(&per_cu, (const void*)mega_kernel, NTHREADS, LDS_BYTES) != hipSuccess || per_cu < 1) per_cu = 1;
    if (cus <= 0) cus = 256;
    grid_blocks = cus * per_cu;
    (void)hipGetLastError();
  }
#if SINGLE_LAUNCH
  void* args[] = {&p};
  hipError_t e = hipLaunchCooperativeKernel((const void*)mega_kernel, dim3(grid_blocks), dim3(NTHREADS), args, LDS_BYTES, stream);
  if (e != hipSuccess) fprintf(stderr, "cooperative launch failed: %s (grid %d)\n", hipGetErrorString(e), grid_blocks);
#else
  for (int ph = 0; ph < NPHASE; ++ph) hipLaunchKernelGGL(phase_kernel, dim3(grid_blocks), dim3(NTHREADS), LDS_BYTES, stream, p, ph);
#endif
}
```

```cpp
#include <hip/hip_runtime.h>
#include <hip/hip_cooperative_groups.h>
#include <cstdint>
#include <cstring>
#include <cstdio>
namespace cg = cooperative_groups;

#ifndef SINGLE_LAUNCH
#define SINGLE_LAUNCH 1
#endif

typedef unsigned short bf16_t;
typedef short bf16x8 __attribute__((ext_vector_type(8)));
typedef float f32x2 __attribute__((ext_vector_type(2)));
typedef float f32x4 __attribute__((ext_vector_type(4)));
typedef float f32x16 __attribute__((ext_vector_type(16)));
typedef __bf16 bf16x2_t __attribute__((ext_vector_type(2)));
#define DI __device__ __forceinline__

constexpr int D = 1024, NB = 8, SEQ = 4096, CTXL = 256;
constexpr int NL = NB * SEQ, NC = NB * CTXL, NT = NL + NC, DFF = 4096;
constexpr int NKEY = SEQ + CTXL;
constexpr int NTHREADS = 512;
constexpr int ROWB = 144;
constexpr int GEMM_STAGE = (256 + 128) * ROWB;
constexpr int LDS_BYTES = 131072 + 16;

struct TJob { const float* src; bf16_t* dst; int K, N, tstart, tiles_n; };

struct Params {
  const float *x, *c, *ctx, *c_ctx, *w_mod, *b_mod, *norm_mix, *norm_mlp, *mlp_w1, *mlp_w2;
  const float *mu, *wr, *wk, *wv, *wo, *w0, *w1, *w2, *a0, *a1, *a2, *g1, *g2, *k_k, *k_a, *r_k, *ln_w, *ln_b;
  const float *wqkv, *q_norm, *k_norm, *awo, *final_norm;
  float* out;
  bf16_t *Wcat, *L2w, *g2T, *woT, *w1T[2], *w2T[2], *wqkvT, *awoT;
  float *MOD, *TAB, *XC;
  bf16_t* S[6];
  bf16_t *Hd, *L1;
  float* BON;
  float* NRM;
  unsigned* BAR;
  TJob jobs[20];
  int njobs, total_tiles;
};

DI unsigned pack2(float lo, float hi) {
  f32x2 v = {lo, hi};
  bf16x2_t b = __builtin_convertvector(v, bf16x2_t);
  return __builtin_bit_cast(unsigned, b);
}
DI float bflo(unsigned u) { return __uint_as_float(u << 16); }
DI float bfhi(unsigned u) { return __uint_as_float(u & 0xffff0000u); }
DI void store_bf4(bf16_t* p, float a, float b, float c, float d) { *(uint2*)p = make_uint2(pack2(a, b), pack2(c, d)); }
DI void load_bf4(const bf16_t* p, float& a, float& b, float& c, float& d) { uint2 u = *(const uint2*)p; a = bflo(u.x); b = bfhi(u.x); c = bflo(u.y); d = bfhi(u.y); }
DI void store_bf8(bf16_t* p, const f32x4& a, const f32x4& b) {
  uint4 o; o.x = pack2(a[0], a[1]); o.y = pack2(a[2], a[3]); o.z = pack2(b[0], b[1]); o.w = pack2(b[2], b[3]);
  *(uint4*)p = o;
}
DI void store16_sc1(void* p, const uint4& v) {
  typedef unsigned u32x4_t __attribute__((ext_vector_type(4)));
  const u32x4_t d = {v.x, v.y, v.z, v.w};
  asm volatile("global_store_dwordx4 %0, %1, off sc1" :: "v"(p), "v"(d) : "memory");
}
DI void unpack_bf8(const uint4& u, float (&o)[8]) {
  o[0] = bflo(u.x); o[1] = bfhi(u.x); o[2] = bflo(u.y); o[3] = bfhi(u.y); o[4] = bflo(u.z); o[5] = bfhi(u.z); o[6] = bflo(u.w); o[7] = bfhi(u.w);
}
DI int perm32(int rho) { return 8 * ((rho & 15) >> 2) + 4 * (rho >> 4) + (rho & 3); }
DI float sigmoidf_(float x) { return 1.f / (1.f + __expf(-x)); }
DI float tanhf_(float x) { return 1.f - 2.f / (1.f + __expf(2.f * x)); }
DI float quad_sum(float x) {
  x += __builtin_bit_cast(float, __builtin_amdgcn_mov_dpp(__builtin_bit_cast(int, x), 0xB1, 0xF, 0xF, true));
  x += __builtin_bit_cast(float, __builtin_amdgcn_mov_dpp(__builtin_bit_cast(int, x), 0x4E, 0xF, 0xF, true));
  return x;
}
DI float oct_sum(float x) {
  x = quad_sum(x);
  x += __builtin_bit_cast(float, __builtin_amdgcn_mov_dpp(__builtin_bit_cast(int, x), 0x141, 0xF, 0xF, true));
  return x;
}
struct StepV { f32x2 r[4], w[4], k[4], kk[4], b[4]; f32x2 v; };
DI void scan_load(StepV& s, const float* base, const float* vp) {
#pragma unroll
  for (int i = 0; i < 2; ++i) {
    const float4 t0 = *(const float4*)(base + i * 4);       s.r[2 * i] = f32x2{t0.x, t0.y};  s.r[2 * i + 1] = f32x2{t0.z, t0.w};
    const float4 t1 = *(const float4*)(base + 64 + i * 4);  s.w[2 * i] = f32x2{t1.x, t1.y};  s.w[2 * i + 1] = f32x2{t1.z, t1.w};
    const float4 t2 = *(const float4*)(base + 128 + i * 4); s.k[2 * i] = f32x2{t2.x, t2.y};  s.k[2 * i + 1] = f32x2{t2.z, t2.w};
    const float4 t3 = *(const float4*)(base + 192 + i * 4); s.kk[2 * i] = f32x2{t3.x, t3.y}; s.kk[2 * i + 1] = f32x2{t3.z, t3.w};
    const float4 t4 = *(const float4*)(base + 256 + i * 4); s.b[2 * i] = f32x2{t4.x, t4.y};  s.b[2 * i + 1] = f32x2{t4.z, t4.w};
  }
  const float2 vv = *(const float2*)vp;
  s.v = f32x2{vv.x, vv.y};
}
DI void scan_step(const StepV& s, f32x2 (&S0)[4], f32x2 (&S1)[4], float* yp, bool writer) {
  f32x2 d0 = S0[0] * s.kk[0], d1 = S1[0] * s.kk[0];
#pragma unroll
  for (int i = 1; i < 4; ++i) { d0 += S0[i] * s.kk[i]; d1 += S1[i] * s.kk[i]; }
  const float sa0 = -oct_sum(d0.x + d0.y), sa1 = -oct_sum(d1.x + d1.y);
  const f32x2 sa0v = {sa0, sa0}, sa1v = {sa1, sa1}, v0 = {s.v.x, s.v.x}, v1 = {s.v.y, s.v.y};
#pragma unroll
  for (int i = 0; i < 4; ++i) {
    S0[i] = S0[i] * s.w[i] + (sa0v * s.b[i] + v0 * s.k[i]);
    S1[i] = S1[i] * s.w[i] + (sa1v * s.b[i] + v1 * s.k[i]);
  }
  f32x2 y0 = S0[0] * s.r[0], y1 = S1[0] * s.r[0];
#pragma unroll
  for (int i = 1; i < 4; ++i) { y0 += S0[i] * s.r[i]; y1 += S1[i] * s.r[i]; }
  const float ya = oct_sum(y0.x + y0.y), yb = oct_sum(y1.x + y1.y);
  if (writer) *(float2*)yp = make_float2(ya, yb);
}
DI float wave_sum(float x) {
#pragma unroll
  for (int m = 1; m < 64; m <<= 1) x += __shfl_xor(x, m);
  return x;
}
#define MFMA16(a, b, c) __builtin_amdgcn_mfma_f32_16x16x32_bf16((a), (b), (c), 0, 0, 0)
#define MFMA32(a, b, c) __builtin_amdgcn_mfma_f32_32x32x16_bf16((a), (b), (c), 0, 0, 0)

DI unsigned lerp2(unsigned a, unsigned n, float ma, float mb) {
  const float h0 = bflo(a), h1 = bfhi(a), s0 = bflo(n), s1 = bfhi(n);
  return pack2(h0 + (s0 - h0) * ma, h1 + (s1 - h1) * mb);
}
template <bool LERP>
DI void gemm_tile(const bf16_t* __restrict__ X, int ldx, const bf16_t* __restrict__ W, int ldw, int K, int tok0, int f0,
                  char* lds, f32x4 (&acc)[4][4], const float* __restrict__ mu) {
  const int tid = threadIdx.x, lane = tid & 63, wave = tid >> 6;
  const int wt = wave & 3, wf = wave >> 2, lr = lane & 15, lq = lane >> 4;
  const int lrow = tid >> 3, kc = tid & 7;
#pragma unroll
  for (int i = 0; i < 4; ++i)
#pragma unroll
    for (int j = 0; j < 4; ++j) acc[i][j] = f32x4{0.f, 0.f, 0.f, 0.f};
  uint4 xr[4], wr[2], xn[4];
  float4 m0 = make_float4(0, 0, 0, 0), m1 = m0;
  const int nk = K >> 6;
  __syncthreads();
  for (int kt = -1; kt < nk; ++kt) {
    const bool more = kt + 1 < nk;
    if (more) {
      const int k0 = (kt + 1) << 6;
#pragma unroll
      for (int i = 0; i < 4; ++i) {
        const int tg = tok0 + lrow + 64 * i;
        xr[i] = *(const uint4*)(X + (size_t)tg * ldx + k0 + kc * 8);
        if (LERP) {
          int nb; bool valid;
          if (tok0 < NL) {
            const int s = tg & 4095, col = s & 63, rw = s >> 6, qd = k0 >> 8;
            if (qd == 0) { valid = col > 0; nb = tg - 1; }
            else if (qd == 1) { valid = col < 63; nb = tg + 1; }
            else if (qd == 2) { valid = rw > 0; nb = tg - 64; }
            else { valid = rw < 63; nb = tg + 64; }
          } else {
            const int s = (tg - NL) & 255;
            if (k0 < 512) { valid = s > 0; nb = tg - 1; }
            else { valid = s < 255; nb = tg + 1; }
          }
          if (valid) xn[i] = *(const uint4*)(X + (size_t)nb * ldx + k0 + kc * 8);
          else xn[i] = make_uint4(0, 0, 0, 0);
        }
      }
#pragma unroll
      for (int i = 0; i < 2; ++i) wr[i] = *(const uint4*)(W + (size_t)(f0 + 64 * i + (lrow & 32) + perm32(lrow & 31)) * ldw + k0 + kc * 8);
      if (LERP) { m0 = *(const float4*)(mu + k0 + kc * 8); m1 = *(const float4*)(mu + k0 + kc * 8 + 4); }
    }
    if (kt >= 0) {
      const char* xs = lds + (kt & 1) * GEMM_STAGE;
      const char* wsm = xs + 256 * ROWB;
#pragma unroll
      for (int ks = 0; ks < 2; ++ks) {
        bf16x8 wfr[4], xfr[4];
#pragma unroll
        for (int i = 0; i < 4; ++i) wfr[i] = *(const bf16x8*)(wsm + (wf * 64 + i * 16 + lr) * ROWB + ks * 64 + lq * 16);
#pragma unroll
        for (int i = 0; i < 4; ++i) xfr[i] = *(const bf16x8*)(xs + (wt * 64 + i * 16 + lr) * ROWB + ks * 64 + lq * 16);
#pragma unroll
        for (int fi = 0; fi < 4; ++fi)
#pragma unroll
          for (int ti = 0; ti < 4; ++ti) acc[fi][ti] = MFMA16(wfr[fi], xfr[ti], acc[fi][ti]);
      }
    }
    if (more) {
      char* xs = lds + ((kt + 1) & 1) * GEMM_STAGE;
      char* wsm = xs + 256 * ROWB;
#pragma unroll
      for (int i = 0; i < 4; ++i) {
        uint4 v = xr[i];
        if (LERP) {
          v.x = lerp2(xr[i].x, xn[i].x, m0.x, m0.y);
          v.y = lerp2(xr[i].y, xn[i].y, m0.z, m0.w);
          v.z = lerp2(xr[i].z, xn[i].z, m1.x, m1.y);
          v.w = lerp2(xr[i].w, xn[i].w, m1.z, m1.w);
        }
        *(uint4*)(xs + (lrow + 64 * i) * ROWB + kc * 16) = v;
      }
#pragma unroll
      for (int i = 0; i < 2; ++i) *(uint4*)(wsm + (lrow + 64 * i) * ROWB + kc * 16) = wr[i];
    }
    __syncthreads();
  }
}


namespace g256 {
constexpr int BK = 64, HALF = 128, HT = HALF * BK;
DI int lds_byte(int r, int c) { const int st = (r >> 4) * 2 + (c >> 5), rr = r & 15, cc = c & 31, ob = rr * 64 + cc * 2; return st * 1024 + (ob ^ (((ob >> 9) & 1) << 5)); }
DI void stage_rc(int b, int& R, int& C) { const int st = b / 1024, sb = b % 1024, swz = sb ^ (((sb >> 9) & 1) << 5); R = (st >> 1) * 16 + swz / 64; C = (st & 1) * 32 + (swz % 64) / 2; }
}
#define G_SA(b, h) (((b) * 2 + (h)) * 16384)
#define G_SB(b, h) ((4 + (b) * 2 + (h)) * 16384)
#define G_STAGEV(bufoff, gbase, vo) do { _Pragma("unroll") for (int _i = 0; _i < 2; ++_i) \
    __builtin_amdgcn_global_load_lds((const unsigned*)((const char*)(gbase) + (vo)[_i]), (__attribute__((address_space(3))) unsigned*)(lds + (bufoff) + ldsw + _i * 8192), 16, 0, 0); } while (0)
#define G_LDA(dst, b, h) do { _Pragma("unroll") for (int m = 0; m < 4; ++m) _Pragma("unroll") for (int k = 0; k < 2; ++k) \
    dst[m][k] = *(const __attribute__((address_space(3))) bf16x8*)(lds + G_SA(b, h) + aoff + m * 2048 + k * 1024); } while (0)
#define G_LDB(dst, b, h) do { _Pragma("unroll") for (int n = 0; n < 2; ++n) _Pragma("unroll") for (int k = 0; k < 2; ++k) \
    dst[n][k] = *(const __attribute__((address_space(3))) bf16x8*)(lds + G_SB(b, h) + boff + n * 2048 + k * 1024); } while (0)
#define G_MMA(ai, bj, At, Bt) do { __builtin_amdgcn_s_setprio(1); \
    _Pragma("unroll") for (int m = 0; m < 4; ++m) _Pragma("unroll") for (int n = 0; n < 2; ++n) _Pragma("unroll") for (int k = 0; k < 2; ++k) \
      acc[ai][bj][m][n] = __builtin_amdgcn_mfma_f32_16x16x32_bf16(At[m][k], Bt[n][k], acc[ai][bj][m][n], 0, 0, 0); \
    __builtin_amdgcn_s_setprio(0); } while (0)
#define G_WAIT_V(n) asm volatile("s_waitcnt vmcnt(" #n ")" ::: "memory")
#define G_WAIT_L(n) asm volatile("s_waitcnt lgkmcnt(" #n ")" ::: "memory")
#define G_BAR __builtin_amdgcn_s_barrier()
#define G_SCHED __builtin_amdgcn_sched_barrier(0)

template <bool PERM>
DI void gemm256_tile(const bf16_t* __restrict__ A, const bf16_t* __restrict__ Bt, int K, int brow, int bcol, char* lds_, f32x4 (&acc)[2][2][4][2]) {
  __attribute__((address_space(3))) unsigned char* lds = (__attribute__((address_space(3))) unsigned char*)lds_;
  int tid = threadIdx.x; asm volatile("" : "+v"(tid));
  const int wid = __builtin_amdgcn_readfirstlane(tid >> 6), lane = tid & 63, wr = wid >> 2, wc = wid & 3, fr = lane & 15, fq = lane >> 4;
#pragma unroll
  for (int a = 0; a < 2; ++a)
#pragma unroll
    for (int b = 0; b < 2; ++b)
#pragma unroll
      for (int m = 0; m < 4; ++m)
#pragma unroll
        for (int n = 0; n < 2; ++n) acc[a][b][m][n] = f32x4{0.f, 0.f, 0.f, 0.f};
  unsigned voff[2], voffA[2];
#pragma unroll
  for (int i = 0; i < 2; ++i) { int R, C; g256::stage_rc(tid * 16 + i * 8192, R, C); voff[i] = (unsigned)(R * K + C) * 2u;
    const int Ra = PERM ? ((R & ~31) + perm32(R & 31)) : R; voffA[i] = (unsigned)(Ra * K + C) * 2u; }
  const size_t kstep = 128, hstep = (size_t)128 * K * 2;
  const unsigned ldsw = (unsigned)wid * 1024u;
  const int aoff = g256::lds_byte(wr * 64 + fr, fq * 8), boff = g256::lds_byte(wc * 32 + fr, fq * 8);
  const char* cA = (const char*)A + (size_t)brow * K * 2;
  const char* cB = (const char*)Bt + (size_t)bcol * K * 2;
  bf16x8 At[4][2], B0[2][2], B1[2][2];
  const int nt = K / g256::BK;
  __syncthreads();
  G_STAGEV(G_SB(0, 0), cB, voff); G_STAGEV(G_SA(0, 0), cA, voffA); G_STAGEV(G_SB(0, 1), cB + hstep, voff); G_STAGEV(G_SA(0, 1), cA + hstep, voffA);
  if (wr == 1) G_BAR;
  G_WAIT_V(4); G_BAR;
  G_STAGEV(G_SB(1, 0), cB + kstep, voff); G_STAGEV(G_SA(1, 0), cA + kstep, voffA); G_STAGEV(G_SB(1, 1), cB + hstep + kstep, voff);
  G_WAIT_V(6); G_BAR;
  for (int t = 0; t < nt - 2; t += 2) {
    const char* a1 = cA + (size_t)(t + 1) * kstep;
    const char* a2 = cA + (size_t)(t + 2) * kstep; const char* b2 = cB + (size_t)(t + 2) * kstep;
    const char* a3 = a2 + kstep; const char* b3 = b2 + kstep;
    G_LDB(B0, 0, 0); G_SCHED; G_LDA(At, 0, 0); G_STAGEV(G_SA(1, 1), a1 + hstep, voffA);
    G_WAIT_L(8); G_BAR; G_WAIT_L(0); G_MMA(0, 0, At, B0); G_BAR; G_SCHED;
    G_LDB(B1, 0, 1); G_STAGEV(G_SB(0, 0), b2, voff);
    G_BAR; G_WAIT_L(0); G_MMA(0, 1, At, B1); G_BAR;
    G_LDA(At, 0, 1); G_STAGEV(G_SA(0, 0), a2, voffA);
    G_BAR; G_WAIT_L(0); G_MMA(1, 0, At, B0); G_BAR; G_SCHED;
    G_STAGEV(G_SB(0, 1), b2 + hstep, voff);
    G_WAIT_V(6); G_BAR; G_MMA(1, 1, At, B1); G_BAR;
    G_LDB(B0, 1, 0); G_SCHED; G_LDA(At, 1, 0); G_STAGEV(G_SA(0, 1), a2 + hstep, voffA);
    G_WAIT_L(8); G_BAR; G_WAIT_L(0); G_MMA(0, 0, At, B0); G_BAR; G_SCHED;
    G_LDB(B1, 1, 1); G_STAGEV(G_SB(1, 0), b3, voff);
    G_BAR; G_WAIT_L(0); G_MMA(0, 1, At, B1); G_BAR;
    G_LDA(At, 1, 1); G_STAGEV(G_SA(1, 0), a3, voffA);
    G_BAR; G_WAIT_L(0); G_MMA(1, 0, At, B0); G_BAR; G_SCHED;
    G_STAGEV(G_SB(1, 1), b3 + hstep, voff);
    G_WAIT_V(6); G_BAR; G_MMA(1, 1, At, B1); G_BAR;
  }
  { G_LDB(B0, 0, 0); G_LDA(At, 0, 0); G_STAGEV(G_SA(1, 1), cA + (size_t)(nt - 1) * kstep + hstep, voffA);
    G_BAR; G_WAIT_L(0); G_MMA(0, 0, At, B0); G_BAR;
    G_LDB(B1, 0, 1); G_BAR; G_WAIT_L(0); G_MMA(0, 1, At, B1); G_BAR;
    G_LDA(At, 0, 1); G_WAIT_V(4); G_BAR; G_WAIT_L(0); G_MMA(1, 0, At, B0); G_MMA(1, 1, At, B1); G_BAR; }
  { G_LDB(B0, 1, 0); G_LDA(At, 1, 0); G_WAIT_V(2); G_BAR; G_WAIT_L(0); G_MMA(0, 0, At, B0); G_BAR;
    G_LDB(B1, 1, 1); G_WAIT_V(0); G_BAR; G_WAIT_L(0); G_MMA(0, 1, At, B1); G_BAR;
    G_LDA(At, 1, 1); G_BAR; G_WAIT_L(0); G_MMA(1, 0, At, B0); G_MMA(1, 1, At, B1); G_BAR; }
  if (wr == 0) G_BAR;
}

DI void convert_tile(const TJob& jb, int t, char* lds) {
  float* tile = (float*)lds;
  const int tid = threadIdx.x;
  const int tk = t / jb.tiles_n, tn = t % jb.tiles_n;
  const int k0 = tk * 64, n0 = tn * 64;
  __syncthreads();
#pragma unroll
  for (int i = 0; i < 2; ++i) {
    const int idx = tid + 512 * i, row = idx >> 4, c4 = idx & 15;
    const float4 v = *(const float4*)(jb.src + (size_t)(k0 + row) * jb.N + n0 + c4 * 4);
    tile[row * 65 + c4 * 4 + 0] = v.x; tile[row * 65 + c4 * 4 + 1] = v.y; tile[row * 65 + c4 * 4 + 2] = v.z; tile[row * 65 + c4 * 4 + 3] = v.w;
  }
  __syncthreads();
  const int n = tid >> 3, kc = tid & 7;
  float v[8];
#pragma unroll
  for (int j = 0; j < 8; ++j) v[j] = tile[(kc * 8 + j) * 65 + n];
  uint4 o;
  o.x = pack2(v[0], v[1]); o.y = pack2(v[2], v[3]); o.z = pack2(v[4], v[5]); o.w = pack2(v[6], v[7]);
  *(uint4*)(jb.dst + (size_t)(n0 + n) * jb.K + k0 + kc * 8) = o;
}

DI void mod_unit(const Params& p, int mu_, char* lds) {
  const int tid = threadIdx.x;
  const int layer = mu_ / 96, cc = mu_ % 96;
  float* sc = (float*)lds;
  float* red = sc + 9 * 1024;
  __syncthreads();
  for (int i = tid; i < 9 * 1024; i += 512) {
    const int row = i >> 10, k = i & 1023;
    const float v = row < 8 ? p.c[row * 1024 + k] : p.c_ctx[k];
    sc[i] = v / (1.f + __expf(-v));
  }
  __syncthreads();
  const int kg = tid >> 6, col = tid & 63;
  const float* w = p.w_mod + (size_t)layer * 1024 * 6144 + cc * 64 + col;
  float a[9];
#pragma unroll
  for (int r = 0; r < 9; ++r) a[r] = 0.f;
#pragma unroll 4
  for (int k = kg * 128; k < kg * 128 + 128; ++k) {
    const float wv = w[(size_t)k * 6144];
#pragma unroll
    for (int r = 0; r < 9; ++r) a[r] += sc[r * 1024 + k] * wv;
  }
#pragma unroll
  for (int r = 0; r < 9; ++r) red[(kg * 9 + r) * 64 + col] = a[r];
  __syncthreads();
  for (int i = tid; i < 576; i += 512) {
    const int r = i >> 6, cl = i & 63;
    float s = 0.f;
#pragma unroll
    for (int g = 0; g < 8; ++g) s += red[(g * 9 + r) * 64 + cl];
    const int n = cc * 64 + cl;
    p.MOD[(layer * 9 + r) * 6144 + n] = s + p.b_mod[layer * 6144 + n];
  }
  __syncthreads();
}

DI void sincos_d(double a, double& s, double& c) {
  const double n = rint(a * 0.6366197723675814);
  const double r = (a - n * 1.5707963267948966) - n * 6.123233995736766e-17;
  const double r2 = r * r;
  const double sp = r * (1.0 + r2 * (-1.0 / 6.0 + r2 * (1.0 / 120.0 + r2 * (-1.0 / 5040.0 + r2 * (1.0 / 362880.0 + r2 * (-1.0 / 39916800.0 + r2 * (1.0 / 6227020800.0)))))));
  const double cp = 1.0 + r2 * (-0.5 + r2 * (1.0 / 24.0 + r2 * (-1.0 / 720.0 + r2 * (1.0 / 40320.0 + r2 * (-1.0 / 3628800.0 + r2 * (1.0 / 479001600.0 + r2 * (-1.0 / 87178291200.0)))))));
  const int q = ((int)n) & 3;
  if (q == 0) { s = sp; c = cp; }
  else if (q == 1) { s = cp; c = -sp; }
  else if (q == 2) { s = -sp; c = -cp; }
  else { s = -cp; c = sp; }
}

DI void tab_unit(const Params& p) {
  for (int idx = threadIdx.x; idx < 1024; idx += 512) {
    const int pos = idx >> 4, fi = idx & 15;
    double f = 1.0;
    for (int i = 0; i < fi; ++i) f *= 0.5623413251903491;
    double s, c;
    sincos_d((double)pos * (double)(float)f, s, c);
    p.TAB[idx * 2 + 0] = (float)c;
    p.TAB[idx * 2 + 1] = (float)s;
  }
}

__device__ void phase0(const Params& p, char* lds) {
  const int total = p.total_tiles + 192 + 1;
  for (int u = blockIdx.x; u < total; u += gridDim.x) {
    if (u < p.total_tiles) {
      int j = 0;
#pragma unroll 1
      for (int q = 1; q < p.njobs; ++q) if (u >= p.jobs[q].tstart) j = q;
      convert_tile(p.jobs[j], u - p.jobs[j].tstart, lds);
    } else if (u < p.total_tiles + 192) {
      mod_unit(p, u - p.total_tiles, lds);
    } else {
      tab_unit(p);
    }
  }
}

DI void norm_mod_phase(const float* __restrict__ xl, const float* __restrict__ xc, const float* __restrict__ gain,
                               const float* __restrict__ mod, int shift_i, int scale_i, bf16_t* __restrict__ H, int ntok) {
  const int lane = threadIdx.x & 63;
  const int wg = blockIdx.x * 8 + (threadIdx.x >> 6), nw = gridDim.x * 8;
  for (int t = wg; t < ntok; t += nw) {
    const float* row = t < NL ? xl + (size_t)t * 1024 : xc + (size_t)(t - NL) * 1024;
    float4 v[4];
    float ss = 0.f;
#pragma unroll
    for (int i = 0; i < 4; ++i) {
      v[i] = *(const float4*)(row + (lane + 64 * i) * 4);
      ss += v[i].x * v[i].x + v[i].y * v[i].y + v[i].z * v[i].z + v[i].w * v[i].w;
    }
    ss = wave_sum(ss);
    const float rstd = rsqrtf(ss * (1.f / 1024.f) + 1e-6f);
    const int bp = t < NL ? (t >> 12) : 8;
    const float* sh = mod + (bp * 6 + shift_i) * 1024;
    const float* sc = mod + (bp * 6 + scale_i) * 1024;
#pragma unroll
    for (int i = 0; i < 4; ++i) {
      const int c = (lane + 64 * i) * 4;
      const float4 g = *(const float4*)(gain + c), s4 = *(const float4*)(sh + c), c4 = *(const float4*)(sc + c);
      store_bf4(H + (size_t)t * 1024 + c,
                v[i].x * rstd * g.x * (1.f + c4.x) + s4.x, v[i].y * rstd * g.y * (1.f + c4.y) + s4.y,
                v[i].z * rstd * g.z * (1.f + c4.z) + s4.z, v[i].w * rstd * g.w * (1.f + c4.w) + s4.w);
    }
  }
}

__device__ void final_norm_phase(const Params& p) {
  const int lane = threadIdx.x & 63;
  const int wg = blockIdx.x * 8 + (threadIdx.x >> 6), nw = gridDim.x * 8;
  for (int t = wg; t < NL; t += nw) {
    float* row = p.out + (size_t)t * 1024;
    float4 v[4];
    float ss = 0.f;
#pragma unroll
    for (int i = 0; i < 4; ++i) {
      v[i] = *(const float4*)(row + (lane + 64 * i) * 4);
      ss += v[i].x * v[i].x + v[i].y * v[i].y + v[i].z * v[i].z + v[i].w * v[i].w;
    }
    ss = wave_sum(ss);
    const float rstd = rsqrtf(ss * (1.f / 1024.f) + 1e-6f);
#pragma unroll
    for (int i = 0; i < 4; ++i) {
      const int c = (lane + 64 * i) * 4;
      const float4 g = *(const float4*)(p.final_norm + c);
      *(float4*)(row + c) = make_float4(v[i].x * rstd * g.x, v[i].y * rstd * g.y, v[i].z * rstd * g.z, v[i].w * rstd * g.w);
    }
  }
}

__device__ void phase_proj(const Params& p, char* lds) {
  const int lane = threadIdx.x & 63, wave = threadIdx.x >> 6;
  const int wt = wave & 3, wf = wave >> 2, lr = lane & 15, lq = lane >> 4;
  const int ntn = 27, total = (NT / 256) * ntn;
  for (int u = blockIdx.x; u < total; u += gridDim.x) {
    const int mt = u / ntn, nt = u % ntn;
    const int mi = nt < 8 ? 0 : nt < 16 ? 2 : nt < 24 ? 3 : nt == 24 ? 5 : nt == 25 ? 1 : 4;
    f32x4 acc[4][4];
    gemm_tile<true>(p.Hd, 1024, p.Wcat, 1024, 1024, mt * 256, nt * 128, lds, acc, p.mu + mi * 1024);
#pragma unroll
    for (int pp = 0; pp < 2; ++pp)
#pragma unroll
      for (int ti = 0; ti < 4; ++ti) {
        const int t = mt * 256 + wt * 64 + ti * 16 + lr;
        const int fl = wf * 64 + pp * 32 + lq * 8;
        f32x4 a = acc[2 * pp][ti], b = acc[2 * pp + 1][ti];
        if (nt >= 8 && nt < 16) {
          const int f = (nt & 7) * 128 + fl;
          const float4 kkl = *(const float4*)(p.k_k + f), kkh = *(const float4*)(p.k_k + f + 4);
          a[0] *= kkl.x; a[1] *= kkl.y; a[2] *= kkl.z; a[3] *= kkl.w; b[0] *= kkh.x; b[1] *= kkh.y; b[2] *= kkh.z; b[3] *= kkh.w;
          const f32x4 a2 = acc[2 * (1 - pp)][ti], b2 = acc[2 * (1 - pp) + 1][ti];
          const int f2 = (nt & 7) * 128 + wf * 64 + (1 - pp) * 32 + lq * 8;
          const float4 kkl2 = *(const float4*)(p.k_k + f2), kkh2 = *(const float4*)(p.k_k + f2 + 4);
          float ss = a[0] * a[0] + a[1] * a[1] + a[2] * a[2] + a[3] * a[3] + b[0] * b[0] + b[1] * b[1] + b[2] * b[2] + b[3] * b[3];
          ss += a2[0] * kkl2.x * a2[0] * kkl2.x + a2[1] * kkl2.y * a2[1] * kkl2.y + a2[2] * kkl2.z * a2[2] * kkl2.z + a2[3] * kkl2.w * a2[3] * kkl2.w
              + b2[0] * kkh2.x * b2[0] * kkh2.x + b2[1] * kkh2.y * b2[1] * kkh2.y + b2[2] * kkh2.z * b2[2] * kkh2.z + b2[3] * kkh2.w * b2[3] * kkh2.w;
          ss += __shfl_xor(ss, 16); ss += __shfl_xor(ss, 32);
          const float kinv = rsqrtf(ss + 1e-12f);
#pragma unroll
          for (int j = 0; j < 4; ++j) { a[j] *= kinv; b[j] *= kinv; }
          store_bf8(p.S[2] + (size_t)t * 1024 + f, a, b);
          if (pp == 0 && lq == 0) p.NRM[(size_t)((nt & 7) * 2 + wf) * NT + t] = sqrtf(ss + 1e-12f);
        } else if (nt < 24) {
          bf16_t* dst = nt < 8 ? p.S[0] : p.S[1];
          store_bf8(dst + (size_t)t * 1024 + (nt & 7) * 128 + fl, a, b);
        } else if (nt == 24) {
#pragma unroll
          for (int j = 0; j < 4; ++j) { a[j] = sigmoidf_(a[j]); b[j] = sigmoidf_(b[j]); }
          store_bf8(p.L1 + (size_t)t * 384 + fl, a, b);
        } else if (nt == 25) {
#pragma unroll
          for (int j = 0; j < 4; ++j) { a[j] = tanhf_(a[j]); b[j] = tanhf_(b[j]); }
          store_bf8(p.L1 + (size_t)t * 384 + 128 + fl, a, b);
        } else {
          store_bf8(p.L1 + (size_t)t * 384 + 256 + fl, a, b);
        }
      }
  }
}

__device__ void phase_prep(const Params& p, char* lds) {
  const int lane = threadIdx.x & 63, wave = threadIdx.x >> 6;
  const int wt = wave & 3, wf = wave >> 2, lr = lane & 15, lq = lane >> 4;
  const int total = (NT / 256) * 8;
  for (int u = blockIdx.x; u < total; u += gridDim.x) {
    const int mt = u >> 3, nt = u & 7;
    const int tok0 = mt * 256, f0 = nt * 128;
    f32x4 acc[4][4];
    uint4 afp[2][4];
    gemm_tile<false>(p.L1 + 256, 384, p.L2w + 0 * 65536, 64, 64, tok0, f0, lds, acc, nullptr);
#pragma unroll
    for (int pp = 0; pp < 2; ++pp) {
      const int f = f0 + wf * 64 + pp * 32 + lq * 8;
      const float4 a0l = *(const float4*)(p.a0 + f), a0h = *(const float4*)(p.a0 + f + 4);
#pragma unroll
      for (int ti = 0; ti < 4; ++ti) {
        const int t = tok0 + wt * 64 + ti * 16 + lr;
        f32x4 a = acc[2 * pp][ti], b = acc[2 * pp + 1][ti];
        a[0] = sigmoidf_(a[0] + a0l.x); a[1] = sigmoidf_(a[1] + a0l.y); a[2] = sigmoidf_(a[2] + a0l.z); a[3] = sigmoidf_(a[3] + a0l.w);
        b[0] = sigmoidf_(b[0] + a0h.x); b[1] = sigmoidf_(b[1] + a0h.y); b[2] = sigmoidf_(b[2] + a0h.z); b[3] = sigmoidf_(b[3] + a0h.w);
        uint4 o; o.x = pack2(a[0], a[1]); o.y = pack2(a[2], a[3]); o.z = pack2(b[0], b[1]); o.w = pack2(b[2], b[3]);
        afp[pp][ti] = o;
        *(uint4*)(p.S[3] + (size_t)t * 1024 + f) = o;
      }
    }
    gemm_tile<false>(p.L1 + 320, 384, p.L2w + 1 * 65536, 64, 64, tok0, f0, lds, acc, nullptr);
#pragma unroll
    for (int ti = 0; ti < 4; ++ti) {
      const int t = tok0 + wt * 64 + ti * 16 + lr;
      float bon = 0.f;
      const float nrm = p.NRM[(size_t)(nt * 2 + wf) * NT + t];
#pragma unroll
      for (int pp = 0; pp < 2; ++pp) {
        const int f = f0 + wf * 64 + pp * 32 + lq * 8;
        const float4 a0l = *(const float4*)(p.a0 + 1024 + f), a0h = *(const float4*)(p.a0 + 1024 + f + 4);
        const float4 rkl = *(const float4*)(p.r_k + f), rkh = *(const float4*)(p.r_k + f + 4);
        const float4 kal = *(const float4*)(p.k_a + f), kah = *(const float4*)(p.k_a + f + 4);
        const float4 kkl = *(const float4*)(p.k_k + f), kkh = *(const float4*)(p.k_k + f + 4);
        const float rk8[8] = {rkl.x, rkl.y, rkl.z, rkl.w, rkh.x, rkh.y, rkh.z, rkh.w};
        const float ka8[8] = {kal.x, kal.y, kal.z, kal.w, kah.x, kah.y, kah.z, kah.w};
        const float kk8[8] = {kkl.x, kkl.y, kkl.z, kkl.w, kkh.x, kkh.y, kkh.z, kkh.w};
        f32x4 a = acc[2 * pp][ti], b = acc[2 * pp + 1][ti];
        a[0] = sigmoidf_(a[0] + a0l.x); a[1] = sigmoidf_(a[1] + a0l.y); a[2] = sigmoidf_(a[2] + a0l.z); a[3] = sigmoidf_(a[3] + a0l.w);
        b[0] = sigmoidf_(b[0] + a0h.x); b[1] = sigmoidf_(b[1] + a0h.y); b[2] = sigmoidf_(b[2] + a0h.z); b[3] = sigmoidf_(b[3] + a0h.w);
        store_bf8(p.S[4] + (size_t)t * 1024 + f, a, b);
        const float ab8[8] = {a[0], a[1], a[2], a[3], b[0], b[1], b[2], b[3]};
        float af8[8], r8[8], k8[8];
        unpack_bf8(afp[pp][ti], af8);
        unpack_bf8(*(const uint4*)(p.S[0] + (size_t)t * 1024 + f), r8);
        unpack_bf8(*(const uint4*)(p.S[2] + (size_t)t * 1024 + f), k8);
#pragma unroll
        for (int e2 = 0; e2 < 8; ++e2) {
          const float k = k8[e2] * nrm / kk8[e2];
          bon += r8[e2] * k * rk8[e2] * (2.f + (ab8[e2] + af8[e2] - 2.f) * ka8[e2]);
        }
      }
      bon += __shfl_xor(bon, 16); bon += __shfl_xor(bon, 32);
      if (lq == 0) p.BON[(size_t)(nt * 2 + wf) * NT + t] = bon;
    }
#pragma unroll 1
    for (int dr = 0; dr < 2; ++dr) {
      gemm_tile<false>(p.L1 + 128 + dr * 64, 384, p.L2w + (2 + dr) * 65536, 64, 64, tok0, f0, lds, acc, nullptr);
      bf16_t* dst = dr ? p.S[5] : p.Hd;
#pragma unroll
      for (int pp = 0; pp < 2; ++pp) {
        const int f = f0 + wf * 64 + pp * 32 + lq * 8;
        const float4 w0l = *(const float4*)(p.w0 + dr * 1024 + f), w0h = *(const float4*)(p.w0 + dr * 1024 + f + 4);
#pragma unroll
        for (int ti = 0; ti < 4; ++ti) {
          const int t = tok0 + wt * 64 + ti * 16 + lr;
          f32x4 a = acc[2 * pp][ti], b = acc[2 * pp + 1][ti];
          a[0] = -0.60653066f * sigmoidf_(a[0] + w0l.x); a[1] = -0.60653066f * sigmoidf_(a[1] + w0l.y);
          a[2] = -0.60653066f * sigmoidf_(a[2] + w0l.z); a[3] = -0.60653066f * sigmoidf_(a[3] + w0l.w);
          b[0] = -0.60653066f * sigmoidf_(b[0] + w0h.x); b[1] = -0.60653066f * sigmoidf_(b[1] + w0h.y);
          b[2] = -0.60653066f * sigmoidf_(b[2] + w0h.z); b[3] = -0.60653066f * sigmoidf_(b[3] + w0h.w);
          store_bf8(dst + (size_t)t * 1024 + f, a, b);
        }
      }
    }
  }
}

__device__ void phase_scan(const Params& p, char* lds, bool dupout = false) {
  float* buf = (float*)lds;
  float* ybuf = (float*)(lds + 2 * 49152);
  const int tid = threadIdx.x;
  const bool loader = tid >= 256;
  const int lt = tid & 255, ltk = lt >> 3, lch = (lt & 7) * 8;
  const int rp = lt >> 3, l8 = lt & 7;
  constexpr int NCH = NKEY / 32;
  for (int unit = blockIdx.x; unit < 256; unit += gridDim.x) {
    const int dir = unit & 1, h = (unit >> 1) & 15, b = unit >> 5;
    const bf16_t* Rp = p.S[0]; const bf16_t* Vp = p.S[1]; const bf16_t* Kp = p.S[2];
    bf16_t* Ap = dir ? p.S[4] : p.S[3];
    const bf16_t* Lp = dir ? p.S[5] : p.Hd;
    auto tok_of = [&](int i) -> int {
      if (i < 256) return NL + b * 256 + (dir ? 255 - i : i);
      const int s = i - 256;
      return b * 4096 + (dir ? 4095 - s : s);
    };
    uint4 raw[5];
    float nrmv = 0.f;
    float kkc[8], kac[8];
    f32x2 S0[4], S1[4];
#pragma unroll
    for (int i = 0; i < 4; ++i) { S0[i] = f32x2{0.f, 0.f}; S1[i] = f32x2{0.f, 0.f}; }
    if (loader) {
#pragma unroll
      for (int j = 0; j < 8; ++j) { kkc[j] = p.k_k[h * 64 + lch + j]; kac[j] = p.k_a[h * 64 + lch + j]; }
    }
    auto issue = [&](int c) {
      const int t = tok_of(c * 32 + ltk);
      const size_t off = (size_t)t * 1024 + h * 64 + lch;
      raw[0] = *(const uint4*)(Rp + off); raw[1] = *(const uint4*)(Vp + off); raw[2] = *(const uint4*)(Kp + off);
      raw[3] = *(const uint4*)(Ap + off); raw[4] = *(const uint4*)(Lp + off);
      nrmv = p.NRM[(size_t)h * NT + t];
    };
    auto unpack8 = [&](const uint4& u, float (&o)[8]) {
      o[0] = bflo(u.x); o[1] = bfhi(u.x); o[2] = bflo(u.y); o[3] = bfhi(u.y); o[4] = bflo(u.z); o[5] = bfhi(u.z); o[6] = bflo(u.w); o[7] = bfhi(u.w);
    };
    auto process = [&](int stage) {
      float r8[8], v8[8], k8[8], a8[8], l8[8], kk8[8], kd8[8], b8[8], w8[8];
      unpack8(raw[0], r8); unpack8(raw[1], v8); unpack8(raw[2], k8); unpack8(raw[3], a8); unpack8(raw[4], l8);
#pragma unroll
      for (int j = 0; j < 8; ++j) {
        kk8[j] = k8[j];
        const float k = k8[j] * nrmv / kkc[j];
        kd8[j] = k * (1.f + (a8[j] - 1.f) * kac[j]);
        b8[j] = kk8[j] * a8[j];
        w8[j] = __expf(l8[j]);
      }
      float* dst = buf + stage * 12288 + ltk * 384 + lch;
      *(float4*)(dst + 0) = make_float4(r8[0], r8[1], r8[2], r8[3]);       *(float4*)(dst + 4) = make_float4(r8[4], r8[5], r8[6], r8[7]);
      *(float4*)(dst + 64) = make_float4(w8[0], w8[1], w8[2], w8[3]);      *(float4*)(dst + 68) = make_float4(w8[4], w8[5], w8[6], w8[7]);
      *(float4*)(dst + 128) = make_float4(kd8[0], kd8[1], kd8[2], kd8[3]); *(float4*)(dst + 132) = make_float4(kd8[4], kd8[5], kd8[6], kd8[7]);
      *(float4*)(dst + 192) = make_float4(kk8[0], kk8[1], kk8[2], kk8[3]); *(float4*)(dst + 196) = make_float4(kk8[4], kk8[5], kk8[6], kk8[7]);
      *(float4*)(dst + 256) = make_float4(b8[0], b8[1], b8[2], b8[3]);     *(float4*)(dst + 260) = make_float4(b8[4], b8[5], b8[6], b8[7]);
      *(float4*)(dst + 320) = make_float4(v8[0], v8[1], v8[2], v8[3]);     *(float4*)(dst + 324) = make_float4(v8[4], v8[5], v8[6], v8[7]);
    };
    auto yout = [&](int c) {
      const float* yb = ybuf + (c & 1) * 2048 + ltk * 64 + lch;
      const float4 y0 = *(const float4*)yb, y1 = *(const float4*)(yb + 4);
      const int t = tok_of(c * 32 + ltk);
      uint4 o;
      o.x = pack2(y0.x, y0.y); o.y = pack2(y0.z, y0.w); o.z = pack2(y1.x, y1.y); o.w = pack2(y1.z, y1.w);
      *(uint4*)((dupout ? p.S[0] : Ap) + (size_t)t * 1024 + h * 64 + lch) = o;
    };
    __syncthreads();
    if (loader) { issue(0); process(0); issue(1); }
    __syncthreads();
    for (int c = 0; c < NCH; ++c) {
      if (loader) {
        if (c >= 1) yout(c - 1);
        if (c + 1 < NCH) { process((c + 1) & 1); if (c + 2 < NCH) issue(c + 2); }
      } else {
        const float* bb = buf + (c & 1) * 12288 + l8 * 8;
        const float* vb = buf + (c & 1) * 12288 + 320 + 2 * rp;
        float* yb = ybuf + (c & 1) * 2048 + 2 * rp;
        StepV A, B;
        scan_load(A, bb, vb);
#pragma unroll 1
        for (int j = 0; j < 32; j += 2) {
          scan_load(B, bb + (j + 1) * 384, vb + (j + 1) * 384);
          scan_step(A, S0, S1, yb + j * 64, l8 == 0);
          if (j + 2 < 32) scan_load(A, bb + (j + 2) * 384, vb + (j + 2) * 384);
          scan_step(B, S0, S1, yb + (j + 1) * 64, l8 == 0);
        }
      }
      __syncthreads();
    }
    if (loader) yout(NCH - 1);
    __syncthreads();
  }
}

__device__ void phase_readout(const Params& p, char* lds) {
  const int lane = threadIdx.x & 63, wave = threadIdx.x >> 6;
  const int wt = wave & 3, wf = wave >> 2, lr = lane & 15, lq = lane >> 4;
  const int total = (NT / 256) * 8;
  for (int u = blockIdx.x; u < total; u += gridDim.x) {
    const int mt = u >> 3, nt = u & 7;
    const int tok0 = mt * 256, f0 = nt * 128;
    f32x4 g[4][4];
    gemm_tile<false>(p.L1, 384, p.g2T, 128, 128, tok0, f0, lds, g, nullptr);
    const int head = nt * 2 + wf;
#pragma unroll
    for (int ti = 0; ti < 4; ++ti) {
      const int t = tok0 + wt * 64 + ti * 16 + lr;
      float y[2][8];
      float sum = 0.f;
#pragma unroll
      for (int pp = 0; pp < 2; ++pp) {
        const int f = f0 + wf * 64 + pp * 32 + lq * 8;
        float ya[8], yb[8];
        unpack_bf8(*(const uint4*)(p.S[3] + (size_t)t * 1024 + f), ya);
        unpack_bf8(*(const uint4*)(p.S[4] + (size_t)t * 1024 + f), yb);
#pragma unroll
        for (int e2 = 0; e2 < 8; ++e2) { y[pp][e2] = ya[e2] + yb[e2]; sum += y[pp][e2]; }
      }
      sum += __shfl_xor(sum, 16); sum += __shfl_xor(sum, 32);
      const float mean = sum * (1.f / 64.f);
      float vs = 0.f;
#pragma unroll
      for (int pp = 0; pp < 2; ++pp)
#pragma unroll
        for (int e2 = 0; e2 < 8; ++e2) { const float d = y[pp][e2] - mean; vs += d * d; }
      vs += __shfl_xor(vs, 16); vs += __shfl_xor(vs, 32);
      const float rstd = rsqrtf(vs * (1.f / 64.f) + 64e-5f);
      const float bon = p.BON[(size_t)head * NT + t];
#pragma unroll
      for (int pp = 0; pp < 2; ++pp) {
        const int f = f0 + wf * 64 + pp * 32 + lq * 8;
        const float4 lwl = *(const float4*)(p.ln_w + f), lwh = *(const float4*)(p.ln_w + f + 4);
        const float4 lbl = *(const float4*)(p.ln_b + f), lbh = *(const float4*)(p.ln_b + f + 4);
        const float lw8[8] = {lwl.x, lwl.y, lwl.z, lwl.w, lwh.x, lwh.y, lwh.z, lwh.w};
        const float lb8[8] = {lbl.x, lbl.y, lbl.z, lbl.w, lbh.x, lbh.y, lbh.z, lbh.w};
        float v8[8];
        unpack_bf8(*(const uint4*)(p.S[1] + (size_t)t * 1024 + f), v8);
        f32x4 oa, ob;
#pragma unroll
        for (int j = 0; j < 4; ++j) {
          oa[j] = ((y[pp][j] - mean) * rstd * lw8[j] + lb8[j] + bon * v8[j]) * g[2 * pp][ti][j];
          ob[j] = ((y[pp][4 + j] - mean) * rstd * lw8[4 + j] + lb8[4 + j] + bon * v8[4 + j]) * g[2 * pp + 1][ti][j];
        }
        store_bf8(p.S[0] + (size_t)t * 1024 + f, oa, ob);
      }
    }
  }
}

DI void phase_gemm_resid(const Params& p, char* lds, const bf16_t* A, const bf16_t* W, int K, int ntm,
                                 const float* xin_l, const float* xin_c, const float* gate, float* dummy_out = nullptr) {
  const int lane = threadIdx.x & 63, wave = threadIdx.x >> 6;
  const int wr = wave >> 2, wc = wave & 3;
  const int total = ntm * 4;
  for (int u = blockIdx.x; u < total; u += gridDim.x) {
    const int mt = u >> 2, nt = u & 3;
    f32x4 acc[2][2][4][2];
    gemm256_tile<true>(W, A, K, nt * 256, mt * 256, lds, acc);
    int lane_o = threadIdx.x & 63; asm volatile("" : "+v"(lane_o));
    const int fr = lane_o & 15, fq = lane_o >> 4;
#pragma unroll
    for (int bj = 0; bj < 2; ++bj)
#pragma unroll
      for (int n = 0; n < 2; ++n) {
        const int t = mt * 256 + bj * 128 + wc * 32 + n * 16 + fr;
        const int bp = t < NL ? (t >> 12) : 8;
        const float* xi = t < NL ? xin_l + (size_t)t * 1024 : xin_c + (size_t)(t - NL) * 1024;
        float* xo = dummy_out ? dummy_out + (size_t)t * 1024 : (t < NL ? p.out + (size_t)t * 1024 : p.XC + (size_t)(t - NL) * 1024);
#pragma unroll
        for (int ai = 0; ai < 2; ++ai)
#pragma unroll
          for (int mp = 0; mp < 2; ++mp) {
            const int f = nt * 256 + ai * 128 + wr * 64 + mp * 32 + fq * 8;
            const float4 g0 = *(const float4*)(gate + bp * 6144 + f), g1 = *(const float4*)(gate + bp * 6144 + f + 4);
            const float4 x0 = *(const float4*)(xi + f), x1 = *(const float4*)(xi + f + 4);
            const f32x4 a = acc[ai][bj][2 * mp][n], b = acc[ai][bj][2 * mp + 1][n];
            *(float4*)(xo + f) = make_float4(x0.x + g0.x * a[0], x0.y + g0.y * a[1], x0.z + g0.z * a[2], x0.w + g0.w * a[3]);
            *(float4*)(xo + f + 4) = make_float4(x1.x + g1.x * b[0], x1.y + g1.y * b[1], x1.z + g1.z * b[2], x1.w + g1.w * b[3]);
          }
      }
  }
}

DI void phase_up(const Params& p, char* lds, const bf16_t* H, const bf16_t* W, bf16_t* U, int ntm) {
  const int lane = threadIdx.x & 63, wave = threadIdx.x >> 6;
  const int wr = wave >> 2, wc = wave & 3;
  const int total = ntm * 16;
  for (int u = blockIdx.x; u < total; u += gridDim.x) {
    const int mt = u >> 4, nt = u & 15;
    f32x4 acc[2][2][4][2];
    gemm256_tile<true>(W, H, 1024, nt * 256, mt * 256, lds, acc);
    int lane_o = threadIdx.x & 63; asm volatile("" : "+v"(lane_o));
    const int fr = lane_o & 15, fq = lane_o >> 4;
#pragma unroll
    for (int bj = 0; bj < 2; ++bj)
#pragma unroll
      for (int n = 0; n < 2; ++n) {
        const int t = mt * 256 + bj * 128 + wc * 32 + n * 16 + fr;
#pragma unroll
        for (int ai = 0; ai < 2; ++ai)
#pragma unroll
          for (int mp = 0; mp < 2; ++mp) {
            const int f = nt * 256 + ai * 128 + wr * 64 + mp * 32 + fq * 8;
            f32x4 a = acc[ai][bj][2 * mp][n], b = acc[ai][bj][2 * mp + 1][n];
#pragma unroll
            for (int j = 0; j < 4; ++j) { const float ra = fmaxf(a[j], 0.f), rb = fmaxf(b[j], 0.f); a[j] = ra * ra; b[j] = rb * rb; }
            store_bf8(U + (size_t)t * 4096 + f, a, b);
          }
      }
  }
}

__device__ void phase_qkv(const Params& p, char* lds) {
  const int lane = threadIdx.x & 63, wave = threadIdx.x >> 6;
  const int wr = wave >> 2, wc = wave & 3;
  const int total = (NT / 256) * 6;
  bf16_t* Q = p.S[0]; bf16_t* KA = p.S[1]; bf16_t* VT = p.S[2];
  for (int u = blockIdx.x; u < total; u += gridDim.x) {
    const int mt = u / 6, nt = u % 6;
    if (mt >= NL / 256 && nt < 4) continue;
    f32x4 acc[2][2][4][2];
    gemm256_tile<false>(p.wqkvT, p.S[5], 1024, nt * 256, mt * 256, lds, acc);
    int lane_o = threadIdx.x & 63; asm volatile("" : "+v"(lane_o));
    const int fr = lane_o & 15, fq = lane_o >> 4;
#pragma unroll
    for (int bj = 0; bj < 2; ++bj)
#pragma unroll
      for (int n = 0; n < 2; ++n) {
        const int t = mt * 256 + bj * 128 + wc * 32 + n * 16 + fr;
        const bool lat = t < NL;
        const int b = lat ? (t >> 12) : ((t - NL) >> 8);
        const int key = lat ? (t & 4095) : 4096 + ((t - NL) & 255);
#pragma unroll
        for (int ai = 0; ai < 2; ++ai) {
          const int hh = ai * 2 + wr;
          asm volatile("" ::: "memory");
          if (nt < 5) {
            float ss = 0.f;
#pragma unroll
            for (int m = 0; m < 4; ++m)
#pragma unroll
              for (int j = 0; j < 4; ++j) ss += acc[ai][bj][m][n][j] * acc[ai][bj][m][n][j];
            ss += __shfl_xor(ss, 16); ss += __shfl_xor(ss, 32);
            const float rstd = rsqrtf(ss * (1.f / 64.f) + 1e-6f);
            const float* gn = nt < 4 ? p.q_norm : p.k_norm;
            float v[4][4];
#pragma unroll
            for (int m = 0; m < 4; ++m) {
              const float4 g4 = *(const float4*)(gn + m * 16 + fq * 4);
              v[m][0] = acc[ai][bj][m][n][0] * rstd * g4.x; v[m][1] = acc[ai][bj][m][n][1] * rstd * g4.y;
              v[m][2] = acc[ai][bj][m][n][2] * rstd * g4.z; v[m][3] = acc[ai][bj][m][n][3] * rstd * g4.w;
            }
            if (lat) {
              const int s = t & 4095, rowp = s >> 6, colp = s & 63;
#pragma unroll
              for (int j = 0; j < 4; ++j) {
                const float2 cs0 = *(const float2*)(p.TAB + (rowp * 16 + fq * 4 + j) * 2);
                const float2 cs1 = *(const float2*)(p.TAB + (colp * 16 + fq * 4 + j) * 2);
                const float x1 = v[0][j], x2 = v[1][j], z1 = v[2][j], z2 = v[3][j];
                v[0][j] = x1 * cs0.x - x2 * cs0.y; v[1][j] = x2 * cs0.x + x1 * cs0.y;
                v[2][j] = z1 * cs1.x - z2 * cs1.y; v[3][j] = z2 * cs1.x + z1 * cs1.y;
              }
            }
            if (nt < 4) {
              const float qs = 0.125f * 1.4426950408889634f;
              const int head = nt * 4 + hh;
#pragma unroll
              for (int m = 0; m < 4; ++m)
                store_bf4(Q + (size_t)t * 1024 + head * 64 + m * 16 + fq * 4, v[m][0] * qs, v[m][1] * qs, v[m][2] * qs, v[m][3] * qs);
            } else {
#pragma unroll
              for (int m = 0; m < 4; ++m)
                store_bf4(KA + ((size_t)(b * 4 + hh) * NKEY + key) * 64 + m * 16 + fq * 4, v[m][0], v[m][1], v[m][2], v[m][3]);
            }
          } else {
#pragma unroll
            for (int m = 0; m < 4; ++m)
#pragma unroll
              for (int j = 0; j < 4; ++j) {
                const int d = m * 16 + fq * 4 + j;
                const unsigned pk = pack2(acc[ai][bj][m][n][j], 0.f);
                VT[((size_t)(b * 4 + hh) * 64 + d) * NKEY + key] = (bf16_t)(pk & 0xffffu);
              }
          }
        }
      }
  }
}

__device__ void phase_attn(const Params& p, char* lds) {
  const int tid = threadIdx.x, lane = tid & 63, wave = tid >> 6;
  const int l31 = lane & 31, lh = lane >> 5;
  const int srow = tid >> 3, sch = tid & 7;
  const bf16_t* Q = p.S[0]; const bf16_t* KA = p.S[1]; const bf16_t* VT = p.S[2]; bf16_t* O = p.S[3];
  float gq = 0.f, gk = 0.f;
  for (int i = 0; i < 64; ++i) { gq = fmaxf(gq, fabsf(p.q_norm[i])); gk = fmaxf(gk, fabsf(p.k_norm[i])); }
  const float M2 = 8.f * gq * gk * 1.4426950408889634f;
  constexpr int NKT = NKEY / 64;
  constexpr int AST = 2 * 64 * ROWB;
  for (int u = blockIdx.x; u < 2048; u += gridDim.x) {
    const int qb = u & 15, head = (u >> 4) & 15, b = u >> 8, kvh = head >> 2;
    const bf16_t* Kg = KA + (size_t)(b * 4 + kvh) * NKEY * 64;
    const bf16_t* Vg = VT + (size_t)(b * 4 + kvh) * 64 * NKEY;
    const int tq = b * 4096 + qb * 256 + wave * 32 + l31;
    bf16x8 qf[4];
#pragma unroll
    for (int s = 0; s < 4; ++s) qf[s] = *(const bf16x8*)(Q + (size_t)tq * 1024 + head * 64 + s * 16 + lh * 8);
    f32x16 o0, o1;
#pragma unroll
    for (int i = 0; i < 16; ++i) { o0[i] = 0.f; o1[i] = 0.f; }
    float lsum = 0.f;
    uint4 kreg, vreg;
    auto gload = [&](int kt) {
      kreg = *(const uint4*)(Kg + (size_t)(kt * 64 + srow) * 64 + sch * 8);
      vreg = *(const uint4*)(Vg + (size_t)srow * NKEY + kt * 64 + sch * 8);
    };
    auto lwrite = [&](int st) {
      *(uint4*)(lds + st * AST + srow * ROWB + sch * 16) = kreg;
      *(uint4*)(lds + st * AST + 64 * ROWB + srow * ROWB + sch * 16) = vreg;
    };
    gload(0);
    __syncthreads();
    lwrite(0);
    __syncthreads();
    for (int kt = 0; kt < NKT; ++kt) {
      if (kt + 1 < NKT) gload(kt + 1);
      const char* ksm = lds + (kt & 1) * AST;
      const char* vsm = ksm + 64 * ROWB;
      f32x16 sT[2];
#pragma unroll
      for (int k2 = 0; k2 < 2; ++k2) {
#pragma unroll
        for (int i = 0; i < 16; ++i) sT[k2][i] = 0.f;
#pragma unroll
        for (int s = 0; s < 4; ++s) {
          const bf16x8 kf = *(const bf16x8*)(ksm + (k2 * 32 + l31) * ROWB + s * 32 + lh * 16);
          sT[k2] = MFMA32(kf, qf[s], sT[k2]);
        }
      }
#pragma unroll
      for (int k2 = 0; k2 < 2; ++k2)
#pragma unroll
        for (int i = 0; i < 16; ++i) { const float pv = __builtin_amdgcn_exp2f(sT[k2][i] - M2); lsum += pv; sT[k2][i] = pv; }
#pragma unroll
      for (int k2 = 0; k2 < 2; ++k2)
#pragma unroll
        for (int s2 = 0; s2 < 2; ++s2) {
          uint4 pk;
          pk.x = pack2(sT[k2][8 * s2 + 0], sT[k2][8 * s2 + 1]); pk.y = pack2(sT[k2][8 * s2 + 2], sT[k2][8 * s2 + 3]);
          pk.z = pack2(sT[k2][8 * s2 + 4], sT[k2][8 * s2 + 5]); pk.w = pack2(sT[k2][8 * s2 + 6], sT[k2][8 * s2 + 7]);
          const bf16x8 pf = __builtin_bit_cast(bf16x8, pk);
          const int koff = (k2 * 32 + 16 * s2 + 4 * lh) * 2;
          {
            const uint2 lo = *(const uint2*)(vsm + l31 * ROWB + koff), hi = *(const uint2*)(vsm + l31 * ROWB + koff + 16);
            const uint4 vv = make_uint4(lo.x, lo.y, hi.x, hi.y);
            o0 = MFMA32(__builtin_bit_cast(bf16x8, vv), pf, o0);
          }
          {
            const uint2 lo = *(const uint2*)(vsm + (32 + l31) * ROWB + koff), hi = *(const uint2*)(vsm + (32 + l31) * ROWB + koff + 16);
            const uint4 vv = make_uint4(lo.x, lo.y, hi.x, hi.y);
            o1 = MFMA32(__builtin_bit_cast(bf16x8, vv), pf, o1);
          }
        }
      if (kt + 1 < NKT) lwrite((kt + 1) & 1);
      __syncthreads();
    }
    lsum += __shfl_xor(lsum, 32);
    const float inv = 1.f / lsum;
#pragma unroll
    for (int g = 0; g < 4; ++g) {
      const int d0 = 8 * g + 4 * lh;
      store_bf4(O + (size_t)tq * 1024 + head * 64 + d0, o0[4 * g] * inv, o0[4 * g + 1] * inv, o0[4 * g + 2] * inv, o0[4 * g + 3] * inv);
      store_bf4(O + (size_t)tq * 1024 + head * 64 + 32 + d0, o1[4 * g] * inv, o1[4 * g + 1] * inv, o1[4 * g + 2] * inv, o1[4 * g + 3] * inv);
    }
  }
}

#define XB_TMO      128
#define XB_XCNT(j)  (256  + 64 * (j))
#define XB_XSUB(j)  (1280 + 64 * (j))
#define XB_XGEN(j)  (2304 + 64 * (j))
#define XB_TOP      3328
#define XB_TOPGEN   3392
#define XCD_BAR_WORDS 3456
#define XB_SPIN_CAP (1u << 18)
#define LAS __attribute__((address_space(3)))

__device__ __forceinline__ unsigned xb_ld(unsigned* p)              { return __hip_atomic_load(p, __ATOMIC_RELAXED, __HIP_MEMORY_SCOPE_AGENT); }
__device__ __forceinline__ unsigned xb_add(unsigned* p, unsigned v) { return __hip_atomic_fetch_add(p, v, __ATOMIC_RELAXED, __HIP_MEMORY_SCOPE_AGENT); }
__device__ __forceinline__ unsigned xb_xcc_id() { return (unsigned)__builtin_amdgcn_s_getreg((3 << 11) | 20) & 0xFu; }
#define XB_SPIN(cond, bar) do { unsigned _sp = 0; while (cond) { __builtin_amdgcn_s_sleep(1); \
    if ((++_sp & 255u) == 0u) { if (xb_ld(&(bar)[XB_TMO])) break; if (_sp > XB_SPIN_CAP) { atomicAdd(&(bar)[XB_TMO], 1u); break; } } } } while (0)

struct XcdBarrier {
    unsigned* bar; unsigned x;
    volatile LAS unsigned* st;
};

__device__ __forceinline__ XcdBarrier xcd_barrier_post(unsigned* bar, volatile LAS unsigned* st) {
    XcdBarrier b; b.bar = bar; b.x = xb_xcc_id(); b.st = st;
    if (threadIdx.x == 0) (void)xb_add(&bar[XB_XCNT(b.x)], 1u);
    return b;
}
__device__ __forceinline__ void xcd_barrier_complete(unsigned* bar, unsigned x, unsigned& nloc, unsigned& nx) {
    const unsigned G = gridDim.x * gridDim.y * gridDim.z;
    unsigned sum, cnt, mine, sp = 0u;
    for (;;) {
        sum = 0u; cnt = 0u; mine = 0u;
#pragma unroll
        for (unsigned j = 0; j < 16; ++j) { const unsigned c = xb_ld(&bar[XB_XCNT(j)]); sum += c; cnt += (c > 0u) ? 1u : 0u; mine = (j == x) ? c : mine; }
        if (sum == G) break;
        __builtin_amdgcn_s_sleep(1);
        if ((++sp & 255u) == 0u) { if (xb_ld(&bar[XB_TMO])) break; if (sp > XB_SPIN_CAP) { atomicAdd(&bar[XB_TMO], 1u); break; } }
    }
    nloc = mine > 0u ? mine : 1u; nx = cnt > 0u ? cnt : 1u;
}

__device__ __forceinline__ void xcd_barrier(const XcdBarrier& b) {
    asm volatile("s_waitcnt vmcnt(0)" ::: "memory");
    __syncthreads();
    if (threadIdx.x == 0) {
        unsigned* bar = b.bar;
        __builtin_amdgcn_s_waitcnt(0);
        unsigned nloc = b.st[0], nx = b.st[1];
        if (nloc == 0u) { xcd_barrier_complete(bar, b.x, nloc, nx); b.st[0] = nloc; b.st[1] = nx; }
        const unsigned old = xb_add(&bar[XB_XSUB(b.x)], 1u);
        const unsigned gen = old / nloc;
        if (old + 1u == (gen + 1u) * nloc) {
            __builtin_amdgcn_fence(__ATOMIC_RELEASE, "agent");
            asm volatile("s_waitcnt vmcnt(0)" ::: "memory");
            const unsigned og = xb_add(&bar[XB_TOP], 1u);
            const unsigned tg = og / nx;
            if (og + 1u == (tg + 1u) * nx) xb_add(&bar[XB_TOPGEN], 1u);
            else XB_SPIN(xb_ld(&bar[XB_TOPGEN]) == tg, bar);
            __builtin_amdgcn_fence(__ATOMIC_ACQUIRE, "agent");
            xb_add(&bar[XB_XGEN(b.x)], 1u);
            asm volatile("s_waitcnt vmcnt(0)" ::: "memory");
        } else {
            XB_SPIN(xb_ld(&bar[XB_XGEN(b.x)]) == gen, bar);
            __builtin_amdgcn_fence(__ATOMIC_ACQUIRE, "agent");
            asm volatile("s_waitcnt vmcnt(0)" ::: "memory");
        }
    }
    __syncthreads();
}


DI void run_phase(const Params& p, int ph, char* lds) {
  const float* mod0 = p.MOD;
  const float* mod1 = p.MOD + 9 * 6144;
  switch (ph) {
    case 0: phase0(p, lds); break;
    case 1: norm_mod_phase(p.x, p.ctx, p.norm_mix, mod0, 0, 1, p.Hd, NT); break;
    case 2: phase_proj(p, lds); break;
    case 3: phase_prep(p, lds); break;
    case 4: phase_scan(p, lds); break;
    case 5: phase_readout(p, lds); break;
    case 6: phase_gemm_resid(p, lds, p.S[0], p.woT, 1024, NT / 256, p.x, p.ctx, mod0 + 2 * 1024); break;
    case 7: norm_mod_phase(p.out, p.XC, p.norm_mlp, mod0, 3, 4, p.S[5], NT); break;
    case 8: phase_up(p, lds, p.S[5], p.w1T[0], p.S[0], NT / 256); break;
    case 9: phase_gemm_resid(p, lds, p.S[0], p.w2T[0], 4096, NT / 256, p.out, p.XC, mod0 + 5 * 1024); break;
    case 10: norm_mod_phase(p.out, p.XC, p.norm_mix + 1024, mod1, 0, 1, p.S[5], NT); break;
    case 11: phase_qkv(p, lds); break;
    case 12: phase_attn(p, lds); break;
    case 13: phase_gemm_resid(p, lds, p.S[3], p.awoT, 1024, NL / 256, p.out, p.XC, mod1 + 2 * 1024); break;
    case 14: norm_mod_phase(p.out, p.XC, p.norm_mlp + 1024, mod1, 3, 4, p.S[5], NL); break;
    case 15: phase_up(p, lds, p.S[5], p.w1T[1], p.S[0], NL / 256); break;
    case 16: phase_gemm_resid(p, lds, p.S[0], p.w2T[1], 4096, NL / 256, p.out, p.XC, mod1 + 5 * 1024); break;
    case 17: final_norm_phase(p); break;
  }
}
constexpr int NPHASE = 18;

__global__ void __launch_bounds__(NTHREADS) phase_kernel(Params p, int ph) {
  extern __shared__ __attribute__((aligned(16))) char lds[];
  run_phase(p, ph, lds);
}

__global__ void __launch_bounds__(NTHREADS) mega_kernel(Params p) {
  extern __shared__ __attribute__((aligned(16))) char lds[];
  cg::grid_group grid = cg::this_grid();
  volatile LAS unsigned* st = (volatile LAS unsigned*)(LAS char*)(lds + 131072);
  if (threadIdx.x == 0) { st[0] = 0u; st[1] = 0u; }
  if (blockIdx.x == 0) for (int i = threadIdx.x; i < XCD_BAR_WORDS; i += NTHREADS) p.BAR[i] = 0u;
  __syncthreads();
  run_phase(p, 0, lds);
  grid.sync();
  const XcdBarrier xb = xcd_barrier_post(p.BAR, st);
#ifndef DUP
#define DUP -1
#endif
#define PH(n) run_phase(p, n, lds); xcd_barrier(xb); if (DUP == n) { if (n == 4) phase_scan(p, lds, true); else if (n == 9) phase_gemm_resid(p, lds, p.S[0], p.w2T[0], 4096, NT / 256, p.out, p.XC, p.MOD + 5 * 1024, (float*)p.S[4]); else run_phase(p, n, lds); xcd_barrier(xb); } if (DUP == 100) { xcd_barrier(xb); }
  PH(1) PH(2) PH(3) PH(4) PH(5) PH(6) PH(7) PH(8) PH(9) PH(10) PH(11) PH(12) PH(13) PH(14) PH(15) PH(16)
  run_phase(p, 17, lds);
}

extern "C" void kernel_launch(void* const* d_in, const int* in_sizes, int n_in, void* d_out, int out_size, void* d_ws, size_t ws_size, hipStream_t stream) {
  Params p;
  memset(&p, 0, sizeof(p));
  const float* const* in = (const float* const*)d_in;
  p.x = in[0]; p.c = in[1]; p.ctx = in[2]; p.c_ctx = in[3]; p.w_mod = in[4]; p.b_mod = in[5]; p.norm_mix = in[6]; p.norm_mlp = in[7];
  p.mlp_w1 = in[8]; p.mlp_w2 = in[9]; p.mu = in[10]; p.wr = in[11]; p.wk = in[12]; p.wv = in[13]; p.wo = in[14]; p.w0 = in[15]; p.w1 = in[16];
  p.w2 = in[17]; p.a0 = in[18]; p.a1 = in[19]; p.a2 = in[20]; p.g1 = in[21]; p.g2 = in[22]; p.k_k = in[23]; p.k_a = in[24]; p.r_k = in[25];
  p.ln_w = in[26]; p.ln_b = in[27]; p.wqkv = in[28]; p.q_norm = in[29]; p.k_norm = in[30]; p.awo = in[31]; p.final_norm = in[32];
  p.out = (float*)d_out;
  char* ws = (char*)d_ws;
  size_t off = 0;
  auto take = [&](size_t bytes) -> char* { char* r = ws + off; off += (bytes + 255) & ~(size_t)255; return r; };
  p.Wcat = (bf16_t*)take((size_t)3456 * 1024 * 2);
  p.L2w = (bf16_t*)take((size_t)4 * 65536 * 2);
  p.g2T = (bf16_t*)take((size_t)1024 * 128 * 2);
  p.woT = (bf16_t*)take((size_t)1024 * 1024 * 2);
  p.w1T[0] = (bf16_t*)take((size_t)4096 * 1024 * 2);
  p.w1T[1] = (bf16_t*)take((size_t)4096 * 1024 * 2);
  p.w2T[0] = (bf16_t*)take((size_t)4096 * 1024 * 2);
  p.w2T[1] = (bf16_t*)take((size_t)4096 * 1024 * 2);
  p.wqkvT = (bf16_t*)take((size_t)1536 * 1024 * 2);
  p.awoT = (bf16_t*)take((size_t)1024 * 1024 * 2);
  p.MOD = (float*)take((size_t)2 * 9 * 6144 * 4);
  p.TAB = (float*)take((size_t)1024 * 2 * 4);
  p.XC = (float*)take((size_t)NC * 1024 * 4);
  p.BAR = (unsigned*)take((size_t)XCD_BAR_WORDS * 4);
  for (int i = 0; i < 6; ++i) p.S[i] = (bf16_t*)take((size_t)NT * 1024 * 2);
  if (off > ws_size) { fprintf(stderr, "kernel_launch: workspace too small (%zu needed, %zu given)\n", off, ws_size); return; }
  char* ob = (char*)d_out;
  p.Hd = (bf16_t*)ob;
  p.L1 = (bf16_t*)(ob + (size_t)NT * 1024 * 2);
  p.BON = (float*)(ob + (size_t)NT * 1024 * 2 + (size_t)NT * 384 * 2);
  p.NRM = (float*)(ob + (size_t)NT * 1024 * 2 + (size_t)NT * 384 * 2 + (size_t)NT * 16 * 4);
  int nj = 0, tiles = 0;
  auto job = [&](const float* src, bf16_t* dst, int K, int N) {
    p.jobs[nj].src = src; p.jobs[nj].dst = dst; p.jobs[nj].K = K; p.jobs[nj].N = N; p.jobs[nj].tstart = tiles; p.jobs[nj].tiles_n = N / 64;
    tiles += (K / 64) * (N / 64); ++nj;
  };
  job(p.wr, p.Wcat, 1024, 1024);
  job(p.wk, p.Wcat + (size_t)1024 * 1024, 1024, 1024);
  job(p.wv, p.Wcat + (size_t)2048 * 1024, 1024, 1024);
  job(p.g1, p.Wcat + (size_t)3072 * 1024, 1024, 128);
  job(p.w1, p.Wcat + (size_t)3200 * 1024, 1024, 64);
  job(p.w1 + 65536, p.Wcat + (size_t)3264 * 1024, 1024, 64);
  job(p.a1, p.Wcat + (size_t)3328 * 1024, 1024, 64);
  job(p.a1 + 65536, p.Wcat + (size_t)3392 * 1024, 1024, 64);
  job(p.a2, p.L2w, 64, 1024);
  job(p.a2 + 65536, p.L2w + 65536, 64, 1024);
  job(p.w2, p.L2w + 2 * 65536, 64, 1024);
  job(p.w2 + 65536, p.L2w + 3 * 65536, 64, 1024);
  job(p.g2, p.g2T, 128, 1024);
  job(p.wo, p.woT, 1024, 1024);
  job(p.mlp_w1, p.w1T[0], 1024, 4096);
  job(p.mlp_w1 + (size_t)4096 * 1024, p.w1T[1], 1024, 4096);
  job(p.mlp_w2, p.w2T[0], 4096, 1024);
  job(p.mlp_w2 + (size_t)4096 * 1024, p.w2T[1], 4096, 1024);
  job(p.wqkv, p.wqkvT, 1024, 1536);
  job(p.awo, p.awoT, 1024, 1024);
  p.njobs = nj; p.total_tiles = tiles;

  static int grid_blocks = 0;
  if (!grid_blocks) {
    (void)hipFuncSetAttribute((const void*)mega_kernel, hipFuncAttributeMaxDynamicSharedMemorySize, LDS_BYTES);
    (void)hipFuncSetAttribute((const void*)phase_kernel, hipFuncAttributeMaxDynamicSharedMemorySize, LDS_BYTES);
    int dev = 0, cus = 0, per_cu = 0;
    (void)hipGetDevice(&dev);
    (void)hipDeviceGetAttribute(&cus, hipDeviceAttributeMultiprocessorCount, dev);
    if (hipOccupancyMaxActiveBlocksPerMultiprocessor(&per_cu, (const void*)mega_kernel, NTHREADS, LDS_BYTES) != hipSuccess || per_cu < 1) per_cu = 1;
    if (cus <= 0) cus = 256;
    grid_blocks = cus * per_cu;
    (void)hipGetLastError();
  }
#if SINGLE_LAUNCH
  void* args[] = {&p};
  hipError_t e = hipLaunchCooperativeKernel((const void*)mega_kernel, dim3(grid_blocks), dim3(NTHREADS), args, LDS_BYTES, stream);
  if (e != hipSuccess) fprintf(stderr, "cooperative launch failed: %s (grid %d)\n", hipGetErrorString(e), grid_blocks);
#else
  for (int ph = 0; ph < NPHASE; ++ph) hipLaunchKernelGGL(phase_kernel, dim3(grid_blocks), dim3(NTHREADS), LDS_BYTES, stream, p, ph);
#endif
}
```

```cpp
#include <hip/hip_runtime.h>
#include <hip/hip_cooperative_groups.h>
#include <cstdint>
#include <cstring>
#include <cstdio>
namespace cg = cooperative_groups;

#ifndef SINGLE_LAUNCH
#define SINGLE_LAUNCH 1
#endif

typedef unsigned short bf16_t;
typedef short bf16x8 __attribute__((ext_vector_type(8)));
typedef float f32x2 __attribute__((ext_vector_type(2)));
typedef float f32x4 __attribute__((ext_vector_type(4)));
typedef float f32x16 __attribute__((ext_vector_type(16)));
typedef __bf16 bf16x2_t __attribute__((ext_vector_type(2)));
#define DI __device__ __forceinline__

constexpr int D = 1024, NB = 8, SEQ = 4096, CTXL = 256;
constexpr int NL = NB * SEQ, NC = NB * CTXL, NT = NL + NC, DFF = 4096;
constexpr int NKEY = SEQ + CTXL;
constexpr int NTHREADS = 512;
constexpr int ROWB = 144;
constexpr int GEMM_STAGE = (256 + 128) * ROWB;
constexpr int LDS_BYTES = 131072 + 16;

struct TJob { const float* src; bf16_t* dst; int K, N, tstart, tiles_n; };

struct Params {
  const float *x, *c, *ctx, *c_ctx, *w_mod, *b_mod, *norm_mix, *norm_mlp, *mlp_w1, *mlp_w2;
  const float *mu, *wr, *wk, *wv, *wo, *w0, *w1, *w2, *a0, *a1, *a2, *g1, *g2, *k_k, *k_a, *r_k, *ln_w, *ln_b;
  const float *wqkv, *q_norm, *k_norm, *awo, *final_norm;
  float* out;
  bf16_t *Wcat, *L2w, *g2T, *woT, *w1T[2], *w2T[2], *wqkvT, *awoT;
  float *MOD, *TAB, *XC;
  bf16_t* S[6];
  bf16_t *Hd, *L1;
  float* BON;
  float* NRM;
  unsigned* BAR;
  TJob jobs[20];
  int njobs, total_tiles;
};

DI unsigned pack2(float lo, float hi) {
  f32x2 v = {lo, hi};
  bf16x2_t b = __builtin_convertvector(v, bf16x2_t);
  return __builtin_bit_cast(unsigned, b);
}
DI float bflo(unsigned u) { return __uint_as_float(u << 16); }
DI float bfhi(unsigned u) { return __uint_as_float(u & 0xffff0000u); }
DI void store_bf4(bf16_t* p, float a, float b, float c, float d) { *(uint2*)p = make_uint2(pack2(a, b), pack2(c, d)); }
DI void load_bf4(const bf16_t* p, float& a, float& b, float& c, float& d) { uint2 u = *(const uint2*)p; a = bflo(u.x); b = bfhi(u.x); c = bflo(u.y); d = bfhi(u.y); }
DI void store_bf8(bf16_t* p, const f32x4& a, const f32x4& b) {
  uint4 o; o.x = pack2(a[0], a[1]); o.y = pack2(a[2], a[3]); o.z = pack2(b[0], b[1]); o.w = pack2(b[2], b[3]);
  *(uint4*)p = o;
}
DI void store16_sc1(void* p, const uint4& v) {
  typedef unsigned u32x4_t __attribute__((ext_vector_type(4)));
  const u32x4_t d = {v.x, v.y, v.z, v.w};
  asm volatile("global_store_dwordx4 %0, %1, off sc1" :: "v"(p), "v"(d) : "memory");
}
DI void unpack_bf8(const uint4& u, float (&o)[8]) {
  o[0] = bflo(u.x); o[1] = bfhi(u.x); o[2] = bflo(u.y); o[3] = bfhi(u.y); o[4] = bflo(u.z); o[5] = bfhi(u.z); o[6] = bflo(u.w); o[7] = bfhi(u.w);
}
DI int perm32(int rho) { return 8 * ((rho & 15) >> 2) + 4 * (rho >> 4) + (rho & 3); }
DI float sigmoidf_(float x) { return 1.f / (1.f + __expf(-x)); }
DI float tanhf_(float x) { return 1.f - 2.f / (1.f + __expf(2.f * x)); }
DI float quad_sum(float x) {
  x += __builtin_bit_cast(float, __builtin_amdgcn_mov_dpp(__builtin_bit_cast(int, x), 0xB1, 0xF, 0xF, true));
  x += __builtin_bit_cast(float, __builtin_amdgcn_mov_dpp(__builtin_bit_cast(int, x), 0x4E, 0xF, 0xF, true));
  return x;
}
DI float oct_sum(float x) {
  x = quad_sum(x);
  x += __builtin_bit_cast(float, __builtin_amdgcn_mov_dpp(__builtin_bit_cast(int, x), 0x141, 0xF, 0xF, true));
  return x;
}
struct StepV { f32x2 r[4], w[4], k[4], kk[4], b[4]; f32x2 v; };
DI void scan_load(StepV& s, const float* base, const float* vp) {
#pragma unroll
  for (int i = 0; i < 2; ++i) {
    const float4 t0 = *(const float4*)(base + i * 4);       s.r[2 * i] = f32x2{t0.x, t0.y};  s.r[2 * i + 1] = f32x2{t0.z, t0.w};
    const float4 t1 = *(const float4*)(base + 64 + i * 4);  s.w[2 * i] = f32x2{t1.x, t1.y};  s.w[2 * i + 1] = f32x2{t1.z, t1.w};
    const float4 t2 = *(const float4*)(base + 128 + i * 4); s.k[2 * i] = f32x2{t2.x, t2.y};  s.k[2 * i + 1] = f32x2{t2.z, t2.w};
    const float4 t3 = *(const float4*)(base + 192 + i * 4); s.kk[2 * i] = f32x2{t3.x, t3.y}; s.kk[2 * i + 1] = f32x2{t3.z, t3.w};
    const float4 t4 = *(const float4*)(base + 256 + i * 4); s.b[2 * i] = f32x2{t4.x, t4.y};  s.b[2 * i + 1] = f32x2{t4.z, t4.w};
  }
  const float2 vv = *(const float2*)vp;
  s.v = f32x2{vv.x, vv.y};
}
DI void scan_step(const StepV& s, f32x2 (&S0)[4], f32x2 (&S1)[4], float* yp, bool writer) {
  f32x2 d0 = S0[0] * s.kk[0], d1 = S1[0] * s.kk[0];
#pragma unroll
  for (int i = 1; i < 4; ++i) { d0 += S0[i] * s.kk[i]; d1 += S1[i] * s.kk[i]; }
  const float sa0 = -oct_sum(d0.x + d0.y), sa1 = -oct_sum(d1.x + d1.y);
  const f32x2 sa0v = {sa0, sa0}, sa1v = {sa1, sa1}, v0 = {s.v.x, s.v.x}, v1 = {s.v.y, s.v.y};
#pragma unroll
  for (int i = 0; i < 4; ++i) {
    S0[i] = S0[i] * s.w[i] + (sa0v * s.b[i] + v0 * s.k[i]);
    S1[i] = S1[i] * s.w[i] + (sa1v * s.b[i] + v1 * s.k[i]);
  }
  f32x2 y0 = S0[0] * s.r[0], y1 = S1[0] * s.r[0];
#pragma unroll
  for (int i = 1; i < 4; ++i) { y0 += S0[i] * s.r[i]; y1 += S1[i] * s.r[i]; }
  const float ya = oct_sum(y0.x + y0.y), yb = oct_sum(y1.x + y1.y);
  if (writer) *(float2*)yp = make_float2(ya, yb);
}
DI float wave_sum(float x) {
#pragma unroll
  for (int m = 1; m < 64; m <<= 1) x += __shfl_xor(x, m);
  return x;
}
#define MFMA16(a, b, c) __builtin_amdgcn_mfma_f32_16x16x32_bf16((a), (b), (c), 0, 0, 0)
#define MFMA32(a, b, c) __builtin_amdgcn_mfma_f32_32x32x16_bf16((a), (b), (c), 0, 0, 0)

DI unsigned lerp2(unsigned a, unsigned n, float ma, float mb) {
  const float h0 = bflo(a), h1 = bfhi(a), s0 = bflo(n), s1 = bfhi(n);
  return pack2(h0 + (s0 - h0) * ma, h1 + (s1 - h1) * mb);
}
template <bool LERP>
DI void gemm_tile(const bf16_t* __restrict__ X, int ldx, const bf16_t* __restrict__ W, int ldw, int K, int tok0, int f0,
                  char* lds, f32x4 (&acc)[4][4], const float* __restrict__ mu) {
  const int tid = threadIdx.x, lane = tid & 63, wave = tid >> 6;
  const int wt = wave & 3, wf = wave >> 2, lr = lane & 15, lq = lane >> 4;
  const int lrow = tid >> 3, kc = tid & 7;
#pragma unroll
  for (int i = 0; i < 4; ++i)
#pragma unroll
    for (int j = 0; j < 4; ++j) acc[i][j] = f32x4{0.f, 0.f, 0.f, 0.f};
  uint4 xr[4], wr[2], xn[4];
  float4 m0 = make_float4(0, 0, 0, 0), m1 = m0;
  const int nk = K >> 6;
  __syncthreads();
  for (int kt = -1; kt < nk; ++kt) {
    const bool more = kt + 1 < nk;
    if (more) {
      const int k0 = (kt + 1) << 6;
#pragma unroll
      for (int i = 0; i < 4; ++i) {
        const int tg = tok0 + lrow + 64 * i;
        xr[i] = *(const uint4*)(X + (size_t)tg * ldx + k0 + kc * 8);
        if (LERP) {
          int nb; bool valid;
          if (tok0 < NL) {
            const int s = tg & 4095, col = s & 63, rw = s >> 6, qd = k0 >> 8;
            if (qd == 0) { valid = col > 0; nb = tg - 1; }
            else if (qd == 1) { valid = col < 63; nb = tg + 1; }
            else if (qd == 2) { valid = rw > 0; nb = tg - 64; }
            else { valid = rw < 63; nb = tg + 64; }
          } else {
            const int s = (tg - NL) & 255;
            if (k0 < 512) { valid = s > 0; nb = tg - 1; }
            else { valid = s < 255; nb = tg + 1; }
          }
          if (valid) xn[i] = *(const uint4*)(X + (size_t)nb * ldx + k0 + kc * 8);
          else xn[i] = make_uint4(0, 0, 0, 0);
        }
      }
#pragma unroll
      for (int i = 0; i < 2; ++i) wr[i] = *(const uint4*)(W + (size_t)(f0 + 64 * i + (lrow & 32) + perm32(lrow & 31)) * ldw + k0 + kc * 8);
      if (LERP) { m0 = *(const float4*)(mu + k0 + kc * 8); m1 = *(const float4*)(mu + k0 + kc * 8 + 4); }
    }
    if (kt >= 0) {
      const char* xs = lds + (kt & 1) * GEMM_STAGE;
      const char* wsm = xs + 256 * ROWB;
#pragma unroll
      for (int ks = 0; ks < 2; ++ks) {
        bf16x8 wfr[4], xfr[4];
#pragma unroll
        for (int i = 0; i < 4; ++i) wfr[i] = *(const bf16x8*)(wsm + (wf * 64 + i * 16 + lr) * ROWB + ks * 64 + lq * 16);
#pragma unroll
        for (int i = 0; i < 4; ++i) xfr[i] = *(const bf16x8*)(xs + (wt * 64 + i * 16 + lr) * ROWB + ks * 64 + lq * 16);
#pragma unroll
        for (int fi = 0; fi < 4; ++fi)
#pragma unroll
          for (int ti = 0; ti < 4; ++ti) acc[fi][ti] = MFMA16(wfr[fi], xfr[ti], acc[fi][ti]);
      }
    }
    if (more) {
      char* xs = lds + ((kt + 1) & 1) * GEMM_STAGE;
      char* wsm = xs + 256 * ROWB;
#pragma unroll
      for (int i = 0; i < 4; ++i) {
        uint4 v = xr[i];
        if (LERP) {
          v.x = lerp2(xr[i].x, xn[i].x, m0.x, m0.y);
          v.y = lerp2(xr[i].y, xn[i].y, m0.z, m0.w);
          v.z = lerp2(xr[i].z, xn[i].z, m1.x, m1.y);
          v.w = lerp2(xr[i].w, xn[i].w, m1.z, m1.w);
        }
        *(uint4*)(xs + (lrow + 64 * i) * ROWB + kc * 16) = v;
      }
#pragma unroll
      for (int i = 0; i < 2; ++i) *(uint4*)(wsm + (lrow + 64 * i) * ROWB + kc * 16) = wr[i];
    }
    __syncthreads();
  }
}


namespace g256 {
constexpr int BK = 64, HALF = 128, HT = HALF * BK;
DI int lds_byte(int r, int c) { const int st = (r >> 4) * 2 + (c >> 5), rr = r & 15, cc = c & 31, ob = rr * 64 + cc * 2; return st * 1024 + (ob ^ (((ob >> 9) & 1) << 5)); }
DI void stage_rc(int b, int& R, int& C) { const int st = b / 1024, sb = b % 1024, swz = sb ^ (((sb >> 9) & 1) << 5); R = (st >> 1) * 16 + swz / 64; C = (st & 1) * 32 + (swz % 64) / 2; }
}
#define G_SA(b, h) (((b) * 2 + (h)) * 16384)
#define G_SB(b, h) ((4 + (b) * 2 + (h)) * 16384)
#define G_STAGEV(bufoff, gbase, vo) do { _Pragma("unroll") for (int _i = 0; _i < 2; ++_i) \
    __builtin_amdgcn_global_load_lds((const unsigned*)((const char*)(gbase) + (vo)[_i]), (__attribute__((address_space(3))) unsigned*)(lds + (bufoff) + ldsw + _i * 8192), 16, 0, 0); } while (0)
#define G_LDA(dst, b, h) do { _Pragma("unroll") for (int m = 0; m < 4; ++m) _Pragma("unroll") for (int k = 0; k < 2; ++k) \
    dst[m][k] = *(const __attribute__((address_space(3))) bf16x8*)(lds + G_SA(b, h) + aoff + m * 2048 + k * 1024); } while (0)
#define G_LDB(dst, b, h) do { _Pragma("unroll") for (int n = 0; n < 2; ++n) _Pragma("unroll") for (int k = 0; k < 2; ++k) \
    dst[n][k] = *(const __attribute__((address_space(3))) bf16x8*)(lds + G_SB(b, h) + boff + n * 2048 + k * 1024); } while (0)
#define G_MMA(ai, bj, At, Bt) do { __builtin_amdgcn_s_setprio(1); \
    _Pragma("unroll") for (int m = 0; m < 4; ++m) _Pragma("unroll") for (int n = 0; n < 2; ++n) _Pragma("unroll") for (int k = 0; k < 2; ++k) \
      acc[ai][bj][m][n] = __builtin_amdgcn_mfma_f32_16x16x32_bf16(At[m][k], Bt[n][k], acc[ai][bj][m][n], 0, 0, 0); \
    __builtin_amdgcn_s_setprio(0); } while (0)
#define G_WAIT_V(n) asm volatile("s_waitcnt vmcnt(" #n ")" ::: "memory")
#define G_WAIT_L(n) asm volatile("s_waitcnt lgkmcnt(" #n ")" ::: "memory")
#define G_BAR __builtin_amdgcn_s_barrier()
#define G_SCHED __builtin_amdgcn_sched_barrier(0)

template <bool PERM>
DI void gemm256_tile(const bf16_t* __restrict__ A, const bf16_t* __restrict__ Bt, int K, int brow, int bcol, char* lds_, f32x4 (&acc)[2][2][4][2]) {
  __attribute__((address_space(3))) unsigned char* lds = (__attribute__((address_space(3))) unsigned char*)lds_;
  int tid = threadIdx.x; asm volatile("" : "+v"(tid));
  const int wid = __builtin_amdgcn_readfirstlane(tid >> 6), lane = tid & 63, wr = wid >> 2, wc = wid & 3, fr = lane & 15, fq = lane >> 4;
#pragma unroll
  for (int a = 0; a < 2; ++a)
#pragma unroll
    for (int b = 0; b < 2; ++b)
#pragma unroll
      for (int m = 0; m < 4; ++m)
#pragma unroll
        for (int n = 0; n < 2; ++n) acc[a][b][m][n] = f32x4{0.f, 0.f, 0.f, 0.f};
  unsigned voff[2], voffA[2];
#pragma unroll
  for (int i = 0; i < 2; ++i) { int R, C; g256::stage_rc(tid * 16 + i * 8192, R, C); voff[i] = (unsigned)(R * K + C) * 2u;
    const int Ra = PERM ? ((R & ~31) + perm32(R & 31)) : R; voffA[i] = (unsigned)(Ra * K + C) * 2u; }
  const size_t kstep = 128, hstep = (size_t)128 * K * 2;
  const unsigned ldsw = (unsigned)wid * 1024u;
  const int aoff = g256::lds_byte(wr * 64 + fr, fq * 8), boff = g256::lds_byte(wc * 32 + fr, fq * 8);
  const char* cA = (const char*)A + (size_t)brow * K * 2;
  const char* cB = (const char*)Bt + (size_t)bcol * K * 2;
  bf16x8 At[4][2], B0[2][2], B1[2][2];
  const int nt = K / g256::BK;
  __syncthreads();
  G_STAGEV(G_SB(0, 0), cB, voff); G_STAGEV(G_SA(0, 0), cA, voffA); G_STAGEV(G_SB(0, 1), cB + hstep, voff); G_STAGEV(G_SA(0, 1), cA + hstep, voffA);
  if (wr == 1) G_BAR;
  G_WAIT_V(4); G_BAR;
  G_STAGEV(G_SB(1, 0), cB + kstep, voff); G_STAGEV(G_SA(1, 0), cA + kstep, voffA); G_STAGEV(G_SB(1, 1), cB + hstep + kstep, voff);
  G_WAIT_V(6); G_BAR;
  for (int t = 0; t < nt - 2; t += 2) {
    const char* a1 = cA + (size_t)(t + 1) * kstep;
    const char* a2 = cA + (size_t)(t + 2) * kstep; const char* b2 = cB + (size_t)(t + 2) * kstep;
    const char* a3 = a2 + kstep; const char* b3 = b2 + kstep;
    G_LDB(B0, 0, 0); G_SCHED; G_LDA(At, 0, 0); G_STAGEV(G_SA(1, 1), a1 + hstep, voffA);
    G_WAIT_L(8); G_BAR; G_WAIT_L(0); G_MMA(0, 0, At, B0); G_BAR; G_SCHED;
    G_LDB(B1, 0, 1); G_STAGEV(G_SB(0, 0), b2, voff);
    G_BAR; G_WAIT_L(0); G_MMA(0, 1, At, B1); G_BAR;
    G_LDA(At, 0, 1); G_STAGEV(G_SA(0, 0), a2, voffA);
    G_BAR; G_WAIT_L(0); G_MMA(1, 0, At, B0); G_BAR; G_SCHED;
    G_STAGEV(G_SB(0, 1), b2 + hstep, voff);
    G_WAIT_V(6); G_BAR; G_MMA(1, 1, At, B1); G_BAR;
    G_LDB(B0, 1, 0); G_SCHED; G_LDA(At, 1, 0); G_STAGEV(G_SA(0, 1), a2 + hstep, voffA);
    G_WAIT_L(8); G_BAR; G_WAIT_L(0); G_MMA(0, 0, At, B0); G_BAR; G_SCHED;
    G_LDB(B1, 1, 1); G_STAGEV(G_SB(1, 0), b3, voff);
    G_BAR; G_WAIT_L(0); G_MMA(0, 1, At, B1); G_BAR;
    G_LDA(At, 1, 1); G_STAGEV(G_SA(1, 0), a3, voffA);
    G_BAR; G_WAIT_L(0); G_MMA(1, 0, At, B0); G_BAR; G_SCHED;
    G_STAGEV(G_SB(1, 1), b3 + hstep, voff);
    G_WAIT_V(6); G_BAR; G_MMA(1, 1, At, B1); G_BAR;
  }
  { G_LDB(B0, 0, 0); G_LDA(At, 0, 0); G_STAGEV(G_SA(1, 1), cA + (size_t)(nt - 1) * kstep + hstep, voffA);
    G_BAR; G_WAIT_L(0); G_MMA(0, 0, At, B0); G_BAR;
    G_LDB(B1, 0, 1); G_BAR; G_WAIT_L(0); G_MMA(0, 1, At, B1); G_BAR;
    G_LDA(At, 0, 1); G_WAIT_V(4); G_BAR; G_WAIT_L(0); G_MMA(1, 0, At, B0); G_MMA(1, 1, At, B1); G_BAR; }
  { G_LDB(B0, 1, 0); G_LDA(At, 1, 0); G_WAIT_V(2); G_BAR; G_WAIT_L(0); G_MMA(0, 0, At, B0); G_BAR;
    G_LDB(B1, 1, 1); G_WAIT_V(0); G_BAR; G_WAIT_L(0); G_MMA(0, 1, At, B1); G_BAR;
    G_LDA(At, 1, 1); G_BAR; G_WAIT_L(0); G_MMA(1, 0, At, B0); G_MMA(1, 1, At, B1); G_BAR; }
  if (wr == 0) G_BAR;
}

DI void convert_tile(const TJob& jb, int t, char* lds) {
  float* tile = (float*)lds;
  const int tid = threadIdx.x;
  const int tk = t / jb.tiles_n, tn = t % jb.tiles_n;
  const int k0 = tk * 64, n0 = tn * 64;
  __syncthreads();
#pragma unroll
  for (int i = 0; i < 2; ++i) {
    const int idx = tid + 512 * i, row = idx >> 4, c4 = idx & 15;
    const float4 v = *(const float4*)(jb.src + (size_t)(k0 + row) * jb.N + n0 + c4 * 4);
    tile[row * 65 + c4 * 4 + 0] = v.x; tile[row * 65 + c4 * 4 + 1] = v.y; tile[row * 65 + c4 * 4 + 2] = v.z; tile[row * 65 + c4 * 4 + 3] = v.w;
  }
  __syncthreads();
  const int n = tid >> 3, kc = tid & 7;
  float v[8];
#pragma unroll
  for (int j = 0; j < 8; ++j) v[j] = tile[(kc * 8 + j) * 65 + n];
  uint4 o;
  o.x = pack2(v[0], v[1]); o.y = pack2(v[2], v[3]); o.z = pack2(v[4], v[5]); o.w = pack2(v[6], v[7]);
  *(uint4*)(jb.dst + (size_t)(n0 + n) * jb.K + k0 + kc * 8) = o;
}

DI void mod_unit(const Params& p, int mu_, char* lds) {
  const int tid = threadIdx.x;
  const int layer = mu_ / 96, cc = mu_ % 96;
  float* sc = (float*)lds;
  float* red = sc + 9 * 1024;
  __syncthreads();
  for (int i = tid; i < 9 * 1024; i += 512) {
    const int row = i >> 10, k = i & 1023;
    const float v = row < 8 ? p.c[row * 1024 + k] : p.c_ctx[k];
    sc[i] = v / (1.f + __expf(-v));
  }
  __syncthreads();
  const int kg = tid >> 6, col = tid & 63;
  const float* w = p.w_mod + (size_t)layer * 1024 * 6144 + cc * 64 + col;
  float a[9];
#pragma unroll
  for (int r = 0; r < 9; ++r) a[r] = 0.f;
#pragma unroll 4
  for (int k = kg * 128; k < kg * 128 + 128; ++k) {
    const float wv = w[(size_t)k * 6144];
#pragma unroll
    for (int r = 0; r < 9; ++r) a[r] += sc[r * 1024 + k] * wv;
  }
#pragma unroll
  for (int r = 0; r < 9; ++r) red[(kg * 9 + r) * 64 + col] = a[r];
  __syncthreads();
  for (int i = tid; i < 576; i += 512) {
    const int r = i >> 6, cl = i & 63;
    float s = 0.f;
#pragma unroll
    for (int g = 0; g < 8; ++g) s += red[(g * 9 + r) * 64 + cl];
    const int n = cc * 64 + cl;
    p.MOD[(layer * 9 + r) * 6144 + n] = s + p.b_mod[layer * 6144 + n];
  }
  __syncthreads();
}

DI void sincos_d(double a, double& s, double& c) {
  const double n = rint(a * 0.6366197723675814);
  const double r = (a - n * 1.5707963267948966) - n * 6.123233995736766e-17;
  const double r2 = r * r;
  const double sp = r * (1.0 + r2 * (-1.0 / 6.0 + r2 * (1.0 / 120.0 + r2 * (-1.0 / 5040.0 + r2 * (1.0 / 362880.0 + r2 * (-1.0 / 39916800.0 + r2 * (1.0 / 6227020800.0)))))));
  const double cp = 1.0 + r2 * (-0.5 + r2 * (1.0 / 24.0 + r2 * (-1.0 / 720.0 + r2 * (1.0 / 40320.0 + r2 * (-1.0 / 3628800.0 + r2 * (1.0 / 479001600.0 + r2 * (-1.0 / 87178291200.0)))))));
  const int q = ((int)n) & 3;
  if (q == 0) { s = sp; c = cp; }
  else if (q == 1) { s = cp; c = -sp; }
  else if (q == 2) { s = -sp; c = -cp; }
  else { s = -cp; c = sp; }
}

DI void tab_unit(const Params& p) {
  for (int idx = threadIdx.x; idx < 1024; idx += 512) {
    const int pos = idx >> 4, fi = idx & 15;
    double f = 1.0;
    for (int i = 0; i < fi; ++i) f *= 0.5623413251903491;
    double s, c;
    sincos_d((double)pos * (double)(float)f, s, c);
    p.TAB[idx * 2 + 0] = (float)c;
    p.TAB[idx * 2 + 1] = (float)s;
  }
}

__device__ void phase0(const Params& p, char* lds) {
  const int total = p.total_tiles + 192 + 1;
  for (int u = blockIdx.x; u < total; u += gridDim.x) {
    if (u < p.total_tiles) {
      int j = 0;
#pragma unroll 1
      for (int q = 1; q < p.njobs; ++q) if (u >= p.jobs[q].tstart) j = q;
      convert_tile(p.jobs[j], u - p.jobs[j].tstart, lds);
    } else if (u < p.total_tiles + 192) {
      mod_unit(p, u - p.total_tiles, lds);
    } else {
      tab_unit(p);
    }
  }
}

DI void norm_mod_phase(const float* __restrict__ xl, const float* __restrict__ xc, const float* __restrict__ gain,
                               const float* __restrict__ mod, int shift_i, int scale_i, bf16_t* __restrict__ H, int ntok) {
  const int lane = threadIdx.x & 63;
  const int wg = blockIdx.x * 8 + (threadIdx.x >> 6), nw = gridDim.x * 8;
  for (int t = wg; t < ntok; t += nw) {
    const float* row = t < NL ? xl + (size_t)t * 1024 : xc + (size_t)(t - NL) * 1024;
    float4 v[4];
    float ss = 0.f;
#pragma unroll
    for (int i = 0; i < 4; ++i) {
      v[i] = *(const float4*)(row + (lane + 64 * i) * 4);
      ss += v[i].x * v[i].x + v[i].y * v[i].y + v[i].z * v[i].z + v[i].w * v[i].w;
    }
    ss = wave_sum(ss);
    const float rstd = rsqrtf(ss * (1.f / 1024.f) + 1e-6f);
    const int bp = t < NL ? (t >> 12) : 8;
    const float* sh = mod + (bp * 6 + shift_i) * 1024;
    const float* sc = mod + (bp * 6 + scale_i) * 1024;
#pragma unroll
    for (int i = 0; i < 4; ++i) {
      const int c = (lane + 64 * i) * 4;
      const float4 g = *(const float4*)(gain + c), s4 = *(const float4*)(sh + c), c4 = *(const float4*)(sc + c);
      store_bf4(H + (size_t)t * 1024 + c,
                v[i].x * rstd * g.x * (1.f + c4.x) + s4.x, v[i].y * rstd * g.y * (1.f + c4.y) + s4.y,
                v[i].z * rstd * g.z * (1.f + c4.z) + s4.z, v[i].w * rstd * g.w * (1.f + c4.w) + s4.w);
    }
  }
}

__device__ void final_norm_phase(const Params& p) {
  const int lane = threadIdx.x & 63;
  const int wg = blockIdx.x * 8 + (threadIdx.x >> 6), nw = gridDim.x * 8;
  for (int t = wg; t < NL; t += nw) {
    float* row = p.out + (size_t)t * 1024;
    float4 v[4];
    float ss = 0.f;
#pragma unroll
    for (int i = 0; i < 4; ++i) {
      v[i] = *(const float4*)(row + (lane + 64 * i) * 4);
      ss += v[i].x * v[i].x + v[i].y * v[i].y + v[i].z * v[i].z + v[i].w * v[i].w;
    }
    ss = wave_sum(ss);
    const float rstd = rsqrtf(ss * (1.f / 1024.f) + 1e-6f);
#pragma unroll
    for (int i = 0; i < 4; ++i) {
      const int c = (lane + 64 * i) * 4;
      const float4 g = *(const float4*)(p.final_norm + c);
      *(float4*)(row + c) = make_float4(v[i].x * rstd * g.x, v[i].y * rstd * g.y, v[i].z * rstd * g.z, v[i].w * rstd * g.w);
    }
  }
}

__device__ void phase_proj(const Params& p, char* lds) {
  const int lane = threadIdx.x & 63, wave = threadIdx.x >> 6;
  const int wt = wave & 3, wf = wave >> 2, lr = lane & 15, lq = lane >> 4;
  const int ntn = 27, total = (NT / 256) * ntn;
  for (int u = blockIdx.x; u < total; u += gridDim.x) {
    const int mt = u / ntn, nt = u % ntn;
    const int mi = nt < 8 ? 0 : nt < 16 ? 2 : nt < 24 ? 3 : nt == 24 ? 5 : nt == 25 ? 1 : 4;
    f32x4 acc[4][4];
    gemm_tile<true>(p.Hd, 1024, p.Wcat, 1024, 1024, mt * 256, nt * 128, lds, acc, p.mu + mi * 1024);
#pragma unroll
    for (int pp = 0; pp < 2; ++pp)
#pragma unroll
      for (int ti = 0; ti < 4; ++ti) {
        const int t = mt * 256 + wt * 64 + ti * 16 + lr;
        const int fl = wf * 64 + pp * 32 + lq * 8;
        f32x4 a = acc[2 * pp][ti], b = acc[2 * pp + 1][ti];
        if (nt >= 8 && nt < 16) {
          const int f = (nt & 7) * 128 + fl;
          const float4 kkl = *(const float4*)(p.k_k + f), kkh = *(const float4*)(p.k_k + f + 4);
          a[0] *= kkl.x; a[1] *= kkl.y; a[2] *= kkl.z; a[3] *= kkl.w; b[0] *= kkh.x; b[1] *= kkh.y; b[2] *= kkh.z; b[3] *= kkh.w;
          const f32x4 a2 = acc[2 * (1 - pp)][ti], b2 = acc[2 * (1 - pp) + 1][ti];
          const int f2 = (nt & 7) * 128 + wf * 64 + (1 - pp) * 32 + lq * 8;
          const float4 kkl2 = *(const float4*)(p.k_k + f2), kkh2 = *(const float4*)(p.k_k + f2 + 4);
          float ss = a[0] * a[0] + a[1] * a[1] + a[2] * a[2] + a[3] * a[3] + b[0] * b[0] + b[1] * b[1] + b[2] * b[2] + b[3] * b[3];
          ss += a2[0] * kkl2.x * a2[0] * kkl2.x + a2[1] * kkl2.y * a2[1] * kkl2.y + a2[2] * kkl2.z * a2[2] * kkl2.z + a2[3] * kkl2.w * a2[3] * kkl2.w
              + b2[0] * kkh2.x * b2[0] * kkh2.x + b2[1] * kkh2.y * b2[1] * kkh2.y + b2[2] * kkh2.z * b2[2] * kkh2.z + b2[3] * kkh2.w * b2[3] * kkh2.w;
          ss += __shfl_xor(ss, 16); ss += __shfl_xor(ss, 32);
          const float kinv = rsqrtf(ss + 1e-12f);
#pragma unroll
          for (int j = 0; j < 4; ++j) { a[j] *= kinv; b[j] *= kinv; }
          store_bf8(p.S[2] + (size_t)t * 1024 + f, a, b);
          if (pp == 0 && lq == 0) p.NRM[(size_t)((nt & 7) * 2 + wf) * NT + t] = sqrtf(ss + 1e-12f);
        } else if (nt < 24) {
          bf16_t* dst = nt < 8 ? p.S[0] : p.S[1];
          store_bf8(dst + (size_t)t * 1024 + (nt & 7) * 128 + fl, a, b);
        } else if (nt == 24) {
#pragma unroll
          for (int j = 0; j < 4; ++j) { a[j] = sigmoidf_(a[j]); b[j] = sigmoidf_(b[j]); }
          store_bf8(p.L1 + (size_t)t * 384 + fl, a, b);
        } else if (nt == 25) {
#pragma unroll
          for (int j = 0; j < 4; ++j) { a[j] = tanhf_(a[j]); b[j] = tanhf_(b[j]); }
          store_bf8(p.L1 + (size_t)t * 384 + 128 + fl, a, b);
        } else {
          store_bf8(p.L1 + (size_t)t * 384 + 256 + fl, a, b);
        }
      }
  }
}

__device__ void phase_prep(const Params& p, char* lds) {
  const int lane = threadIdx.x & 63, wave = threadIdx.x >> 6;
  const int wt = wave & 3, wf = wave >> 2, lr = lane & 15, lq = lane >> 4;
  const int total = (NT / 256) * 8;
  for (int u = blockIdx.x; u < total; u += gridDim.x) {
    const int mt = u >> 3, nt = u & 7;
    const int tok0 = mt * 256, f0 = nt * 128;
    f32x4 acc[4][4];
    uint4 afp[2][4];
    gemm_tile<false>(p.L1 + 256, 384, p.L2w + 0 * 65536, 64, 64, tok0, f0, lds, acc, nullptr);
#pragma unroll
    for (int pp = 0; pp < 2; ++pp) {
      const int f = f0 + wf * 64 + pp * 32 + lq * 8;
      const float4 a0l = *(const float4*)(p.a0 + f), a0h = *(const float4*)(p.a0 + f + 4);
#pragma unroll
      for (int ti = 0; ti < 4; ++ti) {
        const int t = tok0 + wt * 64 + ti * 16 + lr;
        f32x4 a = acc[2 * pp][ti], b = acc[2 * pp + 1][ti];
        a[0] = sigmoidf_(a[0] + a0l.x); a[1] = sigmoidf_(a[1] + a0l.y); a[2] = sigmoidf_(a[2] + a0l.z); a[3] = sigmoidf_(a[3] + a0l.w);
        b[0] = sigmoidf_(b[0] + a0h.x); b[1] = sigmoidf_(b[1] + a0h.y); b[2] = sigmoidf_(b[2] + a0h.z); b[3] = sigmoidf_(b[3] + a0h.w);
        uint4 o; o.x = pack2(a[0], a[1]); o.y = pack2(a[2], a[3]); o.z = pack2(b[0], b[1]); o.w = pack2(b[2], b[3]);
        afp[pp][ti] = o;
        *(uint4*)(p.S[3] + (size_t)t * 1024 + f) = o;
      }
    }
    gemm_tile<false>(p.L1 + 320, 384, p.L2w + 1 * 65536, 64, 64, tok0, f0, lds, acc, nullptr);
#pragma unroll
    for (int ti = 0; ti < 4; ++ti) {
      const int t = tok0 + wt * 64 + ti * 16 + lr;
      float bon = 0.f;
      const float nrm = p.NRM[(size_t)(nt * 2 + wf) * NT + t];
#pragma unroll
      for (int pp = 0; pp < 2; ++pp) {
        const int f = f0 + wf * 64 + pp * 32 + lq * 8;
        const float4 a0l = *(const float4*)(p.a0 + 1024 + f), a0h = *(const float4*)(p.a0 + 1024 + f + 4);
        const float4 rkl = *(const float4*)(p.r_k + f), rkh = *(const float4*)(p.r_k + f + 4);
        const float4 kal = *(const float4*)(p.k_a + f), kah = *(const float4*)(p.k_a + f + 4);
        const float4 kkl = *(const float4*)(p.k_k + f), kkh = *(const float4*)(p.k_k + f + 4);
        const float rk8[8] = {rkl.x, rkl.y, rkl.z, rkl.w, rkh.x, rkh.y, rkh.z, rkh.w};
        const float ka8[8] = {kal.x, kal.y, kal.z, kal.w, kah.x, kah.y, kah.z, kah.w};
        const float kk8[8] = {kkl.x, kkl.y, kkl.z, kkl.w, kkh.x, kkh.y, kkh.z, kkh.w};
        f32x4 a = acc[2 * pp][ti], b = acc[2 * pp + 1][ti];
        a[0] = sigmoidf_(a[0] + a0l.x); a[1] = sigmoidf_(a[1] + a0l.y); a[2] = sigmoidf_(a[2] + a0l.z); a[3] = sigmoidf_(a[3] + a0l.w);
        b[0] = sigmoidf_(b[0] + a0h.x); b[1] = sigmoidf_(b[1] + a0h.y); b[2] = sigmoidf_(b[2] + a0h.z); b[3] = sigmoidf_(b[3] + a0h.w);
        store_bf8(p.S[4] + (size_t)t * 1024 + f, a, b);
        const float ab8[8] = {a[0], a[1], a[2], a[3], b[0], b[1], b[2], b[3]};
        float af8[8], r8[8], k8[8];
        unpack_bf8(afp[pp][ti], af8);
        unpack_bf8(*(const uint4*)(p.S[0] + (size_t)t * 1024 + f), r8);
        unpack_bf8(*(const uint4*)(p.S[2] + (size_t)t * 1024 + f), k8);
#pragma unroll
        for (int e2 = 0; e2 < 8; ++e2) {
          const float k = k8[e2] * nrm / kk8[e2];
          bon += r8[e2] * k * rk8[e2] * (2.f + (ab8[e2] + af8[e2] - 2.f) * ka8[e2]);
        }
      }
      bon += __shfl_xor(bon, 16); bon += __shfl_xor(bon, 32);
      if (lq == 0) p.BON[(size_t)(nt * 2 + wf) * NT + t] = bon;
    }
#pragma unroll 1
    for (int dr = 0; dr < 2; ++dr) {
      gemm_tile<false>(p.L1 + 128 + dr * 64, 384, p.L2w + (2 + dr) * 65536, 64, 64, tok0, f0, lds, acc, nullptr);
      bf16_t* dst = dr ? p.S[5] : p.Hd;
#pragma unroll
      for (int pp = 0; pp < 2; ++pp) {
        const int f = f0 + wf * 64 + pp * 32 + lq * 8;
        const float4 w0l = *(const float4*)(p.w0 + dr * 1024 + f), w0h = *(const float4*)(p.w0 + dr * 1024 + f + 4);
#pragma unroll
        for (int ti = 0; ti < 4; ++ti) {
          const int t = tok0 + wt * 64 + ti * 16 + lr;
          f32x4 a = acc[2 * pp][ti], b = acc[2 * pp + 1][ti];
          a[0] = -0.60653066f * sigmoidf_(a[0] + w0l.x); a[1] = -0.60653066f * sigmoidf_(a[1] + w0l.y);
          a[2] = -0.60653066f * sigmoidf_(a[2] + w0l.z); a[3] = -0.60653066f * sigmoidf_(a[3] + w0l.w);
          b[0] = -0.60653066f * sigmoidf_(b[0] + w0h.x); b[1] = -0.60653066f * sigmoidf_(b[1] + w0h.y);
          b[2] = -0.60653066f * sigmoidf_(b[2] + w0h.z); b[3] = -0.60653066f * sigmoidf_(b[3] + w0h.w);
          store_bf8(dst + (size_t)t * 1024 + f, a, b);
        }
      }
    }
  }
}

__device__ void phase_scan(const Params& p, char* lds, bool dupout = false) {
  float* buf = (float*)lds;
  float* ybuf = (float*)(lds + 2 * 49152);
  const int tid = threadIdx.x;
  const bool loader = tid >= 256;
  const int lt = tid & 255, ltk = lt >> 3, lch = (lt & 7) * 8;
  const int rp = lt >> 3, l8 = lt & 7;
  constexpr int NCH = NKEY / 32;
  for (int unit = blockIdx.x; unit < 256; unit += gridDim.x) {
    const int dir = unit & 1, h = (unit >> 1) & 15, b = unit >> 5;
    const bf16_t* Rp = p.S[0]; const bf16_t* Vp = p.S[1]; const bf16_t* Kp = p.S[2];
    bf16_t* Ap = dir ? p.S[4] : p.S[3];
    const bf16_t* Lp = dir ? p.S[5] : p.Hd;
    auto tok_of = [&](int i) -> int {
      if (i < 256) return NL + b * 256 + (dir ? 255 - i : i);
      const int s = i - 256;
      return b * 4096 + (dir ? 4095 - s : s);
    };
    uint4 raw[5];
    float nrmv = 0.f;
    float kkc[8], kac[8];
    f32x2 S0[4], S1[4];
#pragma unroll
    for (int i = 0; i < 4; ++i) { S0[i] = f32x2{0.f, 0.f}; S1[i] = f32x2{0.f, 0.f}; }
    if (loader) {
#pragma unroll
      for (int j = 0; j < 8; ++j) { kkc[j] = p.k_k[h * 64 + lch + j]; kac[j] = p.k_a[h * 64 + lch + j]; }
    }
    auto issue = [&](int c) {
      const int t = tok_of(c * 32 + ltk);
      const size_t off = (size_t)t * 1024 + h * 64 + lch;
      raw[0] = *(const uint4*)(Rp + off); raw[1] = *(const uint4*)(Vp + off); raw[2] = *(const uint4*)(Kp + off);
      raw[3] = *(const uint4*)(Ap + off); raw[4] = *(const uint4*)(Lp + off);
      nrmv = p.NRM[(size_t)h * NT + t];
    };
    auto unpack8 = [&](const uint4& u, float (&o)[8]) {
      o[0] = bflo(u.x); o[1] = bfhi(u.x); o[2] = bflo(u.y); o[3] = bfhi(u.y); o[4] = bflo(u.z); o[5] = bfhi(u.z); o[6] = bflo(u.w); o[7] = bfhi(u.w);
    };
    auto process = [&](int stage) {
      float r8[8], v8[8], k8[8], a8[8], l8[8], kk8[8], kd8[8], b8[8], w8[8];
      unpack8(raw[0], r8); unpack8(raw[1], v8); unpack8(raw[2], k8); unpack8(raw[3], a8); unpack8(raw[4], l8);
#pragma unroll
      for (int j = 0; j < 8; ++j) {
        kk8[j] = k8[j];
        const float k = k8[j] * nrmv / kkc[j];
        kd8[j] = k * (1.f + (a8[j] - 1.f) * kac[j]);
        b8[j] = kk8[j] * a8[j];
        w8[j] = __expf(l8[j]);
      }
      float* dst = buf + stage * 12288 + ltk * 384 + lch;
      *(float4*)(dst + 0) = make_float4(r8[0], r8[1], r8[2], r8[3]);       *(float4*)(dst + 4) = make_float4(r8[4], r8[5], r8[6], r8[7]);
      *(float4*)(dst + 64) = make_float4(w8[0], w8[1], w8[2], w8[3]);      *(float4*)(dst + 68) = make_float4(w8[4], w8[5], w8[6], w8[7]);
      *(float4*)(dst + 128) = make_float4(kd8[0], kd8[1], kd8[2], kd8[3]); *(float4*)(dst + 132) = make_float4(kd8[4], kd8[5], kd8[6], kd8[7]);
      *(float4*)(dst + 192) = make_float4(kk8[0], kk8[1], kk8[2], kk8[3]); *(float4*)(dst + 196) = make_float4(kk8[4], kk8[5], kk8[6], kk8[7]);
      *(float4*)(dst + 256) = make_float4(b8[0], b8[1], b8[2], b8[3]);     *(float4*)(dst + 260) = make_float4(b8[4], b8[5], b8[6], b8[7]);
      *(float4*)(dst + 320) = make_float4(v8[0], v8[1], v8[2], v8[3]);     *(float4*)(dst + 324) = make_float4(v8[4], v8[5], v8[6], v8[7]);
    };
    auto yout = [&](int c) {
      const float* yb = ybuf + (c & 1) * 2048 + ltk * 64 + lch;
      const float4 y0 = *(const float4*)yb, y1 = *(const float4*)(yb + 4);
      const int t = tok_of(c * 32 + ltk);
      uint4 o;
      o.x = pack2(y0.x, y0.y); o.y = pack2(y0.z, y0.w); o.z = pack2(y1.x, y1.y); o.w = pack2(y1.z, y1.w);
      *(uint4*)((dupout ? p.S[0] : Ap) + (size_t)t * 1024 + h * 64 + lch) = o;
    };
    __syncthreads();
    if (loader) { issue(0); process(0); issue(1); }
    __syncthreads();
    for (int c = 0; c < NCH; ++c) {
      if (loader) {
        if (c >= 1) yout(c - 1);
        if (c + 1 < NCH) { process((c + 1) & 1); if (c + 2 < NCH) issue(c + 2); }
      } else {
        const float* bb = buf + (c & 1) * 12288 + l8 * 8;
        const float* vb = buf + (c & 1) * 12288 + 320 + 2 * rp;
        float* yb = ybuf + (c & 1) * 2048 + 2 * rp;
        StepV A, B;
        scan_load(A, bb, vb);
#pragma unroll 1
        for (int j = 0; j < 32; j += 2) {
          scan_load(B, bb + (j + 1) * 384, vb + (j + 1) * 384);
          scan_step(A, S0, S1, yb + j * 64, l8 == 0);
          if (j + 2 < 32) scan_load(A, bb + (j + 2) * 384, vb + (j + 2) * 384);
          scan_step(B, S0, S1, yb + (j + 1) * 64, l8 == 0);
        }
      }
      __syncthreads();
    }
    if (loader) yout(NCH - 1);
    __syncthreads();
  }
}

__device__ void phase_readout(const Params& p, char* lds) {
  const int lane = threadIdx.x & 63, wave = threadIdx.x >> 6;
  const int wt = wave & 3, wf = wave >> 2, lr = lane & 15, lq = lane >> 4;
  const int total = (NT / 256) * 8;
  for (int u = blockIdx.x; u < total; u += gridDim.x) {
    const int mt = u >> 3, nt = u & 7;
    const int tok0 = mt * 256, f0 = nt * 128;
    f32x4 g[4][4];
    gemm_tile<false>(p.L1, 384, p.g2T, 128, 128, tok0, f0, lds, g, nullptr);
    const int head = nt * 2 + wf;
#pragma unroll
    for (int ti = 0; ti < 4; ++ti) {
      const int t = tok0 + wt * 64 + ti * 16 + lr;
      float y[2][8];
      float sum = 0.f;
#pragma unroll
      for (int pp = 0; pp < 2; ++pp) {
        const int f = f0 + wf * 64 + pp * 32 + lq * 8;
        float ya[8], yb[8];
        unpack_bf8(*(const uint4*)(p.S[3] + (size_t)t * 1024 + f), ya);
        unpack_bf8(*(const uint4*)(p.S[4] + (size_t)t * 1024 + f), yb);
#pragma unroll
        for (int e2 = 0; e2 < 8; ++e2) { y[pp][e2] = ya[e2] + yb[e2]; sum += y[pp][e2]; }
      }
      sum += __shfl_xor(sum, 16); sum += __shfl_xor(sum, 32);
      const float mean = sum * (1.f / 64.f);
      float vs = 0.f;
#pragma unroll
      for (int pp = 0; pp < 2; ++pp)
#pragma unroll
        for (int e2 = 0; e2 < 8; ++e2) { const float d = y[pp][e2] - mean; vs += d * d; }
      vs += __shfl_xor(vs, 16); vs += __shfl_xor(vs, 32);
      const float rstd = rsqrtf(vs * (1.f / 64.f) + 64e-5f);
      const float bon = p.BON[(size_t)head * NT + t];
#pragma unroll
      for (int pp = 0; pp < 2; ++pp) {
        const int f = f0 + wf * 64 + pp * 32 + lq * 8;
        const float4 lwl = *(const float4*)(p.ln_w + f), lwh = *(const float4*)(p.ln_w + f + 4);
        const float4 lbl = *(const float4*)(p.ln_b + f), lbh = *(const float4*)(p.ln_b + f + 4);
        const float lw8[8] = {lwl.x, lwl.y, lwl.z, lwl.w, lwh.x, lwh.y, lwh.z, lwh.w};
        const float lb8[8] = {lbl.x, lbl.y, lbl.z, lbl.w, lbh.x, lbh.y, lbh.z, lbh.w};
        float v8[8];
        unpack_bf8(*(const uint4*)(p.S[1] + (size_t)t * 1024 + f), v8);
        f32x4 oa, ob;
#pragma unroll
        for (int j = 0; j < 4; ++j) {
          oa[j] = ((y[pp][j] - mean) * rstd * lw8[j] + lb8[j] + bon * v8[j]) * g[2 * pp][ti][j];
          ob[j] = ((y[pp][4 + j] - mean) * rstd * lw8[4 + j] + lb8[4 + j] + bon * v8[4 + j]) * g[2 * pp + 1][ti][j];
        }
        store_bf8(p.S[0] + (size_t)t * 1024 + f, oa, ob);
      }
    }
  }
}

DI void phase_gemm_resid(const Params& p, char* lds, const bf16_t* A, const bf16_t* W, int K, int ntm,
                                 const float* xin_l, const float* xin_c, const float* gate, float* dummy_out = nullptr) {
  const int lane = threadIdx.x & 63, wave = threadIdx.x >> 6;
  const int wr = wave >> 2, wc = wave & 3;
  const int total = ntm * 4;
  for (int u = blockIdx.x; u < total; u += gridDim.x) {
    const int mt = u >> 2, nt = u & 3;
    f32x4 acc[2][2][4][2];
    gemm256_tile<true>(W, A, K, nt * 256, mt * 256, lds, acc);
    int lane_o = threadIdx.x & 63; asm volatile("" : "+v"(lane_o));
    const int fr = lane_o & 15, fq = lane_o >> 4;
#pragma unroll
    for (int bj = 0; bj < 2; ++bj)
#pragma unroll
      for (int n = 0; n < 2; ++n) {
        const int t = mt * 256 + bj * 128 + wc * 32 + n * 16 + fr;
        const int bp = t < NL ? (t >> 12) : 8;
        const float* xi = t < NL ? xin_l + (size_t)t * 1024 : xin_c + (size_t)(t - NL) * 1024;
        float* xo = dummy_out ? dummy_out + (size_t)t * 1024 : (t < NL ? p.out + (size_t)t * 1024 : p.XC + (size_t)(t - NL) * 1024);
#pragma unroll
        for (int ai = 0; ai < 2; ++ai)
#pragma unroll
          for (int mp = 0; mp < 2; ++mp) {
            const int f = nt * 256 + ai * 128 + wr * 64 + mp * 32 + fq * 8;
            const float4 g0 = *(const float4*)(gate + bp * 6144 + f), g1 = *(const float4*)(gate + bp * 6144 + f + 4);
            const float4 x0 = *(const float4*)(xi + f), x1 = *(const float4*)(xi + f + 4);
            const f32x4 a = acc[ai][bj][2 * mp][n], b = acc[ai][bj][2 * mp + 1][n];
            *(float4*)(xo + f) = make_float4(x0.x + g0.x * a[0], x0.y + g0.y * a[1], x0.z + g0.z * a[2], x0.w + g0.w * a[3]);
            *(float4*)(xo + f + 4) = make_float4(x1.x + g1.x * b[0], x1.y + g1.y * b[1], x1.z + g1.z * b[2], x1.w + g1.w * b[3]);
          }
      }
  }
}

DI void phase_up(const Params& p, char* lds, const bf16_t* H, const bf16_t* W, bf16_t* U, int ntm) {
  const int lane = threadIdx.x & 63, wave = threadIdx.x >> 6;
  const int wr = wave >> 2, wc = wave & 3;
  const int total = ntm * 16;
  for (int u = blockIdx.x; u < total; u += gridDim.x) {
    const int mt = u >> 4, nt = u & 15;
    f32x4 acc[2][2][4][2];
    gemm256_tile<true>(W, H, 1024, nt * 256, mt * 256, lds, acc);
    int lane_o = threadIdx.x & 63; asm volatile("" : "+v"(lane_o));
    const int fr = lane_o & 15, fq = lane_o >> 4;
#pragma unroll
    for (int bj = 0; bj < 2; ++bj)
#pragma unroll
      for (int n = 0; n < 2; ++n) {
        const int t = mt * 256 + bj * 128 + wc * 32 + n * 16 + fr;
#pragma unroll
        for (int ai = 0; ai < 2; ++ai)
#pragma unroll
          for (int mp = 0; mp < 2; ++mp) {
            const int f = nt * 256 + ai * 128 + wr * 64 + mp * 32 + fq * 8;
            f32x4 a = acc[ai][bj][2 * mp][n], b = acc[ai][bj][2 * mp + 1][n];
#pragma unroll
            for (int j = 0; j < 4; ++j) { const float ra = fmaxf(a[j], 0.f), rb = fmaxf(b[j], 0.f); a[j] = ra * ra; b[j] = rb * rb; }
            store_bf8(U + (size_t)t * 4096 + f, a, b);
          }
      }
  }
}

__device__ void phase_qkv(const Params& p, char* lds) {
  const int lane = threadIdx.x & 63, wave = threadIdx.x >> 6;
  const int wr = wave >> 2, wc = wave & 3;
  const int total = (NT / 256) * 6;
  bf16_t* Q = p.S[0]; bf16_t* KA = p.S[1]; bf16_t* VT = p.S[2];
  for (int u = blockIdx.x; u < total; u += gridDim.x) {
    const int mt = u / 6, nt = u % 6;
    if (mt >= NL / 256 && nt < 4) continue;
    f32x4 acc[2][2][4][2];
    gemm256_tile<false>(p.wqkvT, p.S[5], 1024, nt * 256, mt * 256, lds, acc);
    int lane_o = threadIdx.x & 63; asm volatile("" : "+v"(lane_o));
    const int fr = lane_o & 15, fq = lane_o >> 4;
#pragma unroll
    for (int bj = 0; bj < 2; ++bj)
#pragma unroll
      for (int n = 0; n < 2; ++n) {
        const int t = mt * 256 + bj * 128 + wc * 32 + n * 16 + fr;
        const bool lat = t < NL;
        const int b = lat ? (t >> 12) : ((t - NL) >> 8);
        const int key = lat ? (t & 4095) : 4096 + ((t - NL) & 255);
#pragma unroll
        for (int ai = 0; ai < 2; ++ai) {
          const int hh = ai * 2 + wr;
          asm volatile("" ::: "memory");
          if (nt < 5) {
            float ss = 0.f;
#pragma unroll
            for (int m = 0; m < 4; ++m)
#pragma unroll
              for (int j = 0; j < 4; ++j) ss += acc[ai][bj][m][n][j] * acc[ai][bj][m][n][j];
            ss += __shfl_xor(ss, 16); ss += __shfl_xor(ss, 32);
            const float rstd = rsqrtf(ss * (1.f / 64.f) + 1e-6f);
            const float* gn = nt < 4 ? p.q_norm : p.k_norm;
            float v[4][4];
#pragma unroll
            for (int m = 0; m < 4; ++m) {
              const float4 g4 = *(const float4*)(gn + m * 16 + fq * 4);
              v[m][0] = acc[ai][bj][m][n][0] * rstd * g4.x; v[m][1] = acc[ai][bj][m][n][1] * rstd * g4.y;
              v[m][2] = acc[ai][bj][m][n][2] * rstd * g4.z; v[m][3] = acc[ai][bj][m][n][3] * rstd * g4.w;
            }
            if (lat) {
              const int s = t & 4095, rowp = s >> 6, colp = s & 63;
#pragma unroll
              for (int j = 0; j < 4; ++j) {
                const float2 cs0 = *(const float2*)(p.TAB + (rowp * 16 + fq * 4 + j) * 2);
                const float2 cs1 = *(const float2*)(p.TAB + (colp * 16 + fq * 4 + j) * 2);
                const float x1 = v[0][j], x2 = v[1][j], z1 = v[2][j], z2 = v[3][j];
                v[0][j] = x1 * cs0.x - x2 * cs0.y; v[1][j] = x2 * cs0.x + x1 * cs0.y;
                v[2][j] = z1 * cs1.x - z2 * cs1.y; v[3][j] = z2 * cs1.x + z1 * cs1.y;
              }
            }
            if (nt < 4) {
              const float qs = 0.125f * 1.4426950408889634f;
              const int head = nt * 4 + hh;
#pragma unroll
              for (int m = 0; m < 4; ++m)
                store_bf4(Q + (size_t)t * 1024 + head * 64 + m * 16 + fq * 4, v[m][0] * qs, v[m][1] * qs, v[m][2] * qs, v[m][3] * qs);
            } else {
#pragma unroll
              for (int m = 0; m < 4; ++m)
                store_bf4(KA + ((size_t)(b * 4 + hh) * NKEY + key) * 64 + m * 16 + fq * 4, v[m][0], v[m][1], v[m][2], v[m][3]);
            }
          } else {
#pragma unroll
            for (int m = 0; m < 4; ++m)
#pragma unroll
              for (int j = 0; j < 4; ++j) {
                const int d = m * 16 + fq * 4 + j;
                const unsigned pk = pack2(acc[ai][bj][m][n][j], 0.f);
                VT[((size_t)(b * 4 + hh) * 64 + d) * NKEY + key] = (bf16_t)(pk & 0xffffu);
              }
          }
        }
      }
  }
}

__device__ void phase_attn(const Params& p, char* lds) {
  const int tid = threadIdx.x, lane = tid & 63, wave = tid >> 6;
  const int l31 = lane & 31, lh = lane >> 5;
  const int srow = tid >> 3, sch = tid & 7;
  const bf16_t* Q = p.S[0]; const bf16_t* KA = p.S[1]; const bf16_t* VT = p.S[2]; bf16_t* O = p.S[3];
  float gq = 0.f, gk = 0.f;
  for (int i = 0; i < 64; ++i) { gq = fmaxf(gq, fabsf(p.q_norm[i])); gk = fmaxf(gk, fabsf(p.k_norm[i])); }
  const float M2 = 8.f * gq * gk * 1.4426950408889634f;
  constexpr int NKT = NKEY / 64;
  constexpr int AST = 2 * 64 * ROWB;
  for (int u = blockIdx.x; u < 2048; u += gridDim.x) {
    const int qb = u & 15, head = (u >> 4) & 15, b = u >> 8, kvh = head >> 2;
    const bf16_t* Kg = KA + (size_t)(b * 4 + kvh) * NKEY * 64;
    const bf16_t* Vg = VT + (size_t)(b * 4 + kvh) * 64 * NKEY;
    const int tq = b * 4096 + qb * 256 + wave * 32 + l31;
    bf16x8 qf[4];
#pragma unroll
    for (int s = 0; s < 4; ++s) qf[s] = *(const bf16x8*)(Q + (size_t)tq * 1024 + head * 64 + s * 16 + lh * 8);
    f32x16 o0, o1;
#pragma unroll
    for (int i = 0; i < 16; ++i) { o0[i] = 0.f; o1[i] = 0.f; }
    float lsum = 0.f;
    uint4 kreg, vreg;
    auto gload = [&](int kt) {
      kreg = *(const uint4*)(Kg + (size_t)(kt * 64 + srow) * 64 + sch * 8);
      vreg = *(const uint4*)(Vg + (size_t)srow * NKEY + kt * 64 + sch * 8);
    };
    auto lwrite = [&](int st) {
      *(uint4*)(lds + st * AST + srow * ROWB + sch * 16) = kreg;
      *(uint4*)(lds + st * AST + 64 * ROWB + srow * ROWB + sch * 16) = vreg;
    };
    gload(0);
    __syncthreads();
    lwrite(0);
    __syncthreads();
    for (int kt = 0; kt < NKT; ++kt) {
      if (kt + 1 < NKT) gload(kt + 1);
      const char* ksm = lds + (kt & 1) * AST;
      const char* vsm = ksm + 64 * ROWB;
      f32x16 sT[2];
#pragma unroll
      for (int k2 = 0; k2 < 2; ++k2) {
#pragma unroll
        for (int i = 0; i < 16; ++i) sT[k2][i] = -M2;
#pragma unroll
        for (int s = 0; s < 4; ++s) {
          const bf16x8 kf = *(const bf16x8*)(ksm + (k2 * 32 + l31) * ROWB + s * 32 + lh * 16);
          sT[k2] = MFMA32(kf, qf[s], sT[k2]);
        }
      }
#pragma unroll
      for (int k2 = 0; k2 < 2; ++k2)
#pragma unroll
        for (int i = 0; i < 16; ++i) { const float pv = __builtin_amdgcn_exp2f(sT[k2][i]); lsum += pv; sT[k2][i] = pv; }
#pragma unroll
      for (int k2 = 0; k2 < 2; ++k2)
#pragma unroll
        for (int s2 = 0; s2 < 2; ++s2) {
          uint4 pk;
          pk.x = pack2(sT[k2][8 * s2 + 0], sT[k2][8 * s2 + 1]); pk.y = pack2(sT[k2][8 * s2 + 2], sT[k2][8 * s2 + 3]);
          pk.z = pack2(sT[k2][8 * s2 + 4], sT[k2][8 * s2 + 5]); pk.w = pack2(sT[k2][8 * s2 + 6], sT[k2][8 * s2 + 7]);
          const bf16x8 pf = __builtin_bit_cast(bf16x8, pk);
          const int koff = (k2 * 32 + 16 * s2 + 4 * lh) * 2;
          {
            const uint2 lo = *(const uint2*)(vsm + l31 * ROWB + koff), hi = *(const uint2*)(vsm + l31 * ROWB + koff + 16);
            const uint4 vv = make_uint4(lo.x, lo.y, hi.x, hi.y);
            o0 = MFMA32(__builtin_bit_cast(bf16x8, vv), pf, o0);
          }
          {
            const uint2 lo = *(const uint2*)(vsm + (32 + l31) * ROWB + koff), hi = *(const uint2*)(vsm + (32 + l31) * ROWB + koff + 16);
            const uint4 vv = make_uint4(lo.x, lo.y, hi.x, hi.y);
            o1 = MFMA32(__builtin_bit_cast(bf16x8, vv), pf, o1);
          }
        }
      if (kt + 1 < NKT) lwrite((kt + 1) & 1);
      __syncthreads();
    }
    lsum += __shfl_xor(lsum, 32);
    const float inv = 1.f / lsum;
#pragma unroll
    for (int g = 0; g < 4; ++g) {
      const int d0 = 8 * g + 4 * lh;
      store_bf4(O + (size_t)tq * 1024 + head * 64 + d0, o0[4 * g] * inv, o0[4 * g + 1] * inv, o0[4 * g + 2] * inv, o0[4 * g + 3] * inv);
      store_bf4(O + (size_t)tq * 1024 + head * 64 + 32 + d0, o1[4 * g] * inv, o1[4 * g + 1] * inv, o1[4 * g + 2] * inv, o1[4 * g + 3] * inv);
    }
  }
}

#define XB_TMO      128
#define XB_XCNT(j)  (256  + 64 * (j))
#define XB_XSUB(j)  (1280 + 64 * (j))
#define XB_XGEN(j)  (2304 + 64 * (j))
#define XB_TOP      3328
#define XB_TOPGEN   3392
#define XCD_BAR_WORDS 3456
#define XB_SPIN_CAP (1u << 18)
#define LAS __attribute__((address_space(3)))

__device__ __forceinline__ unsigned xb_ld(unsigned* p)              { return __hip_atomic_load(p, __ATOMIC_RELAXED, __HIP_MEMORY_SCOPE_AGENT); }
__device__ __forceinline__ unsigned xb_add(unsigned* p, unsigned v) { return __hip_atomic_fetch_add(p, v, __ATOMIC_RELAXED, __HIP_MEMORY_SCOPE_AGENT); }
__device__ __forceinline__ unsigned xb_xcc_id() { return (unsigned)__builtin_amdgcn_s_getreg((3 << 11) | 20) & 0xFu; }
#define XB_SPIN(cond, bar) do { unsigned _sp = 0; while (cond) { __builtin_amdgcn_s_sleep(1); \
    if ((++_sp & 255u) == 0u) { if (xb_ld(&(bar)[XB_TMO])) break; if (_sp > XB_SPIN_CAP) { atomicAdd(&(bar)[XB_TMO], 1u); break; } } } } while (0)

struct XcdBarrier {
    unsigned* bar; unsigned x;
    volatile LAS unsigned* st;
};

__device__ __forceinline__ XcdBarrier xcd_barrier_post(unsigned* bar, volatile LAS unsigned* st) {
    XcdBarrier b; b.bar = bar; b.x = xb_xcc_id(); b.st = st;
    if (threadIdx.x == 0) (void)xb_add(&bar[XB_XCNT(b.x)], 1u);
    return b;
}
__device__ __forceinline__ void xcd_barrier_complete(unsigned* bar, unsigned x, unsigned& nloc, unsigned& nx) {
    const unsigned G = gridDim.x * gridDim.y * gridDim.z;
    unsigned sum, cnt, mine, sp = 0u;
    for (;;) {
        sum = 0u; cnt = 0u; mine = 0u;
#pragma unroll
        for (unsigned j = 0; j < 16; ++j) { const unsigned c = xb_ld(&bar[XB_XCNT(j)]); sum += c; cnt += (c > 0u) ? 1u : 0u; mine = (j == x) ? c : mine; }
        if (sum == G) break;
        __builtin_amdgcn_s_sleep(1);
        if ((++sp & 255u) == 0u) { if (xb_ld(&bar[XB_TMO])) break; if (sp > XB_SPIN_CAP) { atomicAdd(&bar[XB_TMO], 1u); break; } }
    }
    nloc = mine > 0u ? mine : 1u; nx = cnt > 0u ? cnt : 1u;
}

__device__ __forceinline__ void xcd_barrier(const XcdBarrier& b) {
    asm volatile("s_waitcnt vmcnt(0)" ::: "memory");
    __syncthreads();
    if (threadIdx.x == 0) {
        unsigned* bar = b.bar;
        __builtin_amdgcn_s_waitcnt(0);
        unsigned nloc = b.st[0], nx = b.st[1];
        if (nloc == 0u) { xcd_barrier_complete(bar, b.x, nloc, nx); b.st[0] = nloc; b.st[1] = nx; }
        const unsigned old = xb_add(&bar[XB_XSUB(b.x)], 1u);
        const unsigned gen = old / nloc;
        if (old + 1u == (gen + 1u) * nloc) {
            __builtin_amdgcn_fence(__ATOMIC_RELEASE, "agent");
            asm volatile("s_waitcnt vmcnt(0)" ::: "memory");
            const unsigned og = xb_add(&bar[XB_TOP], 1u);
            const unsigned tg = og / nx;
            if (og + 1u == (tg + 1u) * nx) xb_add(&bar[XB_TOPGEN], 1u);
            else XB_SPIN(xb_ld(&bar[XB_TOPGEN]) == tg, bar);
            __builtin_amdgcn_fence(__ATOMIC_ACQUIRE, "agent");
            xb_add(&bar[XB_XGEN(b.x)], 1u);
            asm volatile("s_waitcnt vmcnt(0)" ::: "memory");
        } else {
            XB_SPIN(xb_ld(&bar[XB_XGEN(b.x)]) == gen, bar);
            __builtin_amdgcn_fence(__ATOMIC_ACQUIRE, "agent");
            asm volatile("s_waitcnt vmcnt(0)" ::: "memory");
        }
    }
    __syncthreads();
}


DI void run_phase(const Params& p, int ph, char* lds) {
  const float* mod0 = p.MOD;
  const float* mod1 = p.MOD + 9 * 6144;
  switch (ph) {
    case 0: phase0(p, lds); break;
    case 1: norm_mod_phase(p.x, p.ctx, p.norm_mix, mod0, 0, 1, p.Hd, NT); break;
    case 2: phase_proj(p, lds); break;
    case 3: phase_prep(p, lds); break;
    case 4: phase_scan(p, lds); break;
    case 5: phase_readout(p, lds); break;
    case 6: phase_gemm_resid(p, lds, p.S[0], p.woT, 1024, NT / 256, p.x, p.ctx, mod0 + 2 * 1024); break;
    case 7: norm_mod_phase(p.out, p.XC, p.norm_mlp, mod0, 3, 4, p.S[5], NT); break;
    case 8: phase_up(p, lds, p.S[5], p.w1T[0], p.S[0], NT / 256); break;
    case 9: phase_gemm_resid(p, lds, p.S[0], p.w2T[0], 4096, NT / 256, p.out, p.XC, mod0 + 5 * 1024); break;
    case 10: norm_mod_phase(p.out, p.XC, p.norm_mix + 1024, mod1, 0, 1, p.S[5], NT); break;
    case 11: phase_qkv(p, lds); break;
    case 12: phase_attn(p, lds); break;
    case 13: phase_gemm_resid(p, lds, p.S[3], p.awoT, 1024, NL / 256, p.out, p.XC, mod1 + 2 * 1024); break;
    case 14: norm_mod_phase(p.out, p.XC, p.norm_mlp + 1024, mod1, 3, 4, p.S[5], NL); break;
    case 15: phase_up(p, lds, p.S[5], p.w1T[1], p.S[0], NL / 256); break;
    case 16: phase_gemm_resid(p, lds, p.S[0], p.w2T[1], 4096, NL / 256, p.out, p.XC, mod1 + 5 * 1024); break;
    case 17: final_norm_phase(p); break;
  }
}
constexpr int NPHASE = 18;

__global__ void __launch_bounds__(NTHREADS) phase_kernel(Params p, int ph) {
  extern __shared__ __attribute__((aligned(16))) char lds[];
  run_phase(p, ph, lds);
}

__global__ void __launch_bounds__(NTHREADS) mega_kernel(Params p) {
  extern __shared__ __attribute__((aligned(16))) char lds[];
  cg::grid_group grid = cg::this_grid();
  volatile LAS unsigned* st = (volatile LAS unsigned*)(LAS char*)(lds + 131072);
  if (threadIdx.x == 0) { st[0] = 0u; st[1] = 0u; }
  if (blockIdx.x == 0) for (int i = threadIdx.x; i < XCD_BAR_WORDS; i += NTHREADS) p.BAR[i] = 0u;
  __syncthreads();
  run_phase(p, 0, lds);
  grid.sync();
  const XcdBarrier xb = xcd_barrier_post(p.BAR, st);
#ifndef DUP
#define DUP -1
#endif
#define PH(n) run_phase(p, n, lds); xcd_barrier(xb); if (DUP == n) { if (n == 4) phase_scan(p, lds, true); else if (n == 9) phase_gemm_resid(p, lds, p.S[0], p.w2T[0], 4096, NT / 256, p.out, p.XC, p.MOD + 5 * 1024, (float*)p.S[4]); else run_phase(p, n, lds); xcd_barrier(xb); } if (DUP == 100) { xcd_barrier(xb); }
  PH(1) PH(2) PH(3) PH(4) PH(5) PH(6) PH(7) PH(8) PH(9) PH(10) PH(11) PH(12) PH(13) PH(14) PH(15) PH(16)
  run_phase(p, 17, lds);
}

extern "C" void kernel_launch(void* const* d_in, const int* in_sizes, int n_in, void* d_out, int out_size, void* d_ws, size_t ws_size, hipStream_t stream) {
  Params p;
  memset(&p, 0, sizeof(p));
  const float* const* in = (const float* const*)d_in;
  p.x = in[0]; p.c = in[1]; p.ctx = in[2]; p.c_ctx = in[3]; p.w_mod = in[4]; p.b_mod = in[5]; p.norm_mix = in[6]; p.norm_mlp = in[7];
  p.mlp_w1 = in[8]; p.mlp_w2 = in[9]; p.mu = in[10]; p.wr = in[11]; p.wk = in[12]; p.wv = in[13]; p.wo = in[14]; p.w0 = in[15]; p.w1 = in[16];
  p.w2 = in[17]; p.a0 = in[18]; p.a1 = in[19]; p.a2 = in[20]; p.g1 = in[21]; p.g2 = in[22]; p.k_k = in[23]; p.k_a = in[24]; p.r_k = in[25];
  p.ln_w = in[26]; p.ln_b = in[27]; p.wqkv = in[28]; p.q_norm = in[29]; p.k_norm = in[30]; p.awo = in[31]; p.final_norm = in[32];
  p.out = (float*)d_out;
  char* ws = (char*)d_ws;
  size_t off = 0;
  auto take = [&](size_t bytes) -> char* { char* r = ws + off; off += (bytes + 255) & ~(size_t)255; return r; };
  p.Wcat = (bf16_t*)take((size_t)3456 * 1024 * 2);
  p.L2w = (bf16_t*)take((size_t)4 * 65536 * 2);
  p.g2T = (bf16_t*)take((size_t)1024 * 128 * 2);
  p.woT = (bf16_t*)take((size_t)1024 * 1024 * 2);
  p.w1T[0] = (bf16_t*)take((size_t)4096 * 1024 * 2);
  p.w1T[1] = (bf16_t*)take((size_t)4096 * 1024 * 2);
  p.w2T[0] = (bf16_t*)take((size_t)4096 * 1024 * 2);
  p.w2T[1] = (bf16_t*)take((size_t)4096 * 1024 * 2);
  p.wqkvT = (bf16_t*)take((size_t)1536 * 1024 * 2);
  p.awoT = (bf16_t*)take((size_t)1024 * 1024 * 2);
  p.MOD = (float*)take((size_t)2 * 9 * 6144 * 4);
  p.TAB = (float*)take((size_t)1024 * 2 * 4);
  p.XC = (float*)take((size_t)NC * 1024 * 4);
  p.BAR = (unsigned*)take((size_t)XCD_BAR_WORDS * 4);
  for (int i = 0; i < 6; ++i) p.S[i] = (bf16_t*)take((size_t)NT * 1024 * 2);
  if (off > ws_size) { fprintf(stderr, "kernel_launch: workspace too small (%zu needed, %zu given)\n", off, ws_size); return; }
  char* ob = (char*)d_out;
  p.Hd = (bf16_t*)ob;
  p.L1 = (bf16_t*)(ob + (size_t)NT * 1024 * 2);
  p.BON = (float*)(ob + (size_t)NT * 1024 * 2 + (size_t)NT * 384 * 2);
  p.NRM = (float*)(ob + (size_t)NT * 1024 * 2 + (size_t)NT * 384 * 2 + (size_t)NT * 16 * 4);
  int nj = 0, tiles = 0;
  auto job = [&](const float* src, bf16_t* dst, int K, int N) {
    p.jobs[nj].src = src; p.jobs[nj].dst = dst; p.jobs[nj].K = K; p.jobs[nj].N = N; p.jobs[nj].tstart = tiles; p.jobs[nj].tiles_n = N / 64;
    tiles += (K / 64) * (N / 64); ++nj;
  };
  job(p.wr, p.Wcat, 1024, 1024);
  job(p.wk, p.Wcat + (size_t)1024 * 1024, 1024, 1024);
  job(p.wv, p.Wcat + (size_t)2048 * 1024, 1024, 1024);
  job(p.g1, p.Wcat + (size_t)3072 * 1024, 1024, 128);
  job(p.w1, p.Wcat + (size_t)3200 * 1024, 1024, 64);
  job(p.w1 + 65536, p.Wcat + (size_t)3264 * 1024, 1024, 64);
  job(p.a1, p.Wcat + (size_t)3328 * 1024, 1024, 64);
  job(p.a1 + 65536, p.Wcat + (size_t)3392 * 1024, 1024, 64);
  job(p.a2, p.L2w, 64, 1024);
  job(p.a2 + 65536, p.L2w + 65536, 64, 1024);
  job(p.w2, p.L2w + 2 * 65536, 64, 1024);
  job(p.w2 + 65536, p.L2w + 3 * 65536, 64, 1024);
  job(p.g2, p.g2T, 128, 1024);
  job(p.wo, p.woT, 1024, 1024);
  job(p.mlp_w1, p.w1T[0], 1024, 4096);
  job(p.mlp_w1 + (size_t)4096 * 1024, p.w1T[1], 1024, 4096);
  job(p.mlp_w2, p.w2T[0], 4096, 1024);
  job(p.mlp_w2 + (size_t)4096 * 1024, p.w2T[1], 4096, 1024);
  job(p.wqkv, p.wqkvT, 1024, 1536);
  job(p.awo, p.awoT, 1024, 1024);
  p.njobs = nj; p.total_tiles = tiles;

  static int grid_blocks = 0;
  if (!grid_blocks) {
    (void)hipFuncSetAttribute((const void*)mega_kernel, hipFuncAttributeMaxDynamicSharedMemorySize, LDS_BYTES);
    (void)hipFuncSetAttribute((const void*)phase_kernel, hipFuncAttributeMaxDynamicSharedMemorySize, LDS_BYTES);
    int dev = 0, cus = 0, per_cu = 0;
    (void)hipGetDevice(&dev);
    (void)hipDeviceGetAttribute(&cus, hipDeviceAttributeMultiprocessorCount, dev);
    if (hipOccupancyMaxActiveBlocksPerMultiprocessor(&per_cu, (const void*)mega_kernel, NTHREADS, LDS_BYTES) != hipSuccess || per_cu < 1) per_cu = 1;
    if (cus <= 0) cus = 256;
    grid_blocks = cus * per_cu;
    (void)hipGetLastError();
  }
#if SINGLE_LAUNCH
  void* args[] = {&p};
  hipError_t e = hipLaunchCooperativeKernel((const void*)mega_kernel, dim3(grid_blocks), dim3(NTHREADS), args, LDS_BYTES, stream);
  if (e != hipSuccess) fprintf(stderr, "cooperative launch failed: %s (grid %d)\n", hipGetErrorString(e), grid_blocks);
#else
  for (int ph = 0; ph < NPHASE; ++ph) hipLaunchKernelGGL(phase_kernel, dim3(grid_blocks), dim3(NTHREADS), LDS_BYTES, stream, p, ph);
#endif
}
```

```cpp
#include <hip/hip_runtime.h>
#include <hip/hip_cooperative_groups.h>
#include <cstdint>
#include <cstring>
#include <cstdio>
namespace cg = cooperative_groups;

#ifndef SINGLE_LAUNCH
#define SINGLE_LAUNCH 1
#endif

typedef unsigned short bf16_t;
typedef short bf16x8 __attribute__((ext_vector_type(8)));
typedef float f32x2 __attribute__((ext_vector_type(2)));
typedef float f32x4 __attribute__((ext_vector_type(4)));
typedef float f32x16 __attribute__((ext_vector_type(16)));
typedef __bf16 bf16x2_t __attribute__((ext_vector_type(2)));
#define DI __device__ __forceinline__

constexpr int D = 1024, NB = 8, SEQ = 4096, CTXL = 256;
constexpr int NL = NB * SEQ, NC = NB * CTXL, NT = NL + NC, DFF = 4096;
constexpr int NKEY = SEQ + CTXL;
constexpr int NTHREADS = 512;
constexpr int ROWB = 144;
constexpr int GEMM_STAGE = (256 + 128) * ROWB;
constexpr int LDS_BYTES = 131072 + 16;

struct TJob { const float* src; bf16_t* dst; int K, N, tstart, tiles_n; };

struct Params {
  const float *x, *c, *ctx, *c_ctx, *w_mod, *b_mod, *norm_mix, *norm_mlp, *mlp_w1, *mlp_w2;
  const float *mu, *wr, *wk, *wv, *wo, *w0, *w1, *w2, *a0, *a1, *a2, *g1, *g2, *k_k, *k_a, *r_k, *ln_w, *ln_b;
  const float *wqkv, *q_norm, *k_norm, *awo, *final_norm;
  float* out;
  bf16_t *Wcat, *L2w, *g2T, *woT, *w1T[2], *w2T[2], *wqkvT, *awoT;
  float *MOD, *TAB, *XC;
  bf16_t* S[6];
  bf16_t *Hd, *L1;
  float* BON;
  float* NRM;
  unsigned* BAR;
  TJob jobs[20];
  int njobs, total_tiles;
};

DI unsigned pack2(float lo, float hi) {
  f32x2 v = {lo, hi};
  bf16x2_t b = __builtin_convertvector(v, bf16x2_t);
  return __builtin_bit_cast(unsigned, b);
}
DI float bflo(unsigned u) { return __uint_as_float(u << 16); }
DI float bfhi(unsigned u) { return __uint_as_float(u & 0xffff0000u); }
DI void store_bf4(bf16_t* p, float a, float b, float c, float d) { *(uint2*)p = make_uint2(pack2(a, b), pack2(c, d)); }
DI void load_bf4(const bf16_t* p, float& a, float& b, float& c, float& d) { uint2 u = *(const uint2*)p; a = bflo(u.x); b = bfhi(u.x); c = bflo(u.y); d = bfhi(u.y); }
DI void store_bf8(bf16_t* p, const f32x4& a, const f32x4& b) {
  uint4 o; o.x = pack2(a[0], a[1]); o.y = pack2(a[2], a[3]); o.z = pack2(b[0], b[1]); o.w = pack2(b[2], b[3]);
  *(uint4*)p = o;
}
DI void store16_sc1(void* p, const uint4& v) {
  typedef unsigned u32x4_t __attribute__((ext_vector_type(4)));
  const u32x4_t d = {v.x, v.y, v.z, v.w};
  asm volatile("global_store_dwordx4 %0, %1, off sc1" :: "v"(p), "v"(d) : "memory");
}
DI void unpack_bf8(const uint4& u, float (&o)[8]) {
  o[0] = bflo(u.x); o[1] = bfhi(u.x); o[2] = bflo(u.y); o[3] = bfhi(u.y); o[4] = bflo(u.z); o[5] = bfhi(u.z); o[6] = bflo(u.w); o[7] = bfhi(u.w);
}
DI int perm32(int rho) { return 8 * ((rho & 15) >> 2) + 4 * (rho >> 4) + (rho & 3); }
DI float sigmoidf_(float x) { return 1.f / (1.f + __expf(-x)); }
DI float tanhf_(float x) { return 1.f - 2.f / (1.f + __expf(2.f * x)); }
DI float quad_sum(float x) {
  x += __builtin_bit_cast(float, __builtin_amdgcn_mov_dpp(__builtin_bit_cast(int, x), 0xB1, 0xF, 0xF, true));
  x += __builtin_bit_cast(float, __builtin_amdgcn_mov_dpp(__builtin_bit_cast(int, x), 0x4E, 0xF, 0xF, true));
  return x;
}
DI float oct_sum(float x) {
  x = quad_sum(x);
  x += __builtin_bit_cast(float, __builtin_amdgcn_mov_dpp(__builtin_bit_cast(int, x), 0x141, 0xF, 0xF, true));
  return x;
}
struct StepV { f32x2 r[4], w[4], k[4], kk[4], b[4]; f32x2 v; };
DI void scan_load(StepV& s, const float* base, const float* vp) {
#pragma unroll
  for (int i = 0; i < 2; ++i) {
    const float4 t0 = *(const float4*)(base + i * 4);       s.r[2 * i] = f32x2{t0.x, t0.y};  s.r[2 * i + 1] = f32x2{t0.z, t0.w};
    const float4 t1 = *(const float4*)(base + 64 + i * 4);  s.w[2 * i] = f32x2{t1.x, t1.y};  s.w[2 * i + 1] = f32x2{t1.z, t1.w};
    const float4 t2 = *(const float4*)(base + 128 + i * 4); s.k[2 * i] = f32x2{t2.x, t2.y};  s.k[2 * i + 1] = f32x2{t2.z, t2.w};
    const float4 t3 = *(const float4*)(base + 192 + i * 4); s.kk[2 * i] = f32x2{t3.x, t3.y}; s.kk[2 * i + 1] = f32x2{t3.z, t3.w};
    const float4 t4 = *(const float4*)(base + 256 + i * 4); s.b[2 * i] = f32x2{t4.x, t4.y};  s.b[2 * i + 1] = f32x2{t4.z, t4.w};
  }
  const float2 vv = *(const float2*)vp;
  s.v = f32x2{vv.x, vv.y};
}
DI void scan_step(const StepV& s, f32x2 (&S0)[4], f32x2 (&S1)[4], float* yp, bool writer) {
  f32x2 d0 = S0[0] * s.kk[0], d1 = S1[0] * s.kk[0];
#pragma unroll
  for (int i = 1; i < 4; ++i) { d0 += S0[i] * s.kk[i]; d1 += S1[i] * s.kk[i]; }
  const float sa0 = -oct_sum(d0.x + d0.y), sa1 = -oct_sum(d1.x + d1.y);
  const f32x2 sa0v = {sa0, sa0}, sa1v = {sa1, sa1}, v0 = {s.v.x, s.v.x}, v1 = {s.v.y, s.v.y};
#pragma unroll
  for (int i = 0; i < 4; ++i) {
    S0[i] = S0[i] * s.w[i] + (sa0v * s.b[i] + v0 * s.k[i]);
    S1[i] = S1[i] * s.w[i] + (sa1v * s.b[i] + v1 * s.k[i]);
  }
  f32x2 y0 = S0[0] * s.r[0], y1 = S1[0] * s.r[0];
#pragma unroll
  for (int i = 1; i < 4; ++i) { y0 += S0[i] * s.r[i]; y1 += S1[i] * s.r[i]; }
  const float ya = oct_sum(y0.x + y0.y), yb = oct_sum(y1.x + y1.y);
  if (writer) *(float2*)yp = make_float2(ya, yb);
}
DI float wave_sum(float x) {
#pragma unroll
  for (int m = 1; m < 64; m <<= 1) x += __shfl_xor(x, m);
  return x;
}
#define MFMA16(a, b, c) __builtin_amdgcn_mfma_f32_16x16x32_bf16((a), (b), (c), 0, 0, 0)
#define MFMA32(a, b, c) __builtin_amdgcn_mfma_f32_32x32x16_bf16((a), (b), (c), 0, 0, 0)

DI unsigned lerp2(unsigned a, unsigned n, float ma, float mb) {
  const float h0 = bflo(a), h1 = bfhi(a), s0 = bflo(n), s1 = bfhi(n);
  return pack2(h0 + (s0 - h0) * ma, h1 + (s1 - h1) * mb);
}
template <bool LERP>
DI void gemm_tile(const bf16_t* __restrict__ X, int ldx, const bf16_t* __restrict__ W, int ldw, int K, int tok0, int f0,
                  char* lds, f32x4 (&acc)[4][4], const float* __restrict__ mu) {
  const int tid = threadIdx.x, lane = tid & 63, wave = tid >> 6;
  const int wt = wave & 3, wf = wave >> 2, lr = lane & 15, lq = lane >> 4;
  const int lrow = tid >> 3, kc = tid & 7;
#pragma unroll
  for (int i = 0; i < 4; ++i)
#pragma unroll
    for (int j = 0; j < 4; ++j) acc[i][j] = f32x4{0.f, 0.f, 0.f, 0.f};
  uint4 xr[4], wr[2], xn[4];
  float4 m0 = make_float4(0, 0, 0, 0), m1 = m0;
  const int nk = K >> 6;
  __syncthreads();
  for (int kt = -1; kt < nk; ++kt) {
    const bool more = kt + 1 < nk;
    if (more) {
      const int k0 = (kt + 1) << 6;
#pragma unroll
      for (int i = 0; i < 4; ++i) {
        const int tg = tok0 + lrow + 64 * i;
        xr[i] = *(const uint4*)(X + (size_t)tg * ldx + k0 + kc * 8);
        if (LERP) {
          int nb; bool valid;
          if (tok0 < NL) {
            const int s = tg & 4095, col = s & 63, rw = s >> 6, qd = k0 >> 8;
            if (qd == 0) { valid = col > 0; nb = tg - 1; }
            else if (qd == 1) { valid = col < 63; nb = tg + 1; }
            else if (qd == 2) { valid = rw > 0; nb = tg - 64; }
            else { valid = rw < 63; nb = tg + 64; }
          } else {
            const int s = (tg - NL) & 255;
            if (k0 < 512) { valid = s > 0; nb = tg - 1; }
            else { valid = s < 255; nb = tg + 1; }
          }
          if (valid) xn[i] = *(const uint4*)(X + (size_t)nb * ldx + k0 + kc * 8);
          else xn[i] = make_uint4(0, 0, 0, 0);
        }
      }
#pragma unroll
      for (int i = 0; i < 2; ++i) wr[i] = *(const uint4*)(W + (size_t)(f0 + 64 * i + (lrow & 32) + perm32(lrow & 31)) * ldw + k0 + kc * 8);
      if (LERP) { m0 = *(const float4*)(mu + k0 + kc * 8); m1 = *(const float4*)(mu + k0 + kc * 8 + 4); }
    }
    if (kt >= 0) {
      const char* xs = lds + (kt & 1) * GEMM_STAGE;
      const char* wsm = xs + 256 * ROWB;
#pragma unroll
      for (int ks = 0; ks < 2; ++ks) {
        bf16x8 wfr[4], xfr[4];
#pragma unroll
        for (int i = 0; i < 4; ++i) wfr[i] = *(const bf16x8*)(wsm + (wf * 64 + i * 16 + lr) * ROWB + ks * 64 + lq * 16);
#pragma unroll
        for (int i = 0; i < 4; ++i) xfr[i] = *(const bf16x8*)(xs + (wt * 64 + i * 16 + lr) * ROWB + ks * 64 + lq * 16);
#pragma unroll
        for (int fi = 0; fi < 4; ++fi)
#pragma unroll
          for (int ti = 0; ti < 4; ++ti) acc[fi][ti] = MFMA16(wfr[fi], xfr[ti], acc[fi][ti]);
      }
    }
    if (more) {
      char* xs = lds + ((kt + 1) & 1) * GEMM_STAGE;
      char* wsm = xs + 256 * ROWB;
#pragma unroll
      for (int i = 0; i < 4; ++i) {
        uint4 v = xr[i];
        if (LERP) {
          v.x = lerp2(xr[i].x, xn[i].x, m0.x, m0.y);
          v.y = lerp2(xr[i].y, xn[i].y, m0.z, m0.w);
          v.z = lerp2(xr[i].z, xn[i].z, m1.x, m1.y);
          v.w = lerp2(xr[i].w, xn[i].w, m1.z, m1.w);
        }
        *(uint4*)(xs + (lrow + 64 * i) * ROWB + kc * 16) = v;
      }
#pragma unroll
      for (int i = 0; i < 2; ++i) *(uint4*)(wsm + (lrow + 64 * i) * ROWB + kc * 16) = wr[i];
    }
    __syncthreads();
  }
}


namespace g256 {
constexpr int BK = 64, HALF = 128, HT = HALF * BK;
DI int lds_byte(int r, int c) { const int st = (r >> 4) * 2 + (c >> 5), rr = r & 15, cc = c & 31, ob = rr * 64 + cc * 2; return st * 1024 + (ob ^ (((ob >> 9) & 1) << 5)); }
DI void stage_rc(int b, int& R, int& C) { const int st = b / 1024, sb = b % 1024, swz = sb ^ (((sb >> 9) & 1) << 5); R = (st >> 1) * 16 + swz / 64; C = (st & 1) * 32 + (swz % 64) / 2; }
}
#define G_SA(b, h) (((b) * 2 + (h)) * 16384)
#define G_SB(b, h) ((4 + (b) * 2 + (h)) * 16384)
#define G_STAGEV(bufoff, gbase, vo) do { _Pragma("unroll") for (int _i = 0; _i < 2; ++_i) \
    __builtin_amdgcn_global_load_lds((const unsigned*)((const char*)(gbase) + (vo)[_i]), (__attribute__((address_space(3))) unsigned*)(lds + (bufoff) + ldsw + _i * 8192), 16, 0, 0); } while (0)
#define G_LDA(dst, b, h) do { _Pragma("unroll") for (int m = 0; m < 4; ++m) _Pragma("unroll") for (int k = 0; k < 2; ++k) \
    dst[m][k] = *(const __attribute__((address_space(3))) bf16x8*)(lds + G_SA(b, h) + aoff + m * 2048 + k * 1024); } while (0)
#define G_LDB(dst, b, h) do { _Pragma("unroll") for (int n = 0; n < 2; ++n) _Pragma("unroll") for (int k = 0; k < 2; ++k) \
    dst[n][k] = *(const __attribute__((address_space(3))) bf16x8*)(lds + G_SB(b, h) + boff + n * 2048 + k * 1024); } while (0)
#define G_MMA(ai, bj, At, Bt) do { __builtin_amdgcn_s_setprio(1); \
    _Pragma("unroll") for (int m = 0; m < 4; ++m) _Pragma("unroll") for (int n = 0; n < 2; ++n) _Pragma("unroll") for (int k = 0; k < 2; ++k) \
      acc[ai][bj][m][n] = __builtin_amdgcn_mfma_f32_16x16x32_bf16(At[m][k], Bt[n][k], acc[ai][bj][m][n], 0, 0, 0); \
    __builtin_amdgcn_s_setprio(0); } while (0)
#define G_WAIT_V(n) asm volatile("s_waitcnt vmcnt(" #n ")" ::: "memory")
#define G_WAIT_L(n) asm volatile("s_waitcnt lgkmcnt(" #n ")" ::: "memory")
#define G_BAR __builtin_amdgcn_s_barrier()
#define G_SCHED __builtin_amdgcn_sched_barrier(0)

template <bool PERM>
DI void gemm256_tile(const bf16_t* __restrict__ A, const bf16_t* __restrict__ Bt, int K, int brow, int bcol, char* lds_, f32x4 (&acc)[2][2][4][2]) {
  __attribute__((address_space(3))) unsigned char* lds = (__attribute__((address_space(3))) unsigned char*)lds_;
  int tid = threadIdx.x; asm volatile("" : "+v"(tid));
  const int wid = __builtin_amdgcn_readfirstlane(tid >> 6), lane = tid & 63, wr = wid >> 2, wc = wid & 3, fr = lane & 15, fq = lane >> 4;
#pragma unroll
  for (int a = 0; a < 2; ++a)
#pragma unroll
    for (int b = 0; b < 2; ++b)
#pragma unroll
      for (int m = 0; m < 4; ++m)
#pragma unroll
        for (int n = 0; n < 2; ++n) acc[a][b][m][n] = f32x4{0.f, 0.f, 0.f, 0.f};
  unsigned voff[2], voffA[2];
#pragma unroll
  for (int i = 0; i < 2; ++i) { int R, C; g256::stage_rc(tid * 16 + i * 8192, R, C); voff[i] = (unsigned)(R * K + C) * 2u;
    const int Ra = PERM ? ((R & ~31) + perm32(R & 31)) : R; voffA[i] = (unsigned)(Ra * K + C) * 2u; }
  const size_t kstep = 128, hstep = (size_t)128 * K * 2;
  const unsigned ldsw = (unsigned)wid * 1024u;
  const int aoff = g256::lds_byte(wr * 64 + fr, fq * 8), boff = g256::lds_byte(wc * 32 + fr, fq * 8);
  const char* cA = (const char*)A + (size_t)brow * K * 2;
  const char* cB = (const char*)Bt + (size_t)bcol * K * 2;
  bf16x8 At[4][2], B0[2][2], B1[2][2];
  const int nt = K / g256::BK;
  __syncthreads();
  G_STAGEV(G_SB(0, 0), cB, voff); G_STAGEV(G_SA(0, 0), cA, voffA); G_STAGEV(G_SB(0, 1), cB + hstep, voff); G_STAGEV(G_SA(0, 1), cA + hstep, voffA);
  if (wr == 1) G_BAR;
  G_WAIT_V(4); G_BAR;
  G_STAGEV(G_SB(1, 0), cB + kstep, voff); G_STAGEV(G_SA(1, 0), cA + kstep, voffA); G_STAGEV(G_SB(1, 1), cB + hstep + kstep, voff);
  G_WAIT_V(6); G_BAR;
  for (int t = 0; t < nt - 2; t += 2) {
    const char* a1 = cA + (size_t)(t + 1) * kstep;
    const char* a2 = cA + (size_t)(t + 2) * kstep; const char* b2 = cB + (size_t)(t + 2) * kstep;
    const char* a3 = a2 + kstep; const char* b3 = b2 + kstep;
    G_LDB(B0, 0, 0); G_SCHED; G_LDA(At, 0, 0); G_STAGEV(G_SA(1, 1), a1 + hstep, voffA);
    G_WAIT_L(8); G_BAR; G_WAIT_L(0); G_MMA(0, 0, At, B0); G_BAR; G_SCHED;
    G_LDB(B1, 0, 1); G_STAGEV(G_SB(0, 0), b2, voff);
    G_BAR; G_WAIT_L(0); G_MMA(0, 1, At, B1); G_BAR;
    G_LDA(At, 0, 1); G_STAGEV(G_SA(0, 0), a2, voffA);
    G_BAR; G_WAIT_L(0); G_MMA(1, 0, At, B0); G_BAR; G_SCHED;
    G_STAGEV(G_SB(0, 1), b2 + hstep, voff);
    G_WAIT_V(6); G_BAR; G_MMA(1, 1, At, B1); G_BAR;
    G_LDB(B0, 1, 0); G_SCHED; G_LDA(At, 1, 0); G_STAGEV(G_SA(0, 1), a2 + hstep, voffA);
    G_WAIT_L(8); G_BAR; G_WAIT_L(0); G_MMA(0, 0, At, B0); G_BAR; G_SCHED;
    G_LDB(B1, 1, 1); G_STAGEV(G_SB(1, 0), b3, voff);
    G_BAR; G_WAIT_L(0); G_MMA(0, 1, At, B1); G_BAR;
    G_LDA(At, 1, 1); G_STAGEV(G_SA(1, 0), a3, voffA);
    G_BAR; G_WAIT_L(0); G_MMA(1, 0, At, B0); G_BAR; G_SCHED;
    G_STAGEV(G_SB(1, 1), b3 + hstep, voff);
    G_WAIT_V(6); G_BAR; G_MMA(1, 1, At, B1); G_BAR;
  }
  { G_LDB(B0, 0, 0); G_LDA(At, 0, 0); G_STAGEV(G_SA(1, 1), cA + (size_t)(nt - 1) * kstep + hstep, voffA);
    G_BAR; G_WAIT_L(0); G_MMA(0, 0, At, B0); G_BAR;
    G_LDB(B1, 0, 1); G_BAR; G_WAIT_L(0); G_MMA(0, 1, At, B1); G_BAR;
    G_LDA(At, 0, 1); G_WAIT_V(4); G_BAR; G_WAIT_L(0); G_MMA(1, 0, At, B0); G_MMA(1, 1, At, B1); G_BAR; }
  { G_LDB(B0, 1, 0); G_LDA(At, 1, 0); G_WAIT_V(2); G_BAR; G_WAIT_L(0); G_MMA(0, 0, At, B0); G_BAR;
    G_LDB(B1, 1, 1); G_WAIT_V(0); G_BAR; G_WAIT_L(0); G_MMA(0, 1, At, B1); G_BAR;
    G_LDA(At, 1, 1); G_BAR; G_WAIT_L(0); G_MMA(1, 0, At, B0); G_MMA(1, 1, At, B1); G_BAR; }
  if (wr == 0) G_BAR;
}

DI void convert_tile(const TJob& jb, int t, char* lds) {
  float* tile = (float*)lds;
  const int tid = threadIdx.x;
  const int tk = t / jb.tiles_n, tn = t % jb.tiles_n;
  const int k0 = tk * 64, n0 = tn * 64;
  __syncthreads();
#pragma unroll
  for (int i = 0; i < 2; ++i) {
    const int idx = tid + 512 * i, row = idx >> 4, c4 = idx & 15;
    const float4 v = *(const float4*)(jb.src + (size_t)(k0 + row) * jb.N + n0 + c4 * 4);
    tile[row * 65 + c4 * 4 + 0] = v.x; tile[row * 65 + c4 * 4 + 1] = v.y; tile[row * 65 + c4 * 4 + 2] = v.z; tile[row * 65 + c4 * 4 + 3] = v.w;
  }
  __syncthreads();
  const int n = tid >> 3, kc = tid & 7;
  float v[8];
#pragma unroll
  for (int j = 0; j < 8; ++j) v[j] = tile[(kc * 8 + j) * 65 + n];
  uint4 o;
  o.x = pack2(v[0], v[1]); o.y = pack2(v[2], v[3]); o.z = pack2(v[4], v[5]); o.w = pack2(v[6], v[7]);
  *(uint4*)(jb.dst + (size_t)(n0 + n) * jb.K + k0 + kc * 8) = o;
}

DI void mod_unit(const Params& p, int mu_, char* lds) {
  const int tid = threadIdx.x;
  const int layer = mu_ / 96, cc = mu_ % 96;
  float* sc = (float*)lds;
  float* red = sc + 9 * 1024;
  __syncthreads();
  for (int i = tid; i < 9 * 1024; i += 512) {
    const int row = i >> 10, k = i & 1023;
    const float v = row < 8 ? p.c[row * 1024 + k] : p.c_ctx[k];
    sc[i] = v / (1.f + __expf(-v));
  }
  __syncthreads();
  const int kg = tid >> 6, col = tid & 63;
  const float* w = p.w_mod + (size_t)layer * 1024 * 6144 + cc * 64 + col;
  float a[9];
#pragma unroll
  for (int r = 0; r < 9; ++r) a[r] = 0.f;
#pragma unroll 4
  for (int k = kg * 128; k < kg * 128 + 128; ++k) {
    const float wv = w[(size_t)k * 6144];
#pragma unroll
    for (int r = 0; r < 9; ++r) a[r] += sc[r * 1024 + k] * wv;
  }
#pragma unroll
  for (int r = 0; r < 9; ++r) red[(kg * 9 + r) * 64 + col] = a[r];
  __syncthreads();
  for (int i = tid; i < 576; i += 512) {
    const int r = i >> 6, cl = i & 63;
    float s = 0.f;
#pragma unroll
    for (int g = 0; g < 8; ++g) s += red[(g * 9 + r) * 64 + cl];
    const int n = cc * 64 + cl;
    p.MOD[(layer * 9 + r) * 6144 + n] = s + p.b_mod[layer * 6144 + n];
  }
  __syncthreads();
}

DI void sincos_d(double a, double& s, double& c) {
  const double n = rint(a * 0.6366197723675814);
  const double r = (a - n * 1.5707963267948966) - n * 6.123233995736766e-17;
  const double r2 = r * r;
  const double sp = r * (1.0 + r2 * (-1.0 / 6.0 + r2 * (1.0 / 120.0 + r2 * (-1.0 / 5040.0 + r2 * (1.0 / 362880.0 + r2 * (-1.0 / 39916800.0 + r2 * (1.0 / 6227020800.0)))))));
  const double cp = 1.0 + r2 * (-0.5 + r2 * (1.0 / 24.0 + r2 * (-1.0 / 720.0 + r2 * (1.0 / 40320.0 + r2 * (-1.0 / 3628800.0 + r2 * (1.0 / 479001600.0 + r2 * (-1.0 / 87178291200.0)))))));
  const int q = ((int)n) & 3;
  if (q == 0) { s = sp; c = cp; }
  else if (q == 1) { s = cp; c = -sp; }
  else if (q == 2) { s = -sp; c = -cp; }
  else { s = -cp; c = sp; }
}

DI void tab_unit(const Params& p) {
  for (int idx = threadIdx.x; idx < 1024; idx += 512) {
    const int pos = idx >> 4, fi = idx & 15;
    double f = 1.0;
    for (int i = 0; i < fi; ++i) f *= 0.5623413251903491;
    double s, c;
    sincos_d((double)pos * (double)(float)f, s, c);
    p.TAB[idx * 2 + 0] = (float)c;
    p.TAB[idx * 2 + 1] = (float)s;
  }
}

__device__ void phase0(const Params& p, char* lds) {
  const int total = p.total_tiles + 192 + 1;
  for (int u = blockIdx.x; u < total; u += gridDim.x) {
    if (u < p.total_tiles) {
      int j = 0;
#pragma unroll 1
      for (int q = 1; q < p.njobs; ++q) if (u >= p.jobs[q].tstart) j = q;
      convert_tile(p.jobs[j], u - p.jobs[j].tstart, lds);
    } else if (u < p.total_tiles + 192) {
      mod_unit(p, u - p.total_tiles, lds);
    } else {
      tab_unit(p);
    }
  }
}

DI void norm_mod_phase(const float* __restrict__ xl, const float* __restrict__ xc, const float* __restrict__ gain,
                               const float* __restrict__ mod, int shift_i, int scale_i, bf16_t* __restrict__ H, int ntok) {
  const int lane = threadIdx.x & 63;
  const int wg = blockIdx.x * 8 + (threadIdx.x >> 6), nw = gridDim.x * 8;
  for (int t = wg; t < ntok; t += nw) {
    const float* row = t < NL ? xl + (size_t)t * 1024 : xc + (size_t)(t - NL) * 1024;
    float4 v[4];
    float ss = 0.f;
#pragma unroll
    for (int i = 0; i < 4; ++i) {
      v[i] = *(const float4*)(row + (lane + 64 * i) * 4);
      ss += v[i].x * v[i].x + v[i].y * v[i].y + v[i].z * v[i].z + v[i].w * v[i].w;
    }
    ss = wave_sum(ss);
    const float rstd = rsqrtf(ss * (1.f / 1024.f) + 1e-6f);
    const int bp = t < NL ? (t >> 12) : 8;
    const float* sh = mod + (bp * 6 + shift_i) * 1024;
    const float* sc = mod + (bp * 6 + scale_i) * 1024;
#pragma unroll
    for (int i = 0; i < 4; ++i) {
      const int c = (lane + 64 * i) * 4;
      const float4 g = *(const float4*)(gain + c), s4 = *(const float4*)(sh + c), c4 = *(const float4*)(sc + c);
      store_bf4(H + (size_t)t * 1024 + c,
                v[i].x * rstd * g.x * (1.f + c4.x) + s4.x, v[i].y * rstd * g.y * (1.f + c4.y) + s4.y,
                v[i].z * rstd * g.z * (1.f + c4.z) + s4.z, v[i].w * rstd * g.w * (1.f + c4.w) + s4.w);
    }
  }
}

__device__ void final_norm_phase(const Params& p) {
  const int lane = threadIdx.x & 63;
  const int wg = blockIdx.x * 8 + (threadIdx.x >> 6), nw = gridDim.x * 8;
  for (int t = wg; t < NL; t += nw) {
    float* row = p.out + (size_t)t * 1024;
    float4 v[4];
    float ss = 0.f;
#pragma unroll
    for (int i = 0; i < 4; ++i) {
      v[i] = *(const float4*)(row + (lane + 64 * i) * 4);
      ss += v[i].x * v[i].x + v[i].y * v[i].y + v[i].z * v[i].z + v[i].w * v[i].w;
    }
    ss = wave_sum(ss);
    const float rstd = rsqrtf(ss * (1.f / 1024.f) + 1e-6f);
#pragma unroll
    for (int i = 0; i < 4; ++i) {
      const int c = (lane + 64 * i) * 4;
      const float4 g = *(const float4*)(p.final_norm + c);
      *(float4*)(row + c) = make_float4(v[i].x * rstd * g.x, v[i].y * rstd * g.y, v[i].z * rstd * g.z, v[i].w * rstd * g.w);
    }
  }
}

__device__ void phase_mix(const Params& p) {
  const int lane = threadIdx.x & 63;
  const int wg = blockIdx.x * 8 + (threadIdx.x >> 6), nw = gridDim.x * 8;
  for (int t = wg; t < NT; t += nw) {
#pragma unroll
    for (int i = 0; i < 2; ++i) {
      const int c = lane * 8 + 512 * i;
      const uint4 own = *(const uint4*)(p.Hd + (size_t)t * 1024 + c);
      int nb; bool valid;
      if (t < NL) {
        const int s = t & 4095, col = s & 63, rw = s >> 6, qd = c >> 8;
        if (qd == 0) { valid = col > 0; nb = t - 1; }
        else if (qd == 1) { valid = col < 63; nb = t + 1; }
        else if (qd == 2) { valid = rw > 0; nb = t - 64; }
        else { valid = rw < 63; nb = t + 64; }
      } else {
        const int s = (t - NL) & 255;
        if (c < 512) { valid = s > 0; nb = t - 1; }
        else { valid = s < 255; nb = t + 1; }
      }
      uint4 nv = make_uint4(0, 0, 0, 0);
      if (valid) nv = *(const uint4*)(p.Hd + (size_t)nb * 1024 + c);
#pragma unroll
      for (int j = 0; j < 3; ++j) {
        const int mi = j == 0 ? 0 : j == 1 ? 2 : 3;
        const float4 m0 = *(const float4*)(p.mu + mi * 1024 + c), m1 = *(const float4*)(p.mu + mi * 1024 + c + 4);
        uint4 o;
        o.x = lerp2(own.x, nv.x, m0.x, m0.y); o.y = lerp2(own.y, nv.y, m0.z, m0.w);
        o.z = lerp2(own.z, nv.z, m1.x, m1.y); o.w = lerp2(own.w, nv.w, m1.z, m1.w);
        *(uint4*)(p.S[3 + j] + (size_t)t * 1024 + c) = o;
      }
    }
  }
}

__device__ void phase_proj(const Params& p, char* lds) {
  const int lane = threadIdx.x & 63, wave = threadIdx.x >> 6;
  constexpr int NLORA = (NT / 256) * 3, NRKV = (NT / 256) * 12;
  for (int u = blockIdx.x; u < NLORA; u += gridDim.x) {
    {
      const int wt = wave & 3, wf = wave >> 2, lr = lane & 15, lq = lane >> 4;
      const int mt = u / 3, nt = 24 + u % 3;
      const int mi = nt == 24 ? 5 : nt == 25 ? 1 : 4;
      f32x4 acc[4][4];
      gemm_tile<true>(p.Hd, 1024, p.Wcat, 1024, 1024, mt * 256, nt * 128, lds, acc, p.mu + mi * 1024);
#pragma unroll
      for (int pp = 0; pp < 2; ++pp)
#pragma unroll
        for (int ti = 0; ti < 4; ++ti) {
          const int t = mt * 256 + wt * 64 + ti * 16 + lr;
          const int fl = wf * 64 + pp * 32 + lq * 8;
          f32x4 a = acc[2 * pp][ti], b = acc[2 * pp + 1][ti];
          if (nt == 24) {
#pragma unroll
            for (int j = 0; j < 4; ++j) { a[j] = sigmoidf_(a[j]); b[j] = sigmoidf_(b[j]); }
            store_bf8(p.L1 + (size_t)t * 384 + fl, a, b);
          } else if (nt == 25) {
#pragma unroll
            for (int j = 0; j < 4; ++j) { a[j] = tanhf_(a[j]); b[j] = tanhf_(b[j]); }
            store_bf8(p.L1 + (size_t)t * 384 + 128 + fl, a, b);
          } else {
            store_bf8(p.L1 + (size_t)t * 384 + 256 + fl, a, b);
          }
        }
    }
  }
  for (int v0 = blockIdx.x; v0 < NRKV; v0 += gridDim.x) {
    {
      const int wr = wave >> 2, wc = wave & 3;
      f32x4 acc[2][2][4][2];
      { const int mt0 = v0 / 12, rem0 = v0 % 12, j0 = rem0 >> 2, nt0 = rem0 & 3;
        gemm256_tile<true>(p.Wcat + (size_t)j0 * 1024 * 1024, p.S[3 + j0], 1024, nt0 * 256, mt0 * 256, lds, acc); }
      int lane_o = threadIdx.x & 63; asm volatile("" : "+v"(lane_o));
      int v = v0; asm volatile("" : "+s"(v));
      const int mt = v / 12, rem = v % 12, j = rem >> 2, nt = rem & 3;
      const int fr = lane_o & 15, fq = lane_o >> 4;
#pragma unroll
      for (int bj = 0; bj < 2; ++bj)
#pragma unroll
        for (int n = 0; n < 2; ++n) {
          const int t = mt * 256 + bj * 128 + wc * 32 + n * 16 + fr;
#pragma unroll
          for (int ai = 0; ai < 2; ++ai) {
            const int fh = nt * 256 + ai * 128 + wr * 64;
            if (j == 1) {
              f32x4 a[2], b[2];
              float ss = 0.f;
#pragma unroll
              for (int mp = 0; mp < 2; ++mp) {
                const int f = fh + mp * 32 + fq * 8;
                const float4 kkl = *(const float4*)(p.k_k + f), kkh = *(const float4*)(p.k_k + f + 4);
                a[mp] = acc[ai][bj][2 * mp][n]; b[mp] = acc[ai][bj][2 * mp + 1][n];
                a[mp][0] *= kkl.x; a[mp][1] *= kkl.y; a[mp][2] *= kkl.z; a[mp][3] *= kkl.w;
                b[mp][0] *= kkh.x; b[mp][1] *= kkh.y; b[mp][2] *= kkh.z; b[mp][3] *= kkh.w;
#pragma unroll
                for (int e2 = 0; e2 < 4; ++e2) ss += a[mp][e2] * a[mp][e2] + b[mp][e2] * b[mp][e2];
              }
              ss += __shfl_xor(ss, 16); ss += __shfl_xor(ss, 32);
              const float kinv = rsqrtf(ss + 1e-12f);
#pragma unroll
              for (int mp = 0; mp < 2; ++mp) {
#pragma unroll
                for (int e2 = 0; e2 < 4; ++e2) { a[mp][e2] *= kinv; b[mp][e2] *= kinv; }
                store_bf8(p.S[2] + (size_t)t * 1024 + fh + mp * 32 + fq * 8, a[mp], b[mp]);
              }
              if (fq == 0) p.NRM[(size_t)(fh >> 6) * NT + t] = sqrtf(ss + 1e-12f);
            } else {
              bf16_t* dst = j == 0 ? p.S[0] : p.S[1];
#pragma unroll
              for (int mp = 0; mp < 2; ++mp)
                store_bf8(dst + (size_t)t * 1024 + fh + mp * 32 + fq * 8, acc[ai][bj][2 * mp][n], acc[ai][bj][2 * mp + 1][n]);
            }
          }
        }
    }
  }
}

__device__ void phase_prep(const Params& p, char* lds) {
  const int lane = threadIdx.x & 63, wave = threadIdx.x >> 6;
  const int wt = wave & 3, wf = wave >> 2, lr = lane & 15, lq = lane >> 4;
  const int total = (NT / 256) * 8;
  for (int u = blockIdx.x; u < total; u += gridDim.x) {
    const int mt = u >> 3, nt = u & 7;
    const int tok0 = mt * 256, f0 = nt * 128;
    f32x4 acc[4][4];
    uint4 afp[2][4];
    gemm_tile<false>(p.L1 + 256, 384, p.L2w + 0 * 65536, 64, 64, tok0, f0, lds, acc, nullptr);
#pragma unroll
    for (int pp = 0; pp < 2; ++pp) {
      const int f = f0 + wf * 64 + pp * 32 + lq * 8;
      const float4 a0l = *(const float4*)(p.a0 + f), a0h = *(const float4*)(p.a0 + f + 4);
#pragma unroll
      for (int ti = 0; ti < 4; ++ti) {
        const int t = tok0 + wt * 64 + ti * 16 + lr;
        f32x4 a = acc[2 * pp][ti], b = acc[2 * pp + 1][ti];
        a[0] = sigmoidf_(a[0] + a0l.x); a[1] = sigmoidf_(a[1] + a0l.y); a[2] = sigmoidf_(a[2] + a0l.z); a[3] = sigmoidf_(a[3] + a0l.w);
        b[0] = sigmoidf_(b[0] + a0h.x); b[1] = sigmoidf_(b[1] + a0h.y); b[2] = sigmoidf_(b[2] + a0h.z); b[3] = sigmoidf_(b[3] + a0h.w);
        uint4 o; o.x = pack2(a[0], a[1]); o.y = pack2(a[2], a[3]); o.z = pack2(b[0], b[1]); o.w = pack2(b[2], b[3]);
        afp[pp][ti] = o;
        *(uint4*)(p.S[3] + (size_t)t * 1024 + f) = o;
      }
    }
    gemm_tile<false>(p.L1 + 320, 384, p.L2w + 1 * 65536, 64, 64, tok0, f0, lds, acc, nullptr);
#pragma unroll
    for (int ti = 0; ti < 4; ++ti) {
      const int t = tok0 + wt * 64 + ti * 16 + lr;
      float bon = 0.f;
      const float nrm = p.NRM[(size_t)(nt * 2 + wf) * NT + t];
#pragma unroll
      for (int pp = 0; pp < 2; ++pp) {
        const int f = f0 + wf * 64 + pp * 32 + lq * 8;
        const float4 a0l = *(const float4*)(p.a0 + 1024 + f), a0h = *(const float4*)(p.a0 + 1024 + f + 4);
        const float4 rkl = *(const float4*)(p.r_k + f), rkh = *(const float4*)(p.r_k + f + 4);
        const float4 kal = *(const float4*)(p.k_a + f), kah = *(const float4*)(p.k_a + f + 4);
        const float4 kkl = *(const float4*)(p.k_k + f), kkh = *(const float4*)(p.k_k + f + 4);
        const float rk8[8] = {rkl.x, rkl.y, rkl.z, rkl.w, rkh.x, rkh.y, rkh.z, rkh.w};
        const float ka8[8] = {kal.x, kal.y, kal.z, kal.w, kah.x, kah.y, kah.z, kah.w};
        const float kk8[8] = {kkl.x, kkl.y, kkl.z, kkl.w, kkh.x, kkh.y, kkh.z, kkh.w};
        f32x4 a = acc[2 * pp][ti], b = acc[2 * pp + 1][ti];
        a[0] = sigmoidf_(a[0] + a0l.x); a[1] = sigmoidf_(a[1] + a0l.y); a[2] = sigmoidf_(a[2] + a0l.z); a[3] = sigmoidf_(a[3] + a0l.w);
        b[0] = sigmoidf_(b[0] + a0h.x); b[1] = sigmoidf_(b[1] + a0h.y); b[2] = sigmoidf_(b[2] + a0h.z); b[3] = sigmoidf_(b[3] + a0h.w);
        store_bf8(p.S[4] + (size_t)t * 1024 + f, a, b);
        const float ab8[8] = {a[0], a[1], a[2], a[3], b[0], b[1], b[2], b[3]};
        float af8[8], r8[8], k8[8];
        unpack_bf8(afp[pp][ti], af8);
        unpack_bf8(*(const uint4*)(p.S[0] + (size_t)t * 1024 + f), r8);
        unpack_bf8(*(const uint4*)(p.S[2] + (size_t)t * 1024 + f), k8);
#pragma unroll
        for (int e2 = 0; e2 < 8; ++e2) {
          const float k = k8[e2] * nrm / kk8[e2];
          bon += r8[e2] * k * rk8[e2] * (2.f + (ab8[e2] + af8[e2] - 2.f) * ka8[e2]);
        }
      }
      bon += __shfl_xor(bon, 16); bon += __shfl_xor(bon, 32);
      if (lq == 0) p.BON[(size_t)(nt * 2 + wf) * NT + t] = bon;
    }
#pragma unroll 1
    for (int dr = 0; dr < 2; ++dr) {
      gemm_tile<false>(p.L1 + 128 + dr * 64, 384, p.L2w + (2 + dr) * 65536, 64, 64, tok0, f0, lds, acc, nullptr);
      bf16_t* dst = dr ? p.S[5] : p.Hd;
#pragma unroll
      for (int pp = 0; pp < 2; ++pp) {
        const int f = f0 + wf * 64 + pp * 32 + lq * 8;
        const float4 w0l = *(const float4*)(p.w0 + dr * 1024 + f), w0h = *(const float4*)(p.w0 + dr * 1024 + f + 4);
#pragma unroll
        for (int ti = 0; ti < 4; ++ti) {
          const int t = tok0 + wt * 64 + ti * 16 + lr;
          f32x4 a = acc[2 * pp][ti], b = acc[2 * pp + 1][ti];
          a[0] = -0.60653066f * sigmoidf_(a[0] + w0l.x); a[1] = -0.60653066f * sigmoidf_(a[1] + w0l.y);
          a[2] = -0.60653066f * sigmoidf_(a[2] + w0l.z); a[3] = -0.60653066f * sigmoidf_(a[3] + w0l.w);
          b[0] = -0.60653066f * sigmoidf_(b[0] + w0h.x); b[1] = -0.60653066f * sigmoidf_(b[1] + w0h.y);
          b[2] = -0.60653066f * sigmoidf_(b[2] + w0h.z); b[3] = -0.60653066f * sigmoidf_(b[3] + w0h.w);
          store_bf8(dst + (size_t)t * 1024 + f, a, b);
        }
      }
    }
  }
}

__device__ void phase_scan(const Params& p, char* lds, bool dupout = false) {
  float* buf = (float*)lds;
  float* ybuf = (float*)(lds + 2 * 49152);
  const int tid = threadIdx.x;
  const bool loader = tid >= 256;
  const int lt = tid & 255, ltk = lt >> 3, lch = (lt & 7) * 8;
  const int rp = lt >> 3, l8 = lt & 7;
  constexpr int NCH = NKEY / 32;
  for (int unit = blockIdx.x; unit < 256; unit += gridDim.x) {
    const int dir = unit & 1, h = (unit >> 1) & 15, b = unit >> 5;
    const bf16_t* Rp = p.S[0]; const bf16_t* Vp = p.S[1]; const bf16_t* Kp = p.S[2];
    bf16_t* Ap = dir ? p.S[4] : p.S[3];
    const bf16_t* Lp = dir ? p.S[5] : p.Hd;
    auto tok_of = [&](int i) -> int {
      if (i < 256) return NL + b * 256 + (dir ? 255 - i : i);
      const int s = i - 256;
      return b * 4096 + (dir ? 4095 - s : s);
    };
    uint4 raw[5];
    float nrmv = 0.f;
    float kkc[8], kac[8];
    f32x2 S0[4], S1[4];
#pragma unroll
    for (int i = 0; i < 4; ++i) { S0[i] = f32x2{0.f, 0.f}; S1[i] = f32x2{0.f, 0.f}; }
    if (loader) {
#pragma unroll
      for (int j = 0; j < 8; ++j) { kkc[j] = p.k_k[h * 64 + lch + j]; kac[j] = p.k_a[h * 64 + lch + j]; }
    }
    auto issue = [&](int c) {
      const int t = tok_of(c * 32 + ltk);
      const size_t off = (size_t)t * 1024 + h * 64 + lch;
      raw[0] = *(const uint4*)(Rp + off); raw[1] = *(const uint4*)(Vp + off); raw[2] = *(const uint4*)(Kp + off);
      raw[3] = *(const uint4*)(Ap + off); raw[4] = *(const uint4*)(Lp + off);
      nrmv = p.NRM[(size_t)h * NT + t];
    };
    auto unpack8 = [&](const uint4& u, float (&o)[8]) {
      o[0] = bflo(u.x); o[1] = bfhi(u.x); o[2] = bflo(u.y); o[3] = bfhi(u.y); o[4] = bflo(u.z); o[5] = bfhi(u.z); o[6] = bflo(u.w); o[7] = bfhi(u.w);
    };
    auto process = [&](int stage) {
      float r8[8], v8[8], k8[8], a8[8], l8[8], kk8[8], kd8[8], b8[8], w8[8];
      unpack8(raw[0], r8); unpack8(raw[1], v8); unpack8(raw[2], k8); unpack8(raw[3], a8); unpack8(raw[4], l8);
#pragma unroll
      for (int j = 0; j < 8; ++j) {
        kk8[j] = k8[j];
        const float k = k8[j] * nrmv / kkc[j];
        kd8[j] = k * (1.f + (a8[j] - 1.f) * kac[j]);
        b8[j] = kk8[j] * a8[j];
        w8[j] = __expf(l8[j]);
      }
      float* dst = buf + stage * 12288 + ltk * 384 + lch;
      *(float4*)(dst + 0) = make_float4(r8[0], r8[1], r8[2], r8[3]);       *(float4*)(dst + 4) = make_float4(r8[4], r8[5], r8[6], r8[7]);
      *(float4*)(dst + 64) = make_float4(w8[0], w8[1], w8[2], w8[3]);      *(float4*)(dst + 68) = make_float4(w8[4], w8[5], w8[6], w8[7]);
      *(float4*)(dst + 128) = make_float4(kd8[0], kd8[1], kd8[2], kd8[3]); *(float4*)(dst + 132) = make_float4(kd8[4], kd8[5], kd8[6], kd8[7]);
      *(float4*)(dst + 192) = make_float4(kk8[0], kk8[1], kk8[2], kk8[3]); *(float4*)(dst + 196) = make_float4(kk8[4], kk8[5], kk8[6], kk8[7]);
      *(float4*)(dst + 256) = make_float4(b8[0], b8[1], b8[2], b8[3]);     *(float4*)(dst + 260) = make_float4(b8[4], b8[5], b8[6], b8[7]);
      *(float4*)(dst + 320) = make_float4(v8[0], v8[1], v8[2], v8[3]);     *(float4*)(dst + 324) = make_float4(v8[4], v8[5], v8[6], v8[7]);
    };
    auto yout = [&](int c) {
      const float* yb = ybuf + (c & 1) * 2048 + ltk * 64 + lch;
      const float4 y0 = *(const float4*)yb, y1 = *(const float4*)(yb + 4);
      const int t = tok_of(c * 32 + ltk);
      uint4 o;
      o.x = pack2(y0.x, y0.y); o.y = pack2(y0.z, y0.w); o.z = pack2(y1.x, y1.y); o.w = pack2(y1.z, y1.w);
      *(uint4*)((dupout ? p.S[0] : Ap) + (size_t)t * 1024 + h * 64 + lch) = o;
    };
    __syncthreads();
    if (loader) { issue(0); process(0); issue(1); }
    __syncthreads();
    for (int c = 0; c < NCH; ++c) {
      if (loader) {
        if (c >= 1) yout(c - 1);
        if (c + 1 < NCH) { process((c + 1) & 1); if (c + 2 < NCH) issue(c + 2); }
      } else {
        const float* bb = buf + (c & 1) * 12288 + l8 * 8;
        const float* vb = buf + (c & 1) * 12288 + 320 + 2 * rp;
        float* yb = ybuf + (c & 1) * 2048 + 2 * rp;
        StepV A, B;
        scan_load(A, bb, vb);
#pragma unroll 1
        for (int j = 0; j < 32; j += 2) {
          scan_load(B, bb + (j + 1) * 384, vb + (j + 1) * 384);
          scan_step(A, S0, S1, yb + j * 64, l8 == 0);
          if (j + 2 < 32) scan_load(A, bb + (j + 2) * 384, vb + (j + 2) * 384);
          scan_step(B, S0, S1, yb + (j + 1) * 64, l8 == 0);
        }
      }
      __syncthreads();
    }
    if (loader) yout(NCH - 1);
    __syncthreads();
  }
}

__device__ void phase_readout(const Params& p, char* lds) {
  const int lane = threadIdx.x & 63, wave = threadIdx.x >> 6;
  const int wt = wave & 3, wf = wave >> 2, lr = lane & 15, lq = lane >> 4;
  const int total = (NT / 256) * 8;
  for (int u = blockIdx.x; u < total; u += gridDim.x) {
    const int mt = u >> 3, nt = u & 7;
    const int tok0 = mt * 256, f0 = nt * 128;
    f32x4 g[4][4];
    gemm_tile<false>(p.L1, 384, p.g2T, 128, 128, tok0, f0, lds, g, nullptr);
    const int head = nt * 2 + wf;
#pragma unroll
    for (int ti = 0; ti < 4; ++ti) {
      const int t = tok0 + wt * 64 + ti * 16 + lr;
      float y[2][8];
      float sum = 0.f;
#pragma unroll
      for (int pp = 0; pp < 2; ++pp) {
        const int f = f0 + wf * 64 + pp * 32 + lq * 8;
        float ya[8], yb[8];
        unpack_bf8(*(const uint4*)(p.S[3] + (size_t)t * 1024 + f), ya);
        unpack_bf8(*(const uint4*)(p.S[4] + (size_t)t * 1024 + f), yb);
#pragma unroll
        for (int e2 = 0; e2 < 8; ++e2) { y[pp][e2] = ya[e2] + yb[e2]; sum += y[pp][e2]; }
      }
      sum += __shfl_xor(sum, 16); sum += __shfl_xor(sum, 32);
      const float mean = sum * (1.f / 64.f);
      float vs = 0.f;
#pragma unroll
      for (int pp = 0; pp < 2; ++pp)
#pragma unroll
        for (int e2 = 0; e2 < 8; ++e2) { const float d = y[pp][e2] - mean; vs += d * d; }
      vs += __shfl_xor(vs, 16); vs += __shfl_xor(vs, 32);
      const float rstd = rsqrtf(vs * (1.f / 64.f) + 64e-5f);
      const float bon = p.BON[(size_t)head * NT + t];
#pragma unroll
      for (int pp = 0; pp < 2; ++pp) {
        const int f = f0 + wf * 64 + pp * 32 + lq * 8;
        const float4 lwl = *(const float4*)(p.ln_w + f), lwh = *(const float4*)(p.ln_w + f + 4);
        const float4 lbl = *(const float4*)(p.ln_b + f), lbh = *(const float4*)(p.ln_b + f + 4);
        const float lw8[8] = {lwl.x, lwl.y, lwl.z, lwl.w, lwh.x, lwh.y, lwh.z, lwh.w};
        const float lb8[8] = {lbl.x, lbl.y, lbl.z, lbl.w, lbh.x, lbh.y, lbh.z, lbh.w};
        float v8[8];
        unpack_bf8(*(const uint4*)(p.S[1] + (size_t)t * 1024 + f), v8);
        f32x4 oa, ob;
#pragma unroll
        for (int j = 0; j < 4; ++j) {
          oa[j] = ((y[pp][j] - mean) * rstd * lw8[j] + lb8[j] + bon * v8[j]) * g[2 * pp][ti][j];
          ob[j] = ((y[pp][4 + j] - mean) * rstd * lw8[4 + j] + lb8[4 + j] + bon * v8[4 + j]) * g[2 * pp + 1][ti][j];
        }
        store_bf8(p.S[0] + (size_t)t * 1024 + f, oa, ob);
      }
    }
  }
}

DI void phase_gemm_resid(const Params& p, char* lds, const bf16_t* A, const bf16_t* W, int K, int ntm,
                                 const float* xin_l, const float* xin_c, const float* gate, float* dummy_out = nullptr) {
  const int lane = threadIdx.x & 63, wave = threadIdx.x >> 6;
  const int wr = wave >> 2, wc = wave & 3;
  const int total = ntm * 4;
  for (int u = blockIdx.x; u < total; u += gridDim.x) {
    const int mt = u >> 2, nt = u & 3;
    f32x4 acc[2][2][4][2];
    gemm256_tile<true>(W, A, K, nt * 256, mt * 256, lds, acc);
    int lane_o = threadIdx.x & 63; asm volatile("" : "+v"(lane_o));
    const int fr = lane_o & 15, fq = lane_o >> 4;
#pragma unroll
    for (int bj = 0; bj < 2; ++bj)
#pragma unroll
      for (int n = 0; n < 2; ++n) {
        const int t = mt * 256 + bj * 128 + wc * 32 + n * 16 + fr;
        const int bp = t < NL ? (t >> 12) : 8;
        const float* xi = t < NL ? xin_l + (size_t)t * 1024 : xin_c + (size_t)(t - NL) * 1024;
        float* xo = dummy_out ? dummy_out + (size_t)t * 1024 : (t < NL ? p.out + (size_t)t * 1024 : p.XC + (size_t)(t - NL) * 1024);
#pragma unroll
        for (int ai = 0; ai < 2; ++ai)
#pragma unroll
          for (int mp = 0; mp < 2; ++mp) {
            const int f = nt * 256 + ai * 128 + wr * 64 + mp * 32 + fq * 8;
            const float4 g0 = *(const float4*)(gate + bp * 6144 + f), g1 = *(const float4*)(gate + bp * 6144 + f + 4);
            const float4 x0 = *(const float4*)(xi + f), x1 = *(const float4*)(xi + f + 4);
            const f32x4 a = acc[ai][bj][2 * mp][n], b = acc[ai][bj][2 * mp + 1][n];
            *(float4*)(xo + f) = make_float4(x0.x + g0.x * a[0], x0.y + g0.y * a[1], x0.z + g0.z * a[2], x0.w + g0.w * a[3]);
            *(float4*)(xo + f + 4) = make_float4(x1.x + g1.x * b[0], x1.y + g1.y * b[1], x1.z + g1.z * b[2], x1.w + g1.w * b[3]);
          }
      }
  }
}

DI void phase_up(const Params& p, char* lds, const bf16_t* H, const bf16_t* W, bf16_t* U, int ntm) {
  const int lane = threadIdx.x & 63, wave = threadIdx.x >> 6;
  const int wr = wave >> 2, wc = wave & 3;
  const int total = ntm * 16;
  for (int u = blockIdx.x; u < total; u += gridDim.x) {
    const int mt = u >> 4, nt = u & 15;
    f32x4 acc[2][2][4][2];
    gemm256_tile<true>(W, H, 1024, nt * 256, mt * 256, lds, acc);
    int lane_o = threadIdx.x & 63; asm volatile("" : "+v"(lane_o));
    const int fr = lane_o & 15, fq = lane_o >> 4;
#pragma unroll
    for (int bj = 0; bj < 2; ++bj)
#pragma unroll
      for (int n = 0; n < 2; ++n) {
        const int t = mt * 256 + bj * 128 + wc * 32 + n * 16 + fr;
#pragma unroll
        for (int ai = 0; ai < 2; ++ai)
#pragma unroll
          for (int mp = 0; mp < 2; ++mp) {
            const int f = nt * 256 + ai * 128 + wr * 64 + mp * 32 + fq * 8;
            f32x4 a = acc[ai][bj][2 * mp][n], b = acc[ai][bj][2 * mp + 1][n];
#pragma unroll
            for (int j = 0; j < 4; ++j) { const float ra = fmaxf(a[j], 0.f), rb = fmaxf(b[j], 0.f); a[j] = ra * ra; b[j] = rb * rb; }
            store_bf8(U + (size_t)t * 4096 + f, a, b);
          }
      }
  }
}

__device__ void phase_qkv(const Params& p, char* lds) {
  const int lane = threadIdx.x & 63, wave = threadIdx.x >> 6;
  const int wr = wave >> 2, wc = wave & 3;
  const int total = (NT / 256) * 6;
  bf16_t* Q = p.S[0]; bf16_t* KA = p.S[1]; bf16_t* VT = p.S[2];
  for (int u = blockIdx.x; u < total; u += gridDim.x) {
    const int mt = u / 6, nt = u % 6;
    if (mt >= NL / 256 && nt < 4) continue;
    f32x4 acc[2][2][4][2];
    gemm256_tile<false>(p.wqkvT, p.S[5], 1024, nt * 256, mt * 256, lds, acc);
    int lane_o = threadIdx.x & 63; asm volatile("" : "+v"(lane_o));
    const int fr = lane_o & 15, fq = lane_o >> 4;
#pragma unroll
    for (int bj = 0; bj < 2; ++bj)
#pragma unroll
      for (int n = 0; n < 2; ++n) {
        const int t = mt * 256 + bj * 128 + wc * 32 + n * 16 + fr;
        const bool lat = t < NL;
        const int b = lat ? (t >> 12) : ((t - NL) >> 8);
        const int key = lat ? (t & 4095) : 4096 + ((t - NL) & 255);
#pragma unroll
        for (int ai = 0; ai < 2; ++ai) {
          const int hh = ai * 2 + wr;
          asm volatile("" ::: "memory");
          if (nt < 5) {
            float ss = 0.f;
#pragma unroll
            for (int m = 0; m < 4; ++m)
#pragma unroll
              for (int j = 0; j < 4; ++j) ss += acc[ai][bj][m][n][j] * acc[ai][bj][m][n][j];
            ss += __shfl_xor(ss, 16); ss += __shfl_xor(ss, 32);
            const float rstd = rsqrtf(ss * (1.f / 64.f) + 1e-6f);
            const float* gn = nt < 4 ? p.q_norm : p.k_norm;
            float v[4][4];
#pragma unroll
            for (int m = 0; m < 4; ++m) {
              const float4 g4 = *(const float4*)(gn + m * 16 + fq * 4);
              v[m][0] = acc[ai][bj][m][n][0] * rstd * g4.x; v[m][1] = acc[ai][bj][m][n][1] * rstd * g4.y;
              v[m][2] = acc[ai][bj][m][n][2] * rstd * g4.z; v[m][3] = acc[ai][bj][m][n][3] * rstd * g4.w;
            }
            if (lat) {
              const int s = t & 4095, rowp = s >> 6, colp = s & 63;
#pragma unroll
              for (int j = 0; j < 4; ++j) {
                const float2 cs0 = *(const float2*)(p.TAB + (rowp * 16 + fq * 4 + j) * 2);
                const float2 cs1 = *(const float2*)(p.TAB + (colp * 16 + fq * 4 + j) * 2);
                const float x1 = v[0][j], x2 = v[1][j], z1 = v[2][j], z2 = v[3][j];
                v[0][j] = x1 * cs0.x - x2 * cs0.y; v[1][j] = x2 * cs0.x + x1 * cs0.y;
                v[2][j] = z1 * cs1.x - z2 * cs1.y; v[3][j] = z2 * cs1.x + z1 * cs1.y;
              }
            }
            if (nt < 4) {
              const float qs = 0.125f * 1.4426950408889634f;
              const int head = nt * 4 + hh;
#pragma unroll
              for (int m = 0; m < 4; ++m)
                store_bf4(Q + (size_t)t * 1024 + head * 64 + m * 16 + fq * 4, v[m][0] * qs, v[m][1] * qs, v[m][2] * qs, v[m][3] * qs);
            } else {
#pragma unroll
              for (int m = 0; m < 4; ++m)
                store_bf4(KA + ((size_t)(b * 4 + hh) * NKEY + key) * 64 + m * 16 + fq * 4, v[m][0], v[m][1], v[m][2], v[m][3]);
            }
          } else {
#pragma unroll
            for (int m = 0; m < 4; ++m)
#pragma unroll
              for (int j = 0; j < 4; ++j) {
                const int d = m * 16 + fq * 4 + j;
                const unsigned pk = pack2(acc[ai][bj][m][n][j], 0.f);
                VT[((size_t)(b * 4 + hh) * 64 + d) * NKEY + key] = (bf16_t)(pk & 0xffffu);
              }
          }
        }
      }
  }
}

__device__ void phase_attn(const Params& p, char* lds) {
  const int tid = threadIdx.x, lane = tid & 63, wave = tid >> 6;
  const int l31 = lane & 31, lh = lane >> 5;
  const int srow = tid >> 3, sch = tid & 7;
  const bf16_t* Q = p.S[0]; const bf16_t* KA = p.S[1]; const bf16_t* VT = p.S[2]; bf16_t* O = p.S[3];
  float gq = 0.f, gk = 0.f;
  for (int i = 0; i < 64; ++i) { gq = fmaxf(gq, fabsf(p.q_norm[i])); gk = fmaxf(gk, fabsf(p.k_norm[i])); }
  const float M2 = 8.f * gq * gk * 1.4426950408889634f;
  constexpr int NKT = NKEY / 64;
  constexpr int AST = 2 * 64 * ROWB;
  for (int u = blockIdx.x; u < 2048; u += gridDim.x) {
    const int qb = u & 15, head = (u >> 4) & 15, b = u >> 8, kvh = head >> 2;
    const bf16_t* Kg = KA + (size_t)(b * 4 + kvh) * NKEY * 64;
    const bf16_t* Vg = VT + (size_t)(b * 4 + kvh) * 64 * NKEY;
    const int tq = b * 4096 + qb * 256 + wave * 32 + l31;
    bf16x8 qf[4];
#pragma unroll
    for (int s = 0; s < 4; ++s) qf[s] = *(const bf16x8*)(Q + (size_t)tq * 1024 + head * 64 + s * 16 + lh * 8);
    f32x16 o0, o1;
#pragma unroll
    for (int i = 0; i < 16; ++i) { o0[i] = 0.f; o1[i] = 0.f; }
    float lsum = 0.f;
    uint4 kreg, vreg;
    auto gload = [&](int kt) {
      kreg = *(const uint4*)(Kg + (size_t)(kt * 64 + srow) * 64 + sch * 8);
      vreg = *(const uint4*)(Vg + (size_t)srow * NKEY + kt * 64 + sch * 8);
    };
    auto lwrite = [&](int st) {
      *(uint4*)(lds + st * AST + srow * ROWB + sch * 16) = kreg;
      *(uint4*)(lds + st * AST + 64 * ROWB + srow * ROWB + sch * 16) = vreg;
    };
    gload(0);
    __syncthreads();
    lwrite(0);
    __syncthreads();
    for (int kt = 0; kt < NKT; ++kt) {
      if (kt + 1 < NKT) gload(kt + 1);
      const char* ksm = lds + (kt & 1) * AST;
      const char* vsm = ksm + 64 * ROWB;
      f32x16 sT[2];
#pragma unroll
      for (int k2 = 0; k2 < 2; ++k2) {
#pragma unroll
        for (int i = 0; i < 16; ++i) sT[k2][i] = -M2;
#pragma unroll
        for (int s = 0; s < 4; ++s) {
          const bf16x8 kf = *(const bf16x8*)(ksm + (k2 * 32 + l31) * ROWB + s * 32 + lh * 16);
          sT[k2] = MFMA32(kf, qf[s], sT[k2]);
        }
      }
#pragma unroll
      for (int k2 = 0; k2 < 2; ++k2)
#pragma unroll
        for (int i = 0; i < 16; ++i) { const float pv = __builtin_amdgcn_exp2f(sT[k2][i]); lsum += pv; sT[k2][i] = pv; }
#pragma unroll
      for (int k2 = 0; k2 < 2; ++k2)
#pragma unroll
        for (int s2 = 0; s2 < 2; ++s2) {
          uint4 pk;
          pk.x = pack2(sT[k2][8 * s2 + 0], sT[k2][8 * s2 + 1]); pk.y = pack2(sT[k2][8 * s2 + 2], sT[k2][8 * s2 + 3]);
          pk.z = pack2(sT[k2][8 * s2 + 4], sT[k2][8 * s2 + 5]); pk.w = pack2(sT[k2][8 * s2 + 6], sT[k2][8 * s2 + 7]);
          const bf16x8 pf = __builtin_bit_cast(bf16x8, pk);
          const int koff = (k2 * 32 + 16 * s2 + 4 * lh) * 2;
          {
            const uint2 lo = *(const uint2*)(vsm + l31 * ROWB + koff), hi = *(const uint2*)(vsm + l31 * ROWB + koff + 16);
            const uint4 vv = make_uint4(lo.x, lo.y, hi.x, hi.y);
            o0 = MFMA32(__builtin_bit_cast(bf16x8, vv), pf, o0);
          }
          {
            const uint2 lo = *(const uint2*)(vsm + (32 + l31) * ROWB + koff), hi = *(const uint2*)(vsm + (32 + l31) * ROWB + koff + 16);
            const uint4 vv = make_uint4(lo.x, lo.y, hi.x, hi.y);
            o1 = MFMA32(__builtin_bit_cast(bf16x8, vv), pf, o1);
          }
        }
      if (kt + 1 < NKT) lwrite((kt + 1) & 1);
      __syncthreads();
    }
    lsum += __shfl_xor(lsum, 32);
    const float inv = 1.f / lsum;
#pragma unroll
    for (int g = 0; g < 4; ++g) {
      const int d0 = 8 * g + 4 * lh;
      store_bf4(O + (size_t)tq * 1024 + head * 64 + d0, o0[4 * g] * inv, o0[4 * g + 1] * inv, o0[4 * g + 2] * inv, o0[4 * g + 3] * inv);
      store_bf4(O + (size_t)tq * 1024 + head * 64 + 32 + d0, o1[4 * g] * inv, o1[4 * g + 1] * inv, o1[4 * g + 2] * inv, o1[4 * g + 3] * inv);
    }
  }
}

#define XB_TMO      128
#define XB_XCNT(j)  (256  + 64 * (j))
#define XB_XSUB(j)  (1280 + 64 * (j))
#define XB_XGEN(j)  (2304 + 64 * (j))
#define XB_TOP      3328
#define XB_TOPGEN   3392
#define XCD_BAR_WORDS 3456
#define XB_SPIN_CAP (1u << 18)
#define LAS __attribute__((address_space(3)))

__device__ __forceinline__ unsigned xb_ld(unsigned* p)              { return __hip_atomic_load(p, __ATOMIC_RELAXED, __HIP_MEMORY_SCOPE_AGENT); }
__device__ __forceinline__ unsigned xb_add(unsigned* p, unsigned v) { return __hip_atomic_fetch_add(p, v, __ATOMIC_RELAXED, __HIP_MEMORY_SCOPE_AGENT); }
__device__ __forceinline__ unsigned xb_xcc_id() { return (unsigned)__builtin_amdgcn_s_getreg((3 << 11) | 20) & 0xFu; }
#define XB_SPIN(cond, bar) do { unsigned _sp = 0; while (cond) { __builtin_amdgcn_s_sleep(1); \
    if ((++_sp & 255u) == 0u) { if (xb_ld(&(bar)[XB_TMO])) break; if (_sp > XB_SPIN_CAP) { atomicAdd(&(bar)[XB_TMO], 1u); break; } } } } while (0)

struct XcdBarrier {
    unsigned* bar; unsigned x;
    volatile LAS unsigned* st;
};

__device__ __forceinline__ XcdBarrier xcd_barrier_post(unsigned* bar, volatile LAS unsigned* st) {
    XcdBarrier b; b.bar = bar; b.x = xb_xcc_id(); b.st = st;
    if (threadIdx.x == 0) (void)xb_add(&bar[XB_XCNT(b.x)], 1u);
    return b;
}
__device__ __forceinline__ void xcd_barrier_complete(unsigned* bar, unsigned x, unsigned& nloc, unsigned& nx) {
    const unsigned G = gridDim.x * gridDim.y * gridDim.z;
    unsigned sum, cnt, mine, sp = 0u;
    for (;;) {
        sum = 0u; cnt = 0u; mine = 0u;
#pragma unroll
        for (unsigned j = 0; j < 16; ++j) { const unsigned c = xb_ld(&bar[XB_XCNT(j)]); sum += c; cnt += (c > 0u) ? 1u : 0u; mine = (j == x) ? c : mine; }
        if (sum == G) break;
        __builtin_amdgcn_s_sleep(1);
        if ((++sp & 255u) == 0u) { if (xb_ld(&bar[XB_TMO])) break; if (sp > XB_SPIN_CAP) { atomicAdd(&bar[XB_TMO], 1u); break; } }
    }
    nloc = mine > 0u ? mine : 1u; nx = cnt > 0u ? cnt : 1u;
}

__device__ __forceinline__ void xcd_barrier(const XcdBarrier& b) {
    asm volatile("s_waitcnt vmcnt(0)" ::: "memory");
    __syncthreads();
    if (threadIdx.x == 0) {
        unsigned* bar = b.bar;
        __builtin_amdgcn_s_waitcnt(0);
        unsigned nloc = b.st[0], nx = b.st[1];
        if (nloc == 0u) { xcd_barrier_complete(bar, b.x, nloc, nx); b.st[0] = nloc; b.st[1] = nx; }
        const unsigned old = xb_add(&bar[XB_XSUB(b.x)], 1u);
        const unsigned gen = old / nloc;
        if (old + 1u == (gen + 1u) * nloc) {
            __builtin_amdgcn_fence(__ATOMIC_RELEASE, "agent");
            asm volatile("s_waitcnt vmcnt(0)" ::: "memory");
            const unsigned og = xb_add(&bar[XB_TOP], 1u);
            const unsigned tg = og / nx;
            if (og + 1u == (tg + 1u) * nx) xb_add(&bar[XB_TOPGEN], 1u);
            else XB_SPIN(xb_ld(&bar[XB_TOPGEN]) == tg, bar);
            __builtin_amdgcn_fence(__ATOMIC_ACQUIRE, "agent");
            xb_add(&bar[XB_XGEN(b.x)], 1u);
            asm volatile("s_waitcnt vmcnt(0)" ::: "memory");
        } else {
            XB_SPIN(xb_ld(&bar[XB_XGEN(b.x)]) == gen, bar);
            __builtin_amdgcn_fence(__ATOMIC_ACQUIRE, "agent");
            asm volatile("s_waitcnt vmcnt(0)" ::: "memory");
        }
    }
    __syncthreads();
}


DI void run_phase(const Params& p, int ph, char* lds) {
  const float* mod0 = p.MOD;
  const float* mod1 = p.MOD + 9 * 6144;
  switch (ph) {
    case 0: phase0(p, lds); break;
    case 1: norm_mod_phase(p.x, p.ctx, p.norm_mix, mod0, 0, 1, p.Hd, NT); break;
    case 2: phase_proj(p, lds); break;
    case 20: phase_mix(p); break;
    case 3: phase_prep(p, lds); break;
    case 4: phase_scan(p, lds); break;
    case 5: phase_readout(p, lds); break;
    case 6: phase_gemm_resid(p, lds, p.S[0], p.woT, 1024, NT / 256, p.x, p.ctx, mod0 + 2 * 1024); break;
    case 7: norm_mod_phase(p.out, p.XC, p.norm_mlp, mod0, 3, 4, p.S[5], NT); break;
    case 8: phase_up(p, lds, p.S[5], p.w1T[0], p.S[0], NT / 256); break;
    case 9: phase_gemm_resid(p, lds, p.S[0], p.w2T[0], 4096, NT / 256, p.out, p.XC, mod0 + 5 * 1024); break;
    case 10: norm_mod_phase(p.out, p.XC, p.norm_mix + 1024, mod1, 0, 1, p.S[5], NT); break;
    case 11: phase_qkv(p, lds); break;
    case 12: phase_attn(p, lds); break;
    case 13: phase_gemm_resid(p, lds, p.S[3], p.awoT, 1024, NL / 256, p.out, p.XC, mod1 + 2 * 1024); break;
    case 14: norm_mod_phase(p.out, p.XC, p.norm_mlp + 1024, mod1, 3, 4, p.S[5], NL); break;
    case 15: phase_up(p, lds, p.S[5], p.w1T[1], p.S[0], NL / 256); break;
    case 16: phase_gemm_resid(p, lds, p.S[0], p.w2T[1], 4096, NL / 256, p.out, p.XC, mod1 + 5 * 1024); break;
    case 17: final_norm_phase(p); break;
  }
}
constexpr int NPHASE = 18;

__global__ void __launch_bounds__(NTHREADS) phase_kernel(Params p, int ph) {
  extern __shared__ __attribute__((aligned(16))) char lds[];
  run_phase(p, ph, lds);
}

__global__ void __launch_bounds__(NTHREADS) mega_kernel(Params p) {
  extern __shared__ __attribute__((aligned(16))) char lds[];
  cg::grid_group grid = cg::this_grid();
  volatile LAS unsigned* st = (volatile LAS unsigned*)(LAS char*)(lds + 131072);
  if (threadIdx.x == 0) { st[0] = 0u; st[1] = 0u; }
  if (blockIdx.x == 0) for (int i = threadIdx.x; i < XCD_BAR_WORDS; i += NTHREADS) p.BAR[i] = 0u;
  __syncthreads();
  run_phase(p, 0, lds);
  grid.sync();
  const XcdBarrier xb = xcd_barrier_post(p.BAR, st);
#ifndef DUP
#define DUP -1
#endif
#define PH(n) run_phase(p, n, lds); xcd_barrier(xb); if (DUP == n) { if (n == 4) phase_scan(p, lds, true); else if (n == 9) phase_gemm_resid(p, lds, p.S[0], p.w2T[0], 4096, NT / 256, p.out, p.XC, p.MOD + 5 * 1024, (float*)p.S[4]); else run_phase(p, n, lds); xcd_barrier(xb); } if (DUP == 100) { xcd_barrier(xb); }
  PH(1) PH(20) PH(2) PH(3) PH(4) PH(5) PH(6) PH(7) PH(8) PH(9) PH(10) PH(11) PH(12) PH(13) PH(14) PH(15) PH(16)
  run_phase(p, 17, lds);
}

extern "C" void kernel_launch(void* const* d_in, const int* in_sizes, int n_in, void* d_out, int out_size, void* d_ws, size_t ws_size, hipStream_t stream) {
  Params p;
  memset(&p, 0, sizeof(p));
  const float* const* in = (const float* const*)d_in;
  p.x = in[0]; p.c = in[1]; p.ctx = in[2]; p.c_ctx = in[3]; p.w_mod = in[4]; p.b_mod = in[5]; p.norm_mix = in[6]; p.norm_mlp = in[7];
  p.mlp_w1 = in[8]; p.mlp_w2 = in[9]; p.mu = in[10]; p.wr = in[11]; p.wk = in[12]; p.wv = in[13]; p.wo = in[14]; p.w0 = in[15]; p.w1 = in[16];
  p.w2 = in[17]; p.a0 = in[18]; p.a1 = in[19]; p.a2 = in[20]; p.g1 = in[21]; p.g2 = in[22]; p.k_k = in[23]; p.k_a = in[24]; p.r_k = in[25];
  p.ln_w = in[26]; p.ln_b = in[27]; p.wqkv = in[28]; p.q_norm = in[29]; p.k_norm = in[30]; p.awo = in[31]; p.final_norm = in[32];
  p.out = (float*)d_out;
  char* ws = (char*)d_ws;
  size_t off = 0;
  auto take = [&](size_t bytes) -> char* { char* r = ws + off; off += (bytes + 255) & ~(size_t)255; return r; };
  p.Wcat = (bf16_t*)take((size_t)3456 * 1024 * 2);
  p.L2w = (bf16_t*)take((size_t)4 * 65536 * 2);
  p.g2T = (bf16_t*)take((size_t)1024 * 128 * 2);
  p.woT = (bf16_t*)take((size_t)1024 * 1024 * 2);
  p.w1T[0] = (bf16_t*)take((size_t)4096 * 1024 * 2);
  p.w1T[1] = (bf16_t*)take((size_t)4096 * 1024 * 2);
  p.w2T[0] = (bf16_t*)take((size_t)4096 * 1024 * 2);
  p.w2T[1] = (bf16_t*)take((size_t)4096 * 1024 * 2);
  p.wqkvT = (bf16_t*)take((size_t)1536 * 1024 * 2);
  p.awoT = (bf16_t*)take((size_t)1024 * 1024 * 2);
  p.MOD = (float*)take((size_t)2 * 9 * 6144 * 4);
  p.TAB = (float*)take((size_t)1024 * 2 * 4);
  p.XC = (float*)take((size_t)NC * 1024 * 4);
  p.BAR = (unsigned*)take((size_t)XCD_BAR_WORDS * 4);
  for (int i = 0; i < 6; ++i) p.S[i] = (bf16_t*)take((size_t)NT * 1024 * 2);
  if (off > ws_size) { fprintf(stderr, "kernel_launch: workspace too small (%zu needed, %zu given)\n", off, ws_size); return; }
  char* ob = (char*)d_out;
  p.Hd = (bf16_t*)ob;
  p.L1 = (bf16_t*)(ob + (size_t)NT * 1024 * 2);
  p.BON = (float*)(ob + (size_t)NT * 1024 * 2 + (size_t)NT * 384 * 2);
  p.NRM = (float*)(ob + (size_t)NT * 1024 * 2 + (size_t)NT * 384 * 2 + (size_t)NT * 16 * 4);
  int nj = 0, tiles = 0;
  auto job = [&](const float* src, bf16_t* dst, int K, int N) {
    p.jobs[nj].src = src; p.jobs[nj].dst = dst; p.jobs[nj].K = K; p.jobs[nj].N = N; p.jobs[nj].tstart = tiles; p.jobs[nj].tiles_n = N / 64;
    tiles += (K / 64) * (N / 64); ++nj;
  };
  job(p.wr, p.Wcat, 1024, 1024);
  job(p.wk, p.Wcat + (size_t)1024 * 1024, 1024, 1024);
  job(p.wv, p.Wcat + (size_t)2048 * 1024, 1024, 1024);
  job(p.g1, p.Wcat + (size_t)3072 * 1024, 1024, 128);
  job(p.w1, p.Wcat + (size_t)3200 * 1024, 1024, 64);
  job(p.w1 + 65536, p.Wcat + (size_t)3264 * 1024, 1024, 64);
  job(p.a1, p.Wcat + (size_t)3328 * 1024, 1024, 64);
  job(p.a1 + 65536, p.Wcat + (size_t)3392 * 1024, 1024, 64);
  job(p.a2, p.L2w, 64, 1024);
  job(p.a2 + 65536, p.L2w + 65536, 64, 1024);
  job(p.w2, p.L2w + 2 * 65536, 64, 1024);
  job(p.w2 + 65536, p.L2w + 3 * 65536, 64, 1024);
  job(p.g2, p.g2T, 128, 1024);
  job(p.wo, p.woT, 1024, 1024);
  job(p.mlp_w1, p.w1T[0], 1024, 4096);
  job(p.mlp_w1 + (size_t)4096 * 1024, p.w1T[1], 1024, 4096);
  job(p.mlp_w2, p.w2T[0], 4096, 1024);
  job(p.mlp_w2 + (size_t)4096 * 1024, p.w2T[1], 4096, 1024);
  job(p.wqkv, p.wqkvT, 1024, 1536);
  job(p.awo, p.awoT, 1024, 1024);
  p.njobs = nj; p.total_tiles = tiles;

  static int grid_blocks = 0;
  if (!grid_blocks) {
    (void)hipFuncSetAttribute((const void*)mega_kernel, hipFuncAttributeMaxDynamicSharedMemorySize, LDS_BYTES);
    (void)hipFuncSetAttribute((const void*)phase_kernel, hipFuncAttributeMaxDynamicSharedMemorySize, LDS_BYTES);
    int dev = 0, cus = 0, per_cu = 0;
    (void)hipGetDevice(&dev);
    (void)hipDeviceGetAttribute(&cus, hipDeviceAttributeMultiprocessorCount, dev);
    if (hipOccupancyMaxActiveBlocksPerMultiprocessor(&per_cu, (const void*)mega_kernel, NTHREADS, LDS_BYTES) != hipSuccess || per_cu < 1) per_cu = 1;
    if (cus <= 0) cus = 256;
    grid_blocks = cus * per_cu;
    (void)hipGetLastError();
  }
#if SINGLE_LAUNCH
  void* args[] = {&p};
  hipError_t e = hipLaunchCooperativeKernel((const void*)mega_kernel, dim3(grid_blocks), dim3(NTHREADS), args, LDS_BYTES, stream);
  if (e != hipSuccess) fprintf(stderr, "cooperative launch failed: %s (grid %d)\n", hipGetErrorString(e), grid_blocks);
#else
  for (int ph = 0; ph < NPHASE; ++ph) hipLaunchKernelGGL(phase_kernel, dim3(grid_blocks), dim3(NTHREADS), LDS_BYTES, stream, p, ph);
#endif
}
```

```cpp
#include <hip/hip_runtime.h>
#include <hip/hip_cooperative_groups.h>
#include <cstdint>
#include <cstring>
#include <cstdio>
namespace cg = cooperative_groups;

#ifndef SINGLE_LAUNCH
#define SINGLE_LAUNCH 1
#endif

typedef unsigned short bf16_t;
typedef short bf16x8 __attribute__((ext_vector_type(8)));
typedef float f32x2 __attribute__((ext_vector_type(2)));
typedef float f32x4 __attribute__((ext_vector_type(4)));
typedef float f32x16 __attribute__((ext_vector_type(16)));
typedef __bf16 bf16x2_t __attribute__((ext_vector_type(2)));
#define DI __device__ __forceinline__

constexpr int D = 1024, NB = 8, SEQ = 4096, CTXL = 256;
constexpr int NL = NB * SEQ, NC = NB * CTXL, NT = NL + NC, DFF = 4096;
constexpr int NKEY = SEQ + CTXL;
constexpr int NTHREADS = 512;
constexpr int ROWB = 144;
constexpr int GEMM_STAGE = (256 + 128) * ROWB;
constexpr int LDS_BYTES = 131072 + 16;

struct TJob { const float* src; bf16_t* dst; int K, N, tstart, tiles_n; };

struct Params {
  const float *x, *c, *ctx, *c_ctx, *w_mod, *b_mod, *norm_mix, *norm_mlp, *mlp_w1, *mlp_w2;
  const float *mu, *wr, *wk, *wv, *wo, *w0, *w1, *w2, *a0, *a1, *a2, *g1, *g2, *k_k, *k_a, *r_k, *ln_w, *ln_b;
  const float *wqkv, *q_norm, *k_norm, *awo, *final_norm;
  float* out;
  bf16_t *Wcat, *L2w, *g2T, *woT, *w1T[2], *w2T[2], *wqkvT, *awoT;
  float *MOD, *TAB, *XC;
  bf16_t* S[6];
  bf16_t *Hd, *L1;
  float* BON;
  float* NRM;
  unsigned* BAR;
  TJob jobs[20];
  int njobs, total_tiles;
};

DI unsigned pack2(float lo, float hi) {
  f32x2 v = {lo, hi};
  bf16x2_t b = __builtin_convertvector(v, bf16x2_t);
  return __builtin_bit_cast(unsigned, b);
}
DI float bflo(unsigned u) { return __uint_as_float(u << 16); }
DI float bfhi(unsigned u) { return __uint_as_float(u & 0xffff0000u); }
DI void store_bf4(bf16_t* p, float a, float b, float c, float d) { *(uint2*)p = make_uint2(pack2(a, b), pack2(c, d)); }
DI void load_bf4(const bf16_t* p, float& a, float& b, float& c, float& d) { uint2 u = *(const uint2*)p; a = bflo(u.x); b = bfhi(u.x); c = bflo(u.y); d = bfhi(u.y); }
DI void store_bf8(bf16_t* p, const f32x4& a, const f32x4& b) {
  uint4 o; o.x = pack2(a[0], a[1]); o.y = pack2(a[2], a[3]); o.z = pack2(b[0], b[1]); o.w = pack2(b[2], b[3]);
  *(uint4*)p = o;
}
DI void store16_sc1(void* p, const uint4& v) {
  typedef unsigned u32x4_t __attribute__((ext_vector_type(4)));
  const u32x4_t d = {v.x, v.y, v.z, v.w};
  asm volatile("global_store_dwordx4 %0, %1, off sc1" :: "v"(p), "v"(d) : "memory");
}
DI void unpack_bf8(const uint4& u, float (&o)[8]) {
  o[0] = bflo(u.x); o[1] = bfhi(u.x); o[2] = bflo(u.y); o[3] = bfhi(u.y); o[4] = bflo(u.z); o[5] = bfhi(u.z); o[6] = bflo(u.w); o[7] = bfhi(u.w);
}
DI int perm32(int rho) { return 8 * ((rho & 15) >> 2) + 4 * (rho >> 4) + (rho & 3); }
DI float sigmoidf_(float x) { return 1.f / (1.f + __expf(-x)); }
DI float tanhf_(float x) { return 1.f - 2.f / (1.f + __expf(2.f * x)); }
DI float quad_sum(float x) {
  x += __builtin_bit_cast(float, __builtin_amdgcn_mov_dpp(__builtin_bit_cast(int, x), 0xB1, 0xF, 0xF, true));
  x += __builtin_bit_cast(float, __builtin_amdgcn_mov_dpp(__builtin_bit_cast(int, x), 0x4E, 0xF, 0xF, true));
  return x;
}
DI float oct_sum(float x) {
  x = quad_sum(x);
  x += __builtin_bit_cast(float, __builtin_amdgcn_mov_dpp(__builtin_bit_cast(int, x), 0x141, 0xF, 0xF, true));
  return x;
}
DI float wave_sum(float x) {
#pragma unroll
  for (int m = 1; m < 64; m <<= 1) x += __shfl_xor(x, m);
  return x;
}
#define MFMA16(a, b, c) __builtin_amdgcn_mfma_f32_16x16x32_bf16((a), (b), (c), 0, 0, 0)
#define MFMA32(a, b, c) __builtin_amdgcn_mfma_f32_32x32x16_bf16((a), (b), (c), 0, 0, 0)

DI unsigned lerp2(unsigned a, unsigned n, float ma, float mb) {
  const float h0 = bflo(a), h1 = bfhi(a), s0 = bflo(n), s1 = bfhi(n);
  return pack2(h0 + (s0 - h0) * ma, h1 + (s1 - h1) * mb);
}
template <bool LERP>
DI void gemm_tile(const bf16_t* __restrict__ X, int ldx, const bf16_t* __restrict__ W, int ldw, int K, int tok0, int f0,
                  char* lds, f32x4 (&acc)[4][4], const float* __restrict__ mu) {
  const int tid = threadIdx.x, lane = tid & 63, wave = tid >> 6;
  const int wt = wave & 3, wf = wave >> 2, lr = lane & 15, lq = lane >> 4;
  const int lrow = tid >> 3, kc = tid & 7;
#pragma unroll
  for (int i = 0; i < 4; ++i)
#pragma unroll
    for (int j = 0; j < 4; ++j) acc[i][j] = f32x4{0.f, 0.f, 0.f, 0.f};
  uint4 xr[4], wr[2], xn[4];
  float4 m0 = make_float4(0, 0, 0, 0), m1 = m0;
  const int nk = K >> 6;
  __syncthreads();
  for (int kt = -1; kt < nk; ++kt) {
    const bool more = kt + 1 < nk;
    if (more) {
      const int k0 = (kt + 1) << 6;
#pragma unroll
      for (int i = 0; i < 4; ++i) {
        const int tg = tok0 + lrow + 64 * i;
        xr[i] = *(const uint4*)(X + (size_t)tg * ldx + k0 + kc * 8);
        if (LERP) {
          int nb; bool valid;
          if (tok0 < NL) {
            const int s = tg & 4095, col = s & 63, rw = s >> 6, qd = k0 >> 8;
            if (qd == 0) { valid = col > 0; nb = tg - 1; }
            else if (qd == 1) { valid = col < 63; nb = tg + 1; }
            else if (qd == 2) { valid = rw > 0; nb = tg - 64; }
            else { valid = rw < 63; nb = tg + 64; }
          } else {
            const int s = (tg - NL) & 255;
            if (k0 < 512) { valid = s > 0; nb = tg - 1; }
            else { valid = s < 255; nb = tg + 1; }
          }
          if (valid) xn[i] = *(const uint4*)(X + (size_t)nb * ldx + k0 + kc * 8);
          else xn[i] = make_uint4(0, 0, 0, 0);
        }
      }
#pragma unroll
      for (int i = 0; i < 2; ++i) wr[i] = *(const uint4*)(W + (size_t)(f0 + 64 * i + (lrow & 32) + perm32(lrow & 31)) * ldw + k0 + kc * 8);
      if (LERP) { m0 = *(const float4*)(mu + k0 + kc * 8); m1 = *(const float4*)(mu + k0 + kc * 8 + 4); }
    }
    if (kt >= 0) {
      const char* xs = lds + (kt & 1) * GEMM_STAGE;
      const char* wsm = xs + 256 * ROWB;
#pragma unroll
      for (int ks = 0; ks < 2; ++ks) {
        bf16x8 wfr[4], xfr[4];
#pragma unroll
        for (int i = 0; i < 4; ++i) wfr[i] = *(const bf16x8*)(wsm + (wf * 64 + i * 16 + lr) * ROWB + ks * 64 + lq * 16);
#pragma unroll
        for (int i = 0; i < 4; ++i) xfr[i] = *(const bf16x8*)(xs + (wt * 64 + i * 16 + lr) * ROWB + ks * 64 + lq * 16);
#pragma unroll
        for (int fi = 0; fi < 4; ++fi)
#pragma unroll
          for (int ti = 0; ti < 4; ++ti) acc[fi][ti] = MFMA16(wfr[fi], xfr[ti], acc[fi][ti]);
      }
    }
    if (more) {
      char* xs = lds + ((kt + 1) & 1) * GEMM_STAGE;
      char* wsm = xs + 256 * ROWB;
#pragma unroll
      for (int i = 0; i < 4; ++i) {
        uint4 v = xr[i];
        if (LERP) {
          v.x = lerp2(xr[i].x, xn[i].x, m0.x, m0.y);
          v.y = lerp2(xr[i].y, xn[i].y, m0.z, m0.w);
          v.z = lerp2(xr[i].z, xn[i].z, m1.x, m1.y);
          v.w = lerp2(xr[i].w, xn[i].w, m1.z, m1.w);
        }
        *(uint4*)(xs + (lrow + 64 * i) * ROWB + kc * 16) = v;
      }
#pragma unroll
      for (int i = 0; i < 2; ++i) *(uint4*)(wsm + (lrow + 64 * i) * ROWB + kc * 16) = wr[i];
    }
    __syncthreads();
  }
}


namespace g256 {
constexpr int BK = 64, HALF = 128, HT = HALF * BK;
DI int lds_byte(int r, int c) { const int st = (r >> 4) * 2 + (c >> 5), rr = r & 15, cc = c & 31, ob = rr * 64 + cc * 2; return st * 1024 + (ob ^ (((ob >> 9) & 1) << 5)); }
DI void stage_rc(int b, int& R, int& C) { const int st = b / 1024, sb = b % 1024, swz = sb ^ (((sb >> 9) & 1) << 5); R = (st >> 1) * 16 + swz / 64; C = (st & 1) * 32 + (swz % 64) / 2; }
}
#define G_SA(b, h) (((b) * 2 + (h)) * 16384)
#define G_SB(b, h) ((4 + (b) * 2 + (h)) * 16384)
#define G_STAGEV(bufoff, gbase, vo) do { _Pragma("unroll") for (int _i = 0; _i < 2; ++_i) \
    __builtin_amdgcn_global_load_lds((const unsigned*)((const char*)(gbase) + (vo)[_i]), (__attribute__((address_space(3))) unsigned*)(lds + (bufoff) + ldsw + _i * 8192), 16, 0, 0); } while (0)
#define G_LDA(dst, b, h) do { _Pragma("unroll") for (int m = 0; m < 4; ++m) _Pragma("unroll") for (int k = 0; k < 2; ++k) \
    dst[m][k] = *(const __attribute__((address_space(3))) bf16x8*)(lds + G_SA(b, h) + aoff + m * 2048 + k * 1024); } while (0)
#define G_LDB(dst, b, h) do { _Pragma("unroll") for (int n = 0; n < 2; ++n) _Pragma("unroll") for (int k = 0; k < 2; ++k) \
    dst[n][k] = *(const __attribute__((address_space(3))) bf16x8*)(lds + G_SB(b, h) + boff + n * 2048 + k * 1024); } while (0)
#define G_MMA(ai, bj, At, Bt) do { __builtin_amdgcn_s_setprio(1); \
    _Pragma("unroll") for (int m = 0; m < 4; ++m) _Pragma("unroll") for (int n = 0; n < 2; ++n) _Pragma("unroll") for (int k = 0; k < 2; ++k) \
      acc[ai][bj][m][n] = __builtin_amdgcn_mfma_f32_16x16x32_bf16(At[m][k], Bt[n][k], acc[ai][bj][m][n], 0, 0, 0); \
    __builtin_amdgcn_s_setprio(0); } while (0)
#define G_WAIT_V(n) asm volatile("s_waitcnt vmcnt(" #n ")" ::: "memory")
#define G_WAIT_L(n) asm volatile("s_waitcnt lgkmcnt(" #n ")" ::: "memory")
#define G_BAR __builtin_amdgcn_s_barrier()
#define G_SCHED __builtin_amdgcn_sched_barrier(0)

template <bool PERM>
DI void gemm256_tile(const bf16_t* __restrict__ A, const bf16_t* __restrict__ Bt, int K, int brow, int bcol, char* lds_, f32x4 (&acc)[2][2][4][2]) {
  __attribute__((address_space(3))) unsigned char* lds = (__attribute__((address_space(3))) unsigned char*)lds_;
  int tid = threadIdx.x; asm volatile("" : "+v"(tid));
  const int wid = __builtin_amdgcn_readfirstlane(tid >> 6), lane = tid & 63, wr = wid >> 2, wc = wid & 3, fr = lane & 15, fq = lane >> 4;
#pragma unroll
  for (int a = 0; a < 2; ++a)
#pragma unroll
    for (int b = 0; b < 2; ++b)
#pragma unroll
      for (int m = 0; m < 4; ++m)
#pragma unroll
        for (int n = 0; n < 2; ++n) acc[a][b][m][n] = f32x4{0.f, 0.f, 0.f, 0.f};
  unsigned voff[2], voffA[2];
#pragma unroll
  for (int i = 0; i < 2; ++i) { int R, C; g256::stage_rc(tid * 16 + i * 8192, R, C); voff[i] = (unsigned)(R * K + C) * 2u;
    const int Ra = PERM ? ((R & ~31) + perm32(R & 31)) : R; voffA[i] = (unsigned)(Ra * K + C) * 2u; }
  const size_t kstep = 128, hstep = (size_t)128 * K * 2;
  const unsigned ldsw = (unsigned)wid * 1024u;
  const int aoff = g256::lds_byte(wr * 64 + fr, fq * 8), boff = g256::lds_byte(wc * 32 + fr, fq * 8);
  const char* cA = (const char*)A + (size_t)brow * K * 2;
  const char* cB = (const char*)Bt + (size_t)bcol * K * 2;
  bf16x8 At[4][2], B0[2][2], B1[2][2];
  const int nt = K / g256::BK;
  __syncthreads();
  G_STAGEV(G_SB(0, 0), cB, voff); G_STAGEV(G_SA(0, 0), cA, voffA); G_STAGEV(G_SB(0, 1), cB + hstep, voff); G_STAGEV(G_SA(0, 1), cA + hstep, voffA);
  if (wr == 1) G_BAR;
  G_WAIT_V(4); G_BAR;
  G_STAGEV(G_SB(1, 0), cB + kstep, voff); G_STAGEV(G_SA(1, 0), cA + kstep, voffA); G_STAGEV(G_SB(1, 1), cB + hstep + kstep, voff);
  G_WAIT_V(6); G_BAR;
  for (int t = 0; t < nt - 2; t += 2) {
    const char* a1 = cA + (size_t)(t + 1) * kstep;
    const char* a2 = cA + (size_t)(t + 2) * kstep; const char* b2 = cB + (size_t)(t + 2) * kstep;
    const char* a3 = a2 + kstep; const char* b3 = b2 + kstep;
    G_LDB(B0, 0, 0); G_SCHED; G_LDA(At, 0, 0); G_STAGEV(G_SA(1, 1), a1 + hstep, voffA);
    G_WAIT_L(8); G_BAR; G_WAIT_L(0); G_MMA(0, 0, At, B0); G_BAR; G_SCHED;
    G_LDB(B1, 0, 1); G_STAGEV(G_SB(0, 0), b2, voff);
    G_BAR; G_WAIT_L(0); G_MMA(0, 1, At, B1); G_BAR;
    G_LDA(At, 0, 1); G_STAGEV(G_SA(0, 0), a2, voffA);
    G_BAR; G_WAIT_L(0); G_MMA(1, 0, At, B0); G_BAR; G_SCHED;
    G_STAGEV(G_SB(0, 1), b2 + hstep, voff);
    G_WAIT_V(6); G_BAR; G_MMA(1, 1, At, B1); G_BAR;
    G_LDB(B0, 1, 0); G_SCHED; G_LDA(At, 1, 0); G_STAGEV(G_SA(0, 1), a2 + hstep, voffA);
    G_WAIT_L(8); G_BAR; G_WAIT_L(0); G_MMA(0, 0, At, B0); G_BAR; G_SCHED;
    G_LDB(B1, 1, 1); G_STAGEV(G_SB(1, 0), b3, voff);
    G_BAR; G_WAIT_L(0); G_MMA(0, 1, At, B1); G_BAR;
    G_LDA(At, 1, 1); G_STAGEV(G_SA(1, 0), a3, voffA);
    G_BAR; G_WAIT_L(0); G_MMA(1, 0, At, B0); G_BAR; G_SCHED;
    G_STAGEV(G_SB(1, 1), b3 + hstep, voff);
    G_WAIT_V(6); G_BAR; G_MMA(1, 1, At, B1); G_BAR;
  }
  { G_LDB(B0, 0, 0); G_LDA(At, 0, 0); G_STAGEV(G_SA(1, 1), cA + (size_t)(nt - 1) * kstep + hstep, voffA);
    G_BAR; G_WAIT_L(0); G_MMA(0, 0, At, B0); G_BAR;
    G_LDB(B1, 0, 1); G_BAR; G_WAIT_L(0); G_MMA(0, 1, At, B1); G_BAR;
    G_LDA(At, 0, 1); G_WAIT_V(4); G_BAR; G_WAIT_L(0); G_MMA(1, 0, At, B0); G_MMA(1, 1, At, B1); G_BAR; }
  { G_LDB(B0, 1, 0); G_LDA(At, 1, 0); G_WAIT_V(2); G_BAR; G_WAIT_L(0); G_MMA(0, 0, At, B0); G_BAR;
    G_LDB(B1, 1, 1); G_WAIT_V(0); G_BAR; G_WAIT_L(0); G_MMA(0, 1, At, B1); G_BAR;
    G_LDA(At, 1, 1); G_BAR; G_WAIT_L(0); G_MMA(1, 0, At, B0); G_MMA(1, 1, At, B1); G_BAR; }
  if (wr == 0) G_BAR;
}

DI void convert_tile(const TJob& jb, int t, char* lds) {
  float* tile = (float*)lds;
  const int tid = threadIdx.x;
  const int tk = t / jb.tiles_n, tn = t % jb.tiles_n;
  const int k0 = tk * 64, n0 = tn * 64;
  __syncthreads();
#pragma unroll
  for (int i = 0; i < 2; ++i) {
    const int idx = tid + 512 * i, row = idx >> 4, c4 = idx & 15;
    const float4 v = *(const float4*)(jb.src + (size_t)(k0 + row) * jb.N + n0 + c4 * 4);
    tile[row * 65 + c4 * 4 + 0] = v.x; tile[row * 65 + c4 * 4 + 1] = v.y; tile[row * 65 + c4 * 4 + 2] = v.z; tile[row * 65 + c4 * 4 + 3] = v.w;
  }
  __syncthreads();
  const int n = tid >> 3, kc = tid & 7;
  float v[8];
#pragma unroll
  for (int j = 0; j < 8; ++j) v[j] = tile[(kc * 8 + j) * 65 + n];
  uint4 o;
  o.x = pack2(v[0], v[1]); o.y = pack2(v[2], v[3]); o.z = pack2(v[4], v[5]); o.w = pack2(v[6], v[7]);
  *(uint4*)(jb.dst + (size_t)(n0 + n) * jb.K + k0 + kc * 8) = o;
}

DI void mod_unit(const Params& p, int mu_, char* lds) {
  const int tid = threadIdx.x;
  const int layer = mu_ / 96, cc = mu_ % 96;
  float* sc = (float*)lds;
  float* red = sc + 9 * 1024;
  __syncthreads();
  for (int i = tid; i < 9 * 1024; i += 512) {
    const int row = i >> 10, k = i & 1023;
    const float v = row < 8 ? p.c[row * 1024 + k] : p.c_ctx[k];
    sc[i] = v / (1.f + __expf(-v));
  }
  __syncthreads();
  const int kg = tid >> 6, col = tid & 63;
  const float* w = p.w_mod + (size_t)layer * 1024 * 6144 + cc * 64 + col;
  float a[9];
#pragma unroll
  for (int r = 0; r < 9; ++r) a[r] = 0.f;
#pragma unroll 4
  for (int k = kg * 128; k < kg * 128 + 128; ++k) {
    const float wv = w[(size_t)k * 6144];
#pragma unroll
    for (int r = 0; r < 9; ++r) a[r] += sc[r * 1024 + k] * wv;
  }
#pragma unroll
  for (int r = 0; r < 9; ++r) red[(kg * 9 + r) * 64 + col] = a[r];
  __syncthreads();
  for (int i = tid; i < 576; i += 512) {
    const int r = i >> 6, cl = i & 63;
    float s = 0.f;
#pragma unroll
    for (int g = 0; g < 8; ++g) s += red[(g * 9 + r) * 64 + cl];
    const int n = cc * 64 + cl;
    p.MOD[(layer * 9 + r) * 6144 + n] = s + p.b_mod[layer * 6144 + n];
  }
  __syncthreads();
}

DI void sincos_d(double a, double& s, double& c) {
  const double n = rint(a * 0.6366197723675814);
  const double r = (a - n * 1.5707963267948966) - n * 6.123233995736766e-17;
  const double r2 = r * r;
  const double sp = r * (1.0 + r2 * (-1.0 / 6.0 + r2 * (1.0 / 120.0 + r2 * (-1.0 / 5040.0 + r2 * (1.0 / 362880.0 + r2 * (-1.0 / 39916800.0 + r2 * (1.0 / 6227020800.0)))))));
  const double cp = 1.0 + r2 * (-0.5 + r2 * (1.0 / 24.0 + r2 * (-1.0 / 720.0 + r2 * (1.0 / 40320.0 + r2 * (-1.0 / 3628800.0 + r2 * (1.0 / 479001600.0 + r2 * (-1.0 / 87178291200.0)))))));
  const int q = ((int)n) & 3;
  if (q == 0) { s = sp; c = cp; }
  else if (q == 1) { s = cp; c = -sp; }
  else if (q == 2) { s = -sp; c = -cp; }
  else { s = -cp; c = sp; }
}

DI void tab_unit(const Params& p) {
  for (int idx = threadIdx.x; idx < 1024; idx += 512) {
    const int pos = idx >> 4, fi = idx & 15;
    double f = 1.0;
    for (int i = 0; i < fi; ++i) f *= 0.5623413251903491;
    double s, c;
    sincos_d((double)pos * (double)(float)f, s, c);
    p.TAB[idx * 2 + 0] = (float)c;
    p.TAB[idx * 2 + 1] = (float)s;
  }
}

__device__ void phase0(const Params& p, char* lds) {
  const int total = p.total_tiles + 192 + 1;
  for (int u = blockIdx.x; u < total; u += gridDim.x) {
    if (u < p.total_tiles) {
      int j = 0;
#pragma unroll 1
      for (int q = 1; q < p.njobs; ++q) if (u >= p.jobs[q].tstart) j = q;
      convert_tile(p.jobs[j], u - p.jobs[j].tstart, lds);
    } else if (u < p.total_tiles + 192) {
      mod_unit(p, u - p.total_tiles, lds);
    } else {
      tab_unit(p);
    }
  }
}

DI void norm_mod_phase(const float* __restrict__ xl, const float* __restrict__ xc, const float* __restrict__ gain,
                               const float* __restrict__ mod, int shift_i, int scale_i, bf16_t* __restrict__ H, int ntok) {
  const int lane = threadIdx.x & 63;
  const int wg = blockIdx.x * 8 + (threadIdx.x >> 6), nw = gridDim.x * 8;
  for (int t = wg; t < ntok; t += nw) {
    const float* row = t < NL ? xl + (size_t)t * 1024 : xc + (size_t)(t - NL) * 1024;
    float4 v[4];
    float ss = 0.f;
#pragma unroll
    for (int i = 0; i < 4; ++i) {
      v[i] = *(const float4*)(row + (lane + 64 * i) * 4);
      ss += v[i].x * v[i].x + v[i].y * v[i].y + v[i].z * v[i].z + v[i].w * v[i].w;
    }
    ss = wave_sum(ss);
    const float rstd = rsqrtf(ss * (1.f / 1024.f) + 1e-6f);
    const int bp = t < NL ? (t >> 12) : 8;
    const float* sh = mod + (bp * 6 + shift_i) * 1024;
    const float* sc = mod + (bp * 6 + scale_i) * 1024;
#pragma unroll
    for (int i = 0; i < 4; ++i) {
      const int c = (lane + 64 * i) * 4;
      const float4 g = *(const float4*)(gain + c), s4 = *(const float4*)(sh + c), c4 = *(const float4*)(sc + c);
      store_bf4(H + (size_t)t * 1024 + c,
                v[i].x * rstd * g.x * (1.f + c4.x) + s4.x, v[i].y * rstd * g.y * (1.f + c4.y) + s4.y,
                v[i].z * rstd * g.z * (1.f + c4.z) + s4.z, v[i].w * rstd * g.w * (1.f + c4.w) + s4.w);
    }
  }
}

__device__ void final_norm_phase(const Params& p) {
  const int lane = threadIdx.x & 63;
  const int wg = blockIdx.x * 8 + (threadIdx.x >> 6), nw = gridDim.x * 8;
  for (int t = wg; t < NL; t += nw) {
    float* row = p.out + (size_t)t * 1024;
    float4 v[4];
    float ss = 0.f;
#pragma unroll
    for (int i = 0; i < 4; ++i) {
      v[i] = *(const float4*)(row + (lane + 64 * i) * 4);
      ss += v[i].x * v[i].x + v[i].y * v[i].y + v[i].z * v[i].z + v[i].w * v[i].w;
    }
    ss = wave_sum(ss);
    const float rstd = rsqrtf(ss * (1.f / 1024.f) + 1e-6f);
#pragma unroll
    for (int i = 0; i < 4; ++i) {
      const int c = (lane + 64 * i) * 4;
      const float4 g = *(const float4*)(p.final_norm + c);
      *(float4*)(row + c) = make_float4(v[i].x * rstd * g.x, v[i].y * rstd * g.y, v[i].z * rstd * g.z, v[i].w * rstd * g.w);
    }
  }
}

__device__ void phase_mix(const Params& p) {
  const int lane = threadIdx.x & 63;
  const int wg = blockIdx.x * 8 + (threadIdx.x >> 6), nw = gridDim.x * 8;
  for (int t = wg; t < NT; t += nw) {
#pragma unroll
    for (int i = 0; i < 2; ++i) {
      const int c = lane * 8 + 512 * i;
      const uint4 own = *(const uint4*)(p.Hd + (size_t)t * 1024 + c);
      int nb; bool valid;
      if (t < NL) {
        const int s = t & 4095, col = s & 63, rw = s >> 6, qd = c >> 8;
        if (qd == 0) { valid = col > 0; nb = t - 1; }
        else if (qd == 1) { valid = col < 63; nb = t + 1; }
        else if (qd == 2) { valid = rw > 0; nb = t - 64; }
        else { valid = rw < 63; nb = t + 64; }
      } else {
        const int s = (t - NL) & 255;
        if (c < 512) { valid = s > 0; nb = t - 1; }
        else { valid = s < 255; nb = t + 1; }
      }
      uint4 nv = make_uint4(0, 0, 0, 0);
      if (valid) nv = *(const uint4*)(p.Hd + (size_t)nb * 1024 + c);
#pragma unroll
      for (int j = 0; j < 3; ++j) {
        const int mi = j == 0 ? 0 : j == 1 ? 2 : 3;
        const float4 m0 = *(const float4*)(p.mu + mi * 1024 + c), m1 = *(const float4*)(p.mu + mi * 1024 + c + 4);
        uint4 o;
        o.x = lerp2(own.x, nv.x, m0.x, m0.y); o.y = lerp2(own.y, nv.y, m0.z, m0.w);
        o.z = lerp2(own.z, nv.z, m1.x, m1.y); o.w = lerp2(own.w, nv.w, m1.z, m1.w);
        *(uint4*)(p.S[3 + j] + (size_t)t * 1024 + c) = o;
      }
    }
  }
}

__device__ void phase_proj(const Params& p, char* lds) {
  const int lane = threadIdx.x & 63, wave = threadIdx.x >> 6;
  constexpr int NLORA = (NT / 256) * 3, NRKV = (NT / 256) * 12;
  for (int u = blockIdx.x; u < NLORA; u += gridDim.x) {
    {
      const int wt = wave & 3, wf = wave >> 2, lr = lane & 15, lq = lane >> 4;
      const int mt = u / 3, nt = 24 + u % 3;
      const int mi = nt == 24 ? 5 : nt == 25 ? 1 : 4;
      f32x4 acc[4][4];
      gemm_tile<true>(p.Hd, 1024, p.Wcat, 1024, 1024, mt * 256, nt * 128, lds, acc, p.mu + mi * 1024);
#pragma unroll
      for (int pp = 0; pp < 2; ++pp)
#pragma unroll
        for (int ti = 0; ti < 4; ++ti) {
          const int t = mt * 256 + wt * 64 + ti * 16 + lr;
          const int fl = wf * 64 + pp * 32 + lq * 8;
          f32x4 a = acc[2 * pp][ti], b = acc[2 * pp + 1][ti];
          if (nt == 24) {
#pragma unroll
            for (int j = 0; j < 4; ++j) { a[j] = sigmoidf_(a[j]); b[j] = sigmoidf_(b[j]); }
            store_bf8(p.L1 + (size_t)t * 384 + fl, a, b);
          } else if (nt == 25) {
#pragma unroll
            for (int j = 0; j < 4; ++j) { a[j] = tanhf_(a[j]); b[j] = tanhf_(b[j]); }
            store_bf8(p.L1 + (size_t)t * 384 + 128 + fl, a, b);
          } else {
            store_bf8(p.L1 + (size_t)t * 384 + 256 + fl, a, b);
          }
        }
    }
  }
  for (int v0 = blockIdx.x; v0 < NRKV; v0 += gridDim.x) {
    {
      const int wr = wave >> 2, wc = wave & 3;
      f32x4 acc[2][2][4][2];
      { const int mt0 = v0 / 12, rem0 = v0 % 12, j0 = rem0 >> 2, nt0 = rem0 & 3;
        gemm256_tile<true>(p.Wcat + (size_t)j0 * 1024 * 1024, p.S[3 + j0], 1024, nt0 * 256, mt0 * 256, lds, acc); }
      int lane_o = threadIdx.x & 63; asm volatile("" : "+v"(lane_o));
      int v = v0; asm volatile("" : "+s"(v));
      const int mt = v / 12, rem = v % 12, j = rem >> 2, nt = rem & 3;
      const int fr = lane_o & 15, fq = lane_o >> 4;
#pragma unroll
      for (int bj = 0; bj < 2; ++bj)
#pragma unroll
        for (int n = 0; n < 2; ++n) {
          const int t = mt * 256 + bj * 128 + wc * 32 + n * 16 + fr;
#pragma unroll
          for (int ai = 0; ai < 2; ++ai) {
            const int fh = nt * 256 + ai * 128 + wr * 64;
            if (j == 1) {
              f32x4 a[2], b[2];
              float ss = 0.f;
#pragma unroll
              for (int mp = 0; mp < 2; ++mp) {
                const int f = fh + mp * 32 + fq * 8;
                const float4 kkl = *(const float4*)(p.k_k + f), kkh = *(const float4*)(p.k_k + f + 4);
                a[mp] = acc[ai][bj][2 * mp][n]; b[mp] = acc[ai][bj][2 * mp + 1][n];
                a[mp][0] *= kkl.x; a[mp][1] *= kkl.y; a[mp][2] *= kkl.z; a[mp][3] *= kkl.w;
                b[mp][0] *= kkh.x; b[mp][1] *= kkh.y; b[mp][2] *= kkh.z; b[mp][3] *= kkh.w;
#pragma unroll
                for (int e2 = 0; e2 < 4; ++e2) ss += a[mp][e2] * a[mp][e2] + b[mp][e2] * b[mp][e2];
              }
              ss += __shfl_xor(ss, 16); ss += __shfl_xor(ss, 32);
              const float kinv = rsqrtf(ss + 1e-12f);
#pragma unroll
              for (int mp = 0; mp < 2; ++mp) {
#pragma unroll
                for (int e2 = 0; e2 < 4; ++e2) { a[mp][e2] *= kinv; b[mp][e2] *= kinv; }
                store_bf8(p.S[2] + (size_t)t * 1024 + fh + mp * 32 + fq * 8, a[mp], b[mp]);
              }
              if (fq == 0) p.NRM[(size_t)(fh >> 6) * NT + t] = sqrtf(ss + 1e-12f);
            } else {
              bf16_t* dst = j == 0 ? p.S[0] : p.S[1];
#pragma unroll
              for (int mp = 0; mp < 2; ++mp)
                store_bf8(dst + (size_t)t * 1024 + fh + mp * 32 + fq * 8, acc[ai][bj][2 * mp][n], acc[ai][bj][2 * mp + 1][n]);
            }
          }
        }
    }
  }
}

__device__ void phase_prep(const Params& p, char* lds) {
  const int lane = threadIdx.x & 63, wave = threadIdx.x >> 6;
  const int wt = wave & 3, wf = wave >> 2, lr = lane & 15, lq = lane >> 4;
  const int total = (NT / 256) * 8;
  for (int u = blockIdx.x; u < total; u += gridDim.x) {
    const int mt = u >> 3, nt = u & 7;
    const int tok0 = mt * 256, f0 = nt * 128;
    f32x4 acc[4][4];
    uint4 afp[2][4];
    gemm_tile<false>(p.L1 + 256, 384, p.L2w + 0 * 65536, 64, 64, tok0, f0, lds, acc, nullptr);
#pragma unroll
    for (int pp = 0; pp < 2; ++pp) {
      const int f = f0 + wf * 64 + pp * 32 + lq * 8;
      const float4 a0l = *(const float4*)(p.a0 + f), a0h = *(const float4*)(p.a0 + f + 4);
#pragma unroll
      for (int ti = 0; ti < 4; ++ti) {
        const int t = tok0 + wt * 64 + ti * 16 + lr;
        f32x4 a = acc[2 * pp][ti], b = acc[2 * pp + 1][ti];
        a[0] = sigmoidf_(a[0] + a0l.x); a[1] = sigmoidf_(a[1] + a0l.y); a[2] = sigmoidf_(a[2] + a0l.z); a[3] = sigmoidf_(a[3] + a0l.w);
        b[0] = sigmoidf_(b[0] + a0h.x); b[1] = sigmoidf_(b[1] + a0h.y); b[2] = sigmoidf_(b[2] + a0h.z); b[3] = sigmoidf_(b[3] + a0h.w);
        uint4 o; o.x = pack2(a[0], a[1]); o.y = pack2(a[2], a[3]); o.z = pack2(b[0], b[1]); o.w = pack2(b[2], b[3]);
        afp[pp][ti] = o;
        *(uint4*)(p.S[3] + (size_t)t * 1024 + f) = o;
      }
    }
    gemm_tile<false>(p.L1 + 320, 384, p.L2w + 1 * 65536, 64, 64, tok0, f0, lds, acc, nullptr);
#pragma unroll
    for (int ti = 0; ti < 4; ++ti) {
      const int t = tok0 + wt * 64 + ti * 16 + lr;
      float bon = 0.f;
      const float nrm = p.NRM[(size_t)(nt * 2 + wf) * NT + t];
#pragma unroll
      for (int pp = 0; pp < 2; ++pp) {
        const int f = f0 + wf * 64 + pp * 32 + lq * 8;
        const float4 a0l = *(const float4*)(p.a0 + 1024 + f), a0h = *(const float4*)(p.a0 + 1024 + f + 4);
        const float4 rkl = *(const float4*)(p.r_k + f), rkh = *(const float4*)(p.r_k + f + 4);
        const float4 kal = *(const float4*)(p.k_a + f), kah = *(const float4*)(p.k_a + f + 4);
        const float4 kkl = *(const float4*)(p.k_k + f), kkh = *(const float4*)(p.k_k + f + 4);
        const float rk8[8] = {rkl.x, rkl.y, rkl.z, rkl.w, rkh.x, rkh.y, rkh.z, rkh.w};
        const float ka8[8] = {kal.x, kal.y, kal.z, kal.w, kah.x, kah.y, kah.z, kah.w};
        const float kk8[8] = {kkl.x, kkl.y, kkl.z, kkl.w, kkh.x, kkh.y, kkh.z, kkh.w};
        f32x4 a = acc[2 * pp][ti], b = acc[2 * pp + 1][ti];
        a[0] = sigmoidf_(a[0] + a0l.x); a[1] = sigmoidf_(a[1] + a0l.y); a[2] = sigmoidf_(a[2] + a0l.z); a[3] = sigmoidf_(a[3] + a0l.w);
        b[0] = sigmoidf_(b[0] + a0h.x); b[1] = sigmoidf_(b[1] + a0h.y); b[2] = sigmoidf_(b[2] + a0h.z); b[3] = sigmoidf_(b[3] + a0h.w);
        store_bf8(p.S[4] + (size_t)t * 1024 + f, a, b);
        const float ab8[8] = {a[0], a[1], a[2], a[3], b[0], b[1], b[2], b[3]};
        float af8[8], r8[8], k8[8];
        unpack_bf8(afp[pp][ti], af8);
        unpack_bf8(*(const uint4*)(p.S[0] + (size_t)t * 1024 + f), r8);
        unpack_bf8(*(const uint4*)(p.S[2] + (size_t)t * 1024 + f), k8);
#pragma unroll
        for (int e2 = 0; e2 < 8; ++e2) {
          const float k = k8[e2] * nrm / kk8[e2];
          bon += r8[e2] * k * rk8[e2] * (2.f + (ab8[e2] + af8[e2] - 2.f) * ka8[e2]);
        }
      }
      bon += __shfl_xor(bon, 16); bon += __shfl_xor(bon, 32);
      if (lq == 0) p.BON[(size_t)(nt * 2 + wf) * NT + t] = bon;
    }
#pragma unroll 1
    for (int dr = 0; dr < 2; ++dr) {
      gemm_tile<false>(p.L1 + 128 + dr * 64, 384, p.L2w + (2 + dr) * 65536, 64, 64, tok0, f0, lds, acc, nullptr);
      bf16_t* dst = dr ? p.S[5] : p.Hd;
#pragma unroll
      for (int pp = 0; pp < 2; ++pp) {
        const int f = f0 + wf * 64 + pp * 32 + lq * 8;
        const float4 w0l = *(const float4*)(p.w0 + dr * 1024 + f), w0h = *(const float4*)(p.w0 + dr * 1024 + f + 4);
#pragma unroll
        for (int ti = 0; ti < 4; ++ti) {
          const int t = tok0 + wt * 64 + ti * 16 + lr;
          f32x4 a = acc[2 * pp][ti], b = acc[2 * pp + 1][ti];
          a[0] = -0.60653066f * sigmoidf_(a[0] + w0l.x); a[1] = -0.60653066f * sigmoidf_(a[1] + w0l.y);
          a[2] = -0.60653066f * sigmoidf_(a[2] + w0l.z); a[3] = -0.60653066f * sigmoidf_(a[3] + w0l.w);
          b[0] = -0.60653066f * sigmoidf_(b[0] + w0h.x); b[1] = -0.60653066f * sigmoidf_(b[1] + w0h.y);
          b[2] = -0.60653066f * sigmoidf_(b[2] + w0h.z); b[3] = -0.60653066f * sigmoidf_(b[3] + w0h.w);
          store_bf8(dst + (size_t)t * 1024 + f, a, b);
        }
      }
    }
  }
}

typedef short s16x4 __attribute__((ext_vector_type(4)));
#define MFMA16K(a, b, c) __builtin_amdgcn_mfma_f32_16x16x16bf16_1k((a), (b), (c), 0, 0, 0)
DI s16x4 pack4(const f32x4& x) { const uint2 u = make_uint2(pack2(x[0], x[1]), pack2(x[2], x[3])); return __builtin_bit_cast(s16x4, u); }
DI bf16x8 pack8(const f32x4& a, const f32x4& b) { const uint4 u = make_uint4(pack2(a[0], a[1]), pack2(a[2], a[3]), pack2(b[0], b[1]), pack2(b[2], b[3])); return __builtin_bit_cast(bf16x8, u); }
constexpr int SC_KK = 0, SC_R = 2304, SC_B = 4608, SC_K = 6912, SC_BT = 9216, SC_KT = 12288, SC_VT = 15360, SC_CL = 18432, SC_CHUNK = 18688, SC_GROUP = 2 * SC_CHUNK, SC_YBUF = 2 * SC_GROUP;

#define KEEP8(x) asm volatile("" :: "v"(x))
#define KEEP4(x) asm volatile("" :: "v"(x))
DI void scan_chunk(const char* cb, float* yb, f32x4 (&ST)[4], int vb, int c, int q) {
  const f32x4 z = {0.f, 0.f, 0.f, 0.f};
  bf16x8 fB[2], fK[2], fKK[2], fR[2];
#pragma unroll
  for (int ks = 0; ks < 2; ++ks) {
    fB[ks] = *(const bf16x8*)(cb + SC_B + c * 144 + ks * 64 + q * 16);
    fK[ks] = *(const bf16x8*)(cb + SC_K + c * 144 + ks * 64 + q * 16);
    fKK[ks] = *(const bf16x8*)(cb + SC_KK + c * 144 + ks * 64 + q * 16);
    fR[ks] = *(const bf16x8*)(cb + SC_R + c * 144 + ks * 64 + q * 16);
  }
  f32x4 Abk = MFMA16(fB[0], fKK[0], z);  Abk = MFMA16(fB[1], fKK[1], Abk);
  f32x4 AbkT = MFMA16(fKK[0], fB[0], z); AbkT = MFMA16(fKK[1], fB[1], AbkT);
  f32x4 Akk = MFMA16(fK[0], fKK[0], z);  Akk = MFMA16(fK[1], fKK[1], Akk);
  f32x4 Abr = MFMA16(fB[0], fR[0], z);   Abr = MFMA16(fB[1], fR[1], Abr);
  f32x4 Akr = MFMA16(fK[0], fR[0], z);   Akr = MFMA16(fK[1], fR[1], Akr);
  KEEP8(fB[0]); KEEP8(fB[1]); KEEP8(fK[0]); KEEP8(fK[1]); KEEP8(fKK[0]); KEEP8(fKK[1]); KEEP8(fR[0]); KEEP8(fR[1]);
  f32x4 P;
#pragma unroll
  for (int j = 0; j < 4; ++j) {
    const int rr = 4 * q + j;
    Abk[j] = rr < c ? Abk[j] : 0.f;  Akk[j] = rr < c ? Akk[j] : 0.f;
    Abr[j] = rr <= c ? Abr[j] : 0.f; Akr[j] = rr <= c ? Akr[j] : 0.f;
    AbkT[j] = c < rr ? AbkT[j] : 0.f;
    P[j] = (rr == c ? 1.f : 0.f) - Abk[j];
  }
  const s16x4 bN = pack4(Abk), bNT = pack4(AbkT);
  const f32x4 N2 = MFMA16K(bNT, bN, z), N2T = MFMA16K(bN, bNT, z);
  KEEP4(bN); KEEP4(bNT);
  const s16x4 bN2 = pack4(N2), bN2T = pack4(N2T);
  const f32x4 N4 = MFMA16K(bN2T, bN2, z), N4T = MFMA16K(bN2, bN2T, z);
  KEEP4(bN2); KEEP4(bN2T);
  const s16x4 bN4 = pack4(N4), bN4T = pack4(N4T);
  const f32x4 N8T = MFMA16K(bN4, bN4T, z);
  KEEP4(bN4); KEEP4(bN4T);
  const s16x4 bN8T = pack4(N8T);
  { const s16x4 pp_ = pack4(P); P = MFMA16K(bN2T, pp_, P); KEEP4(pp_); KEEP4(bN2T); }
  { const s16x4 pp_ = pack4(P); P = MFMA16K(bN4T, pp_, P); KEEP4(pp_); KEEP4(bN4T); }
  { const s16x4 pp_ = pack4(P); P = MFMA16K(bN8T, pp_, P); KEEP4(pp_); KEEP4(bN8T); }
  const s16x4 bT = pack4(P);
  bf16x8 sf[2], kkp[2], rp[2];
#pragma unroll
  for (int i = 0; i < 2; ++i) {
    sf[i] = pack8(ST[2 * i], ST[2 * i + 1]);
    const uint2 klo = *(const uint2*)(cb + SC_KK + c * 144 + (32 * i + 4 * q) * 2), khi = *(const uint2*)(cb + SC_KK + c * 144 + (32 * i + 16 + 4 * q) * 2);
    const uint2 rlo = *(const uint2*)(cb + SC_R + c * 144 + (32 * i + 4 * q) * 2), rhi = *(const uint2*)(cb + SC_R + c * 144 + (32 * i + 16 + 4 * q) * 2);
    kkp[i] = __builtin_bit_cast(bf16x8, make_uint4(klo.x, klo.y, khi.x, khi.y));
    rp[i] = __builtin_bit_cast(bf16x8, make_uint4(rlo.x, rlo.y, rhi.x, rhi.y));
  }
  f32x4 XT = MFMA16(kkp[0], sf[0], z); XT = MFMA16(kkp[1], sf[1], XT);
  f32x4 YT = MFMA16(rp[0], sf[0], z);  YT = MFMA16(rp[1], sf[1], YT);
  KEEP8(kkp[0]); KEEP8(kkp[1]); KEEP8(rp[0]); KEEP8(rp[1]); KEEP8(sf[0]); KEEP8(sf[1]);
  const s16x4 vf = *(const s16x4*)(cb + SC_VT + (vb * 16 + c) * 48 + q * 8);
  const s16x4 pAkk = pack4(Akk);
  XT = MFMA16K(pAkk, vf, XT); KEEP4(pAkk);
  const s16x4 pXT = pack4(XT);
  f32x4 UT = MFMA16K(bT, pXT, z); KEEP4(pXT); KEEP4(bT);
#pragma unroll
  for (int j = 0; j < 4; ++j) UT[j] = -UT[j];
  const s16x4 bU = pack4(UT);
  const s16x4 pAbr = pack4(Abr), pAkr = pack4(Akr);
  YT = MFMA16K(pAbr, bU, YT);
  YT = MFMA16K(pAkr, vf, YT); KEEP4(pAbr); KEEP4(pAkr);
#pragma unroll
  for (int j = 0; j < 4; ++j) yb[(4 * q + j) * 64 + vb * 16 + c] = YT[j];
#pragma unroll
  for (int kt = 0; kt < 4; ++kt) {
    const s16x4 bh = *(const s16x4*)(cb + SC_BT + (16 * kt + c) * 48 + q * 8);
    const s16x4 kh = *(const s16x4*)(cb + SC_KT + (16 * kt + c) * 48 + q * 8);
    f32x4 s = MFMA16K(bh, bU, ST[kt]);
    s = MFMA16K(kh, vf, s); KEEP4(bh); KEEP4(kh);
    const float4 cl = *(const float4*)(cb + SC_CL + (16 * kt + 4 * q) * 4);
    s[0] *= cl.x; s[1] *= cl.y; s[2] *= cl.z; s[3] *= cl.w;
    ST[kt] = s;
  }
  KEEP4(bU); KEEP4(vf);
}

__device__ void phase_scan(const Params& p, char* lds, bool dupout = false) {
  float* ybuf = (float*)(lds + SC_YBUF);
  const int tid = threadIdx.x, lane = tid & 63, wave = tid >> 6;
  const bool loader = tid >= 256;
  const int lt = tid & 255, ltk = lt >> 3, lch = (lt & 7) * 8;
  const int lcc = (wave >> 1) & 1, lchh = wave & 1, ltok = lane >> 2, loct = lane & 3, ch0 = lchh * 32 + loct * 8;
  const int vb = wave & 3, cc_ = lane & 15, qq = lane >> 4;
  constexpr int NG = NKEY / 32;
  for (int unit = blockIdx.x; unit < 256; unit += gridDim.x) {
    const int dir = unit & 1, h = (unit >> 1) & 15, b = unit >> 5;
    const bf16_t* Rp = p.S[0]; const bf16_t* Vp = p.S[1]; const bf16_t* Kp = p.S[2];
    bf16_t* Ap = dir ? p.S[4] : p.S[3];
    const bf16_t* Lp = dir ? p.S[5] : p.Hd;
    auto tok_of = [&](int i) -> int {
      if (i < 256) return NL + b * 256 + (dir ? 255 - i : i);
      const int s = i - 256;
      return b * 4096 + (dir ? 4095 - s : s);
    };
    uint4 raw[5];
    float nrmv = 0.f;
    float rkk[8], kac[8];
    f32x4 ST[4];
#pragma unroll
    for (int i = 0; i < 4; ++i) ST[i] = f32x4{0.f, 0.f, 0.f, 0.f};
    if (loader) {
#pragma unroll
      for (int j = 0; j < 8; ++j) { rkk[j] = 1.f / p.k_k[h * 64 + ch0 + j]; kac[j] = p.k_a[h * 64 + ch0 + j]; }
    }
    auto issue = [&](int g) {
      const int t = tok_of(g * 32 + lcc * 16 + ltok);
      const size_t off = (size_t)t * 1024 + h * 64 + ch0;
      raw[0] = *(const uint4*)(Rp + off); raw[1] = *(const uint4*)(Vp + off); raw[2] = *(const uint4*)(Kp + off);
      raw[3] = *(const uint4*)(Ap + off); raw[4] = *(const uint4*)(Lp + off);
      nrmv = p.NRM[(size_t)h * NT + t];
    };
    auto process = [&](int stage) {
      float r8[8], kk8[8], a8[8], l8[8], L[8];
      unpack_bf8(raw[0], r8); unpack_bf8(raw[2], kk8); unpack_bf8(raw[3], a8); unpack_bf8(raw[4], l8);
#pragma unroll
      for (int j = 0; j < 8; ++j) L[j] = l8[j];
#pragma unroll
      for (int d = 4; d < 64; d <<= 1) {
#pragma unroll
        for (int j = 0; j < 8; ++j) { const float o = __shfl_up(L[j], d); if (lane >= d) L[j] += o; }
      }
      float okk[8], orr[8], ob[8], ok[8], cend[8];
#pragma unroll
      for (int j = 0; j < 8; ++j) {
        const float cc = __expf(L[j]), cprev = __expf(L[j] - l8[j]), cinv = __expf(-L[j]);
        const float k = kk8[j] * nrmv * rkk[j];
        const float kd = k * (1.f + (a8[j] - 1.f) * kac[j]);
        okk[j] = kk8[j] * cprev; orr[j] = r8[j] * cc; ob[j] = kk8[j] * a8[j] * cinv; ok[j] = kd * cinv; cend[j] = cc;
      }
      char* cb = lds + stage * SC_GROUP + lcc * SC_CHUNK;
      uint4 o;
      o = make_uint4(pack2(okk[0], okk[1]), pack2(okk[2], okk[3]), pack2(okk[4], okk[5]), pack2(okk[6], okk[7])); *(uint4*)(cb + SC_KK + ltok * 144 + ch0 * 2) = o;
      o = make_uint4(pack2(orr[0], orr[1]), pack2(orr[2], orr[3]), pack2(orr[4], orr[5]), pack2(orr[6], orr[7])); *(uint4*)(cb + SC_R + ltok * 144 + ch0 * 2) = o;
      const uint4 obp = make_uint4(pack2(ob[0], ob[1]), pack2(ob[2], ob[3]), pack2(ob[4], ob[5]), pack2(ob[6], ob[7])); *(uint4*)(cb + SC_B + ltok * 144 + ch0 * 2) = obp;
      const uint4 okp = make_uint4(pack2(ok[0], ok[1]), pack2(ok[2], ok[3]), pack2(ok[4], ok[5]), pack2(ok[6], ok[7])); *(uint4*)(cb + SC_K + ltok * 144 + ch0 * 2) = okp;
      const unsigned bw[4] = {obp.x, obp.y, obp.z, obp.w}, kw[4] = {okp.x, okp.y, okp.z, okp.w}, vw[4] = {raw[1].x, raw[1].y, raw[1].z, raw[1].w};
#pragma unroll
      for (int j = 0; j < 8; ++j) {
        const int sh = (j & 1) * 16;
        *(bf16_t*)(cb + SC_BT + (ch0 + j) * 48 + ltok * 2) = (bf16_t)((bw[j >> 1] >> sh) & 0xffffu);
        *(bf16_t*)(cb + SC_KT + (ch0 + j) * 48 + ltok * 2) = (bf16_t)((kw[j >> 1] >> sh) & 0xffffu);
        *(bf16_t*)(cb + SC_VT + (ch0 + j) * 48 + ltok * 2) = (bf16_t)((vw[j >> 1] >> sh) & 0xffffu);
      }
      if (ltok == 15) {
        *(float4*)(cb + SC_CL + ch0 * 4) = make_float4(cend[0], cend[1], cend[2], cend[3]);
        *(float4*)(cb + SC_CL + ch0 * 4 + 16) = make_float4(cend[4], cend[5], cend[6], cend[7]);
      }
    };
    auto yout = [&](int g) {
      const float* yb = ybuf + (g & 1) * 2048 + ltk * 64 + lch;
      const float4 y0 = *(const float4*)yb, y1 = *(const float4*)(yb + 4);
      const int t = tok_of(g * 32 + ltk);
      uint4 o;
      o.x = pack2(y0.x, y0.y); o.y = pack2(y0.z, y0.w); o.z = pack2(y1.x, y1.y); o.w = pack2(y1.z, y1.w);
      *(uint4*)((dupout ? p.S[0] : Ap) + (size_t)t * 1024 + h * 64 + lch) = o;
    };
    __syncthreads();
    if (loader) { issue(0); process(0); issue(1); }
    __syncthreads();
    for (int g = 0; g < NG; ++g) {
      if (loader) {
        if (g >= 1) yout(g - 1);
        if (g + 1 < NG) { process((g + 1) & 1); if (g + 2 < NG) issue(g + 2); }
      } else {
        const char* gb = lds + (g & 1) * SC_GROUP;
        float* yb = ybuf + (g & 1) * 2048;
        scan_chunk(gb, yb, ST, vb, cc_, qq);
        scan_chunk(gb + SC_CHUNK, yb + 16 * 64, ST, vb, cc_, qq);
      }
      __syncthreads();
    }
    if (loader) yout(NG - 1);
    __syncthreads();
  }
}

__device__ void phase_readout(const Params& p, char* lds) {
  const int lane = threadIdx.x & 63, wave = threadIdx.x >> 6;
  const int wt = wave & 3, wf = wave >> 2, lr = lane & 15, lq = lane >> 4;
  const int total = (NT / 256) * 8;
  for (int u = blockIdx.x; u < total; u += gridDim.x) {
    const int mt = u >> 3, nt = u & 7;
    const int tok0 = mt * 256, f0 = nt * 128;
    f32x4 g[4][4];
    gemm_tile<false>(p.L1, 384, p.g2T, 128, 128, tok0, f0, lds, g, nullptr);
    const int head = nt * 2 + wf;
#pragma unroll
    for (int ti = 0; ti < 4; ++ti) {
      const int t = tok0 + wt * 64 + ti * 16 + lr;
      float y[2][8];
      float sum = 0.f;
#pragma unroll
      for (int pp = 0; pp < 2; ++pp) {
        const int f = f0 + wf * 64 + pp * 32 + lq * 8;
        float ya[8], yb[8];
        unpack_bf8(*(const uint4*)(p.S[3] + (size_t)t * 1024 + f), ya);
        unpack_bf8(*(const uint4*)(p.S[4] + (size_t)t * 1024 + f), yb);
#pragma unroll
        for (int e2 = 0; e2 < 8; ++e2) { y[pp][e2] = ya[e2] + yb[e2]; sum += y[pp][e2]; }
      }
      sum += __shfl_xor(sum, 16); sum += __shfl_xor(sum, 32);
      const float mean = sum * (1.f / 64.f);
      float vs = 0.f;
#pragma unroll
      for (int pp = 0; pp < 2; ++pp)
#pragma unroll
        for (int e2 = 0; e2 < 8; ++e2) { const float d = y[pp][e2] - mean; vs += d * d; }
      vs += __shfl_xor(vs, 16); vs += __shfl_xor(vs, 32);
      const float rstd = rsqrtf(vs * (1.f / 64.f) + 64e-5f);
      const float bon = p.BON[(size_t)head * NT + t];
#pragma unroll
      for (int pp = 0; pp < 2; ++pp) {
        const int f = f0 + wf * 64 + pp * 32 + lq * 8;
        const float4 lwl = *(const float4*)(p.ln_w + f), lwh = *(const float4*)(p.ln_w + f + 4);
        const float4 lbl = *(const float4*)(p.ln_b + f), lbh = *(const float4*)(p.ln_b + f + 4);
        const float lw8[8] = {lwl.x, lwl.y, lwl.z, lwl.w, lwh.x, lwh.y, lwh.z, lwh.w};
        const float lb8[8] = {lbl.x, lbl.y, lbl.z, lbl.w, lbh.x, lbh.y, lbh.z, lbh.w};
        float v8[8];
        unpack_bf8(*(const uint4*)(p.S[1] + (size_t)t * 1024 + f), v8);
        f32x4 oa, ob;
#pragma unroll
        for (int j = 0; j < 4; ++j) {
          oa[j] = ((y[pp][j] - mean) * rstd * lw8[j] + lb8[j] + bon * v8[j]) * g[2 * pp][ti][j];
          ob[j] = ((y[pp][4 + j] - mean) * rstd * lw8[4 + j] + lb8[4 + j] + bon * v8[4 + j]) * g[2 * pp + 1][ti][j];
        }
        store_bf8(p.S[0] + (size_t)t * 1024 + f, oa, ob);
      }
    }
  }
}

DI void phase_gemm_resid(const Params& p, char* lds, const bf16_t* A, const bf16_t* W, int K, int ntm,
                                 const float* xin_l, const float* xin_c, const float* gate, float* dummy_out = nullptr) {
  const int lane = threadIdx.x & 63, wave = threadIdx.x >> 6;
  const int wr = wave >> 2, wc = wave & 3;
  const int total = ntm * 4;
  for (int u = blockIdx.x; u < total; u += gridDim.x) {
    const int mt = u >> 2, nt = u & 3;
    f32x4 acc[2][2][4][2];
    gemm256_tile<true>(W, A, K, nt * 256, mt * 256, lds, acc);
    int lane_o = threadIdx.x & 63; asm volatile("" : "+v"(lane_o));
    const int fr = lane_o & 15, fq = lane_o >> 4;
#pragma unroll
    for (int bj = 0; bj < 2; ++bj)
#pragma unroll
      for (int n = 0; n < 2; ++n) {
        const int t = mt * 256 + bj * 128 + wc * 32 + n * 16 + fr;
        const int bp = t < NL ? (t >> 12) : 8;
        const float* xi = t < NL ? xin_l + (size_t)t * 1024 : xin_c + (size_t)(t - NL) * 1024;
        float* xo = dummy_out ? dummy_out + (size_t)t * 1024 : (t < NL ? p.out + (size_t)t * 1024 : p.XC + (size_t)(t - NL) * 1024);
#pragma unroll
        for (int ai = 0; ai < 2; ++ai)
#pragma unroll
          for (int mp = 0; mp < 2; ++mp) {
            const int f = nt * 256 + ai * 128 + wr * 64 + mp * 32 + fq * 8;
            const float4 g0 = *(const float4*)(gate + bp * 6144 + f), g1 = *(const float4*)(gate + bp * 6144 + f + 4);
            const float4 x0 = *(const float4*)(xi + f), x1 = *(const float4*)(xi + f + 4);
            const f32x4 a = acc[ai][bj][2 * mp][n], b = acc[ai][bj][2 * mp + 1][n];
            *(float4*)(xo + f) = make_float4(x0.x + g0.x * a[0], x0.y + g0.y * a[1], x0.z + g0.z * a[2], x0.w + g0.w * a[3]);
            *(float4*)(xo + f + 4) = make_float4(x1.x + g1.x * b[0], x1.y + g1.y * b[1], x1.z + g1.z * b[2], x1.w + g1.w * b[3]);
          }
      }
  }
}

DI void phase_up(const Params& p, char* lds, const bf16_t* H, const bf16_t* W, bf16_t* U, int ntm) {
  const int lane = threadIdx.x & 63, wave = threadIdx.x >> 6;
  const int wr = wave >> 2, wc = wave & 3;
  const int total = ntm * 16;
  for (int u = blockIdx.x; u < total; u += gridDim.x) {
    const int mt = u >> 4, nt = u & 15;
    f32x4 acc[2][2][4][2];
    gemm256_tile<true>(W, H, 1024, nt * 256, mt * 256, lds, acc);
    int lane_o = threadIdx.x & 63; asm volatile("" : "+v"(lane_o));
    const int fr = lane_o & 15, fq = lane_o >> 4;
#pragma unroll
    for (int bj = 0; bj < 2; ++bj)
#pragma unroll
      for (int n = 0; n < 2; ++n) {
        const int t = mt * 256 + bj * 128 + wc * 32 + n * 16 + fr;
#pragma unroll
        for (int ai = 0; ai < 2; ++ai)
#pragma unroll
          for (int mp = 0; mp < 2; ++mp) {
            const int f = nt * 256 + ai * 128 + wr * 64 + mp * 32 + fq * 8;
            f32x4 a = acc[ai][bj][2 * mp][n], b = acc[ai][bj][2 * mp + 1][n];
#pragma unroll
            for (int j = 0; j < 4; ++j) { const float ra = fmaxf(a[j], 0.f), rb = fmaxf(b[j], 0.f); a[j] = ra * ra; b[j] = rb * rb; }
            store_bf8(U + (size_t)t * 4096 + f, a, b);
          }
      }
  }
}

__device__ void phase_qkv(const Params& p, char* lds) {
  const int lane = threadIdx.x & 63, wave = threadIdx.x >> 6;
  const int wr = wave >> 2, wc = wave & 3;
  const int total = (NT / 256) * 6;
  bf16_t* Q = p.S[0]; bf16_t* KA = p.S[1]; bf16_t* VT = p.S[2];
  for (int u = blockIdx.x; u < total; u += gridDim.x) {
    const int mt = u / 6, nt = u % 6;
    if (mt >= NL / 256 && nt < 4) continue;
    f32x4 acc[2][2][4][2];
    gemm256_tile<false>(p.wqkvT, p.S[5], 1024, nt * 256, mt * 256, lds, acc);
    int lane_o = threadIdx.x & 63; asm volatile("" : "+v"(lane_o));
    const int fr = lane_o & 15, fq = lane_o >> 4;
#pragma unroll
    for (int bj = 0; bj < 2; ++bj)
#pragma unroll
      for (int n = 0; n < 2; ++n) {
        const int t = mt * 256 + bj * 128 + wc * 32 + n * 16 + fr;
        const bool lat = t < NL;
        const int b = lat ? (t >> 12) : ((t - NL) >> 8);
        const int key = lat ? (t & 4095) : 4096 + ((t - NL) & 255);
#pragma unroll
        for (int ai = 0; ai < 2; ++ai) {
          const int hh = ai * 2 + wr;
          asm volatile("" ::: "memory");
          if (nt < 5) {
            float ss = 0.f;
#pragma unroll
            for (int m = 0; m < 4; ++m)
#pragma unroll
              for (int j = 0; j < 4; ++j) ss += acc[ai][bj][m][n][j] * acc[ai][bj][m][n][j];
            ss += __shfl_xor(ss, 16); ss += __shfl_xor(ss, 32);
            const float rstd = rsqrtf(ss * (1.f / 64.f) + 1e-6f);
            const float* gn = nt < 4 ? p.q_norm : p.k_norm;
            float v[4][4];
#pragma unroll
            for (int m = 0; m < 4; ++m) {
              const float4 g4 = *(const float4*)(gn + m * 16 + fq * 4);
              v[m][0] = acc[ai][bj][m][n][0] * rstd * g4.x; v[m][1] = acc[ai][bj][m][n][1] * rstd * g4.y;
              v[m][2] = acc[ai][bj][m][n][2] * rstd * g4.z; v[m][3] = acc[ai][bj][m][n][3] * rstd * g4.w;
            }
            if (lat) {
              const int s = t & 4095, rowp = s >> 6, colp = s & 63;
#pragma unroll
              for (int j = 0; j < 4; ++j) {
                const float2 cs0 = *(const float2*)(p.TAB + (rowp * 16 + fq * 4 + j) * 2);
                const float2 cs1 = *(const float2*)(p.TAB + (colp * 16 + fq * 4 + j) * 2);
                const float x1 = v[0][j], x2 = v[1][j], z1 = v[2][j], z2 = v[3][j];
                v[0][j] = x1 * cs0.x - x2 * cs0.y; v[1][j] = x2 * cs0.x + x1 * cs0.y;
                v[2][j] = z1 * cs1.x - z2 * cs1.y; v[3][j] = z2 * cs1.x + z1 * cs1.y;
              }
            }
            if (nt < 4) {
              const float qs = 0.125f * 1.4426950408889634f;
              const int head = nt * 4 + hh;
#pragma unroll
              for (int m = 0; m < 4; ++m)
                store_bf4(Q + (size_t)t * 1024 + head * 64 + m * 16 + fq * 4, v[m][0] * qs, v[m][1] * qs, v[m][2] * qs, v[m][3] * qs);
            } else {
#pragma unroll
              for (int m = 0; m < 4; ++m)
                store_bf4(KA + ((size_t)(b * 4 + hh) * NKEY + key) * 64 + m * 16 + fq * 4, v[m][0], v[m][1], v[m][2], v[m][3]);
            }
          } else {
#pragma unroll
            for (int m = 0; m < 4; ++m)
#pragma unroll
              for (int j = 0; j < 4; ++j) {
                const int d = m * 16 + fq * 4 + j;
                const unsigned pk = pack2(acc[ai][bj][m][n][j], 0.f);
                VT[((size_t)(b * 4 + hh) * 64 + d) * NKEY + key] = (bf16_t)(pk & 0xffffu);
              }
          }
        }
      }
  }
}

__device__ void phase_attn(const Params& p, char* lds) {
  const int tid = threadIdx.x, lane = tid & 63, wave = tid >> 6;
  const int l31 = lane & 31, lh = lane >> 5;
  const int srow = tid >> 3, sch = tid & 7;
  const bf16_t* Q = p.S[0]; const bf16_t* KA = p.S[1]; const bf16_t* VT = p.S[2]; bf16_t* O = p.S[3];
  float gq = 0.f, gk = 0.f;
  for (int i = 0; i < 64; ++i) { gq = fmaxf(gq, fabsf(p.q_norm[i])); gk = fmaxf(gk, fabsf(p.k_norm[i])); }
  const float M2 = 8.f * gq * gk * 1.4426950408889634f;
  constexpr int NKT = NKEY / 64;
  constexpr int AST = 2 * 64 * ROWB;
  for (int u = blockIdx.x; u < 2048; u += gridDim.x) {
    const int qb = u & 15, head = (u >> 4) & 15, b = u >> 8, kvh = head >> 2;
    const bf16_t* Kg = KA + (size_t)(b * 4 + kvh) * NKEY * 64;
    const bf16_t* Vg = VT + (size_t)(b * 4 + kvh) * 64 * NKEY;
    const int tq = b * 4096 + qb * 256 + wave * 32 + l31;
    bf16x8 qf[4];
#pragma unroll
    for (int s = 0; s < 4; ++s) qf[s] = *(const bf16x8*)(Q + (size_t)tq * 1024 + head * 64 + s * 16 + lh * 8);
    f32x16 o0, o1;
#pragma unroll
    for (int i = 0; i < 16; ++i) { o0[i] = 0.f; o1[i] = 0.f; }
    float lsum = 0.f;
    uint4 kreg, vreg;
    auto gload = [&](int kt) {
      kreg = *(const uint4*)(Kg + (size_t)(kt * 64 + srow) * 64 + sch * 8);
      vreg = *(const uint4*)(Vg + (size_t)srow * NKEY + kt * 64 + sch * 8);
    };
    auto lwrite = [&](int st) {
      *(uint4*)(lds + st * AST + srow * ROWB + sch * 16) = kreg;
      *(uint4*)(lds + st * AST + 64 * ROWB + srow * ROWB + sch * 16) = vreg;
    };
    gload(0);
    __syncthreads();
    lwrite(0);
    __syncthreads();
    for (int kt = 0; kt < NKT; ++kt) {
      if (kt + 1 < NKT) gload(kt + 1);
      const char* ksm = lds + (kt & 1) * AST;
      const char* vsm = ksm + 64 * ROWB;
      f32x16 sT[2];
#pragma unroll
      for (int k2 = 0; k2 < 2; ++k2) {
#pragma unroll
        for (int i = 0; i < 16; ++i) sT[k2][i] = -M2;
#pragma unroll
        for (int s = 0; s < 4; ++s) {
          const bf16x8 kf = *(const bf16x8*)(ksm + (k2 * 32 + l31) * ROWB + s * 32 + lh * 16);
          sT[k2] = MFMA32(kf, qf[s], sT[k2]);
        }
      }
#pragma unroll
      for (int k2 = 0; k2 < 2; ++k2)
#pragma unroll
        for (int i = 0; i < 16; ++i) { const float pv = __builtin_amdgcn_exp2f(sT[k2][i]); lsum += pv; sT[k2][i] = pv; }
#pragma unroll
      for (int k2 = 0; k2 < 2; ++k2)
#pragma unroll
        for (int s2 = 0; s2 < 2; ++s2) {
          uint4 pk;
          pk.x = pack2(sT[k2][8 * s2 + 0], sT[k2][8 * s2 + 1]); pk.y = pack2(sT[k2][8 * s2 + 2], sT[k2][8 * s2 + 3]);
          pk.z = pack2(sT[k2][8 * s2 + 4], sT[k2][8 * s2 + 5]); pk.w = pack2(sT[k2][8 * s2 + 6], sT[k2][8 * s2 + 7]);
          const bf16x8 pf = __builtin_bit_cast(bf16x8, pk);
          const int koff = (k2 * 32 + 16 * s2 + 4 * lh) * 2;
          {
            const uint2 lo = *(const uint2*)(vsm + l31 * ROWB + koff), hi = *(const uint2*)(vsm + l31 * ROWB + koff + 16);
            const uint4 vv = make_uint4(lo.x, lo.y, hi.x, hi.y);
            o0 = MFMA32(__builtin_bit_cast(bf16x8, vv), pf, o0);
          }
          {
            const uint2 lo = *(const uint2*)(vsm + (32 + l31) * ROWB + koff), hi = *(const uint2*)(vsm + (32 + l31) * ROWB + koff + 16);
            const uint4 vv = make_uint4(lo.x, lo.y, hi.x, hi.y);
            o1 = MFMA32(__builtin_bit_cast(bf16x8, vv), pf, o1);
          }
        }
      if (kt + 1 < NKT) lwrite((kt + 1) & 1);
      __syncthreads();
    }
    lsum += __shfl_xor(lsum, 32);
    const float inv = 1.f / lsum;
#pragma unroll
    for (int g = 0; g < 4; ++g) {
      const int d0 = 8 * g + 4 * lh;
      store_bf4(O + (size_t)tq * 1024 + head * 64 + d0, o0[4 * g] * inv, o0[4 * g + 1] * inv, o0[4 * g + 2] * inv, o0[4 * g + 3] * inv);
      store_bf4(O + (size_t)tq * 1024 + head * 64 + 32 + d0, o1[4 * g] * inv, o1[4 * g + 1] * inv, o1[4 * g + 2] * inv, o1[4 * g + 3] * inv);
    }
  }
}

#define XB_TMO      128
#define XB_XCNT(j)  (256  + 64 * (j))
#define XB_XSUB(j)  (1280 + 64 * (j))
#define XB_XGEN(j)  (2304 + 64 * (j))
#define XB_TOP      3328
#define XB_TOPGEN   3392
#define XCD_BAR_WORDS 3456
#define XB_SPIN_CAP (1u << 18)
#define LAS __attribute__((address_space(3)))

__device__ __forceinline__ unsigned xb_ld(unsigned* p)              { return __hip_atomic_load(p, __ATOMIC_RELAXED, __HIP_MEMORY_SCOPE_AGENT); }
__device__ __forceinline__ unsigned xb_add(unsigned* p, unsigned v) { return __hip_atomic_fetch_add(p, v, __ATOMIC_RELAXED, __HIP_MEMORY_SCOPE_AGENT); }
__device__ __forceinline__ unsigned xb_xcc_id() { return (unsigned)__builtin_amdgcn_s_getreg((3 << 11) | 20) & 0xFu; }
#define XB_SPIN(cond, bar) do { unsigned _sp = 0; while (cond) { __builtin_amdgcn_s_sleep(1); \
    if ((++_sp & 255u) == 0u) { if (xb_ld(&(bar)[XB_TMO])) break; if (_sp > XB_SPIN_CAP) { atomicAdd(&(bar)[XB_TMO], 1u); break; } } } } while (0)

struct XcdBarrier {
    unsigned* bar; unsigned x;
    volatile LAS unsigned* st;
};

__device__ __forceinline__ XcdBarrier xcd_barrier_post(unsigned* bar, volatile LAS unsigned* st) {
    XcdBarrier b; b.bar = bar; b.x = xb_xcc_id(); b.st = st;
    if (threadIdx.x == 0) (void)xb_add(&bar[XB_XCNT(b.x)], 1u);
    return b;
}
__device__ __forceinline__ void xcd_barrier_complete(unsigned* bar, unsigned x, unsigned& nloc, unsigned& nx) {
    const unsigned G = gridDim.x * gridDim.y * gridDim.z;
    unsigned sum, cnt, mine, sp = 0u;
    for (;;) {
        sum = 0u; cnt = 0u; mine = 0u;
#pragma unroll
        for (unsigned j = 0; j < 16; ++j) { const unsigned c = xb_ld(&bar[XB_XCNT(j)]); sum += c; cnt += (c > 0u) ? 1u : 0u; mine = (j == x) ? c : mine; }
        if (sum == G) break;
        __builtin_amdgcn_s_sleep(1);
        if ((++sp & 255u) == 0u) { if (xb_ld(&bar[XB_TMO])) break; if (sp > XB_SPIN_CAP) { atomicAdd(&bar[XB_TMO], 1u); break; } }
    }
    nloc = mine > 0u ? mine : 1u; nx = cnt > 0u ? cnt : 1u;
}

__device__ __forceinline__ void xcd_barrier(const XcdBarrier& b) {
    asm volatile("s_waitcnt vmcnt(0)" ::: "memory");
    __syncthreads();
    if (threadIdx.x == 0) {
        unsigned* bar = b.bar;
        __builtin_amdgcn_s_waitcnt(0);
        unsigned nloc = b.st[0], nx = b.st[1];
        if (nloc == 0u) { xcd_barrier_complete(bar, b.x, nloc, nx); b.st[0] = nloc; b.st[1] = nx; }
        const unsigned old = xb_add(&bar[XB_XSUB(b.x)], 1u);
        const unsigned gen = old / nloc;
        if (old + 1u == (gen + 1u) * nloc) {
            __builtin_amdgcn_fence(__ATOMIC_RELEASE, "agent");
            asm volatile("s_waitcnt vmcnt(0)" ::: "memory");
            const unsigned og = xb_add(&bar[XB_TOP], 1u);
            const unsigned tg = og / nx;
            if (og + 1u == (tg + 1u) * nx) xb_add(&bar[XB_TOPGEN], 1u);
            else XB_SPIN(xb_ld(&bar[XB_TOPGEN]) == tg, bar);
            __builtin_amdgcn_fence(__ATOMIC_ACQUIRE, "agent");
            xb_add(&bar[XB_XGEN(b.x)], 1u);
            asm volatile("s_waitcnt vmcnt(0)" ::: "memory");
        } else {
            XB_SPIN(xb_ld(&bar[XB_XGEN(b.x)]) == gen, bar);
            __builtin_amdgcn_fence(__ATOMIC_ACQUIRE, "agent");
            asm volatile("s_waitcnt vmcnt(0)" ::: "memory");
        }
    }
    __syncthreads();
}


DI void run_phase(const Params& p, int ph, char* lds) {
  const float* mod0 = p.MOD;
  const float* mod1 = p.MOD + 9 * 6144;
  switch (ph) {
    case 0: phase0(p, lds); break;
    case 1: norm_mod_phase(p.x, p.ctx, p.norm_mix, mod0, 0, 1, p.Hd, NT); break;
    case 2: phase_proj(p, lds); break;
    case 20: phase_mix(p); break;
    case 3: phase_prep(p, lds); break;
    case 4: phase_scan(p, lds); break;
    case 5: phase_readout(p, lds); break;
    case 6: phase_gemm_resid(p, lds, p.S[0], p.woT, 1024, NT / 256, p.x, p.ctx, mod0 + 2 * 1024); break;
    case 7: norm_mod_phase(p.out, p.XC, p.norm_mlp, mod0, 3, 4, p.S[5], NT); break;
    case 8: phase_up(p, lds, p.S[5], p.w1T[0], p.S[0], NT / 256); break;
    case 9: phase_gemm_resid(p, lds, p.S[0], p.w2T[0], 4096, NT / 256, p.out, p.XC, mod0 + 5 * 1024); break;
    case 10: norm_mod_phase(p.out, p.XC, p.norm_mix + 1024, mod1, 0, 1, p.S[5], NT); break;
    case 11: phase_qkv(p, lds); break;
    case 12: phase_attn(p, lds); break;
    case 13: phase_gemm_resid(p, lds, p.S[3], p.awoT, 1024, NL / 256, p.out, p.XC, mod1 + 2 * 1024); break;
    case 14: norm_mod_phase(p.out, p.XC, p.norm_mlp + 1024, mod1, 3, 4, p.S[5], NL); break;
    case 15: phase_up(p, lds, p.S[5], p.w1T[1], p.S[0], NL / 256); break;
    case 16: phase_gemm_resid(p, lds, p.S[0], p.w2T[1], 4096, NL / 256, p.out, p.XC, mod1 + 5 * 1024); break;
    case 17: final_norm_phase(p); break;
  }
}
constexpr int NPHASE = 18;

__global__ void __launch_bounds__(NTHREADS) phase_kernel(Params p, int ph) {
  extern __shared__ __attribute__((aligned(16))) char lds[];
  run_phase(p, ph, lds);
}

__global__ void __launch_bounds__(NTHREADS) mega_kernel(Params p) {
  extern __shared__ __attribute__((aligned(16))) char lds[];
  cg::grid_group grid = cg::this_grid();
  volatile LAS unsigned* st = (volatile LAS unsigned*)(LAS char*)(lds + 131072);
  if (threadIdx.x == 0) { st[0] = 0u; st[1] = 0u; }
  if (blockIdx.x == 0) for (int i = threadIdx.x; i < XCD_BAR_WORDS; i += NTHREADS) p.BAR[i] = 0u;
  __syncthreads();
  run_phase(p, 0, lds);
  grid.sync();
  const XcdBarrier xb = xcd_barrier_post(p.BAR, st);
#ifndef DUP
#define DUP -1
#endif
#define PH(n) run_phase(p, n, lds); xcd_barrier(xb); if (DUP == n) { if (n == 4) phase_scan(p, lds, true); else if (n == 9) phase_gemm_resid(p, lds, p.S[0], p.w2T[0], 4096, NT / 256, p.out, p.XC, p.MOD + 5 * 1024, (float*)p.S[4]); else run_phase(p, n, lds); xcd_barrier(xb); } if (DUP == 100) { xcd_barrier(xb); }
  PH(1) PH(20) PH(2) PH(3) PH(4) PH(5) PH(6) PH(7) PH(8) PH(9) PH(10) PH(11) PH(12) PH(13) PH(14) PH(15) PH(16)
  run_phase(p, 17, lds);
}

extern "C" void kernel_launch(void* const* d_in, const int* in_sizes, int n_in, void* d_out, int out_size, void* d_ws, size_t ws_size, hipStream_t stream) {
  Params p;
  memset(&p, 0, sizeof(p));
  const float* const* in = (const float* const*)d_in;
  p.x = in[0]; p.c = in[1]; p.ctx = in[2]; p.c_ctx = in[3]; p.w_mod = in[4]; p.b_mod = in[5]; p.norm_mix = in[6]; p.norm_mlp = in[7];
  p.mlp_w1 = in[8]; p.mlp_w2 = in[9]; p.mu = in[10]; p.wr = in[11]; p.wk = in[12]; p.wv = in[13]; p.wo = in[14]; p.w0 = in[15]; p.w1 = in[16];
  p.w2 = in[17]; p.a0 = in[18]; p.a1 = in[19]; p.a2 = in[20]; p.g1 = in[21]; p.g2 = in[22]; p.k_k = in[23]; p.k_a = in[24]; p.r_k = in[25];
  p.ln_w = in[26]; p.ln_b = in[27]; p.wqkv = in[28]; p.q_norm = in[29]; p.k_norm = in[30]; p.awo = in[31]; p.final_norm = in[32];
  p.out = (float*)d_out;
  char* ws = (char*)d_ws;
  size_t off = 0;
  auto take = [&](size_t bytes) -> char* { char* r = ws + off; off += (bytes + 255) & ~(size_t)255; return r; };
  p.Wcat = (bf16_t*)take((size_t)3456 * 1024 * 2);
  p.L2w = (bf16_t*)take((size_t)4 * 65536 * 2);
  p.g2T = (bf16_t*)take((size_t)1024 * 128 * 2);
  p.woT = (bf16_t*)take((size_t)1024 * 1024 * 2);
  p.w1T[0] = (bf16_t*)take((size_t)4096 * 1024 * 2);
  p.w1T[1] = (bf16_t*)take((size_t)4096 * 1024 * 2);
  p.w2T[0] = (bf16_t*)take((size_t)4096 * 1024 * 2);
  p.w2T[1] = (bf16_t*)take((size_t)4096 * 1024 * 2);
  p.wqkvT = (bf16_t*)take((size_t)1536 * 1024 * 2);
  p.awoT = (bf16_t*)take((size_t)1024 * 1024 * 2);
  p.MOD = (float*)take((size_t)2 * 9 * 6144 * 4);
  p.TAB = (float*)take((size_t)1024 * 2 * 4);
  p.XC = (float*)take((size_t)NC * 1024 * 4);
  p.BAR = (unsigned*)take((size_t)XCD_BAR_WORDS * 4);
  for (int i = 0; i < 6; ++i) p.S[i] = (bf16_t*)take((size_t)NT * 1024 * 2);
  if (off > ws_size) { fprintf(stderr, "kernel_launch: workspace too small (%zu needed, %zu given)\n", off, ws_size); return; }
  char* ob = (char*)d_out;
  p.Hd = (bf16_t*)ob;
  p.L1 = (bf16_t*)(ob + (size_t)NT * 1024 * 2);
  p.BON = (float*)(ob + (size_t)NT * 1024 * 2 + (size_t)NT * 384 * 2);
  p.NRM = (float*)(ob + (size_t)NT * 1024 * 2 + (size_t)NT * 384 * 2 + (size_t)NT * 16 * 4);
  int nj = 0, tiles = 0;
  auto job = [&](const float* src, bf16_t* dst, int K, int N) {
    p.jobs[nj].src = src; p.jobs[nj].dst = dst; p.jobs[nj].K = K; p.jobs[nj].N = N; p.jobs[nj].tstart = tiles; p.jobs[nj].tiles_n = N / 64;
    tiles += (K / 64) * (N / 64); ++nj;
  };
  job(p.wr, p.Wcat, 1024, 1024);
  job(p.wk, p.Wcat + (size_t)1024 * 1024, 1024, 1024);
  job(p.wv, p.Wcat + (size_t)2048 * 1024, 1024, 1024);
  job(p.g1, p.Wcat + (size_t)3072 * 1024, 1024, 128);
  job(p.w1, p.Wcat + (size_t)3200 * 1024, 1024, 64);
  job(p.w1 + 65536, p.Wcat + (size_t)3264 * 1024, 1024, 64);
  job(p.a1, p.Wcat + (size_t)3328 * 1024, 1024, 64);
  job(p.a1 + 65536, p.Wcat + (size_t)3392 * 1024, 1024, 64);
  job(p.a2, p.L2w, 64, 1024);
  job(p.a2 + 65536, p.L2w + 65536, 64, 1024);
  job(p.w2, p.L2w + 2 * 65536, 64, 1024);
  job(p.w2 + 65536, p.L2w + 3 * 65536, 64, 1024);
  job(p.g2, p.g2T, 128, 1024);
  job(p.wo, p.woT, 1024, 1024);
  job(p.mlp_w1, p.w1T[0], 1024, 4096);
  job(p.mlp_w1 + (size_t)4096 * 1024, p.w1T[1], 1024, 4096);
  job(p.mlp_w2, p.w2T[0], 4096, 1024);
  job(p.mlp_w2 + (size_t)4096 * 1024, p.w2T[1], 4096, 1024);
  job(p.wqkv, p.wqkvT, 1024, 1536);
  job(p.awo, p.awoT, 1024, 1024);
  p.njobs = nj; p.total_tiles = tiles;

  static int grid_blocks = 0;
  if (!grid_blocks) {
    (void)hipFuncSetAttribute((const void*)mega_kernel, hipFuncAttributeMaxDynamicSharedMemorySize, LDS_BYTES);
    (void)hipFuncSetAttribute((const void*)phase_kernel, hipFuncAttributeMaxDynamicSharedMemorySize, LDS_BYTES);
    int dev = 0, cus = 0, per_cu = 0;
    (void)hipGetDevice(&dev);
    (void)hipDeviceGetAttribute(&cus, hipDeviceAttributeMultiprocessorCount, dev);
    if (hipOccupancyMaxActiveBlocksPerMultiprocessor(&per_cu, (const void*)mega_kernel, NTHREADS, LDS_BYTES) != hipSuccess || per_cu < 1) per_cu = 1;
    if (cus <= 0) cus = 256;
    grid_blocks = cus * per_cu;
    (void)hipGetLastError();
  }
#if SINGLE_LAUNCH
  void* args[] = {&p};
  hipError_t e = hipLaunchCooperativeKernel((const void*)mega_kernel, dim3(grid_blocks), dim3(NTHREADS), args, LDS_BYTES, stream);
  if (e != hipSuccess) fprintf(stderr, "cooperative launch failed: %s (grid %d)\n", hipGetErrorString(e), grid_blocks);
#else
  for (int ph = 0; ph < NPHASE; ++ph) hipLaunchKernelGGL(phase_kernel, dim3(grid_blocks), dim3(NTHREADS), LDS_BYTES, stream, p, ph);
#endif
}
```

```cpp
#include <hip/hip_runtime.h>
#include <hip/hip_cooperative_groups.h>
#include <cstdint>
#include <cstring>
#include <cstdio>
namespace cg = cooperative_groups;

#ifndef SINGLE_LAUNCH
#define SINGLE_LAUNCH 1
#endif

typedef unsigned short bf16_t;
typedef short bf16x8 __attribute__((ext_vector_type(8)));
typedef float f32x2 __attribute__((ext_vector_type(2)));
typedef float f32x4 __attribute__((ext_vector_type(4)));
typedef float f32x16 __attribute__((ext_vector_type(16)));
typedef __bf16 bf16x2_t __attribute__((ext_vector_type(2)));
#define DI __device__ __forceinline__

constexpr int D = 1024, NB = 8, SEQ = 4096, CTXL = 256;
constexpr int NL = NB * SEQ, NC = NB * CTXL, NT = NL + NC, DFF = 4096;
constexpr int NKEY = SEQ + CTXL;
constexpr int NTHREADS = 512;
constexpr int ROWB = 144;
constexpr int GEMM_STAGE = (256 + 128) * ROWB;
constexpr int LDS_BYTES = 131072 + 16;

struct TJob { const float* src; bf16_t* dst; int K, N, tstart, tiles_n; };

struct Params {
  const float *x, *c, *ctx, *c_ctx, *w_mod, *b_mod, *norm_mix, *norm_mlp, *mlp_w1, *mlp_w2;
  const float *mu, *wr, *wk, *wv, *wo, *w0, *w1, *w2, *a0, *a1, *a2, *g1, *g2, *k_k, *k_a, *r_k, *ln_w, *ln_b;
  const float *wqkv, *q_norm, *k_norm, *awo, *final_norm;
  float* out;
  bf16_t *Wcat, *L2w, *g2T, *woT, *w1T[2], *w2T[2], *wqkvT, *awoT;
  float *MOD, *TAB, *XC;
  bf16_t* S[6];
  bf16_t *Hd, *L1;
  float* BON;
  float* NRM;
  unsigned* BAR;
  TJob jobs[20];
  int njobs, total_tiles;
};

DI unsigned pack2(float lo, float hi) {
  f32x2 v = {lo, hi};
  bf16x2_t b = __builtin_convertvector(v, bf16x2_t);
  return __builtin_bit_cast(unsigned, b);
}
DI float bflo(unsigned u) { return __uint_as_float(u << 16); }
DI float bfhi(unsigned u) { return __uint_as_float(u & 0xffff0000u); }
DI void store_bf4(bf16_t* p, float a, float b, float c, float d) { *(uint2*)p = make_uint2(pack2(a, b), pack2(c, d)); }
DI void load_bf4(const bf16_t* p, float& a, float& b, float& c, float& d) { uint2 u = *(const uint2*)p; a = bflo(u.x); b = bfhi(u.x); c = bflo(u.y); d = bfhi(u.y); }
DI void store_bf8(bf16_t* p, const f32x4& a, const f32x4& b) {
  uint4 o; o.x = pack2(a[0], a[1]); o.y = pack2(a[2], a[3]); o.z = pack2(b[0], b[1]); o.w = pack2(b[2], b[3]);
  *(uint4*)p = o;
}
DI void store16_sc1(void* p, const uint4& v) {
  typedef unsigned u32x4_t __attribute__((ext_vector_type(4)));
  const u32x4_t d = {v.x, v.y, v.z, v.w};
  asm volatile("global_store_dwordx4 %0, %1, off sc1" :: "v"(p), "v"(d) : "memory");
}
DI void unpack_bf8(const uint4& u, float (&o)[8]) {
  o[0] = bflo(u.x); o[1] = bfhi(u.x); o[2] = bflo(u.y); o[3] = bfhi(u.y); o[4] = bflo(u.z); o[5] = bfhi(u.z); o[6] = bflo(u.w); o[7] = bfhi(u.w);
}
DI int perm32(int rho) { return 8 * ((rho & 15) >> 2) + 4 * (rho >> 4) + (rho & 3); }
DI float sigmoidf_(float x) { return 1.f / (1.f + __expf(-x)); }
DI float tanhf_(float x) { return 1.f - 2.f / (1.f + __expf(2.f * x)); }
DI float quad_sum(float x) {
  x += __builtin_bit_cast(float, __builtin_amdgcn_mov_dpp(__builtin_bit_cast(int, x), 0xB1, 0xF, 0xF, true));
  x += __builtin_bit_cast(float, __builtin_amdgcn_mov_dpp(__builtin_bit_cast(int, x), 0x4E, 0xF, 0xF, true));
  return x;
}
DI float oct_sum(float x) {
  x = quad_sum(x);
  x += __builtin_bit_cast(float, __builtin_amdgcn_mov_dpp(__builtin_bit_cast(int, x), 0x141, 0xF, 0xF, true));
  return x;
}
DI float wave_sum(float x) {
#pragma unroll
  for (int m = 1; m < 64; m <<= 1) x += __shfl_xor(x, m);
  return x;
}
#define MFMA16(a, b, c) __builtin_amdgcn_mfma_f32_16x16x32_bf16((a), (b), (c), 0, 0, 0)
#define MFMA32(a, b, c) __builtin_amdgcn_mfma_f32_32x32x16_bf16((a), (b), (c), 0, 0, 0)

DI unsigned lerp2(unsigned a, unsigned n, float ma, float mb) {
  const float h0 = bflo(a), h1 = bfhi(a), s0 = bflo(n), s1 = bfhi(n);
  return pack2(h0 + (s0 - h0) * ma, h1 + (s1 - h1) * mb);
}
template <bool LERP>
DI void gemm_tile(const bf16_t* __restrict__ X, int ldx, const bf16_t* __restrict__ W, int ldw, int K, int tok0, int f0,
                  char* lds, f32x4 (&acc)[4][4], const float* __restrict__ mu) {
  const int tid = threadIdx.x, lane = tid & 63, wave = tid >> 6;
  const int wt = wave & 3, wf = wave >> 2, lr = lane & 15, lq = lane >> 4;
  const int lrow = tid >> 3, kc = tid & 7;
#pragma unroll
  for (int i = 0; i < 4; ++i)
#pragma unroll
    for (int j = 0; j < 4; ++j) acc[i][j] = f32x4{0.f, 0.f, 0.f, 0.f};
  uint4 xr[4], wr[2], xn[4];
  float4 m0 = make_float4(0, 0, 0, 0), m1 = m0;
  const int nk = K >> 6;
  __syncthreads();
  for (int kt = -1; kt < nk; ++kt) {
    const bool more = kt + 1 < nk;
    if (more) {
      const int k0 = (kt + 1) << 6;
#pragma unroll
      for (int i = 0; i < 4; ++i) {
        const int tg = tok0 + lrow + 64 * i;
        xr[i] = *(const uint4*)(X + (size_t)tg * ldx + k0 + kc * 8);
        if (LERP) {
          int nb; bool valid;
          if (tok0 < NL) {
            const int s = tg & 4095, col = s & 63, rw = s >> 6, qd = k0 >> 8;
            if (qd == 0) { valid = col > 0; nb = tg - 1; }
            else if (qd == 1) { valid = col < 63; nb = tg + 1; }
            else if (qd == 2) { valid = rw > 0; nb = tg - 64; }
            else { valid = rw < 63; nb = tg + 64; }
          } else {
            const int s = (tg - NL) & 255;
            if (k0 < 512) { valid = s > 0; nb = tg - 1; }
            else { valid = s < 255; nb = tg + 1; }
          }
          if (valid) xn[i] = *(const uint4*)(X + (size_t)nb * ldx + k0 + kc * 8);
          else xn[i] = make_uint4(0, 0, 0, 0);
        }
      }
#pragma unroll
      for (int i = 0; i < 2; ++i) wr[i] = *(const uint4*)(W + (size_t)(f0 + 64 * i + (lrow & 32) + perm32(lrow & 31)) * ldw + k0 + kc * 8);
      if (LERP) { m0 = *(const float4*)(mu + k0 + kc * 8); m1 = *(const float4*)(mu + k0 + kc * 8 + 4); }
    }
    if (kt >= 0) {
      const char* xs = lds + (kt & 1) * GEMM_STAGE;
      const char* wsm = xs + 256 * ROWB;
#pragma unroll
      for (int ks = 0; ks < 2; ++ks) {
        bf16x8 wfr[4], xfr[4];
#pragma unroll
        for (int i = 0; i < 4; ++i) wfr[i] = *(const bf16x8*)(wsm + (wf * 64 + i * 16 + lr) * ROWB + ks * 64 + lq * 16);
#pragma unroll
        for (int i = 0; i < 4; ++i) xfr[i] = *(const bf16x8*)(xs + (wt * 64 + i * 16 + lr) * ROWB + ks * 64 + lq * 16);
#pragma unroll
        for (int fi = 0; fi < 4; ++fi)
#pragma unroll
          for (int ti = 0; ti < 4; ++ti) acc[fi][ti] = MFMA16(wfr[fi], xfr[ti], acc[fi][ti]);
      }
    }
    if (more) {
      char* xs = lds + ((kt + 1) & 1) * GEMM_STAGE;
      char* wsm = xs + 256 * ROWB;
#pragma unroll
      for (int i = 0; i < 4; ++i) {
        uint4 v = xr[i];
        if (LERP) {
          v.x = lerp2(xr[i].x, xn[i].x, m0.x, m0.y);
          v.y = lerp2(xr[i].y, xn[i].y, m0.z, m0.w);
          v.z = lerp2(xr[i].z, xn[i].z, m1.x, m1.y);
          v.w = lerp2(xr[i].w, xn[i].w, m1.z, m1.w);
        }
        *(uint4*)(xs + (lrow + 64 * i) * ROWB + kc * 16) = v;
      }
#pragma unroll
      for (int i = 0; i < 2; ++i) *(uint4*)(wsm + (lrow + 64 * i) * ROWB + kc * 16) = wr[i];
    }
    __syncthreads();
  }
}


namespace g256 {
constexpr int BK = 64, HALF = 128, HT = HALF * BK;
DI int lds_byte(int r, int c) { const int st = (r >> 4) * 2 + (c >> 5), rr = r & 15, cc = c & 31, ob = rr * 64 + cc * 2; return st * 1024 + (ob ^ (((ob >> 9) & 1) << 5)); }
DI void stage_rc(int b, int& R, int& C) { const int st = b / 1024, sb = b % 1024, swz = sb ^ (((sb >> 9) & 1) << 5); R = (st >> 1) * 16 + swz / 64; C = (st & 1) * 32 + (swz % 64) / 2; }
}
#define G_SA(b, h) (((b) * 2 + (h)) * 16384)
#define G_SB(b, h) ((4 + (b) * 2 + (h)) * 16384)
#define G_STAGEV(bufoff, gbase, vo) do { _Pragma("unroll") for (int _i = 0; _i < 2; ++_i) \
    __builtin_amdgcn_global_load_lds((const unsigned*)((const char*)(gbase) + (vo)[_i]), (__attribute__((address_space(3))) unsigned*)(lds + (bufoff) + ldsw + _i * 8192), 16, 0, 0); } while (0)
#define G_LDA(dst, b, h) do { _Pragma("unroll") for (int m = 0; m < 4; ++m) _Pragma("unroll") for (int k = 0; k < 2; ++k) \
    dst[m][k] = *(const __attribute__((address_space(3))) bf16x8*)(lds + G_SA(b, h) + aoff + m * 2048 + k * 1024); } while (0)
#define G_LDB(dst, b, h) do { _Pragma("unroll") for (int n = 0; n < 2; ++n) _Pragma("unroll") for (int k = 0; k < 2; ++k) \
    dst[n][k] = *(const __attribute__((address_space(3))) bf16x8*)(lds + G_SB(b, h) + boff + n * 2048 + k * 1024); } while (0)
#define G_MMA(ai, bj, At, Bt) do { __builtin_amdgcn_s_setprio(1); \
    _Pragma("unroll") for (int m = 0; m < 4; ++m) _Pragma("unroll") for (int n = 0; n < 2; ++n) _Pragma("unroll") for (int k = 0; k < 2; ++k) \
      acc[ai][bj][m][n] = __builtin_amdgcn_mfma_f32_16x16x32_bf16(At[m][k], Bt[n][k], acc[ai][bj][m][n], 0, 0, 0); \
    __builtin_amdgcn_s_setprio(0); } while (0)
#define G_WAIT_V(n) asm volatile("s_waitcnt vmcnt(" #n ")" ::: "memory")
#define G_WAIT_L(n) asm volatile("s_waitcnt lgkmcnt(" #n ")" ::: "memory")
#define G_BAR __builtin_amdgcn_s_barrier()
#define G_SCHED __builtin_amdgcn_sched_barrier(0)

template <bool PERM>
DI void gemm256_tile(const bf16_t* __restrict__ A, const bf16_t* __restrict__ Bt, int K, int brow, int bcol, char* lds_, f32x4 (&acc)[2][2][4][2]) {
  __attribute__((address_space(3))) unsigned char* lds = (__attribute__((address_space(3))) unsigned char*)lds_;
  int tid = threadIdx.x; asm volatile("" : "+v"(tid));
  const int wid = __builtin_amdgcn_readfirstlane(tid >> 6), lane = tid & 63, wr = wid >> 2, wc = wid & 3, fr = lane & 15, fq = lane >> 4;
#pragma unroll
  for (int a = 0; a < 2; ++a)
#pragma unroll
    for (int b = 0; b < 2; ++b)
#pragma unroll
      for (int m = 0; m < 4; ++m)
#pragma unroll
        for (int n = 0; n < 2; ++n) acc[a][b][m][n] = f32x4{0.f, 0.f, 0.f, 0.f};
  unsigned voff[2], voffA[2];
#pragma unroll
  for (int i = 0; i < 2; ++i) { int R, C; g256::stage_rc(tid * 16 + i * 8192, R, C); voff[i] = (unsigned)(R * K + C) * 2u;
    const int Ra = PERM ? ((R & ~31) + perm32(R & 31)) : R; voffA[i] = (unsigned)(Ra * K + C) * 2u; }
  const size_t kstep = 128, hstep = (size_t)128 * K * 2;
  const unsigned ldsw = (unsigned)wid * 1024u;
  const int aoff = g256::lds_byte(wr * 64 + fr, fq * 8), boff = g256::lds_byte(wc * 32 + fr, fq * 8);
  const char* cA = (const char*)A + (size_t)brow * K * 2;
  const char* cB = (const char*)Bt + (size_t)bcol * K * 2;
  bf16x8 At[4][2], B0[2][2], B1[2][2];
  const int nt = K / g256::BK;
  __syncthreads();
  G_STAGEV(G_SB(0, 0), cB, voff); G_STAGEV(G_SA(0, 0), cA, voffA); G_STAGEV(G_SB(0, 1), cB + hstep, voff); G_STAGEV(G_SA(0, 1), cA + hstep, voffA);
  if (wr == 1) G_BAR;
  G_WAIT_V(4); G_BAR;
  G_STAGEV(G_SB(1, 0), cB + kstep, voff); G_STAGEV(G_SA(1, 0), cA + kstep, voffA); G_STAGEV(G_SB(1, 1), cB + hstep + kstep, voff);
  G_WAIT_V(6); G_BAR;
  for (int t = 0; t < nt - 2; t += 2) {
    const char* a1 = cA + (size_t)(t + 1) * kstep;
    const char* a2 = cA + (size_t)(t + 2) * kstep; const char* b2 = cB + (size_t)(t + 2) * kstep;
    const char* a3 = a2 + kstep; const char* b3 = b2 + kstep;
    G_LDB(B0, 0, 0); G_SCHED; G_LDA(At, 0, 0); G_STAGEV(G_SA(1, 1), a1 + hstep, voffA);
    G_WAIT_L(8); G_BAR; G_WAIT_L(0); G_MMA(0, 0, At, B0); G_BAR; G_SCHED;
    G_LDB(B1, 0, 1); G_STAGEV(G_SB(0, 0), b2, voff);
    G_BAR; G_WAIT_L(0); G_MMA(0, 1, At, B1); G_BAR;
    G_LDA(At, 0, 1); G_STAGEV(G_SA(0, 0), a2, voffA);
    G_BAR; G_WAIT_L(0); G_MMA(1, 0, At, B0); G_BAR; G_SCHED;
    G_STAGEV(G_SB(0, 1), b2 + hstep, voff);
    G_WAIT_V(6); G_BAR; G_MMA(1, 1, At, B1); G_BAR;
    G_LDB(B0, 1, 0); G_SCHED; G_LDA(At, 1, 0); G_STAGEV(G_SA(0, 1), a2 + hstep, voffA);
    G_WAIT_L(8); G_BAR; G_WAIT_L(0); G_MMA(0, 0, At, B0); G_BAR; G_SCHED;
    G_LDB(B1, 1, 1); G_STAGEV(G_SB(1, 0), b3, voff);
    G_BAR; G_WAIT_L(0); G_MMA(0, 1, At, B1); G_BAR;
    G_LDA(At, 1, 1); G_STAGEV(G_SA(1, 0), a3, voffA);
    G_BAR; G_WAIT_L(0); G_MMA(1, 0, At, B0); G_BAR; G_SCHED;
    G_STAGEV(G_SB(1, 1), b3 + hstep, voff);
    G_WAIT_V(6); G_BAR; G_MMA(1, 1, At, B1); G_BAR;
  }
  { G_LDB(B0, 0, 0); G_LDA(At, 0, 0); G_STAGEV(G_SA(1, 1), cA + (size_t)(nt - 1) * kstep + hstep, voffA);
    G_BAR; G_WAIT_L(0); G_MMA(0, 0, At, B0); G_BAR;
    G_LDB(B1, 0, 1); G_BAR; G_WAIT_L(0); G_MMA(0, 1, At, B1); G_BAR;
    G_LDA(At, 0, 1); G_WAIT_V(4); G_BAR; G_WAIT_L(0); G_MMA(1, 0, At, B0); G_MMA(1, 1, At, B1); G_BAR; }
  { G_LDB(B0, 1, 0); G_LDA(At, 1, 0); G_WAIT_V(2); G_BAR; G_WAIT_L(0); G_MMA(0, 0, At, B0); G_BAR;
    G_LDB(B1, 1, 1); G_WAIT_V(0); G_BAR; G_WAIT_L(0); G_MMA(0, 1, At, B1); G_BAR;
    G_LDA(At, 1, 1); G_BAR; G_WAIT_L(0); G_MMA(1, 0, At, B0); G_MMA(1, 1, At, B1); G_BAR; }
  if (wr == 0) G_BAR;
}

DI void tile_map(int L, int total, int ntm, int ntn, int& mt, int& nt) {
  const int q = total >> 3, r = total & 7, xcd = L & 7, off = L >> 3;
  const int id = (xcd < r ? xcd * (q + 1) : r * (q + 1) + (xcd - r) * q) + off;
  const int nig = 8 * ntn, g = id / nig, w = id % nig, fm = g * 8, gsz = min(ntm - fm, 8);
  mt = fm + w % gsz; nt = w / gsz;
}
DI void convert_tile(const TJob& jb, int t, char* lds) {
  float* tile = (float*)lds;
  const int tid = threadIdx.x;
  const int tk = t / jb.tiles_n, tn = t % jb.tiles_n;
  const int k0 = tk * 64, n0 = tn * 64;
  __syncthreads();
#pragma unroll
  for (int i = 0; i < 2; ++i) {
    const int idx = tid + 512 * i, row = idx >> 4, c4 = idx & 15;
    const float4 v = *(const float4*)(jb.src + (size_t)(k0 + row) * jb.N + n0 + c4 * 4);
    tile[row * 65 + c4 * 4 + 0] = v.x; tile[row * 65 + c4 * 4 + 1] = v.y; tile[row * 65 + c4 * 4 + 2] = v.z; tile[row * 65 + c4 * 4 + 3] = v.w;
  }
  __syncthreads();
  const int n = tid >> 3, kc = tid & 7;
  float v[8];
#pragma unroll
  for (int j = 0; j < 8; ++j) v[j] = tile[(kc * 8 + j) * 65 + n];
  uint4 o;
  o.x = pack2(v[0], v[1]); o.y = pack2(v[2], v[3]); o.z = pack2(v[4], v[5]); o.w = pack2(v[6], v[7]);
  *(uint4*)(jb.dst + (size_t)(n0 + n) * jb.K + k0 + kc * 8) = o;
}

DI void mod_unit(const Params& p, int mu_, char* lds) {
  const int tid = threadIdx.x;
  const int layer = mu_ / 96, cc = mu_ % 96;
  float* sc = (float*)lds;
  float* red = sc + 9 * 1024;
  __syncthreads();
  for (int i = tid; i < 9 * 1024; i += 512) {
    const int row = i >> 10, k = i & 1023;
    const float v = row < 8 ? p.c[row * 1024 + k] : p.c_ctx[k];
    sc[i] = v / (1.f + __expf(-v));
  }
  __syncthreads();
  const int kg = tid >> 6, col = tid & 63;
  const float* w = p.w_mod + (size_t)layer * 1024 * 6144 + cc * 64 + col;
  float a[9];
#pragma unroll
  for (int r = 0; r < 9; ++r) a[r] = 0.f;
#pragma unroll 16
  for (int k = kg * 128; k < kg * 128 + 128; ++k) {
    const float wv = w[(size_t)k * 6144];
#pragma unroll
    for (int r = 0; r < 9; ++r) a[r] += sc[r * 1024 + k] * wv;
  }
#pragma unroll
  for (int r = 0; r < 9; ++r) red[(kg * 9 + r) * 64 + col] = a[r];
  __syncthreads();
  for (int i = tid; i < 576; i += 512) {
    const int r = i >> 6, cl = i & 63;
    float s = 0.f;
#pragma unroll
    for (int g = 0; g < 8; ++g) s += red[(g * 9 + r) * 64 + cl];
    const int n = cc * 64 + cl;
    p.MOD[(layer * 9 + r) * 6144 + n] = s + p.b_mod[layer * 6144 + n];
  }
  __syncthreads();
}

DI void sincos_d(double a, double& s, double& c) {
  const double n = rint(a * 0.6366197723675814);
  const double r = (a - n * 1.5707963267948966) - n * 6.123233995736766e-17;
  const double r2 = r * r;
  const double sp = r * (1.0 + r2 * (-1.0 / 6.0 + r2 * (1.0 / 120.0 + r2 * (-1.0 / 5040.0 + r2 * (1.0 / 362880.0 + r2 * (-1.0 / 39916800.0 + r2 * (1.0 / 6227020800.0)))))));
  const double cp = 1.0 + r2 * (-0.5 + r2 * (1.0 / 24.0 + r2 * (-1.0 / 720.0 + r2 * (1.0 / 40320.0 + r2 * (-1.0 / 3628800.0 + r2 * (1.0 / 479001600.0 + r2 * (-1.0 / 87178291200.0)))))));
  const int q = ((int)n) & 3;
  if (q == 0) { s = sp; c = cp; }
  else if (q == 1) { s = cp; c = -sp; }
  else if (q == 2) { s = -sp; c = -cp; }
  else { s = -cp; c = sp; }
}

DI void tab_unit(const Params& p) {
  for (int idx = threadIdx.x; idx < 1024; idx += 512) {
    const int pos = idx >> 4, fi = idx & 15;
    double f = 1.0;
    for (int i = 0; i < fi; ++i) f *= 0.5623413251903491;
    double s, c;
    sincos_d((double)pos * (double)(float)f, s, c);
    p.TAB[idx * 2 + 0] = (float)c;
    p.TAB[idx * 2 + 1] = (float)s;
  }
}

__device__ void phase0(const Params& p, char* lds) {
  const int total = p.total_tiles + 192 + 1;
  for (int u = blockIdx.x; u < total; u += gridDim.x) {
    if (u < p.total_tiles) {
      int j = 0;
#pragma unroll 1
      for (int q = 1; q < p.njobs; ++q) if (u >= p.jobs[q].tstart) j = q;
      convert_tile(p.jobs[j], u - p.jobs[j].tstart, lds);
    } else if (u < p.total_tiles + 192) {
      mod_unit(p, u - p.total_tiles, lds);
    } else {
      tab_unit(p);
    }
  }
}

DI void norm_mod_phase(const float* __restrict__ xl, const float* __restrict__ xc, const float* __restrict__ gain,
                               const float* __restrict__ mod, int shift_i, int scale_i, bf16_t* __restrict__ H, int ntok) {
  const int lane = threadIdx.x & 63;
  const int wg = blockIdx.x * 8 + (threadIdx.x >> 6), nw = gridDim.x * 8;
  for (int t = wg; t < ntok; t += nw) {
    const float* row = t < NL ? xl + (size_t)t * 1024 : xc + (size_t)(t - NL) * 1024;
    float4 v[4];
    float ss = 0.f;
#pragma unroll
    for (int i = 0; i < 4; ++i) {
      v[i] = *(const float4*)(row + (lane + 64 * i) * 4);
      ss += v[i].x * v[i].x + v[i].y * v[i].y + v[i].z * v[i].z + v[i].w * v[i].w;
    }
    ss = wave_sum(ss);
    const float rstd = rsqrtf(ss * (1.f / 1024.f) + 1e-6f);
    const int bp = t < NL ? (t >> 12) : 8;
    const float* sh = mod + (bp * 6 + shift_i) * 1024;
    const float* sc = mod + (bp * 6 + scale_i) * 1024;
#pragma unroll
    for (int i = 0; i < 4; ++i) {
      const int c = (lane + 64 * i) * 4;
      const float4 g = *(const float4*)(gain + c), s4 = *(const float4*)(sh + c), c4 = *(const float4*)(sc + c);
      store_bf4(H + (size_t)t * 1024 + c,
                v[i].x * rstd * g.x * (1.f + c4.x) + s4.x, v[i].y * rstd * g.y * (1.f + c4.y) + s4.y,
                v[i].z * rstd * g.z * (1.f + c4.z) + s4.z, v[i].w * rstd * g.w * (1.f + c4.w) + s4.w);
    }
  }
}

__device__ void final_norm_phase(const Params& p) {
  const int lane = threadIdx.x & 63;
  const int wg = blockIdx.x * 8 + (threadIdx.x >> 6), nw = gridDim.x * 8;
  for (int t = wg; t < NL; t += nw) {
    float* row = p.out + (size_t)t * 1024;
    float4 v[4];
    float ss = 0.f;
#pragma unroll
    for (int i = 0; i < 4; ++i) {
      v[i] = *(const float4*)(row + (lane + 64 * i) * 4);
      ss += v[i].x * v[i].x + v[i].y * v[i].y + v[i].z * v[i].z + v[i].w * v[i].w;
    }
    ss = wave_sum(ss);
    const float rstd = rsqrtf(ss * (1.f / 1024.f) + 1e-6f);
#pragma unroll
    for (int i = 0; i < 4; ++i) {
      const int c = (lane + 64 * i) * 4;
      const float4 g = *(const float4*)(p.final_norm + c);
      *(float4*)(row + c) = make_float4(v[i].x * rstd * g.x, v[i].y * rstd * g.y, v[i].z * rstd * g.z, v[i].w * rstd * g.w);
    }
  }
}

__device__ void phase_mix(const Params& p) {
  const int lane = threadIdx.x & 63;
  const int wg = blockIdx.x * 8 + (threadIdx.x >> 6), nw = gridDim.x * 8;
  for (int t = wg; t < NT; t += nw) {
#pragma unroll
    for (int i = 0; i < 2; ++i) {
      const int c = lane * 8 + 512 * i;
      const uint4 own = *(const uint4*)(p.Hd + (size_t)t * 1024 + c);
      int nb; bool valid;
      if (t < NL) {
        const int s = t & 4095, col = s & 63, rw = s >> 6, qd = c >> 8;
        if (qd == 0) { valid = col > 0; nb = t - 1; }
        else if (qd == 1) { valid = col < 63; nb = t + 1; }
        else if (qd == 2) { valid = rw > 0; nb = t - 64; }
        else { valid = rw < 63; nb = t + 64; }
      } else {
        const int s = (t - NL) & 255;
        if (c < 512) { valid = s > 0; nb = t - 1; }
        else { valid = s < 255; nb = t + 1; }
      }
      uint4 nv = make_uint4(0, 0, 0, 0);
      if (valid) nv = *(const uint4*)(p.Hd + (size_t)nb * 1024 + c);
#pragma unroll
      for (int j = 0; j < 3; ++j) {
        const int mi = j == 0 ? 0 : j == 1 ? 2 : 3;
        const float4 m0 = *(const float4*)(p.mu + mi * 1024 + c), m1 = *(const float4*)(p.mu + mi * 1024 + c + 4);
        uint4 o;
        o.x = lerp2(own.x, nv.x, m0.x, m0.y); o.y = lerp2(own.y, nv.y, m0.z, m0.w);
        o.z = lerp2(own.z, nv.z, m1.x, m1.y); o.w = lerp2(own.w, nv.w, m1.z, m1.w);
        *(uint4*)(p.S[3 + j] + (size_t)t * 1024 + c) = o;
      }
    }
  }
}

__device__ void phase_proj(const Params& p, char* lds) {
  const int lane = threadIdx.x & 63, wave = threadIdx.x >> 6;
  constexpr int NLORA = (NT / 256) * 3, NRKV = (NT / 256) * 12;
  for (int u = blockIdx.x; u < NLORA; u += gridDim.x) {
    {
      const int wt = wave & 3, wf = wave >> 2, lr = lane & 15, lq = lane >> 4;
      const int mt = u / 3, nt = 24 + u % 3;
      const int mi = nt == 24 ? 5 : nt == 25 ? 1 : 4;
      f32x4 acc[4][4];
      gemm_tile<true>(p.Hd, 1024, p.Wcat, 1024, 1024, mt * 256, nt * 128, lds, acc, p.mu + mi * 1024);
#pragma unroll
      for (int pp = 0; pp < 2; ++pp)
#pragma unroll
        for (int ti = 0; ti < 4; ++ti) {
          const int t = mt * 256 + wt * 64 + ti * 16 + lr;
          const int fl = wf * 64 + pp * 32 + lq * 8;
          f32x4 a = acc[2 * pp][ti], b = acc[2 * pp + 1][ti];
          if (nt == 24) {
#pragma unroll
            for (int j = 0; j < 4; ++j) { a[j] = sigmoidf_(a[j]); b[j] = sigmoidf_(b[j]); }
            store_bf8(p.L1 + (size_t)t * 384 + fl, a, b);
          } else if (nt == 25) {
#pragma unroll
            for (int j = 0; j < 4; ++j) { a[j] = tanhf_(a[j]); b[j] = tanhf_(b[j]); }
            store_bf8(p.L1 + (size_t)t * 384 + 128 + fl, a, b);
          } else {
            store_bf8(p.L1 + (size_t)t * 384 + 256 + fl, a, b);
          }
        }
    }
  }
  for (int v0 = blockIdx.x; v0 < NRKV; v0 += gridDim.x) {
    {
      const int wr = wave >> 2, wc = wave & 3;
      f32x4 acc[2][2][4][2];
      { int mt0, rem0; tile_map(v0, NRKV, NT / 256, 12, mt0, rem0); const int j0 = rem0 >> 2, nt0 = rem0 & 3;
        gemm256_tile<true>(p.Wcat + (size_t)j0 * 1024 * 1024, p.S[3 + j0], 1024, nt0 * 256, mt0 * 256, lds, acc); }
      int lane_o = threadIdx.x & 63; asm volatile("" : "+v"(lane_o));
      int v = v0; asm volatile("" : "+s"(v));
      int mt, rem; tile_map(v, NRKV, NT / 256, 12, mt, rem); const int j = rem >> 2, nt = rem & 3;
      const int fr = lane_o & 15, fq = lane_o >> 4;
#pragma unroll
      for (int bj = 0; bj < 2; ++bj)
#pragma unroll
        for (int n = 0; n < 2; ++n) {
          const int t = mt * 256 + bj * 128 + wc * 32 + n * 16 + fr;
#pragma unroll
          for (int ai = 0; ai < 2; ++ai) {
            const int fh = nt * 256 + ai * 128 + wr * 64;
            if (j == 1) {
              f32x4 a[2], b[2];
              float ss = 0.f;
#pragma unroll
              for (int mp = 0; mp < 2; ++mp) {
                const int f = fh + mp * 32 + fq * 8;
                const float4 kkl = *(const float4*)(p.k_k + f), kkh = *(const float4*)(p.k_k + f + 4);
                a[mp] = acc[ai][bj][2 * mp][n]; b[mp] = acc[ai][bj][2 * mp + 1][n];
                a[mp][0] *= kkl.x; a[mp][1] *= kkl.y; a[mp][2] *= kkl.z; a[mp][3] *= kkl.w;
                b[mp][0] *= kkh.x; b[mp][1] *= kkh.y; b[mp][2] *= kkh.z; b[mp][3] *= kkh.w;
#pragma unroll
                for (int e2 = 0; e2 < 4; ++e2) ss += a[mp][e2] * a[mp][e2] + b[mp][e2] * b[mp][e2];
              }
              ss += __shfl_xor(ss, 16); ss += __shfl_xor(ss, 32);
              const float kinv = rsqrtf(ss + 1e-12f);
#pragma unroll
              for (int mp = 0; mp < 2; ++mp) {
#pragma unroll
                for (int e2 = 0; e2 < 4; ++e2) { a[mp][e2] *= kinv; b[mp][e2] *= kinv; }
                store_bf8(p.S[2] + (size_t)t * 1024 + fh + mp * 32 + fq * 8, a[mp], b[mp]);
              }
              if (fq == 0) p.NRM[(size_t)(fh >> 6) * NT + t] = sqrtf(ss + 1e-12f);
            } else {
              bf16_t* dst = j == 0 ? p.S[0] : p.S[1];
#pragma unroll
              for (int mp = 0; mp < 2; ++mp)
                store_bf8(dst + (size_t)t * 1024 + fh + mp * 32 + fq * 8, acc[ai][bj][2 * mp][n], acc[ai][bj][2 * mp + 1][n]);
            }
          }
        }
    }
  }
}

__device__ void phase_prep(const Params& p, char* lds) {
  const int lane = threadIdx.x & 63, wave = threadIdx.x >> 6;
  const int wt = wave & 3, wf = wave >> 2, lr = lane & 15, lq = lane >> 4;
  const int total = (NT / 256) * 8;
  for (int u = blockIdx.x; u < total; u += gridDim.x) {
    const int mt = u >> 3, nt = u & 7;
    const int tok0 = mt * 256, f0 = nt * 128;
    f32x4 acc[4][4];
    uint4 afp[2][4];
    gemm_tile<false>(p.L1 + 256, 384, p.L2w + 0 * 65536, 64, 64, tok0, f0, lds, acc, nullptr);
#pragma unroll
    for (int pp = 0; pp < 2; ++pp) {
      const int f = f0 + wf * 64 + pp * 32 + lq * 8;
      const float4 a0l = *(const float4*)(p.a0 + f), a0h = *(const float4*)(p.a0 + f + 4);
#pragma unroll
      for (int ti = 0; ti < 4; ++ti) {
        const int t = tok0 + wt * 64 + ti * 16 + lr;
        f32x4 a = acc[2 * pp][ti], b = acc[2 * pp + 1][ti];
        a[0] = sigmoidf_(a[0] + a0l.x); a[1] = sigmoidf_(a[1] + a0l.y); a[2] = sigmoidf_(a[2] + a0l.z); a[3] = sigmoidf_(a[3] + a0l.w);
        b[0] = sigmoidf_(b[0] + a0h.x); b[1] = sigmoidf_(b[1] + a0h.y); b[2] = sigmoidf_(b[2] + a0h.z); b[3] = sigmoidf_(b[3] + a0h.w);
        uint4 o; o.x = pack2(a[0], a[1]); o.y = pack2(a[2], a[3]); o.z = pack2(b[0], b[1]); o.w = pack2(b[2], b[3]);
        afp[pp][ti] = o;
        *(uint4*)(p.S[3] + (size_t)t * 1024 + f) = o;
      }
    }
    gemm_tile<false>(p.L1 + 320, 384, p.L2w + 1 * 65536, 64, 64, tok0, f0, lds, acc, nullptr);
#pragma unroll
    for (int ti = 0; ti < 4; ++ti) {
      const int t = tok0 + wt * 64 + ti * 16 + lr;
      float bon = 0.f;
      const float nrm = p.NRM[(size_t)(nt * 2 + wf) * NT + t];
#pragma unroll
      for (int pp = 0; pp < 2; ++pp) {
        const int f = f0 + wf * 64 + pp * 32 + lq * 8;
        const float4 a0l = *(const float4*)(p.a0 + 1024 + f), a0h = *(const float4*)(p.a0 + 1024 + f + 4);
        const float4 rkl = *(const float4*)(p.r_k + f), rkh = *(const float4*)(p.r_k + f + 4);
        const float4 kal = *(const float4*)(p.k_a + f), kah = *(const float4*)(p.k_a + f + 4);
        const float4 kkl = *(const float4*)(p.k_k + f), kkh = *(const float4*)(p.k_k + f + 4);
        const float rk8[8] = {rkl.x, rkl.y, rkl.z, rkl.w, rkh.x, rkh.y, rkh.z, rkh.w};
        const float ka8[8] = {kal.x, kal.y, kal.z, kal.w, kah.x, kah.y, kah.z, kah.w};
        const float kk8[8] = {kkl.x, kkl.y, kkl.z, kkl.w, kkh.x, kkh.y, kkh.z, kkh.w};
        f32x4 a = acc[2 * pp][ti], b = acc[2 * pp + 1][ti];
        a[0] = sigmoidf_(a[0] + a0l.x); a[1] = sigmoidf_(a[1] + a0l.y); a[2] = sigmoidf_(a[2] + a0l.z); a[3] = sigmoidf_(a[3] + a0l.w);
        b[0] = sigmoidf_(b[0] + a0h.x); b[1] = sigmoidf_(b[1] + a0h.y); b[2] = sigmoidf_(b[2] + a0h.z); b[3] = sigmoidf_(b[3] + a0h.w);
        store_bf8(p.S[4] + (size_t)t * 1024 + f, a, b);
        const float ab8[8] = {a[0], a[1], a[2], a[3], b[0], b[1], b[2], b[3]};
        float af8[8], r8[8], k8[8];
        unpack_bf8(afp[pp][ti], af8);
        unpack_bf8(*(const uint4*)(p.S[0] + (size_t)t * 1024 + f), r8);
        unpack_bf8(*(const uint4*)(p.S[2] + (size_t)t * 1024 + f), k8);
#pragma unroll
        for (int e2 = 0; e2 < 8; ++e2) {
          const float k = k8[e2] * nrm / kk8[e2];
          bon += r8[e2] * k * rk8[e2] * (2.f + (ab8[e2] + af8[e2] - 2.f) * ka8[e2]);
        }
      }
      bon += __shfl_xor(bon, 16); bon += __shfl_xor(bon, 32);
      if (lq == 0) p.BON[(size_t)(nt * 2 + wf) * NT + t] = bon;
    }
#pragma unroll 1
    for (int dr = 0; dr < 2; ++dr) {
      gemm_tile<false>(p.L1 + 128 + dr * 64, 384, p.L2w + (2 + dr) * 65536, 64, 64, tok0, f0, lds, acc, nullptr);
      bf16_t* dst = dr ? p.S[5] : p.Hd;
#pragma unroll
      for (int pp = 0; pp < 2; ++pp) {
        const int f = f0 + wf * 64 + pp * 32 + lq * 8;
        const float4 w0l = *(const float4*)(p.w0 + dr * 1024 + f), w0h = *(const float4*)(p.w0 + dr * 1024 + f + 4);
#pragma unroll
        for (int ti = 0; ti < 4; ++ti) {
          const int t = tok0 + wt * 64 + ti * 16 + lr;
          f32x4 a = acc[2 * pp][ti], b = acc[2 * pp + 1][ti];
          a[0] = -0.60653066f * sigmoidf_(a[0] + w0l.x); a[1] = -0.60653066f * sigmoidf_(a[1] + w0l.y);
          a[2] = -0.60653066f * sigmoidf_(a[2] + w0l.z); a[3] = -0.60653066f * sigmoidf_(a[3] + w0l.w);
          b[0] = -0.60653066f * sigmoidf_(b[0] + w0h.x); b[1] = -0.60653066f * sigmoidf_(b[1] + w0h.y);
          b[2] = -0.60653066f * sigmoidf_(b[2] + w0h.z); b[3] = -0.60653066f * sigmoidf_(b[3] + w0h.w);
          store_bf8(dst + (size_t)t * 1024 + f, a, b);
        }
      }
    }
  }
}

typedef short s16x4 __attribute__((ext_vector_type(4)));
#define MFMA16K(a, b, c) __builtin_amdgcn_mfma_f32_16x16x16bf16_1k((a), (b), (c), 0, 0, 0)
DI s16x4 pack4(const f32x4& x) { const uint2 u = make_uint2(pack2(x[0], x[1]), pack2(x[2], x[3])); return __builtin_bit_cast(s16x4, u); }
DI bf16x8 pack8(const f32x4& a, const f32x4& b) { const uint4 u = make_uint4(pack2(a[0], a[1]), pack2(a[2], a[3]), pack2(b[0], b[1]), pack2(b[2], b[3])); return __builtin_bit_cast(bf16x8, u); }
constexpr int SC_KK = 0, SC_R = 2304, SC_B = 4608, SC_K = 6912, SC_BT = 9216, SC_KT = 12288, SC_VT = 15360, SC_CL = 18432, SC_CHUNK = 18688, SC_GROUP = 2 * SC_CHUNK, SC_YBUF = 2 * SC_GROUP;

#define KEEP8(x) asm volatile("" :: "v"(x))
#define KEEP4(x) asm volatile("" :: "v"(x))
DI void scan_chunk(const char* cb, float* yb, f32x4 (&ST)[4], int vb, int c, int q) {
  const f32x4 z = {0.f, 0.f, 0.f, 0.f};
  bf16x8 fB[2], fK[2], fKK[2], fR[2];
#pragma unroll
  for (int ks = 0; ks < 2; ++ks) {
    fB[ks] = *(const bf16x8*)(cb + SC_B + c * 144 + ks * 64 + q * 16);
    fK[ks] = *(const bf16x8*)(cb + SC_K + c * 144 + ks * 64 + q * 16);
    fKK[ks] = *(const bf16x8*)(cb + SC_KK + c * 144 + ks * 64 + q * 16);
    fR[ks] = *(const bf16x8*)(cb + SC_R + c * 144 + ks * 64 + q * 16);
  }
  f32x4 Abk = MFMA16(fB[0], fKK[0], z);  Abk = MFMA16(fB[1], fKK[1], Abk);
  f32x4 AbkT = MFMA16(fKK[0], fB[0], z); AbkT = MFMA16(fKK[1], fB[1], AbkT);
  f32x4 Akk = MFMA16(fK[0], fKK[0], z);  Akk = MFMA16(fK[1], fKK[1], Akk);
  f32x4 Abr = MFMA16(fB[0], fR[0], z);   Abr = MFMA16(fB[1], fR[1], Abr);
  f32x4 Akr = MFMA16(fK[0], fR[0], z);   Akr = MFMA16(fK[1], fR[1], Akr);
  KEEP8(fB[0]); KEEP8(fB[1]); KEEP8(fK[0]); KEEP8(fK[1]); KEEP8(fKK[0]); KEEP8(fKK[1]); KEEP8(fR[0]); KEEP8(fR[1]);
  f32x4 P;
#pragma unroll
  for (int j = 0; j < 4; ++j) {
    const int rr = 4 * q + j;
    Abk[j] = rr < c ? Abk[j] : 0.f;  Akk[j] = rr < c ? Akk[j] : 0.f;
    Abr[j] = rr <= c ? Abr[j] : 0.f; Akr[j] = rr <= c ? Akr[j] : 0.f;
    AbkT[j] = c < rr ? AbkT[j] : 0.f;
    P[j] = (rr == c ? 1.f : 0.f) - Abk[j];
  }
  const s16x4 bN = pack4(Abk), bNT = pack4(AbkT);
  const f32x4 N2 = MFMA16K(bNT, bN, z), N2T = MFMA16K(bN, bNT, z);
  KEEP4(bN); KEEP4(bNT);
  const s16x4 bN2 = pack4(N2), bN2T = pack4(N2T);
  const f32x4 N4 = MFMA16K(bN2T, bN2, z), N4T = MFMA16K(bN2, bN2T, z);
  KEEP4(bN2); KEEP4(bN2T);
  const s16x4 bN4 = pack4(N4), bN4T = pack4(N4T);
  const f32x4 N8T = MFMA16K(bN4, bN4T, z);
  KEEP4(bN4); KEEP4(bN4T);
  const s16x4 bN8T = pack4(N8T);
  { const s16x4 pp_ = pack4(P); P = MFMA16K(bN2T, pp_, P); KEEP4(pp_); KEEP4(bN2T); }
  { const s16x4 pp_ = pack4(P); P = MFMA16K(bN4T, pp_, P); KEEP4(pp_); KEEP4(bN4T); }
  { const s16x4 pp_ = pack4(P); P = MFMA16K(bN8T, pp_, P); KEEP4(pp_); KEEP4(bN8T); }
  const s16x4 bT = pack4(P);
  bf16x8 sf[2], kkp[2], rp[2];
#pragma unroll
  for (int i = 0; i < 2; ++i) {
    sf[i] = pack8(ST[2 * i], ST[2 * i + 1]);
    const uint2 klo = *(const uint2*)(cb + SC_KK + c * 144 + (32 * i + 4 * q) * 2), khi = *(const uint2*)(cb + SC_KK + c * 144 + (32 * i + 16 + 4 * q) * 2);
    const uint2 rlo = *(const uint2*)(cb + SC_R + c * 144 + (32 * i + 4 * q) * 2), rhi = *(const uint2*)(cb + SC_R + c * 144 + (32 * i + 16 + 4 * q) * 2);
    kkp[i] = __builtin_bit_cast(bf16x8, make_uint4(klo.x, klo.y, khi.x, khi.y));
    rp[i] = __builtin_bit_cast(bf16x8, make_uint4(rlo.x, rlo.y, rhi.x, rhi.y));
  }
  f32x4 XT = MFMA16(kkp[0], sf[0], z); XT = MFMA16(kkp[1], sf[1], XT);
  f32x4 YT = MFMA16(rp[0], sf[0], z);  YT = MFMA16(rp[1], sf[1], YT);
  KEEP8(kkp[0]); KEEP8(kkp[1]); KEEP8(rp[0]); KEEP8(rp[1]); KEEP8(sf[0]); KEEP8(sf[1]);
  const s16x4 vf = *(const s16x4*)(cb + SC_VT + (vb * 16 + c) * 48 + q * 8);
  const s16x4 pAkk = pack4(Akk);
  XT = MFMA16K(pAkk, vf, XT); KEEP4(pAkk);
  const s16x4 pXT = pack4(XT);
  f32x4 UT = MFMA16K(bT, pXT, z); KEEP4(pXT); KEEP4(bT);
#pragma unroll
  for (int j = 0; j < 4; ++j) UT[j] = -UT[j];
  const s16x4 bU = pack4(UT);
  const s16x4 pAbr = pack4(Abr), pAkr = pack4(Akr);
  YT = MFMA16K(pAbr, bU, YT);
  YT = MFMA16K(pAkr, vf, YT); KEEP4(pAbr); KEEP4(pAkr);
#pragma unroll
  for (int j = 0; j < 4; ++j) yb[(4 * q + j) * 64 + vb * 16 + c] = YT[j];
#pragma unroll
  for (int kt = 0; kt < 4; ++kt) {
    const s16x4 bh = *(const s16x4*)(cb + SC_BT + (16 * kt + c) * 48 + q * 8);
    const s16x4 kh = *(const s16x4*)(cb + SC_KT + (16 * kt + c) * 48 + q * 8);
    f32x4 s = MFMA16K(bh, bU, ST[kt]);
    s = MFMA16K(kh, vf, s); KEEP4(bh); KEEP4(kh);
    const float4 cl = *(const float4*)(cb + SC_CL + (16 * kt + 4 * q) * 4);
    s[0] *= cl.x; s[1] *= cl.y; s[2] *= cl.z; s[3] *= cl.w;
    ST[kt] = s;
  }
  KEEP4(bU); KEEP4(vf);
}

__device__ void phase_scan(const Params& p, char* lds, bool dupout = false) {
  float* ybuf = (float*)(lds + SC_YBUF);
  const int tid = threadIdx.x, lane = tid & 63, wave = tid >> 6;
  const bool loader = tid >= 256;
  const int lt = tid & 255, ltk = lt >> 3, lch = (lt & 7) * 8;
  const int lcc = (wave >> 1) & 1, lchh = wave & 1, ltok = lane >> 2, loct = lane & 3, ch0 = lchh * 32 + loct * 8;
  const int vb = wave & 3, cc_ = lane & 15, qq = lane >> 4;
  constexpr int NG = NKEY / 32;
  for (int unit = blockIdx.x; unit < 256; unit += gridDim.x) {
    const int dir = unit & 1, h = (unit >> 1) & 15, b = unit >> 5;
    const bf16_t* Rp = p.S[0]; const bf16_t* Vp = p.S[1]; const bf16_t* Kp = p.S[2];
    bf16_t* Ap = dir ? p.S[4] : p.S[3];
    const bf16_t* Lp = dir ? p.S[5] : p.Hd;
    auto tok_of = [&](int i) -> int {
      if (i < 256) return NL + b * 256 + (dir ? 255 - i : i);
      const int s = i - 256;
      return b * 4096 + (dir ? 4095 - s : s);
    };
    uint4 rawA[5], rawB[5];
    float nrmA = 0.f, nrmB = 0.f;
    float rkk[8], kac[8];
    f32x4 ST[4];
#pragma unroll
    for (int i = 0; i < 4; ++i) ST[i] = f32x4{0.f, 0.f, 0.f, 0.f};
    if (loader) {
#pragma unroll
      for (int j = 0; j < 8; ++j) { rkk[j] = 1.f / p.k_k[h * 64 + ch0 + j]; kac[j] = p.k_a[h * 64 + ch0 + j]; }
    }
    auto issue = [&](int g, uint4 (&rw)[5], float& nv) {
      const int t = tok_of(g * 32 + lcc * 16 + ltok);
      const size_t off = (size_t)t * 1024 + h * 64 + ch0;
      rw[0] = *(const uint4*)(Rp + off); rw[1] = *(const uint4*)(Vp + off); rw[2] = *(const uint4*)(Kp + off);
      rw[3] = *(const uint4*)(Ap + off); rw[4] = *(const uint4*)(Lp + off);
      nv = p.NRM[(size_t)h * NT + t];
    };
    auto process = [&](int stage, const uint4 (&raw)[5], const float nrmv) {
      float r8[8], kk8[8], a8[8], l8[8], L[8];
      unpack_bf8(raw[0], r8); unpack_bf8(raw[2], kk8); unpack_bf8(raw[3], a8); unpack_bf8(raw[4], l8);
#pragma unroll
      for (int j = 0; j < 8; ++j) L[j] = l8[j];
#pragma unroll
      for (int d = 4; d < 64; d <<= 1) {
#pragma unroll
        for (int j = 0; j < 8; ++j) { const float o = __shfl_up(L[j], d); if (lane >= d) L[j] += o; }
      }
      float okk[8], orr[8], ob[8], ok[8], cend[8];
#pragma unroll
      for (int j = 0; j < 8; ++j) {
        const float cc = __expf(L[j]), cprev = __expf(L[j] - l8[j]), cinv = __expf(-L[j]);
        const float k = kk8[j] * nrmv * rkk[j];
        const float kd = k * (1.f + (a8[j] - 1.f) * kac[j]);
        okk[j] = kk8[j] * cprev; orr[j] = r8[j] * cc; ob[j] = kk8[j] * a8[j] * cinv; ok[j] = kd * cinv; cend[j] = cc;
      }
      char* cb = lds + stage * SC_GROUP + lcc * SC_CHUNK;
      uint4 o;
      o = make_uint4(pack2(okk[0], okk[1]), pack2(okk[2], okk[3]), pack2(okk[4], okk[5]), pack2(okk[6], okk[7])); *(uint4*)(cb + SC_KK + ltok * 144 + ch0 * 2) = o;
      o = make_uint4(pack2(orr[0], orr[1]), pack2(orr[2], orr[3]), pack2(orr[4], orr[5]), pack2(orr[6], orr[7])); *(uint4*)(cb + SC_R + ltok * 144 + ch0 * 2) = o;
      const uint4 obp = make_uint4(pack2(ob[0], ob[1]), pack2(ob[2], ob[3]), pack2(ob[4], ob[5]), pack2(ob[6], ob[7])); *(uint4*)(cb + SC_B + ltok * 144 + ch0 * 2) = obp;
      const uint4 okp = make_uint4(pack2(ok[0], ok[1]), pack2(ok[2], ok[3]), pack2(ok[4], ok[5]), pack2(ok[6], ok[7])); *(uint4*)(cb + SC_K + ltok * 144 + ch0 * 2) = okp;
      const unsigned bw[4] = {obp.x, obp.y, obp.z, obp.w}, kw[4] = {okp.x, okp.y, okp.z, okp.w}, vw[4] = {raw[1].x, raw[1].y, raw[1].z, raw[1].w};
#pragma unroll
      for (int j = 0; j < 8; ++j) {
        const int sh = (j & 1) * 16;
        *(bf16_t*)(cb + SC_BT + (ch0 + j) * 48 + ltok * 2) = (bf16_t)((bw[j >> 1] >> sh) & 0xffffu);
        *(bf16_t*)(cb + SC_KT + (ch0 + j) * 48 + ltok * 2) = (bf16_t)((kw[j >> 1] >> sh) & 0xffffu);
        *(bf16_t*)(cb + SC_VT + (ch0 + j) * 48 + ltok * 2) = (bf16_t)((vw[j >> 1] >> sh) & 0xffffu);
      }
      if (ltok == 15) {
        *(float4*)(cb + SC_CL + ch0 * 4) = make_float4(cend[0], cend[1], cend[2], cend[3]);
        *(float4*)(cb + SC_CL + ch0 * 4 + 16) = make_float4(cend[4], cend[5], cend[6], cend[7]);
      }
    };
    auto yout = [&](int g) {
      const float* yb = ybuf + (g & 1) * 2048 + ltk * 64 + lch;
      const float4 y0 = *(const float4*)yb, y1 = *(const float4*)(yb + 4);
      const int t = tok_of(g * 32 + ltk);
      uint4 o;
      o.x = pack2(y0.x, y0.y); o.y = pack2(y0.z, y0.w); o.z = pack2(y1.x, y1.y); o.w = pack2(y1.z, y1.w);
      *(uint4*)((dupout ? p.S[0] : Ap) + (size_t)t * 1024 + h * 64 + lch) = o;
    };
    __syncthreads();
    if (loader) { issue(0, rawA, nrmA); issue(1, rawB, nrmB); process(0, rawA, nrmA); issue(2, rawA, nrmA); }
    __syncthreads();
    for (int g = 0; g < NG; g += 2) {
      if (loader) {
        if (g >= 1) yout(g - 1);
        if (g + 1 < NG) { process(1, rawB, nrmB); if (g + 3 < NG) issue(g + 3, rawB, nrmB); }
      } else {
        const char* gb = lds;
        float* yb = ybuf;
        scan_chunk(gb, yb, ST, vb, cc_, qq);
        scan_chunk(gb + SC_CHUNK, yb + 16 * 64, ST, vb, cc_, qq);
      }
      __syncthreads();
      if (g + 1 < NG) {
        if (loader) {
          yout(g);
          if (g + 2 < NG) { process(0, rawA, nrmA); if (g + 4 < NG) issue(g + 4, rawA, nrmA); }
        } else {
          const char* gb = lds + SC_GROUP;
          float* yb = ybuf + 2048;
          scan_chunk(gb, yb, ST, vb, cc_, qq);
          scan_chunk(gb + SC_CHUNK, yb + 16 * 64, ST, vb, cc_, qq);
        }
        __syncthreads();
      }
    }
    if (loader) yout(NG - 1);
    __syncthreads();
  }
}

__device__ void phase_readout(const Params& p, char* lds) {
  const int lane = threadIdx.x & 63, wave = threadIdx.x >> 6;
  const int wt = wave & 3, wf = wave >> 2, lr = lane & 15, lq = lane >> 4;
  const int total = (NT / 256) * 8;
  for (int u = blockIdx.x; u < total; u += gridDim.x) {
    const int mt = u >> 3, nt = u & 7;
    const int tok0 = mt * 256, f0 = nt * 128;
    f32x4 g[4][4];
    gemm_tile<false>(p.L1, 384, p.g2T, 128, 128, tok0, f0, lds, g, nullptr);
    const int head = nt * 2 + wf;
#pragma unroll
    for (int ti = 0; ti < 4; ++ti) {
      const int t = tok0 + wt * 64 + ti * 16 + lr;
      float y[2][8];
      float sum = 0.f;
#pragma unroll
      for (int pp = 0; pp < 2; ++pp) {
        const int f = f0 + wf * 64 + pp * 32 + lq * 8;
        float ya[8], yb[8];
        unpack_bf8(*(const uint4*)(p.S[3] + (size_t)t * 1024 + f), ya);
        unpack_bf8(*(const uint4*)(p.S[4] + (size_t)t * 1024 + f), yb);
#pragma unroll
        for (int e2 = 0; e2 < 8; ++e2) { y[pp][e2] = ya[e2] + yb[e2]; sum += y[pp][e2]; }
      }
      sum += __shfl_xor(sum, 16); sum += __shfl_xor(sum, 32);
      const float mean = sum * (1.f / 64.f);
      float vs = 0.f;
#pragma unroll
      for (int pp = 0; pp < 2; ++pp)
#pragma unroll
        for (int e2 = 0; e2 < 8; ++e2) { const float d = y[pp][e2] - mean; vs += d * d; }
      vs += __shfl_xor(vs, 16); vs += __shfl_xor(vs, 32);
      const float rstd = rsqrtf(vs * (1.f / 64.f) + 64e-5f);
      const float bon = p.BON[(size_t)head * NT + t];
#pragma unroll
      for (int pp = 0; pp < 2; ++pp) {
        const int f = f0 + wf * 64 + pp * 32 + lq * 8;
        const float4 lwl = *(const float4*)(p.ln_w + f), lwh = *(const float4*)(p.ln_w + f + 4);
        const float4 lbl = *(const float4*)(p.ln_b + f), lbh = *(const float4*)(p.ln_b + f + 4);
        const float lw8[8] = {lwl.x, lwl.y, lwl.z, lwl.w, lwh.x, lwh.y, lwh.z, lwh.w};
        const float lb8[8] = {lbl.x, lbl.y, lbl.z, lbl.w, lbh.x, lbh.y, lbh.z, lbh.w};
        float v8[8];
        unpack_bf8(*(const uint4*)(p.S[1] + (size_t)t * 1024 + f), v8);
        f32x4 oa, ob;
#pragma unroll
        for (int j = 0; j < 4; ++j) {
          oa[j] = ((y[pp][j] - mean) * rstd * lw8[j] + lb8[j] + bon * v8[j]) * g[2 * pp][ti][j];
          ob[j] = ((y[pp][4 + j] - mean) * rstd * lw8[4 + j] + lb8[4 + j] + bon * v8[4 + j]) * g[2 * pp + 1][ti][j];
        }
        store_bf8(p.S[0] + (size_t)t * 1024 + f, oa, ob);
      }
    }
  }
}

DI void phase_gemm_resid(const Params& p, char* lds, const bf16_t* A, const bf16_t* W, int K, int ntm,
                                 const float* xin_l, const float* xin_c, const float* gate, float* dummy_out = nullptr) {
  const int lane = threadIdx.x & 63, wave = threadIdx.x >> 6;
  const int wr = wave >> 2, wc = wave & 3;
  const int total = ntm * 4;
  for (int u = blockIdx.x; u < total; u += gridDim.x) {
    int mt, nt; tile_map(u, total, ntm, 4, mt, nt);
    f32x4 acc[2][2][4][2];
    gemm256_tile<true>(W, A, K, nt * 256, mt * 256, lds, acc);
    int lane_o = threadIdx.x & 63; asm volatile("" : "+v"(lane_o));
    const int fr = lane_o & 15, fq = lane_o >> 4;
#pragma unroll
    for (int bj = 0; bj < 2; ++bj)
#pragma unroll
      for (int n = 0; n < 2; ++n) {
        const int t = mt * 256 + bj * 128 + wc * 32 + n * 16 + fr;
        const int bp = t < NL ? (t >> 12) : 8;
        const float* xi = t < NL ? xin_l + (size_t)t * 1024 : xin_c + (size_t)(t - NL) * 1024;
        float* xo = dummy_out ? dummy_out + (size_t)t * 1024 : (t < NL ? p.out + (size_t)t * 1024 : p.XC + (size_t)(t - NL) * 1024);
#pragma unroll
        for (int ai = 0; ai < 2; ++ai)
#pragma unroll
          for (int mp = 0; mp < 2; ++mp) {
            const int f = nt * 256 + ai * 128 + wr * 64 + mp * 32 + fq * 8;
            const float4 g0 = *(const float4*)(gate + bp * 6144 + f), g1 = *(const float4*)(gate + bp * 6144 + f + 4);
            const float4 x0 = *(const float4*)(xi + f), x1 = *(const float4*)(xi + f + 4);
            const f32x4 a = acc[ai][bj][2 * mp][n], b = acc[ai][bj][2 * mp + 1][n];
            *(float4*)(xo + f) = make_float4(x0.x + g0.x * a[0], x0.y + g0.y * a[1], x0.z + g0.z * a[2], x0.w + g0.w * a[3]);
            *(float4*)(xo + f + 4) = make_float4(x1.x + g1.x * b[0], x1.y + g1.y * b[1], x1.z + g1.z * b[2], x1.w + g1.w * b[3]);
          }
      }
  }
}

DI void phase_up(const Params& p, char* lds, const bf16_t* H, const bf16_t* W, bf16_t* U, int ntm) {
  const int lane = threadIdx.x & 63, wave = threadIdx.x >> 6;
  const int wr = wave >> 2, wc = wave & 3;
  const int total = ntm * 16;
  for (int u = blockIdx.x; u < total; u += gridDim.x) {
    int mt, nt; tile_map(u, total, ntm, 16, mt, nt);
    f32x4 acc[2][2][4][2];
    gemm256_tile<true>(W, H, 1024, nt * 256, mt * 256, lds, acc);
    int lane_o = threadIdx.x & 63; asm volatile("" : "+v"(lane_o));
    const int fr = lane_o & 15, fq = lane_o >> 4;
#pragma unroll
    for (int bj = 0; bj < 2; ++bj)
#pragma unroll
      for (int n = 0; n < 2; ++n) {
        const int t = mt * 256 + bj * 128 + wc * 32 + n * 16 + fr;
#pragma unroll
        for (int ai = 0; ai < 2; ++ai)
#pragma unroll
          for (int mp = 0; mp < 2; ++mp) {
            const int f = nt * 256 + ai * 128 + wr * 64 + mp * 32 + fq * 8;
            f32x4 a = acc[ai][bj][2 * mp][n], b = acc[ai][bj][2 * mp + 1][n];
#pragma unroll
            for (int j = 0; j < 4; ++j) { const float ra = fmaxf(a[j], 0.f), rb = fmaxf(b[j], 0.f); a[j] = ra * ra; b[j] = rb * rb; }
            store_bf8(U + (size_t)t * 4096 + f, a, b);
          }
      }
  }
}

__device__ void phase_qkv(const Params& p, char* lds) {
  const int lane = threadIdx.x & 63, wave = threadIdx.x >> 6;
  const int wr = wave >> 2, wc = wave & 3;
  const int total = (NT / 256) * 6;
  bf16_t* Q = p.S[0]; bf16_t* KA = p.S[1]; bf16_t* VT = p.S[2];
  for (int u = blockIdx.x; u < total; u += gridDim.x) {
    int mt, nt; tile_map(u, total, NT / 256, 6, mt, nt);
    if (mt >= NL / 256 && nt < 4) continue;
    f32x4 acc[2][2][4][2];
    gemm256_tile<false>(p.wqkvT, p.S[5], 1024, nt * 256, mt * 256, lds, acc);
    int lane_o = threadIdx.x & 63; asm volatile("" : "+v"(lane_o));
    const int fr = lane_o & 15, fq = lane_o >> 4;
#pragma unroll
    for (int bj = 0; bj < 2; ++bj)
#pragma unroll
      for (int n = 0; n < 2; ++n) {
        const int t = mt * 256 + bj * 128 + wc * 32 + n * 16 + fr;
        const bool lat = t < NL;
        const int b = lat ? (t >> 12) : ((t - NL) >> 8);
        const int key = lat ? (t & 4095) : 4096 + ((t - NL) & 255);
#pragma unroll
        for (int ai = 0; ai < 2; ++ai) {
          const int hh = ai * 2 + wr;
          asm volatile("" ::: "memory");
          if (nt < 5) {
            float ss = 0.f;
#pragma unroll
            for (int m = 0; m < 4; ++m)
#pragma unroll
              for (int j = 0; j < 4; ++j) ss += acc[ai][bj][m][n][j] * acc[ai][bj][m][n][j];
            ss += __shfl_xor(ss, 16); ss += __shfl_xor(ss, 32);
            const float rstd = rsqrtf(ss * (1.f / 64.f) + 1e-6f);
            const float* gn = nt < 4 ? p.q_norm : p.k_norm;
            float v[4][4];
#pragma unroll
            for (int m = 0; m < 4; ++m) {
              const float4 g4 = *(const float4*)(gn + m * 16 + fq * 4);
              v[m][0] = acc[ai][bj][m][n][0] * rstd * g4.x; v[m][1] = acc[ai][bj][m][n][1] * rstd * g4.y;
              v[m][2] = acc[ai][bj][m][n][2] * rstd * g4.z; v[m][3] = acc[ai][bj][m][n][3] * rstd * g4.w;
            }
            if (lat) {
              const int s = t & 4095, rowp = s >> 6, colp = s & 63;
#pragma unroll
              for (int j = 0; j < 4; ++j) {
                const float2 cs0 = *(const float2*)(p.TAB + (rowp * 16 + fq * 4 + j) * 2);
                const float2 cs1 = *(const float2*)(p.TAB + (colp * 16 + fq * 4 + j) * 2);
                const float x1 = v[0][j], x2 = v[1][j], z1 = v[2][j], z2 = v[3][j];
                v[0][j] = x1 * cs0.x - x2 * cs0.y; v[1][j] = x2 * cs0.x + x1 * cs0.y;
                v[2][j] = z1 * cs1.x - z2 * cs1.y; v[3][j] = z2 * cs1.x + z1 * cs1.y;
              }
            }
            if (nt < 4) {
              const float qs = 0.125f * 1.4426950408889634f;
              const int head = nt * 4 + hh;
#pragma unroll
              for (int m = 0; m < 4; ++m)
                store_bf4(Q + (size_t)t * 1024 + head * 64 + m * 16 + fq * 4, v[m][0] * qs, v[m][1] * qs, v[m][2] * qs, v[m][3] * qs);
            } else {
#pragma unroll
              for (int m = 0; m < 4; ++m)
                store_bf4(KA + ((size_t)(b * 4 + hh) * NKEY + key) * 64 + m * 16 + fq * 4, v[m][0], v[m][1], v[m][2], v[m][3]);
            }
          } else {
#pragma unroll
            for (int m = 0; m < 4; ++m)
#pragma unroll
              for (int j = 0; j < 4; ++j) {
                const int d = m * 16 + fq * 4 + j;
                const unsigned pk = pack2(acc[ai][bj][m][n][j], 0.f);
                VT[((size_t)(b * 4 + hh) * 64 + d) * NKEY + key] = (bf16_t)(pk & 0xffffu);
              }
          }
        }
      }
  }
}

__device__ void phase_attn(const Params& p, char* lds) {
  const int tid = threadIdx.x, lane = tid & 63, wave = tid >> 6;
  const int l31 = lane & 31, lh = lane >> 5;
  const int srow = tid >> 3, sch = tid & 7;
  const bf16_t* Q = p.S[0]; const bf16_t* KA = p.S[1]; const bf16_t* VT = p.S[2]; bf16_t* O = p.S[3];
  float gq = 0.f, gk = 0.f;
  for (int i = 0; i < 64; ++i) { gq = fmaxf(gq, fabsf(p.q_norm[i])); gk = fmaxf(gk, fabsf(p.k_norm[i])); }
  const float M2 = 8.f * gq * gk * 1.4426950408889634f;
  constexpr int NKT = NKEY / 64;
  constexpr int AST = 2 * 64 * ROWB;
  for (int u = blockIdx.x; u < 1024; u += gridDim.x) {
    const int qb = u & 7, head = (u >> 3) & 15, b = u >> 7, kvh = head >> 2;
    const bf16_t* Kg = KA + (size_t)(b * 4 + kvh) * NKEY * 64;
    const bf16_t* Vg = VT + (size_t)(b * 4 + kvh) * 64 * NKEY;
    const int tq0 = b * 4096 + qb * 512 + wave * 64 + l31;
    bf16x8 qf[2][4];
#pragma unroll
    for (int blk = 0; blk < 2; ++blk)
#pragma unroll
      for (int s = 0; s < 4; ++s) qf[blk][s] = *(const bf16x8*)(Q + (size_t)(tq0 + blk * 32) * 1024 + head * 64 + s * 16 + lh * 8);
    f32x16 o[2][2];
#pragma unroll
    for (int blk = 0; blk < 2; ++blk)
#pragma unroll
      for (int dt = 0; dt < 2; ++dt)
#pragma unroll
        for (int i = 0; i < 16; ++i) o[blk][dt][i] = 0.f;
    float lsum[2] = {0.f, 0.f};
    uint4 kreg, vreg;
    __syncthreads();
    for (int kt = -1; kt < NKT; ++kt) {
      const bool more = kt + 1 < NKT;
      if (more) {
        kreg = *(const uint4*)(Kg + (size_t)((kt + 1) * 64 + srow) * 64 + sch * 8);
        vreg = *(const uint4*)(Vg + (size_t)srow * NKEY + (kt + 1) * 64 + sch * 8);
      }
      if (kt >= 0) {
        const char* ksm = lds + (kt & 1) * AST;
        const char* vsm = ksm + 64 * ROWB;
        f32x16 sT[2][2];
#pragma unroll
        for (int blk = 0; blk < 2; ++blk)
#pragma unroll
          for (int k2 = 0; k2 < 2; ++k2)
#pragma unroll
            for (int i = 0; i < 16; ++i) sT[blk][k2][i] = -M2;
#pragma unroll
        for (int k2 = 0; k2 < 2; ++k2)
#pragma unroll
          for (int s = 0; s < 4; ++s) {
            const bf16x8 kf = *(const bf16x8*)(ksm + (k2 * 32 + l31) * ROWB + s * 32 + lh * 16);
            sT[0][k2] = MFMA32(kf, qf[0][s], sT[0][k2]);
            sT[1][k2] = MFMA32(kf, qf[1][s], sT[1][k2]);
          }
#pragma unroll
        for (int blk = 0; blk < 2; ++blk)
#pragma unroll
          for (int k2 = 0; k2 < 2; ++k2)
#pragma unroll
            for (int i = 0; i < 16; ++i) { const float pv = __builtin_amdgcn_exp2f(sT[blk][k2][i]); lsum[blk] += pv; sT[blk][k2][i] = pv; }
#pragma unroll
        for (int k2 = 0; k2 < 2; ++k2)
#pragma unroll
          for (int s2 = 0; s2 < 2; ++s2) {
            bf16x8 pf[2];
#pragma unroll
            for (int blk = 0; blk < 2; ++blk) {
              uint4 pk;
              pk.x = pack2(sT[blk][k2][8 * s2 + 0], sT[blk][k2][8 * s2 + 1]); pk.y = pack2(sT[blk][k2][8 * s2 + 2], sT[blk][k2][8 * s2 + 3]);
              pk.z = pack2(sT[blk][k2][8 * s2 + 4], sT[blk][k2][8 * s2 + 5]); pk.w = pack2(sT[blk][k2][8 * s2 + 6], sT[blk][k2][8 * s2 + 7]);
              pf[blk] = __builtin_bit_cast(bf16x8, pk);
            }
            const int koff = (k2 * 32 + 16 * s2 + 4 * lh) * 2;
#pragma unroll
            for (int dt = 0; dt < 2; ++dt) {
              const uint2 lo = *(const uint2*)(vsm + (dt * 32 + l31) * ROWB + koff), hi = *(const uint2*)(vsm + (dt * 32 + l31) * ROWB + koff + 16);
              const bf16x8 vv = __builtin_bit_cast(bf16x8, make_uint4(lo.x, lo.y, hi.x, hi.y));
              o[0][dt] = MFMA32(vv, pf[0], o[0][dt]);
              o[1][dt] = MFMA32(vv, pf[1], o[1][dt]);
            }
          }
      }
      if (more) {
        const int st = (kt + 1) & 1;
        *(uint4*)(lds + st * AST + srow * ROWB + sch * 16) = kreg;
        *(uint4*)(lds + st * AST + 64 * ROWB + srow * ROWB + sch * 16) = vreg;
      }
      __syncthreads();
    }
#pragma unroll
    for (int blk = 0; blk < 2; ++blk) {
      float ls = lsum[blk];
      ls += __shfl_xor(ls, 32);
      const float inv = 1.f / ls;
      const int tq = tq0 + blk * 32;
#pragma unroll
      for (int g = 0; g < 4; ++g) {
        const int d0 = 8 * g + 4 * lh;
        store_bf4(O + (size_t)tq * 1024 + head * 64 + d0, o[blk][0][4 * g] * inv, o[blk][0][4 * g + 1] * inv, o[blk][0][4 * g + 2] * inv, o[blk][0][4 * g + 3] * inv);
        store_bf4(O + (size_t)tq * 1024 + head * 64 + 32 + d0, o[blk][1][4 * g] * inv, o[blk][1][4 * g + 1] * inv, o[blk][1][4 * g + 2] * inv, o[blk][1][4 * g + 3] * inv);
      }
    }
  }
}

#define XB_TMO      128
#define XB_XCNT(j)  (256  + 64 * (j))
#define XB_XSUB(j)  (1280 + 64 * (j))
#define XB_XGEN(j)  (2304 + 64 * (j))
#define XB_TOP      3328
#define XB_TOPGEN   3392
#define XCD_BAR_WORDS 3456
#define XB_SPIN_CAP (1u << 18)
#define LAS __attribute__((address_space(3)))

__device__ __forceinline__ unsigned xb_ld(unsigned* p)              { return __hip_atomic_load(p, __ATOMIC_RELAXED, __HIP_MEMORY_SCOPE_AGENT); }
__device__ __forceinline__ unsigned xb_add(unsigned* p, unsigned v) { return __hip_atomic_fetch_add(p, v, __ATOMIC_RELAXED, __HIP_MEMORY_SCOPE_AGENT); }
__device__ __forceinline__ unsigned xb_xcc_id() { return (unsigned)__builtin_amdgcn_s_getreg((3 << 11) | 20) & 0xFu; }
#define XB_SPIN(cond, bar) do { unsigned _sp = 0; while (cond) { __builtin_amdgcn_s_sleep(1); \
    if ((++_sp & 255u) == 0u) { if (xb_ld(&(bar)[XB_TMO])) break; if (_sp > XB_SPIN_CAP) { atomicAdd(&(bar)[XB_TMO], 1u); break; } } } } while (0)

struct XcdBarrier {
    unsigned* bar; unsigned x;
    volatile LAS unsigned* st;
};

__device__ __forceinline__ XcdBarrier xcd_barrier_post(unsigned* bar, volatile LAS unsigned* st) {
    XcdBarrier b; b.bar = bar; b.x = xb_xcc_id(); b.st = st;
    if (threadIdx.x == 0) (void)xb_add(&bar[XB_XCNT(b.x)], 1u);
    return b;
}
__device__ __forceinline__ void xcd_barrier_complete(unsigned* bar, unsigned x, unsigned& nloc, unsigned& nx) {
    const unsigned G = gridDim.x * gridDim.y * gridDim.z;
    unsigned sum, cnt, mine, sp = 0u;
    for (;;) {
        sum = 0u; cnt = 0u; mine = 0u;
#pragma unroll
        for (unsigned j = 0; j < 16; ++j) { const unsigned c = xb_ld(&bar[XB_XCNT(j)]); sum += c; cnt += (c > 0u) ? 1u : 0u; mine = (j == x) ? c : mine; }
        if (sum == G) break;
        __builtin_amdgcn_s_sleep(1);
        if ((++sp & 255u) == 0u) { if (xb_ld(&bar[XB_TMO])) break; if (sp > XB_SPIN_CAP) { atomicAdd(&bar[XB_TMO], 1u); break; } }
    }
    nloc = mine > 0u ? mine : 1u; nx = cnt > 0u ? cnt : 1u;
}

__device__ __forceinline__ void xcd_barrier(const XcdBarrier& b) {
    asm volatile("s_waitcnt vmcnt(0)" ::: "memory");
    __syncthreads();
    if (threadIdx.x == 0) {
        unsigned* bar = b.bar;
        __builtin_amdgcn_s_waitcnt(0);
        unsigned nloc = b.st[0], nx = b.st[1];
        if (nloc == 0u) { xcd_barrier_complete(bar, b.x, nloc, nx); b.st[0] = nloc; b.st[1] = nx; }
        const unsigned old = xb_add(&bar[XB_XSUB(b.x)], 1u);
        const unsigned gen = old / nloc;
        if (old + 1u == (gen + 1u) * nloc) {
            __builtin_amdgcn_fence(__ATOMIC_RELEASE, "agent");
            asm volatile("s_waitcnt vmcnt(0)" ::: "memory");
            const unsigned og = xb_add(&bar[XB_TOP], 1u);
            const unsigned tg = og / nx;
            if (og + 1u == (tg + 1u) * nx) xb_add(&bar[XB_TOPGEN], 1u);
            else XB_SPIN(xb_ld(&bar[XB_TOPGEN]) == tg, bar);
            __builtin_amdgcn_fence(__ATOMIC_ACQUIRE, "agent");
            xb_add(&bar[XB_XGEN(b.x)], 1u);
            asm volatile("s_waitcnt vmcnt(0)" ::: "memory");
        } else {
            XB_SPIN(xb_ld(&bar[XB_XGEN(b.x)]) == gen, bar);
            __builtin_amdgcn_fence(__ATOMIC_ACQUIRE, "agent");
            asm volatile("s_waitcnt vmcnt(0)" ::: "memory");
        }
    }
    __syncthreads();
}


DI void run_phase(const Params& p, int ph, char* lds) {
  const float* mod0 = p.MOD;
  const float* mod1 = p.MOD + 9 * 6144;
  switch (ph) {
    case 0: phase0(p, lds); break;
    case 1: norm_mod_phase(p.x, p.ctx, p.norm_mix, mod0, 0, 1, p.Hd, NT); break;
    case 2: phase_proj(p, lds); break;
    case 20: phase_mix(p); break;
    case 3: phase_prep(p, lds); break;
    case 4: phase_scan(p, lds); break;
    case 5: phase_readout(p, lds); break;
    case 6: phase_gemm_resid(p, lds, p.S[0], p.woT, 1024, NT / 256, p.x, p.ctx, mod0 + 2 * 1024); break;
    case 7: norm_mod_phase(p.out, p.XC, p.norm_mlp, mod0, 3, 4, p.S[5], NT); break;
    case 8: phase_up(p, lds, p.S[5], p.w1T[0], p.S[0], NT / 256); break;
    case 9: phase_gemm_resid(p, lds, p.S[0], p.w2T[0], 4096, NT / 256, p.out, p.XC, mod0 + 5 * 1024); break;
    case 10: norm_mod_phase(p.out, p.XC, p.norm_mix + 1024, mod1, 0, 1, p.S[5], NT); break;
    case 11: phase_qkv(p, lds); break;
    case 12: phase_attn(p, lds); break;
    case 13: phase_gemm_resid(p, lds, p.S[3], p.awoT, 1024, NL / 256, p.out, p.XC, mod1 + 2 * 1024); break;
    case 14: norm_mod_phase(p.out, p.XC, p.norm_mlp + 1024, mod1, 3, 4, p.S[5], NL); break;
    case 15: phase_up(p, lds, p.S[5], p.w1T[1], p.S[0], NL / 256); break;
    case 16: phase_gemm_resid(p, lds, p.S[0], p.w2T[1], 4096, NL / 256, p.out, p.XC, mod1 + 5 * 1024); break;
    case 17: final_norm_phase(p); break;
  }
}
constexpr int NPHASE = 18;

__global__ void __launch_bounds__(NTHREADS) mega_kernel(Params p) {
  extern __shared__ __attribute__((aligned(16))) char lds[];
  cg::grid_group grid = cg::this_grid();
  volatile LAS unsigned* st = (volatile LAS unsigned*)(LAS char*)(lds + 131072);
  if (threadIdx.x == 0) { st[0] = 0u; st[1] = 0u; }
  if (blockIdx.x == 0) for (int i = threadIdx.x; i < XCD_BAR_WORDS; i += NTHREADS) p.BAR[i] = 0u;
  __syncthreads();
  run_phase(p, 0, lds);
  grid.sync();
  const XcdBarrier xb = xcd_barrier_post(p.BAR, st);
#ifndef DUP
#define DUP -1
#endif
#define PH(n) run_phase(p, n, lds); xcd_barrier(xb); if (DUP == n) { if (n == 4) phase_scan(p, lds, true); else if (n == 9) phase_gemm_resid(p, lds, p.S[0], p.w2T[0], 4096, NT / 256, p.out, p.XC, p.MOD + 5 * 1024, (float*)p.S[4]); else run_phase(p, n, lds); xcd_barrier(xb); } if (DUP == 100) { xcd_barrier(xb); }
  PH(1) PH(20) PH(2) PH(3) PH(4) PH(5) PH(6) PH(7) PH(8) PH(9) PH(10) PH(11) PH(12) PH(13) PH(14) PH(15) PH(16)
  run_phase(p, 17, lds);
}

extern "C" void kernel_launch(void* const* d_in, const int* in_sizes, int n_in, void* d_out, int out_size, void* d_ws, size_t ws_size, hipStream_t stream) {
  Params p;
  memset(&p, 0, sizeof(p));
  const float* const* in = (const float* const*)d_in;
  p.x = in[0]; p.c = in[1]; p.ctx = in[2]; p.c_ctx = in[3]; p.w_mod = in[4]; p.b_mod = in[5]; p.norm_mix = in[6]; p.norm_mlp = in[7];
  p.mlp_w1 = in[8]; p.mlp_w2 = in[9]; p.mu = in[10]; p.wr = in[11]; p.wk = in[12]; p.wv = in[13]; p.wo = in[14]; p.w0 = in[15]; p.w1 = in[16];
  p.w2 = in[17]; p.a0 = in[18]; p.a1 = in[19]; p.a2 = in[20]; p.g1 = in[21]; p.g2 = in[22]; p.k_k = in[23]; p.k_a = in[24]; p.r_k = in[25];
  p.ln_w = in[26]; p.ln_b = in[27]; p.wqkv = in[28]; p.q_norm = in[29]; p.k_norm = in[30]; p.awo = in[31]; p.final_norm = in[32];
  p.out = (float*)d_out;
  char* ws = (char*)d_ws;
  size_t off = 0;
  auto take = [&](size_t bytes) -> char* { char* r = ws + off; off += (bytes + 255) & ~(size_t)255; return r; };
  p.Wcat = (bf16_t*)take((size_t)3456 * 1024 * 2);
  p.L2w = (bf16_t*)take((size_t)4 * 65536 * 2);
  p.g2T = (bf16_t*)take((size_t)1024 * 128 * 2);
  p.woT = (bf16_t*)take((size_t)1024 * 1024 * 2);
  p.w1T[0] = (bf16_t*)take((size_t)4096 * 1024 * 2);
  p.w1T[1] = (bf16_t*)take((size_t)4096 * 1024 * 2);
  p.w2T[0] = (bf16_t*)take((size_t)4096 * 1024 * 2);
  p.w2T[1] = (bf16_t*)take((size_t)4096 * 1024 * 2);
  p.wqkvT = (bf16_t*)take((size_t)1536 * 1024 * 2);
  p.awoT = (bf16_t*)take((size_t)1024 * 1024 * 2);
  p.MOD = (float*)take((size_t)2 * 9 * 6144 * 4);
  p.TAB = (float*)take((size_t)1024 * 2 * 4);
  p.XC = (float*)take((size_t)NC * 1024 * 4);
  p.BAR = (unsigned*)take((size_t)XCD_BAR_WORDS * 4);
  for (int i = 0; i < 6; ++i) p.S[i] = (bf16_t*)take((size_t)NT * 1024 * 2);
  if (off > ws_size) { fprintf(stderr, "kernel_launch: workspace too small (%zu needed, %zu given)\n", off, ws_size); return; }
  char* ob = (char*)d_out;
  p.Hd = (bf16_t*)ob;
  p.L1 = (bf16_t*)(ob + (size_t)NT * 1024 * 2);
  p.BON = (float*)(ob + (size_t)NT * 1024 * 2 + (size_t)NT * 384 * 2);
  p.NRM = (float*)(ob + (size_t)NT * 1024 * 2 + (size_t)NT * 384 * 2 + (size_t)NT * 16 * 4);
  int nj = 0, tiles = 0;
  auto job = [&](const float* src, bf16_t* dst, int K, int N) {
    p.jobs[nj].src = src; p.jobs[nj].dst = dst; p.jobs[nj].K = K; p.jobs[nj].N = N; p.jobs[nj].tstart = tiles; p.jobs[nj].tiles_n = N / 64;
    tiles += (K / 64) * (N / 64); ++nj;
  };
  job(p.wr, p.Wcat, 1024, 1024);
  job(p.wk, p.Wcat + (size_t)1024 * 1024, 1024, 1024);
  job(p.wv, p.Wcat + (size_t)2048 * 1024, 1024, 1024);
  job(p.g1, p.Wcat + (size_t)3072 * 1024, 1024, 128);
  job(p.w1, p.Wcat + (size_t)3200 * 1024, 1024, 64);
  job(p.w1 + 65536, p.Wcat + (size_t)3264 * 1024, 1024, 64);
  job(p.a1, p.Wcat + (size_t)3328 * 1024, 1024, 64);
  job(p.a1 + 65536, p.Wcat + (size_t)3392 * 1024, 1024, 64);
  job(p.a2, p.L2w, 64, 1024);
  job(p.a2 + 65536, p.L2w + 65536, 64, 1024);
  job(p.w2, p.L2w + 2 * 65536, 64, 1024);
  job(p.w2 + 65536, p.L2w + 3 * 65536, 64, 1024);
  job(p.g2, p.g2T, 128, 1024);
  job(p.wo, p.woT, 1024, 1024);
  job(p.mlp_w1, p.w1T[0], 1024, 4096);
  job(p.mlp_w1 + (size_t)4096 * 1024, p.w1T[1], 1024, 4096);
  job(p.mlp_w2, p.w2T[0], 4096, 1024);
  job(p.mlp_w2 + (size_t)4096 * 1024, p.w2T[1], 4096, 1024);
  job(p.wqkv, p.wqkvT, 1024, 1536);
  job(p.awo, p.awoT, 1024, 1024);
  p.njobs = nj; p.total_tiles = tiles;

  static int grid_blocks = 0;
  if (!grid_blocks) {
    (void)hipFuncSetAttribute((const void*)mega_kernel, hipFuncAttributeMaxDynamicSharedMemorySize, LDS_BYTES);
    int dev = 0, cus = 0, per_cu = 0;
    (void)hipGetDevice(&dev);
    (void)hipDeviceGetAttribute(&cus, hipDeviceAttributeMultiprocessorCount, dev);
    if (hipOccupancyMaxActiveBlocksPerMultiprocessor(&per_cu, (const void*)mega_kernel, NTHREADS, LDS_BYTES) != hipSuccess || per_cu < 1) per_cu = 1;
    if (cus <= 0) cus = 256;
    grid_blocks = cus * per_cu;
    (void)hipGetLastError();
  }
  void* args[] = {&p};
  hipError_t e = hipLaunchCooperativeKernel((const void*)mega_kernel, dim3(grid_blocks), dim3(NTHREADS), args, LDS_BYTES, stream);
  if (e != hipSuccess) fprintf(stderr, "cooperative launch failed: %s (grid %d)\n", hipGetErrorString(e), grid_blocks);
}
```

```cpp
#include <hip/hip_runtime.h>
#include <hip/hip_cooperative_groups.h>
#include <cstdint>
#include <cstring>
#include <cstdio>
namespace cg = cooperative_groups;

#ifndef SINGLE_LAUNCH
#define SINGLE_LAUNCH 1
#endif

typedef unsigned short bf16_t;
typedef short bf16x8 __attribute__((ext_vector_type(8)));
typedef float f32x2 __attribute__((ext_vector_type(2)));
typedef float f32x4 __attribute__((ext_vector_type(4)));
typedef float f32x16 __attribute__((ext_vector_type(16)));
typedef __bf16 bf16x2_t __attribute__((ext_vector_type(2)));
#define DI __device__ __forceinline__

constexpr int D = 1024, NB = 8, SEQ = 4096, CTXL = 256;
constexpr int NL = NB * SEQ, NC = NB * CTXL, NT = NL + NC, DFF = 4096;
constexpr int NKEY = SEQ + CTXL;
constexpr int NTHREADS = 512;
constexpr int ROWB = 144;
constexpr int GEMM_STAGE = (256 + 128) * ROWB;
constexpr int LDS_BYTES = 131072 + 16;

struct TJob { const float* src; bf16_t* dst; int K, N, tstart, tiles_n; };

struct Params {
  const float *x, *c, *ctx, *c_ctx, *w_mod, *b_mod, *norm_mix, *norm_mlp, *mlp_w1, *mlp_w2;
  const float *mu, *wr, *wk, *wv, *wo, *w0, *w1, *w2, *a0, *a1, *a2, *g1, *g2, *k_k, *k_a, *r_k, *ln_w, *ln_b;
  const float *wqkv, *q_norm, *k_norm, *awo, *final_norm;
  float* out;
  bf16_t *Wcat, *L2w, *g2T, *woT, *w1T[2], *w2T[2], *wqkvT, *awoT;
  float *MOD, *TAB, *XC;
  bf16_t* S[6];
  bf16_t *Hd, *L1;
  float* BON;
  float* NRM;
  unsigned* BAR;
  TJob jobs[20];
  int njobs, total_tiles;
};

DI size_t HM(int t, int f) { return ((size_t)(f >> 6) * NT + t) * 64 + (f & 63); }
DI unsigned pack2(float lo, float hi) {
  f32x2 v = {lo, hi};
  bf16x2_t b = __builtin_convertvector(v, bf16x2_t);
  return __builtin_bit_cast(unsigned, b);
}
DI float bflo(unsigned u) { return __uint_as_float(u << 16); }
DI float bfhi(unsigned u) { return __uint_as_float(u & 0xffff0000u); }
DI void store_bf4(bf16_t* p, float a, float b, float c, float d) { *(uint2*)p = make_uint2(pack2(a, b), pack2(c, d)); }
DI void load_bf4(const bf16_t* p, float& a, float& b, float& c, float& d) { uint2 u = *(const uint2*)p; a = bflo(u.x); b = bfhi(u.x); c = bflo(u.y); d = bfhi(u.y); }
DI void store_bf8(bf16_t* p, const f32x4& a, const f32x4& b) {
  uint4 o; o.x = pack2(a[0], a[1]); o.y = pack2(a[2], a[3]); o.z = pack2(b[0], b[1]); o.w = pack2(b[2], b[3]);
  *(uint4*)p = o;
}
DI void store16_sc1(void* p, const uint4& v) {
  typedef unsigned u32x4_t __attribute__((ext_vector_type(4)));
  const u32x4_t d = {v.x, v.y, v.z, v.w};
  asm volatile("global_store_dwordx4 %0, %1, off sc1" :: "v"(p), "v"(d) : "memory");
}
DI void unpack_bf8(const uint4& u, float (&o)[8]) {
  o[0] = bflo(u.x); o[1] = bfhi(u.x); o[2] = bflo(u.y); o[3] = bfhi(u.y); o[4] = bflo(u.z); o[5] = bfhi(u.z); o[6] = bflo(u.w); o[7] = bfhi(u.w);
}
DI int perm32(int rho) { return 8 * ((rho & 15) >> 2) + 4 * (rho >> 4) + (rho & 3); }
DI float sigmoidf_(float x) { return 1.f / (1.f + __expf(-x)); }
DI float tanhf_(float x) { return 1.f - 2.f / (1.f + __expf(2.f * x)); }
DI float quad_sum(float x) {
  x += __builtin_bit_cast(float, __builtin_amdgcn_mov_dpp(__builtin_bit_cast(int, x), 0xB1, 0xF, 0xF, true));
  x += __builtin_bit_cast(float, __builtin_amdgcn_mov_dpp(__builtin_bit_cast(int, x), 0x4E, 0xF, 0xF, true));
  return x;
}
DI float oct_sum(float x) {
  x = quad_sum(x);
  x += __builtin_bit_cast(float, __builtin_amdgcn_mov_dpp(__builtin_bit_cast(int, x), 0x141, 0xF, 0xF, true));
  return x;
}
DI float wave_sum(float x) {
#pragma unroll
  for (int m = 1; m < 64; m <<= 1) x += __shfl_xor(x, m);
  return x;
}
#define MFMA16(a, b, c) __builtin_amdgcn_mfma_f32_16x16x32_bf16((a), (b), (c), 0, 0, 0)
#define MFMA32(a, b, c) __builtin_amdgcn_mfma_f32_32x32x16_bf16((a), (b), (c), 0, 0, 0)

DI unsigned lerp2(unsigned a, unsigned n, float ma, float mb) {
  const float h0 = bflo(a), h1 = bfhi(a), s0 = bflo(n), s1 = bfhi(n);
  return pack2(h0 + (s0 - h0) * ma, h1 + (s1 - h1) * mb);
}
template <bool LERP>
DI void gemm_tile(const bf16_t* __restrict__ X, int ldx, const bf16_t* __restrict__ W, int ldw, int K, int tok0, int f0,
                  char* lds, f32x4 (&acc)[4][4], const float* __restrict__ mu) {
  const int tid = threadIdx.x, lane = tid & 63, wave = tid >> 6;
  const int wt = wave & 3, wf = wave >> 2, lr = lane & 15, lq = lane >> 4;
  const int lrow = tid >> 3, kc = tid & 7;
#pragma unroll
  for (int i = 0; i < 4; ++i)
#pragma unroll
    for (int j = 0; j < 4; ++j) acc[i][j] = f32x4{0.f, 0.f, 0.f, 0.f};
  uint4 xr[4], wr[2], xn[4];
  float4 m0 = make_float4(0, 0, 0, 0), m1 = m0;
  const int nk = K >> 6;
  __syncthreads();
  for (int kt = -1; kt < nk; ++kt) {
    const bool more = kt + 1 < nk;
    if (more) {
      const int k0 = (kt + 1) << 6;
#pragma unroll
      for (int i = 0; i < 4; ++i) {
        const int tg = tok0 + lrow + 64 * i;
        xr[i] = *(const uint4*)(X + (size_t)tg * ldx + k0 + kc * 8);
        if (LERP) {
          int nb; bool valid;
          if (tok0 < NL) {
            const int s = tg & 4095, col = s & 63, rw = s >> 6, qd = k0 >> 8;
            if (qd == 0) { valid = col > 0; nb = tg - 1; }
            else if (qd == 1) { valid = col < 63; nb = tg + 1; }
            else if (qd == 2) { valid = rw > 0; nb = tg - 64; }
            else { valid = rw < 63; nb = tg + 64; }
          } else {
            const int s = (tg - NL) & 255;
            if (k0 < 512) { valid = s > 0; nb = tg - 1; }
            else { valid = s < 255; nb = tg + 1; }
          }
          if (valid) xn[i] = *(const uint4*)(X + (size_t)nb * ldx + k0 + kc * 8);
          else xn[i] = make_uint4(0, 0, 0, 0);
        }
      }
#pragma unroll
      for (int i = 0; i < 2; ++i) wr[i] = *(const uint4*)(W + (size_t)(f0 + 64 * i + (lrow & 32) + perm32(lrow & 31)) * ldw + k0 + kc * 8);
      if (LERP) { m0 = *(const float4*)(mu + k0 + kc * 8); m1 = *(const float4*)(mu + k0 + kc * 8 + 4); }
    }
    if (kt >= 0) {
      const char* xs = lds + (kt & 1) * GEMM_STAGE;
      const char* wsm = xs + 256 * ROWB;
#pragma unroll
      for (int ks = 0; ks < 2; ++ks) {
        bf16x8 wfr[4], xfr[4];
#pragma unroll
        for (int i = 0; i < 4; ++i) wfr[i] = *(const bf16x8*)(wsm + (wf * 64 + i * 16 + lr) * ROWB + ks * 64 + lq * 16);
#pragma unroll
        for (int i = 0; i < 4; ++i) xfr[i] = *(const bf16x8*)(xs + (wt * 64 + i * 16 + lr) * ROWB + ks * 64 + lq * 16);
#pragma unroll
        for (int fi = 0; fi < 4; ++fi)
#pragma unroll
          for (int ti = 0; ti < 4; ++ti) acc[fi][ti] = MFMA16(wfr[fi], xfr[ti], acc[fi][ti]);
      }
    }
    if (more) {
      char* xs = lds + ((kt + 1) & 1) * GEMM_STAGE;
      char* wsm = xs + 256 * ROWB;
#pragma unroll
      for (int i = 0; i < 4; ++i) {
        uint4 v = xr[i];
        if (LERP) {
          v.x = lerp2(xr[i].x, xn[i].x, m0.x, m0.y);
          v.y = lerp2(xr[i].y, xn[i].y, m0.z, m0.w);
          v.z = lerp2(xr[i].z, xn[i].z, m1.x, m1.y);
          v.w = lerp2(xr[i].w, xn[i].w, m1.z, m1.w);
        }
        *(uint4*)(xs + (lrow + 64 * i) * ROWB + kc * 16) = v;
      }
#pragma unroll
      for (int i = 0; i < 2; ++i) *(uint4*)(wsm + (lrow + 64 * i) * ROWB + kc * 16) = wr[i];
    }
    __syncthreads();
  }
}


namespace g256 {
constexpr int BK = 64, HALF = 128, HT = HALF * BK;
DI int lds_byte(int r, int c) { const int st = (r >> 4) * 2 + (c >> 5), rr = r & 15, cc = c & 31, ob = rr * 64 + cc * 2; return st * 1024 + (ob ^ (((ob >> 9) & 1) << 5)); }
DI void stage_rc(int b, int& R, int& C) { const int st = b / 1024, sb = b % 1024, swz = sb ^ (((sb >> 9) & 1) << 5); R = (st >> 1) * 16 + swz / 64; C = (st & 1) * 32 + (swz % 64) / 2; }
}
#define G_SA(b, h) (((b) * 2 + (h)) * 16384)
#define G_SB(b, h) ((4 + (b) * 2 + (h)) * 16384)
#define G_STAGEV(bufoff, gbase, vo) do { _Pragma("unroll") for (int _i = 0; _i < 2; ++_i) \
    __builtin_amdgcn_global_load_lds((const unsigned*)((const char*)(gbase) + (vo)[_i]), (__attribute__((address_space(3))) unsigned*)(lds + (bufoff) + ldsw + _i * 8192), 16, 0, 0); } while (0)
#define G_LDA(dst, b, h) do { _Pragma("unroll") for (int m = 0; m < 4; ++m) _Pragma("unroll") for (int k = 0; k < 2; ++k) \
    dst[m][k] = *(const __attribute__((address_space(3))) bf16x8*)(lds + G_SA(b, h) + aoff + m * 2048 + k * 1024); } while (0)
#define G_LDB(dst, b, h) do { _Pragma("unroll") for (int n = 0; n < 2; ++n) _Pragma("unroll") for (int k = 0; k < 2; ++k) \
    dst[n][k] = *(const __attribute__((address_space(3))) bf16x8*)(lds + G_SB(b, h) + boff + n * 2048 + k * 1024); } while (0)
#define G_MMA(ai, bj, At, Bt) do { __builtin_amdgcn_s_setprio(1); \
    _Pragma("unroll") for (int m = 0; m < 4; ++m) _Pragma("unroll") for (int n = 0; n < 2; ++n) _Pragma("unroll") for (int k = 0; k < 2; ++k) \
      acc[ai][bj][m][n] = __builtin_amdgcn_mfma_f32_16x16x32_bf16(At[m][k], Bt[n][k], acc[ai][bj][m][n], 0, 0, 0); \
    __builtin_amdgcn_s_setprio(0); } while (0)
#define G_WAIT_V(n) asm volatile("s_waitcnt vmcnt(" #n ")" ::: "memory")
#define G_WAIT_L(n) asm volatile("s_waitcnt lgkmcnt(" #n ")" ::: "memory")
#define G_BAR __builtin_amdgcn_s_barrier()
#define G_SCHED __builtin_amdgcn_sched_barrier(0)

template <bool PERM>
DI void gemm256_tile(const bf16_t* __restrict__ A, const bf16_t* __restrict__ Bt, int K, int brow, int bcol, char* lds_, f32x4 (&acc)[2][2][4][2]) {
  __attribute__((address_space(3))) unsigned char* lds = (__attribute__((address_space(3))) unsigned char*)lds_;
  int tid = threadIdx.x; asm volatile("" : "+v"(tid));
  const int wid = __builtin_amdgcn_readfirstlane(tid >> 6), lane = tid & 63, wr = wid >> 2, wc = wid & 3, fr = lane & 15, fq = lane >> 4;
#pragma unroll
  for (int a = 0; a < 2; ++a)
#pragma unroll
    for (int b = 0; b < 2; ++b)
#pragma unroll
      for (int m = 0; m < 4; ++m)
#pragma unroll
        for (int n = 0; n < 2; ++n) acc[a][b][m][n] = f32x4{0.f, 0.f, 0.f, 0.f};
  unsigned voff[2], voffA[2];
#pragma unroll
  for (int i = 0; i < 2; ++i) { int R, C; g256::stage_rc(tid * 16 + i * 8192, R, C); voff[i] = (unsigned)(R * K + C) * 2u;
    const int Ra = PERM ? ((R & ~31) + perm32(R & 31)) : R; voffA[i] = (unsigned)(Ra * K + C) * 2u; }
  const size_t kstep = 128, hstep = (size_t)128 * K * 2;
  const unsigned ldsw = (unsigned)wid * 1024u;
  const int aoff = g256::lds_byte(wr * 64 + fr, fq * 8), boff = g256::lds_byte(wc * 32 + fr, fq * 8);
  const char* cA = (const char*)A + (size_t)brow * K * 2;
  const char* cB = (const char*)Bt + (size_t)bcol * K * 2;
  bf16x8 At[4][2], B0[2][2], B1[2][2];
  const int nt = K / g256::BK;
  __syncthreads();
  G_STAGEV(G_SB(0, 0), cB, voff); G_STAGEV(G_SA(0, 0), cA, voffA); G_STAGEV(G_SB(0, 1), cB + hstep, voff); G_STAGEV(G_SA(0, 1), cA + hstep, voffA);
  if (wr == 1) G_BAR;
  G_WAIT_V(4); G_BAR;
  G_STAGEV(G_SB(1, 0), cB + kstep, voff); G_STAGEV(G_SA(1, 0), cA + kstep, voffA); G_STAGEV(G_SB(1, 1), cB + hstep + kstep, voff);
  G_WAIT_V(6); G_BAR;
  for (int t = 0; t < nt - 2; t += 2) {
    const char* a1 = cA + (size_t)(t + 1) * kstep;
    const char* a2 = cA + (size_t)(t + 2) * kstep; const char* b2 = cB + (size_t)(t + 2) * kstep;
    const char* a3 = a2 + kstep; const char* b3 = b2 + kstep;
    G_LDB(B0, 0, 0); G_SCHED; G_LDA(At, 0, 0); G_STAGEV(G_SA(1, 1), a1 + hstep, voffA);
    G_WAIT_L(8); G_BAR; G_WAIT_L(0); G_MMA(0, 0, At, B0); G_BAR; G_SCHED;
    G_LDB(B1, 0, 1); G_STAGEV(G_SB(0, 0), b2, voff);
    G_BAR; G_WAIT_L(0); G_MMA(0, 1, At, B1); G_BAR;
    G_LDA(At, 0, 1); G_STAGEV(G_SA(0, 0), a2, voffA);
    G_BAR; G_WAIT_L(0); G_MMA(1, 0, At, B0); G_BAR; G_SCHED;
    G_STAGEV(G_SB(0, 1), b2 + hstep, voff);
    G_WAIT_V(6); G_BAR; G_MMA(1, 1, At, B1); G_BAR;
    G_LDB(B0, 1, 0); G_SCHED; G_LDA(At, 1, 0); G_STAGEV(G_SA(0, 1), a2 + hstep, voffA);
    G_WAIT_L(8); G_BAR; G_WAIT_L(0); G_MMA(0, 0, At, B0); G_BAR; G_SCHED;
    G_LDB(B1, 1, 1); G_STAGEV(G_SB(1, 0), b3, voff);
    G_BAR; G_WAIT_L(0); G_MMA(0, 1, At, B1); G_BAR;
    G_LDA(At, 1, 1); G_STAGEV(G_SA(1, 0), a3, voffA);
    G_BAR; G_WAIT_L(0); G_MMA(1, 0, At, B0); G_BAR; G_SCHED;
    G_STAGEV(G_SB(1, 1), b3 + hstep, voff);
    G_WAIT_V(6); G_BAR; G_MMA(1, 1, At, B1); G_BAR;
  }
  { G_LDB(B0, 0, 0); G_LDA(At, 0, 0); G_STAGEV(G_SA(1, 1), cA + (size_t)(nt - 1) * kstep + hstep, voffA);
    G_BAR; G_WAIT_L(0); G_MMA(0, 0, At, B0); G_BAR;
    G_LDB(B1, 0, 1); G_BAR; G_WAIT_L(0); G_MMA(0, 1, At, B1); G_BAR;
    G_LDA(At, 0, 1); G_WAIT_V(4); G_BAR; G_WAIT_L(0); G_MMA(1, 0, At, B0); G_MMA(1, 1, At, B1); G_BAR; }
  { G_LDB(B0, 1, 0); G_LDA(At, 1, 0); G_WAIT_V(2); G_BAR; G_WAIT_L(0); G_MMA(0, 0, At, B0); G_BAR;
    G_LDB(B1, 1, 1); G_WAIT_V(0); G_BAR; G_WAIT_L(0); G_MMA(0, 1, At, B1); G_BAR;
    G_LDA(At, 1, 1); G_BAR; G_WAIT_L(0); G_MMA(1, 0, At, B0); G_MMA(1, 1, At, B1); G_BAR; }
  if (wr == 0) G_BAR;
}

DI void tile_map(int L, int total, int ntm, int ntn, int& mt, int& nt) {
  const int q = total >> 3, r = total & 7, xcd = L & 7, off = L >> 3;
  const int id = (xcd < r ? xcd * (q + 1) : r * (q + 1) + (xcd - r) * q) + off;
  const int nig = 8 * ntn, g = id / nig, w = id % nig, fm = g * 8, gsz = min(ntm - fm, 8);
  mt = fm + w % gsz; nt = w / gsz;
}
DI void convert_tile(const TJob& jb, int t, char* lds) {
  float* tile = (float*)lds;
  const int tid = threadIdx.x;
  const int tk = t / jb.tiles_n, tn = t % jb.tiles_n;
  const int k0 = tk * 64, n0 = tn * 64;
  __syncthreads();
#pragma unroll
  for (int i = 0; i < 2; ++i) {
    const int idx = tid + 512 * i, row = idx >> 4, c4 = idx & 15;
    const float4 v = *(const float4*)(jb.src + (size_t)(k0 + row) * jb.N + n0 + c4 * 4);
    tile[row * 65 + c4 * 4 + 0] = v.x; tile[row * 65 + c4 * 4 + 1] = v.y; tile[row * 65 + c4 * 4 + 2] = v.z; tile[row * 65 + c4 * 4 + 3] = v.w;
  }
  __syncthreads();
  const int n = tid >> 3, kc = tid & 7;
  float v[8];
#pragma unroll
  for (int j = 0; j < 8; ++j) v[j] = tile[(kc * 8 + j) * 65 + n];
  uint4 o;
  o.x = pack2(v[0], v[1]); o.y = pack2(v[2], v[3]); o.z = pack2(v[4], v[5]); o.w = pack2(v[6], v[7]);
  *(uint4*)(jb.dst + (size_t)(n0 + n) * jb.K + k0 + kc * 8) = o;
}

DI void mod_unit(const Params& p, int mu_, char* lds) {
  const int tid = threadIdx.x;
  const int layer = mu_ / 96, cc = mu_ % 96;
  float* sc = (float*)lds;
  float* red = sc + 9 * 1024;
  __syncthreads();
  for (int i = tid; i < 9 * 1024; i += 512) {
    const int row = i >> 10, k = i & 1023;
    const float v = row < 8 ? p.c[row * 1024 + k] : p.c_ctx[k];
    sc[i] = v / (1.f + __expf(-v));
  }
  __syncthreads();
  const int kg = tid >> 6, col = tid & 63;
  const float* w = p.w_mod + (size_t)layer * 1024 * 6144 + cc * 64 + col;
  float a[9];
#pragma unroll
  for (int r = 0; r < 9; ++r) a[r] = 0.f;
#pragma unroll 16
  for (int k = kg * 128; k < kg * 128 + 128; ++k) {
    const float wv = w[(size_t)k * 6144];
#pragma unroll
    for (int r = 0; r < 9; ++r) a[r] += sc[r * 1024 + k] * wv;
  }
#pragma unroll
  for (int r = 0; r < 9; ++r) red[(kg * 9 + r) * 64 + col] = a[r];
  __syncthreads();
  for (int i = tid; i < 576; i += 512) {
    const int r = i >> 6, cl = i & 63;
    float s = 0.f;
#pragma unroll
    for (int g = 0; g < 8; ++g) s += red[(g * 9 + r) * 64 + cl];
    const int n = cc * 64 + cl;
    p.MOD[(layer * 9 + r) * 6144 + n] = s + p.b_mod[layer * 6144 + n];
  }
  __syncthreads();
}

DI void sincos_d(double a, double& s, double& c) {
  const double n = rint(a * 0.6366197723675814);
  const double r = (a - n * 1.5707963267948966) - n * 6.123233995736766e-17;
  const double r2 = r * r;
  const double sp = r * (1.0 + r2 * (-1.0 / 6.0 + r2 * (1.0 / 120.0 + r2 * (-1.0 / 5040.0 + r2 * (1.0 / 362880.0 + r2 * (-1.0 / 39916800.0 + r2 * (1.0 / 6227020800.0)))))));
  const double cp = 1.0 + r2 * (-0.5 + r2 * (1.0 / 24.0 + r2 * (-1.0 / 720.0 + r2 * (1.0 / 40320.0 + r2 * (-1.0 / 3628800.0 + r2 * (1.0 / 479001600.0 + r2 * (-1.0 / 87178291200.0)))))));
  const int q = ((int)n) & 3;
  if (q == 0) { s = sp; c = cp; }
  else if (q == 1) { s = cp; c = -sp; }
  else if (q == 2) { s = -sp; c = -cp; }
  else { s = -cp; c = sp; }
}

DI void tab_unit(const Params& p) {
  for (int idx = threadIdx.x; idx < 1024; idx += 512) {
    const int pos = idx >> 4, fi = idx & 15;
    double f = 1.0;
    for (int i = 0; i < fi; ++i) f *= 0.5623413251903491;
    double s, c;
    sincos_d((double)pos * (double)(float)f, s, c);
    p.TAB[idx * 2 + 0] = (float)c;
    p.TAB[idx * 2 + 1] = (float)s;
  }
}

__device__ void phase0(const Params& p, char* lds) {
  const int total = p.total_tiles + 192 + 1;
  for (int u = blockIdx.x; u < total; u += gridDim.x) {
    if (u < p.total_tiles) {
      int j = 0;
#pragma unroll 1
      for (int q = 1; q < p.njobs; ++q) if (u >= p.jobs[q].tstart) j = q;
      convert_tile(p.jobs[j], u - p.jobs[j].tstart, lds);
    } else if (u < p.total_tiles + 192) {
      mod_unit(p, u - p.total_tiles, lds);
    } else {
      tab_unit(p);
    }
  }
}

DI void norm_mod_phase(const float* __restrict__ xl, const float* __restrict__ xc, const float* __restrict__ gain,
                               const float* __restrict__ mod, int shift_i, int scale_i, bf16_t* __restrict__ H, int ntok) {
  const int lane = threadIdx.x & 63;
  const int wg = blockIdx.x * 8 + (threadIdx.x >> 6), nw = gridDim.x * 8;
  for (int t = wg; t < ntok; t += nw) {
    const float* row = t < NL ? xl + (size_t)t * 1024 : xc + (size_t)(t - NL) * 1024;
    float4 v[4];
    float ss = 0.f;
#pragma unroll
    for (int i = 0; i < 4; ++i) {
      v[i] = *(const float4*)(row + (lane + 64 * i) * 4);
      ss += v[i].x * v[i].x + v[i].y * v[i].y + v[i].z * v[i].z + v[i].w * v[i].w;
    }
    ss = wave_sum(ss);
    const float rstd = rsqrtf(ss * (1.f / 1024.f) + 1e-6f);
    const int bp = t < NL ? (t >> 12) : 8;
    const float* sh = mod + (bp * 6 + shift_i) * 1024;
    const float* sc = mod + (bp * 6 + scale_i) * 1024;
#pragma unroll
    for (int i = 0; i < 4; ++i) {
      const int c = (lane + 64 * i) * 4;
      const float4 g = *(const float4*)(gain + c), s4 = *(const float4*)(sh + c), c4 = *(const float4*)(sc + c);
      store_bf4(H + (size_t)t * 1024 + c,
                v[i].x * rstd * g.x * (1.f + c4.x) + s4.x, v[i].y * rstd * g.y * (1.f + c4.y) + s4.y,
                v[i].z * rstd * g.z * (1.f + c4.z) + s4.z, v[i].w * rstd * g.w * (1.f + c4.w) + s4.w);
    }
  }
}

__device__ void final_norm_phase(const Params& p) {
  const int lane = threadIdx.x & 63;
  const int wg = blockIdx.x * 8 + (threadIdx.x >> 6), nw = gridDim.x * 8;
  for (int t = wg; t < NL; t += nw) {
    float* row = p.out + (size_t)t * 1024;
    float4 v[4];
    float ss = 0.f;
#pragma unroll
    for (int i = 0; i < 4; ++i) {
      v[i] = *(const float4*)(row + (lane + 64 * i) * 4);
      ss += v[i].x * v[i].x + v[i].y * v[i].y + v[i].z * v[i].z + v[i].w * v[i].w;
    }
    ss = wave_sum(ss);
    const float rstd = rsqrtf(ss * (1.f / 1024.f) + 1e-6f);
#pragma unroll
    for (int i = 0; i < 4; ++i) {
      const int c = (lane + 64 * i) * 4;
      const float4 g = *(const float4*)(p.final_norm + c);
      *(float4*)(row + c) = make_float4(v[i].x * rstd * g.x, v[i].y * rstd * g.y, v[i].z * rstd * g.z, v[i].w * rstd * g.w);
    }
  }
}

__device__ void phase_mix(const Params& p) {
  const int lane = threadIdx.x & 63;
  const int wg = blockIdx.x * 8 + (threadIdx.x >> 6), nw = gridDim.x * 8;
  for (int t = wg; t < NT; t += nw) {
#pragma unroll
    for (int i = 0; i < 2; ++i) {
      const int c = lane * 8 + 512 * i;
      const uint4 own = *(const uint4*)(p.Hd + (size_t)t * 1024 + c);
      int nb; bool valid;
      if (t < NL) {
        const int s = t & 4095, col = s & 63, rw = s >> 6, qd = c >> 8;
        if (qd == 0) { valid = col > 0; nb = t - 1; }
        else if (qd == 1) { valid = col < 63; nb = t + 1; }
        else if (qd == 2) { valid = rw > 0; nb = t - 64; }
        else { valid = rw < 63; nb = t + 64; }
      } else {
        const int s = (t - NL) & 255;
        if (c < 512) { valid = s > 0; nb = t - 1; }
        else { valid = s < 255; nb = t + 1; }
      }
      uint4 nv = make_uint4(0, 0, 0, 0);
      if (valid) nv = *(const uint4*)(p.Hd + (size_t)nb * 1024 + c);
#pragma unroll
      for (int j = 0; j < 3; ++j) {
        const int mi = j == 0 ? 0 : j == 1 ? 2 : 3;
        const float4 m0 = *(const float4*)(p.mu + mi * 1024 + c), m1 = *(const float4*)(p.mu + mi * 1024 + c + 4);
        uint4 o;
        o.x = lerp2(own.x, nv.x, m0.x, m0.y); o.y = lerp2(own.y, nv.y, m0.z, m0.w);
        o.z = lerp2(own.z, nv.z, m1.x, m1.y); o.w = lerp2(own.w, nv.w, m1.z, m1.w);
        *(uint4*)(p.S[3 + j] + (size_t)t * 1024 + c) = o;
      }
    }
  }
}

__device__ void phase_proj(const Params& p, char* lds) {
  const int lane = threadIdx.x & 63, wave = threadIdx.x >> 6;
  constexpr int NLORA = (NT / 256) * 3, NRKV = (NT / 256) * 12;
  for (int u = blockIdx.x; u < NLORA; u += gridDim.x) {
    {
      const int wt = wave & 3, wf = wave >> 2, lr = lane & 15, lq = lane >> 4;
      const int mt = u / 3, nt = 24 + u % 3;
      const int mi = nt == 24 ? 5 : nt == 25 ? 1 : 4;
      f32x4 acc[4][4];
      gemm_tile<true>(p.Hd, 1024, p.Wcat, 1024, 1024, mt * 256, nt * 128, lds, acc, p.mu + mi * 1024);
#pragma unroll
      for (int pp = 0; pp < 2; ++pp)
#pragma unroll
        for (int ti = 0; ti < 4; ++ti) {
          const int t = mt * 256 + wt * 64 + ti * 16 + lr;
          const int fl = wf * 64 + pp * 32 + lq * 8;
          f32x4 a = acc[2 * pp][ti], b = acc[2 * pp + 1][ti];
          if (nt == 24) {
#pragma unroll
            for (int j = 0; j < 4; ++j) { a[j] = sigmoidf_(a[j]); b[j] = sigmoidf_(b[j]); }
            store_bf8(p.L1 + (size_t)t * 384 + fl, a, b);
          } else if (nt == 25) {
#pragma unroll
            for (int j = 0; j < 4; ++j) { a[j] = tanhf_(a[j]); b[j] = tanhf_(b[j]); }
            store_bf8(p.L1 + (size_t)t * 384 + 128 + fl, a, b);
          } else {
            store_bf8(p.L1 + (size_t)t * 384 + 256 + fl, a, b);
          }
        }
    }
  }
  for (int v0 = blockIdx.x; v0 < NRKV; v0 += gridDim.x) {
    {
      const int wr = wave >> 2, wc = wave & 3;
      f32x4 acc[2][2][4][2];
      { int mt0, rem0; tile_map(v0, NRKV, NT / 256, 12, mt0, rem0); const int j0 = rem0 >> 2, nt0 = rem0 & 3;
        gemm256_tile<true>(p.Wcat + (size_t)j0 * 1024 * 1024, p.S[3 + j0], 1024, nt0 * 256, mt0 * 256, lds, acc); }
      int lane_o = threadIdx.x & 63; asm volatile("" : "+v"(lane_o));
      int v = v0; asm volatile("" : "+s"(v));
      int mt, rem; tile_map(v, NRKV, NT / 256, 12, mt, rem); const int j = rem >> 2, nt = rem & 3;
      const int fr = lane_o & 15, fq = lane_o >> 4;
#pragma unroll
      for (int bj = 0; bj < 2; ++bj)
#pragma unroll
        for (int n = 0; n < 2; ++n) {
          const int t = mt * 256 + bj * 128 + wc * 32 + n * 16 + fr;
#pragma unroll
          for (int ai = 0; ai < 2; ++ai) {
            const int fh = nt * 256 + ai * 128 + wr * 64;
            if (j == 1) {
              f32x4 a[2], b[2];
              float ss = 0.f;
#pragma unroll
              for (int mp = 0; mp < 2; ++mp) {
                const int f = fh + mp * 32 + fq * 8;
                const float4 kkl = *(const float4*)(p.k_k + f), kkh = *(const float4*)(p.k_k + f + 4);
                a[mp] = acc[ai][bj][2 * mp][n]; b[mp] = acc[ai][bj][2 * mp + 1][n];
                a[mp][0] *= kkl.x; a[mp][1] *= kkl.y; a[mp][2] *= kkl.z; a[mp][3] *= kkl.w;
                b[mp][0] *= kkh.x; b[mp][1] *= kkh.y; b[mp][2] *= kkh.z; b[mp][3] *= kkh.w;
#pragma unroll
                for (int e2 = 0; e2 < 4; ++e2) ss += a[mp][e2] * a[mp][e2] + b[mp][e2] * b[mp][e2];
              }
              ss += __shfl_xor(ss, 16); ss += __shfl_xor(ss, 32);
              const float kinv = rsqrtf(ss + 1e-12f);
#pragma unroll
              for (int mp = 0; mp < 2; ++mp) {
#pragma unroll
                for (int e2 = 0; e2 < 4; ++e2) { a[mp][e2] *= kinv; b[mp][e2] *= kinv; }
                store_bf8(p.S[2] + HM(t, fh + mp * 32 + fq * 8), a[mp], b[mp]);
              }
              if (fq == 0) p.NRM[(size_t)(fh >> 6) * NT + t] = sqrtf(ss + 1e-12f);
            } else {
              bf16_t* dst = j == 0 ? p.S[0] : p.S[1];
#pragma unroll
              for (int mp = 0; mp < 2; ++mp)
                store_bf8(dst + HM(t, fh + mp * 32 + fq * 8), acc[ai][bj][2 * mp][n], acc[ai][bj][2 * mp + 1][n]);
            }
          }
        }
    }
  }
}

__device__ void phase_prep(const Params& p, char* lds) {
  const int lane = threadIdx.x & 63, wave = threadIdx.x >> 6;
  const int wt = wave & 3, wf = wave >> 2, lr = lane & 15, lq = lane >> 4;
  const int total = (NT / 256) * 8;
  for (int u = blockIdx.x; u < total; u += gridDim.x) {
    const int mt = u >> 3, nt = u & 7;
    const int tok0 = mt * 256, f0 = nt * 128;
    f32x4 acc[4][4];
    uint4 afp[2][4];
    gemm_tile<false>(p.L1 + 256, 384, p.L2w + 0 * 65536, 64, 64, tok0, f0, lds, acc, nullptr);
#pragma unroll
    for (int pp = 0; pp < 2; ++pp) {
      const int f = f0 + wf * 64 + pp * 32 + lq * 8;
      const float4 a0l = *(const float4*)(p.a0 + f), a0h = *(const float4*)(p.a0 + f + 4);
#pragma unroll
      for (int ti = 0; ti < 4; ++ti) {
        const int t = tok0 + wt * 64 + ti * 16 + lr;
        f32x4 a = acc[2 * pp][ti], b = acc[2 * pp + 1][ti];
        a[0] = sigmoidf_(a[0] + a0l.x); a[1] = sigmoidf_(a[1] + a0l.y); a[2] = sigmoidf_(a[2] + a0l.z); a[3] = sigmoidf_(a[3] + a0l.w);
        b[0] = sigmoidf_(b[0] + a0h.x); b[1] = sigmoidf_(b[1] + a0h.y); b[2] = sigmoidf_(b[2] + a0h.z); b[3] = sigmoidf_(b[3] + a0h.w);
        uint4 o; o.x = pack2(a[0], a[1]); o.y = pack2(a[2], a[3]); o.z = pack2(b[0], b[1]); o.w = pack2(b[2], b[3]);
        afp[pp][ti] = o;
        *(uint4*)(p.S[3] + HM(t, f)) = o;
      }
    }
    gemm_tile<false>(p.L1 + 320, 384, p.L2w + 1 * 65536, 64, 64, tok0, f0, lds, acc, nullptr);
#pragma unroll
    for (int ti = 0; ti < 4; ++ti) {
      const int t = tok0 + wt * 64 + ti * 16 + lr;
      float bon = 0.f;
      const float nrm = p.NRM[(size_t)(nt * 2 + wf) * NT + t];
#pragma unroll
      for (int pp = 0; pp < 2; ++pp) {
        const int f = f0 + wf * 64 + pp * 32 + lq * 8;
        const float4 a0l = *(const float4*)(p.a0 + 1024 + f), a0h = *(const float4*)(p.a0 + 1024 + f + 4);
        const float4 rkl = *(const float4*)(p.r_k + f), rkh = *(const float4*)(p.r_k + f + 4);
        const float4 kal = *(const float4*)(p.k_a + f), kah = *(const float4*)(p.k_a + f + 4);
        const float4 kkl = *(const float4*)(p.k_k + f), kkh = *(const float4*)(p.k_k + f + 4);
        const float rk8[8] = {rkl.x, rkl.y, rkl.z, rkl.w, rkh.x, rkh.y, rkh.z, rkh.w};
        const float ka8[8] = {kal.x, kal.y, kal.z, kal.w, kah.x, kah.y, kah.z, kah.w};
        const float kk8[8] = {kkl.x, kkl.y, kkl.z, kkl.w, kkh.x, kkh.y, kkh.z, kkh.w};
        f32x4 a = acc[2 * pp][ti], b = acc[2 * pp + 1][ti];
        a[0] = sigmoidf_(a[0] + a0l.x); a[1] = sigmoidf_(a[1] + a0l.y); a[2] = sigmoidf_(a[2] + a0l.z); a[3] = sigmoidf_(a[3] + a0l.w);
        b[0] = sigmoidf_(b[0] + a0h.x); b[1] = sigmoidf_(b[1] + a0h.y); b[2] = sigmoidf_(b[2] + a0h.z); b[3] = sigmoidf_(b[3] + a0h.w);
        store_bf8(p.S[4] + HM(t, f), a, b);
        const float ab8[8] = {a[0], a[1], a[2], a[3], b[0], b[1], b[2], b[3]};
        float af8[8], r8[8], k8[8];
        unpack_bf8(afp[pp][ti], af8);
        unpack_bf8(*(const uint4*)(p.S[0] + HM(t, f)), r8);
        unpack_bf8(*(const uint4*)(p.S[2] + HM(t, f)), k8);
#pragma unroll
        for (int e2 = 0; e2 < 8; ++e2) {
          const float k = k8[e2] * nrm / kk8[e2];
          bon += r8[e2] * k * rk8[e2] * (2.f + (ab8[e2] + af8[e2] - 2.f) * ka8[e2]);
        }
      }
      bon += __shfl_xor(bon, 16); bon += __shfl_xor(bon, 32);
      if (lq == 0) p.BON[(size_t)(nt * 2 + wf) * NT + t] = bon;
    }
#pragma unroll 1
    for (int dr = 0; dr < 2; ++dr) {
      gemm_tile<false>(p.L1 + 128 + dr * 64, 384, p.L2w + (2 + dr) * 65536, 64, 64, tok0, f0, lds, acc, nullptr);
      bf16_t* dst = dr ? p.S[5] : p.Hd;
#pragma unroll
      for (int pp = 0; pp < 2; ++pp) {
        const int f = f0 + wf * 64 + pp * 32 + lq * 8;
        const float4 w0l = *(const float4*)(p.w0 + dr * 1024 + f), w0h = *(const float4*)(p.w0 + dr * 1024 + f + 4);
#pragma unroll
        for (int ti = 0; ti < 4; ++ti) {
          const int t = tok0 + wt * 64 + ti * 16 + lr;
          f32x4 a = acc[2 * pp][ti], b = acc[2 * pp + 1][ti];
          a[0] = -0.60653066f * sigmoidf_(a[0] + w0l.x); a[1] = -0.60653066f * sigmoidf_(a[1] + w0l.y);
          a[2] = -0.60653066f * sigmoidf_(a[2] + w0l.z); a[3] = -0.60653066f * sigmoidf_(a[3] + w0l.w);
          b[0] = -0.60653066f * sigmoidf_(b[0] + w0h.x); b[1] = -0.60653066f * sigmoidf_(b[1] + w0h.y);
          b[2] = -0.60653066f * sigmoidf_(b[2] + w0h.z); b[3] = -0.60653066f * sigmoidf_(b[3] + w0h.w);
          store_bf8(dst + HM(t, f), a, b);
        }
      }
    }
  }
}

typedef short s16x4 __attribute__((ext_vector_type(4)));
#define MFMA16K(a, b, c) __builtin_amdgcn_mfma_f32_16x16x16bf16_1k((a), (b), (c), 0, 0, 0)
DI s16x4 pack4(const f32x4& x) { const uint2 u = make_uint2(pack2(x[0], x[1]), pack2(x[2], x[3])); return __builtin_bit_cast(s16x4, u); }
DI bf16x8 pack8(const f32x4& a, const f32x4& b) { const uint4 u = make_uint4(pack2(a[0], a[1]), pack2(a[2], a[3]), pack2(b[0], b[1]), pack2(b[2], b[3])); return __builtin_bit_cast(bf16x8, u); }
constexpr int SC_KK = 0, SC_R = 2304, SC_B = 4608, SC_K = 6912, SC_BT = 9216, SC_KT = 12288, SC_VT = 15360, SC_CL = 18432, SC_CHUNK = 18688, SC_GROUP = 2 * SC_CHUNK, SC_YBUF = 2 * SC_GROUP;

#define KEEP8(x) asm volatile("" :: "v"(x))
#define KEEP4(x) asm volatile("" :: "v"(x))
DI void scan_chunk(const char* cb, float* yb, f32x4 (&ST)[4], int vb, int c, int q) {
  const f32x4 z = {0.f, 0.f, 0.f, 0.f};
  bf16x8 fB[2], fK[2], fKK[2], fR[2];
#pragma unroll
  for (int ks = 0; ks < 2; ++ks) {
    fB[ks] = *(const bf16x8*)(cb + SC_B + c * 144 + ks * 64 + q * 16);
    fK[ks] = *(const bf16x8*)(cb + SC_K + c * 144 + ks * 64 + q * 16);
    fKK[ks] = *(const bf16x8*)(cb + SC_KK + c * 144 + ks * 64 + q * 16);
    fR[ks] = *(const bf16x8*)(cb + SC_R + c * 144 + ks * 64 + q * 16);
  }
  f32x4 Abk = MFMA16(fB[0], fKK[0], z);  Abk = MFMA16(fB[1], fKK[1], Abk);
  f32x4 AbkT = MFMA16(fKK[0], fB[0], z); AbkT = MFMA16(fKK[1], fB[1], AbkT);
  f32x4 Akk = MFMA16(fK[0], fKK[0], z);  Akk = MFMA16(fK[1], fKK[1], Akk);
  f32x4 Abr = MFMA16(fB[0], fR[0], z);   Abr = MFMA16(fB[1], fR[1], Abr);
  f32x4 Akr = MFMA16(fK[0], fR[0], z);   Akr = MFMA16(fK[1], fR[1], Akr);
  KEEP8(fB[0]); KEEP8(fB[1]); KEEP8(fK[0]); KEEP8(fK[1]); KEEP8(fKK[0]); KEEP8(fKK[1]); KEEP8(fR[0]); KEEP8(fR[1]);
  f32x4 P;
#pragma unroll
  for (int j = 0; j < 4; ++j) {
    const int rr = 4 * q + j;
    Abk[j] = rr < c ? Abk[j] : 0.f;  Akk[j] = rr < c ? Akk[j] : 0.f;
    Abr[j] = rr <= c ? Abr[j] : 0.f; Akr[j] = rr <= c ? Akr[j] : 0.f;
    AbkT[j] = c < rr ? AbkT[j] : 0.f;
    P[j] = (rr == c ? 1.f : 0.f) - Abk[j];
  }
  const s16x4 bN = pack4(Abk), bNT = pack4(AbkT);
  const f32x4 N2 = MFMA16K(bNT, bN, z), N2T = MFMA16K(bN, bNT, z);
  KEEP4(bN); KEEP4(bNT);
  const s16x4 bN2 = pack4(N2), bN2T = pack4(N2T);
  const f32x4 N4 = MFMA16K(bN2T, bN2, z), N4T = MFMA16K(bN2, bN2T, z);
  KEEP4(bN2); KEEP4(bN2T);
  const s16x4 bN4 = pack4(N4), bN4T = pack4(N4T);
  const f32x4 N8T = MFMA16K(bN4, bN4T, z);
  KEEP4(bN4); KEEP4(bN4T);
  const s16x4 bN8T = pack4(N8T);
  { const s16x4 pp_ = pack4(P); P = MFMA16K(bN2T, pp_, P); KEEP4(pp_); KEEP4(bN2T); }
  { const s16x4 pp_ = pack4(P); P = MFMA16K(bN4T, pp_, P); KEEP4(pp_); KEEP4(bN4T); }
  { const s16x4 pp_ = pack4(P); P = MFMA16K(bN8T, pp_, P); KEEP4(pp_); KEEP4(bN8T); }
  const s16x4 bT = pack4(P);
  bf16x8 sf[2], kkp[2], rp[2];
#pragma unroll
  for (int i = 0; i < 2; ++i) {
    sf[i] = pack8(ST[2 * i], ST[2 * i + 1]);
    const uint2 klo = *(const uint2*)(cb + SC_KK + c * 144 + (32 * i + 4 * q) * 2), khi = *(const uint2*)(cb + SC_KK + c * 144 + (32 * i + 16 + 4 * q) * 2);
    const uint2 rlo = *(const uint2*)(cb + SC_R + c * 144 + (32 * i + 4 * q) * 2), rhi = *(const uint2*)(cb + SC_R + c * 144 + (32 * i + 16 + 4 * q) * 2);
    kkp[i] = __builtin_bit_cast(bf16x8, make_uint4(klo.x, klo.y, khi.x, khi.y));
    rp[i] = __builtin_bit_cast(bf16x8, make_uint4(rlo.x, rlo.y, rhi.x, rhi.y));
  }
  f32x4 XT = MFMA16(kkp[0], sf[0], z); XT = MFMA16(kkp[1], sf[1], XT);
  f32x4 YT = MFMA16(rp[0], sf[0], z);  YT = MFMA16(rp[1], sf[1], YT);
  KEEP8(kkp[0]); KEEP8(kkp[1]); KEEP8(rp[0]); KEEP8(rp[1]); KEEP8(sf[0]); KEEP8(sf[1]);
  const s16x4 vf = *(const s16x4*)(cb + SC_VT + (vb * 16 + c) * 48 + q * 8);
  const s16x4 pAkk = pack4(Akk);
  XT = MFMA16K(pAkk, vf, XT); KEEP4(pAkk);
  const s16x4 pXT = pack4(XT);
  f32x4 UT = MFMA16K(bT, pXT, z); KEEP4(pXT); KEEP4(bT);
#pragma unroll
  for (int j = 0; j < 4; ++j) UT[j] = -UT[j];
  const s16x4 bU = pack4(UT);
  const s16x4 pAbr = pack4(Abr), pAkr = pack4(Akr);
  YT = MFMA16K(pAbr, bU, YT);
  YT = MFMA16K(pAkr, vf, YT); KEEP4(pAbr); KEEP4(pAkr);
#pragma unroll
  for (int j = 0; j < 4; ++j) yb[(4 * q + j) * 64 + vb * 16 + c] = YT[j];
#pragma unroll
  for (int kt = 0; kt < 4; ++kt) {
    const s16x4 bh = *(const s16x4*)(cb + SC_BT + (16 * kt + c) * 48 + q * 8);
    const s16x4 kh = *(const s16x4*)(cb + SC_KT + (16 * kt + c) * 48 + q * 8);
    f32x4 s = MFMA16K(bh, bU, ST[kt]);
    s = MFMA16K(kh, vf, s); KEEP4(bh); KEEP4(kh);
    const float4 cl = *(const float4*)(cb + SC_CL + (16 * kt + 4 * q) * 4);
    s[0] *= cl.x; s[1] *= cl.y; s[2] *= cl.z; s[3] *= cl.w;
    ST[kt] = s;
  }
  KEEP4(bU); KEEP4(vf);
}

__device__ void phase_scan(const Params& p, char* lds, bool dupout = false) {
  float* ybuf = (float*)(lds + SC_YBUF);
  const int tid = threadIdx.x, lane = tid & 63, wave = tid >> 6;
  const bool loader = tid >= 256;
  const int lt = tid & 255, ltk = lt >> 3, lch = (lt & 7) * 8;
  const int lcc = (wave >> 1) & 1, lchh = wave & 1, ltok = lane >> 2, loct = lane & 3, ch0 = lchh * 32 + loct * 8;
  const int vb = wave & 3, cc_ = lane & 15, qq = lane >> 4;
  constexpr int NG = NKEY / 32;
  for (int unit = blockIdx.x; unit < 256; unit += gridDim.x) {
    const int dir = unit & 1, h = (unit >> 1) & 15, b = unit >> 5;
    const bf16_t* Rp = p.S[0]; const bf16_t* Vp = p.S[1]; const bf16_t* Kp = p.S[2];
    bf16_t* Ap = dir ? p.S[4] : p.S[3];
    const bf16_t* Lp = dir ? p.S[5] : p.Hd;
    auto tok_of = [&](int i) -> int {
      if (i < 256) return NL + b * 256 + (dir ? 255 - i : i);
      const int s = i - 256;
      return b * 4096 + (dir ? 4095 - s : s);
    };
    uint4 rawA[5], rawB[5];
    float nrmA = 0.f, nrmB = 0.f;
    float rkk[8], kac[8];
    f32x4 ST[4];
#pragma unroll
    for (int i = 0; i < 4; ++i) ST[i] = f32x4{0.f, 0.f, 0.f, 0.f};
    if (loader) {
#pragma unroll
      for (int j = 0; j < 8; ++j) { rkk[j] = 1.f / p.k_k[h * 64 + ch0 + j]; kac[j] = p.k_a[h * 64 + ch0 + j]; }
    }
    auto issue = [&](int g, uint4 (&rw)[5], float& nv) {
      const int t = tok_of(g * 32 + lcc * 16 + ltok);
      const size_t off = HM(t, h * 64 + ch0);
      rw[0] = *(const uint4*)(Rp + off); rw[1] = *(const uint4*)(Vp + off); rw[2] = *(const uint4*)(Kp + off);
      rw[3] = *(const uint4*)(Ap + off); rw[4] = *(const uint4*)(Lp + off);
      nv = p.NRM[(size_t)h * NT + t];
    };
    auto process = [&](int stage, const uint4 (&raw)[5], const float nrmv) {
      float r8[8], kk8[8], a8[8], l8[8], L[8];
      unpack_bf8(raw[0], r8); unpack_bf8(raw[2], kk8); unpack_bf8(raw[3], a8); unpack_bf8(raw[4], l8);
#pragma unroll
      for (int j = 0; j < 8; ++j) L[j] = l8[j];
#pragma unroll
      for (int d = 4; d < 64; d <<= 1) {
#pragma unroll
        for (int j = 0; j < 8; ++j) { const float o = __shfl_up(L[j], d); if (lane >= d) L[j] += o; }
      }
      float okk[8], orr[8], ob[8], ok[8], cend[8];
#pragma unroll
      for (int j = 0; j < 8; ++j) {
        const float cc = __expf(L[j]), cprev = __expf(L[j] - l8[j]), cinv = __expf(-L[j]);
        const float k = kk8[j] * nrmv * rkk[j];
        const float kd = k * (1.f + (a8[j] - 1.f) * kac[j]);
        okk[j] = kk8[j] * cprev; orr[j] = r8[j] * cc; ob[j] = kk8[j] * a8[j] * cinv; ok[j] = kd * cinv; cend[j] = cc;
      }
      char* cb = lds + stage * SC_GROUP + lcc * SC_CHUNK;
      uint4 o;
      o = make_uint4(pack2(okk[0], okk[1]), pack2(okk[2], okk[3]), pack2(okk[4], okk[5]), pack2(okk[6], okk[7])); *(uint4*)(cb + SC_KK + ltok * 144 + ch0 * 2) = o;
      o = make_uint4(pack2(orr[0], orr[1]), pack2(orr[2], orr[3]), pack2(orr[4], orr[5]), pack2(orr[6], orr[7])); *(uint4*)(cb + SC_R + ltok * 144 + ch0 * 2) = o;
      const uint4 obp = make_uint4(pack2(ob[0], ob[1]), pack2(ob[2], ob[3]), pack2(ob[4], ob[5]), pack2(ob[6], ob[7])); *(uint4*)(cb + SC_B + ltok * 144 + ch0 * 2) = obp;
      const uint4 okp = make_uint4(pack2(ok[0], ok[1]), pack2(ok[2], ok[3]), pack2(ok[4], ok[5]), pack2(ok[6], ok[7])); *(uint4*)(cb + SC_K + ltok * 144 + ch0 * 2) = okp;
      const unsigned bw[4] = {obp.x, obp.y, obp.z, obp.w}, kw[4] = {okp.x, okp.y, okp.z, okp.w}, vw[4] = {raw[1].x, raw[1].y, raw[1].z, raw[1].w};
#pragma unroll
      for (int j = 0; j < 8; ++j) {
        const int sh = (j & 1) * 16;
        *(bf16_t*)(cb + SC_BT + (ch0 + j) * 48 + ltok * 2) = (bf16_t)((bw[j >> 1] >> sh) & 0xffffu);
        *(bf16_t*)(cb + SC_KT + (ch0 + j) * 48 + ltok * 2) = (bf16_t)((kw[j >> 1] >> sh) & 0xffffu);
        *(bf16_t*)(cb + SC_VT + (ch0 + j) * 48 + ltok * 2) = (bf16_t)((vw[j >> 1] >> sh) & 0xffffu);
      }
      if (ltok == 15) {
        *(float4*)(cb + SC_CL + ch0 * 4) = make_float4(cend[0], cend[1], cend[2], cend[3]);
        *(float4*)(cb + SC_CL + ch0 * 4 + 16) = make_float4(cend[4], cend[5], cend[6], cend[7]);
      }
    };
    auto yout = [&](int g) {
      const float* yb = ybuf + (g & 1) * 2048 + ltk * 64 + lch;
      const float4 y0 = *(const float4*)yb, y1 = *(const float4*)(yb + 4);
      const int t = tok_of(g * 32 + ltk);
      uint4 o;
      o.x = pack2(y0.x, y0.y); o.y = pack2(y0.z, y0.w); o.z = pack2(y1.x, y1.y); o.w = pack2(y1.z, y1.w);
      *(uint4*)((dupout ? p.S[0] : Ap) + HM(t, h * 64 + lch)) = o;
    };
    __syncthreads();
    if (loader) { issue(0, rawA, nrmA); issue(1, rawB, nrmB); process(0, rawA, nrmA); issue(2, rawA, nrmA); }
    __syncthreads();
    for (int g = 0; g < NG; g += 2) {
      if (loader) {
        if (g >= 1) yout(g - 1);
        if (g + 1 < NG) { process(1, rawB, nrmB); if (g + 3 < NG) issue(g + 3, rawB, nrmB); }
      } else {
        const char* gb = lds;
        float* yb = ybuf;
        scan_chunk(gb, yb, ST, vb, cc_, qq);
        scan_chunk(gb + SC_CHUNK, yb + 16 * 64, ST, vb, cc_, qq);
      }
      __syncthreads();
      if (g + 1 < NG) {
        if (loader) {
          yout(g);
          if (g + 2 < NG) { process(0, rawA, nrmA); if (g + 4 < NG) issue(g + 4, rawA, nrmA); }
        } else {
          const char* gb = lds + SC_GROUP;
          float* yb = ybuf + 2048;
          scan_chunk(gb, yb, ST, vb, cc_, qq);
          scan_chunk(gb + SC_CHUNK, yb + 16 * 64, ST, vb, cc_, qq);
        }
        __syncthreads();
      }
    }
    if (loader) yout(NG - 1);
    __syncthreads();
  }
}

__device__ void phase_readout(const Params& p, char* lds) {
  const int lane = threadIdx.x & 63, wave = threadIdx.x >> 6;
  const int wt = wave & 3, wf = wave >> 2, lr = lane & 15, lq = lane >> 4;
  const int total = (NT / 256) * 8;
  for (int u = blockIdx.x; u < total; u += gridDim.x) {
    const int mt = u >> 3, nt = u & 7;
    const int tok0 = mt * 256, f0 = nt * 128;
    f32x4 g[4][4];
    gemm_tile<false>(p.L1, 384, p.g2T, 128, 128, tok0, f0, lds, g, nullptr);
    const int head = nt * 2 + wf;
#pragma unroll
    for (int ti = 0; ti < 4; ++ti) {
      const int t = tok0 + wt * 64 + ti * 16 + lr;
      float y[2][8];
      float sum = 0.f;
#pragma unroll
      for (int pp = 0; pp < 2; ++pp) {
        const int f = f0 + wf * 64 + pp * 32 + lq * 8;
        float ya[8], yb[8];
        unpack_bf8(*(const uint4*)(p.S[3] + HM(t, f)), ya);
        unpack_bf8(*(const uint4*)(p.S[4] + HM(t, f)), yb);
#pragma unroll
        for (int e2 = 0; e2 < 8; ++e2) { y[pp][e2] = ya[e2] + yb[e2]; sum += y[pp][e2]; }
      }
      sum += __shfl_xor(sum, 16); sum += __shfl_xor(sum, 32);
      const float mean = sum * (1.f / 64.f);
      float vs = 0.f;
#pragma unroll
      for (int pp = 0; pp < 2; ++pp)
#pragma unroll
        for (int e2 = 0; e2 < 8; ++e2) { const float d = y[pp][e2] - mean; vs += d * d; }
      vs += __shfl_xor(vs, 16); vs += __shfl_xor(vs, 32);
      const float rstd = rsqrtf(vs * (1.f / 64.f) + 64e-5f);
      const float bon = p.BON[(size_t)head * NT + t];
#pragma unroll
      for (int pp = 0; pp < 2; ++pp) {
        const int f = f0 + wf * 64 + pp * 32 + lq * 8;
        const float4 lwl = *(const float4*)(p.ln_w + f), lwh = *(const float4*)(p.ln_w + f + 4);
        const float4 lbl = *(const float4*)(p.ln_b + f), lbh = *(const float4*)(p.ln_b + f + 4);
        const float lw8[8] = {lwl.x, lwl.y, lwl.z, lwl.w, lwh.x, lwh.y, lwh.z, lwh.w};
        const float lb8[8] = {lbl.x, lbl.y, lbl.z, lbl.w, lbh.x, lbh.y, lbh.z, lbh.w};
        float v8[8];
        unpack_bf8(*(const uint4*)(p.S[1] + HM(t, f)), v8);
        f32x4 oa, ob;
#pragma unroll
        for (int j = 0; j < 4; ++j) {
          oa[j] = ((y[pp][j] - mean) * rstd * lw8[j] + lb8[j] + bon * v8[j]) * g[2 * pp][ti][j];
          ob[j] = ((y[pp][4 + j] - mean) * rstd * lw8[4 + j] + lb8[4 + j] + bon * v8[4 + j]) * g[2 * pp + 1][ti][j];
        }
        store_bf8(p.S[0] + (size_t)t * 1024 + f, oa, ob);
      }
    }
  }
}

DI void phase_gemm_resid(const Params& p, char* lds, const bf16_t* A, const bf16_t* W, int K, int ntm,
                                 const float* xin_l, const float* xin_c, const float* gate, float* dummy_out = nullptr) {
  const int lane = threadIdx.x & 63, wave = threadIdx.x >> 6;
  const int wr = wave >> 2, wc = wave & 3;
  const int total = ntm * 4;
  for (int u = blockIdx.x; u < total; u += gridDim.x) {
    int mt, nt; tile_map(u, total, ntm, 4, mt, nt);
    f32x4 acc[2][2][4][2];
    gemm256_tile<true>(W, A, K, nt * 256, mt * 256, lds, acc);
    int lane_o = threadIdx.x & 63; asm volatile("" : "+v"(lane_o));
    const int fr = lane_o & 15, fq = lane_o >> 4;
#pragma unroll
    for (int bj = 0; bj < 2; ++bj)
#pragma unroll
      for (int n = 0; n < 2; ++n) {
        const int t = mt * 256 + bj * 128 + wc * 32 + n * 16 + fr;
        const int bp = t < NL ? (t >> 12) : 8;
        const float* xi = t < NL ? xin_l + (size_t)t * 1024 : xin_c + (size_t)(t - NL) * 1024;
        float* xo = dummy_out ? dummy_out + (size_t)t * 1024 : (t < NL ? p.out + (size_t)t * 1024 : p.XC + (size_t)(t - NL) * 1024);
#pragma unroll
        for (int ai = 0; ai < 2; ++ai)
#pragma unroll
          for (int mp = 0; mp < 2; ++mp) {
            const int f = nt * 256 + ai * 128 + wr * 64 + mp * 32 + fq * 8;
            const float4 g0 = *(const float4*)(gate + bp * 6144 + f), g1 = *(const float4*)(gate + bp * 6144 + f + 4);
            const float4 x0 = *(const float4*)(xi + f), x1 = *(const float4*)(xi + f + 4);
            const f32x4 a = acc[ai][bj][2 * mp][n], b = acc[ai][bj][2 * mp + 1][n];
            *(float4*)(xo + f) = make_float4(x0.x + g0.x * a[0], x0.y + g0.y * a[1], x0.z + g0.z * a[2], x0.w + g0.w * a[3]);
            *(float4*)(xo + f + 4) = make_float4(x1.x + g1.x * b[0], x1.y + g1.y * b[1], x1.z + g1.z * b[2], x1.w + g1.w * b[3]);
          }
      }
  }
}

DI void phase_up(const Params& p, char* lds, const bf16_t* H, const bf16_t* W, bf16_t* U, int ntm) {
  const int lane = threadIdx.x & 63, wave = threadIdx.x >> 6;
  const int wr = wave >> 2, wc = wave & 3;
  const int total = ntm * 16;
  for (int u = blockIdx.x; u < total; u += gridDim.x) {
    int mt, nt; tile_map(u, total, ntm, 16, mt, nt);
    f32x4 acc[2][2][4][2];
    gemm256_tile<true>(W, H, 1024, nt * 256, mt * 256, lds, acc);
    int lane_o = threadIdx.x & 63; asm volatile("" : "+v"(lane_o));
    const int fr = lane_o & 15, fq = lane_o >> 4;
#pragma unroll
    for (int bj = 0; bj < 2; ++bj)
#pragma unroll
      for (int n = 0; n < 2; ++n) {
        const int t = mt * 256 + bj * 128 + wc * 32 + n * 16 + fr;
#pragma unroll
        for (int ai = 0; ai < 2; ++ai)
#pragma unroll
          for (int mp = 0; mp < 2; ++mp) {
            const int f = nt * 256 + ai * 128 + wr * 64 + mp * 32 + fq * 8;
            f32x4 a = acc[ai][bj][2 * mp][n], b = acc[ai][bj][2 * mp + 1][n];
#pragma unroll
            for (int j = 0; j < 4; ++j) { const float ra = fmaxf(a[j], 0.f), rb = fmaxf(b[j], 0.f); a[j] = ra * ra; b[j] = rb * rb; }
            store_bf8(U + (size_t)t * 4096 + f, a, b);
          }
      }
  }
}

__device__ void phase_qkv(const Params& p, char* lds) {
  const int lane = threadIdx.x & 63, wave = threadIdx.x >> 6;
  const int wr = wave >> 2, wc = wave & 3;
  const int total = (NT / 256) * 6;
  bf16_t* Q = p.S[0]; bf16_t* KA = p.S[1]; bf16_t* VT = p.S[2];
  for (int u = blockIdx.x; u < total; u += gridDim.x) {
    int mt, nt; tile_map(u, total, NT / 256, 6, mt, nt);
    if (mt >= NL / 256 && nt < 4) continue;
    f32x4 acc[2][2][4][2];
    gemm256_tile<false>(p.wqkvT, p.S[5], 1024, nt * 256, mt * 256, lds, acc);
    int lane_o = threadIdx.x & 63; asm volatile("" : "+v"(lane_o));
    const int fr = lane_o & 15, fq = lane_o >> 4;
#pragma unroll
    for (int bj = 0; bj < 2; ++bj)
#pragma unroll
      for (int n = 0; n < 2; ++n) {
        const int t = mt * 256 + bj * 128 + wc * 32 + n * 16 + fr;
        const bool lat = t < NL;
        const int b = lat ? (t >> 12) : ((t - NL) >> 8);
        const int key = lat ? (t & 4095) : 4096 + ((t - NL) & 255);
#pragma unroll
        for (int ai = 0; ai < 2; ++ai) {
          const int hh = ai * 2 + wr;
          asm volatile("" ::: "memory");
          if (nt < 5) {
            float ss = 0.f;
#pragma unroll
            for (int m = 0; m < 4; ++m)
#pragma unroll
              for (int j = 0; j < 4; ++j) ss += acc[ai][bj][m][n][j] * acc[ai][bj][m][n][j];
            ss += __shfl_xor(ss, 16); ss += __shfl_xor(ss, 32);
            const float rstd = rsqrtf(ss * (1.f / 64.f) + 1e-6f);
            const float* gn = nt < 4 ? p.q_norm : p.k_norm;
            float v[4][4];
#pragma unroll
            for (int m = 0; m < 4; ++m) {
              const float4 g4 = *(const float4*)(gn + m * 16 + fq * 4);
              v[m][0] = acc[ai][bj][m][n][0] * rstd * g4.x; v[m][1] = acc[ai][bj][m][n][1] * rstd * g4.y;
              v[m][2] = acc[ai][bj][m][n][2] * rstd * g4.z; v[m][3] = acc[ai][bj][m][n][3] * rstd * g4.w;
            }
            if (lat) {
              const int s = t & 4095, rowp = s >> 6, colp = s & 63;
#pragma unroll
              for (int j = 0; j < 4; ++j) {
                const float2 cs0 = *(const float2*)(p.TAB + (rowp * 16 + fq * 4 + j) * 2);
                const float2 cs1 = *(const float2*)(p.TAB + (colp * 16 + fq * 4 + j) * 2);
                const float x1 = v[0][j], x2 = v[1][j], z1 = v[2][j], z2 = v[3][j];
                v[0][j] = x1 * cs0.x - x2 * cs0.y; v[1][j] = x2 * cs0.x + x1 * cs0.y;
                v[2][j] = z1 * cs1.x - z2 * cs1.y; v[3][j] = z2 * cs1.x + z1 * cs1.y;
              }
            }
            if (nt < 4) {
              const float qs = 0.125f * 1.4426950408889634f;
              const int head = nt * 4 + hh;
#pragma unroll
              for (int m = 0; m < 4; ++m)
                store_bf4(Q + (size_t)t * 1024 + head * 64 + m * 16 + fq * 4, v[m][0] * qs, v[m][1] * qs, v[m][2] * qs, v[m][3] * qs);
            } else {
#pragma unroll
              for (int m = 0; m < 4; ++m)
                store_bf4(KA + ((size_t)(b * 4 + hh) * NKEY + key) * 64 + m * 16 + fq * 4, v[m][0], v[m][1], v[m][2], v[m][3]);
            }
          } else {
#pragma unroll
            for (int m = 0; m < 4; ++m)
#pragma unroll
              for (int j = 0; j < 4; ++j) {
                const int d = m * 16 + fq * 4 + j;
                const unsigned pk = pack2(acc[ai][bj][m][n][j], 0.f);
                VT[((size_t)(b * 4 + hh) * 64 + d) * NKEY + key] = (bf16_t)(pk & 0xffffu);
              }
          }
        }
      }
  }
}

__device__ void phase_attn(const Params& p, char* lds) {
  const int tid = threadIdx.x, lane = tid & 63, wave = tid >> 6;
  const int l31 = lane & 31, lh = lane >> 5;
  const int srow = tid >> 3, sch = tid & 7;
  const bf16_t* Q = p.S[0]; const bf16_t* KA = p.S[1]; const bf16_t* VT = p.S[2]; bf16_t* O = p.S[3];
  float gq = 0.f, gk = 0.f;
  for (int i = 0; i < 64; ++i) { gq = fmaxf(gq, fabsf(p.q_norm[i])); gk = fmaxf(gk, fabsf(p.k_norm[i])); }
  const float M2 = 8.f * gq * gk * 1.4426950408889634f;
  constexpr int NKT = NKEY / 64;
  constexpr int AST = 2 * 64 * ROWB;
  for (int u = blockIdx.x; u < 1024; u += gridDim.x) {
    const int qb = u & 7, head = (u >> 3) & 15, b = u >> 7, kvh = head >> 2;
    const bf16_t* Kg = KA + (size_t)(b * 4 + kvh) * NKEY * 64;
    const bf16_t* Vg = VT + (size_t)(b * 4 + kvh) * 64 * NKEY;
    const int tq0 = b * 4096 + qb * 512 + wave * 64 + l31;
    bf16x8 qf[2][4];
#pragma unroll
    for (int blk = 0; blk < 2; ++blk)
#pragma unroll
      for (int s = 0; s < 4; ++s) qf[blk][s] = *(const bf16x8*)(Q + (size_t)(tq0 + blk * 32) * 1024 + head * 64 + s * 16 + lh * 8);
    f32x16 o[2][2];
#pragma unroll
    for (int blk = 0; blk < 2; ++blk)
#pragma unroll
      for (int dt = 0; dt < 2; ++dt)
#pragma unroll
        for (int i = 0; i < 16; ++i) o[blk][dt][i] = 0.f;
    float lsum[2] = {0.f, 0.f};
    uint4 kreg, vreg;
    __syncthreads();
    for (int kt = -1; kt < NKT; ++kt) {
      const bool more = kt + 1 < NKT;
      if (more) {
        kreg = *(const uint4*)(Kg + (size_t)((kt + 1) * 64 + srow) * 64 + sch * 8);
        vreg = *(const uint4*)(Vg + (size_t)srow * NKEY + (kt + 1) * 64 + sch * 8);
      }
      if (kt >= 0) {
        const char* ksm = lds + (kt & 1) * AST;
        const char* vsm = ksm + 64 * ROWB;
        f32x16 sT[2][2];
#pragma unroll
        for (int blk = 0; blk < 2; ++blk)
#pragma unroll
          for (int k2 = 0; k2 < 2; ++k2)
#pragma unroll
            for (int i = 0; i < 16; ++i) sT[blk][k2][i] = -M2;
#pragma unroll
        for (int k2 = 0; k2 < 2; ++k2)
#pragma unroll
          for (int s = 0; s < 4; ++s) {
            const bf16x8 kf = *(const bf16x8*)(ksm + (k2 * 32 + l31) * ROWB + s * 32 + lh * 16);
            sT[0][k2] = MFMA32(kf, qf[0][s], sT[0][k2]);
            sT[1][k2] = MFMA32(kf, qf[1][s], sT[1][k2]);
          }
#pragma unroll
        for (int blk = 0; blk < 2; ++blk)
#pragma unroll
          for (int k2 = 0; k2 < 2; ++k2)
#pragma unroll
            for (int i = 0; i < 16; ++i) { const float pv = __builtin_amdgcn_exp2f(sT[blk][k2][i]); lsum[blk] += pv; sT[blk][k2][i] = pv; }
#pragma unroll
        for (int k2 = 0; k2 < 2; ++k2)
#pragma unroll
          for (int s2 = 0; s2 < 2; ++s2) {
            bf16x8 pf[2];
#pragma unroll
            for (int blk = 0; blk < 2; ++blk) {
              uint4 pk;
              pk.x = pack2(sT[blk][k2][8 * s2 + 0], sT[blk][k2][8 * s2 + 1]); pk.y = pack2(sT[blk][k2][8 * s2 + 2], sT[blk][k2][8 * s2 + 3]);
              pk.z = pack2(sT[blk][k2][8 * s2 + 4], sT[blk][k2][8 * s2 + 5]); pk.w = pack2(sT[blk][k2][8 * s2 + 6], sT[blk][k2][8 * s2 + 7]);
              pf[blk] = __builtin_bit_cast(bf16x8, pk);
            }
            const int koff = (k2 * 32 + 16 * s2 + 4 * lh) * 2;
#pragma unroll
            for (int dt = 0; dt < 2; ++dt) {
              const uint2 lo = *(const uint2*)(vsm + (dt * 32 + l31) * ROWB + koff), hi = *(const uint2*)(vsm + (dt * 32 + l31) * ROWB + koff + 16);
              const bf16x8 vv = __builtin_bit_cast(bf16x8, make_uint4(lo.x, lo.y, hi.x, hi.y));
              o[0][dt] = MFMA32(vv, pf[0], o[0][dt]);
              o[1][dt] = MFMA32(vv, pf[1], o[1][dt]);
            }
          }
      }
      if (more) {
        const int st = (kt + 1) & 1;
        *(uint4*)(lds + st * AST + srow * ROWB + sch * 16) = kreg;
        *(uint4*)(lds + st * AST + 64 * ROWB + srow * ROWB + sch * 16) = vreg;
      }
      __syncthreads();
    }
#pragma unroll
    for (int blk = 0; blk < 2; ++blk) {
      float ls = lsum[blk];
      ls += __shfl_xor(ls, 32);
      const float inv = 1.f / ls;
      const int tq = tq0 + blk * 32;
#pragma unroll
      for (int g = 0; g < 4; ++g) {
        const int d0 = 8 * g + 4 * lh;
        store_bf4(O + (size_t)tq * 1024 + head * 64 + d0, o[blk][0][4 * g] * inv, o[blk][0][4 * g + 1] * inv, o[blk][0][4 * g + 2] * inv, o[blk][0][4 * g + 3] * inv);
        store_bf4(O + (size_t)tq * 1024 + head * 64 + 32 + d0, o[blk][1][4 * g] * inv, o[blk][1][4 * g + 1] * inv, o[blk][1][4 * g + 2] * inv, o[blk][1][4 * g + 3] * inv);
      }
    }
  }
}

#define XB_TMO      128
#define XB_XCNT(j)  (256  + 64 * (j))
#define XB_XSUB(j)  (1280 + 64 * (j))
#define XB_XGEN(j)  (2304 + 64 * (j))
#define XB_TOP      3328
#define XB_TOPGEN   3392
#define XCD_BAR_WORDS 3456
#define XB_SPIN_CAP (1u << 18)
#define LAS __attribute__((address_space(3)))

__device__ __forceinline__ unsigned xb_ld(unsigned* p)              { return __hip_atomic_load(p, __ATOMIC_RELAXED, __HIP_MEMORY_SCOPE_AGENT); }
__device__ __forceinline__ unsigned xb_add(unsigned* p, unsigned v) { return __hip_atomic_fetch_add(p, v, __ATOMIC_RELAXED, __HIP_MEMORY_SCOPE_AGENT); }
__device__ __forceinline__ unsigned xb_xcc_id() { return (unsigned)__builtin_amdgcn_s_getreg((3 << 11) | 20) & 0xFu; }
#define XB_SPIN(cond, bar) do { unsigned _sp = 0; while (cond) { __builtin_amdgcn_s_sleep(1); \
    if ((++_sp & 255u) == 0u) { if (xb_ld(&(bar)[XB_TMO])) break; if (_sp > XB_SPIN_CAP) { atomicAdd(&(bar)[XB_TMO], 1u); break; } } } } while (0)

struct XcdBarrier {
    unsigned* bar; unsigned x;
    volatile LAS unsigned* st;
};

__device__ __forceinline__ XcdBarrier xcd_barrier_post(unsigned* bar, volatile LAS unsigned* st) {
    XcdBarrier b; b.bar = bar; b.x = xb_xcc_id(); b.st = st;
    if (threadIdx.x == 0) (void)xb_add(&bar[XB_XCNT(b.x)], 1u);
    return b;
}
__device__ __forceinline__ void xcd_barrier_complete(unsigned* bar, unsigned x, unsigned& nloc, unsigned& nx) {
    const unsigned G = gridDim.x * gridDim.y * gridDim.z;
    unsigned sum, cnt, mine, sp = 0u;
    for (;;) {
        sum = 0u; cnt = 0u; mine = 0u;
#pragma unroll
        for (unsigned j = 0; j < 16; ++j) { const unsigned c = xb_ld(&bar[XB_XCNT(j)]); sum += c; cnt += (c > 0u) ? 1u : 0u; mine = (j == x) ? c : mine; }
        if (sum == G) break;
        __builtin_amdgcn_s_sleep(1);
        if ((++sp & 255u) == 0u) { if (xb_ld(&bar[XB_TMO])) break; if (sp > XB_SPIN_CAP) { atomicAdd(&bar[XB_TMO], 1u); break; } }
    }
    nloc = mine > 0u ? mine : 1u; nx = cnt > 0u ? cnt : 1u;
}

__device__ __forceinline__ void xcd_barrier(const XcdBarrier& b) {
    asm volatile("s_waitcnt vmcnt(0)" ::: "memory");
    __syncthreads();
    if (threadIdx.x == 0) {
        unsigned* bar = b.bar;
        __builtin_amdgcn_s_waitcnt(0);
        unsigned nloc = b.st[0], nx = b.st[1];
        if (nloc == 0u) { xcd_barrier_complete(bar, b.x, nloc, nx); b.st[0] = nloc; b.st[1] = nx; }
        const unsigned old = xb_add(&bar[XB_XSUB(b.x)], 1u);
        const unsigned gen = old / nloc;
        if (old + 1u == (gen + 1u) * nloc) {
            __builtin_amdgcn_fence(__ATOMIC_RELEASE, "agent");
            asm volatile("s_waitcnt vmcnt(0)" ::: "memory");
            const unsigned og = xb_add(&bar[XB_TOP], 1u);
            const unsigned tg = og / nx;
            if (og + 1u == (tg + 1u) * nx) xb_add(&bar[XB_TOPGEN], 1u);
            else XB_SPIN(xb_ld(&bar[XB_TOPGEN]) == tg, bar);
            __builtin_amdgcn_fence(__ATOMIC_ACQUIRE, "agent");
            xb_add(&bar[XB_XGEN(b.x)], 1u);
            asm volatile("s_waitcnt vmcnt(0)" ::: "memory");
        } else {
            XB_SPIN(xb_ld(&bar[XB_XGEN(b.x)]) == gen, bar);
            __builtin_amdgcn_fence(__ATOMIC_ACQUIRE, "agent");
            asm volatile("s_waitcnt vmcnt(0)" ::: "memory");
        }
    }
    __syncthreads();
}


DI void run_phase(const Params& p, int ph, char* lds) {
  const float* mod0 = p.MOD;
  const float* mod1 = p.MOD + 9 * 6144;
  switch (ph) {
    case 0: phase0(p, lds); break;
    case 1: norm_mod_phase(p.x, p.ctx, p.norm_mix, mod0, 0, 1, p.Hd, NT); break;
    case 2: phase_proj(p, lds); break;
    case 20: phase_mix(p); break;
    case 3: phase_prep(p, lds); break;
    case 4: phase_scan(p, lds); break;
    case 5: phase_readout(p, lds); break;
    case 6: phase_gemm_resid(p, lds, p.S[0], p.woT, 1024, NT / 256, p.x, p.ctx, mod0 + 2 * 1024); break;
    case 7: norm_mod_phase(p.out, p.XC, p.norm_mlp, mod0, 3, 4, p.S[5], NT); break;
    case 8: phase_up(p, lds, p.S[5], p.w1T[0], p.S[0], NT / 256); break;
    case 9: phase_gemm_resid(p, lds, p.S[0], p.w2T[0], 4096, NT / 256, p.out, p.XC, mod0 + 5 * 1024); break;
    case 10: norm_mod_phase(p.out, p.XC, p.norm_mix + 1024, mod1, 0, 1, p.S[5], NT); break;
    case 11: phase_qkv(p, lds); break;
    case 12: phase_attn(p, lds); break;
    case 13: phase_gemm_resid(p, lds, p.S[3], p.awoT, 1024, NL / 256, p.out, p.XC, mod1 + 2 * 1024); break;
    case 14: norm_mod_phase(p.out, p.XC, p.norm_mlp + 1024, mod1, 3, 4, p.S[5], NL); break;
    case 15: phase_up(p, lds, p.S[5], p.w1T[1], p.S[0], NL / 256); break;
    case 16: phase_gemm_resid(p, lds, p.S[0], p.w2T[1], 4096, NL / 256, p.out, p.XC, mod1 + 5 * 1024); break;
    case 17: final_norm_phase(p); break;
  }
}
constexpr int NPHASE = 18;

__global__ void __launch_bounds__(NTHREADS) mega_kernel(Params p) {
  extern __shared__ __attribute__((aligned(16))) char lds[];
  cg::grid_group grid = cg::this_grid();
  volatile LAS unsigned* st = (volatile LAS unsigned*)(LAS char*)(lds + 131072);
  if (threadIdx.x == 0) { st[0] = 0u; st[1] = 0u; }
  if (blockIdx.x == 0) for (int i = threadIdx.x; i < XCD_BAR_WORDS; i += NTHREADS) p.BAR[i] = 0u;
  __syncthreads();
  run_phase(p, 0, lds);
  grid.sync();
  const XcdBarrier xb = xcd_barrier_post(p.BAR, st);
#ifndef DUP
#define DUP -1
#endif
#define PH(n) run_phase(p, n, lds); xcd_barrier(xb); if (DUP == n) { if (n == 4) phase_scan(p, lds, true); else if (n == 9) phase_gemm_resid(p, lds, p.S[0], p.w2T[0], 4096, NT / 256, p.out, p.XC, p.MOD + 5 * 1024, (float*)p.S[4]); else run_phase(p, n, lds); xcd_barrier(xb); } if (DUP == 100) { xcd_barrier(xb); }
  PH(1) PH(20) PH(2) PH(3) PH(4) PH(5) PH(6) PH(7) PH(8) PH(9) PH(10) PH(11) PH(12) PH(13) PH(14) PH(15) PH(16)
  run_phase(p, 17, lds);
}

extern "C" void kernel_launch(void* const* d_in, const int* in_sizes, int n_in, void* d_out, int out_size, void* d_ws, size_t ws_size, hipStream_t stream) {
  Params p;
  memset(&p, 0, sizeof(p));
  const float* const* in = (const float* const*)d_in;
  p.x = in[0]; p.c = in[1]; p.ctx = in[2]; p.c_ctx = in[3]; p.w_mod = in[4]; p.b_mod = in[5]; p.norm_mix = in[6]; p.norm_mlp = in[7];
  p.mlp_w1 = in[8]; p.mlp_w2 = in[9]; p.mu = in[10]; p.wr = in[11]; p.wk = in[12]; p.wv = in[13]; p.wo = in[14]; p.w0 = in[15]; p.w1 = in[16];
  p.w2 = in[17]; p.a0 = in[18]; p.a1 = in[19]; p.a2 = in[20]; p.g1 = in[21]; p.g2 = in[22]; p.k_k = in[23]; p.k_a = in[24]; p.r_k = in[25];
  p.ln_w = in[26]; p.ln_b = in[27]; p.wqkv = in[28]; p.q_norm = in[29]; p.k_norm = in[30]; p.awo = in[31]; p.final_norm = in[32];
  p.out = (float*)d_out;
  char* ws = (char*)d_ws;
  size_t off = 0;
  auto take = [&](size_t bytes) -> char* { char* r = ws + off; off += (bytes + 255) & ~(size_t)255; return r; };
  p.Wcat = (bf16_t*)take((size_t)3456 * 1024 * 2);
  p.L2w = (bf16_t*)take((size_t)4 * 65536 * 2);
  p.g2T = (bf16_t*)take((size_t)1024 * 128 * 2);
  p.woT = (bf16_t*)take((size_t)1024 * 1024 * 2);
  p.w1T[0] = (bf16_t*)take((size_t)4096 * 1024 * 2);
  p.w1T[1] = (bf16_t*)take((size_t)4096 * 1024 * 2);
  p.w2T[0] = (bf16_t*)take((size_t)4096 * 1024 * 2);
  p.w2T[1] = (bf16_t*)take((size_t)4096 * 1024 * 2);
  p.wqkvT = (bf16_t*)take((size_t)1536 * 1024 * 2);
  p.awoT = (bf16_t*)take((size_t)1024 * 1024 * 2);
  p.MOD = (float*)take((size_t)2 * 9 * 6144 * 4);
  p.TAB = (float*)take((size_t)1024 * 2 * 4);
  p.XC = (float*)take((size_t)NC * 1024 * 4);
  p.BAR = (unsigned*)take((size_t)XCD_BAR_WORDS * 4);
  for (int i = 0; i < 6; ++i) p.S[i] = (bf16_t*)take((size_t)NT * 1024 * 2);
  if (off > ws_size) { fprintf(stderr, "kernel_launch: workspace too small (%zu needed, %zu given)\n", off, ws_size); return; }
  char* ob = (char*)d_out;
  p.Hd = (bf16_t*)ob;
  p.L1 = (bf16_t*)(ob + (size_t)NT * 1024 * 2);
  p.BON = (float*)(ob + (size_t)NT * 1024 * 2 + (size_t)NT * 384 * 2);
  p.NRM = (float*)(ob + (size_t)NT * 1024 * 2 + (size_t)NT * 384 * 2 + (size_t)NT * 16 * 4);
  int nj = 0, tiles = 0;
  auto job = [&](const float* src, bf16_t* dst, int K, int N) {
    p.jobs[nj].src = src; p.jobs[nj].dst = dst; p.jobs[nj].K = K; p.jobs[nj].N = N; p.jobs[nj].tstart = tiles; p.jobs[nj].tiles_n = N / 64;
    tiles += (K / 64) * (N / 64); ++nj;
  };
  job(p.wr, p.Wcat, 1024, 1024);
  job(p.wk, p.Wcat + (size_t)1024 * 1024, 1024, 1024);
  job(p.wv, p.Wcat + (size_t)2048 * 1024, 1024, 1024);
  job(p.g1, p.Wcat + (size_t)3072 * 1024, 1024, 128);
  job(p.w1, p.Wcat + (size_t)3200 * 1024, 1024, 64);
  job(p.w1 + 65536, p.Wcat + (size_t)3264 * 1024, 1024, 64);
  job(p.a1, p.Wcat + (size_t)3328 * 1024, 1024, 64);
  job(p.a1 + 65536, p.Wcat + (size_t)3392 * 1024, 1024, 64);
  job(p.a2, p.L2w, 64, 1024);
  job(p.a2 + 65536, p.L2w + 65536, 64, 1024);
  job(p.w2, p.L2w + 2 * 65536, 64, 1024);
  job(p.w2 + 65536, p.L2w + 3 * 65536, 64, 1024);
  job(p.g2, p.g2T, 128, 1024);
  job(p.wo, p.woT, 1024, 1024);
  job(p.mlp_w1, p.w1T[0], 1024, 4096);
  job(p.mlp_w1 + (size_t)4096 * 1024, p.w1T[1], 1024, 4096);
  job(p.mlp_w2, p.w2T[0], 4096, 1024);
  job(p.mlp_w2 + (size_t)4096 * 1024, p.w2T[1], 4096, 1024);
  job(p.wqkv, p.wqkvT, 1024, 1536);
  job(p.awo, p.awoT, 1024, 1024);
  p.njobs = nj; p.total_tiles = tiles;

  static int grid_blocks = 0;
  if (!grid_blocks) {
    (void)hipFuncSetAttribute((const void*)mega_kernel, hipFuncAttributeMaxDynamicSharedMemorySize, LDS_BYTES);
    int dev = 0, cus = 0, per_cu = 0;
    (void)hipGetDevice(&dev);
    (void)hipDeviceGetAttribute(&cus, hipDeviceAttributeMultiprocessorCount, dev);
    if (hipOccupancyMaxActiveBlocksPerMultiprocessor(&per_cu, (const void*)mega_kernel, NTHREADS, LDS_BYTES) != hipSuccess || per_cu < 1) per_cu = 1;
    if (cus <= 0) cus = 256;
    grid_blocks = cus * per_cu;
    (void)hipGetLastError();
  }
  void* args[] = {&p};
  hipError_t e = hipLaunchCooperativeKernel((const void*)mega_kernel, dim3(grid_blocks), dim3(NTHREADS), args, LDS_BYTES, stream);
  if (e != hipSuccess) fprintf(stderr, "cooperative launch failed: %s (grid %d)\n", hipGetErrorString(e), grid_blocks);
}
```

```cpp
#include <hip/hip_runtime.h>
#include <hip/hip_cooperative_groups.h>
#include <cstdint>
#include <cstring>
#include <cstdio>
namespace cg = cooperative_groups;

typedef unsigned short bf16_t;
typedef short bf16x8 __attribute__((ext_vector_type(8)));
typedef float f32x2 __attribute__((ext_vector_type(2)));
typedef float f32x4 __attribute__((ext_vector_type(4)));
typedef float f32x16 __attribute__((ext_vector_type(16)));
typedef __bf16 bf16x2_t __attribute__((ext_vector_type(2)));
#define DI __device__ __forceinline__

constexpr int D = 1024, NB = 8, SEQ = 4096, CTXL = 256;
constexpr int NL = NB * SEQ, NC = NB * CTXL, NT = NL + NC, DFF = 4096;
constexpr int NKEY = SEQ + CTXL;
constexpr int NTHREADS = 512;
constexpr int ROWB = 144;
constexpr int GEMM_STAGE = (256 + 128) * ROWB;
constexpr int LDS_BYTES = 131072 + 16;

struct TJob { const float* src; bf16_t* dst; int K, N, tstart, tiles_n; };

struct Params {
  const float *x, *c, *ctx, *c_ctx, *w_mod, *b_mod, *norm_mix, *norm_mlp, *mlp_w1, *mlp_w2;
  const float *mu, *wr, *wk, *wv, *wo, *w0, *w1, *w2, *a0, *a1, *a2, *g1, *g2, *k_k, *k_a, *r_k, *ln_w, *ln_b;
  const float *wqkv, *q_norm, *k_norm, *awo, *final_norm;
  float* out;
  bf16_t *Wcat, *L2w, *g2T, *woT, *w1T[2], *w2T[2], *wqkvT, *awoT;
  float *MOD, *TAB, *XC;
  bf16_t* S[6];
  bf16_t *Hd, *L1;
  float* BON;
  float* NRM;
  unsigned* BAR;
  TJob jobs[20];
  int njobs, total_tiles;
};

DI size_t HM(int t, int f) { return ((size_t)(f >> 6) * NT + t) * 64 + (f & 63); }
DI unsigned pack2(float lo, float hi) {
  f32x2 v = {lo, hi};
  bf16x2_t b = __builtin_convertvector(v, bf16x2_t);
  return __builtin_bit_cast(unsigned, b);
}
DI float bflo(unsigned u) { return __uint_as_float(u << 16); }
DI float bfhi(unsigned u) { return __uint_as_float(u & 0xffff0000u); }
DI void store_bf4(bf16_t* p, float a, float b, float c, float d) { *(uint2*)p = make_uint2(pack2(a, b), pack2(c, d)); }
DI void load_bf4(const bf16_t* p, float& a, float& b, float& c, float& d) { uint2 u = *(const uint2*)p; a = bflo(u.x); b = bfhi(u.x); c = bflo(u.y); d = bfhi(u.y); }
DI void store_bf8(bf16_t* p, const f32x4& a, const f32x4& b) {
  uint4 o; o.x = pack2(a[0], a[1]); o.y = pack2(a[2], a[3]); o.z = pack2(b[0], b[1]); o.w = pack2(b[2], b[3]);
  *(uint4*)p = o;
}
DI void store16_sc1(void* p, const uint4& v) {
  typedef unsigned u32x4_t __attribute__((ext_vector_type(4)));
  const u32x4_t d = {v.x, v.y, v.z, v.w};
  asm volatile("global_store_dwordx4 %0, %1, off sc1" :: "v"(p), "v"(d) : "memory");
}
DI void unpack_bf8(const uint4& u, float (&o)[8]) {
  o[0] = bflo(u.x); o[1] = bfhi(u.x); o[2] = bflo(u.y); o[3] = bfhi(u.y); o[4] = bflo(u.z); o[5] = bfhi(u.z); o[6] = bflo(u.w); o[7] = bfhi(u.w);
}
DI int perm32(int rho) { return 8 * ((rho & 15) >> 2) + 4 * (rho >> 4) + (rho & 3); }
DI float sigmoidf_(float x) { return 1.f / (1.f + __expf(-x)); }
DI float tanhf_(float x) { return 1.f - 2.f / (1.f + __expf(2.f * x)); }
DI float wave_sum(float x) {
#pragma unroll
  for (int m = 1; m < 64; m <<= 1) x += __shfl_xor(x, m);
  return x;
}
#define MFMA16(a, b, c) __builtin_amdgcn_mfma_f32_16x16x32_bf16((a), (b), (c), 0, 0, 0)
#define MFMA32(a, b, c) __builtin_amdgcn_mfma_f32_32x32x16_bf16((a), (b), (c), 0, 0, 0)

DI unsigned lerp2(unsigned a, unsigned n, float ma, float mb) {
  const float h0 = bflo(a), h1 = bfhi(a), s0 = bflo(n), s1 = bfhi(n);
  return pack2(h0 + (s0 - h0) * ma, h1 + (s1 - h1) * mb);
}
template <bool LERP>
DI void gemm_tile(const bf16_t* __restrict__ X, int ldx, const bf16_t* __restrict__ W, int ldw, int K, int tok0, int f0,
                  char* lds, f32x4 (&acc)[4][4], const float* __restrict__ mu) {
  const int tid = threadIdx.x, lane = tid & 63, wave = tid >> 6;
  const int wt = wave & 3, wf = wave >> 2, lr = lane & 15, lq = lane >> 4;
  const int lrow = tid >> 3, kc = tid & 7;
#pragma unroll
  for (int i = 0; i < 4; ++i)
#pragma unroll
    for (int j = 0; j < 4; ++j) acc[i][j] = f32x4{0.f, 0.f, 0.f, 0.f};
  uint4 xr[4], wr[2], xn[4];
  float4 m0 = make_float4(0, 0, 0, 0), m1 = m0;
  const int nk = K >> 6;
  __syncthreads();
  for (int kt = -1; kt < nk; ++kt) {
    const bool more = kt + 1 < nk;
    if (more) {
      const int k0 = (kt + 1) << 6;
#pragma unroll
      for (int i = 0; i < 4; ++i) {
        const int tg = tok0 + lrow + 64 * i;
        xr[i] = *(const uint4*)(X + (size_t)tg * ldx + k0 + kc * 8);
        if (LERP) {
          int nb; bool valid;
          if (tok0 < NL) {
            const int s = tg & 4095, col = s & 63, rw = s >> 6, qd = k0 >> 8;
            if (qd == 0) { valid = col > 0; nb = tg - 1; }
            else if (qd == 1) { valid = col < 63; nb = tg + 1; }
            else if (qd == 2) { valid = rw > 0; nb = tg - 64; }
            else { valid = rw < 63; nb = tg + 64; }
          } else {
            const int s = (tg - NL) & 255;
            if (k0 < 512) { valid = s > 0; nb = tg - 1; }
            else { valid = s < 255; nb = tg + 1; }
          }
          if (valid) xn[i] = *(const uint4*)(X + (size_t)nb * ldx + k0 + kc * 8);
          else xn[i] = make_uint4(0, 0, 0, 0);
        }
      }
#pragma unroll
      for (int i = 0; i < 2; ++i) wr[i] = *(const uint4*)(W + (size_t)(f0 + 64 * i + (lrow & 32) + perm32(lrow & 31)) * ldw + k0 + kc * 8);
      if (LERP) { m0 = *(const float4*)(mu + k0 + kc * 8); m1 = *(const float4*)(mu + k0 + kc * 8 + 4); }
    }
    if (kt >= 0) {
      const char* xs = lds + (kt & 1) * GEMM_STAGE;
      const char* wsm = xs + 256 * ROWB;
#pragma unroll
      for (int ks = 0; ks < 2; ++ks) {
        bf16x8 wfr[4], xfr[4];
#pragma unroll
        for (int i = 0; i < 4; ++i) wfr[i] = *(const bf16x8*)(wsm + (wf * 64 + i * 16 + lr) * ROWB + ks * 64 + lq * 16);
#pragma unroll
        for (int i = 0; i < 4; ++i) xfr[i] = *(const bf16x8*)(xs + (wt * 64 + i * 16 + lr) * ROWB + ks * 64 + lq * 16);
#pragma unroll
        for (int fi = 0; fi < 4; ++fi)
#pragma unroll
          for (int ti = 0; ti < 4; ++ti) acc[fi][ti] = MFMA16(wfr[fi], xfr[ti], acc[fi][ti]);
      }
    }
    if (more) {
      char* xs = lds + ((kt + 1) & 1) * GEMM_STAGE;
      char* wsm = xs + 256 * ROWB;
#pragma unroll
      for (int i = 0; i < 4; ++i) {
        uint4 v = xr[i];
        if (LERP) {
          v.x = lerp2(xr[i].x, xn[i].x, m0.x, m0.y);
          v.y = lerp2(xr[i].y, xn[i].y, m0.z, m0.w);
          v.z = lerp2(xr[i].z, xn[i].z, m1.x, m1.y);
          v.w = lerp2(xr[i].w, xn[i].w, m1.z, m1.w);
        }
        *(uint4*)(xs + (lrow + 64 * i) * ROWB + kc * 16) = v;
      }
#pragma unroll
      for (int i = 0; i < 2; ++i) *(uint4*)(wsm + (lrow + 64 * i) * ROWB + kc * 16) = wr[i];
    }
    __syncthreads();
  }
}


namespace g256 {
constexpr int BK = 64, HALF = 128, HT = HALF * BK;
DI int lds_byte(int r, int c) { const int st = (r >> 4) * 2 + (c >> 5), rr = r & 15, cc = c & 31, ob = rr * 64 + cc * 2; return st * 1024 + (ob ^ (((ob >> 9) & 1) << 5)); }
DI void stage_rc(int b, int& R, int& C) { const int st = b / 1024, sb = b % 1024, swz = sb ^ (((sb >> 9) & 1) << 5); R = (st >> 1) * 16 + swz / 64; C = (st & 1) * 32 + (swz % 64) / 2; }
}
#define G_SA(b, h) (((b) * 2 + (h)) * 16384)
#define G_SB(b, h) ((4 + (b) * 2 + (h)) * 16384)
#define G_STAGEV(bufoff, gbase, vo) do { _Pragma("unroll") for (int _i = 0; _i < 2; ++_i) \
    __builtin_amdgcn_global_load_lds((const unsigned*)((const char*)(gbase) + (vo)[_i]), (__attribute__((address_space(3))) unsigned*)(lds + (bufoff) + ldsw + _i * 8192), 16, 0, 0); } while (0)
#define G_LDA(dst, b, h) do { _Pragma("unroll") for (int m = 0; m < 4; ++m) _Pragma("unroll") for (int k = 0; k < 2; ++k) \
    dst[m][k] = *(const __attribute__((address_space(3))) bf16x8*)(lds + G_SA(b, h) + aoff + m * 2048 + k * 1024); } while (0)
#define G_LDB(dst, b, h) do { _Pragma("unroll") for (int n = 0; n < 2; ++n) _Pragma("unroll") for (int k = 0; k < 2; ++k) \
    dst[n][k] = *(const __attribute__((address_space(3))) bf16x8*)(lds + G_SB(b, h) + boff + n * 2048 + k * 1024); } while (0)
#define G_MMA(ai, bj, At, Bt) do { __builtin_amdgcn_s_setprio(1); \
    _Pragma("unroll") for (int m = 0; m < 4; ++m) _Pragma("unroll") for (int n = 0; n < 2; ++n) _Pragma("unroll") for (int k = 0; k < 2; ++k) \
      acc[ai][bj][m][n] = __builtin_amdgcn_mfma_f32_16x16x32_bf16(At[m][k], Bt[n][k], acc[ai][bj][m][n], 0, 0, 0); \
    __builtin_amdgcn_s_setprio(0); } while (0)
#define G_WAIT_V(n) asm volatile("s_waitcnt vmcnt(" #n ")" ::: "memory")
#define G_WAIT_L(n) asm volatile("s_waitcnt lgkmcnt(" #n ")" ::: "memory")
#define G_BAR __builtin_amdgcn_s_barrier()
#define G_SCHED __builtin_amdgcn_sched_barrier(0)

template <bool PERM>
DI void gemm256_tile(const bf16_t* __restrict__ A, const bf16_t* __restrict__ Bt, int K, int brow, int bcol, char* lds_, f32x4 (&acc)[2][2][4][2]) {
  __attribute__((address_space(3))) unsigned char* lds = (__attribute__((address_space(3))) unsigned char*)lds_;
  int tid = threadIdx.x; asm volatile("" : "+v"(tid));
  const int wid = __builtin_amdgcn_readfirstlane(tid >> 6), lane = tid & 63, wr = wid >> 2, wc = wid & 3, fr = lane & 15, fq = lane >> 4;
#pragma unroll
  for (int a = 0; a < 2; ++a)
#pragma unroll
    for (int b = 0; b < 2; ++b)
#pragma unroll
      for (int m = 0; m < 4; ++m)
#pragma unroll
        for (int n = 0; n < 2; ++n) acc[a][b][m][n] = f32x4{0.f, 0.f, 0.f, 0.f};
  unsigned voff[2], voffA[2];
#pragma unroll
  for (int i = 0; i < 2; ++i) { int R, C; g256::stage_rc(tid * 16 + i * 8192, R, C); voff[i] = (unsigned)(R * K + C) * 2u;
    const int Ra = PERM ? ((R & ~31) + perm32(R & 31)) : R; voffA[i] = (unsigned)(Ra * K + C) * 2u; }
  const size_t kstep = 128, hstep = (size_t)128 * K * 2;
  const unsigned ldsw = (unsigned)wid * 1024u;
  const int aoff = g256::lds_byte(wr * 64 + fr, fq * 8), boff = g256::lds_byte(wc * 32 + fr, fq * 8);
  const char* cA = (const char*)A + (size_t)brow * K * 2;
  const char* cB = (const char*)Bt + (size_t)bcol * K * 2;
  bf16x8 At[4][2], B0[2][2], B1[2][2];
  const int nt = K / g256::BK;
  __syncthreads();
  G_STAGEV(G_SB(0, 0), cB, voff); G_STAGEV(G_SA(0, 0), cA, voffA); G_STAGEV(G_SB(0, 1), cB + hstep, voff); G_STAGEV(G_SA(0, 1), cA + hstep, voffA);
  if (wr == 1) G_BAR;
  G_WAIT_V(4); G_BAR;
  G_STAGEV(G_SB(1, 0), cB + kstep, voff); G_STAGEV(G_SA(1, 0), cA + kstep, voffA); G_STAGEV(G_SB(1, 1), cB + hstep + kstep, voff);
  G_WAIT_V(6); G_BAR;
  for (int t = 0; t < nt - 2; t += 2) {
    const char* a1 = cA + (size_t)(t + 1) * kstep;
    const char* a2 = cA + (size_t)(t + 2) * kstep; const char* b2 = cB + (size_t)(t + 2) * kstep;
    const char* a3 = a2 + kstep; const char* b3 = b2 + kstep;
    G_LDB(B0, 0, 0); G_SCHED; G_LDA(At, 0, 0); G_STAGEV(G_SA(1, 1), a1 + hstep, voffA);
    G_WAIT_L(8); G_BAR; G_WAIT_L(0); G_MMA(0, 0, At, B0); G_BAR; G_SCHED;
    G_LDB(B1, 0, 1); G_STAGEV(G_SB(0, 0), b2, voff);
    G_BAR; G_WAIT_L(0); G_MMA(0, 1, At, B1); G_BAR;
    G_LDA(At, 0, 1); G_STAGEV(G_SA(0, 0), a2, voffA);
    G_BAR; G_WAIT_L(0); G_MMA(1, 0, At, B0); G_BAR; G_SCHED;
    G_STAGEV(G_SB(0, 1), b2 + hstep, voff);
    G_WAIT_V(6); G_BAR; G_MMA(1, 1, At, B1); G_BAR;
    G_LDB(B0, 1, 0); G_SCHED; G_LDA(At, 1, 0); G_STAGEV(G_SA(0, 1), a2 + hstep, voffA);
    G_WAIT_L(8); G_BAR; G_WAIT_L(0); G_MMA(0, 0, At, B0); G_BAR; G_SCHED;
    G_LDB(B1, 1, 1); G_STAGEV(G_SB(1, 0), b3, voff);
    G_BAR; G_WAIT_L(0); G_MMA(0, 1, At, B1); G_BAR;
    G_LDA(At, 1, 1); G_STAGEV(G_SA(1, 0), a3, voffA);
    G_BAR; G_WAIT_L(0); G_MMA(1, 0, At, B0); G_BAR; G_SCHED;
    G_STAGEV(G_SB(1, 1), b3 + hstep, voff);
    G_WAIT_V(6); G_BAR; G_MMA(1, 1, At, B1); G_BAR;
  }
  { G_LDB(B0, 0, 0); G_LDA(At, 0, 0); G_STAGEV(G_SA(1, 1), cA + (size_t)(nt - 1) * kstep + hstep, voffA);
    G_BAR; G_WAIT_L(0); G_MMA(0, 0, At, B0); G_BAR;
    G_LDB(B1, 0, 1); G_BAR; G_WAIT_L(0); G_MMA(0, 1, At, B1); G_BAR;
    G_LDA(At, 0, 1); G_WAIT_V(4); G_BAR; G_WAIT_L(0); G_MMA(1, 0, At, B0); G_MMA(1, 1, At, B1); G_BAR; }
  { G_LDB(B0, 1, 0); G_LDA(At, 1, 0); G_WAIT_V(2); G_BAR; G_WAIT_L(0); G_MMA(0, 0, At, B0); G_BAR;
    G_LDB(B1, 1, 1); G_WAIT_V(0); G_BAR; G_WAIT_L(0); G_MMA(0, 1, At, B1); G_BAR;
    G_LDA(At, 1, 1); G_BAR; G_WAIT_L(0); G_MMA(1, 0, At, B0); G_MMA(1, 1, At, B1); G_BAR; }
  if (wr == 0) G_BAR;
}

DI void tile_map(int L, int total, int ntm, int ntn, int& mt, int& nt) {
  const int q = total >> 3, r = total & 7, xcd = L & 7, off = L >> 3;
  const int id = (xcd < r ? xcd * (q + 1) : r * (q + 1) + (xcd - r) * q) + off;
  const int nig = 8 * ntn, g = id / nig, w = id % nig, fm = g * 8, gsz = min(ntm - fm, 8);
  mt = fm + w % gsz; nt = w / gsz;
}
DI void convert_tile(const TJob& jb, int t, char* lds) {
  float* tile = (float*)lds;
  const int tid = threadIdx.x;
  const int tk = t / jb.tiles_n, tn = t % jb.tiles_n;
  const int k0 = tk * 64, n0 = tn * 64;
  __syncthreads();
#pragma unroll
  for (int i = 0; i < 2; ++i) {
    const int idx = tid + 512 * i, row = idx >> 4, c4 = idx & 15;
    const float4 v = *(const float4*)(jb.src + (size_t)(k0 + row) * jb.N + n0 + c4 * 4);
    tile[row * 65 + c4 * 4 + 0] = v.x; tile[row * 65 + c4 * 4 + 1] = v.y; tile[row * 65 + c4 * 4 + 2] = v.z; tile[row * 65 + c4 * 4 + 3] = v.w;
  }
  __syncthreads();
  const int n = tid >> 3, kc = tid & 7;
  float v[8];
#pragma unroll
  for (int j = 0; j < 8; ++j) v[j] = tile[(kc * 8 + j) * 65 + n];
  uint4 o;
  o.x = pack2(v[0], v[1]); o.y = pack2(v[2], v[3]); o.z = pack2(v[4], v[5]); o.w = pack2(v[6], v[7]);
  *(uint4*)(jb.dst + (size_t)(n0 + n) * jb.K + k0 + kc * 8) = o;
}

DI void mod_unit(const Params& p, int mu_, char* lds) {
  const int tid = threadIdx.x;
  const int layer = mu_ / 96, cc = mu_ % 96;
  float* sc = (float*)lds;
  float* red = sc + 9 * 1024;
  __syncthreads();
  for (int i = tid; i < 9 * 1024; i += 512) {
    const int row = i >> 10, k = i & 1023;
    const float v = row < 8 ? p.c[row * 1024 + k] : p.c_ctx[k];
    sc[i] = v / (1.f + __expf(-v));
  }
  __syncthreads();
  const int kg = tid >> 6, col = tid & 63;
  const float* w = p.w_mod + (size_t)layer * 1024 * 6144 + cc * 64 + col;
  float a[9];
#pragma unroll
  for (int r = 0; r < 9; ++r) a[r] = 0.f;
#pragma unroll 16
  for (int k = kg * 128; k < kg * 128 + 128; ++k) {
    const float wv = w[(size_t)k * 6144];
#pragma unroll
    for (int r = 0; r < 9; ++r) a[r] += sc[r * 1024 + k] * wv;
  }
#pragma unroll
  for (int r = 0; r < 9; ++r) red[(kg * 9 + r) * 64 + col] = a[r];
  __syncthreads();
  for (int i = tid; i < 576; i += 512) {
    const int r = i >> 6, cl = i & 63;
    float s = 0.f;
#pragma unroll
    for (int g = 0; g < 8; ++g) s += red[(g * 9 + r) * 64 + cl];
    const int n = cc * 64 + cl;
    p.MOD[(layer * 9 + r) * 6144 + n] = s + p.b_mod[layer * 6144 + n];
  }
  __syncthreads();
}

DI void sincos_d(double a, double& s, double& c) {
  const double n = rint(a * 0.6366197723675814);
  const double r = (a - n * 1.5707963267948966) - n * 6.123233995736766e-17;
  const double r2 = r * r;
  const double sp = r * (1.0 + r2 * (-1.0 / 6.0 + r2 * (1.0 / 120.0 + r2 * (-1.0 / 5040.0 + r2 * (1.0 / 362880.0 + r2 * (-1.0 / 39916800.0 + r2 * (1.0 / 6227020800.0)))))));
  const double cp = 1.0 + r2 * (-0.5 + r2 * (1.0 / 24.0 + r2 * (-1.0 / 720.0 + r2 * (1.0 / 40320.0 + r2 * (-1.0 / 3628800.0 + r2 * (1.0 / 479001600.0 + r2 * (-1.0 / 87178291200.0)))))));
  const int q = ((int)n) & 3;
  if (q == 0) { s = sp; c = cp; }
  else if (q == 1) { s = cp; c = -sp; }
  else if (q == 2) { s = -sp; c = -cp; }
  else { s = -cp; c = sp; }
}

DI void tab_unit(const Params& p) {
  for (int idx = threadIdx.x; idx < 1024; idx += 512) {
    const int pos = idx >> 4, fi = idx & 15;
    double f = 1.0;
    for (int i = 0; i < fi; ++i) f *= 0.5623413251903491;
    double s, c;
    sincos_d((double)pos * (double)(float)f, s, c);
    p.TAB[idx * 2 + 0] = (float)c;
    p.TAB[idx * 2 + 1] = (float)s;
  }
}

DI void phase0(const Params& p, char* lds) {
  const int total = p.total_tiles + 192 + 1;
  for (int u = blockIdx.x; u < total; u += gridDim.x) {
    if (u < p.total_tiles) {
      int j = 0;
#pragma unroll 1
      for (int q = 1; q < p.njobs; ++q) if (u >= p.jobs[q].tstart) j = q;
      convert_tile(p.jobs[j], u - p.jobs[j].tstart, lds);
    } else if (u < p.total_tiles + 192) {
      mod_unit(p, u - p.total_tiles, lds);
    } else {
      tab_unit(p);
    }
  }
}

DI void norm_mod_phase(const float* __restrict__ xl, const float* __restrict__ xc, const float* __restrict__ gain,
                               const float* __restrict__ mod, int shift_i, int scale_i, bf16_t* __restrict__ H, int ntok) {
  const int lane = threadIdx.x & 63;
  const int wg = blockIdx.x * 8 + (threadIdx.x >> 6), nw = gridDim.x * 8;
  for (int t = wg; t < ntok; t += nw) {
    const float* row = t < NL ? xl + (size_t)t * 1024 : xc + (size_t)(t - NL) * 1024;
    float4 v[4];
    float ss = 0.f;
#pragma unroll
    for (int i = 0; i < 4; ++i) {
      v[i] = *(const float4*)(row + (lane + 64 * i) * 4);
      ss += v[i].x * v[i].x + v[i].y * v[i].y + v[i].z * v[i].z + v[i].w * v[i].w;
    }
    ss = wave_sum(ss);
    const float rstd = rsqrtf(ss * (1.f / 1024.f) + 1e-6f);
    const int bp = t < NL ? (t >> 12) : 8;
    const float* sh = mod + (bp * 6 + shift_i) * 1024;
    const float* sc = mod + (bp * 6 + scale_i) * 1024;
#pragma unroll
    for (int i = 0; i < 4; ++i) {
      const int c = (lane + 64 * i) * 4;
      const float4 g = *(const float4*)(gain + c), s4 = *(const float4*)(sh + c), c4 = *(const float4*)(sc + c);
      store_bf4(H + (size_t)t * 1024 + c,
                v[i].x * rstd * g.x * (1.f + c4.x) + s4.x, v[i].y * rstd * g.y * (1.f + c4.y) + s4.y,
                v[i].z * rstd * g.z * (1.f + c4.z) + s4.z, v[i].w * rstd * g.w * (1.f + c4.w) + s4.w);
    }
  }
}

DI void final_norm_phase(const Params& p) {
  const int lane = threadIdx.x & 63;
  const int wg = blockIdx.x * 8 + (threadIdx.x >> 6), nw = gridDim.x * 8;
  for (int t = wg; t < NL; t += nw) {
    float* row = p.out + (size_t)t * 1024;
    float4 v[4];
    float ss = 0.f;
#pragma unroll
    for (int i = 0; i < 4; ++i) {
      v[i] = *(const float4*)(row + (lane + 64 * i) * 4);
      ss += v[i].x * v[i].x + v[i].y * v[i].y + v[i].z * v[i].z + v[i].w * v[i].w;
    }
    ss = wave_sum(ss);
    const float rstd = rsqrtf(ss * (1.f / 1024.f) + 1e-6f);
#pragma unroll
    for (int i = 0; i < 4; ++i) {
      const int c = (lane + 64 * i) * 4;
      const float4 g = *(const float4*)(p.final_norm + c);
      *(float4*)(row + c) = make_float4(v[i].x * rstd * g.x, v[i].y * rstd * g.y, v[i].z * rstd * g.z, v[i].w * rstd * g.w);
    }
  }
}

DI void phase_mix(const Params& p) {
  const int lane = threadIdx.x & 63;
  const int wg = blockIdx.x * 8 + (threadIdx.x >> 6), nw = gridDim.x * 8;
  for (int t = wg; t < NT; t += nw) {
#pragma unroll
    for (int i = 0; i < 2; ++i) {
      const int c = lane * 8 + 512 * i;
      const uint4 own = *(const uint4*)(p.Hd + (size_t)t * 1024 + c);
      int nb; bool valid;
      if (t < NL) {
        const int s = t & 4095, col = s & 63, rw = s >> 6, qd = c >> 8;
        if (qd == 0) { valid = col > 0; nb = t - 1; }
        else if (qd == 1) { valid = col < 63; nb = t + 1; }
        else if (qd == 2) { valid = rw > 0; nb = t - 64; }
        else { valid = rw < 63; nb = t + 64; }
      } else {
        const int s = (t - NL) & 255;
        if (c < 512) { valid = s > 0; nb = t - 1; }
        else { valid = s < 255; nb = t + 1; }
      }
      uint4 nv = make_uint4(0, 0, 0, 0);
      if (valid) nv = *(const uint4*)(p.Hd + (size_t)nb * 1024 + c);
#pragma unroll
      for (int j = 0; j < 3; ++j) {
        const int mi = j == 0 ? 0 : j == 1 ? 2 : 3;
        const float4 m0 = *(const float4*)(p.mu + mi * 1024 + c), m1 = *(const float4*)(p.mu + mi * 1024 + c + 4);
        uint4 o;
        o.x = lerp2(own.x, nv.x, m0.x, m0.y); o.y = lerp2(own.y, nv.y, m0.z, m0.w);
        o.z = lerp2(own.z, nv.z, m1.x, m1.y); o.w = lerp2(own.w, nv.w, m1.z, m1.w);
        *(uint4*)(p.S[3 + j] + (size_t)t * 1024 + c) = o;
      }
    }
  }
}

DI void phase_proj(const Params& p, char* lds) {
  const int lane = threadIdx.x & 63, wave = threadIdx.x >> 6;
  constexpr int NLORA = (NT / 256) * 3, NRKV = (NT / 256) * 12;
  for (int u = blockIdx.x; u < NLORA; u += gridDim.x) {
    {
      const int wt = wave & 3, wf = wave >> 2, lr = lane & 15, lq = lane >> 4;
      const int mt = u / 3, nt = 24 + u % 3;
      const int mi = nt == 24 ? 5 : nt == 25 ? 1 : 4;
      f32x4 acc[4][4];
      gemm_tile<true>(p.Hd, 1024, p.Wcat, 1024, 1024, mt * 256, nt * 128, lds, acc, p.mu + mi * 1024);
#pragma unroll
      for (int pp = 0; pp < 2; ++pp)
#pragma unroll
        for (int ti = 0; ti < 4; ++ti) {
          const int t = mt * 256 + wt * 64 + ti * 16 + lr;
          const int fl = wf * 64 + pp * 32 + lq * 8;
          f32x4 a = acc[2 * pp][ti], b = acc[2 * pp + 1][ti];
          if (nt == 24) {
#pragma unroll
            for (int j = 0; j < 4; ++j) { a[j] = sigmoidf_(a[j]); b[j] = sigmoidf_(b[j]); }
            store_bf8(p.L1 + (size_t)t * 384 + fl, a, b);
          } else if (nt == 25) {
#pragma unroll
            for (int j = 0; j < 4; ++j) { a[j] = tanhf_(a[j]); b[j] = tanhf_(b[j]); }
            store_bf8(p.L1 + (size_t)t * 384 + 128 + fl, a, b);
          } else {
            store_bf8(p.L1 + (size_t)t * 384 + 256 + fl, a, b);
          }
        }
    }
  }
  for (int v0 = blockIdx.x; v0 < NRKV; v0 += gridDim.x) {
    {
      const int wr = wave >> 2, wc = wave & 3;
      f32x4 acc[2][2][4][2];
      { int mt0, rem0; tile_map(v0, NRKV, NT / 256, 12, mt0, rem0); const int j0 = rem0 >> 2, nt0 = rem0 & 3;
        gemm256_tile<true>(p.Wcat + (size_t)j0 * 1024 * 1024, p.S[3 + j0], 1024, nt0 * 256, mt0 * 256, lds, acc); }
      int lane_o = threadIdx.x & 63; asm volatile("" : "+v"(lane_o));
      int v = v0; asm volatile("" : "+s"(v));
      int mt, rem; tile_map(v, NRKV, NT / 256, 12, mt, rem); const int j = rem >> 2, nt = rem & 3;
      const int fr = lane_o & 15, fq = lane_o >> 4;
#pragma unroll
      for (int bj = 0; bj < 2; ++bj)
#pragma unroll
        for (int n = 0; n < 2; ++n) {
          const int t = mt * 256 + bj * 128 + wc * 32 + n * 16 + fr;
#pragma unroll
          for (int ai = 0; ai < 2; ++ai) {
            const int fh = nt * 256 + ai * 128 + wr * 64;
            if (j == 1) {
              f32x4 a[2], b[2];
              float ss = 0.f;
#pragma unroll
              for (int mp = 0; mp < 2; ++mp) {
                const int f = fh + mp * 32 + fq * 8;
                const float4 kkl = *(const float4*)(p.k_k + f), kkh = *(const float4*)(p.k_k + f + 4);
                a[mp] = acc[ai][bj][2 * mp][n]; b[mp] = acc[ai][bj][2 * mp + 1][n];
                a[mp][0] *= kkl.x; a[mp][1] *= kkl.y; a[mp][2] *= kkl.z; a[mp][3] *= kkl.w;
                b[mp][0] *= kkh.x; b[mp][1] *= kkh.y; b[mp][2] *= kkh.z; b[mp][3] *= kkh.w;
#pragma unroll
                for (int e2 = 0; e2 < 4; ++e2) ss += a[mp][e2] * a[mp][e2] + b[mp][e2] * b[mp][e2];
              }
              ss += __shfl_xor(ss, 16); ss += __shfl_xor(ss, 32);
              const float kinv = rsqrtf(ss + 1e-12f);
#pragma unroll
              for (int mp = 0; mp < 2; ++mp) {
#pragma unroll
                for (int e2 = 0; e2 < 4; ++e2) { a[mp][e2] *= kinv; b[mp][e2] *= kinv; }
                store_bf8(p.S[2] + HM(t, fh + mp * 32 + fq * 8), a[mp], b[mp]);
              }
              if (fq == 0) p.NRM[(size_t)(fh >> 6) * NT + t] = sqrtf(ss + 1e-12f);
            } else {
              bf16_t* dst = j == 0 ? p.S[0] : p.S[1];
#pragma unroll
              for (int mp = 0; mp < 2; ++mp)
                store_bf8(dst + HM(t, fh + mp * 32 + fq * 8), acc[ai][bj][2 * mp][n], acc[ai][bj][2 * mp + 1][n]);
            }
          }
        }
    }
  }
}

DI void phase_prep(const Params& p, char* lds) {
  const int lane = threadIdx.x & 63, wave = threadIdx.x >> 6;
  const int wt = wave & 3, wf = wave >> 2, lr = lane & 15, lq = lane >> 4;
  const int total = (NT / 256) * 8;
  for (int u = blockIdx.x; u < total; u += gridDim.x) {
    const int mt = u >> 3, nt = u & 7;
    const int tok0 = mt * 256, f0 = nt * 128;
    f32x4 acc[4][4];
    uint4 afp[2][4];
    gemm_tile<false>(p.L1 + 256, 384, p.L2w + 0 * 65536, 64, 64, tok0, f0, lds, acc, nullptr);
#pragma unroll
    for (int pp = 0; pp < 2; ++pp) {
      const int f = f0 + wf * 64 + pp * 32 + lq * 8;
      const float4 a0l = *(const float4*)(p.a0 + f), a0h = *(const float4*)(p.a0 + f + 4);
#pragma unroll
      for (int ti = 0; ti < 4; ++ti) {
        const int t = tok0 + wt * 64 + ti * 16 + lr;
        f32x4 a = acc[2 * pp][ti], b = acc[2 * pp + 1][ti];
        a[0] = sigmoidf_(a[0] + a0l.x); a[1] = sigmoidf_(a[1] + a0l.y); a[2] = sigmoidf_(a[2] + a0l.z); a[3] = sigmoidf_(a[3] + a0l.w);
        b[0] = sigmoidf_(b[0] + a0h.x); b[1] = sigmoidf_(b[1] + a0h.y); b[2] = sigmoidf_(b[2] + a0h.z); b[3] = sigmoidf_(b[3] + a0h.w);
        uint4 o; o.x = pack2(a[0], a[1]); o.y = pack2(a[2], a[3]); o.z = pack2(b[0], b[1]); o.w = pack2(b[2], b[3]);
        afp[pp][ti] = o;
        *(uint4*)(p.S[3] + HM(t, f)) = o;
      }
    }
    gemm_tile<false>(p.L1 + 320, 384, p.L2w + 1 * 65536, 64, 64, tok0, f0, lds, acc, nullptr);
#pragma unroll
    for (int ti = 0; ti < 4; ++ti) {
      const int t = tok0 + wt * 64 + ti * 16 + lr;
      float bon = 0.f;
      const float nrm = p.NRM[(size_t)(nt * 2 + wf) * NT + t];
#pragma unroll
      for (int pp = 0; pp < 2; ++pp) {
        const int f = f0 + wf * 64 + pp * 32 + lq * 8;
        const float4 a0l = *(const float4*)(p.a0 + 1024 + f), a0h = *(const float4*)(p.a0 + 1024 + f + 4);
        const float4 rkl = *(const float4*)(p.r_k + f), rkh = *(const float4*)(p.r_k + f + 4);
        const float4 kal = *(const float4*)(p.k_a + f), kah = *(const float4*)(p.k_a + f + 4);
        const float4 kkl = *(const float4*)(p.k_k + f), kkh = *(const float4*)(p.k_k + f + 4);
        const float rk8[8] = {rkl.x, rkl.y, rkl.z, rkl.w, rkh.x, rkh.y, rkh.z, rkh.w};
        const float ka8[8] = {kal.x, kal.y, kal.z, kal.w, kah.x, kah.y, kah.z, kah.w};
        const float kk8[8] = {kkl.x, kkl.y, kkl.z, kkl.w, kkh.x, kkh.y, kkh.z, kkh.w};
        f32x4 a = acc[2 * pp][ti], b = acc[2 * pp + 1][ti];
        a[0] = sigmoidf_(a[0] + a0l.x); a[1] = sigmoidf_(a[1] + a0l.y); a[2] = sigmoidf_(a[2] + a0l.z); a[3] = sigmoidf_(a[3] + a0l.w);
        b[0] = sigmoidf_(b[0] + a0h.x); b[1] = sigmoidf_(b[1] + a0h.y); b[2] = sigmoidf_(b[2] + a0h.z); b[3] = sigmoidf_(b[3] + a0h.w);
        store_bf8(p.S[4] + HM(t, f), a, b);
        const float ab8[8] = {a[0], a[1], a[2], a[3], b[0], b[1], b[2], b[3]};
        float af8[8], r8[8], k8[8];
        unpack_bf8(afp[pp][ti], af8);
        unpack_bf8(*(const uint4*)(p.S[0] + HM(t, f)), r8);
        unpack_bf8(*(const uint4*)(p.S[2] + HM(t, f)), k8);
#pragma unroll
        for (int e2 = 0; e2 < 8; ++e2) {
          const float k = k8[e2] * nrm / kk8[e2];
          bon += r8[e2] * k * rk8[e2] * (2.f + (ab8[e2] + af8[e2] - 2.f) * ka8[e2]);
        }
      }
      bon += __shfl_xor(bon, 16); bon += __shfl_xor(bon, 32);
      if (lq == 0) p.BON[(size_t)(nt * 2 + wf) * NT + t] = bon;
    }
#pragma unroll 1
    for (int dr = 0; dr < 2; ++dr) {
      gemm_tile<false>(p.L1 + 128 + dr * 64, 384, p.L2w + (2 + dr) * 65536, 64, 64, tok0, f0, lds, acc, nullptr);
      bf16_t* dst = dr ? p.S[5] : p.Hd;
#pragma unroll
      for (int pp = 0; pp < 2; ++pp) {
        const int f = f0 + wf * 64 + pp * 32 + lq * 8;
        const float4 w0l = *(const float4*)(p.w0 + dr * 1024 + f), w0h = *(const float4*)(p.w0 + dr * 1024 + f + 4);
#pragma unroll
        for (int ti = 0; ti < 4; ++ti) {
          const int t = tok0 + wt * 64 + ti * 16 + lr;
          f32x4 a = acc[2 * pp][ti], b = acc[2 * pp + 1][ti];
          a[0] = -0.60653066f * sigmoidf_(a[0] + w0l.x); a[1] = -0.60653066f * sigmoidf_(a[1] + w0l.y);
          a[2] = -0.60653066f * sigmoidf_(a[2] + w0l.z); a[3] = -0.60653066f * sigmoidf_(a[3] + w0l.w);
          b[0] = -0.60653066f * sigmoidf_(b[0] + w0h.x); b[1] = -0.60653066f * sigmoidf_(b[1] + w0h.y);
          b[2] = -0.60653066f * sigmoidf_(b[2] + w0h.z); b[3] = -0.60653066f * sigmoidf_(b[3] + w0h.w);
          store_bf8(dst + HM(t, f), a, b);
        }
      }
    }
  }
}

typedef short s16x4 __attribute__((ext_vector_type(4)));
#define MFMA16K(a, b, c) __builtin_amdgcn_mfma_f32_16x16x16bf16_1k((a), (b), (c), 0, 0, 0)
DI s16x4 pack4(const f32x4& x) { const uint2 u = make_uint2(pack2(x[0], x[1]), pack2(x[2], x[3])); return __builtin_bit_cast(s16x4, u); }
DI bf16x8 pack8(const f32x4& a, const f32x4& b) { const uint4 u = make_uint4(pack2(a[0], a[1]), pack2(a[2], a[3]), pack2(b[0], b[1]), pack2(b[2], b[3])); return __builtin_bit_cast(bf16x8, u); }
constexpr int SC_KK = 0, SC_R = 2304, SC_B = 4608, SC_K = 6912, SC_BT = 9216, SC_KT = 12288, SC_VT = 15360, SC_CL = 18432, SC_CHUNK = 18688, SC_GROUP = 2 * SC_CHUNK, SC_YBUF = 2 * SC_GROUP;

#define KEEP8(x) asm volatile("" :: "v"(x))
#define KEEP4(x) asm volatile("" :: "v"(x))
DI void scan_chunk(const char* cb, float* yb, f32x4 (&ST)[4], int vb, int c, int q) {
  const f32x4 z = {0.f, 0.f, 0.f, 0.f};
  bf16x8 fB[2], fK[2], fKK[2], fR[2];
#pragma unroll
  for (int ks = 0; ks < 2; ++ks) {
    fB[ks] = *(const bf16x8*)(cb + SC_B + c * 144 + ks * 64 + q * 16);
    fK[ks] = *(const bf16x8*)(cb + SC_K + c * 144 + ks * 64 + q * 16);
    fKK[ks] = *(const bf16x8*)(cb + SC_KK + c * 144 + ks * 64 + q * 16);
    fR[ks] = *(const bf16x8*)(cb + SC_R + c * 144 + ks * 64 + q * 16);
  }
  f32x4 Abk = MFMA16(fB[0], fKK[0], z);  Abk = MFMA16(fB[1], fKK[1], Abk);
  f32x4 AbkT = MFMA16(fKK[0], fB[0], z); AbkT = MFMA16(fKK[1], fB[1], AbkT);
  f32x4 Akk = MFMA16(fK[0], fKK[0], z);  Akk = MFMA16(fK[1], fKK[1], Akk);
  f32x4 Abr = MFMA16(fB[0], fR[0], z);   Abr = MFMA16(fB[1], fR[1], Abr);
  f32x4 Akr = MFMA16(fK[0], fR[0], z);   Akr = MFMA16(fK[1], fR[1], Akr);
  KEEP8(fB[0]); KEEP8(fB[1]); KEEP8(fK[0]); KEEP8(fK[1]); KEEP8(fKK[0]); KEEP8(fKK[1]); KEEP8(fR[0]); KEEP8(fR[1]);
  f32x4 P;
#pragma unroll
  for (int j = 0; j < 4; ++j) {
    const int rr = 4 * q + j;
    Abk[j] = rr < c ? Abk[j] : 0.f;  Akk[j] = rr < c ? Akk[j] : 0.f;
    Abr[j] = rr <= c ? Abr[j] : 0.f; Akr[j] = rr <= c ? Akr[j] : 0.f;
    AbkT[j] = c < rr ? AbkT[j] : 0.f;
    P[j] = (rr == c ? 1.f : 0.f) - Abk[j];
  }
  const s16x4 bN = pack4(Abk), bNT = pack4(AbkT);
  const f32x4 N2 = MFMA16K(bNT, bN, z), N2T = MFMA16K(bN, bNT, z);
  KEEP4(bN); KEEP4(bNT);
  const s16x4 bN2 = pack4(N2), bN2T = pack4(N2T);
  const f32x4 N4 = MFMA16K(bN2T, bN2, z), N4T = MFMA16K(bN2, bN2T, z);
  KEEP4(bN2); KEEP4(bN2T);
  const s16x4 bN4 = pack4(N4), bN4T = pack4(N4T);
  const f32x4 N8T = MFMA16K(bN4, bN4T, z);
  KEEP4(bN4); KEEP4(bN4T);
  const s16x4 bN8T = pack4(N8T);
  { const s16x4 pp_ = pack4(P); P = MFMA16K(bN2T, pp_, P); KEEP4(pp_); KEEP4(bN2T); }
  { const s16x4 pp_ = pack4(P); P = MFMA16K(bN4T, pp_, P); KEEP4(pp_); KEEP4(bN4T); }
  { const s16x4 pp_ = pack4(P); P = MFMA16K(bN8T, pp_, P); KEEP4(pp_); KEEP4(bN8T); }
  const s16x4 bT = pack4(P);
  bf16x8 sf[2], kkp[2], rp[2];
#pragma unroll
  for (int i = 0; i < 2; ++i) {
    sf[i] = pack8(ST[2 * i], ST[2 * i + 1]);
    const uint2 klo = *(const uint2*)(cb + SC_KK + c * 144 + (32 * i + 4 * q) * 2), khi = *(const uint2*)(cb + SC_KK + c * 144 + (32 * i + 16 + 4 * q) * 2);
    const uint2 rlo = *(const uint2*)(cb + SC_R + c * 144 + (32 * i + 4 * q) * 2), rhi = *(const uint2*)(cb + SC_R + c * 144 + (32 * i + 16 + 4 * q) * 2);
    kkp[i] = __builtin_bit_cast(bf16x8, make_uint4(klo.x, klo.y, khi.x, khi.y));
    rp[i] = __builtin_bit_cast(bf16x8, make_uint4(rlo.x, rlo.y, rhi.x, rhi.y));
  }
  f32x4 XT = MFMA16(kkp[0], sf[0], z); XT = MFMA16(kkp[1], sf[1], XT);
  f32x4 YT = MFMA16(rp[0], sf[0], z);  YT = MFMA16(rp[1], sf[1], YT);
  KEEP8(kkp[0]); KEEP8(kkp[1]); KEEP8(rp[0]); KEEP8(rp[1]); KEEP8(sf[0]); KEEP8(sf[1]);
  const s16x4 vf = *(const s16x4*)(cb + SC_VT + (vb * 16 + c) * 48 + q * 8);
  const s16x4 pAkk = pack4(Akk);
  XT = MFMA16K(pAkk, vf, XT); KEEP4(pAkk);
  const s16x4 pXT = pack4(XT);
  f32x4 UT = MFMA16K(bT, pXT, z); KEEP4(pXT); KEEP4(bT);
#pragma unroll
  for (int j = 0; j < 4; ++j) UT[j] = -UT[j];
  const s16x4 bU = pack4(UT);
  const s16x4 pAbr = pack4(Abr), pAkr = pack4(Akr);
  YT = MFMA16K(pAbr, bU, YT);
  YT = MFMA16K(pAkr, vf, YT); KEEP4(pAbr); KEEP4(pAkr);
#pragma unroll
  for (int j = 0; j < 4; ++j) yb[(4 * q + j) * 64 + vb * 16 + c] = YT[j];
#pragma unroll
  for (int kt = 0; kt < 4; ++kt) {
    const s16x4 bh = *(const s16x4*)(cb + SC_BT + (16 * kt + c) * 48 + q * 8);
    const s16x4 kh = *(const s16x4*)(cb + SC_KT + (16 * kt + c) * 48 + q * 8);
    f32x4 s = MFMA16K(bh, bU, ST[kt]);
    s = MFMA16K(kh, vf, s); KEEP4(bh); KEEP4(kh);
    const float4 cl = *(const float4*)(cb + SC_CL + (16 * kt + 4 * q) * 4);
    s[0] *= cl.x; s[1] *= cl.y; s[2] *= cl.z; s[3] *= cl.w;
    ST[kt] = s;
  }
  KEEP4(bU); KEEP4(vf);
}

DI void phase_scan(const Params& p, char* lds) {
  float* ybuf = (float*)(lds + SC_YBUF);
  const int tid = threadIdx.x, lane = tid & 63, wave = tid >> 6;
  const bool loader = tid >= 256;
  const int lt = tid & 255, ltk = lt >> 3, lch = (lt & 7) * 8;
  const int lcc = (wave >> 1) & 1, lchh = wave & 1, ltok = lane >> 2, loct = lane & 3, ch0 = lchh * 32 + loct * 8;
  const int vb = wave & 3, cc_ = lane & 15, qq = lane >> 4;
  constexpr int NG = NKEY / 32;
  for (int unit = blockIdx.x; unit < 256; unit += gridDim.x) {
    const int dir = unit & 1, h = (unit >> 1) & 15, b = unit >> 5;
    const bf16_t* Rp = p.S[0]; const bf16_t* Vp = p.S[1]; const bf16_t* Kp = p.S[2];
    bf16_t* Ap = dir ? p.S[4] : p.S[3];
    const bf16_t* Lp = dir ? p.S[5] : p.Hd;
    auto tok_of = [&](int i) -> int {
      if (i < 256) return NL + b * 256 + (dir ? 255 - i : i);
      const int s = i - 256;
      return b * 4096 + (dir ? 4095 - s : s);
    };
    uint4 rawA[5], rawB[5];
    float nrmA = 0.f, nrmB = 0.f;
    float rkk[8], kac[8];
    f32x4 ST[4];
#pragma unroll
    for (int i = 0; i < 4; ++i) ST[i] = f32x4{0.f, 0.f, 0.f, 0.f};
    if (loader) {
#pragma unroll
      for (int j = 0; j < 8; ++j) { rkk[j] = 1.f / p.k_k[h * 64 + ch0 + j]; kac[j] = p.k_a[h * 64 + ch0 + j]; }
    }
    auto issue = [&](int g, uint4 (&rw)[5], float& nv) {
      const int t = tok_of(g * 32 + lcc * 16 + ltok);
      const size_t off = HM(t, h * 64 + ch0);
      rw[0] = *(const uint4*)(Rp + off); rw[1] = *(const uint4*)(Vp + off); rw[2] = *(const uint4*)(Kp + off);
      rw[3] = *(const uint4*)(Ap + off); rw[4] = *(const uint4*)(Lp + off);
      nv = p.NRM[(size_t)h * NT + t];
    };
    auto process = [&](int stage, const uint4 (&raw)[5], const float nrmv) {
      float r8[8], kk8[8], a8[8], l8[8], L[8];
      unpack_bf8(raw[0], r8); unpack_bf8(raw[2], kk8); unpack_bf8(raw[3], a8); unpack_bf8(raw[4], l8);
#pragma unroll
      for (int j = 0; j < 8; ++j) L[j] = l8[j];
#pragma unroll
      for (int d = 4; d < 64; d <<= 1) {
#pragma unroll
        for (int j = 0; j < 8; ++j) { const float o = __shfl_up(L[j], d); if (lane >= d) L[j] += o; }
      }
      float okk[8], orr[8], ob[8], ok[8], cend[8];
#pragma unroll
      for (int j = 0; j < 8; ++j) {
        const float cc = __expf(L[j]), cprev = __expf(L[j] - l8[j]), cinv = __expf(-L[j]);
        const float k = kk8[j] * nrmv * rkk[j];
        const float kd = k * (1.f + (a8[j] - 1.f) * kac[j]);
        okk[j] = kk8[j] * cprev; orr[j] = r8[j] * cc; ob[j] = kk8[j] * a8[j] * cinv; ok[j] = kd * cinv; cend[j] = cc;
      }
      char* cb = lds + stage * SC_GROUP + lcc * SC_CHUNK;
      uint4 o;
      o = make_uint4(pack2(okk[0], okk[1]), pack2(okk[2], okk[3]), pack2(okk[4], okk[5]), pack2(okk[6], okk[7])); *(uint4*)(cb + SC_KK + ltok * 144 + ch0 * 2) = o;
      o = make_uint4(pack2(orr[0], orr[1]), pack2(orr[2], orr[3]), pack2(orr[4], orr[5]), pack2(orr[6], orr[7])); *(uint4*)(cb + SC_R + ltok * 144 + ch0 * 2) = o;
      const uint4 obp = make_uint4(pack2(ob[0], ob[1]), pack2(ob[2], ob[3]), pack2(ob[4], ob[5]), pack2(ob[6], ob[7])); *(uint4*)(cb + SC_B + ltok * 144 + ch0 * 2) = obp;
      const uint4 okp = make_uint4(pack2(ok[0], ok[1]), pack2(ok[2], ok[3]), pack2(ok[4], ok[5]), pack2(ok[6], ok[7])); *(uint4*)(cb + SC_K + ltok * 144 + ch0 * 2) = okp;
      const unsigned bw[4] = {obp.x, obp.y, obp.z, obp.w}, kw[4] = {okp.x, okp.y, okp.z, okp.w}, vw[4] = {raw[1].x, raw[1].y, raw[1].z, raw[1].w};
#pragma unroll
      for (int j = 0; j < 8; ++j) {
        const int sh = (j & 1) * 16;
        *(bf16_t*)(cb + SC_BT + (ch0 + j) * 48 + ltok * 2) = (bf16_t)((bw[j >> 1] >> sh) & 0xffffu);
        *(bf16_t*)(cb + SC_KT + (ch0 + j) * 48 + ltok * 2) = (bf16_t)((kw[j >> 1] >> sh) & 0xffffu);
        *(bf16_t*)(cb + SC_VT + (ch0 + j) * 48 + ltok * 2) = (bf16_t)((vw[j >> 1] >> sh) & 0xffffu);
      }
      if (ltok == 15) {
        *(float4*)(cb + SC_CL + ch0 * 4) = make_float4(cend[0], cend[1], cend[2], cend[3]);
        *(float4*)(cb + SC_CL + ch0 * 4 + 16) = make_float4(cend[4], cend[5], cend[6], cend[7]);
      }
    };
    auto yout = [&](int g) {
      const float* yb = ybuf + (g & 1) * 2048 + ltk * 64 + lch;
      const float4 y0 = *(const float4*)yb, y1 = *(const float4*)(yb + 4);
      const int t = tok_of(g * 32 + ltk);
      uint4 o;
      o.x = pack2(y0.x, y0.y); o.y = pack2(y0.z, y0.w); o.z = pack2(y1.x, y1.y); o.w = pack2(y1.z, y1.w);
      *(uint4*)(Ap + HM(t, h * 64 + lch)) = o;
    };
    __syncthreads();
    if (loader) { issue(0, rawA, nrmA); issue(1, rawB, nrmB); process(0, rawA, nrmA); issue(2, rawA, nrmA); }
    __syncthreads();
    for (int g = 0; g < NG; g += 2) {
      if (loader) {
        if (g >= 1) yout(g - 1);
        if (g + 1 < NG) { process(1, rawB, nrmB); if (g + 3 < NG) issue(g + 3, rawB, nrmB); }
      } else {
        const char* gb = lds;
        float* yb = ybuf;
        scan_chunk(gb, yb, ST, vb, cc_, qq);
        scan_chunk(gb + SC_CHUNK, yb + 16 * 64, ST, vb, cc_, qq);
      }
      __syncthreads();
      if (g + 1 < NG) {
        if (loader) {
          yout(g);
          if (g + 2 < NG) { process(0, rawA, nrmA); if (g + 4 < NG) issue(g + 4, rawA, nrmA); }
        } else {
          const char* gb = lds + SC_GROUP;
          float* yb = ybuf + 2048;
          scan_chunk(gb, yb, ST, vb, cc_, qq);
          scan_chunk(gb + SC_CHUNK, yb + 16 * 64, ST, vb, cc_, qq);
        }
        __syncthreads();
      }
    }
    if (loader) yout(NG - 1);
    __syncthreads();
  }
}

DI void phase_readout(const Params& p, char* lds) {
  const int lane = threadIdx.x & 63, wave = threadIdx.x >> 6;
  const int wt = wave & 3, wf = wave >> 2, lr = lane & 15, lq = lane >> 4;
  const int total = (NT / 256) * 8;
  for (int u = blockIdx.x; u < total; u += gridDim.x) {
    const int mt = u >> 3, nt = u & 7;
    const int tok0 = mt * 256, f0 = nt * 128;
    f32x4 g[4][4];
    gemm_tile<false>(p.L1, 384, p.g2T, 128, 128, tok0, f0, lds, g, nullptr);
    const int head = nt * 2 + wf;
#pragma unroll
    for (int ti = 0; ti < 4; ++ti) {
      const int t = tok0 + wt * 64 + ti * 16 + lr;
      float y[2][8];
      float sum = 0.f;
#pragma unroll
      for (int pp = 0; pp < 2; ++pp) {
        const int f = f0 + wf * 64 + pp * 32 + lq * 8;
        float ya[8], yb[8];
        unpack_bf8(*(const uint4*)(p.S[3] + HM(t, f)), ya);
        unpack_bf8(*(const uint4*)(p.S[4] + HM(t, f)), yb);
#pragma unroll
        for (int e2 = 0; e2 < 8; ++e2) { y[pp][e2] = ya[e2] + yb[e2]; sum += y[pp][e2]; }
      }
      sum += __shfl_xor(sum, 16); sum += __shfl_xor(sum, 32);
      const float mean = sum * (1.f / 64.f);
      float vs = 0.f;
#pragma unroll
      for (int pp = 0; pp < 2; ++pp)
#pragma unroll
        for (int e2 = 0; e2 < 8; ++e2) { const float d = y[pp][e2] - mean; vs += d * d; }
      vs += __shfl_xor(vs, 16); vs += __shfl_xor(vs, 32);
      const float rstd = rsqrtf(vs * (1.f / 64.f) + 64e-5f);
      const float bon = p.BON[(size_t)head * NT + t];
#pragma unroll
      for (int pp = 0; pp < 2; ++pp) {
        const int f = f0 + wf * 64 + pp * 32 + lq * 8;
        const float4 lwl = *(const float4*)(p.ln_w + f), lwh = *(const float4*)(p.ln_w + f + 4);
        const float4 lbl = *(const float4*)(p.ln_b + f), lbh = *(const float4*)(p.ln_b + f + 4);
        const float lw8[8] = {lwl.x, lwl.y, lwl.z, lwl.w, lwh.x, lwh.y, lwh.z, lwh.w};
        const float lb8[8] = {lbl.x, lbl.y, lbl.z, lbl.w, lbh.x, lbh.y, lbh.z, lbh.w};
        float v8[8];
        unpack_bf8(*(const uint4*)(p.S[1] + HM(t, f)), v8);
        f32x4 oa, ob;
#pragma unroll
        for (int j = 0; j < 4; ++j) {
          oa[j] = ((y[pp][j] - mean) * rstd * lw8[j] + lb8[j] + bon * v8[j]) * g[2 * pp][ti][j];
          ob[j] = ((y[pp][4 + j] - mean) * rstd * lw8[4 + j] + lb8[4 + j] + bon * v8[4 + j]) * g[2 * pp + 1][ti][j];
        }
        store_bf8(p.S[0] + (size_t)t * 1024 + f, oa, ob);
      }
    }
  }
}

DI void phase_gemm_resid(const Params& p, char* lds, const bf16_t* A, const bf16_t* W, int K, int ntm,
                                 const float* xin_l, const float* xin_c, const float* gate) {
  const int lane = threadIdx.x & 63, wave = threadIdx.x >> 6;
  const int wr = wave >> 2, wc = wave & 3;
  const int total = ntm * 4;
  for (int u = blockIdx.x; u < total; u += gridDim.x) {
    int mt, nt; tile_map(u, total, ntm, 4, mt, nt);
    f32x4 acc[2][2][4][2];
    gemm256_tile<true>(W, A, K, nt * 256, mt * 256, lds, acc);
    int lane_o = threadIdx.x & 63; asm volatile("" : "+v"(lane_o));
    const int fr = lane_o & 15, fq = lane_o >> 4;
#pragma unroll
    for (int bj = 0; bj < 2; ++bj)
#pragma unroll
      for (int n = 0; n < 2; ++n) {
        const int t = mt * 256 + bj * 128 + wc * 32 + n * 16 + fr;
        const int bp = t < NL ? (t >> 12) : 8;
        const float* xi = t < NL ? xin_l + (size_t)t * 1024 : xin_c + (size_t)(t - NL) * 1024;
        float* xo = t < NL ? p.out + (size_t)t * 1024 : p.XC + (size_t)(t - NL) * 1024;
#pragma unroll
        for (int ai = 0; ai < 2; ++ai)
#pragma unroll
          for (int mp = 0; mp < 2; ++mp) {
            const int f = nt * 256 + ai * 128 + wr * 64 + mp * 32 + fq * 8;
            const float4 g0 = *(const float4*)(gate + bp * 6144 + f), g1 = *(const float4*)(gate + bp * 6144 + f + 4);
            const float4 x0 = *(const float4*)(xi + f), x1 = *(const float4*)(xi + f + 4);
            const f32x4 a = acc[ai][bj][2 * mp][n], b = acc[ai][bj][2 * mp + 1][n];
            *(float4*)(xo + f) = make_float4(x0.x + g0.x * a[0], x0.y + g0.y * a[1], x0.z + g0.z * a[2], x0.w + g0.w * a[3]);
            *(float4*)(xo + f + 4) = make_float4(x1.x + g1.x * b[0], x1.y + g1.y * b[1], x1.z + g1.z * b[2], x1.w + g1.w * b[3]);
          }
      }
  }
}

DI void phase_up(const Params& p, char* lds, const bf16_t* H, const bf16_t* W, bf16_t* U, int ntm) {
  const int lane = threadIdx.x & 63, wave = threadIdx.x >> 6;
  const int wr = wave >> 2, wc = wave & 3;
  const int total = ntm * 16;
  for (int u = blockIdx.x; u < total; u += gridDim.x) {
    int mt, nt; tile_map(u, total, ntm, 16, mt, nt);
    f32x4 acc[2][2][4][2];
    gemm256_tile<true>(W, H, 1024, nt * 256, mt * 256, lds, acc);
    int lane_o = threadIdx.x & 63; asm volatile("" : "+v"(lane_o));
    const int fr = lane_o & 15, fq = lane_o >> 4;
#pragma unroll
    for (int bj = 0; bj < 2; ++bj)
#pragma unroll
      for (int n = 0; n < 2; ++n) {
        const int t = mt * 256 + bj * 128 + wc * 32 + n * 16 + fr;
#pragma unroll
        for (int ai = 0; ai < 2; ++ai)
#pragma unroll
          for (int mp = 0; mp < 2; ++mp) {
            const int f = nt * 256 + ai * 128 + wr * 64 + mp * 32 + fq * 8;
            f32x4 a = acc[ai][bj][2 * mp][n], b = acc[ai][bj][2 * mp + 1][n];
#pragma unroll
            for (int j = 0; j < 4; ++j) { const float ra = fmaxf(a[j], 0.f), rb = fmaxf(b[j], 0.f); a[j] = ra * ra; b[j] = rb * rb; }
            store_bf8(U + (size_t)t * 4096 + f, a, b);
          }
      }
  }
}

DI void phase_qkv(const Params& p, char* lds) {
  const int lane = threadIdx.x & 63, wave = threadIdx.x >> 6;
  const int wr = wave >> 2, wc = wave & 3;
  const int total = (NT / 256) * 6;
  bf16_t* Q = p.S[0]; bf16_t* KA = p.S[1]; bf16_t* VT = p.S[2];
  for (int u = blockIdx.x; u < total; u += gridDim.x) {
    int mt, nt; tile_map(u, total, NT / 256, 6, mt, nt);
    if (mt >= NL / 256 && nt < 4) continue;
    f32x4 acc[2][2][4][2];
    gemm256_tile<false>(p.wqkvT, p.S[5], 1024, nt * 256, mt * 256, lds, acc);
    int lane_o = threadIdx.x & 63; asm volatile("" : "+v"(lane_o));
    const int fr = lane_o & 15, fq = lane_o >> 4;
#pragma unroll
    for (int bj = 0; bj < 2; ++bj)
#pragma unroll
      for (int n = 0; n < 2; ++n) {
        const int t = mt * 256 + bj * 128 + wc * 32 + n * 16 + fr;
        const bool lat = t < NL;
        const int b = lat ? (t >> 12) : ((t - NL) >> 8);
        const int key = lat ? (t & 4095) : 4096 + ((t - NL) & 255);
#pragma unroll
        for (int ai = 0; ai < 2; ++ai) {
          const int hh = ai * 2 + wr;
          asm volatile("" ::: "memory");
          if (nt < 5) {
            float ss = 0.f;
#pragma unroll
            for (int m = 0; m < 4; ++m)
#pragma unroll
              for (int j = 0; j < 4; ++j) ss += acc[ai][bj][m][n][j] * acc[ai][bj][m][n][j];
            ss += __shfl_xor(ss, 16); ss += __shfl_xor(ss, 32);
            const float rstd = rsqrtf(ss * (1.f / 64.f) + 1e-6f);
            const float* gn = nt < 4 ? p.q_norm : p.k_norm;
            float v[4][4];
#pragma unroll
            for (int m = 0; m < 4; ++m) {
              const float4 g4 = *(const float4*)(gn + m * 16 + fq * 4);
              v[m][0] = acc[ai][bj][m][n][0] * rstd * g4.x; v[m][1] = acc[ai][bj][m][n][1] * rstd * g4.y;
              v[m][2] = acc[ai][bj][m][n][2] * rstd * g4.z; v[m][3] = acc[ai][bj][m][n][3] * rstd * g4.w;
            }
            if (lat) {
              const int s = t & 4095, rowp = s >> 6, colp = s & 63;
#pragma unroll
              for (int j = 0; j < 4; ++j) {
                const float2 cs0 = *(const float2*)(p.TAB + (rowp * 16 + fq * 4 + j) * 2);
                const float2 cs1 = *(const float2*)(p.TAB + (colp * 16 + fq * 4 + j) * 2);
                const float x1 = v[0][j], x2 = v[1][j], z1 = v[2][j], z2 = v[3][j];
                v[0][j] = x1 * cs0.x - x2 * cs0.y; v[1][j] = x2 * cs0.x + x1 * cs0.y;
                v[2][j] = z1 * cs1.x - z2 * cs1.y; v[3][j] = z2 * cs1.x + z1 * cs1.y;
              }
            }
            if (nt < 4) {
              const float qs = 0.125f * 1.4426950408889634f;
              const int head = nt * 4 + hh;
#pragma unroll
              for (int m = 0; m < 4; ++m)
                store_bf4(Q + (size_t)t * 1024 + head * 64 + m * 16 + fq * 4, v[m][0] * qs, v[m][1] * qs, v[m][2] * qs, v[m][3] * qs);
            } else {
#pragma unroll
              for (int m = 0; m < 4; ++m)
                store_bf4(KA + ((size_t)(b * 4 + hh) * NKEY + key) * 64 + m * 16 + fq * 4, v[m][0], v[m][1], v[m][2], v[m][3]);
            }
          } else {
#pragma unroll
            for (int m = 0; m < 4; ++m)
#pragma unroll
              for (int j = 0; j < 4; ++j) {
                const int d = m * 16 + fq * 4 + j;
                const unsigned pk = pack2(acc[ai][bj][m][n][j], 0.f);
                VT[((size_t)(b * 4 + hh) * 64 + d) * NKEY + key] = (bf16_t)(pk & 0xffffu);
              }
          }
        }
      }
  }
}

DI void phase_attn(const Params& p, char* lds) {
  const int tid = threadIdx.x, lane = tid & 63, wave = tid >> 6;
  const int l31 = lane & 31, lh = lane >> 5;
  const int srow = tid >> 3, sch = tid & 7;
  const bf16_t* Q = p.S[0]; const bf16_t* KA = p.S[1]; const bf16_t* VT = p.S[2]; bf16_t* O = p.S[3];
  float gq = 0.f, gk = 0.f;
  for (int i = 0; i < 64; ++i) { gq = fmaxf(gq, fabsf(p.q_norm[i])); gk = fmaxf(gk, fabsf(p.k_norm[i])); }
  const float M2 = 8.f * gq * gk * 1.4426950408889634f;
  constexpr int NKT = NKEY / 64;
  constexpr int AST = 2 * 64 * ROWB;
  for (int u = blockIdx.x; u < 1024; u += gridDim.x) {
    const int qb = u & 7, head = (u >> 3) & 15, b = u >> 7, kvh = head >> 2;
    const bf16_t* Kg = KA + (size_t)(b * 4 + kvh) * NKEY * 64;
    const bf16_t* Vg = VT + (size_t)(b * 4 + kvh) * 64 * NKEY;
    const int tq0 = b * 4096 + qb * 512 + wave * 64 + l31;
    bf16x8 qf[2][4];
#pragma unroll
    for (int blk = 0; blk < 2; ++blk)
#pragma unroll
      for (int s = 0; s < 4; ++s) qf[blk][s] = *(const bf16x8*)(Q + (size_t)(tq0 + blk * 32) * 1024 + head * 64 + s * 16 + lh * 8);
    f32x16 o[2][2];
#pragma unroll
    for (int blk = 0; blk < 2; ++blk)
#pragma unroll
      for (int dt = 0; dt < 2; ++dt)
#pragma unroll
        for (int i = 0; i < 16; ++i) o[blk][dt][i] = 0.f;
    float lsum[2] = {0.f, 0.f};
    uint4 kreg, vreg;
    __syncthreads();
    for (int kt = -1; kt < NKT; ++kt) {
      const bool more = kt + 1 < NKT;
      if (more) {
        kreg = *(const uint4*)(Kg + (size_t)((kt + 1) * 64 + srow) * 64 + sch * 8);
        vreg = *(const uint4*)(Vg + (size_t)srow * NKEY + (kt + 1) * 64 + sch * 8);
      }
      if (kt >= 0) {
        const char* ksm = lds + (kt & 1) * AST;
        const char* vsm = ksm + 64 * ROWB;
        f32x16 sT[2][2];
#pragma unroll
        for (int blk = 0; blk < 2; ++blk)
#pragma unroll
          for (int k2 = 0; k2 < 2; ++k2)
#pragma unroll
            for (int i = 0; i < 16; ++i) sT[blk][k2][i] = -M2;
#pragma unroll
        for (int k2 = 0; k2 < 2; ++k2)
#pragma unroll
          for (int s = 0; s < 4; ++s) {
            const bf16x8 kf = *(const bf16x8*)(ksm + (k2 * 32 + l31) * ROWB + s * 32 + lh * 16);
            sT[0][k2] = MFMA32(kf, qf[0][s], sT[0][k2]);
            sT[1][k2] = MFMA32(kf, qf[1][s], sT[1][k2]);
          }
#pragma unroll
        for (int blk = 0; blk < 2; ++blk)
#pragma unroll
          for (int k2 = 0; k2 < 2; ++k2)
#pragma unroll
            for (int i = 0; i < 16; ++i) { const float pv = __builtin_amdgcn_exp2f(sT[blk][k2][i]); lsum[blk] += pv; sT[blk][k2][i] = pv; }
#pragma unroll
        for (int k2 = 0; k2 < 2; ++k2)
#pragma unroll
          for (int s2 = 0; s2 < 2; ++s2) {
            bf16x8 pf[2];
#pragma unroll
            for (int blk = 0; blk < 2; ++blk) {
              uint4 pk;
              pk.x = pack2(sT[blk][k2][8 * s2 + 0], sT[blk][k2][8 * s2 + 1]); pk.y = pack2(sT[blk][k2][8 * s2 + 2], sT[blk][k2][8 * s2 + 3]);
              pk.z = pack2(sT[blk][k2][8 * s2 + 4], sT[blk][k2][8 * s2 + 5]); pk.w = pack2(sT[blk][k2][8 * s2 + 6], sT[blk][k2][8 * s2 + 7]);
              pf[blk] = __builtin_bit_cast(bf16x8, pk);
            }
            const int koff = (k2 * 32 + 16 * s2 + 4 * lh) * 2;
#pragma unroll
            for (int dt = 0; dt < 2; ++dt) {
              const uint2 lo = *(const uint2*)(vsm + (dt * 32 + l31) * ROWB + koff), hi = *(const uint2*)(vsm + (dt * 32 + l31) * ROWB + koff + 16);
              const bf16x8 vv = __builtin_bit_cast(bf16x8, make_uint4(lo.x, lo.y, hi.x, hi.y));
              o[0][dt] = MFMA32(vv, pf[0], o[0][dt]);
              o[1][dt] = MFMA32(vv, pf[1], o[1][dt]);
            }
          }
      }
      if (more) {
        const int st = (kt + 1) & 1;
        *(uint4*)(lds + st * AST + srow * ROWB + sch * 16) = kreg;
        *(uint4*)(lds + st * AST + 64 * ROWB + srow * ROWB + sch * 16) = vreg;
      }
      __syncthreads();
    }
#pragma unroll
    for (int blk = 0; blk < 2; ++blk) {
      float ls = lsum[blk];
      ls += __shfl_xor(ls, 32);
      const float inv = 1.f / ls;
      const int tq = tq0 + blk * 32;
#pragma unroll
      for (int g = 0; g < 4; ++g) {
        const int d0 = 8 * g + 4 * lh;
        store_bf4(O + (size_t)tq * 1024 + head * 64 + d0, o[blk][0][4 * g] * inv, o[blk][0][4 * g + 1] * inv, o[blk][0][4 * g + 2] * inv, o[blk][0][4 * g + 3] * inv);
        store_bf4(O + (size_t)tq * 1024 + head * 64 + 32 + d0, o[blk][1][4 * g] * inv, o[blk][1][4 * g + 1] * inv, o[blk][1][4 * g + 2] * inv, o[blk][1][4 * g + 3] * inv);
      }
    }
  }
}

#define XB_TMO      128
#define XB_XCNT(j)  (256  + 64 * (j))
#define XB_XSUB(j)  (1280 + 64 * (j))
#define XB_XGEN(j)  (2304 + 64 * (j))
#define XB_TOP      3328
#define XB_TOPGEN   3392
#define XCD_BAR_WORDS 3456
#define XB_SPIN_CAP (1u << 18)
#define LAS __attribute__((address_space(3)))

__device__ __forceinline__ unsigned xb_ld(unsigned* p)              { return __hip_atomic_load(p, __ATOMIC_RELAXED, __HIP_MEMORY_SCOPE_AGENT); }
__device__ __forceinline__ unsigned xb_add(unsigned* p, unsigned v) { return __hip_atomic_fetch_add(p, v, __ATOMIC_RELAXED, __HIP_MEMORY_SCOPE_AGENT); }
__device__ __forceinline__ unsigned xb_xcc_id() { return (unsigned)__builtin_amdgcn_s_getreg((3 << 11) | 20) & 0xFu; }
#define XB_SPIN(cond, bar) do { unsigned _sp = 0; while (cond) { __builtin_amdgcn_s_sleep(1); \
    if ((++_sp & 255u) == 0u) { if (xb_ld(&(bar)[XB_TMO])) break; if (_sp > XB_SPIN_CAP) { atomicAdd(&(bar)[XB_TMO], 1u); break; } } } } while (0)

struct XcdBarrier {
    unsigned* bar; unsigned x;
    volatile LAS unsigned* st;
};

__device__ __forceinline__ XcdBarrier xcd_barrier_post(unsigned* bar, volatile LAS unsigned* st) {
    XcdBarrier b; b.bar = bar; b.x = xb_xcc_id(); b.st = st;
    if (threadIdx.x == 0) (void)xb_add(&bar[XB_XCNT(b.x)], 1u);
    return b;
}
__device__ __forceinline__ void xcd_barrier_complete(unsigned* bar, unsigned x, unsigned& nloc, unsigned& nx) {
    const unsigned G = gridDim.x * gridDim.y * gridDim.z;
    unsigned sum, cnt, mine, sp = 0u;
    for (;;) {
        sum = 0u; cnt = 0u; mine = 0u;
#pragma unroll
        for (unsigned j = 0; j < 16; ++j) { const unsigned c = xb_ld(&bar[XB_XCNT(j)]); sum += c; cnt += (c > 0u) ? 1u : 0u; mine = (j == x) ? c : mine; }
        if (sum == G) break;
        __builtin_amdgcn_s_sleep(1);
        if ((++sp & 255u) == 0u) { if (xb_ld(&bar[XB_TMO])) break; if (sp > XB_SPIN_CAP) { atomicAdd(&bar[XB_TMO], 1u); break; } }
    }
    nloc = mine > 0u ? mine : 1u; nx = cnt > 0u ? cnt : 1u;
}

__device__ __forceinline__ void xcd_barrier(const XcdBarrier& b) {
    asm volatile("s_waitcnt vmcnt(0)" ::: "memory");
    __syncthreads();
    if (threadIdx.x == 0) {
        unsigned* bar = b.bar;
        __builtin_amdgcn_s_waitcnt(0);
        unsigned nloc = b.st[0], nx = b.st[1];
        if (nloc == 0u) { xcd_barrier_complete(bar, b.x, nloc, nx); b.st[0] = nloc; b.st[1] = nx; }
        const unsigned old = xb_add(&bar[XB_XSUB(b.x)], 1u);
        const unsigned gen = old / nloc;
        if (old + 1u == (gen + 1u) * nloc) {
            __builtin_amdgcn_fence(__ATOMIC_RELEASE, "agent");
            asm volatile("s_waitcnt vmcnt(0)" ::: "memory");
            const unsigned og = xb_add(&bar[XB_TOP], 1u);
            const unsigned tg = og / nx;
            if (og + 1u == (tg + 1u) * nx) xb_add(&bar[XB_TOPGEN], 1u);
            else XB_SPIN(xb_ld(&bar[XB_TOPGEN]) == tg, bar);
            __builtin_amdgcn_fence(__ATOMIC_ACQUIRE, "agent");
            xb_add(&bar[XB_XGEN(b.x)], 1u);
            asm volatile("s_waitcnt vmcnt(0)" ::: "memory");
        } else {
            XB_SPIN(xb_ld(&bar[XB_XGEN(b.x)]) == gen, bar);
            __builtin_amdgcn_fence(__ATOMIC_ACQUIRE, "agent");
            asm volatile("s_waitcnt vmcnt(0)" ::: "memory");
        }
    }
    __syncthreads();
}


DI void run_phase(const Params& p, int ph, char* lds) {
  const float* mod0 = p.MOD;
  const float* mod1 = p.MOD + 9 * 6144;
  switch (ph) {
    case 0: phase0(p, lds); break;
    case 1: norm_mod_phase(p.x, p.ctx, p.norm_mix, mod0, 0, 1, p.Hd, NT); break;
    case 2: phase_proj(p, lds); break;
    case 20: phase_mix(p); break;
    case 3: phase_prep(p, lds); break;
    case 4: phase_scan(p, lds); break;
    case 5: phase_readout(p, lds); break;
    case 6: phase_gemm_resid(p, lds, p.S[0], p.woT, 1024, NT / 256, p.x, p.ctx, mod0 + 2 * 1024); break;
    case 7: norm_mod_phase(p.out, p.XC, p.norm_mlp, mod0, 3, 4, p.S[5], NT); break;
    case 8: phase_up(p, lds, p.S[5], p.w1T[0], p.S[0], NT / 256); break;
    case 9: phase_gemm_resid(p, lds, p.S[0], p.w2T[0], 4096, NT / 256, p.out, p.XC, mod0 + 5 * 1024); break;
    case 10: norm_mod_phase(p.out, p.XC, p.norm_mix + 1024, mod1, 0, 1, p.S[5], NT); break;
    case 11: phase_qkv(p, lds); break;
    case 12: phase_attn(p, lds); break;
    case 13: phase_gemm_resid(p, lds, p.S[3], p.awoT, 1024, NL / 256, p.out, p.XC, mod1 + 2 * 1024); break;
    case 14: norm_mod_phase(p.out, p.XC, p.norm_mlp + 1024, mod1, 3, 4, p.S[5], NL); break;
    case 15: phase_up(p, lds, p.S[5], p.w1T[1], p.S[0], NL / 256); break;
    case 16: phase_gemm_resid(p, lds, p.S[0], p.w2T[1], 4096, NL / 256, p.out, p.XC, mod1 + 5 * 1024); break;
    case 17: final_norm_phase(p); break;
  }
}
constexpr int NPHASE = 18;

__global__ void __launch_bounds__(NTHREADS) mega_kernel(Params p) {
  extern __shared__ __attribute__((aligned(16))) char lds[];
  cg::grid_group grid = cg::this_grid();
  volatile LAS unsigned* st = (volatile LAS unsigned*)(LAS char*)(lds + 131072);
  if (threadIdx.x == 0) { st[0] = 0u; st[1] = 0u; }
  if (blockIdx.x == 0) for (int i = threadIdx.x; i < XCD_BAR_WORDS; i += NTHREADS) p.BAR[i] = 0u;
  __syncthreads();
  run_phase(p, 0, lds);
  grid.sync();
  const XcdBarrier xb = xcd_barrier_post(p.BAR, st);
#define PH(n) run_phase(p, n, lds); xcd_barrier(xb);
  PH(1) PH(20) PH(2) PH(3) PH(4) PH(5) PH(6) PH(7) PH(8) PH(9) PH(10) PH(11) PH(12) PH(13) PH(14) PH(15) PH(16)
  run_phase(p, 17, lds);
}

extern "C" void kernel_launch(void* const* d_in, const int* in_sizes, int n_in, void* d_out, int out_size, void* d_ws, size_t ws_size, hipStream_t stream) {
  Params p;
  memset(&p, 0, sizeof(p));
  const float* const* in = (const float* const*)d_in;
  p.x = in[0]; p.c = in[1]; p.ctx = in[2]; p.c_ctx = in[3]; p.w_mod = in[4]; p.b_mod = in[5]; p.norm_mix = in[6]; p.norm_mlp = in[7];
  p.mlp_w1 = in[8]; p.mlp_w2 = in[9]; p.mu = in[10]; p.wr = in[11]; p.wk = in[12]; p.wv = in[13]; p.wo = in[14]; p.w0 = in[15]; p.w1 = in[16];
  p.w2 = in[17]; p.a0 = in[18]; p.a1 = in[19]; p.a2 = in[20]; p.g1 = in[21]; p.g2 = in[22]; p.k_k = in[23]; p.k_a = in[24]; p.r_k = in[25];
  p.ln_w = in[26]; p.ln_b = in[27]; p.wqkv = in[28]; p.q_norm = in[29]; p.k_norm = in[30]; p.awo = in[31]; p.final_norm = in[32];
  p.out = (float*)d_out;
  char* ws = (char*)d_ws;
  size_t off = 0;
  auto take = [&](size_t bytes) -> char* { char* r = ws + off; off += (bytes + 255) & ~(size_t)255; return r; };
  p.Wcat = (bf16_t*)take((size_t)3456 * 1024 * 2);
  p.L2w = (bf16_t*)take((size_t)4 * 65536 * 2);
  p.g2T = (bf16_t*)take((size_t)1024 * 128 * 2);
  p.woT = (bf16_t*)take((size_t)1024 * 1024 * 2);
  p.w1T[0] = (bf16_t*)take((size_t)4096 * 1024 * 2);
  p.w1T[1] = (bf16_t*)take((size_t)4096 * 1024 * 2);
  p.w2T[0] = (bf16_t*)take((size_t)4096 * 1024 * 2);
  p.w2T[1] = (bf16_t*)take((size_t)4096 * 1024 * 2);
  p.wqkvT = (bf16_t*)take((size_t)1536 * 1024 * 2);
  p.awoT = (bf16_t*)take((size_t)1024 * 1024 * 2);
  p.MOD = (float*)take((size_t)2 * 9 * 6144 * 4);
  p.TAB = (float*)take((size_t)1024 * 2 * 4);
  p.XC = (float*)take((size_t)NC * 1024 * 4);
  p.BAR = (unsigned*)take((size_t)XCD_BAR_WORDS * 4);
  for (int i = 0; i < 6; ++i) p.S[i] = (bf16_t*)take((size_t)NT * 1024 * 2);
  if (off > ws_size) { fprintf(stderr, "kernel_launch: workspace too small (%zu needed, %zu given)\n", off, ws_size); return; }
  char* ob = (char*)d_out;
  p.Hd = (bf16_t*)ob;
  p.L1 = (bf16_t*)(ob + (size_t)NT * 1024 * 2);
  p.BON = (float*)(ob + (size_t)NT * 1024 * 2 + (size_t)NT * 384 * 2);
  p.NRM = (float*)(ob + (size_t)NT * 1024 * 2 + (size_t)NT * 384 * 2 + (size_t)NT * 16 * 4);
  int nj = 0, tiles = 0;
  auto job = [&](const float* src, bf16_t* dst, int K, int N) {
    p.jobs[nj].src = src; p.jobs[nj].dst = dst; p.jobs[nj].K = K; p.jobs[nj].N = N; p.jobs[nj].tstart = tiles; p.jobs[nj].tiles_n = N / 64;
    tiles += (K / 64) * (N / 64); ++nj;
  };
  job(p.wr, p.Wcat, 1024, 1024);
  job(p.wk, p.Wcat + (size_t)1024 * 1024, 1024, 1024);
  job(p.wv, p.Wcat + (size_t)2048 * 1024, 1024, 1024);
  job(p.g1, p.Wcat + (size_t)3072 * 1024, 1024, 128);
  job(p.w1, p.Wcat + (size_t)3200 * 1024, 1024, 64);
  job(p.w1 + 65536, p.Wcat + (size_t)3264 * 1024, 1024, 64);
  job(p.a1, p.Wcat + (size_t)3328 * 1024, 1024, 64);
  job(p.a1 + 65536, p.Wcat + (size_t)3392 * 1024, 1024, 64);
  job(p.a2, p.L2w, 64, 1024);
  job(p.a2 + 65536, p.L2w + 65536, 64, 1024);
  job(p.w2, p.L2w + 2 * 65536, 64, 1024);
  job(p.w2 + 65536, p.L2w + 3 * 65536, 64, 1024);
  job(p.g2, p.g2T, 128, 1024);
  job(p.wo, p.woT, 1024, 1024);
  job(p.mlp_w1, p.w1T[0], 1024, 4096);
  job(p.mlp_w1 + (size_t)4096 * 1024, p.w1T[1], 1024, 4096);
  job(p.mlp_w2, p.w2T[0], 4096, 1024);
  job(p.mlp_w2 + (size_t)4096 * 1024, p.w2T[1], 4096, 1024);
  job(p.wqkv, p.wqkvT, 1024, 1536);
  job(p.awo, p.awoT, 1024, 1024);
  p.njobs = nj; p.total_tiles = tiles;

  static int grid_blocks = 0;
  if (!grid_blocks) {
    (void)hipFuncSetAttribute((const void*)mega_kernel, hipFuncAttributeMaxDynamicSharedMemorySize, LDS_BYTES);
    int dev = 0, cus = 0, per_cu = 0;
    (void)hipGetDevice(&dev);
    (void)hipDeviceGetAttribute(&cus, hipDeviceAttributeMultiprocessorCount, dev);
    if (hipOccupancyMaxActiveBlocksPerMultiprocessor(&per_cu, (const void*)mega_kernel, NTHREADS, LDS_BYTES) != hipSuccess || per_cu < 1) per_cu = 1;
    if (cus <= 0) cus = 256;
    grid_blocks = cus * per_cu;
    (void)hipGetLastError();
  }
  void* args[] = {&p};
  hipError_t e = hipLaunchCooperativeKernel((const void*)mega_kernel, dim3(grid_blocks), dim3(NTHREADS), args, LDS_BYTES, stream);
  if (e != hipSuccess) fprintf(stderr, "cooperative launch failed: %s (grid %d)\n", hipGetErrorString(e), grid_blocks);
}
```

```cpp
#include <hip/hip_runtime.h>
#include <hip/hip_cooperative_groups.h>
#include <cstdint>
#include <cstring>
#include <cstdio>
namespace cg = cooperative_groups;

typedef unsigned short bf16_t;
typedef short bf16x8 __attribute__((ext_vector_type(8)));
typedef float f32x2 __attribute__((ext_vector_type(2)));
typedef float f32x4 __attribute__((ext_vector_type(4)));
typedef float f32x16 __attribute__((ext_vector_type(16)));
typedef __bf16 bf16x2_t __attribute__((ext_vector_type(2)));
#define DI __device__ __forceinline__

constexpr int D = 1024, NB = 8, SEQ = 4096, CTXL = 256;
constexpr int NL = NB * SEQ, NC = NB * CTXL, NT = NL + NC, DFF = 4096;
constexpr int NKEY = SEQ + CTXL;
constexpr int NTHREADS = 512;
constexpr int ROWB = 144;
constexpr int GEMM_STAGE = (256 + 128) * ROWB;
constexpr int LDS_BYTES = 131072 + 16;

struct TJob { const float* src; bf16_t* dst; int K, N, tstart, tiles_n; };

struct Params {
  const float *x, *c, *ctx, *c_ctx, *w_mod, *b_mod, *norm_mix, *norm_mlp, *mlp_w1, *mlp_w2;
  const float *mu, *wr, *wk, *wv, *wo, *w0, *w1, *w2, *a0, *a1, *a2, *g1, *g2, *k_k, *k_a, *r_k, *ln_w, *ln_b;
  const float *wqkv, *q_norm, *k_norm, *awo, *final_norm;
  float* out;
  bf16_t *Wcat, *L2w, *g2T, *woT, *w1T[2], *w2T[2], *wqkvT, *awoT;
  float *MOD, *TAB, *XC;
  bf16_t* S[6];
  bf16_t *Hd, *L1;
  float* BON;
  float* NRM;
  unsigned* BAR;
  TJob jobs[20];
  int njobs, total_tiles;
};

DI size_t HM(int t, int f) { return ((size_t)(f >> 6) * NT + t) * 64 + (f & 63); }
DI unsigned pack2(float lo, float hi) {
  f32x2 v = {lo, hi};
  bf16x2_t b = __builtin_convertvector(v, bf16x2_t);
  return __builtin_bit_cast(unsigned, b);
}
DI float bflo(unsigned u) { return __uint_as_float(u << 16); }
DI float bfhi(unsigned u) { return __uint_as_float(u & 0xffff0000u); }
DI void store_bf4(bf16_t* p, float a, float b, float c, float d) { *(uint2*)p = make_uint2(pack2(a, b), pack2(c, d)); }
DI void load_bf4(const bf16_t* p, float& a, float& b, float& c, float& d) { uint2 u = *(const uint2*)p; a = bflo(u.x); b = bfhi(u.x); c = bflo(u.y); d = bfhi(u.y); }
DI void store_bf8(bf16_t* p, const f32x4& a, const f32x4& b) {
  uint4 o; o.x = pack2(a[0], a[1]); o.y = pack2(a[2], a[3]); o.z = pack2(b[0], b[1]); o.w = pack2(b[2], b[3]);
  *(uint4*)p = o;
}
DI void store16_sc1(void* p, const uint4& v) {
  typedef unsigned u32x4_t __attribute__((ext_vector_type(4)));
  const u32x4_t d = {v.x, v.y, v.z, v.w};
  asm volatile("global_store_dwordx4 %0, %1, off sc1" :: "v"(p), "v"(d) : "memory");
}
DI void unpack_bf8(const uint4& u, float (&o)[8]) {
  o[0] = bflo(u.x); o[1] = bfhi(u.x); o[2] = bflo(u.y); o[3] = bfhi(u.y); o[4] = bflo(u.z); o[5] = bfhi(u.z); o[6] = bflo(u.w); o[7] = bfhi(u.w);
}
DI int perm32(int rho) { return 8 * ((rho & 15) >> 2) + 4 * (rho >> 4) + (rho & 3); }
DI float sigmoidf_(float x) { return 1.f / (1.f + __expf(-x)); }
DI float tanhf_(float x) { return 1.f - 2.f / (1.f + __expf(2.f * x)); }
DI float wave_sum(float x) {
#pragma unroll
  for (int m = 1; m < 64; m <<= 1) x += __shfl_xor(x, m);
  return x;
}
#define MFMA16(a, b, c) __builtin_amdgcn_mfma_f32_16x16x32_bf16((a), (b), (c), 0, 0, 0)
#define MFMA32(a, b, c) __builtin_amdgcn_mfma_f32_32x32x16_bf16((a), (b), (c), 0, 0, 0)

DI unsigned lerp2(unsigned a, unsigned n, float ma, float mb) {
  const float h0 = bflo(a), h1 = bfhi(a), s0 = bflo(n), s1 = bfhi(n);
  return pack2(h0 + (s0 - h0) * ma, h1 + (s1 - h1) * mb);
}
template <bool LERP>
DI void gemm_tile(const bf16_t* __restrict__ X, int ldx, const bf16_t* __restrict__ W, int ldw, int K, int tok0, int f0,
                  char* lds, f32x4 (&acc)[4][4], const float* __restrict__ mu) {
  const int tid = threadIdx.x, lane = tid & 63, wave = tid >> 6;
  const int wt = wave & 3, wf = wave >> 2, lr = lane & 15, lq = lane >> 4;
  const int lrow = tid >> 3, kc = tid & 7;
#pragma unroll
  for (int i = 0; i < 4; ++i)
#pragma unroll
    for (int j = 0; j < 4; ++j) acc[i][j] = f32x4{0.f, 0.f, 0.f, 0.f};
  uint4 xr[4], wr[2], xn[4];
  float4 m0 = make_float4(0, 0, 0, 0), m1 = m0;
  const int nk = K >> 6;
  __syncthreads();
  for (int kt = -1; kt < nk; ++kt) {
    const bool more = kt + 1 < nk;
    if (more) {
      const int k0 = (kt + 1) << 6;
#pragma unroll
      for (int i = 0; i < 4; ++i) {
        const int tg = tok0 + lrow + 64 * i;
        xr[i] = *(const uint4*)(X + (size_t)tg * ldx + k0 + kc * 8);
        if (LERP) {
          int nb; bool valid;
          if (tok0 < NL) {
            const int s = tg & 4095, col = s & 63, rw = s >> 6, qd = k0 >> 8;
            if (qd == 0) { valid = col > 0; nb = tg - 1; }
            else if (qd == 1) { valid = col < 63; nb = tg + 1; }
            else if (qd == 2) { valid = rw > 0; nb = tg - 64; }
            else { valid = rw < 63; nb = tg + 64; }
          } else {
            const int s = (tg - NL) & 255;
            if (k0 < 512) { valid = s > 0; nb = tg - 1; }
            else { valid = s < 255; nb = tg + 1; }
          }
          if (valid) xn[i] = *(const uint4*)(X + (size_t)nb * ldx + k0 + kc * 8);
          else xn[i] = make_uint4(0, 0, 0, 0);
        }
      }
#pragma unroll
      for (int i = 0; i < 2; ++i) wr[i] = *(const uint4*)(W + (size_t)(f0 + 64 * i + (lrow & 32) + perm32(lrow & 31)) * ldw + k0 + kc * 8);
      if (LERP) { m0 = *(const float4*)(mu + k0 + kc * 8); m1 = *(const float4*)(mu + k0 + kc * 8 + 4); }
    }
    if (kt >= 0) {
      const char* xs = lds + (kt & 1) * GEMM_STAGE;
      const char* wsm = xs + 256 * ROWB;
#pragma unroll
      for (int ks = 0; ks < 2; ++ks) {
        bf16x8 wfr[4], xfr[4];
#pragma unroll
        for (int i = 0; i < 4; ++i) wfr[i] = *(const bf16x8*)(wsm + (wf * 64 + i * 16 + lr) * ROWB + ks * 64 + lq * 16);
#pragma unroll
        for (int i = 0; i < 4; ++i) xfr[i] = *(const bf16x8*)(xs + (wt * 64 + i * 16 + lr) * ROWB + ks * 64 + lq * 16);
#pragma unroll
        for (int fi = 0; fi < 4; ++fi)
#pragma unroll
          for (int ti = 0; ti < 4; ++ti) acc[fi][ti] = MFMA16(wfr[fi], xfr[ti], acc[fi][ti]);
      }
    }
    if (more) {
      char* xs = lds + ((kt + 1) & 1) * GEMM_STAGE;
      char* wsm = xs + 256 * ROWB;
#pragma unroll
      for (int i = 0; i < 4; ++i) {
        uint4 v = xr[i];
        if (LERP) {
          v.x = lerp2(xr[i].x, xn[i].x, m0.x, m0.y);
          v.y = lerp2(xr[i].y, xn[i].y, m0.z, m0.w);
          v.z = lerp2(xr[i].z, xn[i].z, m1.x, m1.y);
          v.w = lerp2(xr[i].w, xn[i].w, m1.z, m1.w);
        }
        *(uint4*)(xs + (lrow + 64 * i) * ROWB + kc * 16) = v;
      }
#pragma unroll
      for (int i = 0; i < 2; ++i) *(uint4*)(wsm + (lrow + 64 * i) * ROWB + kc * 16) = wr[i];
    }
    __syncthreads();
  }
}


namespace g256 {
constexpr int BK = 64, HALF = 128, HT = HALF * BK;
DI int lds_byte(int r, int c) { const int st = (r >> 4) * 2 + (c >> 5), rr = r & 15, cc = c & 31, ob = rr * 64 + cc * 2; return st * 1024 + (ob ^ (((ob >> 9) & 1) << 5)); }
DI void stage_rc(int b, int& R, int& C) { const int st = b / 1024, sb = b % 1024, swz = sb ^ (((sb >> 9) & 1) << 5); R = (st >> 1) * 16 + swz / 64; C = (st & 1) * 32 + (swz % 64) / 2; }
}
#define G_SA(b, h) (((b) * 2 + (h)) * 16384)
#define G_SB(b, h) ((4 + (b) * 2 + (h)) * 16384)
#define G_STAGEV(bufoff, gbase, vo) do { _Pragma("unroll") for (int _i = 0; _i < 2; ++_i) \
    __builtin_amdgcn_global_load_lds((const unsigned*)((const char*)(gbase) + (vo)[_i]), (__attribute__((address_space(3))) unsigned*)(lds + (bufoff) + ldsw + _i * 8192), 16, 0, 0); } while (0)
#define G_LDA(dst, b, h) do { _Pragma("unroll") for (int m = 0; m < 4; ++m) _Pragma("unroll") for (int k = 0; k < 2; ++k) \
    dst[m][k] = *(const __attribute__((address_space(3))) bf16x8*)(lds + G_SA(b, h) + aoff + m * 2048 + k * 1024); } while (0)
#define G_LDB(dst, b, h) do { _Pragma("unroll") for (int n = 0; n < 2; ++n) _Pragma("unroll") for (int k = 0; k < 2; ++k) \
    dst[n][k] = *(const __attribute__((address_space(3))) bf16x8*)(lds + G_SB(b, h) + boff + n * 2048 + k * 1024); } while (0)
#define G_MMA(ai, bj, At, Bt) do { __builtin_amdgcn_s_setprio(1); \
    _Pragma("unroll") for (int m = 0; m < 4; ++m) _Pragma("unroll") for (int n = 0; n < 2; ++n) _Pragma("unroll") for (int k = 0; k < 2; ++k) \
      acc[ai][bj][m][n] = __builtin_amdgcn_mfma_f32_16x16x32_bf16(At[m][k], Bt[n][k], acc[ai][bj][m][n], 0, 0, 0); \
    __builtin_amdgcn_s_setprio(0); } while (0)
#define G_WAIT_V(n) asm volatile("s_waitcnt vmcnt(" #n ")" ::: "memory")
#define G_WAIT_L(n) asm volatile("s_waitcnt lgkmcnt(" #n ")" ::: "memory")
#define G_BAR __builtin_amdgcn_s_barrier()
#define G_SCHED __builtin_amdgcn_sched_barrier(0)

template <bool PERM>
DI void gemm256_tile(const bf16_t* __restrict__ A, const bf16_t* __restrict__ Bt, int K, int brow, int bcol, char* lds_, f32x4 (&acc)[2][2][4][2]) {
  __attribute__((address_space(3))) unsigned char* lds = (__attribute__((address_space(3))) unsigned char*)lds_;
  int tid = threadIdx.x; asm volatile("" : "+v"(tid));
  const int wid = __builtin_amdgcn_readfirstlane(tid >> 6), lane = tid & 63, wr = wid >> 2, wc = wid & 3, fr = lane & 15, fq = lane >> 4;
#pragma unroll
  for (int a = 0; a < 2; ++a)
#pragma unroll
    for (int b = 0; b < 2; ++b)
#pragma unroll
      for (int m = 0; m < 4; ++m)
#pragma unroll
        for (int n = 0; n < 2; ++n) acc[a][b][m][n] = f32x4{0.f, 0.f, 0.f, 0.f};
  unsigned voff[2], voffA[2];
#pragma unroll
  for (int i = 0; i < 2; ++i) { int R, C; g256::stage_rc(tid * 16 + i * 8192, R, C); voff[i] = (unsigned)(R * K + C) * 2u;
    const int Ra = PERM ? ((R & ~31) + perm32(R & 31)) : R; voffA[i] = (unsigned)(Ra * K + C) * 2u; }
  const size_t kstep = 128, hstep = (size_t)128 * K * 2;
  const unsigned ldsw = (unsigned)wid * 1024u;
  const int aoff = g256::lds_byte(wr * 64 + fr, fq * 8), boff = g256::lds_byte(wc * 32 + fr, fq * 8);
  const char* cA = (const char*)A + (size_t)brow * K * 2;
  const char* cB = (const char*)Bt + (size_t)bcol * K * 2;
  bf16x8 At[4][2], B0[2][2], B1[2][2];
  const int nt = K / g256::BK;
  __syncthreads();
  G_STAGEV(G_SB(0, 0), cB, voff); G_STAGEV(G_SA(0, 0), cA, voffA); G_STAGEV(G_SB(0, 1), cB + hstep, voff); G_STAGEV(G_SA(0, 1), cA + hstep, voffA);
  if (wr == 1) G_BAR;
  G_WAIT_V(4); G_BAR;
  G_STAGEV(G_SB(1, 0), cB + kstep, voff); G_STAGEV(G_SA(1, 0), cA + kstep, voffA); G_STAGEV(G_SB(1, 1), cB + hstep + kstep, voff);
  G_WAIT_V(6); G_BAR;
  for (int t = 0; t < nt - 2; t += 2) {
    const char* a1 = cA + (size_t)(t + 1) * kstep;
    const char* a2 = cA + (size_t)(t + 2) * kstep; const char* b2 = cB + (size_t)(t + 2) * kstep;
    const char* a3 = a2 + kstep; const char* b3 = b2 + kstep;
    G_LDB(B0, 0, 0); G_SCHED; G_LDA(At, 0, 0); G_STAGEV(G_SA(1, 1), a1 + hstep, voffA);
    G_WAIT_L(8); G_BAR; G_WAIT_L(0); G_MMA(0, 0, At, B0); G_BAR; G_SCHED;
    G_LDB(B1, 0, 1); G_STAGEV(G_SB(0, 0), b2, voff);
    G_BAR; G_WAIT_L(0); G_MMA(0, 1, At, B1); G_BAR;
    G_LDA(At, 0, 1); G_STAGEV(G_SA(0, 0), a2, voffA);
    G_BAR; G_WAIT_L(0); G_MMA(1, 0, At, B0); G_BAR; G_SCHED;
    G_STAGEV(G_SB(0, 1), b2 + hstep, voff);
    G_WAIT_V(6); G_BAR; G_MMA(1, 1, At, B1); G_BAR;
    G_LDB(B0, 1, 0); G_SCHED; G_LDA(At, 1, 0); G_STAGEV(G_SA(0, 1), a2 + hstep, voffA);
    G_WAIT_L(8); G_BAR; G_WAIT_L(0); G_MMA(0, 0, At, B0); G_BAR; G_SCHED;
    G_LDB(B1, 1, 1); G_STAGEV(G_SB(1, 0), b3, voff);
    G_BAR; G_WAIT_L(0); G_MMA(0, 1, At, B1); G_BAR;
    G_LDA(At, 1, 1); G_STAGEV(G_SA(1, 0), a3, voffA);
    G_BAR; G_WAIT_L(0); G_MMA(1, 0, At, B0); G_BAR; G_SCHED;
    G_STAGEV(G_SB(1, 1), b3 + hstep, voff);
    G_WAIT_V(6); G_BAR; G_MMA(1, 1, At, B1); G_BAR;
  }
  { G_LDB(B0, 0, 0); G_LDA(At, 0, 0); G_STAGEV(G_SA(1, 1), cA + (size_t)(nt - 1) * kstep + hstep, voffA);
    G_BAR; G_WAIT_L(0); G_MMA(0, 0, At, B0); G_BAR;
    G_LDB(B1, 0, 1); G_BAR; G_WAIT_L(0); G_MMA(0, 1, At, B1); G_BAR;
    G_LDA(At, 0, 1); G_WAIT_V(4); G_BAR; G_WAIT_L(0); G_MMA(1, 0, At, B0); G_MMA(1, 1, At, B1); G_BAR; }
  { G_LDB(B0, 1, 0); G_LDA(At, 1, 0); G_WAIT_V(2); G_BAR; G_WAIT_L(0); G_MMA(0, 0, At, B0); G_BAR;
    G_LDB(B1, 1, 1); G_WAIT_V(0); G_BAR; G_WAIT_L(0); G_MMA(0, 1, At, B1); G_BAR;
    G_LDA(At, 1, 1); G_BAR; G_WAIT_L(0); G_MMA(1, 0, At, B0); G_MMA(1, 1, At, B1); G_BAR; }
  if (wr == 0) G_BAR;
}

DI void tile_map(int L, int total, int ntm, int ntn, int& mt, int& nt) {
  const int q = total >> 3, r = total & 7, xcd = L & 7, off = L >> 3;
  const int id = (xcd < r ? xcd * (q + 1) : r * (q + 1) + (xcd - r) * q) + off;
  const int nig = 8 * ntn, g = id / nig, w = id % nig, fm = g * 8, gsz = min(ntm - fm, 8);
  mt = fm + w % gsz; nt = w / gsz;
}
DI void convert_tile(const TJob& jb, int t, char* lds) {
  float* tile = (float*)lds;
  const int tid = threadIdx.x;
  const int tk = t / jb.tiles_n, tn = t % jb.tiles_n;
  const int k0 = tk * 64, n0 = tn * 64;
  __syncthreads();
#pragma unroll
  for (int i = 0; i < 2; ++i) {
    const int idx = tid + 512 * i, row = idx >> 4, c4 = idx & 15;
    const float4 v = *(const float4*)(jb.src + (size_t)(k0 + row) * jb.N + n0 + c4 * 4);
    tile[row * 65 + c4 * 4 + 0] = v.x; tile[row * 65 + c4 * 4 + 1] = v.y; tile[row * 65 + c4 * 4 + 2] = v.z; tile[row * 65 + c4 * 4 + 3] = v.w;
  }
  __syncthreads();
  const int n = tid >> 3, kc = tid & 7;
  float v[8];
#pragma unroll
  for (int j = 0; j < 8; ++j) v[j] = tile[(kc * 8 + j) * 65 + n];
  uint4 o;
  o.x = pack2(v[0], v[1]); o.y = pack2(v[2], v[3]); o.z = pack2(v[4], v[5]); o.w = pack2(v[6], v[7]);
  *(uint4*)(jb.dst + (size_t)(n0 + n) * jb.K + k0 + kc * 8) = o;
}

DI void mod_unit(const Params& p, int mu_, char* lds) {
  const int tid = threadIdx.x;
  const int layer = mu_ / 96, cc = mu_ % 96;
  float* sc = (float*)lds;
  float* red = sc + 9 * 1024;
  __syncthreads();
  for (int i = tid; i < 9 * 1024; i += 512) {
    const int row = i >> 10, k = i & 1023;
    const float v = row < 8 ? p.c[row * 1024 + k] : p.c_ctx[k];
    sc[i] = v / (1.f + __expf(-v));
  }
  __syncthreads();
  const int kg = tid >> 6, col = tid & 63;
  const float* w = p.w_mod + (size_t)layer * 1024 * 6144 + cc * 64 + col;
  float a[9];
#pragma unroll
  for (int r = 0; r < 9; ++r) a[r] = 0.f;
#pragma unroll 16
  for (int k = kg * 128; k < kg * 128 + 128; ++k) {
    const float wv = w[(size_t)k * 6144];
#pragma unroll
    for (int r = 0; r < 9; ++r) a[r] += sc[r * 1024 + k] * wv;
  }
#pragma unroll
  for (int r = 0; r < 9; ++r) red[(kg * 9 + r) * 64 + col] = a[r];
  __syncthreads();
  for (int i = tid; i < 576; i += 512) {
    const int r = i >> 6, cl = i & 63;
    float s = 0.f;
#pragma unroll
    for (int g = 0; g < 8; ++g) s += red[(g * 9 + r) * 64 + cl];
    const int n = cc * 64 + cl;
    p.MOD[(layer * 9 + r) * 6144 + n] = s + p.b_mod[layer * 6144 + n];
  }
  __syncthreads();
}

DI void sincos_d(double a, double& s, double& c) {
  const double n = rint(a * 0.6366197723675814);
  const double r = (a - n * 1.5707963267948966) - n * 6.123233995736766e-17;
  const double r2 = r * r;
  const double sp = r * (1.0 + r2 * (-1.0 / 6.0 + r2 * (1.0 / 120.0 + r2 * (-1.0 / 5040.0 + r2 * (1.0 / 362880.0 + r2 * (-1.0 / 39916800.0 + r2 * (1.0 / 6227020800.0)))))));
  const double cp = 1.0 + r2 * (-0.5 + r2 * (1.0 / 24.0 + r2 * (-1.0 / 720.0 + r2 * (1.0 / 40320.0 + r2 * (-1.0 / 3628800.0 + r2 * (1.0 / 479001600.0 + r2 * (-1.0 / 87178291200.0)))))));
  const int q = ((int)n) & 3;
  if (q == 0) { s = sp; c = cp; }
  else if (q == 1) { s = cp; c = -sp; }
  else if (q == 2) { s = -sp; c = -cp; }
  else { s = -cp; c = sp; }
}

DI void tab_unit(const Params& p) {
  for (int idx = threadIdx.x; idx < 1024; idx += 512) {
    const int pos = idx >> 4, fi = idx & 15;
    double f = 1.0;
    for (int i = 0; i < fi; ++i) f *= 0.5623413251903491;
    double s, c;
    sincos_d((double)pos * (double)(float)f, s, c);
    p.TAB[idx * 2 + 0] = (float)c;
    p.TAB[idx * 2 + 1] = (float)s;
  }
}

DI void phase0(const Params& p, char* lds) {
  const int total = p.total_tiles + 192 + 1;
  for (int u = blockIdx.x; u < total; u += gridDim.x) {
    if (u < p.total_tiles) {
      int j = 0;
#pragma unroll 1
      for (int q = 1; q < p.njobs; ++q) if (u >= p.jobs[q].tstart) j = q;
      convert_tile(p.jobs[j], u - p.jobs[j].tstart, lds);
    } else if (u < p.total_tiles + 192) {
      mod_unit(p, u - p.total_tiles, lds);
    } else {
      tab_unit(p);
    }
  }
}

DI void norm_mod_phase(const float* __restrict__ xl, const float* __restrict__ xc, const float* __restrict__ gain,
                               const float* __restrict__ mod, int shift_i, int scale_i, bf16_t* __restrict__ H, int ntok) {
  int tid_ = threadIdx.x; asm volatile("" : "+v"(tid_));
  const int lane = tid_ & 63;
  const int wg = blockIdx.x * 8 + (tid_ >> 6), nw = gridDim.x * 8;
  for (int t = wg; t < ntok; t += nw) {
    const float* row = t < NL ? xl + (size_t)t * 1024 : xc + (size_t)(t - NL) * 1024;
    float4 v[4];
    float ss = 0.f;
#pragma unroll
    for (int i = 0; i < 4; ++i) {
      v[i] = *(const float4*)(row + (lane + 64 * i) * 4);
      ss += v[i].x * v[i].x + v[i].y * v[i].y + v[i].z * v[i].z + v[i].w * v[i].w;
    }
    ss = wave_sum(ss);
    const float rstd = rsqrtf(ss * (1.f / 1024.f) + 1e-6f);
    const int bp = t < NL ? (t >> 12) : 8;
    const float* sh = mod + (bp * 6 + shift_i) * 1024;
    const float* sc = mod + (bp * 6 + scale_i) * 1024;
#pragma unroll
    for (int i = 0; i < 4; ++i) {
      const int c = (lane + 64 * i) * 4;
      const float4 g = *(const float4*)(gain + c), s4 = *(const float4*)(sh + c), c4 = *(const float4*)(sc + c);
      store_bf4(H + (size_t)t * 1024 + c,
                v[i].x * rstd * g.x * (1.f + c4.x) + s4.x, v[i].y * rstd * g.y * (1.f + c4.y) + s4.y,
                v[i].z * rstd * g.z * (1.f + c4.z) + s4.z, v[i].w * rstd * g.w * (1.f + c4.w) + s4.w);
    }
  }
}

DI void final_norm_phase(const Params& p) {
  int tid_ = threadIdx.x; asm volatile("" : "+v"(tid_));
  const int lane = tid_ & 63;
  const int wg = blockIdx.x * 8 + (tid_ >> 6), nw = gridDim.x * 8;
  for (int t = wg; t < NL; t += nw) {
    float* row = p.out + (size_t)t * 1024;
    float4 v[4];
    float ss = 0.f;
#pragma unroll
    for (int i = 0; i < 4; ++i) {
      v[i] = *(const float4*)(row + (lane + 64 * i) * 4);
      ss += v[i].x * v[i].x + v[i].y * v[i].y + v[i].z * v[i].z + v[i].w * v[i].w;
    }
    ss = wave_sum(ss);
    const float rstd = rsqrtf(ss * (1.f / 1024.f) + 1e-6f);
#pragma unroll
    for (int i = 0; i < 4; ++i) {
      const int c = (lane + 64 * i) * 4;
      const float4 g = *(const float4*)(p.final_norm + c);
      *(float4*)(row + c) = make_float4(v[i].x * rstd * g.x, v[i].y * rstd * g.y, v[i].z * rstd * g.z, v[i].w * rstd * g.w);
    }
  }
}

DI void phase_mix(const Params& p) {
  const int lane = threadIdx.x & 63;
  const int wg = blockIdx.x * 8 + (threadIdx.x >> 6), nw = gridDim.x * 8;
  for (int t = wg; t < NT; t += nw) {
#pragma unroll
    for (int i = 0; i < 2; ++i) {
      const int c = lane * 8 + 512 * i;
      const uint4 own = *(const uint4*)(p.Hd + (size_t)t * 1024 + c);
      int nb; bool valid;
      if (t < NL) {
        const int s = t & 4095, col = s & 63, rw = s >> 6, qd = c >> 8;
        if (qd == 0) { valid = col > 0; nb = t - 1; }
        else if (qd == 1) { valid = col < 63; nb = t + 1; }
        else if (qd == 2) { valid = rw > 0; nb = t - 64; }
        else { valid = rw < 63; nb = t + 64; }
      } else {
        const int s = (t - NL) & 255;
        if (c < 512) { valid = s > 0; nb = t - 1; }
        else { valid = s < 255; nb = t + 1; }
      }
      uint4 nv = make_uint4(0, 0, 0, 0);
      if (valid) nv = *(const uint4*)(p.Hd + (size_t)nb * 1024 + c);
#pragma unroll
      for (int j = 0; j < 3; ++j) {
        const int mi = j == 0 ? 0 : j == 1 ? 2 : 3;
        const float4 m0 = *(const float4*)(p.mu + mi * 1024 + c), m1 = *(const float4*)(p.mu + mi * 1024 + c + 4);
        uint4 o;
        o.x = lerp2(own.x, nv.x, m0.x, m0.y); o.y = lerp2(own.y, nv.y, m0.z, m0.w);
        o.z = lerp2(own.z, nv.z, m1.x, m1.y); o.w = lerp2(own.w, nv.w, m1.z, m1.w);
        *(uint4*)(p.S[3 + j] + (size_t)t * 1024 + c) = o;
      }
    }
  }
}

DI void phase_proj(const Params& p, char* lds) {
  const int lane = threadIdx.x & 63, wave = threadIdx.x >> 6;
  constexpr int NLORA = (NT / 256) * 3, NRKV = (NT / 256) * 12;
  for (int u = blockIdx.x; u < NLORA; u += gridDim.x) {
    {
      const int wt = wave & 3, wf = wave >> 2, lr = lane & 15, lq = lane >> 4;
      const int mt = u / 3, nt = 24 + u % 3;
      const int mi = nt == 24 ? 5 : nt == 25 ? 1 : 4;
      f32x4 acc[4][4];
      gemm_tile<true>(p.Hd, 1024, p.Wcat, 1024, 1024, mt * 256, nt * 128, lds, acc, p.mu + mi * 1024);
#pragma unroll
      for (int pp = 0; pp < 2; ++pp)
#pragma unroll
        for (int ti = 0; ti < 4; ++ti) {
          const int t = mt * 256 + wt * 64 + ti * 16 + lr;
          const int fl = wf * 64 + pp * 32 + lq * 8;
          f32x4 a = acc[2 * pp][ti], b = acc[2 * pp + 1][ti];
          if (nt == 24) {
#pragma unroll
            for (int j = 0; j < 4; ++j) { a[j] = sigmoidf_(a[j]); b[j] = sigmoidf_(b[j]); }
            store_bf8(p.L1 + (size_t)t * 384 + fl, a, b);
          } else if (nt == 25) {
#pragma unroll
            for (int j = 0; j < 4; ++j) { a[j] = tanhf_(a[j]); b[j] = tanhf_(b[j]); }
            store_bf8(p.L1 + (size_t)t * 384 + 128 + fl, a, b);
          } else {
            store_bf8(p.L1 + (size_t)t * 384 + 256 + fl, a, b);
          }
        }
    }
  }
  for (int v0 = blockIdx.x; v0 < NRKV; v0 += gridDim.x) {
    {
      const int wr = wave >> 2, wc = wave & 3;
      f32x4 acc[2][2][4][2];
      { int mt0, rem0; tile_map(v0, NRKV, NT / 256, 12, mt0, rem0); const int j0 = rem0 >> 2, nt0 = rem0 & 3;
        gemm256_tile<true>(p.Wcat + (size_t)j0 * 1024 * 1024, p.S[3 + j0], 1024, nt0 * 256, mt0 * 256, lds, acc); }
      int lane_o = threadIdx.x & 63; asm volatile("" : "+v"(lane_o));
      int v = v0; asm volatile("" : "+s"(v));
      int mt, rem; tile_map(v, NRKV, NT / 256, 12, mt, rem); const int j = rem >> 2, nt = rem & 3;
      const int fr = lane_o & 15, fq = lane_o >> 4;
#pragma unroll
      for (int bj = 0; bj < 2; ++bj)
#pragma unroll
        for (int n = 0; n < 2; ++n) {
          const int t = mt * 256 + bj * 128 + wc * 32 + n * 16 + fr;
#pragma unroll
          for (int ai = 0; ai < 2; ++ai) {
            const int fh = nt * 256 + ai * 128 + wr * 64;
            if (j == 1) {
              f32x4 a[2], b[2];
              float ss = 0.f;
#pragma unroll
              for (int mp = 0; mp < 2; ++mp) {
                const int f = fh + mp * 32 + fq * 8;
                const float4 kkl = *(const float4*)(p.k_k + f), kkh = *(const float4*)(p.k_k + f + 4);
                a[mp] = acc[ai][bj][2 * mp][n]; b[mp] = acc[ai][bj][2 * mp + 1][n];
                a[mp][0] *= kkl.x; a[mp][1] *= kkl.y; a[mp][2] *= kkl.z; a[mp][3] *= kkl.w;
                b[mp][0] *= kkh.x; b[mp][1] *= kkh.y; b[mp][2] *= kkh.z; b[mp][3] *= kkh.w;
#pragma unroll
                for (int e2 = 0; e2 < 4; ++e2) ss += a[mp][e2] * a[mp][e2] + b[mp][e2] * b[mp][e2];
              }
              ss += __shfl_xor(ss, 16); ss += __shfl_xor(ss, 32);
              const float kinv = rsqrtf(ss + 1e-12f);
#pragma unroll
              for (int mp = 0; mp < 2; ++mp) {
#pragma unroll
                for (int e2 = 0; e2 < 4; ++e2) { a[mp][e2] *= kinv; b[mp][e2] *= kinv; }
                store_bf8(p.S[2] + HM(t, fh + mp * 32 + fq * 8), a[mp], b[mp]);
              }
              if (fq == 0) p.NRM[(size_t)(fh >> 6) * NT + t] = sqrtf(ss + 1e-12f);
            } else {
              bf16_t* dst = j == 0 ? p.S[0] : p.S[1];
#pragma unroll
              for (int mp = 0; mp < 2; ++mp)
                store_bf8(dst + HM(t, fh + mp * 32 + fq * 8), acc[ai][bj][2 * mp][n], acc[ai][bj][2 * mp + 1][n]);
            }
          }
        }
    }
  }
}

DI void phase_prep(const Params& p, char* lds) {
  const int lane = threadIdx.x & 63, wave = threadIdx.x >> 6;
  const int wt = wave & 3, wf = wave >> 2, lr = lane & 15, lq = lane >> 4;
  const int total = (NT / 256) * 8;
  for (int u = blockIdx.x; u < total; u += gridDim.x) {
    const int mt = u >> 3, nt = u & 7;
    const int tok0 = mt * 256, f0 = nt * 128;
    f32x4 acc[4][4];
    uint4 afp[2][4];
    gemm_tile<false>(p.L1 + 256, 384, p.L2w + 0 * 65536, 64, 64, tok0, f0, lds, acc, nullptr);
#pragma unroll
    for (int pp = 0; pp < 2; ++pp) {
      const int f = f0 + wf * 64 + pp * 32 + lq * 8;
      const float4 a0l = *(const float4*)(p.a0 + f), a0h = *(const float4*)(p.a0 + f + 4);
#pragma unroll
      for (int ti = 0; ti < 4; ++ti) {
        const int t = tok0 + wt * 64 + ti * 16 + lr;
        f32x4 a = acc[2 * pp][ti], b = acc[2 * pp + 1][ti];
        a[0] = sigmoidf_(a[0] + a0l.x); a[1] = sigmoidf_(a[1] + a0l.y); a[2] = sigmoidf_(a[2] + a0l.z); a[3] = sigmoidf_(a[3] + a0l.w);
        b[0] = sigmoidf_(b[0] + a0h.x); b[1] = sigmoidf_(b[1] + a0h.y); b[2] = sigmoidf_(b[2] + a0h.z); b[3] = sigmoidf_(b[3] + a0h.w);
        uint4 o; o.x = pack2(a[0], a[1]); o.y = pack2(a[2], a[3]); o.z = pack2(b[0], b[1]); o.w = pack2(b[2], b[3]);
        afp[pp][ti] = o;
        *(uint4*)(p.S[3] + HM(t, f)) = o;
      }
    }
    gemm_tile<false>(p.L1 + 320, 384, p.L2w + 1 * 65536, 64, 64, tok0, f0, lds, acc, nullptr);
#pragma unroll
    for (int ti = 0; ti < 4; ++ti) {
      const int t = tok0 + wt * 64 + ti * 16 + lr;
      float bon = 0.f;
      const float nrm = p.NRM[(size_t)(nt * 2 + wf) * NT + t];
#pragma unroll
      for (int pp = 0; pp < 2; ++pp) {
        const int f = f0 + wf * 64 + pp * 32 + lq * 8;
        const float4 a0l = *(const float4*)(p.a0 + 1024 + f), a0h = *(const float4*)(p.a0 + 1024 + f + 4);
        const float4 rkl = *(const float4*)(p.r_k + f), rkh = *(const float4*)(p.r_k + f + 4);
        const float4 kal = *(const float4*)(p.k_a + f), kah = *(const float4*)(p.k_a + f + 4);
        const float4 kkl = *(const float4*)(p.k_k + f), kkh = *(const float4*)(p.k_k + f + 4);
        const float rk8[8] = {rkl.x, rkl.y, rkl.z, rkl.w, rkh.x, rkh.y, rkh.z, rkh.w};
        const float ka8[8] = {kal.x, kal.y, kal.z, kal.w, kah.x, kah.y, kah.z, kah.w};
        const float kk8[8] = {kkl.x, kkl.y, kkl.z, kkl.w, kkh.x, kkh.y, kkh.z, kkh.w};
        f32x4 a = acc[2 * pp][ti], b = acc[2 * pp + 1][ti];
        a[0] = sigmoidf_(a[0] + a0l.x); a[1] = sigmoidf_(a[1] + a0l.y); a[2] = sigmoidf_(a[2] + a0l.z); a[3] = sigmoidf_(a[3] + a0l.w);
        b[0] = sigmoidf_(b[0] + a0h.x); b[1] = sigmoidf_(b[1] + a0h.y); b[2] = sigmoidf_(b[2] + a0h.z); b[3] = sigmoidf_(b[3] + a0h.w);
        store_bf8(p.S[4] + HM(t, f), a, b);
        const float ab8[8] = {a[0], a[1], a[2], a[3], b[0], b[1], b[2], b[3]};
        float af8[8], r8[8], k8[8];
        unpack_bf8(afp[pp][ti], af8);
        unpack_bf8(*(const uint4*)(p.S[0] + HM(t, f)), r8);
        unpack_bf8(*(const uint4*)(p.S[2] + HM(t, f)), k8);
#pragma unroll
        for (int e2 = 0; e2 < 8; ++e2) {
          const float k = k8[e2] * nrm / kk8[e2];
          bon += r8[e2] * k * rk8[e2] * (2.f + (ab8[e2] + af8[e2] - 2.f) * ka8[e2]);
        }
      }
      bon += __shfl_xor(bon, 16); bon += __shfl_xor(bon, 32);
      if (lq == 0) p.BON[(size_t)(nt * 2 + wf) * NT + t] = bon;
    }
#pragma unroll 1
    for (int dr = 0; dr < 2; ++dr) {
      gemm_tile<false>(p.L1 + 128 + dr * 64, 384, p.L2w + (2 + dr) * 65536, 64, 64, tok0, f0, lds, acc, nullptr);
      bf16_t* dst = dr ? p.S[5] : p.Hd;
#pragma unroll
      for (int pp = 0; pp < 2; ++pp) {
        const int f = f0 + wf * 64 + pp * 32 + lq * 8;
        const float4 w0l = *(const float4*)(p.w0 + dr * 1024 + f), w0h = *(const float4*)(p.w0 + dr * 1024 + f + 4);
#pragma unroll
        for (int ti = 0; ti < 4; ++ti) {
          const int t = tok0 + wt * 64 + ti * 16 + lr;
          f32x4 a = acc[2 * pp][ti], b = acc[2 * pp + 1][ti];
          a[0] = -0.60653066f * sigmoidf_(a[0] + w0l.x); a[1] = -0.60653066f * sigmoidf_(a[1] + w0l.y);
          a[2] = -0.60653066f * sigmoidf_(a[2] + w0l.z); a[3] = -0.60653066f * sigmoidf_(a[3] + w0l.w);
          b[0] = -0.60653066f * sigmoidf_(b[0] + w0h.x); b[1] = -0.60653066f * sigmoidf_(b[1] + w0h.y);
          b[2] = -0.60653066f * sigmoidf_(b[2] + w0h.z); b[3] = -0.60653066f * sigmoidf_(b[3] + w0h.w);
          store_bf8(dst + HM(t, f), a, b);
        }
      }
    }
  }
}

typedef short s16x4 __attribute__((ext_vector_type(4)));
#define MFMA16K(a, b, c) __builtin_amdgcn_mfma_f32_16x16x16bf16_1k((a), (b), (c), 0, 0, 0)
DI s16x4 pack4(const f32x4& x) { const uint2 u = make_uint2(pack2(x[0], x[1]), pack2(x[2], x[3])); return __builtin_bit_cast(s16x4, u); }
DI bf16x8 pack8(const f32x4& a, const f32x4& b) { const uint4 u = make_uint4(pack2(a[0], a[1]), pack2(a[2], a[3]), pack2(b[0], b[1]), pack2(b[2], b[3])); return __builtin_bit_cast(bf16x8, u); }
constexpr int SC_KK = 0, SC_R = 2304, SC_B = 4608, SC_K = 6912, SC_BT = 9216, SC_KT = 12288, SC_VT = 15360, SC_CL = 18432, SC_CHUNK = 18688, SC_GROUP = 2 * SC_CHUNK, SC_YBUF = 2 * SC_GROUP;

#define KEEP8(x) asm volatile("" :: "v"(x))
#define KEEP4(x) asm volatile("" :: "v"(x))
DI void scan_chunk(const char* cb, float* yb, f32x4 (&ST)[4], int vb, int c, int q) {
  const f32x4 z = {0.f, 0.f, 0.f, 0.f};
  bf16x8 fB[2], fK[2], fKK[2], fR[2];
#pragma unroll
  for (int ks = 0; ks < 2; ++ks) {
    fB[ks] = *(const bf16x8*)(cb + SC_B + c * 144 + ks * 64 + q * 16);
    fK[ks] = *(const bf16x8*)(cb + SC_K + c * 144 + ks * 64 + q * 16);
    fKK[ks] = *(const bf16x8*)(cb + SC_KK + c * 144 + ks * 64 + q * 16);
    fR[ks] = *(const bf16x8*)(cb + SC_R + c * 144 + ks * 64 + q * 16);
  }
  f32x4 Abk = MFMA16(fB[0], fKK[0], z);  Abk = MFMA16(fB[1], fKK[1], Abk);
  f32x4 AbkT = MFMA16(fKK[0], fB[0], z); AbkT = MFMA16(fKK[1], fB[1], AbkT);
  f32x4 Akk = MFMA16(fK[0], fKK[0], z);  Akk = MFMA16(fK[1], fKK[1], Akk);
  f32x4 Abr = MFMA16(fB[0], fR[0], z);   Abr = MFMA16(fB[1], fR[1], Abr);
  f32x4 Akr = MFMA16(fK[0], fR[0], z);   Akr = MFMA16(fK[1], fR[1], Akr);
  KEEP8(fB[0]); KEEP8(fB[1]); KEEP8(fK[0]); KEEP8(fK[1]); KEEP8(fKK[0]); KEEP8(fKK[1]); KEEP8(fR[0]); KEEP8(fR[1]);
  f32x4 P;
#pragma unroll
  for (int j = 0; j < 4; ++j) {
    const int rr = 4 * q + j;
    Abk[j] = rr < c ? Abk[j] : 0.f;  Akk[j] = rr < c ? Akk[j] : 0.f;
    Abr[j] = rr <= c ? Abr[j] : 0.f; Akr[j] = rr <= c ? Akr[j] : 0.f;
    AbkT[j] = c < rr ? AbkT[j] : 0.f;
    P[j] = (rr == c ? 1.f : 0.f) - Abk[j];
  }
  const s16x4 bN = pack4(Abk), bNT = pack4(AbkT);
  const f32x4 N2 = MFMA16K(bNT, bN, z), N2T = MFMA16K(bN, bNT, z);
  KEEP4(bN); KEEP4(bNT);
  const s16x4 bN2 = pack4(N2), bN2T = pack4(N2T);
  const f32x4 N4 = MFMA16K(bN2T, bN2, z), N4T = MFMA16K(bN2, bN2T, z);
  KEEP4(bN2); KEEP4(bN2T);
  const s16x4 bN4 = pack4(N4), bN4T = pack4(N4T);
  const f32x4 N8T = MFMA16K(bN4, bN4T, z);
  KEEP4(bN4); KEEP4(bN4T);
  const s16x4 bN8T = pack4(N8T);
  { const s16x4 pp_ = pack4(P); P = MFMA16K(bN2T, pp_, P); KEEP4(pp_); KEEP4(bN2T); }
  { const s16x4 pp_ = pack4(P); P = MFMA16K(bN4T, pp_, P); KEEP4(pp_); KEEP4(bN4T); }
  { const s16x4 pp_ = pack4(P); P = MFMA16K(bN8T, pp_, P); KEEP4(pp_); KEEP4(bN8T); }
  const s16x4 bT = pack4(P);
  bf16x8 sf[2], kkp[2], rp[2];
#pragma unroll
  for (int i = 0; i < 2; ++i) {
    sf[i] = pack8(ST[2 * i], ST[2 * i + 1]);
    const uint2 klo = *(const uint2*)(cb + SC_KK + c * 144 + (32 * i + 4 * q) * 2), khi = *(const uint2*)(cb + SC_KK + c * 144 + (32 * i + 16 + 4 * q) * 2);
    const uint2 rlo = *(const uint2*)(cb + SC_R + c * 144 + (32 * i + 4 * q) * 2), rhi = *(const uint2*)(cb + SC_R + c * 144 + (32 * i + 16 + 4 * q) * 2);
    kkp[i] = __builtin_bit_cast(bf16x8, make_uint4(klo.x, klo.y, khi.x, khi.y));
    rp[i] = __builtin_bit_cast(bf16x8, make_uint4(rlo.x, rlo.y, rhi.x, rhi.y));
  }
  f32x4 XT = MFMA16(kkp[0], sf[0], z); XT = MFMA16(kkp[1], sf[1], XT);
  f32x4 YT = MFMA16(rp[0], sf[0], z);  YT = MFMA16(rp[1], sf[1], YT);
  KEEP8(kkp[0]); KEEP8(kkp[1]); KEEP8(rp[0]); KEEP8(rp[1]); KEEP8(sf[0]); KEEP8(sf[1]);
  const s16x4 vf = *(const s16x4*)(cb + SC_VT + (vb * 16 + c) * 48 + q * 8);
  const s16x4 pAkk = pack4(Akk);
  XT = MFMA16K(pAkk, vf, XT); KEEP4(pAkk);
  const s16x4 pXT = pack4(XT);
  f32x4 UT = MFMA16K(bT, pXT, z); KEEP4(pXT); KEEP4(bT);
#pragma unroll
  for (int j = 0; j < 4; ++j) UT[j] = -UT[j];
  const s16x4 bU = pack4(UT);
  const s16x4 pAbr = pack4(Abr), pAkr = pack4(Akr);
  YT = MFMA16K(pAbr, bU, YT);
  YT = MFMA16K(pAkr, vf, YT); KEEP4(pAbr); KEEP4(pAkr);
#pragma unroll
  for (int j = 0; j < 4; ++j) yb[(4 * q + j) * 64 + vb * 16 + c] = YT[j];
#pragma unroll
  for (int kt = 0; kt < 4; ++kt) {
    const s16x4 bh = *(const s16x4*)(cb + SC_BT + (16 * kt + c) * 48 + q * 8);
    const s16x4 kh = *(const s16x4*)(cb + SC_KT + (16 * kt + c) * 48 + q * 8);
    f32x4 s = MFMA16K(bh, bU, ST[kt]);
    s = MFMA16K(kh, vf, s); KEEP4(bh); KEEP4(kh);
    const float4 cl = *(const float4*)(cb + SC_CL + (16 * kt + 4 * q) * 4);
    s[0] *= cl.x; s[1] *= cl.y; s[2] *= cl.z; s[3] *= cl.w;
    ST[kt] = s;
  }
  KEEP4(bU); KEEP4(vf);
}

DI void phase_scan(const Params& p, char* lds) {
  float* ybuf = (float*)(lds + SC_YBUF);
  const int tid = threadIdx.x, lane = tid & 63, wave = tid >> 6;
  const bool loader = tid >= 256;
  const int lt = tid & 255, ltk = lt >> 3, lch = (lt & 7) * 8;
  const int lcc = (wave >> 1) & 1, lchh = wave & 1, ltok = lane >> 2, loct = lane & 3, ch0 = lchh * 32 + loct * 8;
  const int vb = wave & 3, cc_ = lane & 15, qq = lane >> 4;
  constexpr int NG = NKEY / 32;
  for (int unit = blockIdx.x; unit < 256; unit += gridDim.x) {
    const int dir = unit & 1, h = (unit >> 1) & 15, b = unit >> 5;
    const bf16_t* Rp = p.S[0]; const bf16_t* Vp = p.S[1]; const bf16_t* Kp = p.S[2];
    bf16_t* Ap = dir ? p.S[4] : p.S[3];
    const bf16_t* Lp = dir ? p.S[5] : p.Hd;
    auto tok_of = [&](int i) -> int {
      if (i < 256) return NL + b * 256 + (dir ? 255 - i : i);
      const int s = i - 256;
      return b * 4096 + (dir ? 4095 - s : s);
    };
    uint4 rawA[5], rawB[5];
    float nrmA = 0.f, nrmB = 0.f;
    float rkk[8], kac[8];
    f32x4 ST[4];
#pragma unroll
    for (int i = 0; i < 4; ++i) ST[i] = f32x4{0.f, 0.f, 0.f, 0.f};
    if (loader) {
#pragma unroll
      for (int j = 0; j < 8; ++j) { rkk[j] = 1.f / p.k_k[h * 64 + ch0 + j]; kac[j] = p.k_a[h * 64 + ch0 + j]; }
    }
    auto issue = [&](int g, uint4 (&rw)[5], float& nv) {
      const int t = tok_of(g * 32 + lcc * 16 + ltok);
      const size_t off = HM(t, h * 64 + ch0);
      rw[0] = *(const uint4*)(Rp + off); rw[1] = *(const uint4*)(Vp + off); rw[2] = *(const uint4*)(Kp + off);
      rw[3] = *(const uint4*)(Ap + off); rw[4] = *(const uint4*)(Lp + off);
      nv = p.NRM[(size_t)h * NT + t];
    };
    auto process = [&](int stage, const uint4 (&raw)[5], const float nrmv) {
      float r8[8], kk8[8], a8[8], l8[8], L[8];
      unpack_bf8(raw[0], r8); unpack_bf8(raw[2], kk8); unpack_bf8(raw[3], a8); unpack_bf8(raw[4], l8);
#pragma unroll
      for (int j = 0; j < 8; ++j) L[j] = l8[j];
#pragma unroll
      for (int d = 4; d < 64; d <<= 1) {
#pragma unroll
        for (int j = 0; j < 8; ++j) { const float o = __shfl_up(L[j], d); if (lane >= d) L[j] += o; }
      }
      float okk[8], orr[8], ob[8], ok[8], cend[8];
#pragma unroll
      for (int j = 0; j < 8; ++j) {
        const float cc = __expf(L[j]), cprev = __expf(L[j] - l8[j]), cinv = __expf(-L[j]);
        const float k = kk8[j] * nrmv * rkk[j];
        const float kd = k * (1.f + (a8[j] - 1.f) * kac[j]);
        okk[j] = kk8[j] * cprev; orr[j] = r8[j] * cc; ob[j] = kk8[j] * a8[j] * cinv; ok[j] = kd * cinv; cend[j] = cc;
      }
      char* cb = lds + stage * SC_GROUP + lcc * SC_CHUNK;
      uint4 o;
      o = make_uint4(pack2(okk[0], okk[1]), pack2(okk[2], okk[3]), pack2(okk[4], okk[5]), pack2(okk[6], okk[7])); *(uint4*)(cb + SC_KK + ltok * 144 + ch0 * 2) = o;
      o = make_uint4(pack2(orr[0], orr[1]), pack2(orr[2], orr[3]), pack2(orr[4], orr[5]), pack2(orr[6], orr[7])); *(uint4*)(cb + SC_R + ltok * 144 + ch0 * 2) = o;
      const uint4 obp = make_uint4(pack2(ob[0], ob[1]), pack2(ob[2], ob[3]), pack2(ob[4], ob[5]), pack2(ob[6], ob[7])); *(uint4*)(cb + SC_B + ltok * 144 + ch0 * 2) = obp;
      const uint4 okp = make_uint4(pack2(ok[0], ok[1]), pack2(ok[2], ok[3]), pack2(ok[4], ok[5]), pack2(ok[6], ok[7])); *(uint4*)(cb + SC_K + ltok * 144 + ch0 * 2) = okp;
      const unsigned bw[4] = {obp.x, obp.y, obp.z, obp.w}, kw[4] = {okp.x, okp.y, okp.z, okp.w}, vw[4] = {raw[1].x, raw[1].y, raw[1].z, raw[1].w};
#pragma unroll
      for (int j = 0; j < 8; ++j) {
        const int sh = (j & 1) * 16;
        *(bf16_t*)(cb + SC_BT + (ch0 + j) * 48 + ltok * 2) = (bf16_t)((bw[j >> 1] >> sh) & 0xffffu);
        *(bf16_t*)(cb + SC_KT + (ch0 + j) * 48 + ltok * 2) = (bf16_t)((kw[j >> 1] >> sh) & 0xffffu);
        *(bf16_t*)(cb + SC_VT + (ch0 + j) * 48 + ltok * 2) = (bf16_t)((vw[j >> 1] >> sh) & 0xffffu);
      }
      if (ltok == 15) {
        *(float4*)(cb + SC_CL + ch0 * 4) = make_float4(cend[0], cend[1], cend[2], cend[3]);
        *(float4*)(cb + SC_CL + ch0 * 4 + 16) = make_float4(cend[4], cend[5], cend[6], cend[7]);
      }
    };
    auto yout = [&](int g) {
      const float* yb = ybuf + (g & 1) * 2048 + ltk * 64 + lch;
      const float4 y0 = *(const float4*)yb, y1 = *(const float4*)(yb + 4);
      const int t = tok_of(g * 32 + ltk);
      uint4 o;
      o.x = pack2(y0.x, y0.y); o.y = pack2(y0.z, y0.w); o.z = pack2(y1.x, y1.y); o.w = pack2(y1.z, y1.w);
      *(uint4*)(Ap + HM(t, h * 64 + lch)) = o;
    };
    __syncthreads();
    if (loader) { issue(0, rawA, nrmA); issue(1, rawB, nrmB); process(0, rawA, nrmA); issue(2, rawA, nrmA); }
    __syncthreads();
    for (int g = 0; g < NG; g += 2) {
      if (loader) {
        if (g >= 1) yout(g - 1);
        if (g + 1 < NG) { process(1, rawB, nrmB); if (g + 3 < NG) issue(g + 3, rawB, nrmB); }
      } else {
        const char* gb = lds;
        float* yb = ybuf;
        scan_chunk(gb, yb, ST, vb, cc_, qq);
        scan_chunk(gb + SC_CHUNK, yb + 16 * 64, ST, vb, cc_, qq);
      }
      __syncthreads();
      if (g + 1 < NG) {
        if (loader) {
          yout(g);
          if (g + 2 < NG) { process(0, rawA, nrmA); if (g + 4 < NG) issue(g + 4, rawA, nrmA); }
        } else {
          const char* gb = lds + SC_GROUP;
          float* yb = ybuf + 2048;
          scan_chunk(gb, yb, ST, vb, cc_, qq);
          scan_chunk(gb + SC_CHUNK, yb + 16 * 64, ST, vb, cc_, qq);
        }
        __syncthreads();
      }
    }
    if (loader) yout(NG - 1);
    __syncthreads();
  }
}

DI void phase_readout(const Params& p, char* lds) {
  const int lane = threadIdx.x & 63, wave = threadIdx.x >> 6;
  const int wt = wave & 3, wf = wave >> 2, lr = lane & 15, lq = lane >> 4;
  const int total = (NT / 256) * 8;
  for (int u = blockIdx.x; u < total; u += gridDim.x) {
    const int mt = u >> 3, nt = u & 7;
    const int tok0 = mt * 256, f0 = nt * 128;
    f32x4 g[4][4];
    gemm_tile<false>(p.L1, 384, p.g2T, 128, 128, tok0, f0, lds, g, nullptr);
    const int head = nt * 2 + wf;
#pragma unroll
    for (int ti = 0; ti < 4; ++ti) {
      const int t = tok0 + wt * 64 + ti * 16 + lr;
      float y[2][8];
      float sum = 0.f;
#pragma unroll
      for (int pp = 0; pp < 2; ++pp) {
        const int f = f0 + wf * 64 + pp * 32 + lq * 8;
        float ya[8], yb[8];
        unpack_bf8(*(const uint4*)(p.S[3] + HM(t, f)), ya);
        unpack_bf8(*(const uint4*)(p.S[4] + HM(t, f)), yb);
#pragma unroll
        for (int e2 = 0; e2 < 8; ++e2) { y[pp][e2] = ya[e2] + yb[e2]; sum += y[pp][e2]; }
      }
      sum += __shfl_xor(sum, 16); sum += __shfl_xor(sum, 32);
      const float mean = sum * (1.f / 64.f);
      float vs = 0.f;
#pragma unroll
      for (int pp = 0; pp < 2; ++pp)
#pragma unroll
        for (int e2 = 0; e2 < 8; ++e2) { const float d = y[pp][e2] - mean; vs += d * d; }
      vs += __shfl_xor(vs, 16); vs += __shfl_xor(vs, 32);
      const float rstd = rsqrtf(vs * (1.f / 64.f) + 64e-5f);
      const float bon = p.BON[(size_t)head * NT + t];
#pragma unroll
      for (int pp = 0; pp < 2; ++pp) {
        const int f = f0 + wf * 64 + pp * 32 + lq * 8;
        const float4 lwl = *(const float4*)(p.ln_w + f), lwh = *(const float4*)(p.ln_w + f + 4);
        const float4 lbl = *(const float4*)(p.ln_b + f), lbh = *(const float4*)(p.ln_b + f + 4);
        const float lw8[8] = {lwl.x, lwl.y, lwl.z, lwl.w, lwh.x, lwh.y, lwh.z, lwh.w};
        const float lb8[8] = {lbl.x, lbl.y, lbl.z, lbl.w, lbh.x, lbh.y, lbh.z, lbh.w};
        float v8[8];
        unpack_bf8(*(const uint4*)(p.S[1] + HM(t, f)), v8);
        f32x4 oa, ob;
#pragma unroll
        for (int j = 0; j < 4; ++j) {
          oa[j] = ((y[pp][j] - mean) * rstd * lw8[j] + lb8[j] + bon * v8[j]) * g[2 * pp][ti][j];
          ob[j] = ((y[pp][4 + j] - mean) * rstd * lw8[4 + j] + lb8[4 + j] + bon * v8[4 + j]) * g[2 * pp + 1][ti][j];
        }
        store_bf8(p.S[0] + (size_t)t * 1024 + f, oa, ob);
      }
    }
  }
}

DI void phase_gemm_resid(const Params& p, char* lds, const bf16_t* A, const bf16_t* W, int K, int ntm,
                                 const float* xin_l, const float* xin_c, const float* gate) {
  const int lane = threadIdx.x & 63, wave = threadIdx.x >> 6;
  const int wr = wave >> 2, wc = wave & 3;
  const int total = ntm * 4;
  for (int u = blockIdx.x; u < total; u += gridDim.x) {
    int mt, nt; tile_map(u, total, ntm, 4, mt, nt);
    f32x4 acc[2][2][4][2];
    gemm256_tile<true>(W, A, K, nt * 256, mt * 256, lds, acc);
    int lane_o = threadIdx.x & 63; asm volatile("" : "+v"(lane_o));
    const int fr = lane_o & 15, fq = lane_o >> 4;
#pragma unroll
    for (int bj = 0; bj < 2; ++bj)
#pragma unroll
      for (int n = 0; n < 2; ++n) {
        const int t = mt * 256 + bj * 128 + wc * 32 + n * 16 + fr;
        const int bp = t < NL ? (t >> 12) : 8;
        const float* xi = t < NL ? xin_l + (size_t)t * 1024 : xin_c + (size_t)(t - NL) * 1024;
        float* xo = t < NL ? p.out + (size_t)t * 1024 : p.XC + (size_t)(t - NL) * 1024;
#pragma unroll
        for (int ai = 0; ai < 2; ++ai)
#pragma unroll
          for (int mp = 0; mp < 2; ++mp) {
            const int f = nt * 256 + ai * 128 + wr * 64 + mp * 32 + fq * 8;
            const float4 g0 = *(const float4*)(gate + bp * 6144 + f), g1 = *(const float4*)(gate + bp * 6144 + f + 4);
            const float4 x0 = *(const float4*)(xi + f), x1 = *(const float4*)(xi + f + 4);
            const f32x4 a = acc[ai][bj][2 * mp][n], b = acc[ai][bj][2 * mp + 1][n];
            *(float4*)(xo + f) = make_float4(x0.x + g0.x * a[0], x0.y + g0.y * a[1], x0.z + g0.z * a[2], x0.w + g0.w * a[3]);
            *(float4*)(xo + f + 4) = make_float4(x1.x + g1.x * b[0], x1.y + g1.y * b[1], x1.z + g1.z * b[2], x1.w + g1.w * b[3]);
          }
      }
  }
}

DI void phase_up(const Params& p, char* lds, const bf16_t* H, const bf16_t* W, bf16_t* U, int ntm) {
  const int lane = threadIdx.x & 63, wave = threadIdx.x >> 6;
  const int wr = wave >> 2, wc = wave & 3;
  const int total = ntm * 16;
  for (int u = blockIdx.x; u < total; u += gridDim.x) {
    int mt, nt; tile_map(u, total, ntm, 16, mt, nt);
    f32x4 acc[2][2][4][2];
    gemm256_tile<true>(W, H, 1024, nt * 256, mt * 256, lds, acc);
    int lane_o = threadIdx.x & 63; asm volatile("" : "+v"(lane_o));
    const int fr = lane_o & 15, fq = lane_o >> 4;
#pragma unroll
    for (int bj = 0; bj < 2; ++bj)
#pragma unroll
      for (int n = 0; n < 2; ++n) {
        const int t = mt * 256 + bj * 128 + wc * 32 + n * 16 + fr;
#pragma unroll
        for (int ai = 0; ai < 2; ++ai)
#pragma unroll
          for (int mp = 0; mp < 2; ++mp) {
            const int f = nt * 256 + ai * 128 + wr * 64 + mp * 32 + fq * 8;
            f32x4 a = acc[ai][bj][2 * mp][n], b = acc[ai][bj][2 * mp + 1][n];
#pragma unroll
            for (int j = 0; j < 4; ++j) { const float ra = fmaxf(a[j], 0.f), rb = fmaxf(b[j], 0.f); a[j] = ra * ra; b[j] = rb * rb; }
            store_bf8(U + (size_t)t * 4096 + f, a, b);
          }
      }
  }
}

DI void phase_qkv(const Params& p, char* lds) {
  const int lane = threadIdx.x & 63, wave = threadIdx.x >> 6;
  const int wr = wave >> 2, wc = wave & 3;
  const int total = (NT / 256) * 6;
  bf16_t* Q = p.S[0]; bf16_t* KA = p.S[1]; bf16_t* VT = p.S[2];
  for (int u = blockIdx.x; u < total; u += gridDim.x) {
    int mt, nt; tile_map(u, total, NT / 256, 6, mt, nt);
    if (mt >= NL / 256 && nt < 4) continue;
    f32x4 acc[2][2][4][2];
    gemm256_tile<false>(p.wqkvT, p.S[5], 1024, nt * 256, mt * 256, lds, acc);
    int lane_o = threadIdx.x & 63; asm volatile("" : "+v"(lane_o));
    const int fr = lane_o & 15, fq = lane_o >> 4;
#pragma unroll
    for (int bj = 0; bj < 2; ++bj)
#pragma unroll
      for (int n = 0; n < 2; ++n) {
        const int t = mt * 256 + bj * 128 + wc * 32 + n * 16 + fr;
        const bool lat = t < NL;
        const int b = lat ? (t >> 12) : ((t - NL) >> 8);
        const int key = lat ? (t & 4095) : 4096 + ((t - NL) & 255);
#pragma unroll
        for (int ai = 0; ai < 2; ++ai) {
          const int hh = ai * 2 + wr;
          asm volatile("" ::: "memory");
          if (nt < 5) {
            float ss = 0.f;
#pragma unroll
            for (int m = 0; m < 4; ++m)
#pragma unroll
              for (int j = 0; j < 4; ++j) ss += acc[ai][bj][m][n][j] * acc[ai][bj][m][n][j];
            ss += __shfl_xor(ss, 16); ss += __shfl_xor(ss, 32);
            const float rstd = rsqrtf(ss * (1.f / 64.f) + 1e-6f);
            const float* gn = nt < 4 ? p.q_norm : p.k_norm;
            float v[4][4];
#pragma unroll
            for (int m = 0; m < 4; ++m) {
              const float4 g4 = *(const float4*)(gn + m * 16 + fq * 4);
              v[m][0] = acc[ai][bj][m][n][0] * rstd * g4.x; v[m][1] = acc[ai][bj][m][n][1] * rstd * g4.y;
              v[m][2] = acc[ai][bj][m][n][2] * rstd * g4.z; v[m][3] = acc[ai][bj][m][n][3] * rstd * g4.w;
            }
            if (lat) {
              const int s = t & 4095, rowp = s >> 6, colp = s & 63;
#pragma unroll
              for (int j = 0; j < 4; ++j) {
                const float2 cs0 = *(const float2*)(p.TAB + (rowp * 16 + fq * 4 + j) * 2);
                const float2 cs1 = *(const float2*)(p.TAB + (colp * 16 + fq * 4 + j) * 2);
                const float x1 = v[0][j], x2 = v[1][j], z1 = v[2][j], z2 = v[3][j];
                v[0][j] = x1 * cs0.x - x2 * cs0.y; v[1][j] = x2 * cs0.x + x1 * cs0.y;
                v[2][j] = z1 * cs1.x - z2 * cs1.y; v[3][j] = z2 * cs1.x + z1 * cs1.y;
              }
            }
            if (nt < 4) {
              const float qs = 0.125f * 1.4426950408889634f;
              const int head = nt * 4 + hh;
#pragma unroll
              for (int m = 0; m < 4; ++m)
                store_bf4(Q + (size_t)t * 1024 + head * 64 + m * 16 + fq * 4, v[m][0] * qs, v[m][1] * qs, v[m][2] * qs, v[m][3] * qs);
            } else {
#pragma unroll
              for (int m = 0; m < 4; ++m)
                store_bf4(KA + ((size_t)(b * 4 + hh) * NKEY + key) * 64 + m * 16 + fq * 4, v[m][0], v[m][1], v[m][2], v[m][3]);
            }
          } else {
#pragma unroll
            for (int m = 0; m < 4; ++m)
#pragma unroll
              for (int j = 0; j < 4; ++j) {
                const int d = m * 16 + fq * 4 + j;
                const unsigned pk = pack2(acc[ai][bj][m][n][j], 0.f);
                VT[((size_t)(b * 4 + hh) * 64 + d) * NKEY + key] = (bf16_t)(pk & 0xffffu);
              }
          }
        }
      }
  }
}

DI void phase_attn(const Params& p, char* lds) {
  const int tid = threadIdx.x, lane = tid & 63, wave = tid >> 6;
  const int l31 = lane & 31, lh = lane >> 5;
  const int srow = tid >> 3, sch = tid & 7;
  const bf16_t* Q = p.S[0]; const bf16_t* KA = p.S[1]; const bf16_t* VT = p.S[2]; bf16_t* O = p.S[3];
  float gq = 0.f, gk = 0.f;
  for (int i = 0; i < 64; ++i) { gq = fmaxf(gq, fabsf(p.q_norm[i])); gk = fmaxf(gk, fabsf(p.k_norm[i])); }
  const float M2 = 8.f * gq * gk * 1.4426950408889634f;
  constexpr int NKT = NKEY / 128;
  constexpr int VROW = 272;
  constexpr int KST = 128 * ROWB;
  constexpr int AST = KST + 64 * VROW;
  for (int u = blockIdx.x; u < 1024; u += gridDim.x) {
    const int qb = u & 7, head = (u >> 3) & 15, b = u >> 7, kvh = head >> 2;
    const bf16_t* Kg = KA + (size_t)(b * 4 + kvh) * NKEY * 64;
    const bf16_t* Vg = VT + (size_t)(b * 4 + kvh) * 64 * NKEY;
    const int tq0 = b * 4096 + qb * 512 + wave * 64 + l31;
    bf16x8 qf[2][4];
#pragma unroll
    for (int blk = 0; blk < 2; ++blk)
#pragma unroll
      for (int s = 0; s < 4; ++s) qf[blk][s] = *(const bf16x8*)(Q + (size_t)(tq0 + blk * 32) * 1024 + head * 64 + s * 16 + lh * 8);
    f32x16 o[2][2];
#pragma unroll
    for (int blk = 0; blk < 2; ++blk)
#pragma unroll
      for (int dt = 0; dt < 2; ++dt)
#pragma unroll
        for (int i = 0; i < 16; ++i) o[blk][dt][i] = 0.f;
    float lsum[2] = {0.f, 0.f};
    uint4 kr = make_uint4(0, 0, 0, 0), vr = kr;
    __syncthreads();
    for (int kt = -1; kt < NKT; ++kt) {
      const bool more = kt + 1 < NKT;
#pragma unroll 1
      for (int hf = 0; hf < 2; ++hf) {
        if (more) {
          kr = *(const uint4*)(Kg + (size_t)((kt + 1) * 128 + hf * 64 + srow) * 64 + sch * 8);
          vr = *(const uint4*)(Vg + (size_t)srow * NKEY + (kt + 1) * 128 + hf * 64 + sch * 8);
        }
        if (kt >= 0) {
          const char* ksm = lds + (kt & 1) * AST + hf * 64 * ROWB;
          const char* vsm = lds + (kt & 1) * AST + KST + hf * 128;
          f32x16 sT[2][2];
#pragma unroll
          for (int blk = 0; blk < 2; ++blk)
#pragma unroll
            for (int k2 = 0; k2 < 2; ++k2)
#pragma unroll
              for (int i = 0; i < 16; ++i) sT[blk][k2][i] = -M2;
#pragma unroll
          for (int k2 = 0; k2 < 2; ++k2)
#pragma unroll
            for (int s = 0; s < 4; ++s) {
              const bf16x8 kf = *(const bf16x8*)(ksm + (k2 * 32 + l31) * ROWB + s * 32 + lh * 16);
              sT[0][k2] = MFMA32(kf, qf[0][s], sT[0][k2]);
              sT[1][k2] = MFMA32(kf, qf[1][s], sT[1][k2]);
            }
#pragma unroll
          for (int blk = 0; blk < 2; ++blk)
#pragma unroll
            for (int k2 = 0; k2 < 2; ++k2)
#pragma unroll
              for (int i = 0; i < 16; ++i) { const float pv = __builtin_amdgcn_exp2f(sT[blk][k2][i]); lsum[blk] += pv; sT[blk][k2][i] = pv; }
#pragma unroll
          for (int k2 = 0; k2 < 2; ++k2)
#pragma unroll
            for (int s2 = 0; s2 < 2; ++s2) {
              bf16x8 pf[2];
#pragma unroll
              for (int blk = 0; blk < 2; ++blk) {
                uint4 pk;
                pk.x = pack2(sT[blk][k2][8 * s2 + 0], sT[blk][k2][8 * s2 + 1]); pk.y = pack2(sT[blk][k2][8 * s2 + 2], sT[blk][k2][8 * s2 + 3]);
                pk.z = pack2(sT[blk][k2][8 * s2 + 4], sT[blk][k2][8 * s2 + 5]); pk.w = pack2(sT[blk][k2][8 * s2 + 6], sT[blk][k2][8 * s2 + 7]);
                pf[blk] = __builtin_bit_cast(bf16x8, pk);
              }
              const int koff = (k2 * 32 + 16 * s2 + 4 * lh) * 2;
#pragma unroll
              for (int dt = 0; dt < 2; ++dt) {
                const uint2 lo = *(const uint2*)(vsm + (dt * 32 + l31) * VROW + koff), hi = *(const uint2*)(vsm + (dt * 32 + l31) * VROW + koff + 16);
                const bf16x8 vv = __builtin_bit_cast(bf16x8, make_uint4(lo.x, lo.y, hi.x, hi.y));
                o[0][dt] = MFMA32(vv, pf[0], o[0][dt]);
                o[1][dt] = MFMA32(vv, pf[1], o[1][dt]);
              }
            }
        }
        if (more) {
          char* st = lds + ((kt + 1) & 1) * AST;
          *(uint4*)(st + (hf * 64 + srow) * ROWB + sch * 16) = kr;
          *(uint4*)(st + KST + srow * VROW + hf * 128 + sch * 16) = vr;
        }
      }
      __syncthreads();
    }
#pragma unroll
    for (int blk = 0; blk < 2; ++blk) {
      float ls = lsum[blk];
      ls += __shfl_xor(ls, 32);
      const float inv = 1.f / ls;
      const int tq = tq0 + blk * 32;
#pragma unroll
      for (int g = 0; g < 4; ++g) {
        const int d0 = 8 * g + 4 * lh;
        store_bf4(O + (size_t)tq * 1024 + head * 64 + d0, o[blk][0][4 * g] * inv, o[blk][0][4 * g + 1] * inv, o[blk][0][4 * g + 2] * inv, o[blk][0][4 * g + 3] * inv);
        store_bf4(O + (size_t)tq * 1024 + head * 64 + 32 + d0, o[blk][1][4 * g] * inv, o[blk][1][4 * g + 1] * inv, o[blk][1][4 * g + 2] * inv, o[blk][1][4 * g + 3] * inv);
      }
    }
  }
}

#define XB_TMO      128
#define XB_XCNT(j)  (256  + 64 * (j))
#define XB_XSUB(j)  (1280 + 64 * (j))
#define XB_XGEN(j)  (2304 + 64 * (j))
#define XB_TOP      3328
#define XB_TOPGEN   3392
#define XCD_BAR_WORDS 3456
#define XB_SPIN_CAP (1u << 18)
#define LAS __attribute__((address_space(3)))

__device__ __forceinline__ unsigned xb_ld(unsigned* p)              { return __hip_atomic_load(p, __ATOMIC_RELAXED, __HIP_MEMORY_SCOPE_AGENT); }
__device__ __forceinline__ unsigned xb_add(unsigned* p, unsigned v) { return __hip_atomic_fetch_add(p, v, __ATOMIC_RELAXED, __HIP_MEMORY_SCOPE_AGENT); }
__device__ __forceinline__ unsigned xb_xcc_id() { return (unsigned)__builtin_amdgcn_s_getreg((3 << 11) | 20) & 0xFu; }
#define XB_SPIN(cond, bar) do { unsigned _sp = 0; while (cond) { __builtin_amdgcn_s_sleep(1); \
    if ((++_sp & 255u) == 0u) { if (xb_ld(&(bar)[XB_TMO])) break; if (_sp > XB_SPIN_CAP) { atomicAdd(&(bar)[XB_TMO], 1u); break; } } } } while (0)

struct XcdBarrier {
    unsigned* bar; unsigned x;
    volatile LAS unsigned* st;
};

__device__ __forceinline__ XcdBarrier xcd_barrier_post(unsigned* bar, volatile LAS unsigned* st) {
    XcdBarrier b; b.bar = bar; b.x = xb_xcc_id(); b.st = st;
    if (threadIdx.x == 0) (void)xb_add(&bar[XB_XCNT(b.x)], 1u);
    return b;
}
__device__ __forceinline__ void xcd_barrier_complete(unsigned* bar, unsigned x, unsigned& nloc, unsigned& nx) {
    const unsigned G = gridDim.x * gridDim.y * gridDim.z;
    unsigned sum, cnt, mine, sp = 0u;
    for (;;) {
        sum = 0u; cnt = 0u; mine = 0u;
#pragma unroll
        for (unsigned j = 0; j < 16; ++j) { const unsigned c = xb_ld(&bar[XB_XCNT(j)]); sum += c; cnt += (c > 0u) ? 1u : 0u; mine = (j == x) ? c : mine; }
        if (sum == G) break;
        __builtin_amdgcn_s_sleep(1);
        if ((++sp & 255u) == 0u) { if (xb_ld(&bar[XB_TMO])) break; if (sp > XB_SPIN_CAP) { atomicAdd(&bar[XB_TMO], 1u); break; } }
    }
    nloc = mine > 0u ? mine : 1u; nx = cnt > 0u ? cnt : 1u;
}

__device__ __forceinline__ void xcd_barrier(const XcdBarrier& b) {
    asm volatile("s_waitcnt vmcnt(0)" ::: "memory");
    __syncthreads();
    if (threadIdx.x == 0) {
        unsigned* bar = b.bar;
        __builtin_amdgcn_s_waitcnt(0);
        unsigned nloc = b.st[0], nx = b.st[1];
        if (nloc == 0u) { xcd_barrier_complete(bar, b.x, nloc, nx); b.st[0] = nloc; b.st[1] = nx; }
        const unsigned old = xb_add(&bar[XB_XSUB(b.x)], 1u);
        const unsigned gen = old / nloc;
        if (old + 1u == (gen + 1u) * nloc) {
            __builtin_amdgcn_fence(__ATOMIC_RELEASE, "agent");
            asm volatile("s_waitcnt vmcnt(0)" ::: "memory");
            const unsigned og = xb_add(&bar[XB_TOP], 1u);
            const unsigned tg = og / nx;
            if (og + 1u == (tg + 1u) * nx) xb_add(&bar[XB_TOPGEN], 1u);
            else XB_SPIN(xb_ld(&bar[XB_TOPGEN]) == tg, bar);
            __builtin_amdgcn_fence(__ATOMIC_ACQUIRE, "agent");
            xb_add(&bar[XB_XGEN(b.x)], 1u);
            asm volatile("s_waitcnt vmcnt(0)" ::: "memory");
        } else {
            XB_SPIN(xb_ld(&bar[XB_XGEN(b.x)]) == gen, bar);
            __builtin_amdgcn_fence(__ATOMIC_ACQUIRE, "agent");
            asm volatile("s_waitcnt vmcnt(0)" ::: "memory");
        }
    }
    __syncthreads();
}


DI void run_phase(const Params& p, int ph, char* lds) {
  const float* mod0 = p.MOD;
  const float* mod1 = p.MOD + 9 * 6144;
  switch (ph) {
    case 0: phase0(p, lds); break;
    case 1: norm_mod_phase(p.x, p.ctx, p.norm_mix, mod0, 0, 1, p.Hd, NT); break;
    case 2: phase_proj(p, lds); break;
    case 20: phase_mix(p); break;
    case 3: phase_prep(p, lds); break;
    case 4: phase_scan(p, lds); break;
    case 5: phase_readout(p, lds); break;
    case 6: phase_gemm_resid(p, lds, p.S[0], p.woT, 1024, NT / 256, p.x, p.ctx, mod0 + 2 * 1024); break;
    case 7: norm_mod_phase(p.out, p.XC, p.norm_mlp, mod0, 3, 4, p.S[5], NT); break;
    case 8: phase_up(p, lds, p.S[5], p.w1T[0], p.S[0], NT / 256); break;
    case 9: phase_gemm_resid(p, lds, p.S[0], p.w2T[0], 4096, NT / 256, p.out, p.XC, mod0 + 5 * 1024); break;
    case 10: norm_mod_phase(p.out, p.XC, p.norm_mix + 1024, mod1, 0, 1, p.S[5], NT); break;
    case 11: phase_qkv(p, lds); break;
    case 12: phase_attn(p, lds); break;
    case 13: phase_gemm_resid(p, lds, p.S[3], p.awoT, 1024, NL / 256, p.out, p.XC, mod1 + 2 * 1024); break;
    case 14: norm_mod_phase(p.out, p.XC, p.norm_mlp + 1024, mod1, 3, 4, p.S[5], NL); break;
    case 15: phase_up(p, lds, p.S[5], p.w1T[1], p.S[0], NL / 256); break;
    case 16: phase_gemm_resid(p, lds, p.S[0], p.w2T[1], 4096, NL / 256, p.out, p.XC, mod1 + 5 * 1024); break;
    case 17: final_norm_phase(p); break;
  }
}
constexpr int NPHASE = 18;

__global__ void __launch_bounds__(NTHREADS) mega_kernel(Params p) {
  extern __shared__ __attribute__((aligned(16))) char lds[];
  cg::grid_group grid = cg::this_grid();
  volatile LAS unsigned* st = (volatile LAS unsigned*)(LAS char*)(lds + 131072);
  if (threadIdx.x == 0) { st[0] = 0u; st[1] = 0u; }
  if (blockIdx.x == 0) for (int i = threadIdx.x; i < XCD_BAR_WORDS; i += NTHREADS) p.BAR[i] = 0u;
  __syncthreads();
  run_phase(p, 0, lds);
  grid.sync();
  const XcdBarrier xb = xcd_barrier_post(p.BAR, st);
#define PH(n) run_phase(p, n, lds); xcd_barrier(xb);
  PH(1) PH(20) PH(2) PH(3) PH(4) PH(5) PH(6) PH(7) PH(8) PH(9) PH(10) PH(11) PH(12) PH(13) PH(14) PH(15) PH(16)
  run_phase(p, 17, lds);
}

extern "C" void kernel_launch(void* const* d_in, const int* in_sizes, int n_in, void* d_out, int out_size, void* d_ws, size_t ws_size, hipStream_t stream) {
  Params p;
  memset(&p, 0, sizeof(p));
  const float* const* in = (const float* const*)d_in;
  p.x = in[0]; p.c = in[1]; p.ctx = in[2]; p.c_ctx = in[3]; p.w_mod = in[4]; p.b_mod = in[5]; p.norm_mix = in[6]; p.norm_mlp = in[7];
  p.mlp_w1 = in[8]; p.mlp_w2 = in[9]; p.mu = in[10]; p.wr = in[11]; p.wk = in[12]; p.wv = in[13]; p.wo = in[14]; p.w0 = in[15]; p.w1 = in[16];
  p.w2 = in[17]; p.a0 = in[18]; p.a1 = in[19]; p.a2 = in[20]; p.g1 = in[21]; p.g2 = in[22]; p.k_k = in[23]; p.k_a = in[24]; p.r_k = in[25];
  p.ln_w = in[26]; p.ln_b = in[27]; p.wqkv = in[28]; p.q_norm = in[29]; p.k_norm = in[30]; p.awo = in[31]; p.final_norm = in[32];
  p.out = (float*)d_out;
  char* ws = (char*)d_ws;
  size_t off = 0;
  auto take = [&](size_t bytes) -> char* { char* r = ws + off; off += (bytes + 255) & ~(size_t)255; return r; };
  p.Wcat = (bf16_t*)take((size_t)3456 * 1024 * 2);
  p.L2w = (bf16_t*)take((size_t)4 * 65536 * 2);
  p.g2T = (bf16_t*)take((size_t)1024 * 128 * 2);
  p.woT = (bf16_t*)take((size_t)1024 * 1024 * 2);
  p.w1T[0] = (bf16_t*)take((size_t)4096 * 1024 * 2);
  p.w1T[1] = (bf16_t*)take((size_t)4096 * 1024 * 2);
  p.w2T[0] = (bf16_t*)take((size_t)4096 * 1024 * 2);
  p.w2T[1] = (bf16_t*)take((size_t)4096 * 1024 * 2);
  p.wqkvT = (bf16_t*)take((size_t)1536 * 1024 * 2);
  p.awoT = (bf16_t*)take((size_t)1024 * 1024 * 2);
  p.MOD = (float*)take((size_t)2 * 9 * 6144 * 4);
  p.TAB = (float*)take((size_t)1024 * 2 * 4);
  p.XC = (float*)take((size_t)NC * 1024 * 4);
  p.BAR = (unsigned*)take((size_t)XCD_BAR_WORDS * 4);
  for (int i = 0; i < 6; ++i) p.S[i] = (bf16_t*)take((size_t)NT * 1024 * 2);
  if (off > ws_size) { fprintf(stderr, "kernel_launch: workspace too small (%zu needed, %zu given)\n", off, ws_size); return; }
  char* ob = (char*)d_out;
  p.Hd = (bf16_t*)ob;
  p.L1 = (bf16_t*)(ob + (size_t)NT * 1024 * 2);
  p.BON = (float*)(ob + (size_t)NT * 1024 * 2 + (size_t)NT * 384 * 2);
  p.NRM = (float*)(ob + (size_t)NT * 1024 * 2 + (size_t)NT * 384 * 2 + (size_t)NT * 16 * 4);
  int nj = 0, tiles = 0;
  auto job = [&](const float* src, bf16_t* dst, int K, int N) {
    p.jobs[nj].src = src; p.jobs[nj].dst = dst; p.jobs[nj].K = K; p.jobs[nj].N = N; p.jobs[nj].tstart = tiles; p.jobs[nj].tiles_n = N / 64;
    tiles += (K / 64) * (N / 64); ++nj;
  };
  job(p.wr, p.Wcat, 1024, 1024);
  job(p.wk, p.Wcat + (size_t)1024 * 1024, 1024, 1024);
  job(p.wv, p.Wcat + (size_t)2048 * 1024, 1024, 1024);
  job(p.g1, p.Wcat + (size_t)3072 * 1024, 1024, 128);
  job(p.w1, p.Wcat + (size_t)3200 * 1024, 1024, 64);
  job(p.w1 + 65536, p.Wcat + (size_t)3264 * 1024, 1024, 64);
  job(p.a1, p.Wcat + (size_t)3328 * 1024, 1024, 64);
  job(p.a1 + 65536, p.Wcat + (size_t)3392 * 1024, 1024, 64);
  job(p.a2, p.L2w, 64, 1024);
  job(p.a2 + 65536, p.L2w + 65536, 64, 1024);
  job(p.w2, p.L2w + 2 * 65536, 64, 1024);
  job(p.w2 + 65536, p.L2w + 3 * 65536, 64, 1024);
  job(p.g2, p.g2T, 128, 1024);
  job(p.wo, p.woT, 1024, 1024);
  job(p.mlp_w1, p.w1T[0], 1024, 4096);
  job(p.mlp_w1 + (size_t)4096 * 1024, p.w1T[1], 1024, 4096);
  job(p.mlp_w2, p.w2T[0], 4096, 1024);
  job(p.mlp_w2 + (size_t)4096 * 1024, p.w2T[1], 4096, 1024);
  job(p.wqkv, p.wqkvT, 1024, 1536);
  job(p.awo, p.awoT, 1024, 1024);
  p.njobs = nj; p.total_tiles = tiles;

  static int grid_blocks = 0;
  if (!grid_blocks) {
    (void)hipFuncSetAttribute((const void*)mega_kernel, hipFuncAttributeMaxDynamicSharedMemorySize, LDS_BYTES);
    int dev = 0, cus = 0, per_cu = 0;
    (void)hipGetDevice(&dev);
    (void)hipDeviceGetAttribute(&cus, hipDeviceAttributeMultiprocessorCount, dev);
    if (hipOccupancyMaxActiveBlocksPerMultiprocessor(&per_cu, (const void*)mega_kernel, NTHREADS, LDS_BYTES) != hipSuccess || per_cu < 1) per_cu = 1;
    if (cus <= 0) cus = 256;
    grid_blocks = cus * per_cu;
    (void)hipGetLastError();
  }
  void* args[] = {&p};
  hipError_t e = hipLaunchCooperativeKernel((const void*)mega_kernel, dim3(grid_blocks), dim3(NTHREADS), args, LDS_BYTES, stream);
  if (e != hipSuccess) fprintf(stderr, "cooperative launch failed: %s (grid %d)\n", hipGetErrorString(e), grid_blocks);
}
```

```cpp
#include <hip/hip_runtime.h>
#include <hip/hip_cooperative_groups.h>
#include <cstdint>
#include <cstring>
#include <cstdio>
namespace cg = cooperative_groups;

typedef unsigned short bf16_t;
typedef short bf16x8 __attribute__((ext_vector_type(8)));
typedef float f32x2 __attribute__((ext_vector_type(2)));
typedef float f32x4 __attribute__((ext_vector_type(4)));
typedef float f32x16 __attribute__((ext_vector_type(16)));
typedef __bf16 bf16x2_t __attribute__((ext_vector_type(2)));
#define DI __device__ __forceinline__

constexpr int D = 1024, NB = 8, SEQ = 4096, CTXL = 256;
constexpr int NL = NB * SEQ, NC = NB * CTXL, NT = NL + NC, DFF = 4096;
constexpr int NKEY = SEQ + CTXL;
constexpr int NTHREADS = 512;
constexpr int ROWB = 144;
constexpr int GEMM_STAGE = (256 + 128) * ROWB;
constexpr int LDS_BYTES = 131072 + 16;

struct TJob { const float* src; bf16_t* dst; int K, N, tstart, tiles_n; };

struct Params {
  const float *x, *c, *ctx, *c_ctx, *w_mod, *b_mod, *norm_mix, *norm_mlp, *mlp_w1, *mlp_w2;
  const float *mu, *wr, *wk, *wv, *wo, *w0, *w1, *w2, *a0, *a1, *a2, *g1, *g2, *k_k, *k_a, *r_k, *ln_w, *ln_b;
  const float *wqkv, *q_norm, *k_norm, *awo, *final_norm;
  float* out;
  bf16_t *Wcat, *L2w, *g2T, *woT, *w1T[2], *w2T[2], *wqkvT, *awoT;
  float *MOD, *TAB, *XC;
  bf16_t* S[6];
  bf16_t *Hd, *L1;
  float* BON;
  float* NRM;
  unsigned* BAR;
  TJob jobs[20];
  int njobs, total_tiles;
};

DI size_t HM(int t, int f) { return ((size_t)(f >> 6) * NT + t) * 64 + (f & 63); }
DI unsigned pack2(float lo, float hi) {
  f32x2 v = {lo, hi};
  bf16x2_t b = __builtin_convertvector(v, bf16x2_t);
  return __builtin_bit_cast(unsigned, b);
}
DI float bflo(unsigned u) { return __uint_as_float(u << 16); }
DI float bfhi(unsigned u) { return __uint_as_float(u & 0xffff0000u); }
DI void store_bf4(bf16_t* p, float a, float b, float c, float d) { *(uint2*)p = make_uint2(pack2(a, b), pack2(c, d)); }
DI void load_bf4(const bf16_t* p, float& a, float& b, float& c, float& d) { uint2 u = *(const uint2*)p; a = bflo(u.x); b = bfhi(u.x); c = bflo(u.y); d = bfhi(u.y); }
DI void store_bf8(bf16_t* p, const f32x4& a, const f32x4& b) {
  uint4 o; o.x = pack2(a[0], a[1]); o.y = pack2(a[2], a[3]); o.z = pack2(b[0], b[1]); o.w = pack2(b[2], b[3]);
  *(uint4*)p = o;
}
DI void store16_sc1(void* p, const uint4& v) {
  typedef unsigned u32x4_t __attribute__((ext_vector_type(4)));
  const u32x4_t d = {v.x, v.y, v.z, v.w};
  asm volatile("global_store_dwordx4 %0, %1, off sc1" :: "v"(p), "v"(d) : "memory");
}
DI void unpack_bf8(const uint4& u, float (&o)[8]) {
  o[0] = bflo(u.x); o[1] = bfhi(u.x); o[2] = bflo(u.y); o[3] = bfhi(u.y); o[4] = bflo(u.z); o[5] = bfhi(u.z); o[6] = bflo(u.w); o[7] = bfhi(u.w);
}
DI int perm32(int rho) { return 8 * ((rho & 15) >> 2) + 4 * (rho >> 4) + (rho & 3); }
DI float sigmoidf_(float x) { return 1.f / (1.f + __expf(-x)); }
DI float tanhf_(float x) { return 1.f - 2.f / (1.f + __expf(2.f * x)); }
DI float wave_sum(float x) {
#pragma unroll
  for (int m = 1; m < 64; m <<= 1) x += __shfl_xor(x, m);
  return x;
}
#define MFMA16(a, b, c) __builtin_amdgcn_mfma_f32_16x16x32_bf16((a), (b), (c), 0, 0, 0)
#define MFMA32(a, b, c) __builtin_amdgcn_mfma_f32_32x32x16_bf16((a), (b), (c), 0, 0, 0)

DI unsigned lerp2(unsigned a, unsigned n, float ma, float mb) {
  const float h0 = bflo(a), h1 = bfhi(a), s0 = bflo(n), s1 = bfhi(n);
  return pack2(h0 + (s0 - h0) * ma, h1 + (s1 - h1) * mb);
}
template <bool LERP>
DI void gemm_tile(const bf16_t* __restrict__ X, int ldx, const bf16_t* __restrict__ W, int ldw, int K, int tok0, int f0,
                  char* lds, f32x4 (&acc)[4][4], const float* __restrict__ mu) {
  const int tid = threadIdx.x, lane = tid & 63, wave = tid >> 6;
  const int wt = wave & 3, wf = wave >> 2, lr = lane & 15, lq = lane >> 4;
  const int lrow = tid >> 3, kc = tid & 7;
#pragma unroll
  for (int i = 0; i < 4; ++i)
#pragma unroll
    for (int j = 0; j < 4; ++j) acc[i][j] = f32x4{0.f, 0.f, 0.f, 0.f};
  uint4 xr[4], wr[2], xn[4];
  float4 m0 = make_float4(0, 0, 0, 0), m1 = m0;
  const int nk = K >> 6;
  __syncthreads();
  for (int kt = -1; kt < nk; ++kt) {
    const bool more = kt + 1 < nk;
    if (more) {
      const int k0 = (kt + 1) << 6;
#pragma unroll
      for (int i = 0; i < 4; ++i) {
        const int tg = tok0 + lrow + 64 * i;
        xr[i] = *(const uint4*)(X + (size_t)tg * ldx + k0 + kc * 8);
        if (LERP) {
          int nb; bool valid;
          if (tok0 < NL) {
            const int s = tg & 4095, col = s & 63, rw = s >> 6, qd = k0 >> 8;
            if (qd == 0) { valid = col > 0; nb = tg - 1; }
            else if (qd == 1) { valid = col < 63; nb = tg + 1; }
            else if (qd == 2) { valid = rw > 0; nb = tg - 64; }
            else { valid = rw < 63; nb = tg + 64; }
          } else {
            const int s = (tg - NL) & 255;
            if (k0 < 512) { valid = s > 0; nb = tg - 1; }
            else { valid = s < 255; nb = tg + 1; }
          }
          if (valid) xn[i] = *(const uint4*)(X + (size_t)nb * ldx + k0 + kc * 8);
          else xn[i] = make_uint4(0, 0, 0, 0);
        }
      }
#pragma unroll
      for (int i = 0; i < 2; ++i) wr[i] = *(const uint4*)(W + (size_t)(f0 + 64 * i + (lrow & 32) + perm32(lrow & 31)) * ldw + k0 + kc * 8);
      if (LERP) { m0 = *(const float4*)(mu + k0 + kc * 8); m1 = *(const float4*)(mu + k0 + kc * 8 + 4); }
    }
    if (kt >= 0) {
      const char* xs = lds + (kt & 1) * GEMM_STAGE;
      const char* wsm = xs + 256 * ROWB;
#pragma unroll
      for (int ks = 0; ks < 2; ++ks) {
        bf16x8 wfr[4], xfr[4];
#pragma unroll
        for (int i = 0; i < 4; ++i) wfr[i] = *(const bf16x8*)(wsm + (wf * 64 + i * 16 + lr) * ROWB + ks * 64 + lq * 16);
#pragma unroll
        for (int i = 0; i < 4; ++i) xfr[i] = *(const bf16x8*)(xs + (wt * 64 + i * 16 + lr) * ROWB + ks * 64 + lq * 16);
#pragma unroll
        for (int fi = 0; fi < 4; ++fi)
#pragma unroll
          for (int ti = 0; ti < 4; ++ti) acc[fi][ti] = MFMA16(wfr[fi], xfr[ti], acc[fi][ti]);
      }
    }
    if (more) {
      char* xs = lds + ((kt + 1) & 1) * GEMM_STAGE;
      char* wsm = xs + 256 * ROWB;
#pragma unroll
      for (int i = 0; i < 4; ++i) {
        uint4 v = xr[i];
        if (LERP) {
          v.x = lerp2(xr[i].x, xn[i].x, m0.x, m0.y);
          v.y = lerp2(xr[i].y, xn[i].y, m0.z, m0.w);
          v.z = lerp2(xr[i].z, xn[i].z, m1.x, m1.y);
          v.w = lerp2(xr[i].w, xn[i].w, m1.z, m1.w);
        }
        *(uint4*)(xs + (lrow + 64 * i) * ROWB + kc * 16) = v;
      }
#pragma unroll
      for (int i = 0; i < 2; ++i) *(uint4*)(wsm + (lrow + 64 * i) * ROWB + kc * 16) = wr[i];
    }
    __syncthreads();
  }
}


namespace g256 {
constexpr int BK = 64, HALF = 128, HT = HALF * BK;
DI int lds_byte(int r, int c) { const int st = (r >> 4) * 2 + (c >> 5), rr = r & 15, cc = c & 31, ob = rr * 64 + cc * 2; return st * 1024 + (ob ^ (((ob >> 9) & 1) << 5)); }
DI void stage_rc(int b, int& R, int& C) { const int st = b / 1024, sb = b % 1024, swz = sb ^ (((sb >> 9) & 1) << 5); R = (st >> 1) * 16 + swz / 64; C = (st & 1) * 32 + (swz % 64) / 2; }
}
#define G_SA(b, h) (((b) * 2 + (h)) * 16384)
#define G_SB(b, h) ((4 + (b) * 2 + (h)) * 16384)
#define G_STAGEV(bufoff, gbase, vo) do { _Pragma("unroll") for (int _i = 0; _i < 2; ++_i) \
    __builtin_amdgcn_global_load_lds((const unsigned*)((const char*)(gbase) + (vo)[_i]), (__attribute__((address_space(3))) unsigned*)(lds + (bufoff) + ldsw + _i * 8192), 16, 0, 0); } while (0)
#define G_LDA(dst, b, h) do { _Pragma("unroll") for (int m = 0; m < 4; ++m) _Pragma("unroll") for (int k = 0; k < 2; ++k) \
    dst[m][k] = *(const __attribute__((address_space(3))) bf16x8*)(lds + G_SA(b, h) + aoff + m * 2048 + k * 1024); } while (0)
#define G_LDB(dst, b, h) do { _Pragma("unroll") for (int n = 0; n < 2; ++n) _Pragma("unroll") for (int k = 0; k < 2; ++k) \
    dst[n][k] = *(const __attribute__((address_space(3))) bf16x8*)(lds + G_SB(b, h) + boff + n * 2048 + k * 1024); } while (0)
#define G_MMA(ai, bj, At, Bt) do { __builtin_amdgcn_s_setprio(1); \
    _Pragma("unroll") for (int m = 0; m < 4; ++m) _Pragma("unroll") for (int n = 0; n < 2; ++n) _Pragma("unroll") for (int k = 0; k < 2; ++k) \
      acc[ai][bj][m][n] = __builtin_amdgcn_mfma_f32_16x16x32_bf16(At[m][k], Bt[n][k], acc[ai][bj][m][n], 0, 0, 0); \
    __builtin_amdgcn_s_setprio(0); } while (0)
#define G_WAIT_V(n) asm volatile("s_waitcnt vmcnt(" #n ")" ::: "memory")
#define G_WAIT_L(n) asm volatile("s_waitcnt lgkmcnt(" #n ")" ::: "memory")
#define G_BAR __builtin_amdgcn_s_barrier()
#define G_SCHED __builtin_amdgcn_sched_barrier(0)

template <bool PERM>
DI void gemm256_tile(const bf16_t* __restrict__ A, const bf16_t* __restrict__ Bt, int K, int brow, int bcol, char* lds_, f32x4 (&acc)[2][2][4][2]) {
  __attribute__((address_space(3))) unsigned char* lds = (__attribute__((address_space(3))) unsigned char*)lds_;
  int tid = threadIdx.x; asm volatile("" : "+v"(tid));
  const int wid = __builtin_amdgcn_readfirstlane(tid >> 6), lane = tid & 63, wr = wid >> 2, wc = wid & 3, fr = lane & 15, fq = lane >> 4;
#pragma unroll
  for (int a = 0; a < 2; ++a)
#pragma unroll
    for (int b = 0; b < 2; ++b)
#pragma unroll
      for (int m = 0; m < 4; ++m)
#pragma unroll
        for (int n = 0; n < 2; ++n) acc[a][b][m][n] = f32x4{0.f, 0.f, 0.f, 0.f};
  unsigned voff[2], voffA[2];
#pragma unroll
  for (int i = 0; i < 2; ++i) { int R, C; g256::stage_rc(tid * 16 + i * 8192, R, C); voff[i] = (unsigned)(R * K + C) * 2u;
    const int Ra = PERM ? ((R & ~31) + perm32(R & 31)) : R; voffA[i] = (unsigned)(Ra * K + C) * 2u; }
  const size_t kstep = 128, hstep = (size_t)128 * K * 2;
  const unsigned ldsw = (unsigned)wid * 1024u;
  const int aoff = g256::lds_byte(wr * 64 + fr, fq * 8), boff = g256::lds_byte(wc * 32 + fr, fq * 8);
  const char* cA = (const char*)A + (size_t)brow * K * 2;
  const char* cB = (const char*)Bt + (size_t)bcol * K * 2;
  bf16x8 At[4][2], B0[2][2], B1[2][2];
  const int nt = K / g256::BK;
  __syncthreads();
  G_STAGEV(G_SB(0, 0), cB, voff); G_STAGEV(G_SA(0, 0), cA, voffA); G_STAGEV(G_SB(0, 1), cB + hstep, voff); G_STAGEV(G_SA(0, 1), cA + hstep, voffA);
  if (wr == 1) G_BAR;
  G_WAIT_V(4); G_BAR;
  G_STAGEV(G_SB(1, 0), cB + kstep, voff); G_STAGEV(G_SA(1, 0), cA + kstep, voffA); G_STAGEV(G_SB(1, 1), cB + hstep + kstep, voff);
  G_WAIT_V(6); G_BAR;
  for (int t = 0; t < nt - 2; t += 2) {
    const char* a1 = cA + (size_t)(t + 1) * kstep;
    const char* a2 = cA + (size_t)(t + 2) * kstep; const char* b2 = cB + (size_t)(t + 2) * kstep;
    const char* a3 = a2 + kstep; const char* b3 = b2 + kstep;
    G_LDB(B0, 0, 0); G_SCHED; G_LDA(At, 0, 0); G_STAGEV(G_SA(1, 1), a1 + hstep, voffA);
    G_WAIT_L(8); G_BAR; G_WAIT_L(0); G_MMA(0, 0, At, B0); G_BAR; G_SCHED;
    G_LDB(B1, 0, 1); G_STAGEV(G_SB(0, 0), b2, voff);
    G_BAR; G_WAIT_L(0); G_MMA(0, 1, At, B1); G_BAR;
    G_LDA(At, 0, 1); G_STAGEV(G_SA(0, 0), a2, voffA);
    G_BAR; G_WAIT_L(0); G_MMA(1, 0, At, B0); G_BAR; G_SCHED;
    G_STAGEV(G_SB(0, 1), b2 + hstep, voff);
    G_WAIT_V(6); G_BAR; G_MMA(1, 1, At, B1); G_BAR;
    G_LDB(B0, 1, 0); G_SCHED; G_LDA(At, 1, 0); G_STAGEV(G_SA(0, 1), a2 + hstep, voffA);
    G_WAIT_L(8); G_BAR; G_WAIT_L(0); G_MMA(0, 0, At, B0); G_BAR; G_SCHED;
    G_LDB(B1, 1, 1); G_STAGEV(G_SB(1, 0), b3, voff);
    G_BAR; G_WAIT_L(0); G_MMA(0, 1, At, B1); G_BAR;
    G_LDA(At, 1, 1); G_STAGEV(G_SA(1, 0), a3, voffA);
    G_BAR; G_WAIT_L(0); G_MMA(1, 0, At, B0); G_BAR; G_SCHED;
    G_STAGEV(G_SB(1, 1), b3 + hstep, voff);
    G_WAIT_V(6); G_BAR; G_MMA(1, 1, At, B1); G_BAR;
  }
  { G_LDB(B0, 0, 0); G_LDA(At, 0, 0); G_STAGEV(G_SA(1, 1), cA + (size_t)(nt - 1) * kstep + hstep, voffA);
    G_BAR; G_WAIT_L(0); G_MMA(0, 0, At, B0); G_BAR;
    G_LDB(B1, 0, 1); G_BAR; G_WAIT_L(0); G_MMA(0, 1, At, B1); G_BAR;
    G_LDA(At, 0, 1); G_WAIT_V(4); G_BAR; G_WAIT_L(0); G_MMA(1, 0, At, B0); G_MMA(1, 1, At, B1); G_BAR; }
  { G_LDB(B0, 1, 0); G_LDA(At, 1, 0); G_WAIT_V(2); G_BAR; G_WAIT_L(0); G_MMA(0, 0, At, B0); G_BAR;
    G_LDB(B1, 1, 1); G_WAIT_V(0); G_BAR; G_WAIT_L(0); G_MMA(0, 1, At, B1); G_BAR;
    G_LDA(At, 1, 1); G_BAR; G_WAIT_L(0); G_MMA(1, 0, At, B0); G_MMA(1, 1, At, B1); G_BAR; }
  if (wr == 0) G_BAR;
}

DI void tile_map(int L, int total, int ntm, int ntn, int& mt, int& nt) {
  const int q = total >> 3, r = total & 7, xcd = L & 7, off = L >> 3;
  const int id = (xcd < r ? xcd * (q + 1) : r * (q + 1) + (xcd - r) * q) + off;
  const int nig = 8 * ntn, g = id / nig, w = id % nig, fm = g * 8, gsz = min(ntm - fm, 8);
  mt = fm + w % gsz; nt = w / gsz;
}
DI void convert_tile(const TJob& jb, int t, char* lds) {
  float* tile = (float*)lds;
  const int tid = threadIdx.x;
  const int tk = t / jb.tiles_n, tn = t % jb.tiles_n;
  const int k0 = tk * 64, n0 = tn * 64;
  __syncthreads();
#pragma unroll
  for (int i = 0; i < 2; ++i) {
    const int idx = tid + 512 * i, row = idx >> 4, c4 = idx & 15;
    const float4 v = *(const float4*)(jb.src + (size_t)(k0 + row) * jb.N + n0 + c4 * 4);
    tile[row * 65 + c4 * 4 + 0] = v.x; tile[row * 65 + c4 * 4 + 1] = v.y; tile[row * 65 + c4 * 4 + 2] = v.z; tile[row * 65 + c4 * 4 + 3] = v.w;
  }
  __syncthreads();
  const int n = tid >> 3, kc = tid & 7;
  float v[8];
#pragma unroll
  for (int j = 0; j < 8; ++j) v[j] = tile[(kc * 8 + j) * 65 + n];
  uint4 o;
  o.x = pack2(v[0], v[1]); o.y = pack2(v[2], v[3]); o.z = pack2(v[4], v[5]); o.w = pack2(v[6], v[7]);
  *(uint4*)(jb.dst + (size_t)(n0 + n) * jb.K + k0 + kc * 8) = o;
}

DI void mod_unit(const Params& p, int mu_, char* lds) {
  const int tid = threadIdx.x;
  const int layer = mu_ / 96, cc = mu_ % 96;
  float* sc = (float*)lds;
  float* red = sc + 9 * 1024;
  __syncthreads();
  for (int i = tid; i < 9 * 1024; i += 512) {
    const int row = i >> 10, k = i & 1023;
    const float v = row < 8 ? p.c[row * 1024 + k] : p.c_ctx[k];
    sc[i] = v / (1.f + __expf(-v));
  }
  __syncthreads();
  const int kg = tid >> 6, col = tid & 63;
  const float* w = p.w_mod + (size_t)layer * 1024 * 6144 + cc * 64 + col;
  float a[9];
#pragma unroll
  for (int r = 0; r < 9; ++r) a[r] = 0.f;
#pragma unroll 16
  for (int k = kg * 128; k < kg * 128 + 128; ++k) {
    const float wv = w[(size_t)k * 6144];
#pragma unroll
    for (int r = 0; r < 9; ++r) a[r] += sc[r * 1024 + k] * wv;
  }
#pragma unroll
  for (int r = 0; r < 9; ++r) red[(kg * 9 + r) * 64 + col] = a[r];
  __syncthreads();
  for (int i = tid; i < 576; i += 512) {
    const int r = i >> 6, cl = i & 63;
    float s = 0.f;
#pragma unroll
    for (int g = 0; g < 8; ++g) s += red[(g * 9 + r) * 64 + cl];
    const int n = cc * 64 + cl;
    p.MOD[(layer * 9 + r) * 6144 + n] = s + p.b_mod[layer * 6144 + n];
  }
  __syncthreads();
}

DI void sincos_d(double a, double& s, double& c) {
  const double n = rint(a * 0.6366197723675814);
  const double r = (a - n * 1.5707963267948966) - n * 6.123233995736766e-17;
  const double r2 = r * r;
  const double sp = r * (1.0 + r2 * (-1.0 / 6.0 + r2 * (1.0 / 120.0 + r2 * (-1.0 / 5040.0 + r2 * (1.0 / 362880.0 + r2 * (-1.0 / 39916800.0 + r2 * (1.0 / 6227020800.0)))))));
  const double cp = 1.0 + r2 * (-0.5 + r2 * (1.0 / 24.0 + r2 * (-1.0 / 720.0 + r2 * (1.0 / 40320.0 + r2 * (-1.0 / 3628800.0 + r2 * (1.0 / 479001600.0 + r2 * (-1.0 / 87178291200.0)))))));
  const int q = ((int)n) & 3;
  if (q == 0) { s = sp; c = cp; }
  else if (q == 1) { s = cp; c = -sp; }
  else if (q == 2) { s = -sp; c = -cp; }
  else { s = -cp; c = sp; }
}

DI void tab_unit(const Params& p) {
  for (int idx = threadIdx.x; idx < 1024; idx += 512) {
    const int pos = idx >> 4, fi = idx & 15;
    double f = 1.0;
    for (int i = 0; i < fi; ++i) f *= 0.5623413251903491;
    double s, c;
    sincos_d((double)pos * (double)(float)f, s, c);
    p.TAB[idx * 2 + 0] = (float)c;
    p.TAB[idx * 2 + 1] = (float)s;
  }
}

DI void phase0(const Params& p, char* lds) {
  const int total = p.total_tiles + 192 + 1;
  for (int u = blockIdx.x; u < total; u += gridDim.x) {
    if (u < p.total_tiles) {
      int j = 0;
#pragma unroll 1
      for (int q = 1; q < p.njobs; ++q) if (u >= p.jobs[q].tstart) j = q;
      convert_tile(p.jobs[j], u - p.jobs[j].tstart, lds);
    } else if (u < p.total_tiles + 192) {
      mod_unit(p, u - p.total_tiles, lds);
    } else {
      tab_unit(p);
    }
  }
}

DI void norm_mod_phase(const float* __restrict__ xl, const float* __restrict__ xc, const float* __restrict__ gain,
                               const float* __restrict__ mod, int shift_i, int scale_i, bf16_t* __restrict__ H, int ntok) {
  int tid_ = threadIdx.x; asm volatile("" : "+v"(tid_));
  const int lane = tid_ & 63;
  const int wg = blockIdx.x * 8 + (tid_ >> 6), nw = gridDim.x * 8;
  for (int t = wg; t < ntok; t += nw) {
    const float* row = t < NL ? xl + (size_t)t * 1024 : xc + (size_t)(t - NL) * 1024;
    float4 v[4];
    float ss = 0.f;
#pragma unroll
    for (int i = 0; i < 4; ++i) {
      v[i] = *(const float4*)(row + (lane + 64 * i) * 4);
      ss += v[i].x * v[i].x + v[i].y * v[i].y + v[i].z * v[i].z + v[i].w * v[i].w;
    }
    ss = wave_sum(ss);
    const float rstd = rsqrtf(ss * (1.f / 1024.f) + 1e-6f);
    const int bp = t < NL ? (t >> 12) : 8;
    const float* sh = mod + (bp * 6 + shift_i) * 1024;
    const float* sc = mod + (bp * 6 + scale_i) * 1024;
#pragma unroll
    for (int i = 0; i < 4; ++i) {
      const int c = (lane + 64 * i) * 4;
      const float4 g = *(const float4*)(gain + c), s4 = *(const float4*)(sh + c), c4 = *(const float4*)(sc + c);
      store_bf4(H + (size_t)t * 1024 + c,
                v[i].x * rstd * g.x * (1.f + c4.x) + s4.x, v[i].y * rstd * g.y * (1.f + c4.y) + s4.y,
                v[i].z * rstd * g.z * (1.f + c4.z) + s4.z, v[i].w * rstd * g.w * (1.f + c4.w) + s4.w);
    }
  }
}

DI void final_norm_phase(const Params& p) {
  int tid_ = threadIdx.x; asm volatile("" : "+v"(tid_));
  const int lane = tid_ & 63;
  const int wg = blockIdx.x * 8 + (tid_ >> 6), nw = gridDim.x * 8;
  for (int t = wg; t < NL; t += nw) {
    float* row = p.out + (size_t)t * 1024;
    float4 v[4];
    float ss = 0.f;
#pragma unroll
    for (int i = 0; i < 4; ++i) {
      v[i] = *(const float4*)(row + (lane + 64 * i) * 4);
      ss += v[i].x * v[i].x + v[i].y * v[i].y + v[i].z * v[i].z + v[i].w * v[i].w;
    }
    ss = wave_sum(ss);
    const float rstd = rsqrtf(ss * (1.f / 1024.f) + 1e-6f);
#pragma unroll
    for (int i = 0; i < 4; ++i) {
      const int c = (lane + 64 * i) * 4;
      const float4 g = *(const float4*)(p.final_norm + c);
      *(float4*)(row + c) = make_float4(v[i].x * rstd * g.x, v[i].y * rstd * g.y, v[i].z * rstd * g.z, v[i].w * rstd * g.w);
    }
  }
}

DI void phase_mix(const Params& p) {
  const int lane = threadIdx.x & 63;
  const int wg = blockIdx.x * 8 + (threadIdx.x >> 6), nw = gridDim.x * 8;
  for (int t = wg; t < NT; t += nw) {
#pragma unroll
    for (int i = 0; i < 2; ++i) {
      const int c = lane * 8 + 512 * i;
      const uint4 own = *(const uint4*)(p.Hd + (size_t)t * 1024 + c);
      int nb; bool valid;
      if (t < NL) {
        const int s = t & 4095, col = s & 63, rw = s >> 6, qd = c >> 8;
        if (qd == 0) { valid = col > 0; nb = t - 1; }
        else if (qd == 1) { valid = col < 63; nb = t + 1; }
        else if (qd == 2) { valid = rw > 0; nb = t - 64; }
        else { valid = rw < 63; nb = t + 64; }
      } else {
        const int s = (t - NL) & 255;
        if (c < 512) { valid = s > 0; nb = t - 1; }
        else { valid = s < 255; nb = t + 1; }
      }
      uint4 nv = make_uint4(0, 0, 0, 0);
      if (valid) nv = *(const uint4*)(p.Hd + (size_t)nb * 1024 + c);
#pragma unroll
      for (int j = 0; j < 3; ++j) {
        const int mi = j == 0 ? 0 : j == 1 ? 2 : 3;
        const float4 m0 = *(const float4*)(p.mu + mi * 1024 + c), m1 = *(const float4*)(p.mu + mi * 1024 + c + 4);
        uint4 o;
        o.x = lerp2(own.x, nv.x, m0.x, m0.y); o.y = lerp2(own.y, nv.y, m0.z, m0.w);
        o.z = lerp2(own.z, nv.z, m1.x, m1.y); o.w = lerp2(own.w, nv.w, m1.z, m1.w);
        *(uint4*)(p.S[3 + j] + (size_t)t * 1024 + c) = o;
      }
    }
  }
}

DI void phase_proj(const Params& p, char* lds) {
  const int lane = threadIdx.x & 63, wave = threadIdx.x >> 6;
  constexpr int NLORA = (NT / 256) * 3, NRKV = (NT / 256) * 12;
  for (int u = blockIdx.x; u < NLORA; u += gridDim.x) {
    {
      const int wt = wave & 3, wf = wave >> 2, lr = lane & 15, lq = lane >> 4;
      const int mt = u / 3, nt = 24 + u % 3;
      const int mi = nt == 24 ? 5 : nt == 25 ? 1 : 4;
      f32x4 acc[4][4];
      gemm_tile<true>(p.Hd, 1024, p.Wcat, 1024, 1024, mt * 256, nt * 128, lds, acc, p.mu + mi * 1024);
#pragma unroll
      for (int pp = 0; pp < 2; ++pp)
#pragma unroll
        for (int ti = 0; ti < 4; ++ti) {
          const int t = mt * 256 + wt * 64 + ti * 16 + lr;
          const int fl = wf * 64 + pp * 32 + lq * 8;
          f32x4 a = acc[2 * pp][ti], b = acc[2 * pp + 1][ti];
          if (nt == 24) {
#pragma unroll
            for (int j = 0; j < 4; ++j) { a[j] = sigmoidf_(a[j]); b[j] = sigmoidf_(b[j]); }
            store_bf8(p.L1 + (size_t)t * 384 + fl, a, b);
          } else if (nt == 25) {
#pragma unroll
            for (int j = 0; j < 4; ++j) { a[j] = tanhf_(a[j]); b[j] = tanhf_(b[j]); }
            store_bf8(p.L1 + (size_t)t * 384 + 128 + fl, a, b);
          } else {
            store_bf8(p.L1 + (size_t)t * 384 + 256 + fl, a, b);
          }
        }
    }
  }
  for (int v0 = blockIdx.x; v0 < NRKV; v0 += gridDim.x) {
    {
      const int wr = wave >> 2, wc = wave & 3;
      f32x4 acc[2][2][4][2];
      { int mt0, rem0; tile_map(v0, NRKV, NT / 256, 12, mt0, rem0); const int j0 = rem0 >> 2, nt0 = rem0 & 3;
        gemm256_tile<true>(p.Wcat + (size_t)j0 * 1024 * 1024, p.S[3 + j0], 1024, nt0 * 256, mt0 * 256, lds, acc); }
      int lane_o = threadIdx.x & 63; asm volatile("" : "+v"(lane_o));
      int v = v0; asm volatile("" : "+s"(v));
      int mt, rem; tile_map(v, NRKV, NT / 256, 12, mt, rem); const int j = rem >> 2, nt = rem & 3;
      const int fr = lane_o & 15, fq = lane_o >> 4;
#pragma unroll
      for (int bj = 0; bj < 2; ++bj)
#pragma unroll
        for (int n = 0; n < 2; ++n) {
          const int t = mt * 256 + bj * 128 + wc * 32 + n * 16 + fr;
#pragma unroll
          for (int ai = 0; ai < 2; ++ai) {
            const int fh = nt * 256 + ai * 128 + wr * 64;
            if (j == 1) {
              f32x4 a[2], b[2];
              float ss = 0.f;
#pragma unroll
              for (int mp = 0; mp < 2; ++mp) {
                const int f = fh + mp * 32 + fq * 8;
                const float4 kkl = *(const float4*)(p.k_k + f), kkh = *(const float4*)(p.k_k + f + 4);
                a[mp] = acc[ai][bj][2 * mp][n]; b[mp] = acc[ai][bj][2 * mp + 1][n];
                a[mp][0] *= kkl.x; a[mp][1] *= kkl.y; a[mp][2] *= kkl.z; a[mp][3] *= kkl.w;
                b[mp][0] *= kkh.x; b[mp][1] *= kkh.y; b[mp][2] *= kkh.z; b[mp][3] *= kkh.w;
#pragma unroll
                for (int e2 = 0; e2 < 4; ++e2) ss += a[mp][e2] * a[mp][e2] + b[mp][e2] * b[mp][e2];
              }
              ss += __shfl_xor(ss, 16); ss += __shfl_xor(ss, 32);
              const float kinv = rsqrtf(ss + 1e-12f);
#pragma unroll
              for (int mp = 0; mp < 2; ++mp) {
#pragma unroll
                for (int e2 = 0; e2 < 4; ++e2) { a[mp][e2] *= kinv; b[mp][e2] *= kinv; }
                store_bf8(p.S[2] + HM(t, fh + mp * 32 + fq * 8), a[mp], b[mp]);
              }
              if (fq == 0) p.NRM[(size_t)(fh >> 6) * NT + t] = sqrtf(ss + 1e-12f);
            } else {
              bf16_t* dst = j == 0 ? p.S[0] : p.S[1];
#pragma unroll
              for (int mp = 0; mp < 2; ++mp)
                store_bf8(dst + HM(t, fh + mp * 32 + fq * 8), acc[ai][bj][2 * mp][n], acc[ai][bj][2 * mp + 1][n]);
            }
          }
        }
    }
  }
}

DI void phase_prep(const Params& p, char* lds) {
  const int lane = threadIdx.x & 63, wave = threadIdx.x >> 6;
  const int wt = wave & 3, wf = wave >> 2, lr = lane & 15, lq = lane >> 4;
  const int total = (NT / 256) * 8;
  for (int u = blockIdx.x; u < total; u += gridDim.x) {
    const int mt = u >> 3, nt = u & 7;
    const int tok0 = mt * 256, f0 = nt * 128;
    f32x4 acc[4][4];
    uint4 afp[2][4];
    gemm_tile<false>(p.L1 + 256, 384, p.L2w + 0 * 65536, 64, 64, tok0, f0, lds, acc, nullptr);
#pragma unroll
    for (int pp = 0; pp < 2; ++pp) {
      const int f = f0 + wf * 64 + pp * 32 + lq * 8;
      const float4 a0l = *(const float4*)(p.a0 + f), a0h = *(const float4*)(p.a0 + f + 4);
#pragma unroll
      for (int ti = 0; ti < 4; ++ti) {
        const int t = tok0 + wt * 64 + ti * 16 + lr;
        f32x4 a = acc[2 * pp][ti], b = acc[2 * pp + 1][ti];
        a[0] = sigmoidf_(a[0] + a0l.x); a[1] = sigmoidf_(a[1] + a0l.y); a[2] = sigmoidf_(a[2] + a0l.z); a[3] = sigmoidf_(a[3] + a0l.w);
        b[0] = sigmoidf_(b[0] + a0h.x); b[1] = sigmoidf_(b[1] + a0h.y); b[2] = sigmoidf_(b[2] + a0h.z); b[3] = sigmoidf_(b[3] + a0h.w);
        uint4 o; o.x = pack2(a[0], a[1]); o.y = pack2(a[2], a[3]); o.z = pack2(b[0], b[1]); o.w = pack2(b[2], b[3]);
        afp[pp][ti] = o;
        *(uint4*)(p.S[3] + HM(t, f)) = o;
      }
    }
    gemm_tile<false>(p.L1 + 320, 384, p.L2w + 1 * 65536, 64, 64, tok0, f0, lds, acc, nullptr);
#pragma unroll
    for (int ti = 0; ti < 4; ++ti) {
      const int t = tok0 + wt * 64 + ti * 16 + lr;
      float bon = 0.f;
      const float nrm = p.NRM[(size_t)(nt * 2 + wf) * NT + t];
#pragma unroll
      for (int pp = 0; pp < 2; ++pp) {
        const int f = f0 + wf * 64 + pp * 32 + lq * 8;
        const float4 a0l = *(const float4*)(p.a0 + 1024 + f), a0h = *(const float4*)(p.a0 + 1024 + f + 4);
        const float4 rkl = *(const float4*)(p.r_k + f), rkh = *(const float4*)(p.r_k + f + 4);
        const float4 kal = *(const float4*)(p.k_a + f), kah = *(const float4*)(p.k_a + f + 4);
        const float4 kkl = *(const float4*)(p.k_k + f), kkh = *(const float4*)(p.k_k + f + 4);
        const float rk8[8] = {rkl.x, rkl.y, rkl.z, rkl.w, rkh.x, rkh.y, rkh.z, rkh.w};
        const float ka8[8] = {kal.x, kal.y, kal.z, kal.w, kah.x, kah.y, kah.z, kah.w};
        const float kk8[8] = {kkl.x, kkl.y, kkl.z, kkl.w, kkh.x, kkh.y, kkh.z, kkh.w};
        f32x4 a = acc[2 * pp][ti], b = acc[2 * pp + 1][ti];
        a[0] = sigmoidf_(a[0] + a0l.x); a[1] = sigmoidf_(a[1] + a0l.y); a[2] = sigmoidf_(a[2] + a0l.z); a[3] = sigmoidf_(a[3] + a0l.w);
        b[0] = sigmoidf_(b[0] + a0h.x); b[1] = sigmoidf_(b[1] + a0h.y); b[2] = sigmoidf_(b[2] + a0h.z); b[3] = sigmoidf_(b[3] + a0h.w);
        store_bf8(p.S[4] + HM(t, f), a, b);
        const float ab8[8] = {a[0], a[1], a[2], a[3], b[0], b[1], b[2], b[3]};
        float af8[8], r8[8], k8[8];
        unpack_bf8(afp[pp][ti], af8);
        unpack_bf8(*(const uint4*)(p.S[0] + HM(t, f)), r8);
        unpack_bf8(*(const uint4*)(p.S[2] + HM(t, f)), k8);
#pragma unroll
        for (int e2 = 0; e2 < 8; ++e2) {
          const float k = k8[e2] * nrm / kk8[e2];
          bon += r8[e2] * k * rk8[e2] * (2.f + (ab8[e2] + af8[e2] - 2.f) * ka8[e2]);
        }
      }
      bon += __shfl_xor(bon, 16); bon += __shfl_xor(bon, 32);
      if (lq == 0) p.BON[(size_t)(nt * 2 + wf) * NT + t] = bon;
    }
#pragma unroll 1
    for (int dr = 0; dr < 2; ++dr) {
      gemm_tile<false>(p.L1 + 128 + dr * 64, 384, p.L2w + (2 + dr) * 65536, 64, 64, tok0, f0, lds, acc, nullptr);
      bf16_t* dst = dr ? p.S[5] : p.Hd;
#pragma unroll
      for (int pp = 0; pp < 2; ++pp) {
        const int f = f0 + wf * 64 + pp * 32 + lq * 8;
        const float4 w0l = *(const float4*)(p.w0 + dr * 1024 + f), w0h = *(const float4*)(p.w0 + dr * 1024 + f + 4);
#pragma unroll
        for (int ti = 0; ti < 4; ++ti) {
          const int t = tok0 + wt * 64 + ti * 16 + lr;
          f32x4 a = acc[2 * pp][ti], b = acc[2 * pp + 1][ti];
          a[0] = -0.60653066f * sigmoidf_(a[0] + w0l.x); a[1] = -0.60653066f * sigmoidf_(a[1] + w0l.y);
          a[2] = -0.60653066f * sigmoidf_(a[2] + w0l.z); a[3] = -0.60653066f * sigmoidf_(a[3] + w0l.w);
          b[0] = -0.60653066f * sigmoidf_(b[0] + w0h.x); b[1] = -0.60653066f * sigmoidf_(b[1] + w0h.y);
          b[2] = -0.60653066f * sigmoidf_(b[2] + w0h.z); b[3] = -0.60653066f * sigmoidf_(b[3] + w0h.w);
          store_bf8(dst + HM(t, f), a, b);
        }
      }
    }
  }
}

typedef short s16x4 __attribute__((ext_vector_type(4)));
#define MFMA16K(a, b, c) __builtin_amdgcn_mfma_f32_16x16x16bf16_1k((a), (b), (c), 0, 0, 0)
DI s16x4 pack4(const f32x4& x) { const uint2 u = make_uint2(pack2(x[0], x[1]), pack2(x[2], x[3])); return __builtin_bit_cast(s16x4, u); }
DI bf16x8 pack8(const f32x4& a, const f32x4& b) { const uint4 u = make_uint4(pack2(a[0], a[1]), pack2(a[2], a[3]), pack2(b[0], b[1]), pack2(b[2], b[3])); return __builtin_bit_cast(bf16x8, u); }
constexpr int SC_KK = 0, SC_R = 2304, SC_B = 4608, SC_K = 6912, SC_BT = 9216, SC_KT = 12288, SC_VT = 15360, SC_CL = 18432, SC_CHUNK = 18688, SC_GROUP = 2 * SC_CHUNK, SC_YBUF = 2 * SC_GROUP;

#define KEEP8(x) asm volatile("" :: "v"(x))
#define KEEP4(x) asm volatile("" :: "v"(x))
struct ChunkT { s16x4 bT, pAkk, pAbr, pAkr; };
DI void scan_partA2(const char* cb0, ChunkT (&ct)[2], int c, int q) {
  const f32x4 z = {0.f, 0.f, 0.f, 0.f};
  f32x4 Abk[2], AbkT[2], Akk[2], Abr[2], Akr[2], P[2];
#pragma unroll
  for (int h = 0; h < 2; ++h) {
    const char* cb = cb0 + h * SC_CHUNK;
    bf16x8 fB[2], fK[2], fKK[2], fR[2];
#pragma unroll
    for (int ks = 0; ks < 2; ++ks) {
      fB[ks] = *(const bf16x8*)(cb + SC_B + c * 144 + ks * 64 + q * 16);
      fK[ks] = *(const bf16x8*)(cb + SC_K + c * 144 + ks * 64 + q * 16);
      fKK[ks] = *(const bf16x8*)(cb + SC_KK + c * 144 + ks * 64 + q * 16);
      fR[ks] = *(const bf16x8*)(cb + SC_R + c * 144 + ks * 64 + q * 16);
    }
    Abk[h] = MFMA16(fB[0], fKK[0], z);  Abk[h] = MFMA16(fB[1], fKK[1], Abk[h]);
    AbkT[h] = MFMA16(fKK[0], fB[0], z); AbkT[h] = MFMA16(fKK[1], fB[1], AbkT[h]);
    Akk[h] = MFMA16(fK[0], fKK[0], z);  Akk[h] = MFMA16(fK[1], fKK[1], Akk[h]);
    Abr[h] = MFMA16(fB[0], fR[0], z);   Abr[h] = MFMA16(fB[1], fR[1], Abr[h]);
    Akr[h] = MFMA16(fK[0], fR[0], z);   Akr[h] = MFMA16(fK[1], fR[1], Akr[h]);
    KEEP8(fB[0]); KEEP8(fB[1]); KEEP8(fK[0]); KEEP8(fK[1]); KEEP8(fKK[0]); KEEP8(fKK[1]); KEEP8(fR[0]); KEEP8(fR[1]);
  }
#pragma unroll
  for (int h = 0; h < 2; ++h)
#pragma unroll
    for (int j = 0; j < 4; ++j) {
      const int rr = 4 * q + j;
      Abk[h][j] = rr < c ? Abk[h][j] : 0.f;  Akk[h][j] = rr < c ? Akk[h][j] : 0.f;
      Abr[h][j] = rr <= c ? Abr[h][j] : 0.f; Akr[h][j] = rr <= c ? Akr[h][j] : 0.f;
      AbkT[h][j] = c < rr ? AbkT[h][j] : 0.f;
      P[h][j] = (rr == c ? 1.f : 0.f) - Abk[h][j];
    }
  s16x4 bN[2], bNT[2], bN2[2], bN2T[2], bN4[2], bN4T[2], bN8T[2];
  f32x4 N2[2], N2T[2], N4[2], N4T[2], N8T[2];
#pragma unroll
  for (int h = 0; h < 2; ++h) { bN[h] = pack4(Abk[h]); bNT[h] = pack4(AbkT[h]); }
#pragma unroll
  for (int h = 0; h < 2; ++h) { N2[h] = MFMA16K(bNT[h], bN[h], z); N2T[h] = MFMA16K(bN[h], bNT[h], z); }
#pragma unroll
  for (int h = 0; h < 2; ++h) { KEEP4(bN[h]); KEEP4(bNT[h]); bN2[h] = pack4(N2[h]); bN2T[h] = pack4(N2T[h]); }
#pragma unroll
  for (int h = 0; h < 2; ++h) { N4[h] = MFMA16K(bN2T[h], bN2[h], z); N4T[h] = MFMA16K(bN2[h], bN2T[h], z); }
#pragma unroll
  for (int h = 0; h < 2; ++h) { KEEP4(bN2[h]); bN4[h] = pack4(N4[h]); bN4T[h] = pack4(N4T[h]); }
#pragma unroll
  for (int h = 0; h < 2; ++h) N8T[h] = MFMA16K(bN4[h], bN4T[h], z);
#pragma unroll
  for (int h = 0; h < 2; ++h) { KEEP4(bN4[h]); bN8T[h] = pack4(N8T[h]); }
  s16x4 pp_[2];
#pragma unroll
  for (int h = 0; h < 2; ++h) { pp_[h] = pack4(P[h]); P[h] = MFMA16K(bN2T[h], pp_[h], P[h]); }
#pragma unroll
  for (int h = 0; h < 2; ++h) { KEEP4(pp_[h]); KEEP4(bN2T[h]); }
#pragma unroll
  for (int h = 0; h < 2; ++h) { pp_[h] = pack4(P[h]); P[h] = MFMA16K(bN4T[h], pp_[h], P[h]); }
#pragma unroll
  for (int h = 0; h < 2; ++h) { KEEP4(pp_[h]); KEEP4(bN4T[h]); }
#pragma unroll
  for (int h = 0; h < 2; ++h) { pp_[h] = pack4(P[h]); P[h] = MFMA16K(bN8T[h], pp_[h], P[h]); }
#pragma unroll
  for (int h = 0; h < 2; ++h) { KEEP4(pp_[h]); KEEP4(bN8T[h]); }
#pragma unroll
  for (int h = 0; h < 2; ++h) { ct[h].bT = pack4(P[h]); ct[h].pAkk = pack4(Akk[h]); ct[h].pAbr = pack4(Abr[h]); ct[h].pAkr = pack4(Akr[h]); }
}
DI void scan_partB(const char* cb, float* yb, f32x4 (&ST)[4], const ChunkT& ct, int vb, int c, int q) {
  const f32x4 z = {0.f, 0.f, 0.f, 0.f};
  bf16x8 sf[2], kkp[2], rp[2];
#pragma unroll
  for (int i = 0; i < 2; ++i) {
    sf[i] = pack8(ST[2 * i], ST[2 * i + 1]);
    const uint2 klo = *(const uint2*)(cb + SC_KK + c * 144 + (32 * i + 4 * q) * 2), khi = *(const uint2*)(cb + SC_KK + c * 144 + (32 * i + 16 + 4 * q) * 2);
    const uint2 rlo = *(const uint2*)(cb + SC_R + c * 144 + (32 * i + 4 * q) * 2), rhi = *(const uint2*)(cb + SC_R + c * 144 + (32 * i + 16 + 4 * q) * 2);
    kkp[i] = __builtin_bit_cast(bf16x8, make_uint4(klo.x, klo.y, khi.x, khi.y));
    rp[i] = __builtin_bit_cast(bf16x8, make_uint4(rlo.x, rlo.y, rhi.x, rhi.y));
  }
  f32x4 XT = MFMA16(kkp[0], sf[0], z); XT = MFMA16(kkp[1], sf[1], XT);
  f32x4 YT = MFMA16(rp[0], sf[0], z);  YT = MFMA16(rp[1], sf[1], YT);
  KEEP8(kkp[0]); KEEP8(kkp[1]); KEEP8(rp[0]); KEEP8(rp[1]); KEEP8(sf[0]); KEEP8(sf[1]);
  const s16x4 vf = *(const s16x4*)(cb + SC_VT + (vb * 16 + c) * 48 + q * 8);
  XT = MFMA16K(ct.pAkk, vf, XT);
  const s16x4 pXT = pack4(XT);
  f32x4 UT = MFMA16K(ct.bT, pXT, z); KEEP4(pXT);
#pragma unroll
  for (int j = 0; j < 4; ++j) UT[j] = -UT[j];
  const s16x4 bU = pack4(UT);
  YT = MFMA16K(ct.pAbr, bU, YT);
  YT = MFMA16K(ct.pAkr, vf, YT);
#pragma unroll
  for (int j = 0; j < 4; ++j) yb[(4 * q + j) * 64 + vb * 16 + c] = YT[j];
#pragma unroll
  for (int kt = 0; kt < 4; ++kt) {
    const s16x4 bh = *(const s16x4*)(cb + SC_BT + (16 * kt + c) * 48 + q * 8);
    const s16x4 kh = *(const s16x4*)(cb + SC_KT + (16 * kt + c) * 48 + q * 8);
    f32x4 s = MFMA16K(bh, bU, ST[kt]);
    s = MFMA16K(kh, vf, s); KEEP4(bh); KEEP4(kh);
    const float4 cl = *(const float4*)(cb + SC_CL + (16 * kt + 4 * q) * 4);
    s[0] *= cl.x; s[1] *= cl.y; s[2] *= cl.z; s[3] *= cl.w;
    ST[kt] = s;
  }
  KEEP4(bU); KEEP4(vf); KEEP4(ct.bT); KEEP4(ct.pAkk); KEEP4(ct.pAbr); KEEP4(ct.pAkr);
}

DI void phase_scan(const Params& p, char* lds) {
  float* ybuf = (float*)(lds + SC_YBUF);
  const int tid = threadIdx.x, lane = tid & 63, wave = tid >> 6;
  const bool loader = tid >= 256;
  const int lt = tid & 255, ltk = lt >> 3, lch = (lt & 7) * 8;
  const int lcc = (wave >> 1) & 1, lchh = wave & 1, ltok = lane >> 2, loct = lane & 3, ch0 = lchh * 32 + loct * 8;
  const int vb = wave & 3, cc_ = lane & 15, qq = lane >> 4;
  constexpr int NG = NKEY / 32;
  for (int unit = blockIdx.x; unit < 256; unit += gridDim.x) {
    const int dir = unit & 1, h = (unit >> 1) & 15, b = unit >> 5;
    const bf16_t* Rp = p.S[0]; const bf16_t* Vp = p.S[1]; const bf16_t* Kp = p.S[2];
    bf16_t* Ap = dir ? p.S[4] : p.S[3];
    const bf16_t* Lp = dir ? p.S[5] : p.Hd;
    auto tok_of = [&](int i) -> int {
      if (i < 256) return NL + b * 256 + (dir ? 255 - i : i);
      const int s = i - 256;
      return b * 4096 + (dir ? 4095 - s : s);
    };
    uint4 rawA[5], rawB[5];
    float nrmA = 0.f, nrmB = 0.f;
    float rkk[8], kac[8];
    f32x4 ST[4];
#pragma unroll
    for (int i = 0; i < 4; ++i) ST[i] = f32x4{0.f, 0.f, 0.f, 0.f};
    if (loader) {
#pragma unroll
      for (int j = 0; j < 8; ++j) { rkk[j] = 1.f / p.k_k[h * 64 + ch0 + j]; kac[j] = p.k_a[h * 64 + ch0 + j]; }
    }
    auto issue = [&](int g, uint4 (&rw)[5], float& nv) {
      const int t = tok_of(g * 32 + lcc * 16 + ltok);
      const size_t off = HM(t, h * 64 + ch0);
      rw[0] = *(const uint4*)(Rp + off); rw[1] = *(const uint4*)(Vp + off); rw[2] = *(const uint4*)(Kp + off);
      rw[3] = *(const uint4*)(Ap + off); rw[4] = *(const uint4*)(Lp + off);
      nv = p.NRM[(size_t)h * NT + t];
    };
    auto process = [&](int stage, const uint4 (&raw)[5], const float nrmv) {
      float r8[8], kk8[8], a8[8], l8[8], L[8];
      unpack_bf8(raw[0], r8); unpack_bf8(raw[2], kk8); unpack_bf8(raw[3], a8); unpack_bf8(raw[4], l8);
#pragma unroll
      for (int j = 0; j < 8; ++j) L[j] = l8[j];
#pragma unroll
      for (int d = 4; d < 64; d <<= 1) {
#pragma unroll
        for (int j = 0; j < 8; ++j) { const float o = __shfl_up(L[j], d); if (lane >= d) L[j] += o; }
      }
      float okk[8], orr[8], ob[8], ok[8], cend[8];
#pragma unroll
      for (int j = 0; j < 8; ++j) {
        const float cc = __expf(L[j]), cprev = __expf(L[j] - l8[j]), cinv = __expf(-L[j]);
        const float k = kk8[j] * nrmv * rkk[j];
        const float kd = k * (1.f + (a8[j] - 1.f) * kac[j]);
        okk[j] = kk8[j] * cprev; orr[j] = r8[j] * cc; ob[j] = kk8[j] * a8[j] * cinv; ok[j] = kd * cinv; cend[j] = cc;
      }
      char* cb = lds + stage * SC_GROUP + lcc * SC_CHUNK;
      uint4 o;
      o = make_uint4(pack2(okk[0], okk[1]), pack2(okk[2], okk[3]), pack2(okk[4], okk[5]), pack2(okk[6], okk[7])); *(uint4*)(cb + SC_KK + ltok * 144 + ch0 * 2) = o;
      o = make_uint4(pack2(orr[0], orr[1]), pack2(orr[2], orr[3]), pack2(orr[4], orr[5]), pack2(orr[6], orr[7])); *(uint4*)(cb + SC_R + ltok * 144 + ch0 * 2) = o;
      const uint4 obp = make_uint4(pack2(ob[0], ob[1]), pack2(ob[2], ob[3]), pack2(ob[4], ob[5]), pack2(ob[6], ob[7])); *(uint4*)(cb + SC_B + ltok * 144 + ch0 * 2) = obp;
      const uint4 okp = make_uint4(pack2(ok[0], ok[1]), pack2(ok[2], ok[3]), pack2(ok[4], ok[5]), pack2(ok[6], ok[7])); *(uint4*)(cb + SC_K + ltok * 144 + ch0 * 2) = okp;
      const unsigned bw[4] = {obp.x, obp.y, obp.z, obp.w}, kw[4] = {okp.x, okp.y, okp.z, okp.w}, vw[4] = {raw[1].x, raw[1].y, raw[1].z, raw[1].w};
#pragma unroll
      for (int j = 0; j < 8; ++j) {
        const int sh = (j & 1) * 16;
        *(bf16_t*)(cb + SC_BT + (ch0 + j) * 48 + ltok * 2) = (bf16_t)((bw[j >> 1] >> sh) & 0xffffu);
        *(bf16_t*)(cb + SC_KT + (ch0 + j) * 48 + ltok * 2) = (bf16_t)((kw[j >> 1] >> sh) & 0xffffu);
        *(bf16_t*)(cb + SC_VT + (ch0 + j) * 48 + ltok * 2) = (bf16_t)((vw[j >> 1] >> sh) & 0xffffu);
      }
      if (ltok == 15) {
        *(float4*)(cb + SC_CL + ch0 * 4) = make_float4(cend[0], cend[1], cend[2], cend[3]);
        *(float4*)(cb + SC_CL + ch0 * 4 + 16) = make_float4(cend[4], cend[5], cend[6], cend[7]);
      }
    };
    auto yout = [&](int g) {
      const float* yb = ybuf + (g & 1) * 2048 + ltk * 64 + lch;
      const float4 y0 = *(const float4*)yb, y1 = *(const float4*)(yb + 4);
      const int t = tok_of(g * 32 + ltk);
      uint4 o;
      o.x = pack2(y0.x, y0.y); o.y = pack2(y0.z, y0.w); o.z = pack2(y1.x, y1.y); o.w = pack2(y1.z, y1.w);
      *(uint4*)(Ap + HM(t, h * 64 + lch)) = o;
    };
    __syncthreads();
    if (loader) { issue(0, rawA, nrmA); issue(1, rawB, nrmB); process(0, rawA, nrmA); issue(2, rawA, nrmA); }
    __syncthreads();
    for (int g = 0; g < NG; g += 2) {
      if (loader) {
        if (g >= 1) yout(g - 1);
        if (g + 1 < NG) { process(1, rawB, nrmB); if (g + 3 < NG) issue(g + 3, rawB, nrmB); }
      } else {
        const char* gb = lds;
        float* yb = ybuf;
        ChunkT ct[2];
        scan_partA2(gb, ct, cc_, qq);
        scan_partB(gb, yb, ST, ct[0], vb, cc_, qq);
        scan_partB(gb + SC_CHUNK, yb + 16 * 64, ST, ct[1], vb, cc_, qq);
      }
      __syncthreads();
      if (g + 1 < NG) {
        if (loader) {
          yout(g);
          if (g + 2 < NG) { process(0, rawA, nrmA); if (g + 4 < NG) issue(g + 4, rawA, nrmA); }
        } else {
          const char* gb = lds + SC_GROUP;
          float* yb = ybuf + 2048;
          ChunkT ct[2];
          scan_partA2(gb, ct, cc_, qq);
          scan_partB(gb, yb, ST, ct[0], vb, cc_, qq);
          scan_partB(gb + SC_CHUNK, yb + 16 * 64, ST, ct[1], vb, cc_, qq);
        }
        __syncthreads();
      }
    }
    if (loader) yout(NG - 1);
    __syncthreads();
  }
}

DI void phase_readout(const Params& p, char* lds) {
  const int lane = threadIdx.x & 63, wave = threadIdx.x >> 6;
  const int wt = wave & 3, wf = wave >> 2, lr = lane & 15, lq = lane >> 4;
  const int total = (NT / 256) * 8;
  for (int u = blockIdx.x; u < total; u += gridDim.x) {
    const int mt = u >> 3, nt = u & 7;
    const int tok0 = mt * 256, f0 = nt * 128;
    f32x4 g[4][4];
    gemm_tile<false>(p.L1, 384, p.g2T, 128, 128, tok0, f0, lds, g, nullptr);
    const int head = nt * 2 + wf;
#pragma unroll
    for (int ti = 0; ti < 4; ++ti) {
      const int t = tok0 + wt * 64 + ti * 16 + lr;
      float y[2][8];
      float sum = 0.f;
#pragma unroll
      for (int pp = 0; pp < 2; ++pp) {
        const int f = f0 + wf * 64 + pp * 32 + lq * 8;
        float ya[8], yb[8];
        unpack_bf8(*(const uint4*)(p.S[3] + HM(t, f)), ya);
        unpack_bf8(*(const uint4*)(p.S[4] + HM(t, f)), yb);
#pragma unroll
        for (int e2 = 0; e2 < 8; ++e2) { y[pp][e2] = ya[e2] + yb[e2]; sum += y[pp][e2]; }
      }
      sum += __shfl_xor(sum, 16); sum += __shfl_xor(sum, 32);
      const float mean = sum * (1.f / 64.f);
      float vs = 0.f;
#pragma unroll
      for (int pp = 0; pp < 2; ++pp)
#pragma unroll
        for (int e2 = 0; e2 < 8; ++e2) { const float d = y[pp][e2] - mean; vs += d * d; }
      vs += __shfl_xor(vs, 16); vs += __shfl_xor(vs, 32);
      const float rstd = rsqrtf(vs * (1.f / 64.f) + 64e-5f);
      const float bon = p.BON[(size_t)head * NT + t];
#pragma unroll
      for (int pp = 0; pp < 2; ++pp) {
        const int f = f0 + wf * 64 + pp * 32 + lq * 8;
        const float4 lwl = *(const float4*)(p.ln_w + f), lwh = *(const float4*)(p.ln_w + f + 4);
        const float4 lbl = *(const float4*)(p.ln_b + f), lbh = *(const float4*)(p.ln_b + f + 4);
        const float lw8[8] = {lwl.x, lwl.y, lwl.z, lwl.w, lwh.x, lwh.y, lwh.z, lwh.w};
        const float lb8[8] = {lbl.x, lbl.y, lbl.z, lbl.w, lbh.x, lbh.y, lbh.z, lbh.w};
        float v8[8];
        unpack_bf8(*(const uint4*)(p.S[1] + HM(t, f)), v8);
        f32x4 oa, ob;
#pragma unroll
        for (int j = 0; j < 4; ++j) {
          oa[j] = ((y[pp][j] - mean) * rstd * lw8[j] + lb8[j] + bon * v8[j]) * g[2 * pp][ti][j];
          ob[j] = ((y[pp][4 + j] - mean) * rstd * lw8[4 + j] + lb8[4 + j] + bon * v8[4 + j]) * g[2 * pp + 1][ti][j];
        }
        store_bf8(p.S[0] + (size_t)t * 1024 + f, oa, ob);
      }
    }
  }
}

DI void phase_gemm_resid(const Params& p, char* lds, const bf16_t* A, const bf16_t* W, int K, int ntm,
                                 const float* xin_l, const float* xin_c, const float* gate) {
  const int lane = threadIdx.x & 63, wave = threadIdx.x >> 6;
  const int wr = wave >> 2, wc = wave & 3;
  const int total = ntm * 4;
  for (int u = blockIdx.x; u < total; u += gridDim.x) {
    int mt, nt; tile_map(u, total, ntm, 4, mt, nt);
    f32x4 acc[2][2][4][2];
    gemm256_tile<true>(W, A, K, nt * 256, mt * 256, lds, acc);
    int lane_o = threadIdx.x & 63; asm volatile("" : "+v"(lane_o));
    const int fr = lane_o & 15, fq = lane_o >> 4;
#pragma unroll
    for (int bj = 0; bj < 2; ++bj)
#pragma unroll
      for (int n = 0; n < 2; ++n) {
        const int t = mt * 256 + bj * 128 + wc * 32 + n * 16 + fr;
        const int bp = t < NL ? (t >> 12) : 8;
        const float* xi = t < NL ? xin_l + (size_t)t * 1024 : xin_c + (size_t)(t - NL) * 1024;
        float* xo = t < NL ? p.out + (size_t)t * 1024 : p.XC + (size_t)(t - NL) * 1024;
#pragma unroll
        for (int ai = 0; ai < 2; ++ai)
#pragma unroll
          for (int mp = 0; mp < 2; ++mp) {
            const int f = nt * 256 + ai * 128 + wr * 64 + mp * 32 + fq * 8;
            const float4 g0 = *(const float4*)(gate + bp * 6144 + f), g1 = *(const float4*)(gate + bp * 6144 + f + 4);
            const float4 x0 = *(const float4*)(xi + f), x1 = *(const float4*)(xi + f + 4);
            const f32x4 a = acc[ai][bj][2 * mp][n], b = acc[ai][bj][2 * mp + 1][n];
            *(float4*)(xo + f) = make_float4(x0.x + g0.x * a[0], x0.y + g0.y * a[1], x0.z + g0.z * a[2], x0.w + g0.w * a[3]);
            *(float4*)(xo + f + 4) = make_float4(x1.x + g1.x * b[0], x1.y + g1.y * b[1], x1.z + g1.z * b[2], x1.w + g1.w * b[3]);
          }
      }
  }
}

DI void phase_up(const Params& p, char* lds, const bf16_t* H, const bf16_t* W, bf16_t* U, int ntm) {
  const int lane = threadIdx.x & 63, wave = threadIdx.x >> 6;
  const int wr = wave >> 2, wc = wave & 3;
  const int total = ntm * 16;
  for (int u = blockIdx.x; u < total; u += gridDim.x) {
    int mt, nt; tile_map(u, total, ntm, 16, mt, nt);
    f32x4 acc[2][2][4][2];
    gemm256_tile<true>(W, H, 1024, nt * 256, mt * 256, lds, acc);
    int lane_o = threadIdx.x & 63; asm volatile("" : "+v"(lane_o));
    const int fr = lane_o & 15, fq = lane_o >> 4;
#pragma unroll
    for (int bj = 0; bj < 2; ++bj)
#pragma unroll
      for (int n = 0; n < 2; ++n) {
        const int t = mt * 256 + bj * 128 + wc * 32 + n * 16 + fr;
#pragma unroll
        for (int ai = 0; ai < 2; ++ai)
#pragma unroll
          for (int mp = 0; mp < 2; ++mp) {
            const int f = nt * 256 + ai * 128 + wr * 64 + mp * 32 + fq * 8;
            f32x4 a = acc[ai][bj][2 * mp][n], b = acc[ai][bj][2 * mp + 1][n];
#pragma unroll
            for (int j = 0; j < 4; ++j) { const float ra = fmaxf(a[j], 0.f), rb = fmaxf(b[j], 0.f); a[j] = ra * ra; b[j] = rb * rb; }
            store_bf8(U + (size_t)t * 4096 + f, a, b);
          }
      }
  }
}

DI void phase_qkv(const Params& p, char* lds) {
  const int lane = threadIdx.x & 63, wave = threadIdx.x >> 6;
  const int wr = wave >> 2, wc = wave & 3;
  const int total = (NT / 256) * 6;
  bf16_t* Q = p.S[0]; bf16_t* KA = p.S[1]; bf16_t* VT = p.S[2];
  for (int u = blockIdx.x; u < total; u += gridDim.x) {
    int mt, nt; tile_map(u, total, NT / 256, 6, mt, nt);
    if (mt >= NL / 256 && nt < 4) continue;
    f32x4 acc[2][2][4][2];
    gemm256_tile<false>(p.wqkvT, p.S[5], 1024, nt * 256, mt * 256, lds, acc);
    int lane_o = threadIdx.x & 63; asm volatile("" : "+v"(lane_o));
    const int fr = lane_o & 15, fq = lane_o >> 4;
#pragma unroll
    for (int bj = 0; bj < 2; ++bj)
#pragma unroll
      for (int n = 0; n < 2; ++n) {
        const int t = mt * 256 + bj * 128 + wc * 32 + n * 16 + fr;
        const bool lat = t < NL;
        const int b = lat ? (t >> 12) : ((t - NL) >> 8);
        const int key = lat ? (t & 4095) : 4096 + ((t - NL) & 255);
#pragma unroll
        for (int ai = 0; ai < 2; ++ai) {
          const int hh = ai * 2 + wr;
          asm volatile("" ::: "memory");
          if (nt < 5) {
            float ss = 0.f;
#pragma unroll
            for (int m = 0; m < 4; ++m)
#pragma unroll
              for (int j = 0; j < 4; ++j) ss += acc[ai][bj][m][n][j] * acc[ai][bj][m][n][j];
            ss += __shfl_xor(ss, 16); ss += __shfl_xor(ss, 32);
            const float rstd = rsqrtf(ss * (1.f / 64.f) + 1e-6f);
            const float* gn = nt < 4 ? p.q_norm : p.k_norm;
            float v[4][4];
#pragma unroll
            for (int m = 0; m < 4; ++m) {
              const float4 g4 = *(const float4*)(gn + m * 16 + fq * 4);
              v[m][0] = acc[ai][bj][m][n][0] * rstd * g4.x; v[m][1] = acc[ai][bj][m][n][1] * rstd * g4.y;
              v[m][2] = acc[ai][bj][m][n][2] * rstd * g4.z; v[m][3] = acc[ai][bj][m][n][3] * rstd * g4.w;
            }
            if (lat) {
              const int s = t & 4095, rowp = s >> 6, colp = s & 63;
#pragma unroll
              for (int j = 0; j < 4; ++j) {
                const float2 cs0 = *(const float2*)(p.TAB + (rowp * 16 + fq * 4 + j) * 2);
                const float2 cs1 = *(const float2*)(p.TAB + (colp * 16 + fq * 4 + j) * 2);
                const float x1 = v[0][j], x2 = v[1][j], z1 = v[2][j], z2 = v[3][j];
                v[0][j] = x1 * cs0.x - x2 * cs0.y; v[1][j] = x2 * cs0.x + x1 * cs0.y;
                v[2][j] = z1 * cs1.x - z2 * cs1.y; v[3][j] = z2 * cs1.x + z1 * cs1.y;
              }
            }
            if (nt < 4) {
              const float qs = 0.125f * 1.4426950408889634f;
              const int head = nt * 4 + hh;
#pragma unroll
              for (int m = 0; m < 4; ++m)
                store_bf4(Q + (size_t)t * 1024 + head * 64 + m * 16 + fq * 4, v[m][0] * qs, v[m][1] * qs, v[m][2] * qs, v[m][3] * qs);
            } else {
#pragma unroll
              for (int m = 0; m < 4; ++m)
                store_bf4(KA + ((size_t)(b * 4 + hh) * NKEY + key) * 64 + m * 16 + fq * 4, v[m][0], v[m][1], v[m][2], v[m][3]);
            }
          } else {
#pragma unroll
            for (int m = 0; m < 4; ++m)
#pragma unroll
              for (int j = 0; j < 4; ++j) {
                const int d = m * 16 + fq * 4 + j;
                const unsigned pk = pack2(acc[ai][bj][m][n][j], 0.f);
                VT[((size_t)(b * 4 + hh) * 64 + d) * NKEY + key] = (bf16_t)(pk & 0xffffu);
              }
          }
        }
      }
  }
}

DI void phase_attn(const Params& p, char* lds) {
  const int tid = threadIdx.x, lane = tid & 63, wave = tid >> 6;
  const int l31 = lane & 31, lh = lane >> 5;
  const int srow = tid >> 3, sch = tid & 7;
  const bf16_t* Q = p.S[0]; const bf16_t* KA = p.S[1]; const bf16_t* VT = p.S[2]; bf16_t* O = p.S[3];
  float gq = 0.f, gk = 0.f;
  for (int i = 0; i < 64; ++i) { gq = fmaxf(gq, fabsf(p.q_norm[i])); gk = fmaxf(gk, fabsf(p.k_norm[i])); }
  const float M2 = 8.f * gq * gk * 1.4426950408889634f;
  constexpr int NKT = NKEY / 128;
  constexpr int VROW = 272;
  constexpr int KST = 128 * ROWB;
  constexpr int AST = KST + 64 * VROW;
  for (int u = blockIdx.x; u < 1024; u += gridDim.x) {
    const int qb = u & 7, head = (u >> 3) & 15, b = u >> 7, kvh = head >> 2;
    const bf16_t* Kg = KA + (size_t)(b * 4 + kvh) * NKEY * 64;
    const bf16_t* Vg = VT + (size_t)(b * 4 + kvh) * 64 * NKEY;
    const int tq0 = b * 4096 + qb * 512 + wave * 64 + l31;
    bf16x8 qf[2][4];
#pragma unroll
    for (int blk = 0; blk < 2; ++blk)
#pragma unroll
      for (int s = 0; s < 4; ++s) qf[blk][s] = *(const bf16x8*)(Q + (size_t)(tq0 + blk * 32) * 1024 + head * 64 + s * 16 + lh * 8);
    f32x16 o[2][2];
#pragma unroll
    for (int blk = 0; blk < 2; ++blk)
#pragma unroll
      for (int dt = 0; dt < 2; ++dt)
#pragma unroll
        for (int i = 0; i < 16; ++i) o[blk][dt][i] = 0.f;
    float lsum[2] = {0.f, 0.f};
    uint4 kr = make_uint4(0, 0, 0, 0), vr = kr;
    __syncthreads();
    for (int kt = -1; kt < NKT; ++kt) {
      const bool more = kt + 1 < NKT;
#pragma unroll 1
      for (int hf = 0; hf < 2; ++hf) {
        if (more) {
          kr = *(const uint4*)(Kg + (size_t)((kt + 1) * 128 + hf * 64 + srow) * 64 + sch * 8);
          vr = *(const uint4*)(Vg + (size_t)srow * NKEY + (kt + 1) * 128 + hf * 64 + sch * 8);
        }
        if (kt >= 0) {
          const char* ksm = lds + (kt & 1) * AST + hf * 64 * ROWB;
          const char* vsm = lds + (kt & 1) * AST + KST + hf * 128;
          f32x16 sT[2][2];
#pragma unroll
          for (int blk = 0; blk < 2; ++blk)
#pragma unroll
            for (int k2 = 0; k2 < 2; ++k2)
#pragma unroll
              for (int i = 0; i < 16; ++i) sT[blk][k2][i] = -M2;
#pragma unroll
          for (int k2 = 0; k2 < 2; ++k2)
#pragma unroll
            for (int s = 0; s < 4; ++s) {
              const bf16x8 kf = *(const bf16x8*)(ksm + (k2 * 32 + l31) * ROWB + s * 32 + lh * 16);
              sT[0][k2] = MFMA32(kf, qf[0][s], sT[0][k2]);
              sT[1][k2] = MFMA32(kf, qf[1][s], sT[1][k2]);
            }
#pragma unroll
          for (int blk = 0; blk < 2; ++blk)
#pragma unroll
            for (int k2 = 0; k2 < 2; ++k2)
#pragma unroll
              for (int i = 0; i < 16; ++i) { const float pv = __builtin_amdgcn_exp2f(sT[blk][k2][i]); lsum[blk] += pv; sT[blk][k2][i] = pv; }
#pragma unroll
          for (int k2 = 0; k2 < 2; ++k2)
#pragma unroll
            for (int s2 = 0; s2 < 2; ++s2) {
              bf16x8 pf[2];
#pragma unroll
              for (int blk = 0; blk < 2; ++blk) {
                uint4 pk;
                pk.x = pack2(sT[blk][k2][8 * s2 + 0], sT[blk][k2][8 * s2 + 1]); pk.y = pack2(sT[blk][k2][8 * s2 + 2], sT[blk][k2][8 * s2 + 3]);
                pk.z = pack2(sT[blk][k2][8 * s2 + 4], sT[blk][k2][8 * s2 + 5]); pk.w = pack2(sT[blk][k2][8 * s2 + 6], sT[blk][k2][8 * s2 + 7]);
                pf[blk] = __builtin_bit_cast(bf16x8, pk);
              }
              const int koff = (k2 * 32 + 16 * s2 + 4 * lh) * 2;
#pragma unroll
              for (int dt = 0; dt < 2; ++dt) {
                const uint2 lo = *(const uint2*)(vsm + (dt * 32 + l31) * VROW + koff), hi = *(const uint2*)(vsm + (dt * 32 + l31) * VROW + koff + 16);
                const bf16x8 vv = __builtin_bit_cast(bf16x8, make_uint4(lo.x, lo.y, hi.x, hi.y));
                o[0][dt] = MFMA32(vv, pf[0], o[0][dt]);
                o[1][dt] = MFMA32(vv, pf[1], o[1][dt]);
              }
            }
        }
        if (more) {
          char* st = lds + ((kt + 1) & 1) * AST;
          *(uint4*)(st + (hf * 64 + srow) * ROWB + sch * 16) = kr;
          *(uint4*)(st + KST + srow * VROW + hf * 128 + sch * 16) = vr;
        }
      }
      __syncthreads();
    }
#pragma unroll
    for (int blk = 0; blk < 2; ++blk) {
      float ls = lsum[blk];
      ls += __shfl_xor(ls, 32);
      const float inv = 1.f / ls;
      const int tq = tq0 + blk * 32;
#pragma unroll
      for (int g = 0; g < 4; ++g) {
        const int d0 = 8 * g + 4 * lh;
        store_bf4(O + (size_t)tq * 1024 + head * 64 + d0, o[blk][0][4 * g] * inv, o[blk][0][4 * g + 1] * inv, o[blk][0][4 * g + 2] * inv, o[blk][0][4 * g + 3] * inv);
        store_bf4(O + (size_t)tq * 1024 + head * 64 + 32 + d0, o[blk][1][4 * g] * inv, o[blk][1][4 * g + 1] * inv, o[blk][1][4 * g + 2] * inv, o[blk][1][4 * g + 3] * inv);
      }
    }
  }
}

#define XB_TMO      128
#define XB_XCNT(j)  (256  + 64 * (j))
#define XB_XSUB(j)  (1280 + 64 * (j))
#define XB_XGEN(j)  (2304 + 64 * (j))
#define XB_TOP      3328
#define XB_TOPGEN   3392
#define XCD_BAR_WORDS 3456
#define XB_SPIN_CAP (1u << 18)
#define LAS __attribute__((address_space(3)))

__device__ __forceinline__ unsigned xb_ld(unsigned* p)              { return __hip_atomic_load(p, __ATOMIC_RELAXED, __HIP_MEMORY_SCOPE_AGENT); }
__device__ __forceinline__ unsigned xb_add(unsigned* p, unsigned v) { return __hip_atomic_fetch_add(p, v, __ATOMIC_RELAXED, __HIP_MEMORY_SCOPE_AGENT); }
__device__ __forceinline__ unsigned xb_xcc_id() { return (unsigned)__builtin_amdgcn_s_getreg((3 << 11) | 20) & 0xFu; }
#define XB_SPIN(cond, bar) do { unsigned _sp = 0; while (cond) { __builtin_amdgcn_s_sleep(1); \
    if ((++_sp & 255u) == 0u) { if (xb_ld(&(bar)[XB_TMO])) break; if (_sp > XB_SPIN_CAP) { atomicAdd(&(bar)[XB_TMO], 1u); break; } } } } while (0)

struct XcdBarrier {
    unsigned* bar; unsigned x;
    volatile LAS unsigned* st;
};

__device__ __forceinline__ XcdBarrier xcd_barrier_post(unsigned* bar, volatile LAS unsigned* st) {
    XcdBarrier b; b.bar = bar; b.x = xb_xcc_id(); b.st = st;
    if (threadIdx.x == 0) (void)xb_add(&bar[XB_XCNT(b.x)], 1u);
    return b;
}
__device__ __forceinline__ void xcd_barrier_complete(unsigned* bar, unsigned x, unsigned& nloc, unsigned& nx) {
    const unsigned G = gridDim.x * gridDim.y * gridDim.z;
    unsigned sum, cnt, mine, sp = 0u;
    for (;;) {
        sum = 0u; cnt = 0u; mine = 0u;
#pragma unroll
        for (unsigned j = 0; j < 16; ++j) { const unsigned c = xb_ld(&bar[XB_XCNT(j)]); sum += c; cnt += (c > 0u) ? 1u : 0u; mine = (j == x) ? c : mine; }
        if (sum == G) break;
        __builtin_amdgcn_s_sleep(1);
        if ((++sp & 255u) == 0u) { if (xb_ld(&bar[XB_TMO])) break; if (sp > XB_SPIN_CAP) { atomicAdd(&bar[XB_TMO], 1u); break; } }
    }
    nloc = mine > 0u ? mine : 1u; nx = cnt > 0u ? cnt : 1u;
}

__device__ __forceinline__ void xcd_barrier(const XcdBarrier& b) {
    asm volatile("s_waitcnt vmcnt(0)" ::: "memory");
    __syncthreads();
    if (threadIdx.x == 0) {
        unsigned* bar = b.bar;
        __builtin_amdgcn_s_waitcnt(0);
        unsigned nloc = b.st[0], nx = b.st[1];
        if (nloc == 0u) { xcd_barrier_complete(bar, b.x, nloc, nx); b.st[0] = nloc; b.st[1] = nx; }
        const unsigned old = xb_add(&bar[XB_XSUB(b.x)], 1u);
        const unsigned gen = old / nloc;
        if (old + 1u == (gen + 1u) * nloc) {
            __builtin_amdgcn_fence(__ATOMIC_RELEASE, "agent");
            asm volatile("s_waitcnt vmcnt(0)" ::: "memory");
            const unsigned og = xb_add(&bar[XB_TOP], 1u);
            const unsigned tg = og / nx;
            if (og + 1u == (tg + 1u) * nx) xb_add(&bar[XB_TOPGEN], 1u);
            else XB_SPIN(xb_ld(&bar[XB_TOPGEN]) == tg, bar);
            __builtin_amdgcn_fence(__ATOMIC_ACQUIRE, "agent");
            xb_add(&bar[XB_XGEN(b.x)], 1u);
            asm volatile("s_waitcnt vmcnt(0)" ::: "memory");
        } else {
            XB_SPIN(xb_ld(&bar[XB_XGEN(b.x)]) == gen, bar);
            __builtin_amdgcn_fence(__ATOMIC_ACQUIRE, "agent");
            asm volatile("s_waitcnt vmcnt(0)" ::: "memory");
        }
    }
    __syncthreads();
}


DI void run_phase(const Params& p, int ph, char* lds) {
  const float* mod0 = p.MOD;
  const float* mod1 = p.MOD + 9 * 6144;
  switch (ph) {
    case 0: phase0(p, lds); break;
    case 1: norm_mod_phase(p.x, p.ctx, p.norm_mix, mod0, 0, 1, p.Hd, NT); break;
    case 2: phase_proj(p, lds); break;
    case 20: phase_mix(p); break;
    case 3: phase_prep(p, lds); break;
    case 4: phase_scan(p, lds); break;
    case 5: phase_readout(p, lds); break;
    case 6: phase_gemm_resid(p, lds, p.S[0], p.woT, 1024, NT / 256, p.x, p.ctx, mod0 + 2 * 1024); break;
    case 7: norm_mod_phase(p.out, p.XC, p.norm_mlp, mod0, 3, 4, p.S[5], NT); break;
    case 8: phase_up(p, lds, p.S[5], p.w1T[0], p.S[0], NT / 256); break;
    case 9: phase_gemm_resid(p, lds, p.S[0], p.w2T[0], 4096, NT / 256, p.out, p.XC, mod0 + 5 * 1024); break;
    case 10: norm_mod_phase(p.out, p.XC, p.norm_mix + 1024, mod1, 0, 1, p.S[5], NT); break;
    case 11: phase_qkv(p, lds); break;
    case 12: phase_attn(p, lds); break;
    case 13: phase_gemm_resid(p, lds, p.S[3], p.awoT, 1024, NL / 256, p.out, p.XC, mod1 + 2 * 1024); break;
    case 14: norm_mod_phase(p.out, p.XC, p.norm_mlp + 1024, mod1, 3, 4, p.S[5], NL); break;
    case 15: phase_up(p, lds, p.S[5], p.w1T[1], p.S[0], NL / 256); break;
    case 16: phase_gemm_resid(p, lds, p.S[0], p.w2T[1], 4096, NL / 256, p.out, p.XC, mod1 + 5 * 1024); break;
    case 17: final_norm_phase(p); break;
  }
}
constexpr int NPHASE = 18;

__global__ void __launch_bounds__(NTHREADS) mega_kernel(Params p) {
  extern __shared__ __attribute__((aligned(16))) char lds[];
  cg::grid_group grid = cg::this_grid();
  volatile LAS unsigned* st = (volatile LAS unsigned*)(LAS char*)(lds + 131072);
  if (threadIdx.x == 0) { st[0] = 0u; st[1] = 0u; }
  if (blockIdx.x == 0) for (int i = threadIdx.x; i < XCD_BAR_WORDS; i += NTHREADS) p.BAR[i] = 0u;
  __syncthreads();
  run_phase(p, 0, lds);
  grid.sync();
  const XcdBarrier xb = xcd_barrier_post(p.BAR, st);
#define PH(n) run_phase(p, n, lds); xcd_barrier(xb);
  PH(1) PH(20) PH(2) PH(3) PH(4) PH(5) PH(6) PH(7) PH(8) PH(9) PH(10) PH(11) PH(12) PH(13) PH(14) PH(15) PH(16)
  run_phase(p, 17, lds);
}

extern "C" void kernel_launch(void* const* d_in, const int* in_sizes, int n_in, void* d_out, int out_size, void* d_ws, size_t ws_size, hipStream_t stream) {
  Params p;
  memset(&p, 0, sizeof(p));
  const float* const* in = (const float* const*)d_in;
  p.x = in[0]; p.c = in[1]; p.ctx = in[2]; p.c_ctx = in[3]; p.w_mod = in[4]; p.b_mod = in[5]; p.norm_mix = in[6]; p.norm_mlp = in[7];
  p.mlp_w1 = in[8]; p.mlp_w2 = in[9]; p.mu = in[10]; p.wr = in[11]; p.wk = in[12]; p.wv = in[13]; p.wo = in[14]; p.w0 = in[15]; p.w1 = in[16];
  p.w2 = in[17]; p.a0 = in[18]; p.a1 = in[19]; p.a2 = in[20]; p.g1 = in[21]; p.g2 = in[22]; p.k_k = in[23]; p.k_a = in[24]; p.r_k = in[25];
  p.ln_w = in[26]; p.ln_b = in[27]; p.wqkv = in[28]; p.q_norm = in[29]; p.k_norm = in[30]; p.awo = in[31]; p.final_norm = in[32];
  p.out = (float*)d_out;
  char* ws = (char*)d_ws;
  size_t off = 0;
  auto take = [&](size_t bytes) -> char* { char* r = ws + off; off += (bytes + 255) & ~(size_t)255; return r; };
  p.Wcat = (bf16_t*)take((size_t)3456 * 1024 * 2);
  p.L2w = (bf16_t*)take((size_t)4 * 65536 * 2);
  p.g2T = (bf16_t*)take((size_t)1024 * 128 * 2);
  p.woT = (bf16_t*)take((size_t)1024 * 1024 * 2);
  p.w1T[0] = (bf16_t*)take((size_t)4096 * 1024 * 2);
  p.w1T[1] = (bf16_t*)take((size_t)4096 * 1024 * 2);
  p.w2T[0] = (bf16_t*)take((size_t)4096 * 1024 * 2);
  p.w2T[1] = (bf16_t*)take((size_t)4096 * 1024 * 2);
  p.wqkvT = (bf16_t*)take((size_t)1536 * 1024 * 2);
  p.awoT = (bf16_t*)take((size_t)1024 * 1024 * 2);
  p.MOD = (float*)take((size_t)2 * 9 * 6144 * 4);
  p.TAB = (float*)take((size_t)1024 * 2 * 4);
  p.XC = (float*)take((size_t)NC * 1024 * 4);
  p.BAR = (unsigned*)take((size_t)XCD_BAR_WORDS * 4);
  for (int i = 0; i < 6; ++i) p.S[i] = (bf16_t*)take((size_t)NT * 1024 * 2);
  if (off > ws_size) { fprintf(stderr, "kernel_launch: workspace too small (%zu needed, %zu given)\n", off, ws_size); return; }
  char* ob = (char*)d_out;
  p.Hd = (bf16_t*)ob;
  p.L1 = (bf16_t*)(ob + (size_t)NT * 1024 * 2);
  p.BON = (float*)(ob + (size_t)NT * 1024 * 2 + (size_t)NT * 384 * 2);
  p.NRM = (float*)(ob + (size_t)NT * 1024 * 2 + (size_t)NT * 384 * 2 + (size_t)NT * 16 * 4);
  int nj = 0, tiles = 0;
  auto job = [&](const float* src, bf16_t* dst, int K, int N) {
    p.jobs[nj].src = src; p.jobs[nj].dst = dst; p.jobs[nj].K = K; p.jobs[nj].N = N; p.jobs[nj].tstart = tiles; p.jobs[nj].tiles_n = N / 64;
    tiles += (K / 64) * (N / 64); ++nj;
  };
  job(p.wr, p.Wcat, 1024, 1024);
  job(p.wk, p.Wcat + (size_t)1024 * 1024, 1024, 1024);
  job(p.wv, p.Wcat + (size_t)2048 * 1024, 1024, 1024);
  job(p.g1, p.Wcat + (size_t)3072 * 1024, 1024, 128);
  job(p.w1, p.Wcat + (size_t)3200 * 1024, 1024, 64);
  job(p.w1 + 65536, p.Wcat + (size_t)3264 * 1024, 1024, 64);
  job(p.a1, p.Wcat + (size_t)3328 * 1024, 1024, 64);
  job(p.a1 + 65536, p.Wcat + (size_t)3392 * 1024, 1024, 64);
  job(p.a2, p.L2w, 64, 1024);
  job(p.a2 + 65536, p.L2w + 65536, 64, 1024);
  job(p.w2, p.L2w + 2 * 65536, 64, 1024);
  job(p.w2 + 65536, p.L2w + 3 * 65536, 64, 1024);
  job(p.g2, p.g2T, 128, 1024);
  job(p.wo, p.woT, 1024, 1024);
  job(p.mlp_w1, p.w1T[0], 1024, 4096);
  job(p.mlp_w1 + (size_t)4096 * 1024, p.w1T[1], 1024, 4096);
  job(p.mlp_w2, p.w2T[0], 4096, 1024);
  job(p.mlp_w2 + (size_t)4096 * 1024, p.w2T[1], 4096, 1024);
  job(p.wqkv, p.wqkvT, 1024, 1536);
  job(p.awo, p.awoT, 1024, 1024);
  p.njobs = nj; p.total_tiles = tiles;

  static int grid_blocks = 0;
  if (!grid_blocks) {
    (void)hipFuncSetAttribute((const void*)mega_kernel, hipFuncAttributeMaxDynamicSharedMemorySize, LDS_BYTES);
    int dev = 0, cus = 0, per_cu = 0;
    (void)hipGetDevice(&dev);
    (void)hipDeviceGetAttribute(&cus, hipDeviceAttributeMultiprocessorCount, dev);
    if (hipOccupancyMaxActiveBlocksPerMultiprocessor(&per_cu, (const void*)mega_kernel, NTHREADS, LDS_BYTES) != hipSuccess || per_cu < 1) per_cu = 1;
    if (cus <= 0) cus = 256;
    grid_blocks = cus * per_cu;
    (void)hipGetLastError();
  }
  void* args[] = {&p};
  hipError_t e = hipLaunchCooperativeKernel((const void*)mega_kernel, dim3(grid_blocks), dim3(NTHREADS), args, LDS_BYTES, stream);
  if (e != hipSuccess) fprintf(stderr, "cooperative launch failed: %s (grid %d)\n", hipGetErrorString(e), grid_blocks);
}
```

```cpp
#include <hip/hip_runtime.h>
#include <hip/hip_cooperative_groups.h>
#include <cstdint>
#include <cstring>
#include <cstdio>
namespace cg = cooperative_groups;

typedef unsigned short bf16_t;
typedef short bf16x8 __attribute__((ext_vector_type(8)));
typedef float f32x2 __attribute__((ext_vector_type(2)));
typedef float f32x4 __attribute__((ext_vector_type(4)));
typedef float f32x16 __attribute__((ext_vector_type(16)));
typedef __bf16 bf16x2_t __attribute__((ext_vector_type(2)));
#define DI __device__ __forceinline__

constexpr int D = 1024, NB = 8, SEQ = 4096, CTXL = 256;
constexpr int NL = NB * SEQ, NC = NB * CTXL, NT = NL + NC, DFF = 4096;
constexpr int NKEY = SEQ + CTXL;
constexpr int NTHREADS = 512;
constexpr int ROWB = 144;
constexpr int GEMM_STAGE = (256 + 128) * ROWB;
constexpr int LDS_BYTES = 131072 + 16;

struct TJob { const float* src; bf16_t* dst; int K, N, tstart, tiles_n; };

struct Params {
  const float *x, *c, *ctx, *c_ctx, *w_mod, *b_mod, *norm_mix, *norm_mlp, *mlp_w1, *mlp_w2;
  const float *mu, *wr, *wk, *wv, *wo, *w0, *w1, *w2, *a0, *a1, *a2, *g1, *g2, *k_k, *k_a, *r_k, *ln_w, *ln_b;
  const float *wqkv, *q_norm, *k_norm, *awo, *final_norm;
  float* out;
  bf16_t *Wcat, *L2w, *g2T, *woT, *w1T[2], *w2T[2], *wqkvT, *awoT;
  float *MOD, *TAB, *XC;
  bf16_t* S[6];
  bf16_t *Hd, *L1;
  float* BON;
  float* NRM;
  unsigned* BAR;
  TJob jobs[20];
  int njobs, total_tiles;
};

DI size_t HM(int t, int f) { return ((size_t)(f >> 6) * NT + t) * 64 + (f & 63); }
DI unsigned pack2(float lo, float hi) {
  f32x2 v = {lo, hi};
  bf16x2_t b = __builtin_convertvector(v, bf16x2_t);
  return __builtin_bit_cast(unsigned, b);
}
DI float bflo(unsigned u) { return __uint_as_float(u << 16); }
DI float bfhi(unsigned u) { return __uint_as_float(u & 0xffff0000u); }
DI void store_bf4(bf16_t* p, float a, float b, float c, float d) { *(uint2*)p = make_uint2(pack2(a, b), pack2(c, d)); }
DI void load_bf4(const bf16_t* p, float& a, float& b, float& c, float& d) { uint2 u = *(const uint2*)p; a = bflo(u.x); b = bfhi(u.x); c = bflo(u.y); d = bfhi(u.y); }
DI void store_bf8(bf16_t* p, const f32x4& a, const f32x4& b) {
  uint4 o; o.x = pack2(a[0], a[1]); o.y = pack2(a[2], a[3]); o.z = pack2(b[0], b[1]); o.w = pack2(b[2], b[3]);
  *(uint4*)p = o;
}
DI void store16_sc1(void* p, const uint4& v) {
  typedef unsigned u32x4_t __attribute__((ext_vector_type(4)));
  const u32x4_t d = {v.x, v.y, v.z, v.w};
  asm volatile("global_store_dwordx4 %0, %1, off sc1" :: "v"(p), "v"(d) : "memory");
}
DI void unpack_bf8(const uint4& u, float (&o)[8]) {
  o[0] = bflo(u.x); o[1] = bfhi(u.x); o[2] = bflo(u.y); o[3] = bfhi(u.y); o[4] = bflo(u.z); o[5] = bfhi(u.z); o[6] = bflo(u.w); o[7] = bfhi(u.w);
}
DI int perm32(int rho) { return 8 * ((rho & 15) >> 2) + 4 * (rho >> 4) + (rho & 3); }
DI float sigmoidf_(float x) { return 1.f / (1.f + __expf(-x)); }
DI float tanhf_(float x) { return 1.f - 2.f / (1.f + __expf(2.f * x)); }
DI float wave_sum(float x) {
#pragma unroll
  for (int m = 1; m < 64; m <<= 1) x += __shfl_xor(x, m);
  return x;
}
#define MFMA16(a, b, c) __builtin_amdgcn_mfma_f32_16x16x32_bf16((a), (b), (c), 0, 0, 0)
#define MFMA32(a, b, c) __builtin_amdgcn_mfma_f32_32x32x16_bf16((a), (b), (c), 0, 0, 0)

DI unsigned lerp2(unsigned a, unsigned n, float ma, float mb) {
  const float h0 = bflo(a), h1 = bfhi(a), s0 = bflo(n), s1 = bfhi(n);
  return pack2(h0 + (s0 - h0) * ma, h1 + (s1 - h1) * mb);
}
template <bool LERP>
DI void gemm_tile(const bf16_t* __restrict__ X, int ldx, const bf16_t* __restrict__ W, int ldw, int K, int tok0, int f0,
                  char* lds, f32x4 (&acc)[4][4], const float* __restrict__ mu) {
  const int tid = threadIdx.x, lane = tid & 63, wave = tid >> 6;
  const int wt = wave & 3, wf = wave >> 2, lr = lane & 15, lq = lane >> 4;
  const int lrow = tid >> 3, kc = tid & 7;
#pragma unroll
  for (int i = 0; i < 4; ++i)
#pragma unroll
    for (int j = 0; j < 4; ++j) acc[i][j] = f32x4{0.f, 0.f, 0.f, 0.f};
  uint4 xr[4], wr[2], xn[4];
  float4 m0 = make_float4(0, 0, 0, 0), m1 = m0;
  const int nk = K >> 6;
  __syncthreads();
  for (int kt = -1; kt < nk; ++kt) {
    const bool more = kt + 1 < nk;
    if (more) {
      const int k0 = (kt + 1) << 6;
#pragma unroll
      for (int i = 0; i < 4; ++i) {
        const int tg = tok0 + lrow + 64 * i;
        xr[i] = *(const uint4*)(X + (size_t)tg * ldx + k0 + kc * 8);
        if (LERP) {
          int nb; bool valid;
          if (tok0 < NL) {
            const int s = tg & 4095, col = s & 63, rw = s >> 6, qd = k0 >> 8;
            if (qd == 0) { valid = col > 0; nb = tg - 1; }
            else if (qd == 1) { valid = col < 63; nb = tg + 1; }
            else if (qd == 2) { valid = rw > 0; nb = tg - 64; }
            else { valid = rw < 63; nb = tg + 64; }
          } else {
            const int s = (tg - NL) & 255;
            if (k0 < 512) { valid = s > 0; nb = tg - 1; }
            else { valid = s < 255; nb = tg + 1; }
          }
          if (valid) xn[i] = *(const uint4*)(X + (size_t)nb * ldx + k0 + kc * 8);
          else xn[i] = make_uint4(0, 0, 0, 0);
        }
      }
#pragma unroll
      for (int i = 0; i < 2; ++i) wr[i] = *(const uint4*)(W + (size_t)(f0 + 64 * i + (lrow & 32) + perm32(lrow & 31)) * ldw + k0 + kc * 8);
      if (LERP) { m0 = *(const float4*)(mu + k0 + kc * 8); m1 = *(const float4*)(mu + k0 + kc * 8 + 4); }
    }
    if (kt >= 0) {
      const char* xs = lds + (kt & 1) * GEMM_STAGE;
      const char* wsm = xs + 256 * ROWB;
#pragma unroll
      for (int ks = 0; ks < 2; ++ks) {
        bf16x8 wfr[4], xfr[4];
#pragma unroll
        for (int i = 0; i < 4; ++i) wfr[i] = *(const bf16x8*)(wsm + (wf * 64 + i * 16 + lr) * ROWB + ks * 64 + lq * 16);
#pragma unroll
        for (int i = 0; i < 4; ++i) xfr[i] = *(const bf16x8*)(xs + (wt * 64 + i * 16 + lr) * ROWB + ks * 64 + lq * 16);
#pragma unroll
        for (int fi = 0; fi < 4; ++fi)
#pragma unroll
          for (int ti = 0; ti < 4; ++ti) acc[fi][ti] = MFMA16(wfr[fi], xfr[ti], acc[fi][ti]);
      }
    }
    if (more) {
      char* xs = lds + ((kt + 1) & 1) * GEMM_STAGE;
      char* wsm = xs + 256 * ROWB;
#pragma unroll
      for (int i = 0; i < 4; ++i) {
        uint4 v = xr[i];
        if (LERP) {
          v.x = lerp2(xr[i].x, xn[i].x, m0.x, m0.y);
          v.y = lerp2(xr[i].y, xn[i].y, m0.z, m0.w);
          v.z = lerp2(xr[i].z, xn[i].z, m1.x, m1.y);
          v.w = lerp2(xr[i].w, xn[i].w, m1.z, m1.w);
        }
        *(uint4*)(xs + (lrow + 64 * i) * ROWB + kc * 16) = v;
      }
#pragma unroll
      for (int i = 0; i < 2; ++i) *(uint4*)(wsm + (lrow + 64 * i) * ROWB + kc * 16) = wr[i];
    }
    __syncthreads();
  }
}


namespace g256 {
constexpr int BK = 64, HALF = 128, HT = HALF * BK;
DI int lds_byte(int r, int c) { const int st = (r >> 4) * 2 + (c >> 5), rr = r & 15, cc = c & 31, ob = rr * 64 + cc * 2; return st * 1024 + (ob ^ (((ob >> 9) & 1) << 5)); }
DI void stage_rc(int b, int& R, int& C) { const int st = b / 1024, sb = b % 1024, swz = sb ^ (((sb >> 9) & 1) << 5); R = (st >> 1) * 16 + swz / 64; C = (st & 1) * 32 + (swz % 64) / 2; }
}
#define G_SA(b, h) (((b) * 2 + (h)) * 16384)
#define G_SB(b, h) ((4 + (b) * 2 + (h)) * 16384)
#define G_STAGEV(bufoff, gbase, vo) do { _Pragma("unroll") for (int _i = 0; _i < 2; ++_i) \
    __builtin_amdgcn_global_load_lds((const unsigned*)((const char*)(gbase) + (vo)[_i]), (__attribute__((address_space(3))) unsigned*)(lds + (bufoff) + ldsw + _i * 8192), 16, 0, 0); } while (0)
#define G_LDA(dst, b, h) do { _Pragma("unroll") for (int m = 0; m < 4; ++m) _Pragma("unroll") for (int k = 0; k < 2; ++k) \
    dst[m][k] = *(const __attribute__((address_space(3))) bf16x8*)(lds + G_SA(b, h) + aoff + m * 2048 + k * 1024); } while (0)
#define G_LDB(dst, b, h) do { _Pragma("unroll") for (int n = 0; n < 2; ++n) _Pragma("unroll") for (int k = 0; k < 2; ++k) \
    dst[n][k] = *(const __attribute__((address_space(3))) bf16x8*)(lds + G_SB(b, h) + boff + n * 2048 + k * 1024); } while (0)
#define G_MMA(ai, bj, At, Bt) do { __builtin_amdgcn_s_setprio(1); \
    _Pragma("unroll") for (int m = 0; m < 4; ++m) _Pragma("unroll") for (int n = 0; n < 2; ++n) _Pragma("unroll") for (int k = 0; k < 2; ++k) \
      acc[ai][bj][m][n] = __builtin_amdgcn_mfma_f32_16x16x32_bf16(At[m][k], Bt[n][k], acc[ai][bj][m][n], 0, 0, 0); \
    __builtin_amdgcn_s_setprio(0); } while (0)
#define G_WAIT_V(n) asm volatile("s_waitcnt vmcnt(" #n ")" ::: "memory")
#define G_WAIT_L(n) asm volatile("s_waitcnt lgkmcnt(" #n ")" ::: "memory")
#define G_BAR __builtin_amdgcn_s_barrier()
#define G_SCHED __builtin_amdgcn_sched_barrier(0)

template <bool PERM>
DI void gemm256_tile(const bf16_t* __restrict__ A, const bf16_t* __restrict__ Bt, int K, int brow, int bcol, char* lds_, f32x4 (&acc)[2][2][4][2], int ld = 0) {
  if (ld == 0) ld = K;
  __attribute__((address_space(3))) unsigned char* lds = (__attribute__((address_space(3))) unsigned char*)lds_;
  int tid = threadIdx.x; asm volatile("" : "+v"(tid));
  const int wid = __builtin_amdgcn_readfirstlane(tid >> 6), lane = tid & 63, wr = wid >> 2, wc = wid & 3, fr = lane & 15, fq = lane >> 4;
#pragma unroll
  for (int a = 0; a < 2; ++a)
#pragma unroll
    for (int b = 0; b < 2; ++b)
#pragma unroll
      for (int m = 0; m < 4; ++m)
#pragma unroll
        for (int n = 0; n < 2; ++n) acc[a][b][m][n] = f32x4{0.f, 0.f, 0.f, 0.f};
  unsigned voff[2], voffA[2];
#pragma unroll
  for (int i = 0; i < 2; ++i) { int R, C; g256::stage_rc(tid * 16 + i * 8192, R, C); voff[i] = (unsigned)(R * ld + C) * 2u;
    const int Ra = PERM ? ((R & ~31) + perm32(R & 31)) : R; voffA[i] = (unsigned)(Ra * ld + C) * 2u; }
  const size_t kstep = 128, hstep = (size_t)128 * ld * 2;
  const unsigned ldsw = (unsigned)wid * 1024u;
  const int aoff = g256::lds_byte(wr * 64 + fr, fq * 8), boff = g256::lds_byte(wc * 32 + fr, fq * 8);
  const char* cA = (const char*)A + (size_t)brow * ld * 2;
  const char* cB = (const char*)Bt + (size_t)bcol * ld * 2;
  bf16x8 At[4][2], B0[2][2], B1[2][2];
  const int nt = K / g256::BK;
  __syncthreads();
  G_STAGEV(G_SB(0, 0), cB, voff); G_STAGEV(G_SA(0, 0), cA, voffA); G_STAGEV(G_SB(0, 1), cB + hstep, voff); G_STAGEV(G_SA(0, 1), cA + hstep, voffA);
  if (wr == 1) G_BAR;
  G_WAIT_V(4); G_BAR;
  G_STAGEV(G_SB(1, 0), cB + kstep, voff); G_STAGEV(G_SA(1, 0), cA + kstep, voffA); G_STAGEV(G_SB(1, 1), cB + hstep + kstep, voff);
  G_WAIT_V(6); G_BAR;
  for (int t = 0; t < nt - 2; t += 2) {
    const char* a1 = cA + (size_t)(t + 1) * kstep;
    const char* a2 = cA + (size_t)(t + 2) * kstep; const char* b2 = cB + (size_t)(t + 2) * kstep;
    const char* a3 = a2 + kstep; const char* b3 = b2 + kstep;
    G_LDB(B0, 0, 0); G_SCHED; G_LDA(At, 0, 0); G_STAGEV(G_SA(1, 1), a1 + hstep, voffA);
    G_WAIT_L(8); G_BAR; G_WAIT_L(0); G_MMA(0, 0, At, B0); G_BAR; G_SCHED;
    G_LDB(B1, 0, 1); G_STAGEV(G_SB(0, 0), b2, voff);
    G_BAR; G_WAIT_L(0); G_MMA(0, 1, At, B1); G_BAR;
    G_LDA(At, 0, 1); G_STAGEV(G_SA(0, 0), a2, voffA);
    G_BAR; G_WAIT_L(0); G_MMA(1, 0, At, B0); G_BAR; G_SCHED;
    G_STAGEV(G_SB(0, 1), b2 + hstep, voff);
    G_WAIT_V(6); G_BAR; G_MMA(1, 1, At, B1); G_BAR;
    G_LDB(B0, 1, 0); G_SCHED; G_LDA(At, 1, 0); G_STAGEV(G_SA(0, 1), a2 + hstep, voffA);
    G_WAIT_L(8); G_BAR; G_WAIT_L(0); G_MMA(0, 0, At, B0); G_BAR; G_SCHED;
    G_LDB(B1, 1, 1); G_STAGEV(G_SB(1, 0), b3, voff);
    G_BAR; G_WAIT_L(0); G_MMA(0, 1, At, B1); G_BAR;
    G_LDA(At, 1, 1); G_STAGEV(G_SA(1, 0), a3, voffA);
    G_BAR; G_WAIT_L(0); G_MMA(1, 0, At, B0); G_BAR; G_SCHED;
    G_STAGEV(G_SB(1, 1), b3 + hstep, voff);
    G_WAIT_V(6); G_BAR; G_MMA(1, 1, At, B1); G_BAR;
  }
  { G_LDB(B0, 0, 0); G_LDA(At, 0, 0); G_STAGEV(G_SA(1, 1), cA + (size_t)(nt - 1) * kstep + hstep, voffA);
    G_BAR; G_WAIT_L(0); G_MMA(0, 0, At, B0); G_BAR;
    G_LDB(B1, 0, 1); G_BAR; G_WAIT_L(0); G_MMA(0, 1, At, B1); G_BAR;
    G_LDA(At, 0, 1); G_WAIT_V(4); G_BAR; G_WAIT_L(0); G_MMA(1, 0, At, B0); G_MMA(1, 1, At, B1); G_BAR; }
  { G_LDB(B0, 1, 0); G_LDA(At, 1, 0); G_WAIT_V(2); G_BAR; G_WAIT_L(0); G_MMA(0, 0, At, B0); G_BAR;
    G_LDB(B1, 1, 1); G_WAIT_V(0); G_BAR; G_WAIT_L(0); G_MMA(0, 1, At, B1); G_BAR;
    G_LDA(At, 1, 1); G_BAR; G_WAIT_L(0); G_MMA(1, 0, At, B0); G_MMA(1, 1, At, B1); G_BAR; }
  if (wr == 0) G_BAR;
}

DI void tile_map(int L, int total, int ntm, int ntn, int& mt, int& nt) {
  const int q = total >> 3, r = total & 7, xcd = L & 7, off = L >> 3;
  const int id = (xcd < r ? xcd * (q + 1) : r * (q + 1) + (xcd - r) * q) + off;
  const int nig = 8 * ntn, g = id / nig, w = id % nig, fm = g * 8, gsz = min(ntm - fm, 8);
  mt = fm + w % gsz; nt = w / gsz;
}
DI void convert_tile(const TJob& jb, int t, char* lds) {
  float* tile = (float*)lds;
  const int tid = threadIdx.x;
  const int tk = t / jb.tiles_n, tn = t % jb.tiles_n;
  const int k0 = tk * 64, n0 = tn * 64;
  __syncthreads();
#pragma unroll
  for (int i = 0; i < 2; ++i) {
    const int idx = tid + 512 * i, row = idx >> 4, c4 = idx & 15;
    const float4 v = *(const float4*)(jb.src + (size_t)(k0 + row) * jb.N + n0 + c4 * 4);
    tile[row * 65 + c4 * 4 + 0] = v.x; tile[row * 65 + c4 * 4 + 1] = v.y; tile[row * 65 + c4 * 4 + 2] = v.z; tile[row * 65 + c4 * 4 + 3] = v.w;
  }
  __syncthreads();
  const int n = tid >> 3, kc = tid & 7;
  float v[8];
#pragma unroll
  for (int j = 0; j < 8; ++j) v[j] = tile[(kc * 8 + j) * 65 + n];
  uint4 o;
  o.x = pack2(v[0], v[1]); o.y = pack2(v[2], v[3]); o.z = pack2(v[4], v[5]); o.w = pack2(v[6], v[7]);
  *(uint4*)(jb.dst + (size_t)(n0 + n) * jb.K + k0 + kc * 8) = o;
}

DI void mod_unit(const Params& p, int mu_, char* lds) {
  const int tid = threadIdx.x;
  const int layer = mu_ / 96, cc = mu_ % 96;
  float* sc = (float*)lds;
  float* red = sc + 9 * 1024;
  __syncthreads();
  for (int i = tid; i < 9 * 1024; i += 512) {
    const int row = i >> 10, k = i & 1023;
    const float v = row < 8 ? p.c[row * 1024 + k] : p.c_ctx[k];
    sc[i] = v / (1.f + __expf(-v));
  }
  __syncthreads();
  const int kg = tid >> 6, col = tid & 63;
  const float* w = p.w_mod + (size_t)layer * 1024 * 6144 + cc * 64 + col;
  float a[9];
#pragma unroll
  for (int r = 0; r < 9; ++r) a[r] = 0.f;
#pragma unroll 16
  for (int k = kg * 128; k < kg * 128 + 128; ++k) {
    const float wv = w[(size_t)k * 6144];
#pragma unroll
    for (int r = 0; r < 9; ++r) a[r] += sc[r * 1024 + k] * wv;
  }
#pragma unroll
  for (int r = 0; r < 9; ++r) red[(kg * 9 + r) * 64 + col] = a[r];
  __syncthreads();
  for (int i = tid; i < 576; i += 512) {
    const int r = i >> 6, cl = i & 63;
    float s = 0.f;
#pragma unroll
    for (int g = 0; g < 8; ++g) s += red[(g * 9 + r) * 64 + cl];
    const int n = cc * 64 + cl;
    p.MOD[(layer * 9 + r) * 6144 + n] = s + p.b_mod[layer * 6144 + n];
  }
  __syncthreads();
}

DI void sincos_d(double a, double& s, double& c) {
  const double n = rint(a * 0.6366197723675814);
  const double r = (a - n * 1.5707963267948966) - n * 6.123233995736766e-17;
  const double r2 = r * r;
  const double sp = r * (1.0 + r2 * (-1.0 / 6.0 + r2 * (1.0 / 120.0 + r2 * (-1.0 / 5040.0 + r2 * (1.0 / 362880.0 + r2 * (-1.0 / 39916800.0 + r2 * (1.0 / 6227020800.0)))))));
  const double cp = 1.0 + r2 * (-0.5 + r2 * (1.0 / 24.0 + r2 * (-1.0 / 720.0 + r2 * (1.0 / 40320.0 + r2 * (-1.0 / 3628800.0 + r2 * (1.0 / 479001600.0 + r2 * (-1.0 / 87178291200.0)))))));
  const int q = ((int)n) & 3;
  if (q == 0) { s = sp; c = cp; }
  else if (q == 1) { s = cp; c = -sp; }
  else if (q == 2) { s = -sp; c = -cp; }
  else { s = -cp; c = sp; }
}

DI void tab_unit(const Params& p) {
  for (int idx = threadIdx.x; idx < 1024; idx += 512) {
    const int pos = idx >> 4, fi = idx & 15;
    double f = 1.0;
    for (int i = 0; i < fi; ++i) f *= 0.5623413251903491;
    double s, c;
    sincos_d((double)pos * (double)(float)f, s, c);
    p.TAB[idx * 2 + 0] = (float)c;
    p.TAB[idx * 2 + 1] = (float)s;
  }
}

DI void phase0(const Params& p, char* lds) {
  const int total = p.total_tiles + 192 + 1;
  for (int u = blockIdx.x; u < total; u += gridDim.x) {
    if (u < p.total_tiles) {
      int j = 0;
#pragma unroll 1
      for (int q = 1; q < p.njobs; ++q) if (u >= p.jobs[q].tstart) j = q;
      convert_tile(p.jobs[j], u - p.jobs[j].tstart, lds);
    } else if (u < p.total_tiles + 192) {
      mod_unit(p, u - p.total_tiles, lds);
    } else {
      tab_unit(p);
    }
  }
}

DI void norm_mod_phase(const float* __restrict__ xl, const float* __restrict__ xc, const float* __restrict__ gain,
                               const float* __restrict__ mod, int shift_i, int scale_i, bf16_t* __restrict__ H, int ntok) {
  int tid_ = threadIdx.x; asm volatile("" : "+v"(tid_));
  const int lane = tid_ & 63;
  const int wg = blockIdx.x * 8 + (tid_ >> 6), nw = gridDim.x * 8;
  for (int t = wg; t < ntok; t += nw) {
    const float* row = t < NL ? xl + (size_t)t * 1024 : xc + (size_t)(t - NL) * 1024;
    float4 v[4];
    float ss = 0.f;
#pragma unroll
    for (int i = 0; i < 4; ++i) {
      v[i] = *(const float4*)(row + (lane + 64 * i) * 4);
      ss += v[i].x * v[i].x + v[i].y * v[i].y + v[i].z * v[i].z + v[i].w * v[i].w;
    }
    ss = wave_sum(ss);
    const float rstd = rsqrtf(ss * (1.f / 1024.f) + 1e-6f);
    const int bp = t < NL ? (t >> 12) : 8;
    const float* sh = mod + (bp * 6 + shift_i) * 1024;
    const float* sc = mod + (bp * 6 + scale_i) * 1024;
#pragma unroll
    for (int i = 0; i < 4; ++i) {
      const int c = (lane + 64 * i) * 4;
      const float4 g = *(const float4*)(gain + c), s4 = *(const float4*)(sh + c), c4 = *(const float4*)(sc + c);
      store_bf4(H + (size_t)t * 1024 + c,
                v[i].x * rstd * g.x * (1.f + c4.x) + s4.x, v[i].y * rstd * g.y * (1.f + c4.y) + s4.y,
                v[i].z * rstd * g.z * (1.f + c4.z) + s4.z, v[i].w * rstd * g.w * (1.f + c4.w) + s4.w);
    }
  }
}

DI void final_norm_phase(const Params& p) {
  int tid_ = threadIdx.x; asm volatile("" : "+v"(tid_));
  const int lane = tid_ & 63;
  const int wg = blockIdx.x * 8 + (tid_ >> 6), nw = gridDim.x * 8;
  for (int t = wg; t < NL; t += nw) {
    float* row = p.out + (size_t)t * 1024;
    float4 v[4];
    float ss = 0.f;
#pragma unroll
    for (int i = 0; i < 4; ++i) {
      v[i] = *(const float4*)(row + (lane + 64 * i) * 4);
      ss += v[i].x * v[i].x + v[i].y * v[i].y + v[i].z * v[i].z + v[i].w * v[i].w;
    }
    ss = wave_sum(ss);
    const float rstd = rsqrtf(ss * (1.f / 1024.f) + 1e-6f);
#pragma unroll
    for (int i = 0; i < 4; ++i) {
      const int c = (lane + 64 * i) * 4;
      const float4 g = *(const float4*)(p.final_norm + c);
      *(float4*)(row + c) = make_float4(v[i].x * rstd * g.x, v[i].y * rstd * g.y, v[i].z * rstd * g.z, v[i].w * rstd * g.w);
    }
  }
}

DI void phase_mix(const Params& p) {
  const int lane = threadIdx.x & 63;
  const int wg = blockIdx.x * 8 + (threadIdx.x >> 6), nw = gridDim.x * 8;
  for (int t = wg; t < NT; t += nw) {
#pragma unroll
    for (int i = 0; i < 2; ++i) {
      const int c = lane * 8 + 512 * i;
      const uint4 own = *(const uint4*)(p.Hd + (size_t)t * 1024 + c);
      int nb; bool valid;
      if (t < NL) {
        const int s = t & 4095, col = s & 63, rw = s >> 6, qd = c >> 8;
        if (qd == 0) { valid = col > 0; nb = t - 1; }
        else if (qd == 1) { valid = col < 63; nb = t + 1; }
        else if (qd == 2) { valid = rw > 0; nb = t - 64; }
        else { valid = rw < 63; nb = t + 64; }
      } else {
        const int s = (t - NL) & 255;
        if (c < 512) { valid = s > 0; nb = t - 1; }
        else { valid = s < 255; nb = t + 1; }
      }
      uint4 nv = make_uint4(0, 0, 0, 0);
      if (valid) nv = *(const uint4*)(p.Hd + (size_t)nb * 1024 + c);
#pragma unroll
      for (int j = 0; j < 3; ++j) {
        const int mi = j == 0 ? 0 : j == 1 ? 2 : 3;
        const float4 m0 = *(const float4*)(p.mu + mi * 1024 + c), m1 = *(const float4*)(p.mu + mi * 1024 + c + 4);
        uint4 o;
        o.x = lerp2(own.x, nv.x, m0.x, m0.y); o.y = lerp2(own.y, nv.y, m0.z, m0.w);
        o.z = lerp2(own.z, nv.z, m1.x, m1.y); o.w = lerp2(own.w, nv.w, m1.z, m1.w);
        *(uint4*)(p.S[3 + j] + (size_t)t * 1024 + c) = o;
      }
    }
  }
}

DI void phase_proj(const Params& p, char* lds) {
  const int lane = threadIdx.x & 63, wave = threadIdx.x >> 6;
  constexpr int NLORA = (NT / 256) * 3, NRKV = (NT / 256) * 12;
  for (int u = blockIdx.x; u < NLORA; u += gridDim.x) {
    {
      const int wt = wave & 3, wf = wave >> 2, lr = lane & 15, lq = lane >> 4;
      const int mt = u / 3, nt = 24 + u % 3;
      const int mi = nt == 24 ? 5 : nt == 25 ? 1 : 4;
      f32x4 acc[4][4];
      gemm_tile<true>(p.Hd, 1024, p.Wcat, 1024, 1024, mt * 256, nt * 128, lds, acc, p.mu + mi * 1024);
#pragma unroll
      for (int pp = 0; pp < 2; ++pp)
#pragma unroll
        for (int ti = 0; ti < 4; ++ti) {
          const int t = mt * 256 + wt * 64 + ti * 16 + lr;
          const int fl = wf * 64 + pp * 32 + lq * 8;
          f32x4 a = acc[2 * pp][ti], b = acc[2 * pp + 1][ti];
          if (nt == 24) {
#pragma unroll
            for (int j = 0; j < 4; ++j) { a[j] = sigmoidf_(a[j]); b[j] = sigmoidf_(b[j]); }
            store_bf8(p.L1 + (size_t)t * 384 + fl, a, b);
          } else if (nt == 25) {
#pragma unroll
            for (int j = 0; j < 4; ++j) { a[j] = tanhf_(a[j]); b[j] = tanhf_(b[j]); }
            store_bf8(p.L1 + (size_t)t * 384 + 128 + fl, a, b);
          } else {
            store_bf8(p.L1 + (size_t)t * 384 + 256 + fl, a, b);
          }
        }
    }
  }
  for (int v0 = blockIdx.x; v0 < NRKV; v0 += gridDim.x) {
    {
      const int wr = wave >> 2, wc = wave & 3;
      f32x4 acc[2][2][4][2];
      { int mt0, rem0; tile_map(v0, NRKV, NT / 256, 12, mt0, rem0); const int j0 = rem0 >> 2, nt0 = rem0 & 3;
        gemm256_tile<true>(p.Wcat + (size_t)j0 * 1024 * 1024, p.S[3 + j0], 1024, nt0 * 256, mt0 * 256, lds, acc); }
      int lane_o = threadIdx.x & 63; asm volatile("" : "+v"(lane_o));
      int v = v0; asm volatile("" : "+s"(v));
      int mt, rem; tile_map(v, NRKV, NT / 256, 12, mt, rem); const int j = rem >> 2, nt = rem & 3;
      const int fr = lane_o & 15, fq = lane_o >> 4;
#pragma unroll
      for (int bj = 0; bj < 2; ++bj)
#pragma unroll
        for (int n = 0; n < 2; ++n) {
          const int t = mt * 256 + bj * 128 + wc * 32 + n * 16 + fr;
#pragma unroll
          for (int ai = 0; ai < 2; ++ai) {
            const int fh = nt * 256 + ai * 128 + wr * 64;
            if (j == 1) {
              f32x4 a[2], b[2];
              float ss = 0.f;
#pragma unroll
              for (int mp = 0; mp < 2; ++mp) {
                const int f = fh + mp * 32 + fq * 8;
                const float4 kkl = *(const float4*)(p.k_k + f), kkh = *(const float4*)(p.k_k + f + 4);
                a[mp] = acc[ai][bj][2 * mp][n]; b[mp] = acc[ai][bj][2 * mp + 1][n];
                a[mp][0] *= kkl.x; a[mp][1] *= kkl.y; a[mp][2] *= kkl.z; a[mp][3] *= kkl.w;
                b[mp][0] *= kkh.x; b[mp][1] *= kkh.y; b[mp][2] *= kkh.z; b[mp][3] *= kkh.w;
#pragma unroll
                for (int e2 = 0; e2 < 4; ++e2) ss += a[mp][e2] * a[mp][e2] + b[mp][e2] * b[mp][e2];
              }
              ss += __shfl_xor(ss, 16); ss += __shfl_xor(ss, 32);
              const float kinv = rsqrtf(ss + 1e-12f);
#pragma unroll
              for (int mp = 0; mp < 2; ++mp) {
#pragma unroll
                for (int e2 = 0; e2 < 4; ++e2) { a[mp][e2] *= kinv; b[mp][e2] *= kinv; }
                store_bf8(p.S[2] + HM(t, fh + mp * 32 + fq * 8), a[mp], b[mp]);
              }
              if (fq == 0) p.NRM[(size_t)(fh >> 6) * NT + t] = sqrtf(ss + 1e-12f);
            } else {
              bf16_t* dst = j == 0 ? p.S[0] : p.S[1];
#pragma unroll
              for (int mp = 0; mp < 2; ++mp)
                store_bf8(dst + HM(t, fh + mp * 32 + fq * 8), acc[ai][bj][2 * mp][n], acc[ai][bj][2 * mp + 1][n]);
            }
          }
        }
    }
  }
}

DI void phase_prep(const Params& p, char* lds) {
  const int lane = threadIdx.x & 63, wave = threadIdx.x >> 6;
  const int wt = wave & 3, wf = wave >> 2, lr = lane & 15, lq = lane >> 4;
  const int total = (NT / 256) * 8;
  for (int u = blockIdx.x; u < total; u += gridDim.x) {
    const int mt = u >> 3, nt = u & 7;
    const int tok0 = mt * 256, f0 = nt * 128;
    f32x4 acc[4][4];
    uint4 afp[2][4];
    gemm_tile<false>(p.L1 + 256, 384, p.L2w + 0 * 65536, 64, 64, tok0, f0, lds, acc, nullptr);
#pragma unroll
    for (int pp = 0; pp < 2; ++pp) {
      const int f = f0 + wf * 64 + pp * 32 + lq * 8;
      const float4 a0l = *(const float4*)(p.a0 + f), a0h = *(const float4*)(p.a0 + f + 4);
#pragma unroll
      for (int ti = 0; ti < 4; ++ti) {
        const int t = tok0 + wt * 64 + ti * 16 + lr;
        f32x4 a = acc[2 * pp][ti], b = acc[2 * pp + 1][ti];
        a[0] = sigmoidf_(a[0] + a0l.x); a[1] = sigmoidf_(a[1] + a0l.y); a[2] = sigmoidf_(a[2] + a0l.z); a[3] = sigmoidf_(a[3] + a0l.w);
        b[0] = sigmoidf_(b[0] + a0h.x); b[1] = sigmoidf_(b[1] + a0h.y); b[2] = sigmoidf_(b[2] + a0h.z); b[3] = sigmoidf_(b[3] + a0h.w);
        uint4 o; o.x = pack2(a[0], a[1]); o.y = pack2(a[2], a[3]); o.z = pack2(b[0], b[1]); o.w = pack2(b[2], b[3]);
        afp[pp][ti] = o;
        *(uint4*)(p.S[3] + HM(t, f)) = o;
      }
    }
    gemm_tile<false>(p.L1 + 320, 384, p.L2w + 1 * 65536, 64, 64, tok0, f0, lds, acc, nullptr);
#pragma unroll
    for (int ti = 0; ti < 4; ++ti) {
      const int t = tok0 + wt * 64 + ti * 16 + lr;
      float bon = 0.f;
      const float nrm = p.NRM[(size_t)(nt * 2 + wf) * NT + t];
#pragma unroll
      for (int pp = 0; pp < 2; ++pp) {
        const int f = f0 + wf * 64 + pp * 32 + lq * 8;
        const float4 a0l = *(const float4*)(p.a0 + 1024 + f), a0h = *(const float4*)(p.a0 + 1024 + f + 4);
        const float4 rkl = *(const float4*)(p.r_k + f), rkh = *(const float4*)(p.r_k + f + 4);
        const float4 kal = *(const float4*)(p.k_a + f), kah = *(const float4*)(p.k_a + f + 4);
        const float4 kkl = *(const float4*)(p.k_k + f), kkh = *(const float4*)(p.k_k + f + 4);
        const float rk8[8] = {rkl.x, rkl.y, rkl.z, rkl.w, rkh.x, rkh.y, rkh.z, rkh.w};
        const float ka8[8] = {kal.x, kal.y, kal.z, kal.w, kah.x, kah.y, kah.z, kah.w};
        const float kk8[8] = {kkl.x, kkl.y, kkl.z, kkl.w, kkh.x, kkh.y, kkh.z, kkh.w};
        f32x4 a = acc[2 * pp][ti], b = acc[2 * pp + 1][ti];
        a[0] = sigmoidf_(a[0] + a0l.x); a[1] = sigmoidf_(a[1] + a0l.y); a[2] = sigmoidf_(a[2] + a0l.z); a[3] = sigmoidf_(a[3] + a0l.w);
        b[0] = sigmoidf_(b[0] + a0h.x); b[1] = sigmoidf_(b[1] + a0h.y); b[2] = sigmoidf_(b[2] + a0h.z); b[3] = sigmoidf_(b[3] + a0h.w);
        store_bf8(p.S[4] + HM(t, f), a, b);
        const float ab8[8] = {a[0], a[1], a[2], a[3], b[0], b[1], b[2], b[3]};
        float af8[8], r8[8], k8[8];
        unpack_bf8(afp[pp][ti], af8);
        unpack_bf8(*(const uint4*)(p.S[0] + HM(t, f)), r8);
        unpack_bf8(*(const uint4*)(p.S[2] + HM(t, f)), k8);
#pragma unroll
        for (int e2 = 0; e2 < 8; ++e2) {
          const float k = k8[e2] * nrm / kk8[e2];
          bon += r8[e2] * k * rk8[e2] * (2.f + (ab8[e2] + af8[e2] - 2.f) * ka8[e2]);
        }
      }
      bon += __shfl_xor(bon, 16); bon += __shfl_xor(bon, 32);
      if (lq == 0) p.BON[(size_t)(nt * 2 + wf) * NT + t] = bon;
    }
#pragma unroll 1
    for (int dr = 0; dr < 2; ++dr) {
      gemm_tile<false>(p.L1 + 128 + dr * 64, 384, p.L2w + (2 + dr) * 65536, 64, 64, tok0, f0, lds, acc, nullptr);
      bf16_t* dst = dr ? p.S[5] : p.Hd;
#pragma unroll
      for (int pp = 0; pp < 2; ++pp) {
        const int f = f0 + wf * 64 + pp * 32 + lq * 8;
        const float4 w0l = *(const float4*)(p.w0 + dr * 1024 + f), w0h = *(const float4*)(p.w0 + dr * 1024 + f + 4);
#pragma unroll
        for (int ti = 0; ti < 4; ++ti) {
          const int t = tok0 + wt * 64 + ti * 16 + lr;
          f32x4 a = acc[2 * pp][ti], b = acc[2 * pp + 1][ti];
          a[0] = -0.60653066f * sigmoidf_(a[0] + w0l.x); a[1] = -0.60653066f * sigmoidf_(a[1] + w0l.y);
          a[2] = -0.60653066f * sigmoidf_(a[2] + w0l.z); a[3] = -0.60653066f * sigmoidf_(a[3] + w0l.w);
          b[0] = -0.60653066f * sigmoidf_(b[0] + w0h.x); b[1] = -0.60653066f * sigmoidf_(b[1] + w0h.y);
          b[2] = -0.60653066f * sigmoidf_(b[2] + w0h.z); b[3] = -0.60653066f * sigmoidf_(b[3] + w0h.w);
          store_bf8(dst + HM(t, f), a, b);
        }
      }
    }
  }
}

typedef short s16x4 __attribute__((ext_vector_type(4)));
#define MFMA16K(a, b, c) __builtin_amdgcn_mfma_f32_16x16x16bf16_1k((a), (b), (c), 0, 0, 0)
DI s16x4 pack4(const f32x4& x) { const uint2 u = make_uint2(pack2(x[0], x[1]), pack2(x[2], x[3])); return __builtin_bit_cast(s16x4, u); }
DI bf16x8 pack8(const f32x4& a, const f32x4& b) { const uint4 u = make_uint4(pack2(a[0], a[1]), pack2(a[2], a[3]), pack2(b[0], b[1]), pack2(b[2], b[3])); return __builtin_bit_cast(bf16x8, u); }
constexpr int SC_KK = 0, SC_R = 2304, SC_B = 4608, SC_K = 6912, SC_BT = 9216, SC_KT = 12288, SC_VT = 15360, SC_CL = 18432, SC_CHUNK = 18688, SC_GROUP = 2 * SC_CHUNK, SC_YBUF = 2 * SC_GROUP;

#define KEEP8(x) asm volatile("" :: "v"(x))
#define KEEP4(x) asm volatile("" :: "v"(x))
struct ChunkT { s16x4 bT, pAkk, pAbr, pAkr; };
DI void scan_partA2(const char* cb0, ChunkT (&ct)[2], int c, int q) {
  const f32x4 z = {0.f, 0.f, 0.f, 0.f};
  f32x4 Abk[2], AbkT[2], Akk[2], Abr[2], Akr[2], P[2];
#pragma unroll
  for (int h = 0; h < 2; ++h) {
    const char* cb = cb0 + h * SC_CHUNK;
    bf16x8 fB[2], fK[2], fKK[2], fR[2];
#pragma unroll
    for (int ks = 0; ks < 2; ++ks) {
      fB[ks] = *(const bf16x8*)(cb + SC_B + c * 144 + ks * 64 + q * 16);
      fK[ks] = *(const bf16x8*)(cb + SC_K + c * 144 + ks * 64 + q * 16);
      fKK[ks] = *(const bf16x8*)(cb + SC_KK + c * 144 + ks * 64 + q * 16);
      fR[ks] = *(const bf16x8*)(cb + SC_R + c * 144 + ks * 64 + q * 16);
    }
    Abk[h] = MFMA16(fB[0], fKK[0], z);  Abk[h] = MFMA16(fB[1], fKK[1], Abk[h]);
    AbkT[h] = MFMA16(fKK[0], fB[0], z); AbkT[h] = MFMA16(fKK[1], fB[1], AbkT[h]);
    Akk[h] = MFMA16(fK[0], fKK[0], z);  Akk[h] = MFMA16(fK[1], fKK[1], Akk[h]);
    Abr[h] = MFMA16(fB[0], fR[0], z);   Abr[h] = MFMA16(fB[1], fR[1], Abr[h]);
    Akr[h] = MFMA16(fK[0], fR[0], z);   Akr[h] = MFMA16(fK[1], fR[1], Akr[h]);
    KEEP8(fB[0]); KEEP8(fB[1]); KEEP8(fK[0]); KEEP8(fK[1]); KEEP8(fKK[0]); KEEP8(fKK[1]); KEEP8(fR[0]); KEEP8(fR[1]);
  }
#pragma unroll
  for (int h = 0; h < 2; ++h)
#pragma unroll
    for (int j = 0; j < 4; ++j) {
      const int rr = 4 * q + j;
      Abk[h][j] = rr < c ? Abk[h][j] : 0.f;  Akk[h][j] = rr < c ? Akk[h][j] : 0.f;
      Abr[h][j] = rr <= c ? Abr[h][j] : 0.f; Akr[h][j] = rr <= c ? Akr[h][j] : 0.f;
      AbkT[h][j] = c < rr ? AbkT[h][j] : 0.f;
      P[h][j] = (rr == c ? 1.f : 0.f) - Abk[h][j];
    }
  s16x4 bN[2], bNT[2], bN2[2], bN2T[2], bN4[2], bN4T[2], bN8T[2];
  f32x4 N2[2], N2T[2], N4[2], N4T[2], N8T[2];
#pragma unroll
  for (int h = 0; h < 2; ++h) { bN[h] = pack4(Abk[h]); bNT[h] = pack4(AbkT[h]); }
#pragma unroll
  for (int h = 0; h < 2; ++h) { N2[h] = MFMA16K(bNT[h], bN[h], z); N2T[h] = MFMA16K(bN[h], bNT[h], z); }
#pragma unroll
  for (int h = 0; h < 2; ++h) { KEEP4(bN[h]); KEEP4(bNT[h]); bN2[h] = pack4(N2[h]); bN2T[h] = pack4(N2T[h]); }
#pragma unroll
  for (int h = 0; h < 2; ++h) { N4[h] = MFMA16K(bN2T[h], bN2[h], z); N4T[h] = MFMA16K(bN2[h], bN2T[h], z); }
#pragma unroll
  for (int h = 0; h < 2; ++h) { KEEP4(bN2[h]); bN4[h] = pack4(N4[h]); bN4T[h] = pack4(N4T[h]); }
#pragma unroll
  for (int h = 0; h < 2; ++h) N8T[h] = MFMA16K(bN4[h], bN4T[h], z);
#pragma unroll
  for (int h = 0; h < 2; ++h) { KEEP4(bN4[h]); bN8T[h] = pack4(N8T[h]); }
  s16x4 pp_[2];
#pragma unroll
  for (int h = 0; h < 2; ++h) { pp_[h] = pack4(P[h]); P[h] = MFMA16K(bN2T[h], pp_[h], P[h]); }
#pragma unroll
  for (int h = 0; h < 2; ++h) { KEEP4(pp_[h]); KEEP4(bN2T[h]); }
#pragma unroll
  for (int h = 0; h < 2; ++h) { pp_[h] = pack4(P[h]); P[h] = MFMA16K(bN4T[h], pp_[h], P[h]); }
#pragma unroll
  for (int h = 0; h < 2; ++h) { KEEP4(pp_[h]); KEEP4(bN4T[h]); }
#pragma unroll
  for (int h = 0; h < 2; ++h) { pp_[h] = pack4(P[h]); P[h] = MFMA16K(bN8T[h], pp_[h], P[h]); }
#pragma unroll
  for (int h = 0; h < 2; ++h) { KEEP4(pp_[h]); KEEP4(bN8T[h]); }
#pragma unroll
  for (int h = 0; h < 2; ++h) { ct[h].bT = pack4(P[h]); ct[h].pAkk = pack4(Akk[h]); ct[h].pAbr = pack4(Abr[h]); ct[h].pAkr = pack4(Akr[h]); }
}
DI void scan_partB(const char* cb, float* yb, f32x4 (&ST)[4], const ChunkT& ct, int vb, int c, int q) {
  const f32x4 z = {0.f, 0.f, 0.f, 0.f};
  bf16x8 sf[2], kkp[2], rp[2];
#pragma unroll
  for (int i = 0; i < 2; ++i) {
    sf[i] = pack8(ST[2 * i], ST[2 * i + 1]);
    const uint2 klo = *(const uint2*)(cb + SC_KK + c * 144 + (32 * i + 4 * q) * 2), khi = *(const uint2*)(cb + SC_KK + c * 144 + (32 * i + 16 + 4 * q) * 2);
    const uint2 rlo = *(const uint2*)(cb + SC_R + c * 144 + (32 * i + 4 * q) * 2), rhi = *(const uint2*)(cb + SC_R + c * 144 + (32 * i + 16 + 4 * q) * 2);
    kkp[i] = __builtin_bit_cast(bf16x8, make_uint4(klo.x, klo.y, khi.x, khi.y));
    rp[i] = __builtin_bit_cast(bf16x8, make_uint4(rlo.x, rlo.y, rhi.x, rhi.y));
  }
  f32x4 XT = MFMA16(kkp[0], sf[0], z); XT = MFMA16(kkp[1], sf[1], XT);
  f32x4 YT = MFMA16(rp[0], sf[0], z);  YT = MFMA16(rp[1], sf[1], YT);
  KEEP8(kkp[0]); KEEP8(kkp[1]); KEEP8(rp[0]); KEEP8(rp[1]); KEEP8(sf[0]); KEEP8(sf[1]);
  const s16x4 vf = *(const s16x4*)(cb + SC_VT + (vb * 16 + c) * 48 + q * 8);
  XT = MFMA16K(ct.pAkk, vf, XT);
  const s16x4 pXT = pack4(XT);
  f32x4 UT = MFMA16K(ct.bT, pXT, z); KEEP4(pXT);
#pragma unroll
  for (int j = 0; j < 4; ++j) UT[j] = -UT[j];
  const s16x4 bU = pack4(UT);
  YT = MFMA16K(ct.pAbr, bU, YT);
  YT = MFMA16K(ct.pAkr, vf, YT);
#pragma unroll
  for (int j = 0; j < 4; ++j) yb[(4 * q + j) * 64 + vb * 16 + c] = YT[j];
#pragma unroll
  for (int kt = 0; kt < 4; ++kt) {
    const s16x4 bh = *(const s16x4*)(cb + SC_BT + (16 * kt + c) * 48 + q * 8);
    const s16x4 kh = *(const s16x4*)(cb + SC_KT + (16 * kt + c) * 48 + q * 8);
    f32x4 s = MFMA16K(bh, bU, ST[kt]);
    s = MFMA16K(kh, vf, s); KEEP4(bh); KEEP4(kh);
    const float4 cl = *(const float4*)(cb + SC_CL + (16 * kt + 4 * q) * 4);
    s[0] *= cl.x; s[1] *= cl.y; s[2] *= cl.z; s[3] *= cl.w;
    ST[kt] = s;
  }
  KEEP4(bU); KEEP4(vf); KEEP4(ct.bT); KEEP4(ct.pAkk); KEEP4(ct.pAbr); KEEP4(ct.pAkr);
}

DI void phase_scan(const Params& p, char* lds) {
  float* ybuf = (float*)(lds + SC_YBUF);
  const int tid = threadIdx.x, lane = tid & 63, wave = tid >> 6;
  const bool loader = tid >= 256;
  const int lt = tid & 255, ltk = lt >> 3, lch = (lt & 7) * 8;
  const int lcc = (wave >> 1) & 1, lchh = wave & 1, ltok = lane >> 2, loct = lane & 3, ch0 = lchh * 32 + loct * 8;
  const int vb = wave & 3, cc_ = lane & 15, qq = lane >> 4;
  constexpr int NG = NKEY / 32;
  for (int unit = blockIdx.x; unit < 256; unit += gridDim.x) {
    const int dir = unit & 1, h = (unit >> 1) & 15, b = unit >> 5;
    const bf16_t* Rp = p.S[0]; const bf16_t* Vp = p.S[1]; const bf16_t* Kp = p.S[2];
    bf16_t* Ap = dir ? p.S[4] : p.S[3];
    const bf16_t* Lp = dir ? p.S[5] : p.Hd;
    auto tok_of = [&](int i) -> int {
      if (i < 256) return NL + b * 256 + (dir ? 255 - i : i);
      const int s = i - 256;
      return b * 4096 + (dir ? 4095 - s : s);
    };
    uint4 rawA[5], rawB[5];
    float nrmA = 0.f, nrmB = 0.f;
    float rkk[8], kac[8];
    f32x4 ST[4];
#pragma unroll
    for (int i = 0; i < 4; ++i) ST[i] = f32x4{0.f, 0.f, 0.f, 0.f};
    if (loader) {
#pragma unroll
      for (int j = 0; j < 8; ++j) { rkk[j] = 1.f / p.k_k[h * 64 + ch0 + j]; kac[j] = p.k_a[h * 64 + ch0 + j]; }
    }
    auto issue = [&](int g, uint4 (&rw)[5], float& nv) {
      const int t = tok_of(g * 32 + lcc * 16 + ltok);
      const size_t off = HM(t, h * 64 + ch0);
      rw[0] = *(const uint4*)(Rp + off); rw[1] = *(const uint4*)(Vp + off); rw[2] = *(const uint4*)(Kp + off);
      rw[3] = *(const uint4*)(Ap + off); rw[4] = *(const uint4*)(Lp + off);
      nv = p.NRM[(size_t)h * NT + t];
    };
    auto process = [&](int stage, const uint4 (&raw)[5], const float nrmv) {
      float r8[8], kk8[8], a8[8], l8[8], L[8];
      unpack_bf8(raw[0], r8); unpack_bf8(raw[2], kk8); unpack_bf8(raw[3], a8); unpack_bf8(raw[4], l8);
#pragma unroll
      for (int j = 0; j < 8; ++j) L[j] = l8[j];
#pragma unroll
      for (int d = 4; d < 64; d <<= 1) {
#pragma unroll
        for (int j = 0; j < 8; ++j) { const float o = __shfl_up(L[j], d); if (lane >= d) L[j] += o; }
      }
      float okk[8], orr[8], ob[8], ok[8], cend[8];
#pragma unroll
      for (int j = 0; j < 8; ++j) {
        const float cc = __expf(L[j]), cprev = __expf(L[j] - l8[j]), cinv = __expf(-L[j]);
        const float k = kk8[j] * nrmv * rkk[j];
        const float kd = k * (1.f + (a8[j] - 1.f) * kac[j]);
        okk[j] = kk8[j] * cprev; orr[j] = r8[j] * cc; ob[j] = kk8[j] * a8[j] * cinv; ok[j] = kd * cinv; cend[j] = cc;
      }
      char* cb = lds + stage * SC_GROUP + lcc * SC_CHUNK;
      uint4 o;
      o = make_uint4(pack2(okk[0], okk[1]), pack2(okk[2], okk[3]), pack2(okk[4], okk[5]), pack2(okk[6], okk[7])); *(uint4*)(cb + SC_KK + ltok * 144 + ch0 * 2) = o;
      o = make_uint4(pack2(orr[0], orr[1]), pack2(orr[2], orr[3]), pack2(orr[4], orr[5]), pack2(orr[6], orr[7])); *(uint4*)(cb + SC_R + ltok * 144 + ch0 * 2) = o;
      const uint4 obp = make_uint4(pack2(ob[0], ob[1]), pack2(ob[2], ob[3]), pack2(ob[4], ob[5]), pack2(ob[6], ob[7])); *(uint4*)(cb + SC_B + ltok * 144 + ch0 * 2) = obp;
      const uint4 okp = make_uint4(pack2(ok[0], ok[1]), pack2(ok[2], ok[3]), pack2(ok[4], ok[5]), pack2(ok[6], ok[7])); *(uint4*)(cb + SC_K + ltok * 144 + ch0 * 2) = okp;
      const unsigned bw[4] = {obp.x, obp.y, obp.z, obp.w}, kw[4] = {okp.x, okp.y, okp.z, okp.w}, vw[4] = {raw[1].x, raw[1].y, raw[1].z, raw[1].w};
#pragma unroll
      for (int j = 0; j < 8; ++j) {
        const int sh = (j & 1) * 16;
        *(bf16_t*)(cb + SC_BT + (ch0 + j) * 48 + ltok * 2) = (bf16_t)((bw[j >> 1] >> sh) & 0xffffu);
        *(bf16_t*)(cb + SC_KT + (ch0 + j) * 48 + ltok * 2) = (bf16_t)((kw[j >> 1] >> sh) & 0xffffu);
        *(bf16_t*)(cb + SC_VT + (ch0 + j) * 48 + ltok * 2) = (bf16_t)((vw[j >> 1] >> sh) & 0xffffu);
      }
      if (ltok == 15) {
        *(float4*)(cb + SC_CL + ch0 * 4) = make_float4(cend[0], cend[1], cend[2], cend[3]);
        *(float4*)(cb + SC_CL + ch0 * 4 + 16) = make_float4(cend[4], cend[5], cend[6], cend[7]);
      }
    };
    auto yout = [&](int g) {
      const float* yb = ybuf + (g & 1) * 2048 + ltk * 64 + lch;
      const float4 y0 = *(const float4*)yb, y1 = *(const float4*)(yb + 4);
      const int t = tok_of(g * 32 + ltk);
      uint4 o;
      o.x = pack2(y0.x, y0.y); o.y = pack2(y0.z, y0.w); o.z = pack2(y1.x, y1.y); o.w = pack2(y1.z, y1.w);
      *(uint4*)(Ap + HM(t, h * 64 + lch)) = o;
    };
    __syncthreads();
    if (loader) { issue(0, rawA, nrmA); issue(1, rawB, nrmB); process(0, rawA, nrmA); issue(2, rawA, nrmA); }
    __syncthreads();
    for (int g = 0; g < NG; g += 2) {
      if (loader) {
        if (g >= 1) yout(g - 1);
        if (g + 1 < NG) { process(1, rawB, nrmB); if (g + 3 < NG) issue(g + 3, rawB, nrmB); }
      } else {
        const char* gb = lds;
        float* yb = ybuf;
        ChunkT ct[2];
        scan_partA2(gb, ct, cc_, qq);
        scan_partB(gb, yb, ST, ct[0], vb, cc_, qq);
        scan_partB(gb + SC_CHUNK, yb + 16 * 64, ST, ct[1], vb, cc_, qq);
      }
      __syncthreads();
      if (g + 1 < NG) {
        if (loader) {
          yout(g);
          if (g + 2 < NG) { process(0, rawA, nrmA); if (g + 4 < NG) issue(g + 4, rawA, nrmA); }
        } else {
          const char* gb = lds + SC_GROUP;
          float* yb = ybuf + 2048;
          ChunkT ct[2];
          scan_partA2(gb, ct, cc_, qq);
          scan_partB(gb, yb, ST, ct[0], vb, cc_, qq);
          scan_partB(gb + SC_CHUNK, yb + 16 * 64, ST, ct[1], vb, cc_, qq);
        }
        __syncthreads();
      }
    }
    if (loader) yout(NG - 1);
    __syncthreads();
  }
}

DI void phase_readout(const Params& p, char* lds) {
  const int lane = threadIdx.x & 63, wave = threadIdx.x >> 6;
  const int wt = wave & 3, wf = wave >> 2, lr = lane & 15, lq = lane >> 4;
  const int total = (NT / 256) * 8;
  for (int u = blockIdx.x; u < total; u += gridDim.x) {
    const int mt = u >> 3, nt = u & 7;
    const int tok0 = mt * 256, f0 = nt * 128;
    f32x4 g[4][4];
    gemm_tile<false>(p.L1, 384, p.g2T, 128, 128, tok0, f0, lds, g, nullptr);
    const int head = nt * 2 + wf;
#pragma unroll
    for (int ti = 0; ti < 4; ++ti) {
      const int t = tok0 + wt * 64 + ti * 16 + lr;
      float y[2][8];
      float sum = 0.f;
#pragma unroll
      for (int pp = 0; pp < 2; ++pp) {
        const int f = f0 + wf * 64 + pp * 32 + lq * 8;
        float ya[8], yb[8];
        unpack_bf8(*(const uint4*)(p.S[3] + HM(t, f)), ya);
        unpack_bf8(*(const uint4*)(p.S[4] + HM(t, f)), yb);
#pragma unroll
        for (int e2 = 0; e2 < 8; ++e2) { y[pp][e2] = ya[e2] + yb[e2]; sum += y[pp][e2]; }
      }
      sum += __shfl_xor(sum, 16); sum += __shfl_xor(sum, 32);
      const float mean = sum * (1.f / 64.f);
      float vs = 0.f;
#pragma unroll
      for (int pp = 0; pp < 2; ++pp)
#pragma unroll
        for (int e2 = 0; e2 < 8; ++e2) { const float d = y[pp][e2] - mean; vs += d * d; }
      vs += __shfl_xor(vs, 16); vs += __shfl_xor(vs, 32);
      const float rstd = rsqrtf(vs * (1.f / 64.f) + 64e-5f);
      const float bon = p.BON[(size_t)head * NT + t];
#pragma unroll
      for (int pp = 0; pp < 2; ++pp) {
        const int f = f0 + wf * 64 + pp * 32 + lq * 8;
        const float4 lwl = *(const float4*)(p.ln_w + f), lwh = *(const float4*)(p.ln_w + f + 4);
        const float4 lbl = *(const float4*)(p.ln_b + f), lbh = *(const float4*)(p.ln_b + f + 4);
        const float lw8[8] = {lwl.x, lwl.y, lwl.z, lwl.w, lwh.x, lwh.y, lwh.z, lwh.w};
        const float lb8[8] = {lbl.x, lbl.y, lbl.z, lbl.w, lbh.x, lbh.y, lbh.z, lbh.w};
        float v8[8];
        unpack_bf8(*(const uint4*)(p.S[1] + HM(t, f)), v8);
        f32x4 oa, ob;
#pragma unroll
        for (int j = 0; j < 4; ++j) {
          oa[j] = ((y[pp][j] - mean) * rstd * lw8[j] + lb8[j] + bon * v8[j]) * g[2 * pp][ti][j];
          ob[j] = ((y[pp][4 + j] - mean) * rstd * lw8[4 + j] + lb8[4 + j] + bon * v8[4 + j]) * g[2 * pp + 1][ti][j];
        }
        store_bf8(p.S[0] + (size_t)t * 1024 + f, oa, ob);
      }
    }
  }
}

DI void phase_gemm_resid(const Params& p, char* lds, const bf16_t* A, const bf16_t* W, int K, int ntm,
                                 const float* xin_l, const float* xin_c, const float* gate) {
  const int lane = threadIdx.x & 63, wave = threadIdx.x >> 6;
  const int wr = wave >> 2, wc = wave & 3;
  const int total = ntm * 4;
  for (int u = blockIdx.x; u < total; u += gridDim.x) {
    int mt, nt; tile_map(u, total, ntm, 4, mt, nt);
    f32x4 acc[2][2][4][2];
    gemm256_tile<true>(W, A, K, nt * 256, mt * 256, lds, acc);
    int lane_o = threadIdx.x & 63; asm volatile("" : "+v"(lane_o));
    const int fr = lane_o & 15, fq = lane_o >> 4;
#pragma unroll
    for (int bj = 0; bj < 2; ++bj)
#pragma unroll
      for (int n = 0; n < 2; ++n) {
        const int t = mt * 256 + bj * 128 + wc * 32 + n * 16 + fr;
        const int bp = t < NL ? (t >> 12) : 8;
        const float* xi = t < NL ? xin_l + (size_t)t * 1024 : xin_c + (size_t)(t - NL) * 1024;
        float* xo = t < NL ? p.out + (size_t)t * 1024 : p.XC + (size_t)(t - NL) * 1024;
#pragma unroll
        for (int ai = 0; ai < 2; ++ai)
#pragma unroll
          for (int mp = 0; mp < 2; ++mp) {
            const int f = nt * 256 + ai * 128 + wr * 64 + mp * 32 + fq * 8;
            const float4 g0 = *(const float4*)(gate + bp * 6144 + f), g1 = *(const float4*)(gate + bp * 6144 + f + 4);
            const float4 x0 = *(const float4*)(xi + f), x1 = *(const float4*)(xi + f + 4);
            const f32x4 a = acc[ai][bj][2 * mp][n], b = acc[ai][bj][2 * mp + 1][n];
            *(float4*)(xo + f) = make_float4(x0.x + g0.x * a[0], x0.y + g0.y * a[1], x0.z + g0.z * a[2], x0.w + g0.w * a[3]);
            *(float4*)(xo + f + 4) = make_float4(x1.x + g1.x * b[0], x1.y + g1.y * b[1], x1.z + g1.z * b[2], x1.w + g1.w * b[3]);
          }
      }
  }
}

constexpr int DT_MAIN = 512, DT_TOTAL = 544, DT_SLICES = 8;
DI void phase_down_split(const Params& p, char* lds, const float* gate) {
  const int wave = threadIdx.x >> 6;
  const int wr = wave >> 2, wc = wave & 3;
  const bf16_t* A = p.S[0]; const bf16_t* W = p.w2T[0];
  for (int u = blockIdx.x; u < DT_MAIN; u += gridDim.x) {
    int mt, nt; tile_map(u, DT_TOTAL, NT / 256, 4, mt, nt);
    f32x4 acc[2][2][4][2];
    gemm256_tile<true>(W, A, 4096, nt * 256, mt * 256, lds, acc);
    int lane_o = threadIdx.x & 63; asm volatile("" : "+v"(lane_o));
    const int fr = lane_o & 15, fq = lane_o >> 4;
#pragma unroll
    for (int bj = 0; bj < 2; ++bj)
#pragma unroll
      for (int n = 0; n < 2; ++n) {
        const int t = mt * 256 + bj * 128 + wc * 32 + n * 16 + fr;
        const int bp = t < NL ? (t >> 12) : 8;
        float* xo = t < NL ? p.out + (size_t)t * 1024 : p.XC + (size_t)(t - NL) * 1024;
#pragma unroll
        for (int ai = 0; ai < 2; ++ai)
#pragma unroll
          for (int mp = 0; mp < 2; ++mp) {
            const int f = nt * 256 + ai * 128 + wr * 64 + mp * 32 + fq * 8;
            const float4 g0 = *(const float4*)(gate + bp * 6144 + f), g1 = *(const float4*)(gate + bp * 6144 + f + 4);
            const float4 x0 = *(const float4*)(xo + f), x1 = *(const float4*)(xo + f + 4);
            const f32x4 a = acc[ai][bj][2 * mp][n], b = acc[ai][bj][2 * mp + 1][n];
            *(float4*)(xo + f) = make_float4(x0.x + g0.x * a[0], x0.y + g0.y * a[1], x0.z + g0.z * a[2], x0.w + g0.w * a[3]);
            *(float4*)(xo + f + 4) = make_float4(x1.x + g1.x * b[0], x1.y + g1.y * b[1], x1.z + g1.z * b[2], x1.w + g1.w * b[3]);
          }
      }
  }
  f32x4* part = (f32x4*)p.S[4];
  for (int w = blockIdx.x; w < (DT_TOTAL - DT_MAIN) * DT_SLICES; w += gridDim.x) {
    const int tile = w >> 3, sl = w & 7;
    int mt, nt; tile_map(DT_MAIN + tile, DT_TOTAL, NT / 256, 4, mt, nt);
    f32x4 acc[2][2][4][2];
    gemm256_tile<true>(W + sl * 512, A + sl * 512, 512, nt * 256, mt * 256, lds, acc, 4096);
    int tid_o = threadIdx.x; asm volatile("" : "+v"(tid_o));
    f32x4* dst = part + (size_t)(tile * DT_SLICES + sl) * 32 * 512 + tid_o;
#pragma unroll
    for (int ai = 0; ai < 2; ++ai)
#pragma unroll
      for (int bj = 0; bj < 2; ++bj)
#pragma unroll
        for (int m = 0; m < 4; ++m)
#pragma unroll
          for (int n = 0; n < 2; ++n) dst[(((ai * 2 + bj) * 4 + m) * 2 + n) * 512] = acc[ai][bj][m][n];
  }
}
DI void phase_down_reduce(const Params& p, const float* gate) {
  const int tid = threadIdx.x, lane = tid & 63, wave = tid >> 6;
  const int wr = wave >> 2, wc = wave & 3, fr = lane & 15, fq = lane >> 4;
  const f32x4* part = (const f32x4*)p.S[4];
  for (int w = blockIdx.x; w < (DT_TOTAL - DT_MAIN) * 8; w += gridDim.x) {
    const int tile = w >> 3, pt = w & 7;
    int mt, nt; tile_map(DT_MAIN + tile, DT_TOTAL, NT / 256, 4, mt, nt);
#pragma unroll
    for (int i = 0; i < 4; ++i) {
      const int k = pt * 4 + i, ai = k >> 4, bj = (k >> 3) & 1, m = (k >> 1) & 3, n = k & 1;
      f32x4 s = part[((size_t)(tile * DT_SLICES + 0) * 32 + k) * 512 + tid];
#pragma unroll
      for (int sl = 1; sl < DT_SLICES; ++sl) s += part[((size_t)(tile * DT_SLICES + sl) * 32 + k) * 512 + tid];
      const int t = mt * 256 + bj * 128 + wc * 32 + n * 16 + fr;
      const int bp = t < NL ? (t >> 12) : 8;
      float* xo = t < NL ? p.out + (size_t)t * 1024 : p.XC + (size_t)(t - NL) * 1024;
      const int f = nt * 256 + ai * 128 + wr * 64 + (m >> 1) * 32 + fq * 8 + (m & 1) * 4;
      const float4 g0 = *(const float4*)(gate + bp * 6144 + f);
      const float4 x0 = *(const float4*)(xo + f);
      *(float4*)(xo + f) = make_float4(x0.x + g0.x * s[0], x0.y + g0.y * s[1], x0.z + g0.z * s[2], x0.w + g0.w * s[3]);
    }
  }
}

DI void phase_up(const Params& p, char* lds, const bf16_t* H, const bf16_t* W, bf16_t* U, int ntm) {
  const int lane = threadIdx.x & 63, wave = threadIdx.x >> 6;
  const int wr = wave >> 2, wc = wave & 3;
  const int total = ntm * 16;
  for (int u = blockIdx.x; u < total; u += gridDim.x) {
    int mt, nt; tile_map(u, total, ntm, 16, mt, nt);
    f32x4 acc[2][2][4][2];
    gemm256_tile<true>(W, H, 1024, nt * 256, mt * 256, lds, acc);
    int lane_o = threadIdx.x & 63; asm volatile("" : "+v"(lane_o));
    const int fr = lane_o & 15, fq = lane_o >> 4;
#pragma unroll
    for (int bj = 0; bj < 2; ++bj)
#pragma unroll
      for (int n = 0; n < 2; ++n) {
        const int t = mt * 256 + bj * 128 + wc * 32 + n * 16 + fr;
#pragma unroll
        for (int ai = 0; ai < 2; ++ai)
#pragma unroll
          for (int mp = 0; mp < 2; ++mp) {
            const int f = nt * 256 + ai * 128 + wr * 64 + mp * 32 + fq * 8;
            f32x4 a = acc[ai][bj][2 * mp][n], b = acc[ai][bj][2 * mp + 1][n];
#pragma unroll
            for (int j = 0; j < 4; ++j) { const float ra = fmaxf(a[j], 0.f), rb = fmaxf(b[j], 0.f); a[j] = ra * ra; b[j] = rb * rb; }
            store_bf8(U + (size_t)t * 4096 + f, a, b);
          }
      }
  }
}

DI void phase_qkv(const Params& p, char* lds) {
  const int lane = threadIdx.x & 63, wave = threadIdx.x >> 6;
  const int wr = wave >> 2, wc = wave & 3;
  const int total = (NT / 256) * 6;
  bf16_t* Q = p.S[0]; bf16_t* KA = p.S[1]; bf16_t* VT = p.S[2];
  for (int u = blockIdx.x; u < total; u += gridDim.x) {
    int mt, nt; tile_map(u, total, NT / 256, 6, mt, nt);
    if (mt >= NL / 256 && nt < 4) continue;
    f32x4 acc[2][2][4][2];
    gemm256_tile<false>(p.wqkvT, p.S[5], 1024, nt * 256, mt * 256, lds, acc);
    int lane_o = threadIdx.x & 63; asm volatile("" : "+v"(lane_o));
    const int fr = lane_o & 15, fq = lane_o >> 4;
#pragma unroll
    for (int bj = 0; bj < 2; ++bj)
#pragma unroll
      for (int n = 0; n < 2; ++n) {
        const int t = mt * 256 + bj * 128 + wc * 32 + n * 16 + fr;
        const bool lat = t < NL;
        const int b = lat ? (t >> 12) : ((t - NL) >> 8);
        const int key = lat ? (t & 4095) : 4096 + ((t - NL) & 255);
#pragma unroll
        for (int ai = 0; ai < 2; ++ai) {
          const int hh = ai * 2 + wr;
          asm volatile("" ::: "memory");
          if (nt < 5) {
            float ss = 0.f;
#pragma unroll
            for (int m = 0; m < 4; ++m)
#pragma unroll
              for (int j = 0; j < 4; ++j) ss += acc[ai][bj][m][n][j] * acc[ai][bj][m][n][j];
            ss += __shfl_xor(ss, 16); ss += __shfl_xor(ss, 32);
            const float rstd = rsqrtf(ss * (1.f / 64.f) + 1e-6f);
            const float* gn = nt < 4 ? p.q_norm : p.k_norm;
            float v[4][4];
#pragma unroll
            for (int m = 0; m < 4; ++m) {
              const float4 g4 = *(const float4*)(gn + m * 16 + fq * 4);
              v[m][0] = acc[ai][bj][m][n][0] * rstd * g4.x; v[m][1] = acc[ai][bj][m][n][1] * rstd * g4.y;
              v[m][2] = acc[ai][bj][m][n][2] * rstd * g4.z; v[m][3] = acc[ai][bj][m][n][3] * rstd * g4.w;
            }
            if (lat) {
              const int s = t & 4095, rowp = s >> 6, colp = s & 63;
#pragma unroll
              for (int j = 0; j < 4; ++j) {
                const float2 cs0 = *(const float2*)(p.TAB + (rowp * 16 + fq * 4 + j) * 2);
                const float2 cs1 = *(const float2*)(p.TAB + (colp * 16 + fq * 4 + j) * 2);
                const float x1 = v[0][j], x2 = v[1][j], z1 = v[2][j], z2 = v[3][j];
                v[0][j] = x1 * cs0.x - x2 * cs0.y; v[1][j] = x2 * cs0.x + x1 * cs0.y;
                v[2][j] = z1 * cs1.x - z2 * cs1.y; v[3][j] = z2 * cs1.x + z1 * cs1.y;
              }
            }
            if (nt < 4) {
              const float qs = 0.125f * 1.4426950408889634f;
              const int head = nt * 4 + hh;
#pragma unroll
              for (int m = 0; m < 4; ++m)
                store_bf4(Q + (size_t)t * 1024 + head * 64 + m * 16 + fq * 4, v[m][0] * qs, v[m][1] * qs, v[m][2] * qs, v[m][3] * qs);
            } else {
#pragma unroll
              for (int m = 0; m < 4; ++m)
                store_bf4(KA + ((size_t)(b * 4 + hh) * NKEY + key) * 64 + m * 16 + fq * 4, v[m][0], v[m][1], v[m][2], v[m][3]);
            }
          } else {
#pragma unroll
            for (int m = 0; m < 4; ++m)
#pragma unroll
              for (int j = 0; j < 4; ++j) {
                const int d = m * 16 + fq * 4 + j;
                const unsigned pk = pack2(acc[ai][bj][m][n][j], 0.f);
                VT[((size_t)(b * 4 + hh) * 64 + d) * NKEY + key] = (bf16_t)(pk & 0xffffu);
              }
          }
        }
      }
  }
}

DI void phase_attn(const Params& p, char* lds) {
  const int tid = threadIdx.x, lane = tid & 63, wave = tid >> 6;
  const int l31 = lane & 31, lh = lane >> 5;
  const int srow = tid >> 3, sch = tid & 7;
  const bf16_t* Q = p.S[0]; const bf16_t* KA = p.S[1]; const bf16_t* VT = p.S[2]; bf16_t* O = p.S[3];
  float gq = 0.f, gk = 0.f;
  for (int i = 0; i < 64; ++i) { gq = fmaxf(gq, fabsf(p.q_norm[i])); gk = fmaxf(gk, fabsf(p.k_norm[i])); }
  const float M2 = 8.f * gq * gk * 1.4426950408889634f;
  constexpr int NKT = NKEY / 128;
  constexpr int VROW = 272;
  constexpr int KST = 128 * ROWB;
  constexpr int AST = KST + 64 * VROW;
  for (int u = blockIdx.x; u < 1024; u += gridDim.x) {
    const int qb = u & 7, head = (u >> 3) & 15, b = u >> 7, kvh = head >> 2;
    const bf16_t* Kg = KA + (size_t)(b * 4 + kvh) * NKEY * 64;
    const bf16_t* Vg = VT + (size_t)(b * 4 + kvh) * 64 * NKEY;
    const int tq0 = b * 4096 + qb * 512 + wave * 64 + l31;
    bf16x8 qf[2][4];
#pragma unroll
    for (int blk = 0; blk < 2; ++blk)
#pragma unroll
      for (int s = 0; s < 4; ++s) qf[blk][s] = *(const bf16x8*)(Q + (size_t)(tq0 + blk * 32) * 1024 + head * 64 + s * 16 + lh * 8);
    f32x16 o[2][2];
#pragma unroll
    for (int blk = 0; blk < 2; ++blk)
#pragma unroll
      for (int dt = 0; dt < 2; ++dt)
#pragma unroll
        for (int i = 0; i < 16; ++i) o[blk][dt][i] = 0.f;
    float lsum[2] = {0.f, 0.f};
    uint4 kr = make_uint4(0, 0, 0, 0), vr = kr;
    __syncthreads();
    for (int kt = -1; kt < NKT; ++kt) {
      const bool more = kt + 1 < NKT;
#pragma unroll 1
      for (int hf = 0; hf < 2; ++hf) {
        if (more) {
          kr = *(const uint4*)(Kg + (size_t)((kt + 1) * 128 + hf * 64 + srow) * 64 + sch * 8);
          vr = *(const uint4*)(Vg + (size_t)srow * NKEY + (kt + 1) * 128 + hf * 64 + sch * 8);
        }
        if (kt >= 0) {
          const char* ksm = lds + (kt & 1) * AST + hf * 64 * ROWB;
          const char* vsm = lds + (kt & 1) * AST + KST + hf * 128;
          f32x16 sT[2][2];
#pragma unroll
          for (int blk = 0; blk < 2; ++blk)
#pragma unroll
            for (int k2 = 0; k2 < 2; ++k2)
#pragma unroll
              for (int i = 0; i < 16; ++i) sT[blk][k2][i] = -M2;
#pragma unroll
          for (int k2 = 0; k2 < 2; ++k2)
#pragma unroll
            for (int s = 0; s < 4; ++s) {
              const bf16x8 kf = *(const bf16x8*)(ksm + (k2 * 32 + l31) * ROWB + s * 32 + lh * 16);
              sT[0][k2] = MFMA32(kf, qf[0][s], sT[0][k2]);
              sT[1][k2] = MFMA32(kf, qf[1][s], sT[1][k2]);
            }
#pragma unroll
          for (int blk = 0; blk < 2; ++blk)
#pragma unroll
            for (int k2 = 0; k2 < 2; ++k2)
#pragma unroll
              for (int i = 0; i < 16; ++i) { const float pv = __builtin_amdgcn_exp2f(sT[blk][k2][i]); lsum[blk] += pv; sT[blk][k2][i] = pv; }
#pragma unroll
          for (int k2 = 0; k2 < 2; ++k2)
#pragma unroll
            for (int s2 = 0; s2 < 2; ++s2) {
              bf16x8 pf[2];
#pragma unroll
              for (int blk = 0; blk < 2; ++blk) {
                uint4 pk;
                pk.x = pack2(sT[blk][k2][8 * s2 + 0], sT[blk][k2][8 * s2 + 1]); pk.y = pack2(sT[blk][k2][8 * s2 + 2], sT[blk][k2][8 * s2 + 3]);
                pk.z = pack2(sT[blk][k2][8 * s2 + 4], sT[blk][k2][8 * s2 + 5]); pk.w = pack2(sT[blk][k2][8 * s2 + 6], sT[blk][k2][8 * s2 + 7]);
                pf[blk] = __builtin_bit_cast(bf16x8, pk);
              }
              const int koff = (k2 * 32 + 16 * s2 + 4 * lh) * 2;
#pragma unroll
              for (int dt = 0; dt < 2; ++dt) {
                const uint2 lo = *(const uint2*)(vsm + (dt * 32 + l31) * VROW + koff), hi = *(const uint2*)(vsm + (dt * 32 + l31) * VROW + koff + 16);
                const bf16x8 vv = __builtin_bit_cast(bf16x8, make_uint4(lo.x, lo.y, hi.x, hi.y));
                o[0][dt] = MFMA32(vv, pf[0], o[0][dt]);
                o[1][dt] = MFMA32(vv, pf[1], o[1][dt]);
              }
            }
        }
        if (more) {
          char* st = lds + ((kt + 1) & 1) * AST;
          *(uint4*)(st + (hf * 64 + srow) * ROWB + sch * 16) = kr;
          *(uint4*)(st + KST + srow * VROW + hf * 128 + sch * 16) = vr;
        }
      }
      __syncthreads();
    }
#pragma unroll
    for (int blk = 0; blk < 2; ++blk) {
      float ls = lsum[blk];
      ls += __shfl_xor(ls, 32);
      const float inv = 1.f / ls;
      const int tq = tq0 + blk * 32;
#pragma unroll
      for (int g = 0; g < 4; ++g) {
        const int d0 = 8 * g + 4 * lh;
        store_bf4(O + (size_t)tq * 1024 + head * 64 + d0, o[blk][0][4 * g] * inv, o[blk][0][4 * g + 1] * inv, o[blk][0][4 * g + 2] * inv, o[blk][0][4 * g + 3] * inv);
        store_bf4(O + (size_t)tq * 1024 + head * 64 + 32 + d0, o[blk][1][4 * g] * inv, o[blk][1][4 * g + 1] * inv, o[blk][1][4 * g + 2] * inv, o[blk][1][4 * g + 3] * inv);
      }
    }
  }
}

#define XB_TMO      128
#define XB_XCNT(j)  (256  + 64 * (j))
#define XB_XSUB(j)  (1280 + 64 * (j))
#define XB_XGEN(j)  (2304 + 64 * (j))
#define XB_TOP      3328
#define XB_TOPGEN   3392
#define XCD_BAR_WORDS 3456
#define XB_SPIN_CAP (1u << 18)
#define LAS __attribute__((address_space(3)))

__device__ __forceinline__ unsigned xb_ld(unsigned* p)              { return __hip_atomic_load(p, __ATOMIC_RELAXED, __HIP_MEMORY_SCOPE_AGENT); }
__device__ __forceinline__ unsigned xb_add(unsigned* p, unsigned v) { return __hip_atomic_fetch_add(p, v, __ATOMIC_RELAXED, __HIP_MEMORY_SCOPE_AGENT); }
__device__ __forceinline__ unsigned xb_xcc_id() { return (unsigned)__builtin_amdgcn_s_getreg((3 << 11) | 20) & 0xFu; }
#define XB_SPIN(cond, bar) do { unsigned _sp = 0; while (cond) { __builtin_amdgcn_s_sleep(1); \
    if ((++_sp & 255u) == 0u) { if (xb_ld(&(bar)[XB_TMO])) break; if (_sp > XB_SPIN_CAP) { atomicAdd(&(bar)[XB_TMO], 1u); break; } } } } while (0)

struct XcdBarrier {
    unsigned* bar; unsigned x;
    volatile LAS unsigned* st;
};

__device__ __forceinline__ XcdBarrier xcd_barrier_post(unsigned* bar, volatile LAS unsigned* st) {
    XcdBarrier b; b.bar = bar; b.x = xb_xcc_id(); b.st = st;
    if (threadIdx.x == 0) (void)xb_add(&bar[XB_XCNT(b.x)], 1u);
    return b;
}
__device__ __forceinline__ void xcd_barrier_complete(unsigned* bar, unsigned x, unsigned& nloc, unsigned& nx) {
    const unsigned G = gridDim.x * gridDim.y * gridDim.z;
    unsigned sum, cnt, mine, sp = 0u;
    for (;;) {
        sum = 0u; cnt = 0u; mine = 0u;
#pragma unroll
        for (unsigned j = 0; j < 16; ++j) { const unsigned c = xb_ld(&bar[XB_XCNT(j)]); sum += c; cnt += (c > 0u) ? 1u : 0u; mine = (j == x) ? c : mine; }
        if (sum == G) break;
        __builtin_amdgcn_s_sleep(1);
        if ((++sp & 255u) == 0u) { if (xb_ld(&bar[XB_TMO])) break; if (sp > XB_SPIN_CAP) { atomicAdd(&bar[XB_TMO], 1u); break; } }
    }
    nloc = mine > 0u ? mine : 1u; nx = cnt > 0u ? cnt : 1u;
}

__device__ __forceinline__ void xcd_barrier(const XcdBarrier& b) {
    asm volatile("s_waitcnt vmcnt(0)" ::: "memory");
    __syncthreads();
    if (threadIdx.x == 0) {
        unsigned* bar = b.bar;
        __builtin_amdgcn_s_waitcnt(0);
        unsigned nloc = b.st[0], nx = b.st[1];
        if (nloc == 0u) { xcd_barrier_complete(bar, b.x, nloc, nx); b.st[0] = nloc; b.st[1] = nx; }
        const unsigned old = xb_add(&bar[XB_XSUB(b.x)], 1u);
        const unsigned gen = old / nloc;
        if (old + 1u == (gen + 1u) * nloc) {
            __builtin_amdgcn_fence(__ATOMIC_RELEASE, "agent");
            asm volatile("s_waitcnt vmcnt(0)" ::: "memory");
            const unsigned og = xb_add(&bar[XB_TOP], 1u);
            const unsigned tg = og / nx;
            if (og + 1u == (tg + 1u) * nx) xb_add(&bar[XB_TOPGEN], 1u);
            else XB_SPIN(xb_ld(&bar[XB_TOPGEN]) == tg, bar);
            __builtin_amdgcn_fence(__ATOMIC_ACQUIRE, "agent");
            xb_add(&bar[XB_XGEN(b.x)], 1u);
            asm volatile("s_waitcnt vmcnt(0)" ::: "memory");
        } else {
            XB_SPIN(xb_ld(&bar[XB_XGEN(b.x)]) == gen, bar);
            __builtin_amdgcn_fence(__ATOMIC_ACQUIRE, "agent");
            asm volatile("s_waitcnt vmcnt(0)" ::: "memory");
        }
    }
    __syncthreads();
}


DI void run_phase(const Params& p, int ph, char* lds) {
  const float* mod0 = p.MOD;
  const float* mod1 = p.MOD + 9 * 6144;
  switch (ph) {
    case 0: phase0(p, lds); break;
    case 1: norm_mod_phase(p.x, p.ctx, p.norm_mix, mod0, 0, 1, p.Hd, NT); break;
    case 2: phase_proj(p, lds); break;
    case 20: phase_mix(p); break;
    case 3: phase_prep(p, lds); break;
    case 4: phase_scan(p, lds); break;
    case 5: phase_readout(p, lds); break;
    case 6: phase_gemm_resid(p, lds, p.S[0], p.woT, 1024, NT / 256, p.x, p.ctx, mod0 + 2 * 1024); break;
    case 7: norm_mod_phase(p.out, p.XC, p.norm_mlp, mod0, 3, 4, p.S[5], NT); break;
    case 8: phase_up(p, lds, p.S[5], p.w1T[0], p.S[0], NT / 256); break;
    case 9: phase_down_split(p, lds, mod0 + 5 * 1024); break;
    case 21: phase_down_reduce(p, mod0 + 5 * 1024); break;
    case 10: norm_mod_phase(p.out, p.XC, p.norm_mix + 1024, mod1, 0, 1, p.S[5], NT); break;
    case 11: phase_qkv(p, lds); break;
    case 12: phase_attn(p, lds); break;
    case 13: phase_gemm_resid(p, lds, p.S[3], p.awoT, 1024, NL / 256, p.out, p.XC, mod1 + 2 * 1024); break;
    case 14: norm_mod_phase(p.out, p.XC, p.norm_mlp + 1024, mod1, 3, 4, p.S[5], NL); break;
    case 15: phase_up(p, lds, p.S[5], p.w1T[1], p.S[0], NL / 256); break;
    case 16: phase_gemm_resid(p, lds, p.S[0], p.w2T[1], 4096, NL / 256, p.out, p.XC, mod1 + 5 * 1024); break;
    case 17: final_norm_phase(p); break;
  }
}
constexpr int NPHASE = 18;

__global__ void __launch_bounds__(NTHREADS) mega_kernel(Params p) {
  extern __shared__ __attribute__((aligned(16))) char lds[];
  cg::grid_group grid = cg::this_grid();
  volatile LAS unsigned* st = (volatile LAS unsigned*)(LAS char*)(lds + 131072);
  if (threadIdx.x == 0) { st[0] = 0u; st[1] = 0u; }
  if (blockIdx.x == 0) for (int i = threadIdx.x; i < XCD_BAR_WORDS; i += NTHREADS) p.BAR[i] = 0u;
  __syncthreads();
  run_phase(p, 0, lds);
  grid.sync();
  const XcdBarrier xb = xcd_barrier_post(p.BAR, st);
#define PH(n) run_phase(p, n, lds); xcd_barrier(xb);
  PH(1) PH(20) PH(2) PH(3) PH(4) PH(5) PH(6) PH(7) PH(8) PH(9) PH(21) PH(10) PH(11) PH(12) PH(13) PH(14) PH(15) PH(16)
  run_phase(p, 17, lds);
}

extern "C" void kernel_launch(void* const* d_in, const int* in_sizes, int n_in, void* d_out, int out_size, void* d_ws, size_t ws_size, hipStream_t stream) {
  Params p;
  memset(&p, 0, sizeof(p));
  const float* const* in = (const float* const*)d_in;
  p.x = in[0]; p.c = in[1]; p.ctx = in[2]; p.c_ctx = in[3]; p.w_mod = in[4]; p.b_mod = in[5]; p.norm_mix = in[6]; p.norm_mlp = in[7];
  p.mlp_w1 = in[8]; p.mlp_w2 = in[9]; p.mu = in[10]; p.wr = in[11]; p.wk = in[12]; p.wv = in[13]; p.wo = in[14]; p.w0 = in[15]; p.w1 = in[16];
  p.w2 = in[17]; p.a0 = in[18]; p.a1 = in[19]; p.a2 = in[20]; p.g1 = in[21]; p.g2 = in[22]; p.k_k = in[23]; p.k_a = in[24]; p.r_k = in[25];
  p.ln_w = in[26]; p.ln_b = in[27]; p.wqkv = in[28]; p.q_norm = in[29]; p.k_norm = in[30]; p.awo = in[31]; p.final_norm = in[32];
  p.out = (float*)d_out;
  char* ws = (char*)d_ws;
  size_t off = 0;
  auto take = [&](size_t bytes) -> char* { char* r = ws + off; off += (bytes + 255) & ~(size_t)255; return r; };
  p.Wcat = (bf16_t*)take((size_t)3456 * 1024 * 2);
  p.L2w = (bf16_t*)take((size_t)4 * 65536 * 2);
  p.g2T = (bf16_t*)take((size_t)1024 * 128 * 2);
  p.woT = (bf16_t*)take((size_t)1024 * 1024 * 2);
  p.w1T[0] = (bf16_t*)take((size_t)4096 * 1024 * 2);
  p.w1T[1] = (bf16_t*)take((size_t)4096 * 1024 * 2);
  p.w2T[0] = (bf16_t*)take((size_t)4096 * 1024 * 2);
  p.w2T[1] = (bf16_t*)take((size_t)4096 * 1024 * 2);
  p.wqkvT = (bf16_t*)take((size_t)1536 * 1024 * 2);
  p.awoT = (bf16_t*)take((size_t)1024 * 1024 * 2);
  p.MOD = (float*)take((size_t)2 * 9 * 6144 * 4);
  p.TAB = (float*)take((size_t)1024 * 2 * 4);
  p.XC = (float*)take((size_t)NC * 1024 * 4);
  p.BAR = (unsigned*)take((size_t)XCD_BAR_WORDS * 4);
  for (int i = 0; i < 6; ++i) p.S[i] = (bf16_t*)take((size_t)NT * 1024 * 2);
  if (off > ws_size) { fprintf(stderr, "kernel_launch: workspace too small (%zu needed, %zu given)\n", off, ws_size); return; }
  char* ob = (char*)d_out;
  p.Hd = (bf16_t*)ob;
  p.L1 = (bf16_t*)(ob + (size_t)NT * 1024 * 2);
  p.BON = (float*)(ob + (size_t)NT * 1024 * 2 + (size_t)NT * 384 * 2);
  p.NRM = (float*)(ob + (size_t)NT * 1024 * 2 + (size_t)NT * 384 * 2 + (size_t)NT * 16 * 4);
  int nj = 0, tiles = 0;
  auto job = [&](const float* src, bf16_t* dst, int K, int N) {
    p.jobs[nj].src = src; p.jobs[nj].dst = dst; p.jobs[nj].K = K; p.jobs[nj].N = N; p.jobs[nj].tstart = tiles; p.jobs[nj].tiles_n = N / 64;
    tiles += (K / 64) * (N / 64); ++nj;
  };
  job(p.wr, p.Wcat, 1024, 1024);
  job(p.wk, p.Wcat + (size_t)1024 * 1024, 1024, 1024);
  job(p.wv, p.Wcat + (size_t)2048 * 1024, 1024, 1024);
  job(p.g1, p.Wcat + (size_t)3072 * 1024, 1024, 128);
  job(p.w1, p.Wcat + (size_t)3200 * 1024, 1024, 64);
  job(p.w1 + 65536, p.Wcat + (size_t)3264 * 1024, 1024, 64);
  job(p.a1, p.Wcat + (size_t)3328 * 1024, 1024, 64);
  job(p.a1 + 65536, p.Wcat + (size_t)3392 * 1024, 1024, 64);
  job(p.a2, p.L2w, 64, 1024);
  job(p.a2 + 65536, p.L2w + 65536, 64, 1024);
  job(p.w2, p.L2w + 2 * 65536, 64, 1024);
  job(p.w2 + 65536, p.L2w + 3 * 65536, 64, 1024);
  job(p.g2, p.g2T, 128, 1024);
  job(p.wo, p.woT, 1024, 1024);
  job(p.mlp_w1, p.w1T[0], 1024, 4096);
  job(p.mlp_w1 + (size_t)4096 * 1024, p.w1T[1], 1024, 4096);
  job(p.mlp_w2, p.w2T[0], 4096, 1024);
  job(p.mlp_w2 + (size_t)4096 * 1024, p.w2T[1], 4096, 1024);
  job(p.wqkv, p.wqkvT, 1024, 1536);
  job(p.awo, p.awoT, 1024, 1024);
  p.njobs = nj; p.total_tiles = tiles;

  static int grid_blocks = 0;
  if (!grid_blocks) {
    (void)hipFuncSetAttribute((const void*)mega_kernel, hipFuncAttributeMaxDynamicSharedMemorySize, LDS_BYTES);
    int dev = 0, cus = 0, per_cu = 0;
    (void)hipGetDevice(&dev);
    (void)hipDeviceGetAttribute(&cus, hipDeviceAttributeMultiprocessorCount, dev);
    if (hipOccupancyMaxActiveBlocksPerMultiprocessor(&per_cu, (const void*)mega_kernel, NTHREADS, LDS_BYTES) != hipSuccess || per_cu < 1) per_cu = 1;
    if (cus <= 0) cus = 256;
    grid_blocks = cus * per_cu;
    (void)hipGetLastError();
  }
  void* args[] = {&p};
  hipError_t e = hipLaunchCooperativeKernel((const void*)mega_kernel, dim3(grid_blocks), dim3(NTHREADS), args, LDS_BYTES, stream);
  if (e != hipSuccess) fprintf(stderr, "cooperative launch failed: %s (grid %d)\n", hipGetErrorString(e), grid_blocks);
}
```

```cpp
#include <hip/hip_runtime.h>
#include <hip/hip_cooperative_groups.h>
#include <cstdint>
#include <cstring>
#include <cstdio>
namespace cg = cooperative_groups;

typedef unsigned short bf16_t;
typedef short bf16x8 __attribute__((ext_vector_type(8)));
typedef float f32x2 __attribute__((ext_vector_type(2)));
typedef float f32x4 __attribute__((ext_vector_type(4)));
typedef float f32x16 __attribute__((ext_vector_type(16)));
typedef __bf16 bf16x2_t __attribute__((ext_vector_type(2)));
#define DI __device__ __forceinline__

constexpr int D = 1024, NB = 8, SEQ = 4096, CTXL = 256;
constexpr int NL = NB * SEQ, NC = NB * CTXL, NT = NL + NC, DFF = 4096;
constexpr int NKEY = SEQ + CTXL;
constexpr int NTHREADS = 512;
constexpr int ROWB = 144;
constexpr int GEMM_STAGE = (256 + 128) * ROWB;
constexpr int LDS_BYTES = 131072 + 16;

struct TJob { const float* src; bf16_t* dst; int K, N, tstart, tiles_n; };

struct Params {
  const float *x, *c, *ctx, *c_ctx, *w_mod, *b_mod, *norm_mix, *norm_mlp, *mlp_w1, *mlp_w2;
  const float *mu, *wr, *wk, *wv, *wo, *w0, *w1, *w2, *a0, *a1, *a2, *g1, *g2, *k_k, *k_a, *r_k, *ln_w, *ln_b;
  const float *wqkv, *q_norm, *k_norm, *awo, *final_norm;
  float* out;
  bf16_t *Wcat, *L2w, *g2T, *woT, *w1T[2], *w2T[2], *wqkvT, *awoT;
  float *MOD, *TAB, *XC;
  bf16_t* S[6];
  bf16_t *Hd, *L1;
  float* BON;
  float* NRM;
  unsigned* BAR;
  TJob jobs[20];
  int njobs, total_tiles;
};

DI size_t HM(int t, int f) { return ((size_t)(f >> 6) * NT + t) * 64 + (f & 63); }
DI unsigned pack2(float lo, float hi) {
  f32x2 v = {lo, hi};
  bf16x2_t b = __builtin_convertvector(v, bf16x2_t);
  return __builtin_bit_cast(unsigned, b);
}
DI float bflo(unsigned u) { return __uint_as_float(u << 16); }
DI float bfhi(unsigned u) { return __uint_as_float(u & 0xffff0000u); }
DI void store_bf4(bf16_t* p, float a, float b, float c, float d) { *(uint2*)p = make_uint2(pack2(a, b), pack2(c, d)); }
DI void load_bf4(const bf16_t* p, float& a, float& b, float& c, float& d) { uint2 u = *(const uint2*)p; a = bflo(u.x); b = bfhi(u.x); c = bflo(u.y); d = bfhi(u.y); }
DI void store_bf8(bf16_t* p, const f32x4& a, const f32x4& b) {
  uint4 o; o.x = pack2(a[0], a[1]); o.y = pack2(a[2], a[3]); o.z = pack2(b[0], b[1]); o.w = pack2(b[2], b[3]);
  *(uint4*)p = o;
}
DI void store16_sc1(void* p, const uint4& v) {
  typedef unsigned u32x4_t __attribute__((ext_vector_type(4)));
  const u32x4_t d = {v.x, v.y, v.z, v.w};
  asm volatile("global_store_dwordx4 %0, %1, off sc1" :: "v"(p), "v"(d) : "memory");
}
DI void unpack_bf8(const uint4& u, float (&o)[8]) {
  o[0] = bflo(u.x); o[1] = bfhi(u.x); o[2] = bflo(u.y); o[3] = bfhi(u.y); o[4] = bflo(u.z); o[5] = bfhi(u.z); o[6] = bflo(u.w); o[7] = bfhi(u.w);
}
DI int perm32(int rho) { return 8 * ((rho & 15) >> 2) + 4 * (rho >> 4) + (rho & 3); }
DI float sigmoidf_(float x) { return 1.f / (1.f + __expf(-x)); }
DI float tanhf_(float x) { return 1.f - 2.f / (1.f + __expf(2.f * x)); }
DI float4 ld_nt4(const float* p) {
  const f32x4 v = __builtin_nontemporal_load((const f32x4*)p);
  return make_float4(v[0], v[1], v[2], v[3]);
}
DI float wave_sum(float x) {
#pragma unroll
  for (int m = 1; m < 64; m <<= 1) x += __shfl_xor(x, m);
  return x;
}
#define MFMA16(a, b, c) __builtin_amdgcn_mfma_f32_16x16x32_bf16((a), (b), (c), 0, 0, 0)
#define MFMA32(a, b, c) __builtin_amdgcn_mfma_f32_32x32x16_bf16((a), (b), (c), 0, 0, 0)

DI unsigned lerp2(unsigned a, unsigned n, float ma, float mb) {
  const float h0 = bflo(a), h1 = bfhi(a), s0 = bflo(n), s1 = bfhi(n);
  return pack2(h0 + (s0 - h0) * ma, h1 + (s1 - h1) * mb);
}
template <bool LERP>
DI void gemm_tile(const bf16_t* __restrict__ X, int ldx, const bf16_t* __restrict__ W, int ldw, int K, int tok0, int f0,
                  char* lds, f32x4 (&acc)[4][4], const float* __restrict__ mu) {
  const int tid = threadIdx.x, lane = tid & 63, wave = tid >> 6;
  const int wt = wave & 3, wf = wave >> 2, lr = lane & 15, lq = lane >> 4;
  const int lrow = tid >> 3, kc = tid & 7;
#pragma unroll
  for (int i = 0; i < 4; ++i)
#pragma unroll
    for (int j = 0; j < 4; ++j) acc[i][j] = f32x4{0.f, 0.f, 0.f, 0.f};
  uint4 xr[4], wr[2], xn[4];
  float4 m0 = make_float4(0, 0, 0, 0), m1 = m0;
  const int nk = K >> 6;
  __syncthreads();
  for (int kt = -1; kt < nk; ++kt) {
    const bool more = kt + 1 < nk;
    if (more) {
      const int k0 = (kt + 1) << 6;
#pragma unroll
      for (int i = 0; i < 4; ++i) {
        const int tg = tok0 + lrow + 64 * i;
        xr[i] = *(const uint4*)(X + (size_t)tg * ldx + k0 + kc * 8);
        if (LERP) {
          int nb; bool valid;
          if (tok0 < NL) {
            const int s = tg & 4095, col = s & 63, rw = s >> 6, qd = k0 >> 8;
            if (qd == 0) { valid = col > 0; nb = tg - 1; }
            else if (qd == 1) { valid = col < 63; nb = tg + 1; }
            else if (qd == 2) { valid = rw > 0; nb = tg - 64; }
            else { valid = rw < 63; nb = tg + 64; }
          } else {
            const int s = (tg - NL) & 255;
            if (k0 < 512) { valid = s > 0; nb = tg - 1; }
            else { valid = s < 255; nb = tg + 1; }
          }
          if (valid) xn[i] = *(const uint4*)(X + (size_t)nb * ldx + k0 + kc * 8);
          else xn[i] = make_uint4(0, 0, 0, 0);
        }
      }
#pragma unroll
      for (int i = 0; i < 2; ++i) wr[i] = *(const uint4*)(W + (size_t)(f0 + 64 * i + (lrow & 32) + perm32(lrow & 31)) * ldw + k0 + kc * 8);
      if (LERP) { m0 = *(const float4*)(mu + k0 + kc * 8); m1 = *(const float4*)(mu + k0 + kc * 8 + 4); }
    }
    if (kt >= 0) {
      const char* xs = lds + (kt & 1) * GEMM_STAGE;
      const char* wsm = xs + 256 * ROWB;
#pragma unroll
      for (int ks = 0; ks < 2; ++ks) {
        bf16x8 wfr[4], xfr[4];
#pragma unroll
        for (int i = 0; i < 4; ++i) wfr[i] = *(const bf16x8*)(wsm + (wf * 64 + i * 16 + lr) * ROWB + ks * 64 + lq * 16);
#pragma unroll
        for (int i = 0; i < 4; ++i) xfr[i] = *(const bf16x8*)(xs + (wt * 64 + i * 16 + lr) * ROWB + ks * 64 + lq * 16);
#pragma unroll
        for (int fi = 0; fi < 4; ++fi)
#pragma unroll
          for (int ti = 0; ti < 4; ++ti) acc[fi][ti] = MFMA16(wfr[fi], xfr[ti], acc[fi][ti]);
      }
    }
    if (more) {
      char* xs = lds + ((kt + 1) & 1) * GEMM_STAGE;
      char* wsm = xs + 256 * ROWB;
#pragma unroll
      for (int i = 0; i < 4; ++i) {
        uint4 v = xr[i];
        if (LERP) {
          v.x = lerp2(xr[i].x, xn[i].x, m0.x, m0.y);
          v.y = lerp2(xr[i].y, xn[i].y, m0.z, m0.w);
          v.z = lerp2(xr[i].z, xn[i].z, m1.x, m1.y);
          v.w = lerp2(xr[i].w, xn[i].w, m1.z, m1.w);
        }
        *(uint4*)(xs + (lrow + 64 * i) * ROWB + kc * 16) = v;
      }
#pragma unroll
      for (int i = 0; i < 2; ++i) *(uint4*)(wsm + (lrow + 64 * i) * ROWB + kc * 16) = wr[i];
    }
    __syncthreads();
  }
}


namespace g256 {
constexpr int BK = 64, HALF = 128, HT = HALF * BK;
DI int lds_byte(int r, int c) { const int st = (r >> 4) * 2 + (c >> 5), rr = r & 15, cc = c & 31, ob = rr * 64 + cc * 2; return st * 1024 + (ob ^ (((ob >> 9) & 1) << 5)); }
DI void stage_rc(int b, int& R, int& C) { const int st = b / 1024, sb = b % 1024, swz = sb ^ (((sb >> 9) & 1) << 5); R = (st >> 1) * 16 + swz / 64; C = (st & 1) * 32 + (swz % 64) / 2; }
}
#define G_SA(b, h) (((b) * 2 + (h)) * 16384)
#define G_SB(b, h) ((4 + (b) * 2 + (h)) * 16384)
#define G_STAGEV(bufoff, gbase, vo) do { _Pragma("unroll") for (int _i = 0; _i < 2; ++_i) \
    __builtin_amdgcn_global_load_lds((const unsigned*)((const char*)(gbase) + (vo)[_i]), (__attribute__((address_space(3))) unsigned*)(lds + (bufoff) + ldsw + _i * 8192), 16, 0, 0); } while (0)
#define G_LDA(dst, b, h) do { _Pragma("unroll") for (int m = 0; m < 4; ++m) _Pragma("unroll") for (int k = 0; k < 2; ++k) \
    dst[m][k] = *(const __attribute__((address_space(3))) bf16x8*)(lds + G_SA(b, h) + aoff + m * 2048 + k * 1024); } while (0)
#define G_LDB(dst, b, h) do { _Pragma("unroll") for (int n = 0; n < 2; ++n) _Pragma("unroll") for (int k = 0; k < 2; ++k) \
    dst[n][k] = *(const __attribute__((address_space(3))) bf16x8*)(lds + G_SB(b, h) + boff + n * 2048 + k * 1024); } while (0)
#define G_MMA(ai, bj, At, Bt) do { __builtin_amdgcn_s_setprio(1); \
    _Pragma("unroll") for (int m = 0; m < 4; ++m) _Pragma("unroll") for (int n = 0; n < 2; ++n) _Pragma("unroll") for (int k = 0; k < 2; ++k) \
      acc[ai][bj][m][n] = __builtin_amdgcn_mfma_f32_16x16x32_bf16(At[m][k], Bt[n][k], acc[ai][bj][m][n], 0, 0, 0); \
    __builtin_amdgcn_s_setprio(0); } while (0)
#define G_WAIT_V(n) asm volatile("s_waitcnt vmcnt(" #n ")" ::: "memory")
#define G_WAIT_L(n) asm volatile("s_waitcnt lgkmcnt(" #n ")" ::: "memory")
#define G_BAR __builtin_amdgcn_s_barrier()
#define G_SCHED __builtin_amdgcn_sched_barrier(0)

template <bool PERM>
DI void gemm256_tile(const bf16_t* __restrict__ A, const bf16_t* __restrict__ Bt, int K, int brow, int bcol, char* lds_, f32x4 (&acc)[2][2][4][2], int ld = 0) {
  if (ld == 0) ld = K;
  __attribute__((address_space(3))) unsigned char* lds = (__attribute__((address_space(3))) unsigned char*)lds_;
  int tid = threadIdx.x; asm volatile("" : "+v"(tid));
  const int wid = __builtin_amdgcn_readfirstlane(tid >> 6), lane = tid & 63, wr = wid >> 2, wc = wid & 3, fr = lane & 15, fq = lane >> 4;
#pragma unroll
  for (int a = 0; a < 2; ++a)
#pragma unroll
    for (int b = 0; b < 2; ++b)
#pragma unroll
      for (int m = 0; m < 4; ++m)
#pragma unroll
        for (int n = 0; n < 2; ++n) acc[a][b][m][n] = f32x4{0.f, 0.f, 0.f, 0.f};
  unsigned voff[2], voffA[2];
#pragma unroll
  for (int i = 0; i < 2; ++i) { int R, C; g256::stage_rc(tid * 16 + i * 8192, R, C); voff[i] = (unsigned)(R * ld + C) * 2u;
    const int Ra = PERM ? ((R & ~31) + perm32(R & 31)) : R; voffA[i] = (unsigned)(Ra * ld + C) * 2u; }
  const size_t kstep = 128, hstep = (size_t)128 * ld * 2;
  const unsigned ldsw = (unsigned)wid * 1024u;
  const int aoff = g256::lds_byte(wr * 64 + fr, fq * 8), boff = g256::lds_byte(wc * 32 + fr, fq * 8);
  const char* cA = (const char*)A + (size_t)brow * ld * 2;
  const char* cB = (const char*)Bt + (size_t)bcol * ld * 2;
  bf16x8 At[4][2], B0[2][2], B1[2][2];
  const int nt = K / g256::BK;
  __syncthreads();
  G_STAGEV(G_SB(0, 0), cB, voff); G_STAGEV(G_SA(0, 0), cA, voffA); G_STAGEV(G_SB(0, 1), cB + hstep, voff); G_STAGEV(G_SA(0, 1), cA + hstep, voffA);
  if (wr == 1) G_BAR;
  G_WAIT_V(4); G_BAR;
  G_STAGEV(G_SB(1, 0), cB + kstep, voff); G_STAGEV(G_SA(1, 0), cA + kstep, voffA); G_STAGEV(G_SB(1, 1), cB + hstep + kstep, voff);
  G_WAIT_V(6); G_BAR;
  for (int t = 0; t < nt - 2; t += 2) {
    const char* a1 = cA + (size_t)(t + 1) * kstep;
    const char* a2 = cA + (size_t)(t + 2) * kstep; const char* b2 = cB + (size_t)(t + 2) * kstep;
    const char* a3 = a2 + kstep; const char* b3 = b2 + kstep;
    G_LDB(B0, 0, 0); G_SCHED; G_LDA(At, 0, 0); G_STAGEV(G_SA(1, 1), a1 + hstep, voffA);
    G_WAIT_L(8); G_BAR; G_WAIT_L(0); G_MMA(0, 0, At, B0); G_BAR; G_SCHED;
    G_LDB(B1, 0, 1); G_STAGEV(G_SB(0, 0), b2, voff);
    G_BAR; G_WAIT_L(0); G_MMA(0, 1, At, B1); G_BAR;
    G_LDA(At, 0, 1); G_STAGEV(G_SA(0, 0), a2, voffA);
    G_BAR; G_WAIT_L(0); G_MMA(1, 0, At, B0); G_BAR; G_SCHED;
    G_STAGEV(G_SB(0, 1), b2 + hstep, voff);
    G_WAIT_V(6); G_BAR; G_MMA(1, 1, At, B1); G_BAR;
    G_LDB(B0, 1, 0); G_SCHED; G_LDA(At, 1, 0); G_STAGEV(G_SA(0, 1), a2 + hstep, voffA);
    G_WAIT_L(8); G_BAR; G_WAIT_L(0); G_MMA(0, 0, At, B0); G_BAR; G_SCHED;
    G_LDB(B1, 1, 1); G_STAGEV(G_SB(1, 0), b3, voff);
    G_BAR; G_WAIT_L(0); G_MMA(0, 1, At, B1); G_BAR;
    G_LDA(At, 1, 1); G_STAGEV(G_SA(1, 0), a3, voffA);
    G_BAR; G_WAIT_L(0); G_MMA(1, 0, At, B0); G_BAR; G_SCHED;
    G_STAGEV(G_SB(1, 1), b3 + hstep, voff);
    G_WAIT_V(6); G_BAR; G_MMA(1, 1, At, B1); G_BAR;
  }
  { G_LDB(B0, 0, 0); G_LDA(At, 0, 0); G_STAGEV(G_SA(1, 1), cA + (size_t)(nt - 1) * kstep + hstep, voffA);
    G_BAR; G_WAIT_L(0); G_MMA(0, 0, At, B0); G_BAR;
    G_LDB(B1, 0, 1); G_BAR; G_WAIT_L(0); G_MMA(0, 1, At, B1); G_BAR;
    G_LDA(At, 0, 1); G_WAIT_V(4); G_BAR; G_WAIT_L(0); G_MMA(1, 0, At, B0); G_MMA(1, 1, At, B1); G_BAR; }
  { G_LDB(B0, 1, 0); G_LDA(At, 1, 0); G_WAIT_V(2); G_BAR; G_WAIT_L(0); G_MMA(0, 0, At, B0); G_BAR;
    G_LDB(B1, 1, 1); G_WAIT_V(0); G_BAR; G_WAIT_L(0); G_MMA(0, 1, At, B1); G_BAR;
    G_LDA(At, 1, 1); G_BAR; G_WAIT_L(0); G_MMA(1, 0, At, B0); G_MMA(1, 1, At, B1); G_BAR; }
  if (wr == 0) G_BAR;
}

DI void tile_map(int L, int total, int ntm, int ntn, int& mt, int& nt) {
  const int q = total >> 3, r = total & 7, xcd = L & 7, off = L >> 3;
  const int id = (xcd < r ? xcd * (q + 1) : r * (q + 1) + (xcd - r) * q) + off;
  const int nig = 8 * ntn, g = id / nig, w = id % nig, fm = g * 8, gsz = min(ntm - fm, 8);
  mt = fm + w % gsz; nt = w / gsz;
}
DI void convert_tile(const TJob& jb, int t, char* lds) {
  float* tile = (float*)lds;
  const int tid = threadIdx.x;
  const int tk = t / jb.tiles_n, tn = t % jb.tiles_n;
  const int k0 = tk * 64, n0 = tn * 64;
  __syncthreads();
#pragma unroll
  for (int i = 0; i < 2; ++i) {
    const int idx = tid + 512 * i, row = idx >> 4, c4 = idx & 15;
    const float4 v = *(const float4*)(jb.src + (size_t)(k0 + row) * jb.N + n0 + c4 * 4);
    tile[row * 65 + c4 * 4 + 0] = v.x; tile[row * 65 + c4 * 4 + 1] = v.y; tile[row * 65 + c4 * 4 + 2] = v.z; tile[row * 65 + c4 * 4 + 3] = v.w;
  }
  __syncthreads();
  const int n = tid >> 3, kc = tid & 7;
  float v[8];
#pragma unroll
  for (int j = 0; j < 8; ++j) v[j] = tile[(kc * 8 + j) * 65 + n];
  uint4 o;
  o.x = pack2(v[0], v[1]); o.y = pack2(v[2], v[3]); o.z = pack2(v[4], v[5]); o.w = pack2(v[6], v[7]);
  *(uint4*)(jb.dst + (size_t)(n0 + n) * jb.K + k0 + kc * 8) = o;
}

DI void mod_unit(const Params& p, int mu_, char* lds) {
  const int tid = threadIdx.x;
  const int layer = mu_ / 96, cc = mu_ % 96;
  float* sc = (float*)lds;
  float* red = sc + 9 * 1024;
  __syncthreads();
  for (int i = tid; i < 9 * 1024; i += 512) {
    const int row = i >> 10, k = i & 1023;
    const float v = row < 8 ? p.c[row * 1024 + k] : p.c_ctx[k];
    sc[i] = v / (1.f + __expf(-v));
  }
  __syncthreads();
  const int kg = tid >> 6, col = tid & 63;
  const float* w = p.w_mod + (size_t)layer * 1024 * 6144 + cc * 64 + col;
  float a[9];
#pragma unroll
  for (int r = 0; r < 9; ++r) a[r] = 0.f;
#pragma unroll 16
  for (int k = kg * 128; k < kg * 128 + 128; ++k) {
    const float wv = w[(size_t)k * 6144];
#pragma unroll
    for (int r = 0; r < 9; ++r) a[r] += sc[r * 1024 + k] * wv;
  }
#pragma unroll
  for (int r = 0; r < 9; ++r) red[(kg * 9 + r) * 64 + col] = a[r];
  __syncthreads();
  for (int i = tid; i < 576; i += 512) {
    const int r = i >> 6, cl = i & 63;
    float s = 0.f;
#pragma unroll
    for (int g = 0; g < 8; ++g) s += red[(g * 9 + r) * 64 + cl];
    const int n = cc * 64 + cl;
    p.MOD[(layer * 9 + r) * 6144 + n] = s + p.b_mod[layer * 6144 + n];
  }
  __syncthreads();
}

DI void sincos_d(double a, double& s, double& c) {
  const double n = rint(a * 0.6366197723675814);
  const double r = (a - n * 1.5707963267948966) - n * 6.123233995736766e-17;
  const double r2 = r * r;
  const double sp = r * (1.0 + r2 * (-1.0 / 6.0 + r2 * (1.0 / 120.0 + r2 * (-1.0 / 5040.0 + r2 * (1.0 / 362880.0 + r2 * (-1.0 / 39916800.0 + r2 * (1.0 / 6227020800.0)))))));
  const double cp = 1.0 + r2 * (-0.5 + r2 * (1.0 / 24.0 + r2 * (-1.0 / 720.0 + r2 * (1.0 / 40320.0 + r2 * (-1.0 / 3628800.0 + r2 * (1.0 / 479001600.0 + r2 * (-1.0 / 87178291200.0)))))));
  const int q = ((int)n) & 3;
  if (q == 0) { s = sp; c = cp; }
  else if (q == 1) { s = cp; c = -sp; }
  else if (q == 2) { s = -sp; c = -cp; }
  else { s = -cp; c = sp; }
}

DI void tab_unit(const Params& p) {
  for (int idx = threadIdx.x; idx < 1024; idx += 512) {
    const int pos = idx >> 4, fi = idx & 15;
    double f = 1.0;
    for (int i = 0; i < fi; ++i) f *= 0.5623413251903491;
    double s, c;
    sincos_d((double)pos * (double)(float)f, s, c);
    p.TAB[idx * 2 + 0] = (float)c;
    p.TAB[idx * 2 + 1] = (float)s;
  }
}

DI void phase0(const Params& p, char* lds) {
  const int total = p.total_tiles + 192 + 1;
  for (int u = blockIdx.x; u < total; u += gridDim.x) {
    if (u < p.total_tiles) {
      int j = 0;
#pragma unroll 1
      for (int q = 1; q < p.njobs; ++q) if (u >= p.jobs[q].tstart) j = q;
      convert_tile(p.jobs[j], u - p.jobs[j].tstart, lds);
    } else if (u < p.total_tiles + 192) {
      mod_unit(p, u - p.total_tiles, lds);
    } else {
      tab_unit(p);
    }
  }
}

DI void norm_mod_phase(const float* __restrict__ xl, const float* __restrict__ xc, const float* __restrict__ gain,
                               const float* __restrict__ mod, int shift_i, int scale_i, bf16_t* __restrict__ H, int ntok) {
  int tid_ = threadIdx.x; asm volatile("" : "+v"(tid_));
  const int lane = tid_ & 63;
  const int wg = blockIdx.x * 8 + (tid_ >> 6), nw = gridDim.x * 8;
  for (int t = wg; t < ntok; t += nw) {
    const float* row = t < NL ? xl + (size_t)t * 1024 : xc + (size_t)(t - NL) * 1024;
    float4 v[4];
    float ss = 0.f;
#pragma unroll
    for (int i = 0; i < 4; ++i) {
      v[i] = ld_nt4(row + (lane + 64 * i) * 4);
      ss += v[i].x * v[i].x + v[i].y * v[i].y + v[i].z * v[i].z + v[i].w * v[i].w;
    }
    ss = wave_sum(ss);
    const float rstd = rsqrtf(ss * (1.f / 1024.f) + 1e-6f);
    const int bp = t < NL ? (t >> 12) : 8;
    const float* sh = mod + (bp * 6 + shift_i) * 1024;
    const float* sc = mod + (bp * 6 + scale_i) * 1024;
#pragma unroll
    for (int i = 0; i < 4; ++i) {
      const int c = (lane + 64 * i) * 4;
      const float4 g = *(const float4*)(gain + c), s4 = *(const float4*)(sh + c), c4 = *(const float4*)(sc + c);
      store_bf4(H + (size_t)t * 1024 + c,
                v[i].x * rstd * g.x * (1.f + c4.x) + s4.x, v[i].y * rstd * g.y * (1.f + c4.y) + s4.y,
                v[i].z * rstd * g.z * (1.f + c4.z) + s4.z, v[i].w * rstd * g.w * (1.f + c4.w) + s4.w);
    }
  }
}

DI void final_norm_phase(const Params& p) {
  int tid_ = threadIdx.x; asm volatile("" : "+v"(tid_));
  const int lane = tid_ & 63;
  const int wg = blockIdx.x * 8 + (tid_ >> 6), nw = gridDim.x * 8;
  for (int t = wg; t < NL; t += nw) {
    float* row = p.out + (size_t)t * 1024;
    float4 v[4];
    float ss = 0.f;
#pragma unroll
    for (int i = 0; i < 4; ++i) {
      v[i] = ld_nt4(row + (lane + 64 * i) * 4);
      ss += v[i].x * v[i].x + v[i].y * v[i].y + v[i].z * v[i].z + v[i].w * v[i].w;
    }
    ss = wave_sum(ss);
    const float rstd = rsqrtf(ss * (1.f / 1024.f) + 1e-6f);
#pragma unroll
    for (int i = 0; i < 4; ++i) {
      const int c = (lane + 64 * i) * 4;
      const float4 g = *(const float4*)(p.final_norm + c);
      *(float4*)(row + c) = make_float4(v[i].x * rstd * g.x, v[i].y * rstd * g.y, v[i].z * rstd * g.z, v[i].w * rstd * g.w);
    }
  }
}

DI void phase_mix(const Params& p) {
  const int lane = threadIdx.x & 63;
  const int wg = blockIdx.x * 8 + (threadIdx.x >> 6), nw = gridDim.x * 8;
  for (int t = wg; t < NT; t += nw) {
#pragma unroll
    for (int i = 0; i < 2; ++i) {
      const int c = lane * 8 + 512 * i;
      const uint4 own = *(const uint4*)(p.Hd + (size_t)t * 1024 + c);
      int nb; bool valid;
      if (t < NL) {
        const int s = t & 4095, col = s & 63, rw = s >> 6, qd = c >> 8;
        if (qd == 0) { valid = col > 0; nb = t - 1; }
        else if (qd == 1) { valid = col < 63; nb = t + 1; }
        else if (qd == 2) { valid = rw > 0; nb = t - 64; }
        else { valid = rw < 63; nb = t + 64; }
      } else {
        const int s = (t - NL) & 255;
        if (c < 512) { valid = s > 0; nb = t - 1; }
        else { valid = s < 255; nb = t + 1; }
      }
      uint4 nv = make_uint4(0, 0, 0, 0);
      if (valid) nv = *(const uint4*)(p.Hd + (size_t)nb * 1024 + c);
#pragma unroll
      for (int j = 0; j < 3; ++j) {
        const int mi = j == 0 ? 0 : j == 1 ? 2 : 3;
        const float4 m0 = *(const float4*)(p.mu + mi * 1024 + c), m1 = *(const float4*)(p.mu + mi * 1024 + c + 4);
        uint4 o;
        o.x = lerp2(own.x, nv.x, m0.x, m0.y); o.y = lerp2(own.y, nv.y, m0.z, m0.w);
        o.z = lerp2(own.z, nv.z, m1.x, m1.y); o.w = lerp2(own.w, nv.w, m1.z, m1.w);
        *(uint4*)(p.S[3 + j] + (size_t)t * 1024 + c) = o;
      }
    }
  }
}

DI void phase_proj(const Params& p, char* lds) {
  const int lane = threadIdx.x & 63, wave = threadIdx.x >> 6;
  constexpr int NLORA = (NT / 256) * 3, NRKV = (NT / 256) * 12;
  for (int u = blockIdx.x; u < NLORA; u += gridDim.x) {
    {
      const int wt = wave & 3, wf = wave >> 2, lr = lane & 15, lq = lane >> 4;
      const int mt = u / 3, nt = 24 + u % 3;
      const int mi = nt == 24 ? 5 : nt == 25 ? 1 : 4;
      f32x4 acc[4][4];
      gemm_tile<true>(p.Hd, 1024, p.Wcat, 1024, 1024, mt * 256, nt * 128, lds, acc, p.mu + mi * 1024);
#pragma unroll
      for (int pp = 0; pp < 2; ++pp)
#pragma unroll
        for (int ti = 0; ti < 4; ++ti) {
          const int t = mt * 256 + wt * 64 + ti * 16 + lr;
          const int fl = wf * 64 + pp * 32 + lq * 8;
          f32x4 a = acc[2 * pp][ti], b = acc[2 * pp + 1][ti];
          if (nt == 24) {
#pragma unroll
            for (int j = 0; j < 4; ++j) { a[j] = sigmoidf_(a[j]); b[j] = sigmoidf_(b[j]); }
            store_bf8(p.L1 + (size_t)t * 384 + fl, a, b);
          } else if (nt == 25) {
#pragma unroll
            for (int j = 0; j < 4; ++j) { a[j] = tanhf_(a[j]); b[j] = tanhf_(b[j]); }
            store_bf8(p.L1 + (size_t)t * 384 + 128 + fl, a, b);
          } else {
            store_bf8(p.L1 + (size_t)t * 384 + 256 + fl, a, b);
          }
        }
    }
  }
  for (int v0 = blockIdx.x; v0 < NRKV; v0 += gridDim.x) {
    {
      const int wr = wave >> 2, wc = wave & 3;
      f32x4 acc[2][2][4][2];
      { int mt0, rem0; tile_map(v0, NRKV, NT / 256, 12, mt0, rem0); const int j0 = rem0 >> 2, nt0 = rem0 & 3;
        gemm256_tile<true>(p.Wcat + (size_t)j0 * 1024 * 1024, p.S[3 + j0], 1024, nt0 * 256, mt0 * 256, lds, acc); }
      int lane_o = threadIdx.x & 63; asm volatile("" : "+v"(lane_o));
      int v = v0; asm volatile("" : "+s"(v));
      int mt, rem; tile_map(v, NRKV, NT / 256, 12, mt, rem); const int j = rem >> 2, nt = rem & 3;
      const int fr = lane_o & 15, fq = lane_o >> 4;
#pragma unroll
      for (int bj = 0; bj < 2; ++bj)
#pragma unroll
        for (int n = 0; n < 2; ++n) {
          const int t = mt * 256 + bj * 128 + wc * 32 + n * 16 + fr;
#pragma unroll
          for (int ai = 0; ai < 2; ++ai) {
            const int fh = nt * 256 + ai * 128 + wr * 64;
            if (j == 1) {
              f32x4 a[2], b[2];
              float ss = 0.f;
#pragma unroll
              for (int mp = 0; mp < 2; ++mp) {
                const int f = fh + mp * 32 + fq * 8;
                const float4 kkl = *(const float4*)(p.k_k + f), kkh = *(const float4*)(p.k_k + f + 4);
                a[mp] = acc[ai][bj][2 * mp][n]; b[mp] = acc[ai][bj][2 * mp + 1][n];
                a[mp][0] *= kkl.x; a[mp][1] *= kkl.y; a[mp][2] *= kkl.z; a[mp][3] *= kkl.w;
                b[mp][0] *= kkh.x; b[mp][1] *= kkh.y; b[mp][2] *= kkh.z; b[mp][3] *= kkh.w;
#pragma unroll
                for (int e2 = 0; e2 < 4; ++e2) ss += a[mp][e2] * a[mp][e2] + b[mp][e2] * b[mp][e2];
              }
              ss += __shfl_xor(ss, 16); ss += __shfl_xor(ss, 32);
              const float kinv = rsqrtf(ss + 1e-12f);
#pragma unroll
              for (int mp = 0; mp < 2; ++mp) {
#pragma unroll
                for (int e2 = 0; e2 < 4; ++e2) { a[mp][e2] *= kinv; b[mp][e2] *= kinv; }
                store_bf8(p.S[2] + HM(t, fh + mp * 32 + fq * 8), a[mp], b[mp]);
              }
              if (fq == 0) p.NRM[(size_t)(fh >> 6) * NT + t] = sqrtf(ss + 1e-12f);
            } else {
              bf16_t* dst = j == 0 ? p.S[0] : p.S[1];
#pragma unroll
              for (int mp = 0; mp < 2; ++mp)
                store_bf8(dst + HM(t, fh + mp * 32 + fq * 8), acc[ai][bj][2 * mp][n], acc[ai][bj][2 * mp + 1][n]);
            }
          }
        }
    }
  }
}

DI void phase_prep(const Params& p, char* lds) {
  const int lane = threadIdx.x & 63, wave = threadIdx.x >> 6;
  const int wt = wave & 3, wf = wave >> 2, lr = lane & 15, lq = lane >> 4;
  const int total = (NT / 256) * 8;
  for (int u = blockIdx.x; u < total; u += gridDim.x) {
    const int mt = u >> 3, nt = u & 7;
    const int tok0 = mt * 256, f0 = nt * 128;
    f32x4 acc[4][4];
    uint4 afp[2][4];
    gemm_tile<false>(p.L1 + 256, 384, p.L2w + 0 * 65536, 64, 64, tok0, f0, lds, acc, nullptr);
#pragma unroll
    for (int pp = 0; pp < 2; ++pp) {
      const int f = f0 + wf * 64 + pp * 32 + lq * 8;
      const float4 a0l = *(const float4*)(p.a0 + f), a0h = *(const float4*)(p.a0 + f + 4);
#pragma unroll
      for (int ti = 0; ti < 4; ++ti) {
        const int t = tok0 + wt * 64 + ti * 16 + lr;
        f32x4 a = acc[2 * pp][ti], b = acc[2 * pp + 1][ti];
        a[0] = sigmoidf_(a[0] + a0l.x); a[1] = sigmoidf_(a[1] + a0l.y); a[2] = sigmoidf_(a[2] + a0l.z); a[3] = sigmoidf_(a[3] + a0l.w);
        b[0] = sigmoidf_(b[0] + a0h.x); b[1] = sigmoidf_(b[1] + a0h.y); b[2] = sigmoidf_(b[2] + a0h.z); b[3] = sigmoidf_(b[3] + a0h.w);
        uint4 o; o.x = pack2(a[0], a[1]); o.y = pack2(a[2], a[3]); o.z = pack2(b[0], b[1]); o.w = pack2(b[2], b[3]);
        afp[pp][ti] = o;
        *(uint4*)(p.S[3] + HM(t, f)) = o;
      }
    }
    gemm_tile<false>(p.L1 + 320, 384, p.L2w + 1 * 65536, 64, 64, tok0, f0, lds, acc, nullptr);
#pragma unroll
    for (int ti = 0; ti < 4; ++ti) {
      const int t = tok0 + wt * 64 + ti * 16 + lr;
      float bon = 0.f;
      const float nrm = p.NRM[(size_t)(nt * 2 + wf) * NT + t];
#pragma unroll
      for (int pp = 0; pp < 2; ++pp) {
        const int f = f0 + wf * 64 + pp * 32 + lq * 8;
        const float4 a0l = *(const float4*)(p.a0 + 1024 + f), a0h = *(const float4*)(p.a0 + 1024 + f + 4);
        const float4 rkl = *(const float4*)(p.r_k + f), rkh = *(const float4*)(p.r_k + f + 4);
        const float4 kal = *(const float4*)(p.k_a + f), kah = *(const float4*)(p.k_a + f + 4);
        const float4 kkl = *(const float4*)(p.k_k + f), kkh = *(const float4*)(p.k_k + f + 4);
        const float rk8[8] = {rkl.x, rkl.y, rkl.z, rkl.w, rkh.x, rkh.y, rkh.z, rkh.w};
        const float ka8[8] = {kal.x, kal.y, kal.z, kal.w, kah.x, kah.y, kah.z, kah.w};
        const float kk8[8] = {kkl.x, kkl.y, kkl.z, kkl.w, kkh.x, kkh.y, kkh.z, kkh.w};
        f32x4 a = acc[2 * pp][ti], b = acc[2 * pp + 1][ti];
        a[0] = sigmoidf_(a[0] + a0l.x); a[1] = sigmoidf_(a[1] + a0l.y); a[2] = sigmoidf_(a[2] + a0l.z); a[3] = sigmoidf_(a[3] + a0l.w);
        b[0] = sigmoidf_(b[0] + a0h.x); b[1] = sigmoidf_(b[1] + a0h.y); b[2] = sigmoidf_(b[2] + a0h.z); b[3] = sigmoidf_(b[3] + a0h.w);
        store_bf8(p.S[4] + HM(t, f), a, b);
        const float ab8[8] = {a[0], a[1], a[2], a[3], b[0], b[1], b[2], b[3]};
        float af8[8], r8[8], k8[8];
        unpack_bf8(afp[pp][ti], af8);
        unpack_bf8(*(const uint4*)(p.S[0] + HM(t, f)), r8);
        unpack_bf8(*(const uint4*)(p.S[2] + HM(t, f)), k8);
#pragma unroll
        for (int e2 = 0; e2 < 8; ++e2) {
          const float k = k8[e2] * nrm / kk8[e2];
          bon += r8[e2] * k * rk8[e2] * (2.f + (ab8[e2] + af8[e2] - 2.f) * ka8[e2]);
        }
      }
      bon += __shfl_xor(bon, 16); bon += __shfl_xor(bon, 32);
      if (lq == 0) p.BON[(size_t)(nt * 2 + wf) * NT + t] = bon;
    }
#pragma unroll 1
    for (int dr = 0; dr < 2; ++dr) {
      gemm_tile<false>(p.L1 + 128 + dr * 64, 384, p.L2w + (2 + dr) * 65536, 64, 64, tok0, f0, lds, acc, nullptr);
      bf16_t* dst = dr ? p.S[5] : p.Hd;
#pragma unroll
      for (int pp = 0; pp < 2; ++pp) {
        const int f = f0 + wf * 64 + pp * 32 + lq * 8;
        const float4 w0l = *(const float4*)(p.w0 + dr * 1024 + f), w0h = *(const float4*)(p.w0 + dr * 1024 + f + 4);
#pragma unroll
        for (int ti = 0; ti < 4; ++ti) {
          const int t = tok0 + wt * 64 + ti * 16 + lr;
          f32x4 a = acc[2 * pp][ti], b = acc[2 * pp + 1][ti];
          a[0] = -0.60653066f * sigmoidf_(a[0] + w0l.x); a[1] = -0.60653066f * sigmoidf_(a[1] + w0l.y);
          a[2] = -0.60653066f * sigmoidf_(a[2] + w0l.z); a[3] = -0.60653066f * sigmoidf_(a[3] + w0l.w);
          b[0] = -0.60653066f * sigmoidf_(b[0] + w0h.x); b[1] = -0.60653066f * sigmoidf_(b[1] + w0h.y);
          b[2] = -0.60653066f * sigmoidf_(b[2] + w0h.z); b[3] = -0.60653066f * sigmoidf_(b[3] + w0h.w);
          store_bf8(dst + HM(t, f), a, b);
        }
      }
    }
  }
}

typedef short s16x4 __attribute__((ext_vector_type(4)));
#define MFMA16K(a, b, c) __builtin_amdgcn_mfma_f32_16x16x16bf16_1k((a), (b), (c), 0, 0, 0)
DI s16x4 pack4(const f32x4& x) { const uint2 u = make_uint2(pack2(x[0], x[1]), pack2(x[2], x[3])); return __builtin_bit_cast(s16x4, u); }
DI bf16x8 pack8(const f32x4& a, const f32x4& b) { const uint4 u = make_uint4(pack2(a[0], a[1]), pack2(a[2], a[3]), pack2(b[0], b[1]), pack2(b[2], b[3])); return __builtin_bit_cast(bf16x8, u); }
constexpr int SC_KK = 0, SC_R = 2304, SC_B = 4608, SC_K = 6912, SC_BT = 9216, SC_KT = 12288, SC_VT = 15360, SC_CL = 18432, SC_CHUNK = 18688, SC_GROUP = 2 * SC_CHUNK, SC_YBUF = 2 * SC_GROUP;

#define KEEP8(x) asm volatile("" :: "v"(x))
#define KEEP4(x) asm volatile("" :: "v"(x))
struct ChunkT { s16x4 bT, pAkk, pAbr, pAkr; };
DI void scan_partA2(const char* cb0, ChunkT (&ct)[2], int c, int q) {
  const f32x4 z = {0.f, 0.f, 0.f, 0.f};
  f32x4 Abk[2], AbkT[2], Akk[2], Abr[2], Akr[2], P[2];
#pragma unroll
  for (int h = 0; h < 2; ++h) {
    const char* cb = cb0 + h * SC_CHUNK;
    bf16x8 fB[2], fK[2], fKK[2], fR[2];
#pragma unroll
    for (int ks = 0; ks < 2; ++ks) {
      fB[ks] = *(const bf16x8*)(cb + SC_B + c * 144 + ks * 64 + q * 16);
      fK[ks] = *(const bf16x8*)(cb + SC_K + c * 144 + ks * 64 + q * 16);
      fKK[ks] = *(const bf16x8*)(cb + SC_KK + c * 144 + ks * 64 + q * 16);
      fR[ks] = *(const bf16x8*)(cb + SC_R + c * 144 + ks * 64 + q * 16);
    }
    Abk[h] = MFMA16(fB[0], fKK[0], z);  Abk[h] = MFMA16(fB[1], fKK[1], Abk[h]);
    AbkT[h] = MFMA16(fKK[0], fB[0], z); AbkT[h] = MFMA16(fKK[1], fB[1], AbkT[h]);
    Akk[h] = MFMA16(fK[0], fKK[0], z);  Akk[h] = MFMA16(fK[1], fKK[1], Akk[h]);
    Abr[h] = MFMA16(fB[0], fR[0], z);   Abr[h] = MFMA16(fB[1], fR[1], Abr[h]);
    Akr[h] = MFMA16(fK[0], fR[0], z);   Akr[h] = MFMA16(fK[1], fR[1], Akr[h]);
    KEEP8(fB[0]); KEEP8(fB[1]); KEEP8(fK[0]); KEEP8(fK[1]); KEEP8(fKK[0]); KEEP8(fKK[1]); KEEP8(fR[0]); KEEP8(fR[1]);
  }
#pragma unroll
  for (int h = 0; h < 2; ++h)
#pragma unroll
    for (int j = 0; j < 4; ++j) {
      const int rr = 4 * q + j;
      Abk[h][j] = rr < c ? Abk[h][j] : 0.f;  Akk[h][j] = rr < c ? Akk[h][j] : 0.f;
      Abr[h][j] = rr <= c ? Abr[h][j] : 0.f; Akr[h][j] = rr <= c ? Akr[h][j] : 0.f;
      AbkT[h][j] = c < rr ? AbkT[h][j] : 0.f;
      P[h][j] = (rr == c ? 1.f : 0.f) - Abk[h][j];
    }
  s16x4 bN[2], bNT[2], bN2[2], bN2T[2], bN4[2], bN4T[2], bN8T[2];
  f32x4 N2[2], N2T[2], N4[2], N4T[2], N8T[2];
#pragma unroll
  for (int h = 0; h < 2; ++h) { bN[h] = pack4(Abk[h]); bNT[h] = pack4(AbkT[h]); }
#pragma unroll
  for (int h = 0; h < 2; ++h) { N2[h] = MFMA16K(bNT[h], bN[h], z); N2T[h] = MFMA16K(bN[h], bNT[h], z); }
#pragma unroll
  for (int h = 0; h < 2; ++h) { KEEP4(bN[h]); KEEP4(bNT[h]); bN2[h] = pack4(N2[h]); bN2T[h] = pack4(N2T[h]); }
#pragma unroll
  for (int h = 0; h < 2; ++h) { N4[h] = MFMA16K(bN2T[h], bN2[h], z); N4T[h] = MFMA16K(bN2[h], bN2T[h], z); }
#pragma unroll
  for (int h = 0; h < 2; ++h) { KEEP4(bN2[h]); bN4[h] = pack4(N4[h]); bN4T[h] = pack4(N4T[h]); }
#pragma unroll
  for (int h = 0; h < 2; ++h) N8T[h] = MFMA16K(bN4[h], bN4T[h], z);
#pragma unroll
  for (int h = 0; h < 2; ++h) { KEEP4(bN4[h]); bN8T[h] = pack4(N8T[h]); }
  s16x4 pp_[2];
#pragma unroll
  for (int h = 0; h < 2; ++h) { pp_[h] = pack4(P[h]); P[h] = MFMA16K(bN2T[h], pp_[h], P[h]); }
#pragma unroll
  for (int h = 0; h < 2; ++h) { KEEP4(pp_[h]); KEEP4(bN2T[h]); }
#pragma unroll
  for (int h = 0; h < 2; ++h) { pp_[h] = pack4(P[h]); P[h] = MFMA16K(bN4T[h], pp_[h], P[h]); }
#pragma unroll
  for (int h = 0; h < 2; ++h) { KEEP4(pp_[h]); KEEP4(bN4T[h]); }
#pragma unroll
  for (int h = 0; h < 2; ++h) { pp_[h] = pack4(P[h]); P[h] = MFMA16K(bN8T[h], pp_[h], P[h]); }
#pragma unroll
  for (int h = 0; h < 2; ++h) { KEEP4(pp_[h]); KEEP4(bN8T[h]); }
#pragma unroll
  for (int h = 0; h < 2; ++h) { ct[h].bT = pack4(P[h]); ct[h].pAkk = pack4(Akk[h]); ct[h].pAbr = pack4(Abr[h]); ct[h].pAkr = pack4(Akr[h]); }
}
DI void scan_partB(const char* cb, float* yb, f32x4 (&ST)[4], const ChunkT& ct, int vb, int c, int q) {
  const f32x4 z = {0.f, 0.f, 0.f, 0.f};
  bf16x8 sf[2], kkp[2], rp[2];
#pragma unroll
  for (int i = 0; i < 2; ++i) {
    sf[i] = pack8(ST[2 * i], ST[2 * i + 1]);
    const uint2 klo = *(const uint2*)(cb + SC_KK + c * 144 + (32 * i + 4 * q) * 2), khi = *(const uint2*)(cb + SC_KK + c * 144 + (32 * i + 16 + 4 * q) * 2);
    const uint2 rlo = *(const uint2*)(cb + SC_R + c * 144 + (32 * i + 4 * q) * 2), rhi = *(const uint2*)(cb + SC_R + c * 144 + (32 * i + 16 + 4 * q) * 2);
    kkp[i] = __builtin_bit_cast(bf16x8, make_uint4(klo.x, klo.y, khi.x, khi.y));
    rp[i] = __builtin_bit_cast(bf16x8, make_uint4(rlo.x, rlo.y, rhi.x, rhi.y));
  }
  f32x4 XT = MFMA16(kkp[0], sf[0], z); XT = MFMA16(kkp[1], sf[1], XT);
  f32x4 YT = MFMA16(rp[0], sf[0], z);  YT = MFMA16(rp[1], sf[1], YT);
  KEEP8(kkp[0]); KEEP8(kkp[1]); KEEP8(rp[0]); KEEP8(rp[1]); KEEP8(sf[0]); KEEP8(sf[1]);
  const s16x4 vf = *(const s16x4*)(cb + SC_VT + (vb * 16 + c) * 48 + q * 8);
  XT = MFMA16K(ct.pAkk, vf, XT);
  const s16x4 pXT = pack4(XT);
  f32x4 UT = MFMA16K(ct.bT, pXT, z); KEEP4(pXT);
#pragma unroll
  for (int j = 0; j < 4; ++j) UT[j] = -UT[j];
  const s16x4 bU = pack4(UT);
  YT = MFMA16K(ct.pAbr, bU, YT);
  YT = MFMA16K(ct.pAkr, vf, YT);
#pragma unroll
  for (int j = 0; j < 4; ++j) yb[(4 * q + j) * 64 + vb * 16 + c] = YT[j];
#pragma unroll
  for (int kt = 0; kt < 4; ++kt) {
    const s16x4 bh = *(const s16x4*)(cb + SC_BT + (16 * kt + c) * 48 + q * 8);
    const s16x4 kh = *(const s16x4*)(cb + SC_KT + (16 * kt + c) * 48 + q * 8);
    f32x4 s = MFMA16K(bh, bU, ST[kt]);
    s = MFMA16K(kh, vf, s); KEEP4(bh); KEEP4(kh);
    const float4 cl = *(const float4*)(cb + SC_CL + (16 * kt + 4 * q) * 4);
    s[0] *= cl.x; s[1] *= cl.y; s[2] *= cl.z; s[3] *= cl.w;
    ST[kt] = s;
  }
  KEEP4(bU); KEEP4(vf); KEEP4(ct.bT); KEEP4(ct.pAkk); KEEP4(ct.pAbr); KEEP4(ct.pAkr);
}

DI void phase_scan(const Params& p, char* lds) {
  float* ybuf = (float*)(lds + SC_YBUF);
  const int tid = threadIdx.x, lane = tid & 63, wave = tid >> 6;
  const bool loader = tid >= 256;
  const int lt = tid & 255, ltk = lt >> 3, lch = (lt & 7) * 8;
  const int lcc = (wave >> 1) & 1, lchh = wave & 1, ltok = lane >> 2, loct = lane & 3, ch0 = lchh * 32 + loct * 8;
  const int vb = wave & 3, cc_ = lane & 15, qq = lane >> 4;
  constexpr int NG = NKEY / 32;
  for (int unit = blockIdx.x; unit < 256; unit += gridDim.x) {
    const int dir = unit & 1, h = (unit >> 1) & 15, b = unit >> 5;
    const bf16_t* Rp = p.S[0]; const bf16_t* Vp = p.S[1]; const bf16_t* Kp = p.S[2];
    bf16_t* Ap = dir ? p.S[4] : p.S[3];
    const bf16_t* Lp = dir ? p.S[5] : p.Hd;
    auto tok_of = [&](int i) -> int {
      if (i < 256) return NL + b * 256 + (dir ? 255 - i : i);
      const int s = i - 256;
      return b * 4096 + (dir ? 4095 - s : s);
    };
    uint4 rawA[5], rawB[5];
    float nrmA = 0.f, nrmB = 0.f;
    float rkk[8], kac[8];
    f32x4 ST[4];
#pragma unroll
    for (int i = 0; i < 4; ++i) ST[i] = f32x4{0.f, 0.f, 0.f, 0.f};
    if (loader) {
#pragma unroll
      for (int j = 0; j < 8; ++j) { rkk[j] = 1.f / p.k_k[h * 64 + ch0 + j]; kac[j] = p.k_a[h * 64 + ch0 + j]; }
    }
    auto issue = [&](int g, uint4 (&rw)[5], float& nv) {
      const int t = tok_of(g * 32 + lcc * 16 + ltok);
      const size_t off = HM(t, h * 64 + ch0);
      rw[0] = *(const uint4*)(Rp + off); rw[1] = *(const uint4*)(Vp + off); rw[2] = *(const uint4*)(Kp + off);
      rw[3] = *(const uint4*)(Ap + off); rw[4] = *(const uint4*)(Lp + off);
      nv = p.NRM[(size_t)h * NT + t];
    };
    auto process = [&](int stage, const uint4 (&raw)[5], const float nrmv) {
      float r8[8], kk8[8], a8[8], l8[8], L[8];
      unpack_bf8(raw[0], r8); unpack_bf8(raw[2], kk8); unpack_bf8(raw[3], a8); unpack_bf8(raw[4], l8);
#pragma unroll
      for (int j = 0; j < 8; ++j) L[j] = l8[j];
#pragma unroll
      for (int d = 4; d < 64; d <<= 1) {
#pragma unroll
        for (int j = 0; j < 8; ++j) { const float o = __shfl_up(L[j], d); if (lane >= d) L[j] += o; }
      }
      float okk[8], orr[8], ob[8], ok[8], cend[8];
#pragma unroll
      for (int j = 0; j < 8; ++j) {
        const float cc = __expf(L[j]), cprev = __expf(L[j] - l8[j]), cinv = __expf(-L[j]);
        const float k = kk8[j] * nrmv * rkk[j];
        const float kd = k * (1.f + (a8[j] - 1.f) * kac[j]);
        okk[j] = kk8[j] * cprev; orr[j] = r8[j] * cc; ob[j] = kk8[j] * a8[j] * cinv; ok[j] = kd * cinv; cend[j] = cc;
      }
      char* cb = lds + stage * SC_GROUP + lcc * SC_CHUNK;
      uint4 o;
      o = make_uint4(pack2(okk[0], okk[1]), pack2(okk[2], okk[3]), pack2(okk[4], okk[5]), pack2(okk[6], okk[7])); *(uint4*)(cb + SC_KK + ltok * 144 + ch0 * 2) = o;
      o = make_uint4(pack2(orr[0], orr[1]), pack2(orr[2], orr[3]), pack2(orr[4], orr[5]), pack2(orr[6], orr[7])); *(uint4*)(cb + SC_R + ltok * 144 + ch0 * 2) = o;
      const uint4 obp = make_uint4(pack2(ob[0], ob[1]), pack2(ob[2], ob[3]), pack2(ob[4], ob[5]), pack2(ob[6], ob[7])); *(uint4*)(cb + SC_B + ltok * 144 + ch0 * 2) = obp;
      const uint4 okp = make_uint4(pack2(ok[0], ok[1]), pack2(ok[2], ok[3]), pack2(ok[4], ok[5]), pack2(ok[6], ok[7])); *(uint4*)(cb + SC_K + ltok * 144 + ch0 * 2) = okp;
      const unsigned bw[4] = {obp.x, obp.y, obp.z, obp.w}, kw[4] = {okp.x, okp.y, okp.z, okp.w}, vw[4] = {raw[1].x, raw[1].y, raw[1].z, raw[1].w};
#pragma unroll
      for (int j = 0; j < 8; ++j) {
        const int sh = (j & 1) * 16;
        *(bf16_t*)(cb + SC_BT + (ch0 + j) * 48 + ltok * 2) = (bf16_t)((bw[j >> 1] >> sh) & 0xffffu);
        *(bf16_t*)(cb + SC_KT + (ch0 + j) * 48 + ltok * 2) = (bf16_t)((kw[j >> 1] >> sh) & 0xffffu);
        *(bf16_t*)(cb + SC_VT + (ch0 + j) * 48 + ltok * 2) = (bf16_t)((vw[j >> 1] >> sh) & 0xffffu);
      }
      if (ltok == 15) {
        *(float4*)(cb + SC_CL + ch0 * 4) = make_float4(cend[0], cend[1], cend[2], cend[3]);
        *(float4*)(cb + SC_CL + ch0 * 4 + 16) = make_float4(cend[4], cend[5], cend[6], cend[7]);
      }
    };
    auto yout = [&](int g) {
      const float* yb = ybuf + (g & 1) * 2048 + ltk * 64 + lch;
      const float4 y0 = *(const float4*)yb, y1 = *(const float4*)(yb + 4);
      const int t = tok_of(g * 32 + ltk);
      uint4 o;
      o.x = pack2(y0.x, y0.y); o.y = pack2(y0.z, y0.w); o.z = pack2(y1.x, y1.y); o.w = pack2(y1.z, y1.w);
      *(uint4*)(Ap + HM(t, h * 64 + lch)) = o;
    };
    __syncthreads();
    if (loader) { issue(0, rawA, nrmA); issue(1, rawB, nrmB); process(0, rawA, nrmA); issue(2, rawA, nrmA); }
    __syncthreads();
    for (int g = 0; g < NG; g += 2) {
      if (loader) {
        if (g >= 1) yout(g - 1);
        if (g + 1 < NG) { process(1, rawB, nrmB); if (g + 3 < NG) issue(g + 3, rawB, nrmB); }
      } else {
        const char* gb = lds;
        float* yb = ybuf;
        ChunkT ct[2];
        scan_partA2(gb, ct, cc_, qq);
        scan_partB(gb, yb, ST, ct[0], vb, cc_, qq);
        scan_partB(gb + SC_CHUNK, yb + 16 * 64, ST, ct[1], vb, cc_, qq);
      }
      __syncthreads();
      if (g + 1 < NG) {
        if (loader) {
          yout(g);
          if (g + 2 < NG) { process(0, rawA, nrmA); if (g + 4 < NG) issue(g + 4, rawA, nrmA); }
        } else {
          const char* gb = lds + SC_GROUP;
          float* yb = ybuf + 2048;
          ChunkT ct[2];
          scan_partA2(gb, ct, cc_, qq);
          scan_partB(gb, yb, ST, ct[0], vb, cc_, qq);
          scan_partB(gb + SC_CHUNK, yb + 16 * 64, ST, ct[1], vb, cc_, qq);
        }
        __syncthreads();
      }
    }
    if (loader) yout(NG - 1);
    __syncthreads();
  }
}

DI void phase_readout(const Params& p, char* lds) {
  const int lane = threadIdx.x & 63, wave = threadIdx.x >> 6;
  const int wt = wave & 3, wf = wave >> 2, lr = lane & 15, lq = lane >> 4;
  const int total = (NT / 256) * 8;
  for (int u = blockIdx.x; u < total; u += gridDim.x) {
    const int mt = u >> 3, nt = u & 7;
    const int tok0 = mt * 256, f0 = nt * 128;
    f32x4 g[4][4];
    gemm_tile<false>(p.L1, 384, p.g2T, 128, 128, tok0, f0, lds, g, nullptr);
    const int head = nt * 2 + wf;
#pragma unroll
    for (int ti = 0; ti < 4; ++ti) {
      const int t = tok0 + wt * 64 + ti * 16 + lr;
      float y[2][8];
      float sum = 0.f;
#pragma unroll
      for (int pp = 0; pp < 2; ++pp) {
        const int f = f0 + wf * 64 + pp * 32 + lq * 8;
        float ya[8], yb[8];
        unpack_bf8(*(const uint4*)(p.S[3] + HM(t, f)), ya);
        unpack_bf8(*(const uint4*)(p.S[4] + HM(t, f)), yb);
#pragma unroll
        for (int e2 = 0; e2 < 8; ++e2) { y[pp][e2] = ya[e2] + yb[e2]; sum += y[pp][e2]; }
      }
      sum += __shfl_xor(sum, 16); sum += __shfl_xor(sum, 32);
      const float mean = sum * (1.f / 64.f);
      float vs = 0.f;
#pragma unroll
      for (int pp = 0; pp < 2; ++pp)
#pragma unroll
        for (int e2 = 0; e2 < 8; ++e2) { const float d = y[pp][e2] - mean; vs += d * d; }
      vs += __shfl_xor(vs, 16); vs += __shfl_xor(vs, 32);
      const float rstd = rsqrtf(vs * (1.f / 64.f) + 64e-5f);
      const float bon = p.BON[(size_t)head * NT + t];
#pragma unroll
      for (int pp = 0; pp < 2; ++pp) {
        const int f = f0 + wf * 64 + pp * 32 + lq * 8;
        const float4 lwl = *(const float4*)(p.ln_w + f), lwh = *(const float4*)(p.ln_w + f + 4);
        const float4 lbl = *(const float4*)(p.ln_b + f), lbh = *(const float4*)(p.ln_b + f + 4);
        const float lw8[8] = {lwl.x, lwl.y, lwl.z, lwl.w, lwh.x, lwh.y, lwh.z, lwh.w};
        const float lb8[8] = {lbl.x, lbl.y, lbl.z, lbl.w, lbh.x, lbh.y, lbh.z, lbh.w};
        float v8[8];
        unpack_bf8(*(const uint4*)(p.S[1] + HM(t, f)), v8);
        f32x4 oa, ob;
#pragma unroll
        for (int j = 0; j < 4; ++j) {
          oa[j] = ((y[pp][j] - mean) * rstd * lw8[j] + lb8[j] + bon * v8[j]) * g[2 * pp][ti][j];
          ob[j] = ((y[pp][4 + j] - mean) * rstd * lw8[4 + j] + lb8[4 + j] + bon * v8[4 + j]) * g[2 * pp + 1][ti][j];
        }
        store_bf8(p.S[0] + (size_t)t * 1024 + f, oa, ob);
      }
    }
  }
}

DI void phase_gemm_resid(const Params& p, char* lds, const bf16_t* A, const bf16_t* W, int K, int ntm,
                                 const float* xin_l, const float* xin_c, const float* gate) {
  const int lane = threadIdx.x & 63, wave = threadIdx.x >> 6;
  const int wr = wave >> 2, wc = wave & 3;
  const int total = ntm * 4;
  for (int u = blockIdx.x; u < total; u += gridDim.x) {
    int mt, nt; tile_map(u, total, ntm, 4, mt, nt);
    f32x4 acc[2][2][4][2];
    gemm256_tile<true>(W, A, K, nt * 256, mt * 256, lds, acc);
    int lane_o = threadIdx.x & 63; asm volatile("" : "+v"(lane_o));
    const int fr = lane_o & 15, fq = lane_o >> 4;
#pragma unroll
    for (int bj = 0; bj < 2; ++bj)
#pragma unroll
      for (int n = 0; n < 2; ++n) {
        const int t = mt * 256 + bj * 128 + wc * 32 + n * 16 + fr;
        const int bp = t < NL ? (t >> 12) : 8;
        const float* xi = t < NL ? xin_l + (size_t)t * 1024 : xin_c + (size_t)(t - NL) * 1024;
        float* xo = t < NL ? p.out + (size_t)t * 1024 : p.XC + (size_t)(t - NL) * 1024;
#pragma unroll
        for (int ai = 0; ai < 2; ++ai)
#pragma unroll
          for (int mp = 0; mp < 2; ++mp) {
            const int f = nt * 256 + ai * 128 + wr * 64 + mp * 32 + fq * 8;
            const float4 g0 = *(const float4*)(gate + bp * 6144 + f), g1 = *(const float4*)(gate + bp * 6144 + f + 4);
            const float4 x0 = *(const float4*)(xi + f), x1 = *(const float4*)(xi + f + 4);
            const f32x4 a = acc[ai][bj][2 * mp][n], b = acc[ai][bj][2 * mp + 1][n];
            *(float4*)(xo + f) = make_float4(x0.x + g0.x * a[0], x0.y + g0.y * a[1], x0.z + g0.z * a[2], x0.w + g0.w * a[3]);
            *(float4*)(xo + f + 4) = make_float4(x1.x + g1.x * b[0], x1.y + g1.y * b[1], x1.z + g1.z * b[2], x1.w + g1.w * b[3]);
          }
      }
  }
}

constexpr int DT_MAIN = 512, DT_TOTAL = 544, DT_SLICES = 8;
DI void phase_down_split(const Params& p, char* lds, const float* gate) {
  const int wave = threadIdx.x >> 6;
  const int wr = wave >> 2, wc = wave & 3;
  const bf16_t* A = p.S[0]; const bf16_t* W = p.w2T[0];
  for (int u = blockIdx.x; u < DT_MAIN; u += gridDim.x) {
    int mt, nt; tile_map(u, DT_TOTAL, NT / 256, 4, mt, nt);
    f32x4 acc[2][2][4][2];
    gemm256_tile<true>(W, A, 4096, nt * 256, mt * 256, lds, acc);
    int lane_o = threadIdx.x & 63; asm volatile("" : "+v"(lane_o));
    const int fr = lane_o & 15, fq = lane_o >> 4;
#pragma unroll
    for (int bj = 0; bj < 2; ++bj)
#pragma unroll
      for (int n = 0; n < 2; ++n) {
        const int t = mt * 256 + bj * 128 + wc * 32 + n * 16 + fr;
        const int bp = t < NL ? (t >> 12) : 8;
        float* xo = t < NL ? p.out + (size_t)t * 1024 : p.XC + (size_t)(t - NL) * 1024;
#pragma unroll
        for (int ai = 0; ai < 2; ++ai)
#pragma unroll
          for (int mp = 0; mp < 2; ++mp) {
            const int f = nt * 256 + ai * 128 + wr * 64 + mp * 32 + fq * 8;
            const float4 g0 = *(const float4*)(gate + bp * 6144 + f), g1 = *(const float4*)(gate + bp * 6144 + f + 4);
            const float4 x0 = *(const float4*)(xo + f), x1 = *(const float4*)(xo + f + 4);
            const f32x4 a = acc[ai][bj][2 * mp][n], b = acc[ai][bj][2 * mp + 1][n];
            *(float4*)(xo + f) = make_float4(x0.x + g0.x * a[0], x0.y + g0.y * a[1], x0.z + g0.z * a[2], x0.w + g0.w * a[3]);
            *(float4*)(xo + f + 4) = make_float4(x1.x + g1.x * b[0], x1.y + g1.y * b[1], x1.z + g1.z * b[2], x1.w + g1.w * b[3]);
          }
      }
  }
  f32x4* part = (f32x4*)p.S[4];
  for (int w = blockIdx.x; w < (DT_TOTAL - DT_MAIN) * DT_SLICES; w += gridDim.x) {
    const int tile = w >> 3, sl = w & 7;
    int mt, nt; tile_map(DT_MAIN + tile, DT_TOTAL, NT / 256, 4, mt, nt);
    f32x4 acc[2][2][4][2];
    gemm256_tile<true>(W + sl * 512, A + sl * 512, 512, nt * 256, mt * 256, lds, acc, 4096);
    int tid_o = threadIdx.x; asm volatile("" : "+v"(tid_o));
    f32x4* dst = part + (size_t)(tile * DT_SLICES + sl) * 32 * 512 + tid_o;
#pragma unroll
    for (int ai = 0; ai < 2; ++ai)
#pragma unroll
      for (int bj = 0; bj < 2; ++bj)
#pragma unroll
        for (int m = 0; m < 4; ++m)
#pragma unroll
          for (int n = 0; n < 2; ++n) dst[(((ai * 2 + bj) * 4 + m) * 2 + n) * 512] = acc[ai][bj][m][n];
  }
}
DI void phase_down_reduce(const Params& p, const float* gate) {
  const int tid = threadIdx.x, lane = tid & 63, wave = tid >> 6;
  const int wr = wave >> 2, wc = wave & 3, fr = lane & 15, fq = lane >> 4;
  const f32x4* part = (const f32x4*)p.S[4];
  for (int w = blockIdx.x; w < (DT_TOTAL - DT_MAIN) * 8; w += gridDim.x) {
    const int tile = w >> 3, pt = w & 7;
    int mt, nt; tile_map(DT_MAIN + tile, DT_TOTAL, NT / 256, 4, mt, nt);
#pragma unroll
    for (int i = 0; i < 4; ++i) {
      const int k = pt * 4 + i, ai = k >> 4, bj = (k >> 3) & 1, m = (k >> 1) & 3, n = k & 1;
      f32x4 s = part[((size_t)(tile * DT_SLICES + 0) * 32 + k) * 512 + tid];
#pragma unroll
      for (int sl = 1; sl < DT_SLICES; ++sl) s += part[((size_t)(tile * DT_SLICES + sl) * 32 + k) * 512 + tid];
      const int t = mt * 256 + bj * 128 + wc * 32 + n * 16 + fr;
      const int bp = t < NL ? (t >> 12) : 8;
      float* xo = t < NL ? p.out + (size_t)t * 1024 : p.XC + (size_t)(t - NL) * 1024;
      const int f = nt * 256 + ai * 128 + wr * 64 + (m >> 1) * 32 + fq * 8 + (m & 1) * 4;
      const float4 g0 = *(const float4*)(gate + bp * 6144 + f);
      const float4 x0 = *(const float4*)(xo + f);
      *(float4*)(xo + f) = make_float4(x0.x + g0.x * s[0], x0.y + g0.y * s[1], x0.z + g0.z * s[2], x0.w + g0.w * s[3]);
    }
  }
}

DI void phase_up(const Params& p, char* lds, const bf16_t* H, const bf16_t* W, bf16_t* U, int ntm) {
  const int lane = threadIdx.x & 63, wave = threadIdx.x >> 6;
  const int wr = wave >> 2, wc = wave & 3;
  const int total = ntm * 16;
  for (int u = blockIdx.x; u < total; u += gridDim.x) {
    int mt, nt; tile_map(u, total, ntm, 16, mt, nt);
    f32x4 acc[2][2][4][2];
    gemm256_tile<true>(W, H, 1024, nt * 256, mt * 256, lds, acc);
    int lane_o = threadIdx.x & 63; asm volatile("" : "+v"(lane_o));
    const int fr = lane_o & 15, fq = lane_o >> 4;
#pragma unroll
    for (int bj = 0; bj < 2; ++bj)
#pragma unroll
      for (int n = 0; n < 2; ++n) {
        const int t = mt * 256 + bj * 128 + wc * 32 + n * 16 + fr;
#pragma unroll
        for (int ai = 0; ai < 2; ++ai)
#pragma unroll
          for (int mp = 0; mp < 2; ++mp) {
            const int f = nt * 256 + ai * 128 + wr * 64 + mp * 32 + fq * 8;
            f32x4 a = acc[ai][bj][2 * mp][n], b = acc[ai][bj][2 * mp + 1][n];
#pragma unroll
            for (int j = 0; j < 4; ++j) { const float ra = fmaxf(a[j], 0.f), rb = fmaxf(b[j], 0.f); a[j] = ra * ra; b[j] = rb * rb; }
            store_bf8(U + (size_t)t * 4096 + f, a, b);
          }
      }
  }
}

DI void phase_qkv(const Params& p, char* lds) {
  const int lane = threadIdx.x & 63, wave = threadIdx.x >> 6;
  const int wr = wave >> 2, wc = wave & 3;
  const int total = (NT / 256) * 6;
  bf16_t* Q = p.S[0]; bf16_t* KA = p.S[1]; bf16_t* VT = p.S[2];
  for (int u = blockIdx.x; u < total; u += gridDim.x) {
    int mt, nt; tile_map(u, total, NT / 256, 6, mt, nt);
    if (mt >= NL / 256 && nt < 4) continue;
    f32x4 acc[2][2][4][2];
    gemm256_tile<false>(p.wqkvT, p.S[5], 1024, nt * 256, mt * 256, lds, acc);
    int lane_o = threadIdx.x & 63; asm volatile("" : "+v"(lane_o));
    const int fr = lane_o & 15, fq = lane_o >> 4;
#pragma unroll
    for (int bj = 0; bj < 2; ++bj)
#pragma unroll
      for (int n = 0; n < 2; ++n) {
        const int t = mt * 256 + bj * 128 + wc * 32 + n * 16 + fr;
        const bool lat = t < NL;
        const int b = lat ? (t >> 12) : ((t - NL) >> 8);
        const int key = lat ? (t & 4095) : 4096 + ((t - NL) & 255);
#pragma unroll
        for (int ai = 0; ai < 2; ++ai) {
          const int hh = ai * 2 + wr;
          asm volatile("" ::: "memory");
          if (nt < 5) {
            float ss = 0.f;
#pragma unroll
            for (int m = 0; m < 4; ++m)
#pragma unroll
              for (int j = 0; j < 4; ++j) ss += acc[ai][bj][m][n][j] * acc[ai][bj][m][n][j];
            ss += __shfl_xor(ss, 16); ss += __shfl_xor(ss, 32);
            const float rstd = rsqrtf(ss * (1.f / 64.f) + 1e-6f);
            const float* gn = nt < 4 ? p.q_norm : p.k_norm;
            float v[4][4];
#pragma unroll
            for (int m = 0; m < 4; ++m) {
              const float4 g4 = *(const float4*)(gn + m * 16 + fq * 4);
              v[m][0] = acc[ai][bj][m][n][0] * rstd * g4.x; v[m][1] = acc[ai][bj][m][n][1] * rstd * g4.y;
              v[m][2] = acc[ai][bj][m][n][2] * rstd * g4.z; v[m][3] = acc[ai][bj][m][n][3] * rstd * g4.w;
            }
            if (lat) {
              const int s = t & 4095, rowp = s >> 6, colp = s & 63;
#pragma unroll
              for (int j = 0; j < 4; ++j) {
                const float2 cs0 = *(const float2*)(p.TAB + (rowp * 16 + fq * 4 + j) * 2);
                const float2 cs1 = *(const float2*)(p.TAB + (colp * 16 + fq * 4 + j) * 2);
                const float x1 = v[0][j], x2 = v[1][j], z1 = v[2][j], z2 = v[3][j];
                v[0][j] = x1 * cs0.x - x2 * cs0.y; v[1][j] = x2 * cs0.x + x1 * cs0.y;
                v[2][j] = z1 * cs1.x - z2 * cs1.y; v[3][j] = z2 * cs1.x + z1 * cs1.y;
              }
            }
            if (nt < 4) {
              const float qs = 0.125f * 1.4426950408889634f;
              const int head = nt * 4 + hh;
#pragma unroll
              for (int m = 0; m < 4; ++m)
                store_bf4(Q + (size_t)t * 1024 + head * 64 + m * 16 + fq * 4, v[m][0] * qs, v[m][1] * qs, v[m][2] * qs, v[m][3] * qs);
            } else {
#pragma unroll
              for (int m = 0; m < 4; ++m)
                store_bf4(KA + ((size_t)(b * 4 + hh) * NKEY + key) * 64 + m * 16 + fq * 4, v[m][0], v[m][1], v[m][2], v[m][3]);
            }
          } else {
#pragma unroll
            for (int m = 0; m < 4; ++m)
#pragma unroll
              for (int j = 0; j < 4; ++j) {
                const int d = m * 16 + fq * 4 + j;
                const unsigned pk = pack2(acc[ai][bj][m][n][j], 0.f);
                VT[((size_t)(b * 4 + hh) * 64 + d) * NKEY + key] = (bf16_t)(pk & 0xffffu);
              }
          }
        }
      }
  }
}

DI void phase_attn(const Params& p, char* lds) {
  const int tid = threadIdx.x, lane = tid & 63, wave = tid >> 6;
  const int l31 = lane & 31, lh = lane >> 5;
  const int srow = tid >> 3, sch = tid & 7;
  const bf16_t* Q = p.S[0]; const bf16_t* KA = p.S[1]; const bf16_t* VT = p.S[2]; bf16_t* O = p.S[3];
  float gq = 0.f, gk = 0.f;
  for (int i = 0; i < 64; ++i) { gq = fmaxf(gq, fabsf(p.q_norm[i])); gk = fmaxf(gk, fabsf(p.k_norm[i])); }
  const float M2 = 8.f * gq * gk * 1.4426950408889634f;
  constexpr int NKT = NKEY / 128;
  constexpr int VROW = 272;
  constexpr int KST = 128 * ROWB;
  constexpr int AST = KST + 64 * VROW;
  for (int u = blockIdx.x; u < 1024; u += gridDim.x) {
    const int qb = u & 7, head = (u >> 3) & 15, b = u >> 7, kvh = head >> 2;
    const bf16_t* Kg = KA + (size_t)(b * 4 + kvh) * NKEY * 64;
    const bf16_t* Vg = VT + (size_t)(b * 4 + kvh) * 64 * NKEY;
    const int tq0 = b * 4096 + qb * 512 + wave * 64 + l31;
    bf16x8 qf[2][4];
#pragma unroll
    for (int blk = 0; blk < 2; ++blk)
#pragma unroll
      for (int s = 0; s < 4; ++s) qf[blk][s] = *(const bf16x8*)(Q + (size_t)(tq0 + blk * 32) * 1024 + head * 64 + s * 16 + lh * 8);
    f32x16 o[2][2];
#pragma unroll
    for (int blk = 0; blk < 2; ++blk)
#pragma unroll
      for (int dt = 0; dt < 2; ++dt)
#pragma unroll
        for (int i = 0; i < 16; ++i) o[blk][dt][i] = 0.f;
    float lsum[2] = {0.f, 0.f};
    uint4 kr = make_uint4(0, 0, 0, 0), vr = kr;
    __syncthreads();
    for (int kt = -1; kt < NKT; ++kt) {
      const bool more = kt + 1 < NKT;
#pragma unroll 1
      for (int hf = 0; hf < 2; ++hf) {
        if (more) {
          kr = *(const uint4*)(Kg + (size_t)((kt + 1) * 128 + hf * 64 + srow) * 64 + sch * 8);
          vr = *(const uint4*)(Vg + (size_t)srow * NKEY + (kt + 1) * 128 + hf * 64 + sch * 8);
        }
        if (kt >= 0) {
          const char* ksm = lds + (kt & 1) * AST + hf * 64 * ROWB;
          const char* vsm = lds + (kt & 1) * AST + KST + hf * 128;
          f32x16 sT[2][2];
#pragma unroll
          for (int blk = 0; blk < 2; ++blk)
#pragma unroll
            for (int k2 = 0; k2 < 2; ++k2)
#pragma unroll
              for (int i = 0; i < 16; ++i) sT[blk][k2][i] = -M2;
#pragma unroll
          for (int k2 = 0; k2 < 2; ++k2)
#pragma unroll
            for (int s = 0; s < 4; ++s) {
              const bf16x8 kf = *(const bf16x8*)(ksm + (k2 * 32 + l31) * ROWB + s * 32 + lh * 16);
              sT[0][k2] = MFMA32(kf, qf[0][s], sT[0][k2]);
              sT[1][k2] = MFMA32(kf, qf[1][s], sT[1][k2]);
            }
#pragma unroll
          for (int blk = 0; blk < 2; ++blk)
#pragma unroll
            for (int k2 = 0; k2 < 2; ++k2)
#pragma unroll
              for (int i = 0; i < 16; ++i) { const float pv = __builtin_amdgcn_exp2f(sT[blk][k2][i]); lsum[blk] += pv; sT[blk][k2][i] = pv; }
#pragma unroll
          for (int k2 = 0; k2 < 2; ++k2)
#pragma unroll
            for (int s2 = 0; s2 < 2; ++s2) {
              bf16x8 pf[2];
#pragma unroll
              for (int blk = 0; blk < 2; ++blk) {
                uint4 pk;
                pk.x = pack2(sT[blk][k2][8 * s2 + 0], sT[blk][k2][8 * s2 + 1]); pk.y = pack2(sT[blk][k2][8 * s2 + 2], sT[blk][k2][8 * s2 + 3]);
                pk.z = pack2(sT[blk][k2][8 * s2 + 4], sT[blk][k2][8 * s2 + 5]); pk.w = pack2(sT[blk][k2][8 * s2 + 6], sT[blk][k2][8 * s2 + 7]);
                pf[blk] = __builtin_bit_cast(bf16x8, pk);
              }
              const int koff = (k2 * 32 + 16 * s2 + 4 * lh) * 2;
#pragma unroll
              for (int dt = 0; dt < 2; ++dt) {
                const uint2 lo = *(const uint2*)(vsm + (dt * 32 + l31) * VROW + koff), hi = *(const uint2*)(vsm + (dt * 32 + l31) * VROW + koff + 16);
                const bf16x8 vv = __builtin_bit_cast(bf16x8, make_uint4(lo.x, lo.y, hi.x, hi.y));
                o[0][dt] = MFMA32(vv, pf[0], o[0][dt]);
                o[1][dt] = MFMA32(vv, pf[1], o[1][dt]);
              }
            }
        }
        if (more) {
          char* st = lds + ((kt + 1) & 1) * AST;
          *(uint4*)(st + (hf * 64 + srow) * ROWB + sch * 16) = kr;
          *(uint4*)(st + KST + srow * VROW + hf * 128 + sch * 16) = vr;
        }
      }
      __syncthreads();
    }
#pragma unroll
    for (int blk = 0; blk < 2; ++blk) {
      float ls = lsum[blk];
      ls += __shfl_xor(ls, 32);
      const float inv = 1.f / ls;
      const int tq = tq0 + blk * 32;
#pragma unroll
      for (int g = 0; g < 4; ++g) {
        const int d0 = 8 * g + 4 * lh;
        store_bf4(O + (size_t)tq * 1024 + head * 64 + d0, o[blk][0][4 * g] * inv, o[blk][0][4 * g + 1] * inv, o[blk][0][4 * g + 2] * inv, o[blk][0][4 * g + 3] * inv);
        store_bf4(O + (size_t)tq * 1024 + head * 64 + 32 + d0, o[blk][1][4 * g] * inv, o[blk][1][4 * g + 1] * inv, o[blk][1][4 * g + 2] * inv, o[blk][1][4 * g + 3] * inv);
      }
    }
  }
}

#define XB_TMO      128
#define XB_XCNT(j)  (256  + 64 * (j))
#define XB_XSUB(j)  (1280 + 64 * (j))
#define XB_XGEN(j)  (2304 + 64 * (j))
#define XB_TOP      3328
#define XB_TOPGEN   3392
#define XCD_BAR_WORDS 3456
#define XB_SPIN_CAP (1u << 18)
#define LAS __attribute__((address_space(3)))

__device__ __forceinline__ unsigned xb_ld(unsigned* p)              { return __hip_atomic_load(p, __ATOMIC_RELAXED, __HIP_MEMORY_SCOPE_AGENT); }
__device__ __forceinline__ unsigned xb_add(unsigned* p, unsigned v) { return __hip_atomic_fetch_add(p, v, __ATOMIC_RELAXED, __HIP_MEMORY_SCOPE_AGENT); }
__device__ __forceinline__ unsigned xb_xcc_id() { return (unsigned)__builtin_amdgcn_s_getreg((3 << 11) | 20) & 0xFu; }
#define XB_SPIN(cond, bar) do { unsigned _sp = 0; while (cond) { __builtin_amdgcn_s_sleep(1); \
    if ((++_sp & 255u) == 0u) { if (xb_ld(&(bar)[XB_TMO])) break; if (_sp > XB_SPIN_CAP) { atomicAdd(&(bar)[XB_TMO], 1u); break; } } } } while (0)

struct XcdBarrier {
    unsigned* bar; unsigned x;
    volatile LAS unsigned* st;
};

__device__ __forceinline__ XcdBarrier xcd_barrier_post(unsigned* bar, volatile LAS unsigned* st) {
    XcdBarrier b; b.bar = bar; b.x = xb_xcc_id(); b.st = st;
    if (threadIdx.x == 0) (void)xb_add(&bar[XB_XCNT(b.x)], 1u);
    return b;
}
__device__ __forceinline__ void xcd_barrier_complete(unsigned* bar, unsigned x, unsigned& nloc, unsigned& nx) {
    const unsigned G = gridDim.x * gridDim.y * gridDim.z;
    unsigned sum, cnt, mine, sp = 0u;
    for (;;) {
        sum = 0u; cnt = 0u; mine = 0u;
#pragma unroll
        for (unsigned j = 0; j < 16; ++j) { const unsigned c = xb_ld(&bar[XB_XCNT(j)]); sum += c; cnt += (c > 0u) ? 1u : 0u; mine = (j == x) ? c : mine; }
        if (sum == G) break;
        __builtin_amdgcn_s_sleep(1);
        if ((++sp & 255u) == 0u) { if (xb_ld(&bar[XB_TMO])) break; if (sp > XB_SPIN_CAP) { atomicAdd(&bar[XB_TMO], 1u); break; } }
    }
    nloc = mine > 0u ? mine : 1u; nx = cnt > 0u ? cnt : 1u;
}

__device__ __forceinline__ void xcd_barrier(const XcdBarrier& b) {
    asm volatile("s_waitcnt vmcnt(0)" ::: "memory");
    __syncthreads();
    if (threadIdx.x == 0) {
        unsigned* bar = b.bar;
        __builtin_amdgcn_s_waitcnt(0);
        unsigned nloc = b.st[0], nx = b.st[1];
        if (nloc == 0u) { xcd_barrier_complete(bar, b.x, nloc, nx); b.st[0] = nloc; b.st[1] = nx; }
        const unsigned old = xb_add(&bar[XB_XSUB(b.x)], 1u);
        const unsigned gen = old / nloc;
        if (old + 1u == (gen + 1u) * nloc) {
            __builtin_amdgcn_fence(__ATOMIC_RELEASE, "agent");
            asm volatile("s_waitcnt vmcnt(0)" ::: "memory");
            const unsigned og = xb_add(&bar[XB_TOP], 1u);
            const unsigned tg = og / nx;
            if (og + 1u == (tg + 1u) * nx) xb_add(&bar[XB_TOPGEN], 1u);
            else XB_SPIN(xb_ld(&bar[XB_TOPGEN]) == tg, bar);
            __builtin_amdgcn_fence(__ATOMIC_ACQUIRE, "agent");
            xb_add(&bar[XB_XGEN(b.x)], 1u);
            asm volatile("s_waitcnt vmcnt(0)" ::: "memory");
        } else {
            XB_SPIN(xb_ld(&bar[XB_XGEN(b.x)]) == gen, bar);
            __builtin_amdgcn_fence(__ATOMIC_ACQUIRE, "agent");
            asm volatile("s_waitcnt vmcnt(0)" ::: "memory");
        }
    }
    __syncthreads();
}


DI void run_phase(const Params& p, int ph, char* lds) {
  const float* mod0 = p.MOD;
  const float* mod1 = p.MOD + 9 * 6144;
  switch (ph) {
    case 0: phase0(p, lds); break;
    case 1: norm_mod_phase(p.x, p.ctx, p.norm_mix, mod0, 0, 1, p.Hd, NT); break;
    case 2: phase_proj(p, lds); break;
    case 20: phase_mix(p); break;
    case 3: phase_prep(p, lds); break;
    case 4: phase_scan(p, lds); break;
    case 5: phase_readout(p, lds); break;
    case 6: phase_gemm_resid(p, lds, p.S[0], p.woT, 1024, NT / 256, p.x, p.ctx, mod0 + 2 * 1024); break;
    case 7: norm_mod_phase(p.out, p.XC, p.norm_mlp, mod0, 3, 4, p.S[5], NT); break;
    case 8: phase_up(p, lds, p.S[5], p.w1T[0], p.S[0], NT / 256); break;
    case 9: phase_down_split(p, lds, mod0 + 5 * 1024); break;
    case 21: phase_down_reduce(p, mod0 + 5 * 1024); break;
    case 10: norm_mod_phase(p.out, p.XC, p.norm_mix + 1024, mod1, 0, 1, p.S[5], NT); break;
    case 11: phase_qkv(p, lds); break;
    case 12: phase_attn(p, lds); break;
    case 13: phase_gemm_resid(p, lds, p.S[3], p.awoT, 1024, NL / 256, p.out, p.XC, mod1 + 2 * 1024); break;
    case 14: norm_mod_phase(p.out, p.XC, p.norm_mlp + 1024, mod1, 3, 4, p.S[5], NL); break;
    case 15: phase_up(p, lds, p.S[5], p.w1T[1], p.S[0], NL / 256); break;
    case 16: phase_gemm_resid(p, lds, p.S[0], p.w2T[1], 4096, NL / 256, p.out, p.XC, mod1 + 5 * 1024); break;
    case 17: final_norm_phase(p); break;
  }
}
constexpr int NPHASE = 18;

__global__ void __launch_bounds__(NTHREADS) mega_kernel(Params p) {
  extern __shared__ __attribute__((aligned(16))) char lds[];
  cg::grid_group grid = cg::this_grid();
  volatile LAS unsigned* st = (volatile LAS unsigned*)(LAS char*)(lds + 131072);
  if (threadIdx.x == 0) { st[0] = 0u; st[1] = 0u; }
  if (blockIdx.x == 0) for (int i = threadIdx.x; i < XCD_BAR_WORDS; i += NTHREADS) p.BAR[i] = 0u;
  __syncthreads();
  run_phase(p, 0, lds);
  grid.sync();
  const XcdBarrier xb = xcd_barrier_post(p.BAR, st);
#define PH(n) run_phase(p, n, lds); xcd_barrier(xb);
  PH(1) PH(20) PH(2) PH(3) PH(4) PH(5) PH(6) PH(7) PH(8) PH(9) PH(21) PH(10) PH(11) PH(12) PH(13) PH(14) PH(15) PH(16)
  run_phase(p, 17, lds);
}

extern "C" void kernel_launch(void* const* d_in, const int* in_sizes, int n_in, void* d_out, int out_size, void* d_ws, size_t ws_size, hipStream_t stream) {
  Params p;
  memset(&p, 0, sizeof(p));
  const float* const* in = (const float* const*)d_in;
  p.x = in[0]; p.c = in[1]; p.ctx = in[2]; p.c_ctx = in[3]; p.w_mod = in[4]; p.b_mod = in[5]; p.norm_mix = in[6]; p.norm_mlp = in[7];
  p.mlp_w1 = in[8]; p.mlp_w2 = in[9]; p.mu = in[10]; p.wr = in[11]; p.wk = in[12]; p.wv = in[13]; p.wo = in[14]; p.w0 = in[15]; p.w1 = in[16];
  p.w2 = in[17]; p.a0 = in[18]; p.a1 = in[19]; p.a2 = in[20]; p.g1 = in[21]; p.g2 = in[22]; p.k_k = in[23]; p.k_a = in[24]; p.r_k = in[25];
  p.ln_w = in[26]; p.ln_b = in[27]; p.wqkv = in[28]; p.q_norm = in[29]; p.k_norm = in[30]; p.awo = in[31]; p.final_norm = in[32];
  p.out = (float*)d_out;
  char* ws = (char*)d_ws;
  size_t off = 0;
  auto take = [&](size_t bytes) -> char* { char* r = ws + off; off += (bytes + 255) & ~(size_t)255; return r; };
  p.Wcat = (bf16_t*)take((size_t)3456 * 1024 * 2);
  p.L2w = (bf16_t*)take((size_t)4 * 65536 * 2);
  p.g2T = (bf16_t*)take((size_t)1024 * 128 * 2);
  p.woT = (bf16_t*)take((size_t)1024 * 1024 * 2);
  p.w1T[0] = (bf16_t*)take((size_t)4096 * 1024 * 2);
  p.w1T[1] = (bf16_t*)take((size_t)4096 * 1024 * 2);
  p.w2T[0] = (bf16_t*)take((size_t)4096 * 1024 * 2);
  p.w2T[1] = (bf16_t*)take((size_t)4096 * 1024 * 2);
  p.wqkvT = (bf16_t*)take((size_t)1536 * 1024 * 2);
  p.awoT = (bf16_t*)take((size_t)1024 * 1024 * 2);
  p.MOD = (float*)take((size_t)2 * 9 * 6144 * 4);
  p.TAB = (float*)take((size_t)1024 * 2 * 4);
  p.XC = (float*)take((size_t)NC * 1024 * 4);
  p.BAR = (unsigned*)take((size_t)XCD_BAR_WORDS * 4);
  for (int i = 0; i < 6; ++i) p.S[i] = (bf16_t*)take((size_t)NT * 1024 * 2);
  if (off > ws_size) { fprintf(stderr, "kernel_launch: workspace too small (%zu needed, %zu given)\n", off, ws_size); return; }
  char* ob = (char*)d_out;
  p.Hd = (bf16_t*)ob;
  p.L1 = (bf16_t*)(ob + (size_t)NT * 1024 * 2);
  p.BON = (float*)(ob + (size_t)NT * 1024 * 2 + (size_t)NT * 384 * 2);
  p.NRM = (float*)(ob + (size_t)NT * 1024 * 2 + (size_t)NT * 384 * 2 + (size_t)NT * 16 * 4);
  int nj = 0, tiles = 0;
  auto job = [&](const float* src, bf16_t* dst, int K, int N) {
    p.jobs[nj].src = src; p.jobs[nj].dst = dst; p.jobs[nj].K = K; p.jobs[nj].N = N; p.jobs[nj].tstart = tiles; p.jobs[nj].tiles_n = N / 64;
    tiles += (K / 64) * (N / 64); ++nj;
  };
  job(p.wr, p.Wcat, 1024, 1024);
  job(p.wk, p.Wcat + (size_t)1024 * 1024, 1024, 1024);
  job(p.wv, p.Wcat + (size_t)2048 * 1024, 1024, 1024);
  job(p.g1, p.Wcat + (size_t)3072 * 1024, 1024, 128);
  job(p.w1, p.Wcat + (size_t)3200 * 1024, 1024, 64);
  job(p.w1 + 65536, p.Wcat + (size_t)3264 * 1024, 1024, 64);
  job(p.a1, p.Wcat + (size_t)3328 * 1024, 1024, 64);
  job(p.a1 + 65536, p.Wcat + (size_t)3392 * 1024, 1024, 64);
  job(p.a2, p.L2w, 64, 1024);
  job(p.a2 + 65536, p.L2w + 65536, 64, 1024);
  job(p.w2, p.L2w + 2 * 65536, 64, 1024);
  job(p.w2 + 65536, p.L2w + 3 * 65536, 64, 1024);
  job(p.g2, p.g2T, 128, 1024);
  job(p.wo, p.woT, 1024, 1024);
  job(p.mlp_w1, p.w1T[0], 1024, 4096);
  job(p.mlp_w1 + (size_t)4096 * 1024, p.w1T[1], 1024, 4096);
  job(p.mlp_w2, p.w2T[0], 4096, 1024);
  job(p.mlp_w2 + (size_t)4096 * 1024, p.w2T[1], 4096, 1024);
  job(p.wqkv, p.wqkvT, 1024, 1536);
  job(p.awo, p.awoT, 1024, 1024);
  p.njobs = nj; p.total_tiles = tiles;

  static int grid_blocks = 0;
  if (!grid_blocks) {
    (void)hipFuncSetAttribute((const void*)mega_kernel, hipFuncAttributeMaxDynamicSharedMemorySize, LDS_BYTES);
    int dev = 0, cus = 0, per_cu = 0;
    (void)hipGetDevice(&dev);
    (void)hipDeviceGetAttribute(&cus, hipDeviceAttributeMultiprocessorCount, dev);
    if (hipOccupancyMaxActiveBlocksPerMultiprocessor(&per_cu, (const void*)mega_kernel, NTHREADS, LDS_BYTES) != hipSuccess || per_cu < 1) per_cu = 1;
    if (cus <= 0) cus = 256;
    grid_blocks = cus * per_cu;
    (void)hipGetLastError();
  }
  void* args[] = {&p};
  hipError_t e = hipLaunchCooperativeKernel((const void*)mega_kernel, dim3(grid_blocks), dim3(NTHREADS), args, LDS_BYTES, stream);
  if (e != hipSuccess) fprintf(stderr, "cooperative launch failed: %s (grid %d)\n", hipGetErrorString(e), grid_blocks);
}
```
